# Optimizing an MI355X kernel written in HIP

```python
import jax
import jax.numpy as jnp
from jax import lax
import numpy as np

D_MODEL = 1024
BATCH = 8
SEQ = 4096
DEPTH = 2

HEAD_DIM = 64
ATT_WIDTH = 3 * D_MODEL // 8
RET_WIDTH = 3 * D_MODEL // 8
HGRN_WIDTH = D_MODEL - ATT_WIDTH - RET_WIDTH
ATT_HEADS = ATT_WIDTH // HEAD_DIM
RET_HEADS = RET_WIDTH // HEAD_DIM
HGRN_HEADS = HGRN_WIDTH // HEAD_DIM
MIX_WIDTH = ATT_WIDTH + RET_WIDTH + HGRN_WIDTH
IN_SPLITS = (ATT_WIDTH,) * 3 + (RET_WIDTH,) * 4 + (HGRN_WIDTH,) * 5
IN_WIDTH = sum(IN_SPLITS)
DILATED_CONFIGS = ((128, 1), (512, 4), (2048, 16))
RET_CHUNK = 128
HGRN_CHUNK = 16
FFN_HIDDEN = ((-(-8 * D_MODEL // 3)) + 255) // 256 * 256
N_MOD = 6
NORM_EPS = 1e-6
NEG_INF = -1e30
LB_FLOOR = 1e-30

kernel_name = 'hybrid_dilated_retention_hgrn2_encoder'


def rms_norm(x, gain):
    xf = x.astype(jnp.float32)
    y = xf * lax.rsqrt(jnp.mean(xf * xf, axis=-1, keepdims=True) + NORM_EPS)
    return (y * gain.astype(jnp.float32)).astype(x.dtype)


def dilated_branch(q, k, v, slopes, window, dilation):
    B, S, H, dh = q.shape
    r = dilation
    n_side = window // 2 // r
    L = S // r
    nb = -(-L // n_side)
    Lp = nb * n_side

    def to_sub(t):
        t = t.reshape(B, L, r, H, dh).transpose(0, 2, 3, 1, 4)
        return jnp.pad(t, ((0, 0), (0, 0), (0, 0), (0, Lp - L), (0, 0)))

    def key_blocks(t):
        t = jnp.pad(to_sub(t), ((0, 0), (0, 0), (0, 0), (n_side, n_side), (0, 0)))
        t = t.reshape(B, r, H, nb + 2, n_side, dh)
        return jnp.concatenate([t[:, :, :, :-2], t[:, :, :, 1:-1], t[:, :, :, 2:]], axis=4)

    qs = to_sub(q).reshape(B, r, H, nb, n_side, dh) * HEAD_DIM ** -0.5
    ks, vs = key_blocks(k), key_blocks(v)
    qi = jnp.arange(Lp).reshape(nb, n_side, 1)
    kj = jnp.arange(nb)[:, None, None] * n_side + jnp.arange(3 * n_side)[None, None, :] - n_side
    steps = jnp.abs(qi - kj)
    valid = (steps <= n_side) & (kj >= 0) & (kj < L)
    bias = -slopes[:, None, None, None] * (dilation * steps).astype(jnp.float32)
    s = jnp.einsum('brhnqd,brhnkd->brhnqk', qs, ks, preferred_element_type=jnp.float32) + bias
    s = jnp.where(valid, s, NEG_INF)
    m = jnp.max(s, axis=-1, keepdims=True)
    p = jnp.exp(s - m)
    l = jnp.sum(p, axis=-1, keepdims=True)
    o = jnp.einsum('brhnqk,brhnkd->brhnqd', p, vs.astype(jnp.float32)) / l
    lse = (m + jnp.log(l))[..., 0]
    o = o.reshape(B, r, H, Lp, dh)[:, :, :, :L].transpose(0, 3, 1, 2, 4).reshape(B, S, H, dh)
    lse = lse.reshape(B, r, H, Lp)[..., :L].transpose(0, 3, 1, 2).reshape(B, S, H)
    return o, lse


def retention_bidir(q, k, v):
    B, S, H, d = q.shape
    C = RET_CHUNK
    N = S // C

    def chunks(t):
        return t.astype(jnp.float32).reshape(B, N, C, H, d).transpose(0, 3, 1, 2, 4)

    q, k, v = chunks(q), chunks(k) * d ** -0.5, chunks(v)
    log_g = jnp.log1p(-jnp.exp2(-5.0 - jnp.arange(H, dtype=jnp.float32)))[:, None, None, None]
    pos = jnp.arange(C, dtype=jnp.float32)[:, None]
    intra = jnp.exp(log_g * jnp.abs(pos - pos.T))
    scores = jnp.einsum('bhnid,bhnjd->bhnij', q, k) * intra
    out = jnp.einsum('bhnij,bhnjd->bhnid', scores, v)
    u_fwd = jnp.einsum('bhncd,bhnce->nbhde', k * jnp.exp(log_g * (C - 1 - pos)), v)
    u_bwd = jnp.einsum('bhncd,bhnce->nbhde', k * jnp.exp(log_g * pos), v)
    chunk_decay = jnp.exp(log_g[:, :, 0] * C)

    def step(state, u):
        return chunk_decay * state + u, state

    zero = jnp.zeros((B, H, d, d), jnp.float32)
    _, r_fwd = lax.scan(step, zero, u_fwd)
    _, r_bwd = lax.scan(step, zero, u_bwd, reverse=True)
    out = (out
           + jnp.einsum('bhncd,nbhde->bhnce', q * jnp.exp(log_g * (pos + 1.0)), r_fwd)
           + jnp.einsum('bhncd,nbhde->bhnce', q * jnp.exp(log_g * (C - pos)), r_bwd))
    return out.transpose(0, 2, 3, 1, 4).reshape(B, S, H, d)


def gated_recurrence_chunked(q, log_f, k, v):
    B, S, H, dk = q.shape
    dv = v.shape[-1]
    C = HGRN_CHUNK
    N = S // C

    def chunks(t):
        return t.reshape(B, N, C, H, t.shape[-1]).transpose(0, 3, 1, 2, 4)

    q, log_f, k, v = chunks(q), chunks(log_f), chunks(k), chunks(v)
    b = jnp.cumsum(log_f, axis=3)
    tri = jnp.tril(jnp.ones((C, C), dtype=bool))[:, :, None]
    rel = jnp.where(tri, jnp.exp(jnp.minimum(b[:, :, :, :, None, :] - b[:, :, :, None, :, :], 0.0)), 0.0)
    attn = jnp.einsum('bhntd,bhnsd,bhntsd->bhnts', q, k, rel)
    out = jnp.einsum('bhnts,bhnse->bhnte', attn, v)
    b_last = b[:, :, :, -1:, :]
    u = jnp.einsum('bhnsd,bhnse->nbhde', k * jnp.exp(b_last - b), v)
    a = jnp.exp(b_last[:, :, :, 0, :]).transpose(2, 0, 1, 3)[..., None]

    def step(state, xs):
        a_n, u_n = xs
        return a_n * state + u_n, state

    _, s_prev = lax.scan(step, jnp.zeros((B, H, dk, dv), jnp.float32), (a, u))
    out = out + jnp.einsum('bhntd,nbhde->bhnte', q * jnp.exp(b), s_prev)
    return out.transpose(0, 2, 3, 1, 4).reshape(B, S, H, dv)


def hgrn2_bidir(hq, hz_fwd, hz_bwd, hi, lb):
    B, S, _ = hq.shape
    shp = (B, S, HGRN_HEADS, HEAD_DIM)
    log_lb = jnp.log(jnp.maximum(lb, LB_FLOOR))
    log_one_minus_lb = jnp.log1p(-lb)

    def gates(z):
        z = z.astype(jnp.float32)
        log_f = jnp.logaddexp(log_lb, log_one_minus_lb + jax.nn.log_sigmoid(z))
        k = (1.0 - lb) * jax.nn.sigmoid(-z)
        return log_f.reshape(shp), k.reshape(shp)

    q = jax.nn.silu(hq.astype(jnp.float32)).reshape(shp)
    v = hi.astype(jnp.float32).reshape(shp)
    lf_f, k_f = gates(hz_fwd)
    lf_b, k_b = gates(hz_bwd)
    o_f = gated_recurrence_chunked(q, lf_f, k_f, v)
    o_b = jnp.flip(gated_recurrence_chunked(jnp.flip(q, 1), jnp.flip(lf_b, 1), jnp.flip(k_b, 1), jnp.flip(v, 1)), 1)
    return (o_f + o_b).reshape(B, S, HGRN_WIDTH)


def hybrid_mixer(h, w_in, w_out, ret_gn, hgrn_gn, lb):
    B, S, _ = h.shape
    proj = h @ w_in
    cuts = [int(i) for i in np.cumsum(IN_SPLITS)[:-1]]
    aq, ak, av, rq, rk, rv, rg, hq, hzf, hzb, hi, hg = jnp.split(proj, cuts, axis=-1)

    def heads(t, n):
        return t.reshape(B, S, n, HEAD_DIM)

    q, k, v = heads(aq, ATT_HEADS), heads(ak, ATT_HEADS), heads(av, ATT_HEADS)
    slopes = jnp.exp2(-8.0 * jnp.arange(1, ATT_HEADS + 1, dtype=jnp.float32) / ATT_HEADS)
    outs, lses = [], []
    for window, dilation in DILATED_CONFIGS:
        o, l = dilated_branch(q, k, v, slopes, window, dilation)
        outs.append(o)
        lses.append(l)
    wts = jax.nn.softmax(jnp.stack(lses), axis=0)[..., None]
    att = jnp.sum(wts * jnp.stack(outs), axis=0).reshape(B, S, ATT_WIDTH)

    ret = retention_bidir(heads(rq, RET_HEADS), heads(rk, RET_HEADS), heads(rv, RET_HEADS))
    mu = jnp.mean(ret, axis=-1, keepdims=True)
    var = jnp.mean(jnp.square(ret - mu), axis=-1, keepdims=True)
    ret = ((ret - mu) * lax.rsqrt(var + NORM_EPS)).reshape(B, S, RET_WIDTH)
    ret = ret * ret_gn.astype(jnp.float32) * jax.nn.silu(rg.astype(jnp.float32))

    hgo = rms_norm(hgrn2_bidir(hq, hzf, hzb, hi, lb), hgrn_gn) * jax.nn.silu(hg.astype(jnp.float32))

    mixed = jnp.concatenate([att, ret, hgo], axis=-1).astype(h.dtype)
    return mixed @ w_out


def swiglu(h, w_gate_up, w_down):
    g, u = jnp.split(h @ w_gate_up, 2, axis=-1)
    return (jax.nn.silu(g) * u) @ w_down


def setup_inputs(seed: int = 0) -> dict:
    key = jax.random.key(seed)
    ks = jax.random.split(key, 16)

    def nrm(k, shape, scale):
        return jax.random.normal(k, shape, jnp.float32) * scale

    D = D_MODEL
    return {
        'x': nrm(ks[0], (BATCH, SEQ, D), 1.0),
        'c': nrm(ks[1], (BATCH, D), 1.0),
        'w_ada': nrm(ks[2], (DEPTH, D, N_MOD * D), 0.5 * D ** -0.5),
        'b_ada': nrm(ks[3], (DEPTH, N_MOD * D), 0.02),
        'g_mix': 1.0 + nrm(ks[4], (DEPTH, D), 0.02),
        'w_in': nrm(ks[5], (DEPTH, D, IN_WIDTH), D ** -0.5),
        'ret_gn': 1.0 + nrm(ks[6], (DEPTH, RET_WIDTH), 0.02),
        'hgrn_gn': 1.0 + nrm(ks[7], (DEPTH, HGRN_WIDTH), 0.02),
        'hgrn_lb_logits': nrm(ks[8], (DEPTH, HGRN_WIDTH), 0.5),
        'w_out': nrm(ks[9], (DEPTH, MIX_WIDTH, D), MIX_WIDTH ** -0.5),
        'g_ffn': 1.0 + nrm(ks[10], (DEPTH, D), 0.02),
        'w_gate_up': nrm(ks[11], (DEPTH, D, 2 * FFN_HIDDEN), D ** -0.5),
        'w_down': nrm(ks[12], (DEPTH, FFN_HIDDEN, D), FFN_HIDDEN ** -0.5),
        'g_final': 1.0 + nrm(ks[13], (D,), 0.02),
    }


def reference(x, c, w_ada, b_ada, g_mix, w_in, ret_gn, hgrn_gn, hgrn_lb_logits, w_out,
              g_ffn, w_gate_up, w_down, g_final):
    B, S, D = x.shape
    lb_p = jax.nn.softmax(hgrn_lb_logits.astype(jnp.float32), axis=0)
    lb_all = jnp.clip(jnp.cumsum(lb_p, axis=0) - lb_p[0:1], 0.0, 1.0 - 1e-6)
    cond = jax.nn.silu(c)
    for layer in range(DEPTH):
        mod = (cond @ w_ada[layer] + b_ada[layer]).reshape(B, N_MOD, 1, D)
        shift1, scale1, gate1 = mod[:, 0], mod[:, 1], mod[:, 2]
        shift2, scale2, gate2 = mod[:, 3], mod[:, 4], mod[:, 5]
        h = rms_norm(x, g_mix[layer]) * (1.0 + scale1) + shift1
        y = hybrid_mixer(h, w_in[layer], w_out[layer], ret_gn[layer], hgrn_gn[layer], lb_all[layer])
        x = x + (gate1 * y).astype(x.dtype)
        h = rms_norm(x, g_ffn[layer]) * (1.0 + scale2) + shift2
        x = x + (gate2 * swiglu(h, w_gate_up[layer], w_down[layer])).astype(x.dtype)
    return rms_norm(x, g_final)
```

```cpp
#include <hip/hip_runtime.h>
#include <hip/hip_cooperative_groups.h>
#include <cstdio>
#include <cstdint>
namespace cg = cooperative_groups;
#ifndef ONE_LAUNCH
#define ONE_LAUNCH 1
#endif
__device__ __forceinline__ int opaque_tid() { int t = threadIdx.x; asm volatile("" : "+v"(t)); return t; }
namespace pg8 {
#define PG8_LAS __attribute__((address_space(3)))
typedef unsigned short bf16_t;
typedef short bf16x8 __attribute__((ext_vector_type(8)));
typedef float f32x4 __attribute__((ext_vector_type(4)));
typedef unsigned u32x4 __attribute__((ext_vector_type(4)));
constexpr int BM = 256, BK = 64, HALF = 128, HTB = HALF * BK * 2  , STAGE_BYTES = 8 * HTB, NXCD = 8, WGM = 8;

__host__ __device__ __forceinline__ int lds_byte(int r, int c) { const int st = (r >> 4) * 2 + (c >> 5), rr = r & 15, cc = c & 31, ob = rr * 64 + cc * 2; return st * 1024 + (ob ^ (((ob >> 9) & 1) << 5)); }
__host__ __device__ __forceinline__ void stage_rc(int b, int& R, int& C) { const int st = b / 1024, sb = b % 1024, swz = sb ^ (((sb >> 9) & 1) << 5); R = (st >> 1) * 16 + swz / 64; C = (st & 1) * 32 + (swz % 64) / 2; }
__host__ __device__ __forceinline__ int perm32(int rho) { const int n = rho >> 4, i = rho & 15; return 8 * (i >> 2) + 4 * n + (i & 3); }

struct Unit { int pm, pn; };
struct Gemm { const bf16_t* A; const bf16_t* Bt; int M, N, K; };

struct StaticOrder {
    int nM, nN, nwg, G, c;
    __host__ __device__ void init(int M, int N, int G_, int c_) { nM = M / BM; nN = N / BM; nwg = nM * nN; G = G_; c = c_; }
    __host__ __device__ bool next(int i, Unit& u) const {
        const long L = (long)i * G + c; if (L >= nwg) return false;
        int wgid = (int)L; { const int q = nwg / NXCD, r = nwg % NXCD, xcd = wgid % NXCD, off = wgid / NXCD; wgid = (xcd < r ? xcd * (q + 1) : r * (q + 1) + (xcd - r) * q) + off; }
        const int nig = WGM * nN, gid = wgid / nig, fm = gid * WGM, gsz = (nM - fm) < WGM ? (nM - fm) : WGM;
        u.pm = fm + ((wgid % nig) % gsz); u.pn = (wgid % nig) / gsz; return true;
    }
    __device__ __forceinline__ void a_ready(const Unit&) const {}
    __device__ __forceinline__ void done(const Unit&) const {}
};
__device__ __forceinline__ unsigned cvt_pk_bf16(float lo, float hi) { unsigned r; asm volatile("v_cvt_pk_bf16_f32 %0, %1, %2" : "=v"(r) : "v"(lo), "v"(hi)); return r; }
typedef float f32x2 __attribute__((ext_vector_type(2)));
template <class Epi, class Sched, bool STAMP = false>
__device__ __forceinline__ void gemm_phase(PG8_LAS unsigned char* lds, const Gemm g, const Sched& S, const Epi& E, unsigned long long* stamps) {
    const int tid = opaque_tid(), wid = __builtin_amdgcn_readfirstlane(tid >> 6), lane = tid & 63, wr = wid >> 2, wc = wid & 3, fr = lane & 15, fq = lane >> 4;
    const int K = g.K, nt = K / BK;
    int ts_lo = 0, ts_hi = 0, nts = 0; const unsigned long long rt_entry = STAMP ? (unsigned long long)wall_clock64() : 0ull;
#define PG8_STAMP() do { if (STAMP && wid == 0 && nts < 64) { const unsigned long long _c = (unsigned long long)clock64(); \
        ts_lo = (lane == nts) ? (int)(unsigned)_c : ts_lo; ts_hi = (lane == nts) ? (int)(unsigned)(_c >> 32) : ts_hi; ++nts; } } while (0)
    PG8_STAMP();
    unsigned voffA[2], voffB[2];
#pragma unroll
    for (int i = 0; i < 2; ++i) { int R, C; stage_rc(tid * 16 + i * 8192, R, C); const int Rb = Epi::PERM ? ((R & ~31) + perm32(R & 31)) : R;
        voffA[i] = (unsigned)(R * K + C) * 2u; voffB[i] = (unsigned)(Rb * K + C) * 2u; }
    const size_t kstep = (size_t)(BK * 2);
    const size_t hstep = (size_t)HALF * K * 2;
    const size_t tstep = 2 * hstep;
    const unsigned ldsw = (unsigned)wid * 1024u;
    const int aoff = lds_byte(wr * 64 + fr, fq * 8), boff = lds_byte(wc * 32 + fr, fq * 8);
#define PG8_SA(b, h) (((b) * 2 + (h)) * HTB)
#define PG8_SB(b, h) ((4 + (b) * 2 + (h)) * HTB)
#define PG8_STAGE(bufoff, gbase, voff) do { _Pragma("unroll") for (int _i = 0; _i < 2; ++_i) \
        __builtin_amdgcn_global_load_lds((const unsigned*)((const char*)(gbase) + (voff)[_i]), (PG8_LAS unsigned*)(lds + (bufoff) + ldsw + _i * 8192), 16, 0, 0); } while (0)
#define PG8_LDA(dst, b, h) do { _Pragma("unroll") for (int m = 0; m < 4; ++m) _Pragma("unroll") for (int k = 0; k < 2; ++k) dst[m][k] = *(const PG8_LAS bf16x8*)(lds + PG8_SA(b, h) + aoff + m * 2048 + k * 1024); } while (0)
#define PG8_LDB(dst, b, h) do { _Pragma("unroll") for (int n = 0; n < 2; ++n) _Pragma("unroll") for (int k = 0; k < 2; ++k) dst[n][k] = *(const PG8_LAS bf16x8*)(lds + PG8_SB(b, h) + boff + n * 2048 + k * 1024); } while (0)
#define PG8_MMA(ai, bj, At, Bt) do { __builtin_amdgcn_s_setprio(1); _Pragma("unroll") for (int m = 0; m < 4; ++m) _Pragma("unroll") for (int n = 0; n < 2; ++n) _Pragma("unroll") for (int k = 0; k < 2; ++k) \
        acc[ai][bj][m][n] = __builtin_amdgcn_mfma_f32_16x16x32_bf16(Bt[n][k], At[m][k], acc[ai][bj][m][n], 0, 0, 0); __builtin_amdgcn_s_setprio(0); } while (0)
#define PG8_WAIT_V(n) asm volatile("s_waitcnt vmcnt(" #n ")" ::: "memory")
#define PG8_WAIT_L(n) asm volatile("s_waitcnt lgkmcnt(" #n ")" ::: "memory")
#define PG8_BAR __builtin_amdgcn_s_barrier()
#define PG8_SCHED __builtin_amdgcn_sched_barrier(0)
    Unit cur, nxt; int ui = 0;
    if (!S.next(0, cur)) return;
    f32x4 acc[2][2][4][2];
#pragma unroll
    for (int a = 0; a < 2; ++a)
#pragma unroll
        for (int b = 0; b < 2; ++b)
#pragma unroll
            for (int m = 0; m < 4; ++m)
#pragma unroll
                for (int n = 0; n < 2; ++n) acc[a][b][m][n] = (f32x4){0.f, 0.f, 0.f, 0.f};
    bf16x8 At[4][2], B0[2][2], B1[2][2];
    const char* cA = (const char*)g.A + (size_t)cur.pm * tstep; const char* cB = (const char*)g.Bt + (size_t)cur.pn * tstep;
    S.a_ready(cur);
    PG8_STAGE(PG8_SB(0, 0), cB, voffB); PG8_STAGE(PG8_SA(0, 0), cA, voffA); PG8_STAGE(PG8_SB(0, 1), cB + hstep, voffB); PG8_STAGE(PG8_SA(0, 1), cA + hstep, voffA);
    if (wr == 1) PG8_BAR;
    PG8_WAIT_V(4); PG8_BAR;
    PG8_STAGE(PG8_SB(1, 0), cB + kstep, voffB); PG8_STAGE(PG8_SA(1, 0), cA + kstep, voffA); PG8_STAGE(PG8_SB(1, 1), cB + hstep + kstep, voffB);
    PG8_WAIT_V(6); PG8_BAR;
    PG8_STAMP();
    for (;;) {
        const bool has_next = S.next(ui + 1, nxt);
        const char* nA = has_next ? (const char*)g.A + (size_t)nxt.pm * tstep : cA; const char* nB = has_next ? (const char*)g.Bt + (size_t)nxt.pn * tstep : cB;
        for (int t = 0; t < nt; t += 2) {
            const bool last = (t == nt - 2);
            const char* a1 = cA + (size_t)(t + 1) * kstep;
            const char* a2 = last ? nA : cA + (size_t)(t + 2) * kstep; const char* b2 = last ? nB : cB + (size_t)(t + 2) * kstep;
            const char* a3 = a2 + kstep; const char* b3 = b2 + kstep;
            if (last && has_next) S.a_ready(nxt);
            PG8_LDB(B0, 0, 0); PG8_SCHED; PG8_LDA(At, 0, 0); PG8_STAGE(PG8_SA(1, 1), a1 + hstep, voffA);
            PG8_WAIT_L(8); PG8_BAR; PG8_WAIT_L(0); PG8_MMA(0, 0, At, B0); PG8_BAR; PG8_SCHED;
            PG8_LDB(B1, 0, 1); PG8_STAGE(PG8_SB(0, 0), b2, voffB);
            PG8_BAR; PG8_WAIT_L(0); PG8_MMA(0, 1, At, B1); PG8_BAR;
            PG8_LDA(At, 0, 1); PG8_STAGE(PG8_SA(0, 0), a2, voffA);
            PG8_BAR; PG8_WAIT_L(0); PG8_MMA(1, 0, At, B0); PG8_BAR; PG8_SCHED;
            PG8_STAGE(PG8_SB(0, 1), b2 + hstep, voffB);
            PG8_WAIT_V(6); PG8_BAR; PG8_MMA(1, 1, At, B1); PG8_BAR;
            PG8_LDB(B0, 1, 0); PG8_SCHED; PG8_LDA(At, 1, 0); PG8_STAGE(PG8_SA(0, 1), a2 + hstep, voffA);
            PG8_WAIT_L(8); PG8_BAR; PG8_WAIT_L(0); PG8_MMA(0, 0, At, B0); PG8_BAR; PG8_SCHED;
            PG8_LDB(B1, 1, 1); PG8_STAGE(PG8_SB(1, 0), b3, voffB);
            PG8_BAR; PG8_WAIT_L(0); PG8_MMA(0, 1, At, B1); PG8_BAR;
            PG8_LDA(At, 1, 1); PG8_STAGE(PG8_SA(1, 0), a3, voffA);
            PG8_BAR; PG8_WAIT_L(0); PG8_MMA(1, 0, At, B0); PG8_BAR; PG8_SCHED;
            PG8_STAGE(PG8_SB(1, 1), b3 + hstep, voffB);
            PG8_WAIT_V(6); PG8_BAR; PG8_MMA(1, 1, At, B1); PG8_BAR;
        }
        PG8_STAMP();
        if constexpr (!Epi::AFTER_DRAIN) { E(acc, cur, wr, wc, fr, fq); S.done(cur); }
        PG8_STAMP();
        if (!has_next) break;
#pragma unroll
        for (int a = 0; a < 2; ++a)
#pragma unroll
            for (int b = 0; b < 2; ++b)
#pragma unroll
                for (int m = 0; m < 4; ++m)
#pragma unroll
                    for (int n = 0; n < 2; ++n) acc[a][b][m][n] = (f32x4){0.f, 0.f, 0.f, 0.f};
        cur = nxt; cA = nA; cB = nB; ++ui;
    }
    PG8_WAIT_V(0);
    if (wr == 0) PG8_BAR;
    PG8_BAR;
    if constexpr (Epi::AFTER_DRAIN) { E.fused(acc, cur, wr, wc, fr, fq, lds, wid, lane); S.done(cur); }
    PG8_STAMP();
    if (STAMP && wid == 0) { stamps[lane] = lane < nts ? (((unsigned long long)(unsigned)ts_hi << 32) | (unsigned)ts_lo) : 0ull;
        if (lane == 62) stamps[62] = rt_entry; if (lane == 63) stamps[63] = (unsigned long long)wall_clock64(); }
#undef PG8_STAMP
#undef PG8_SA
#undef PG8_SB
#undef PG8_STAGE
#undef PG8_LDA
#undef PG8_LDB
#undef PG8_MMA
#undef PG8_WAIT_V
#undef PG8_WAIT_L
#undef PG8_BAR
#undef PG8_SCHED
}
}
#define LAS __attribute__((address_space(3)))
typedef unsigned short bf16_t;
typedef short bf16x8 __attribute__((ext_vector_type(8)));
typedef short bf16x4 __attribute__((ext_vector_type(4)));
typedef float f32x4 __attribute__((ext_vector_type(4)));
typedef unsigned u32x4 __attribute__((ext_vector_type(4)));
typedef unsigned u32x2 __attribute__((ext_vector_type(2)));
constexpr int DM = 1024, NBATCH = 8, SEQ = 4096, NTOK = NBATCH * SEQ, DEPTH = 2;
constexpr int INW = 3968, INWP = 4096, FFN = 2816, NMOD = 6;
constexpr int C_AQ = 0, C_AK = 384, C_AV = 768, C_RQ = 1152, C_RK = 1536, C_RV = 1920, C_RG = 2304, C_HQ = 2688, C_HZF = 2944, C_HZB = 3200, C_HI = 3456, C_HG = 3712;
constexpr float NORM_EPS = 1e-6f;
constexpr int NTHREADS = 512;
constexpr int LDS_BYTES = 135168;
constexpr size_t WS_CTL = 0, WS_MOD = 4096, WS_LB = WS_MOD + 393216, WS_HGA = WS_LB + 2048, WS_LSE = WS_HGA + 524288, WS_WIN = WS_LSE + 2359296,
    WS_WOUT = WS_WIN + 16777216, WS_WGU = WS_WOUT + 4194304, WS_WDN = WS_WGU + 23068672, WS_HBUF = WS_WDN + 11534336, WS_PROJ = WS_HBUF + 67108864,
    WS_OB = WS_PROJ + 260046848, WS_RST = WS_OB + 75497472, WS_HGU = WS_RST + 25165824, WS_END = WS_HGU + 33554432;

struct Params {
    const float *x, *c, *w_ada, *b_ada, *g_mix, *w_in, *ret_gn, *hgrn_gn, *lb_logits, *w_out, *g_ffn, *w_gu, *w_down, *g_final;
    float* out; unsigned char* ws; int ph_lo, ph_hi;
};

__device__ __forceinline__ float bf2f(bf16_t v) { return __uint_as_float(((unsigned)v) << 16); }
__device__ __forceinline__ float bflo(unsigned w) { return __uint_as_float(w << 16); }
__device__ __forceinline__ float bfhi(unsigned w) { return __uint_as_float(w & 0xffff0000u); }
__device__ __forceinline__ bf16_t f2bf(float f) { unsigned u = __float_as_uint(f); u += 0x7fffu + ((u >> 16) & 1u); return (bf16_t)(u >> 16); }
__device__ __forceinline__ unsigned pk2(float lo, float hi) { return (unsigned)f2bf(lo) | ((unsigned)f2bf(hi) << 16); }
__device__ __forceinline__ bf16x4 pk4(f32x4 v) { u32x2 w; w.x = pk2(v[0], v[1]); w.y = pk2(v[2], v[3]); return __builtin_bit_cast(bf16x4, w); }
__device__ __forceinline__ float siluf(float v) { return v / (1.0f + __expf(-v)); }
__device__ __forceinline__ float wave_sum(float v) {
#pragma unroll
    for (int o = 1; o < 64; o <<= 1) v += __shfl_xor(v, o);
    return v;
}
#define MFMA32(a, b, c) __builtin_amdgcn_mfma_f32_16x16x32_bf16((a), (b), (c), 0, 0, 0)
#define MFMA16(a, b, c) __builtin_amdgcn_mfma_f32_16x16x16bf16_1k((a), (b), (c), 0, 0, 0)

struct EpiProj {
    static constexpr bool PERM = true, AFTER_DRAIN = false;
    bf16_t* O;
    __device__ __forceinline__ void operator()(const f32x4 (&acc)[2][2][4][2], const pg8::Unit& u, int wr, int wc, int fr, int fq) const {
        const int row0 = u.pm * 256 + wr * 64 + fr, col0 = u.pn * 256 + wc * 32 + 8 * fq;
#pragma unroll
        for (int ai = 0; ai < 2; ++ai)
#pragma unroll
            for (int m = 0; m < 4; ++m) { bf16_t* rowp = O + (size_t)(row0 + ai * 128 + m * 16) * INW + col0;
#pragma unroll
                for (int bj = 0; bj < 2; ++bj) { if (col0 + bj * 128 < INW) { const f32x4 v0 = acc[ai][bj][m][0], v1 = acc[ai][bj][m][1];
                    u32x4 w; w.x = pk2(v0[0], v0[1]); w.y = pk2(v0[2], v0[3]); w.z = pk2(v1[0], v1[1]); w.w = pk2(v1[2], v1[3]);
                    *(u32x4*)(rowp + bj * 128) = w; } } }
    }
};
struct EpiRes {
    static constexpr bool PERM = false, AFTER_DRAIN = false;
    const float* base; float* out; const float* gate;
    __device__ __forceinline__ void operator()(const f32x4 (&acc)[2][2][4][2], const pg8::Unit& u, int wr, int wc, int fr, int fq) const {
        const int row0 = u.pm * 256 + wr * 64 + fr, col0 = u.pn * 256 + wc * 32 + 4 * fq;
        const float* gp = gate + (size_t)((u.pm * 256) >> 12) * (NMOD * DM) + col0;
        f32x4 gv[2][2];
#pragma unroll
        for (int bj = 0; bj < 2; ++bj)
#pragma unroll
            for (int n = 0; n < 2; ++n) gv[bj][n] = *(const f32x4*)(gp + bj * 128 + n * 16);
#pragma unroll
        for (int ai = 0; ai < 2; ++ai)
#pragma unroll
            for (int m = 0; m < 4; ++m) { const size_t off = (size_t)(row0 + ai * 128 + m * 16) * DM + col0;
#pragma unroll
                for (int bj = 0; bj < 2; ++bj)
#pragma unroll
                    for (int n = 0; n < 2; ++n) { const f32x4 bs = *(const f32x4*)(base + off + bj * 128 + n * 16);
                        *(f32x4*)(out + off + bj * 128 + n * 16) = bs + gv[bj][n] * acc[ai][bj][m][n]; } }
    }
};
struct EpiSwiglu {
    static constexpr bool PERM = true, AFTER_DRAIN = false;
    bf16_t* O;
    __device__ __forceinline__ void operator()(const f32x4 (&acc)[2][2][4][2], const pg8::Unit& u, int wr, int wc, int fr, int fq) const {
        const int row0 = u.pm * 256 + wr * 64 + fr, col0 = u.pn * 128 + wc * 32 + 8 * fq;
#pragma unroll
        for (int ai = 0; ai < 2; ++ai)
#pragma unroll
            for (int m = 0; m < 4; ++m) { bf16_t* rowp = O + (size_t)(row0 + ai * 128 + m * 16) * FFN + col0;
                float r[8];
#pragma unroll
                for (int n = 0; n < 2; ++n)
#pragma unroll
                    for (int i = 0; i < 4; ++i) { const float g = acc[ai][0][m][n][i], uu = acc[ai][1][m][n][i]; r[n * 4 + i] = siluf(g) * uu; }
                u32x4 w; w.x = pk2(r[0], r[1]); w.y = pk2(r[2], r[3]); w.z = pk2(r[4], r[5]); w.w = pk2(r[6], r[7]);
                *(u32x4*)rowp = w; }
    }
};
__device__ __forceinline__ void transpose_item(const float* W, int K, int N, bf16_t* WT, int dst_row0, int src_col0, int k0, LAS float* scr, int lane) {
    if (src_col0 < 0) {
        const int c = lane & 7;
#pragma unroll
        for (int j = 0; j < 4; ++j) { const int n = (lane >> 3) + 8 * j; *(u32x4*)(WT + (size_t)(dst_row0 + n) * K + k0 + 8 * c) = (u32x4){0u, 0u, 0u, 0u}; }
        return;
    }
#pragma unroll 8
    for (int i = 0; i < 32; ++i) { const int kk = 2 * i + (lane >> 5); scr[kk * 33 + (lane & 31)] = W[(size_t)(k0 + kk) * N + src_col0 + (lane & 31)]; }
    __builtin_amdgcn_fence(__ATOMIC_RELEASE, "wavefront"); __builtin_amdgcn_wave_barrier(); __builtin_amdgcn_fence(__ATOMIC_ACQUIRE, "wavefront");
    const int c = lane & 7;
#pragma unroll
    for (int j = 0; j < 4; ++j) { const int n = (lane >> 3) + 8 * j; const LAS float* s = scr + (8 * c) * 33 + n;
        u32x4 o; o.x = pk2(s[0 * 33], s[1 * 33]); o.y = pk2(s[2 * 33], s[3 * 33]); o.z = pk2(s[4 * 33], s[5 * 33]); o.w = pk2(s[6 * 33], s[7 * 33]);
        *(u32x4*)(WT + (size_t)(dst_row0 + n) * K + k0 + 8 * c) = o; }
    __builtin_amdgcn_fence(__ATOMIC_RELEASE, "wavefront"); __builtin_amdgcn_wave_barrier(); __builtin_amdgcn_fence(__ATOMIC_ACQUIRE, "wavefront");
}

__device__ __forceinline__ void phase_prologue(const Params& P, LAS unsigned char* lds) {
    const int tid = opaque_tid(), lane = tid & 63, wave = __builtin_amdgcn_readfirstlane(tid >> 6);
    unsigned char* ws = P.ws;
    {
        LAS float* scr = (LAS float*)(lds + wave * 8704);
        const int gw = blockIdx.x * 8 + wave, NGW = gridDim.x * 8;
        constexpr int I_IN = 16 * 128, I_OUT = 16 * 32, I_GU = 16 * 176, I_DN = 44 * 32, I_L = I_IN + I_OUT + I_GU + I_DN;
        for (int it = gw; it < DEPTH * I_L; it += NGW) {
            const int l = it / I_L; int r = it % I_L;
            if (r < I_IN) { const int kb = r / 128, nb = r % 128, n0 = nb * 32;
                transpose_item(P.w_in + (size_t)l * DM * INW, DM, INW, (bf16_t*)(ws + WS_WIN) + (size_t)l * INWP * DM, n0, n0 < INW ? n0 : -1, kb * 64, scr, lane); continue; }
            r -= I_IN;
            if (r < I_OUT) { const int kb = r / 32, nb = r % 32;
                transpose_item(P.w_out + (size_t)l * DM * DM, DM, DM, (bf16_t*)(ws + WS_WOUT) + (size_t)l * DM * DM, nb * 32, nb * 32, kb * 64, scr, lane); continue; }
            r -= I_OUT;
            if (r < I_GU) { const int kb = r / 176, nb = r % 176, n0 = nb * 32; const int pn = n0 >> 8, half = (n0 >> 7) & 1, jj = n0 & 127;
                transpose_item(P.w_gu + (size_t)l * DM * 2 * FFN, DM, 2 * FFN, (bf16_t*)(ws + WS_WGU) + (size_t)l * 2 * FFN * DM, n0, half * FFN + pn * 128 + jj, kb * 64, scr, lane); continue; }
            r -= I_GU;
            { const int kb = r / 32, nb = r % 32;
                transpose_item(P.w_down + (size_t)l * FFN * DM, FFN, DM, (bf16_t*)(ws + WS_WDN) + (size_t)l * DM * FFN, nb * 32, nb * 32, kb * 64, scr, lane); }
        }
    }
    __syncthreads();
    {
        LAS float* sc = (LAS float*)lds;
        LAS float* red = (LAS float*)(lds + 32768);
        for (int i = tid; i < NBATCH * DM; i += NTHREADS) sc[i] = siluf(P.c[i]);
        __syncthreads();
        float* mod = (float*)(ws + WS_MOD);
        for (int u = blockIdx.x; u < DEPTH * 96; u += gridDim.x) {
            const int l = u / 96, j0 = (u % 96) * 64, col = tid & 63, kp = tid >> 6;
            float acc[8];
#pragma unroll
            for (int b = 0; b < 8; ++b) acc[b] = 0.f;
            const float* wp = P.w_ada + (size_t)l * DM * (NMOD * DM) + j0 + col;
            for (int k = kp * 128; k < kp * 128 + 128; ++k) { const float w = wp[(size_t)k * (NMOD * DM)];
#pragma unroll
                for (int b = 0; b < 8; ++b) acc[b] += sc[b * DM + k] * w; }
#pragma unroll
            for (int b = 0; b < 8; ++b) red[(kp * 8 + b) * 64 + col] = acc[b];
            __syncthreads();
            { const int b = tid >> 6; float s = 0.f;
#pragma unroll
              for (int p = 0; p < 8; ++p) s += red[(p * 8 + b) * 64 + col];
              mod[((size_t)l * NBATCH + b) * (NMOD * DM) + j0 + col] = s + P.b_ada[(size_t)l * NMOD * DM + j0 + col]; }
            __syncthreads();
        }
    }
    if (blockIdx.x == 0 && tid < 256) {
        const float l0 = P.lb_logits[tid], l1 = P.lb_logits[256 + tid], m = fmaxf(l0, l1), e0 = __expf(l0 - m), e1 = __expf(l1 - m);
        const float p0 = e0 / (e0 + e1), p1 = e1 / (e0 + e1);
        float* lb = (float*)(ws + WS_LB);
        lb[tid] = fminf(fmaxf(p0 - p0, 0.f), 1.0f - 1e-6f);
        lb[256 + tid] = fminf(fmaxf((p0 + p1) - p0, 0.f), 1.0f - 1e-6f);
    }
}

__device__ __forceinline__ void phase_norm_mod(const float* src, const float* g, const float* shift, const float* scale, bf16_t* dst) {
    const int tid = opaque_tid(), lane = tid & 63, wave = tid >> 6;
    const int gw = blockIdx.x * 8 + wave, NGW = gridDim.x * 8;
    f32x4 gv[4];
#pragma unroll
    for (int j = 0; j < 4; ++j) gv[j] = *(const f32x4*)(g + 4 * lane + 256 * j);
    for (int row = gw; row < NTOK; row += NGW) {
        const int b = row >> 12;
        const f32x4* xr = (const f32x4*)(src + (size_t)row * DM) + lane;
        f32x4 v[4]; float s = 0.f;
#pragma unroll
        for (int j = 0; j < 4; ++j) { v[j] = xr[64 * j]; s += (v[j][0] * v[j][0] + v[j][1] * v[j][1]) + (v[j][2] * v[j][2] + v[j][3] * v[j][3]); }
        const float rstd = rsqrtf(wave_sum(s) * (1.0f / DM) + NORM_EPS);
        unsigned long long* o8 = (unsigned long long*)(dst + (size_t)row * DM) + lane;
#pragma unroll
        for (int j = 0; j < 4; ++j) {
            const f32x4 sc = *(const f32x4*)(scale + (size_t)b * (NMOD * DM) + 4 * lane + 256 * j), sh = *(const f32x4*)(shift + (size_t)b * (NMOD * DM) + 4 * lane + 256 * j);
            const f32x4 h = v[j] * rstd * gv[j] * (sc + 1.0f) + sh;
            o8[64 * j] = (unsigned long long)pk2(h[0], h[1]) | ((unsigned long long)pk2(h[2], h[3]) << 32);
        }
    }
}
__device__ __forceinline__ void phase_norm_final(float* x, const float* g) {
    const int tid = opaque_tid(), lane = tid & 63, wave = tid >> 6;
    const int gw = blockIdx.x * 8 + wave, NGW = gridDim.x * 8;
    f32x4 gv[4];
#pragma unroll
    for (int j = 0; j < 4; ++j) gv[j] = *(const f32x4*)(g + 4 * lane + 256 * j);
    for (int row = gw; row < NTOK; row += NGW) {
        f32x4* xr = (f32x4*)(x + (size_t)row * DM) + lane;
        f32x4 v[4]; float s = 0.f;
#pragma unroll
        for (int j = 0; j < 4; ++j) { v[j] = xr[64 * j]; s += (v[j][0] * v[j][0] + v[j][1] * v[j][1]) + (v[j][2] * v[j][2] + v[j][3] * v[j][3]); }
        const float rstd = rsqrtf(wave_sum(s) * (1.0f / DM) + NORM_EPS);
#pragma unroll
        for (int j = 0; j < 4; ++j) xr[64 * j] = v[j] * rstd * gv[j];
    }
}
__device__ __forceinline__ void att_unit(const Params& P, LAS unsigned char* lds, int u) {
    const int tid = opaque_tid(), lane = tid & 63, wave = __builtin_amdgcn_readfirstlane(tid >> 6), q = lane & 15, g = lane >> 4;
    const int br = u / 1536, v = u % 1536, b = v / 192, h = (v >> 5) % 6, w = v & 31;
    const int lr = br * 2, r = 1 << lr, nblk = 32 >> lr, rho = w / nblk, blk = w % nblk, L = SEQ >> lr, p0 = blk * 128;
    const int tok0 = b * SEQ + rho;
    const bf16_t* proj = (const bf16_t*)(P.ws + WS_PROJ);
    LAS bf16_t* Ks = (LAS bf16_t*)lds;
    LAS bf16_t* Vt = (LAS bf16_t*)(lds + 36864);
    {
        const int key = tid >> 1, half = tid & 1, kj = p0 - 64 + key;
        u32x4 kv[4], vv[4];
        if (kj >= 0 && kj < L) {
            const bf16_t* src = proj + (size_t)(tok0 + r * kj) * INW + h * 64 + half * 32;
#pragma unroll
            for (int i = 0; i < 4; ++i) { kv[i] = *(const u32x4*)(src + C_AK + 8 * i); vv[i] = *(const u32x4*)(src + C_AV + 8 * i); }
        } else {
#pragma unroll
            for (int i = 0; i < 4; ++i) { kv[i] = (u32x4){0u, 0u, 0u, 0u}; vv[i] = (u32x4){0u, 0u, 0u, 0u}; }
        }
#pragma unroll
        for (int i = 0; i < 4; ++i) *(LAS u32x4*)(Ks + key * 72 + half * 32 + 8 * i) = kv[i];
#pragma unroll
        for (int i = 0; i < 4; ++i)
#pragma unroll
            for (int e = 0; e < 4; ++e) { const unsigned wv = vv[i][e]; const int d = half * 32 + 8 * i + 2 * e;
                Vt[d * 264 + key] = (bf16_t)(wv & 0xffffu); Vt[(d + 1) * 264 + key] = (bf16_t)(wv >> 16); }
    }
    __syncthreads();
    const int p = p0 + 16 * wave + q; const size_t tokq = (size_t)(tok0 + r * p);
    bf16x8 qf[2];
#pragma unroll
    for (int kk = 0; kk < 2; ++kk) qf[kk] = *(const bf16x8*)(proj + tokq * INW + C_AQ + h * 64 + kk * 32 + 8 * g);
    const float slope_r = exp2f(-8.0f * (float)(h + 1) / 6.0f) * (float)r;
    f32x4 st[9]; float mx = -3.0e38f;
#pragma unroll
    for (int t = 0; t < 9; ++t) {
        f32x4 acc = {0.f, 0.f, 0.f, 0.f};
#pragma unroll
        for (int kk = 0; kk < 2; ++kk) { const bf16x8 a = *(const LAS bf16x8*)(Ks + (16 * wave + 16 * t + q) * 72 + kk * 32 + 8 * g); acc = MFMA32(a, qf[kk], acc); }
#pragma unroll
        for (int j = 0; j < 4; ++j) {
            const int kl = 16 * wave + 16 * t + 4 * g + j, kj = p0 - 64 + kl; int dist = p - kj; dist = dist < 0 ? -dist : dist;
            const bool valid = (kj >= 0) && (kj < L) && (dist <= 64);
            const float s = valid ? acc[j] * 0.125f - slope_r * (float)dist : -1.0e30f;
            acc[j] = s; mx = fmaxf(mx, s);
        }
        st[t] = acc;
    }
    mx = fmaxf(mx, __shfl_xor(mx, 16)); mx = fmaxf(mx, __shfl_xor(mx, 32));
    float ls = 0.f; bf16x4 pt[9];
#pragma unroll
    for (int t = 0; t < 9; ++t) { f32x4 e;
#pragma unroll
        for (int j = 0; j < 4; ++j) { e[j] = (st[t][j] > -1.0e29f) ? __expf(st[t][j] - mx) : 0.f; ls += e[j]; }
        pt[t] = pk4(e); }
    ls += __shfl_xor(ls, 16); ls += __shfl_xor(ls, 32);
    const float inv = 1.0f / ls;
    bf16_t* ob = (bf16_t*)(P.ws + WS_OB) + ((size_t)br * NTOK + tokq) * 384 + h * 64;
#pragma unroll
    for (int dt = 0; dt < 4; ++dt) {
        f32x4 acc = {0.f, 0.f, 0.f, 0.f};
#pragma unroll
        for (int t = 0; t < 9; ++t) { const bf16x4 a = *(const LAS bf16x4*)(Vt + (dt * 16 + q) * 264 + 16 * wave + 16 * t + 4 * g); acc = MFMA16(a, pt[t], acc); }
        acc = acc * inv;
        *(bf16x4*)(ob + dt * 16 + 4 * g) = pk4(acc);
    }
    if (g == 0) ((float*)(P.ws + WS_LSE))[((size_t)br * NTOK + tokq) * 6 + h] = mx + __logf(ls);
    __syncthreads();
}
__device__ __forceinline__ void att_merge(const Params& P) {
    const bf16_t* ob = (const bf16_t*)(P.ws + WS_OB); const float* lse = (const float*)(P.ws + WS_LSE); bf16_t* mixed = (bf16_t*)(P.ws + WS_HBUF);
    for (size_t it = (size_t)blockIdx.x * NTHREADS + opaque_tid(); it < (size_t)NTOK * 48; it += (size_t)gridDim.x * NTHREADS) {
        const size_t tok = it / 48; const int grp = (int)(it % 48), h = grp >> 3;
        const float l0 = lse[tok * 6 + h], l1 = lse[((size_t)NTOK + tok) * 6 + h], l2 = lse[((size_t)2 * NTOK + tok) * 6 + h];
        const float m = fmaxf(l0, fmaxf(l1, l2)), e0 = __expf(l0 - m), e1 = __expf(l1 - m), e2 = __expf(l2 - m), is = 1.0f / (e0 + e1 + e2);
        const float w0 = e0 * is, w1 = e1 * is, w2 = e2 * is;
        const u32x4 a = *(const u32x4*)(ob + tok * 384 + grp * 8), bq = *(const u32x4*)(ob + ((size_t)NTOK + tok) * 384 + grp * 8), cq = *(const u32x4*)(ob + ((size_t)2 * NTOK + tok) * 384 + grp * 8);
        u32x4 o;
#pragma unroll
        for (int i = 0; i < 4; ++i) o[i] = pk2(w0 * bflo(a[i]) + w1 * bflo(bq[i]) + w2 * bflo(cq[i]), w0 * bfhi(a[i]) + w1 * bfhi(bq[i]) + w2 * bfhi(cq[i]));
        *(u32x4*)(mixed + tok * DM + grp * 8) = o;
    }
}

__device__ __forceinline__ float ret_logg(int h) { return log1pf(-exp2f(-5.0f - (float)h)); }
__device__ __forceinline__ void retA_unit(const Params& P, LAS unsigned char* lds, int u) {
    const int tid = opaque_tid(), lane = tid & 63, wave = __builtin_amdgcn_readfirstlane(tid >> 6), q = lane & 15, g = lane >> 4;
    const int bh = u >> 5, n = u & 31, b = bh / 6, h = bh % 6;
    const bf16_t* proj = (const bf16_t*)(P.ws + WS_PROJ);
    LAS bf16_t* Kft = (LAS bf16_t*)lds; LAS bf16_t* Kbt = (LAS bf16_t*)(lds + 17408); LAS bf16_t* Vt = (LAS bf16_t*)(lds + 34816);
    const float lg = ret_logg(h);
    {
        const int c = tid >> 2, qd = tid & 3; const bf16_t* src = proj + (size_t)(b * SEQ + n * 128 + c) * INW + h * 64 + qd * 16;
        const u32x4 k0 = *(const u32x4*)(src + C_RK), k1 = *(const u32x4*)(src + C_RK + 8), v0 = *(const u32x4*)(src + C_RV), v1 = *(const u32x4*)(src + C_RV + 8);
        const float wf = 0.125f * __expf(lg * (float)(127 - c)), wb = 0.125f * __expf(lg * (float)c);
#pragma unroll
        for (int e = 0; e < 8; ++e) { const unsigned kw = e < 4 ? k0[e & 3] : k1[e & 3], vw = e < 4 ? v0[e & 3] : v1[e & 3]; const int d = qd * 16 + 2 * e;
            const float ka = bflo(kw), kb = bfhi(kw);
            Kft[d * 136 + c] = f2bf(ka * wf); Kft[(d + 1) * 136 + c] = f2bf(kb * wf);
            Kbt[d * 136 + c] = f2bf(ka * wb); Kbt[(d + 1) * 136 + c] = f2bf(kb * wb);
            Vt[d * 136 + c] = (bf16_t)(vw & 0xffffu); Vt[(d + 1) * 136 + c] = (bf16_t)(vw >> 16); }
    }
    __syncthreads();
    const int dir = wave >> 2, dt = wave & 3; const LAS bf16_t* Kt = dir ? Kbt : Kft;
    bf16x8 afr[4];
#pragma unroll
    for (int kk = 0; kk < 4; ++kk) afr[kk] = *(const LAS bf16x8*)(Kt + (dt * 16 + q) * 136 + kk * 32 + 8 * g);
    bf16_t* dst = (bf16_t*)(P.ws + WS_RST) + ((size_t)(bh * 32 + n) * 2 + dir) * 4096;
#pragma unroll
    for (int et = 0; et < 4; ++et) {
        f32x4 acc = {0.f, 0.f, 0.f, 0.f};
#pragma unroll
        for (int kk = 0; kk < 4; ++kk) { const bf16x8 bfr = *(const LAS bf16x8*)(Vt + (et * 16 + q) * 136 + kk * 32 + 8 * g); acc = MFMA32(afr[kk], bfr, acc); }
        *(bf16x4*)(dst + (et * 16 + q) * 64 + dt * 16 + 4 * g) = pk4(acc);
    }
    __syncthreads();
}
__device__ __forceinline__ void ret_scan(const Params& P) {
    bf16_t* st = (bf16_t*)(P.ws + WS_RST);
    for (int it = blockIdx.x * NTHREADS + opaque_tid(); it < 48 * 2 * 512; it += gridDim.x * NTHREADS) {
        const int ch = it & 511, dir = (it >> 9) & 1, bh = it >> 10, h = bh % 6;
        const float cd = __expf(ret_logg(h) * 128.0f);
        float s[8];
#pragma unroll
        for (int e = 0; e < 8; ++e) s[e] = 0.f;
        for (int i0 = 0; i0 < 32; i0 += 8) {
            u32x4 v[8];
#pragma unroll
            for (int i = 0; i < 8; ++i) { const int n = dir ? 31 - (i0 + i) : (i0 + i); v[i] = *(const u32x4*)(st + ((size_t)(bh * 32 + n) * 2 + dir) * 4096 + 8 * ch); }
#pragma unroll
            for (int i = 0; i < 8; ++i) { const int n = dir ? 31 - (i0 + i) : (i0 + i);
                u32x4 o;
#pragma unroll
                for (int e = 0; e < 4; ++e) o[e] = pk2(s[2 * e], s[2 * e + 1]);
                *(u32x4*)(st + ((size_t)(bh * 32 + n) * 2 + dir) * 4096 + 8 * ch) = o;
#pragma unroll
                for (int e = 0; e < 4; ++e) { s[2 * e] = cd * s[2 * e] + bflo(v[i][e]); s[2 * e + 1] = cd * s[2 * e + 1] + bfhi(v[i][e]); } }
        }
    }
}
__device__ __forceinline__ void retB_unit(const Params& P, LAS unsigned char* lds, int u, int layer) {
    const int tid = opaque_tid(), lane = tid & 63, wave = __builtin_amdgcn_readfirstlane(tid >> 6), q = lane & 15, g = lane >> 4;
    const int bh = u >> 5, n = u & 31, b = bh / 6, h = bh % 6;
    const bf16_t* proj = (const bf16_t*)(P.ws + WS_PROJ);
    LAS bf16_t* Ks = (LAS bf16_t*)lds;
    LAS bf16_t* Vt = (LAS bf16_t*)(lds + 18432);
    LAS bf16_t* Rf = (LAS bf16_t*)(lds + 35840);
    LAS bf16_t* Rb = (LAS bf16_t*)(lds + 45056);
    const float lg = ret_logg(h);
    {
        const int c = tid >> 2, qd = tid & 3; const bf16_t* src = proj + (size_t)(b * SEQ + n * 128 + c) * INW + h * 64 + qd * 16;
        const u32x4 k0 = *(const u32x4*)(src + C_RK), k1 = *(const u32x4*)(src + C_RK + 8), v0 = *(const u32x4*)(src + C_RV), v1 = *(const u32x4*)(src + C_RV + 8);
        *(LAS u32x4*)(Ks + c * 72 + qd * 16) = k0; *(LAS u32x4*)(Ks + c * 72 + qd * 16 + 8) = k1;
#pragma unroll
        for (int e = 0; e < 8; ++e) { const unsigned vw = e < 4 ? v0[e & 3] : v1[e & 3]; const int d = qd * 16 + 2 * e;
            Vt[d * 136 + c] = (bf16_t)(vw & 0xffffu); Vt[(d + 1) * 136 + c] = (bf16_t)(vw >> 16); }
        const bf16_t* rs = (const bf16_t*)(P.ws + WS_RST) + (size_t)(bh * 32 + n) * 2 * 4096;
        const int e = tid >> 3, d8 = (tid & 7) * 8;
        *(LAS u32x4*)(Rf + e * 72 + d8) = *(const u32x4*)(rs + e * 64 + d8);
        *(LAS u32x4*)(Rb + e * 72 + d8) = *(const u32x4*)(rs + 4096 + e * 64 + d8);
    }
    __syncthreads();
    const int i = 16 * wave + q; const size_t tok = (size_t)(b * SEQ + n * 128 + i);
    bf16x8 qf[2], qff[2], qfb[2];
    {
        const float ff = __expf(lg * (float)(i + 1)), fb = __expf(lg * (float)(128 - i));
#pragma unroll
        for (int kk = 0; kk < 2; ++kk) { const u32x4 raw = *(const u32x4*)(proj + tok * INW + C_RQ + h * 64 + kk * 32 + 8 * g);
            qf[kk] = __builtin_bit_cast(bf16x8, raw); u32x4 a, c2;
#pragma unroll
            for (int e = 0; e < 4; ++e) { const float lo = bflo(raw[e]), hi = bfhi(raw[e]); a[e] = pk2(lo * ff, hi * ff); c2[e] = pk2(lo * fb, hi * fb); }
            qff[kk] = __builtin_bit_cast(bf16x8, a); qfb[kk] = __builtin_bit_cast(bf16x8, c2); }
    }
    bf16x4 pt[8];
#pragma unroll
    for (int jt = 0; jt < 8; ++jt) {
        f32x4 acc = {0.f, 0.f, 0.f, 0.f};
#pragma unroll
        for (int kk = 0; kk < 2; ++kk) { const bf16x8 a = *(const LAS bf16x8*)(Ks + (16 * jt + q) * 72 + kk * 32 + 8 * g); acc = MFMA32(a, qf[kk], acc); }
#pragma unroll
        for (int jj = 0; jj < 4; ++jj) { int dd = i - (16 * jt + 4 * g + jj); dd = dd < 0 ? -dd : dd; acc[jj] = acc[jj] * 0.125f * __expf(lg * (float)dd); }
        pt[jt] = pk4(acc);
    }
    f32x4 o[4];
#pragma unroll
    for (int et = 0; et < 4; ++et) {
        f32x4 acc = {0.f, 0.f, 0.f, 0.f};
#pragma unroll
        for (int jt = 0; jt < 8; ++jt) { const bf16x4 a = *(const LAS bf16x4*)(Vt + (et * 16 + q) * 136 + 16 * jt + 4 * g); acc = MFMA16(a, pt[jt], acc); }
#pragma unroll
        for (int kk = 0; kk < 2; ++kk) { const bf16x8 a = *(const LAS bf16x8*)(Rf + (et * 16 + q) * 72 + kk * 32 + 8 * g); acc = MFMA32(a, qff[kk], acc);
            const bf16x8 a2 = *(const LAS bf16x8*)(Rb + (et * 16 + q) * 72 + kk * 32 + 8 * g); acc = MFMA32(a2, qfb[kk], acc); }
        o[et] = acc;
    }
    float s = 0.f;
#pragma unroll
    for (int et = 0; et < 4; ++et) s += (o[et][0] + o[et][1]) + (o[et][2] + o[et][3]);
    s += __shfl_xor(s, 16); s += __shfl_xor(s, 32);
    const float mu = s * (1.0f / 64.0f); float vs = 0.f;
#pragma unroll
    for (int et = 0; et < 4; ++et) { o[et] = o[et] - mu; vs += (o[et][0] * o[et][0] + o[et][1] * o[et][1]) + (o[et][2] * o[et][2] + o[et][3] * o[et][3]); }
    vs += __shfl_xor(vs, 16); vs += __shfl_xor(vs, 32);
    const float rstd = rsqrtf(vs * (1.0f / 64.0f) + NORM_EPS);
    bf16_t* mixed = (bf16_t*)(P.ws + WS_HBUF) + tok * DM + 384 + h * 64;
#pragma unroll
    for (int et = 0; et < 4; ++et) {
        const f32x4 gn = *(const f32x4*)(P.ret_gn + layer * 384 + h * 64 + et * 16 + 4 * g);
        const u32x2 rg = *(const u32x2*)(proj + tok * INW + C_RG + h * 64 + et * 16 + 4 * g);
        f32x4 y; y[0] = o[et][0] * rstd * gn[0] * siluf(bflo(rg.x)); y[1] = o[et][1] * rstd * gn[1] * siluf(bfhi(rg.x));
        y[2] = o[et][2] * rstd * gn[2] * siluf(bflo(rg.y)); y[3] = o[et][3] * rstd * gn[3] * siluf(bfhi(rg.y));
        *(bf16x4*)(mixed + et * 16 + 4 * g) = pk4(y);
    }
    __syncthreads();
}
__device__ __forceinline__ void hgrn_gate(float z, float lbv, float& lf, float& kk) {
    const float ez = __expf(-z), sg = 1.0f / (1.0f + ez), sgn = 1.0f / (1.0f + __expf(z));
    const float f = lbv + (1.0f - lbv) * sg;
    lf = __logf(fmaxf(f, 1.0e-30f)); kk = (1.0f - lbv) * sgn;
}
__device__ __forceinline__ void hgA_unit(const Params& P, LAS unsigned char* lds, int u, int layer) {
    const int tid = opaque_tid(), lane = tid & 63, wave = __builtin_amdgcn_readfirstlane(tid >> 6), q = lane & 15, g = lane >> 4;
    const int bh = u >> 5, n = u & 31, b = bh >> 2, h = bh & 3;
    const bf16_t* proj = (const bf16_t*)(P.ws + WS_PROJ);
    LAS bf16_t* Kt = (LAS bf16_t*)lds;
    LAS bf16_t* Vt = (LAS bf16_t*)(lds + 34816);
    LAS float* segs = (LAS float*)(lds + 52224);
    const size_t tokc = (size_t)(b * SEQ + n * 128);
    {
        const int c = tid >> 2, qd = tid & 3; const bf16_t* src = proj + (tokc + c) * INW + C_HI + h * 64 + qd * 16;
        const u32x4 v0 = *(const u32x4*)src, v1 = *(const u32x4*)(src + 8);
#pragma unroll
        for (int e = 0; e < 8; ++e) { const unsigned vw = e < 4 ? v0[e & 3] : v1[e & 3]; const int d = qd * 16 + 2 * e;
            Vt[d * 136 + c] = (bf16_t)(vw & 0xffffu); Vt[(d + 1) * 136 + c] = (bf16_t)(vw >> 16); }
    }
    const int d = tid & 63, dir = (tid >> 6) & 1, seg = tid >> 7;
    const float lbv = ((const float*)(P.ws + WS_LB))[layer * 256 + h * 64 + d];
    float lf[32], kk[32];
    {
        const bf16_t* zp = proj + (tokc + seg * 32) * INW + (dir ? C_HZB : C_HZF) + h * 64 + d;
        bf16_t zr[32];
#pragma unroll
        for (int i = 0; i < 32; ++i) zr[i] = zp[(size_t)i * INW];
#pragma unroll
        for (int i = 0; i < 32; ++i) hgrn_gate(bf2f(zr[i]), lbv, lf[i], kk[i]);
    }
    float ssum = 0.f;
#pragma unroll
    for (int i = 0; i < 32; ++i) ssum += lf[i];
    segs[(dir * 4 + seg) * 64 + d] = ssum;
    __syncthreads();
    {
        float before = 0.f, after = 0.f;
#pragma unroll
        for (int s2 = 0; s2 < 4; ++s2) { const float v = segs[(dir * 4 + s2) * 64 + d]; if (s2 < seg) before += v; if (s2 > seg) after += v; }
        LAS bf16_t* kt = Kt + dir * (64 * 136) + d * 136 + seg * 32;
        if (dir == 0) {
            float run = after;
#pragma unroll
            for (int i = 31; i >= 0; --i) { kt[i] = f2bf(kk[i] * __expf(run)); run += lf[i]; }
        } else {
            float run = before;
#pragma unroll
            for (int i = 0; i < 32; ++i) { kt[i] = f2bf(kk[i] * __expf(run)); run += lf[i]; }
        }
        if (seg == 0) ((float*)(P.ws + WS_HGA))[((size_t)(bh * 2 + dir) * 32 + n) * 64 + d] = __expf(ssum + after);
    }
    __syncthreads();
    {
        const int wdir = wave >> 2, dt = wave & 3; const LAS bf16_t* kts = Kt + wdir * (64 * 136);
        bf16x8 afr[4];
#pragma unroll
        for (int kq = 0; kq < 4; ++kq) afr[kq] = *(const LAS bf16x8*)(kts + (dt * 16 + q) * 136 + kq * 32 + 8 * g);
        float* dst = (float*)(P.ws + WS_HGU) + ((size_t)(bh * 2 + wdir) * 32 + n) * 4096;
#pragma unroll
        for (int et = 0; et < 4; ++et) {
            f32x4 acc = {0.f, 0.f, 0.f, 0.f};
#pragma unroll
            for (int kq = 0; kq < 4; ++kq) { const bf16x8 bfr = *(const LAS bf16x8*)(Vt + (et * 16 + q) * 136 + kq * 32 + 8 * g); acc = MFMA32(afr[kq], bfr, acc); }
#pragma unroll
            for (int j = 0; j < 4; ++j) dst[(dt * 16 + 4 * g + j) * 64 + et * 16 + q] = acc[j];
        }
    }
    __syncthreads();
}
__device__ __forceinline__ void hg_scan(const Params& P) {
    float* U = (float*)(P.ws + WS_HGU); const float* A = (const float*)(P.ws + WS_HGA);
    for (int it = blockIdx.x * NTHREADS + opaque_tid(); it < 64 * 64 * 16; it += gridDim.x * NTHREADS) {
        const int e4 = it & 15, d = (it >> 4) & 63, bd = it >> 10, dir = bd & 1;
        f32x4 s = {0.f, 0.f, 0.f, 0.f};
        for (int i0 = 0; i0 < 32; i0 += 8) {
            f32x4 v[8]; float a[8];
#pragma unroll
            for (int i = 0; i < 8; ++i) { const int n = dir ? 31 - (i0 + i) : (i0 + i); v[i] = *(const f32x4*)(U + ((size_t)(bd * 32 + n) * 64 + d) * 64 + 4 * e4); a[i] = A[(size_t)(bd * 32 + n) * 64 + d]; }
#pragma unroll
            for (int i = 0; i < 8; ++i) { const int n = dir ? 31 - (i0 + i) : (i0 + i); *(f32x4*)(U + ((size_t)(bd * 32 + n) * 64 + d) * 64 + 4 * e4) = s; s = s * a[i] + v[i]; }
        }
    }
}
__device__ __forceinline__ void hgB_unit(const Params& P, LAS unsigned char* lds, int u, int layer) {
    const int tid = opaque_tid(), lane = tid & 63, wave = __builtin_amdgcn_readfirstlane(tid >> 6), q = lane & 15, g = lane >> 4;
    const int b = u >> 5, n = u & 31;
    const bf16_t* proj = (const bf16_t*)(P.ws + WS_PROJ);
    LAS bf16_t* Qi = (LAS bf16_t*)lds;
    LAS bf16_t* Ki = (LAS bf16_t*)(lds + 36864);
    LAS float* Al = (LAS float*)(lds + 73728);
    LAS bf16_t* Vt = (LAS bf16_t*)(lds + 77824);
    LAS float* obuf = (LAS float*)(lds + 95232);
    LAS float* ssq = (LAS float*)(lds + 130048);
    const size_t tokc = (size_t)(b * SEQ + n * 128);
    bf16_t* mixed = (bf16_t*)(P.ws + WS_HBUF);
    if (tid < 128) ssq[tid] = 0.f;
    for (int h = 0; h < 4; ++h) {
        const int bh = b * 4 + h;
        {
            const int c = tid >> 2, qd = tid & 3; const bf16_t* src = proj + (tokc + c) * INW + C_HI + h * 64 + qd * 16;
            const u32x4 v0 = *(const u32x4*)src, v1 = *(const u32x4*)(src + 8);
#pragma unroll
            for (int e = 0; e < 8; ++e) { const unsigned vw = e < 4 ? v0[e & 3] : v1[e & 3]; const int d = qd * 16 + 2 * e;
                Vt[d * 136 + c] = (bf16_t)(vw & 0xffffu); Vt[(d + 1) * 136 + c] = (bf16_t)(vw >> 16); }
        }
        {
            const int d = tid & 63, sc = tid >> 6;
            const float lbv = ((const float*)(P.ws + WS_LB))[layer * 256 + h * 64 + d];
            const bf16_t* base = proj + (tokc + sc * 16) * INW + h * 64 + d;
            bf16_t qr[16], zf[16], zb[16];
#pragma unroll
            for (int i = 0; i < 16; ++i) { qr[i] = base[(size_t)i * INW + C_HQ]; zf[i] = base[(size_t)i * INW + C_HZF]; zb[i] = base[(size_t)i * INW + C_HZB]; }
            float bs = 0.f;
#pragma unroll
            for (int i = 0; i < 16; ++i) { float lf, kk; hgrn_gate(bf2f(zf[i]), lbv, lf, kk); bs += lf; const float qv = siluf(bf2f(qr[i]));
                Qi[(sc * 16 + i) * 72 + d] = f2bf(qv * __expf(bs)); Ki[(sc * 16 + i) * 72 + d] = f2bf(kk * __expf(fminf(-bs, 80.f))); }
            Al[sc * 64 + d] = __expf(bs);
            bs = 0.f;
#pragma unroll
            for (int i = 15; i >= 0; --i) { float lf, kk; hgrn_gate(bf2f(zb[i]), lbv, lf, kk); bs += lf; const float qv = siluf(bf2f(qr[i]));
                Qi[128 * 72 + (sc * 16 + i) * 72 + d] = f2bf(qv * __expf(bs)); Ki[128 * 72 + (sc * 16 + i) * 72 + d] = f2bf(kk * __expf(fminf(-bs, 80.f))); }
            Al[512 + sc * 64 + d] = __expf(bs);
        }
        __syncthreads();
        const int dir = wave >> 2, et = wave & 3;
        const LAS bf16_t* Qd = Qi + dir * (128 * 72); const LAS bf16_t* Kd = Ki + dir * (128 * 72); const LAS float* Ald = Al + dir * 512;
        f32x4 S[4];
        {
            const float* sp = (const float*)(P.ws + WS_HGU) + ((size_t)(bh * 2 + dir) * 32 + n) * 4096;
#pragma unroll
            for (int dt = 0; dt < 4; ++dt)
#pragma unroll
                for (int j = 0; j < 4; ++j) S[dt][j] = sp[(dt * 16 + 4 * g + j) * 64 + et * 16 + q];
        }
        f32x4 outv[8];
#pragma unroll
        for (int i = 0; i < 8; ++i) {
            const int sc = dir ? 7 - i : i;
            f32x4 o = {0.f, 0.f, 0.f, 0.f};
#pragma unroll
            for (int dt = 0; dt < 4; ++dt) { const bf16x4 a4 = pk4(S[dt]); const bf16x4 b4 = *(const LAS bf16x4*)(Qd + (sc * 16 + q) * 72 + dt * 16 + 4 * g); o = MFMA16(a4, b4, o); }
            f32x4 at = {0.f, 0.f, 0.f, 0.f};
#pragma unroll
            for (int kq = 0; kq < 2; ++kq) { const bf16x8 a8 = *(const LAS bf16x8*)(Kd + (sc * 16 + q) * 72 + kq * 32 + 8 * g), b8 = *(const LAS bf16x8*)(Qd + (sc * 16 + q) * 72 + kq * 32 + 8 * g); at = MFMA32(a8, b8, at); }
#pragma unroll
            for (int j = 0; j < 4; ++j) { const int sl = 4 * g + j; const bool keep = dir ? (sl >= q) : (sl <= q); at[j] = keep ? at[j] : 0.f; }
            const bf16x4 p4 = pk4(at);
            const bf16x4 v4 = *(const LAS bf16x4*)(Vt + (et * 16 + q) * 136 + sc * 16 + 4 * g);
            o = MFMA16(v4, p4, o);
            outv[i] = o;
#pragma unroll
            for (int dt = 0; dt < 4; ++dt) {
                u32x2 kw; const LAS bf16_t* kp = Kd + (sc * 16 + 4 * g) * 72 + dt * 16 + q;
                kw.x = (unsigned)kp[0] | ((unsigned)kp[72] << 16); kw.y = (unsigned)kp[144] | ((unsigned)kp[216] << 16);
                f32x4 s2 = MFMA16(__builtin_bit_cast(bf16x4, kw), v4, S[dt]);
                const f32x4 al = *(const LAS f32x4*)(Ald + sc * 64 + dt * 16 + 4 * g);
                S[dt] = s2 * al;
            }
        }
        if (dir == 1) {
#pragma unroll
            for (int i = 0; i < 8; ++i) *(LAS f32x4*)(obuf + ((7 - i) * 16 + q) * 68 + et * 16 + 4 * g) = outv[i];
        }
        __syncthreads();
        if (dir == 0) {
#pragma unroll
            for (int i = 0; i < 8; ++i) {
                const int tau = i * 16 + q; const f32x4 ob = *(const LAS f32x4*)(obuf + tau * 68 + et * 16 + 4 * g); const f32x4 t = outv[i] + ob;
                float sq = (t[0] * t[0] + t[1] * t[1]) + (t[2] * t[2] + t[3] * t[3]);
                sq += __shfl_xor(sq, 16); sq += __shfl_xor(sq, 32);
                if (g == 0) atomicAdd((float*)(ssq + tau), sq);
                *(bf16x4*)(mixed + (tokc + tau) * DM + 768 + h * 64 + et * 16 + 4 * g) = pk4(t);
            }
        }
        __syncthreads();
    }
    __threadfence();
    __syncthreads();
    {
        const int tau = tid >> 2, qd = tid & 3;
        const float rstd = rsqrtf(ssq[tau] * (1.0f / 256.0f) + NORM_EPS);
        bf16_t* mp = mixed + (tokc + tau) * DM + 768 + qd * 64; const bf16_t* gp = proj + (tokc + tau) * INW + C_HG + qd * 64; const float* gn = P.hgrn_gn + layer * 256 + qd * 64;
#pragma unroll
        for (int c8 = 0; c8 < 8; ++c8) {
            const u32x4 ov = *(const u32x4*)(mp + c8 * 8), gv = *(const u32x4*)(gp + c8 * 8); const f32x4 g0 = *(const f32x4*)(gn + c8 * 8), g1 = *(const f32x4*)(gn + c8 * 8 + 4);
            u32x4 r;
            r.x = pk2(bflo(ov.x) * rstd * g0[0] * siluf(bflo(gv.x)), bfhi(ov.x) * rstd * g0[1] * siluf(bfhi(gv.x)));
            r.y = pk2(bflo(ov.y) * rstd * g0[2] * siluf(bflo(gv.y)), bfhi(ov.y) * rstd * g0[3] * siluf(bfhi(gv.y)));
            r.z = pk2(bflo(ov.z) * rstd * g1[0] * siluf(bflo(gv.z)), bfhi(ov.z) * rstd * g1[1] * siluf(bfhi(gv.z)));
            r.w = pk2(bflo(ov.w) * rstd * g1[2] * siluf(bflo(gv.w)), bfhi(ov.w) * rstd * g1[3] * siluf(bfhi(gv.w)));
            *(u32x4*)(mp + c8 * 8) = r;
        }
    }
    __syncthreads();
}
constexpr int N_PHASES = 20;
__device__ __forceinline__ void run_phase(const Params& P, LAS unsigned char* lds, int ph) {
    unsigned char* ws = P.ws;
    if (ph == 0) { phase_prologue(P, lds); return; }
    if (ph == N_PHASES - 1) { phase_norm_final(P.out, P.g_final); return; }
    const int l = (ph - 1) / 9, s = (ph - 1) % 9;
    const float* mod = (const float*)(ws + WS_MOD) + (size_t)l * NBATCH * NMOD * DM;
    bf16_t* hbuf = (bf16_t*)(ws + WS_HBUF); bf16_t* proj = (bf16_t*)(ws + WS_PROJ);
#ifdef PH_ONLY
    if (s != PH_ONLY) return;
#endif
    int kD = DM, kF = FFN; asm volatile("" : "+s"(kD), "+s"(kF));
    switch (s) {
    case 0: phase_norm_mod(l == 0 ? P.x : P.out, P.g_mix + l * DM, mod + 0 * DM, mod + 1 * DM, hbuf); break;
    case 1: { pg8::Gemm g{hbuf, (const bf16_t*)(ws + WS_WIN) + (size_t)l * INWP * DM, NTOK, INWP, kD}; pg8::StaticOrder S; S.init(NTOK, INWP, gridDim.x, blockIdx.x);
              EpiProj E{proj}; pg8::gemm_phase<EpiProj, pg8::StaticOrder>(lds, g, S, E, nullptr); } break;
    case 2: { for (int u = blockIdx.x; u < 4608; u += gridDim.x) att_unit(P, lds, u);
              for (int u = blockIdx.x; u < 1536; u += gridDim.x) retA_unit(P, lds, u);
              for (int u = blockIdx.x; u < 1024; u += gridDim.x) hgA_unit(P, lds, u, l); } break;
    case 3: { ret_scan(P); hg_scan(P); att_merge(P); } break;
    case 4: { for (int u = blockIdx.x; u < 256; u += gridDim.x) hgB_unit(P, lds, u, l);
              for (int u = blockIdx.x; u < 1536; u += gridDim.x) retB_unit(P, lds, u, l); } break;
    case 5: { pg8::Gemm g{hbuf, (const bf16_t*)(ws + WS_WOUT) + (size_t)l * DM * DM, NTOK, DM, kD}; pg8::StaticOrder S; S.init(NTOK, DM, gridDim.x, blockIdx.x);
              EpiRes E{l == 0 ? P.x : P.out, P.out, mod + 2 * DM}; pg8::gemm_phase<EpiRes, pg8::StaticOrder>(lds, g, S, E, nullptr); } break;
    case 6: phase_norm_mod(P.out, P.g_ffn + l * DM, mod + 3 * DM, mod + 4 * DM, hbuf); break;
    case 7: { pg8::Gemm g{hbuf, (const bf16_t*)(ws + WS_WGU) + (size_t)l * 2 * FFN * DM, NTOK, 2 * FFN, kD}; pg8::StaticOrder S; S.init(NTOK, 2 * FFN, gridDim.x, blockIdx.x);
              EpiSwiglu E{proj}; pg8::gemm_phase<EpiSwiglu, pg8::StaticOrder>(lds, g, S, E, nullptr); } break;
    case 8: { pg8::Gemm g{proj, (const bf16_t*)(ws + WS_WDN) + (size_t)l * DM * FFN, NTOK, DM, kF}; pg8::StaticOrder S; S.init(NTOK, DM, gridDim.x, blockIdx.x);
              EpiRes E{P.out, P.out, mod + 5 * DM}; pg8::gemm_phase<EpiRes, pg8::StaticOrder>(lds, g, S, E, nullptr); } break;
    }
}
__global__ void __launch_bounds__(NTHREADS) hybrid_fwd(Params P) {
    extern __shared__ __attribute__((aligned(16))) unsigned char lds_raw[];
    LAS unsigned char* lds = (LAS unsigned char*)lds_raw;
    for (int ph = P.ph_lo; ph < P.ph_hi; ++ph) {
        run_phase(P, lds, ph);
        if (ph + 1 < P.ph_hi) { cg::this_grid().sync(); }
    }
}

extern "C" void kernel_launch(void* const* d_in, const int* in_sizes, int n_in, void* d_out, int out_size, void* d_ws, size_t ws_size, hipStream_t stream) {
    static int grid = 0;
    if (grid == 0) {
        if (n_in != 14 || out_size != NTOK * DM || ws_size < WS_END) { fprintf(stderr, "kernel_launch: unexpected shapes (n_in %d out %d ws %zu need %zu)\n", n_in, out_size, ws_size, (size_t)WS_END); grid = -1; return; }
        int dev = 0, cus = 0, per_cu = 0;
        hipGetDevice(&dev); hipDeviceGetAttribute(&cus, hipDeviceAttributeMultiprocessorCount, dev);
        if (hipFuncSetAttribute((const void*)hybrid_fwd, hipFuncAttributeMaxDynamicSharedMemorySize, LDS_BYTES) != hipSuccess) { fprintf(stderr, "kernel_launch: hipFuncSetAttribute failed\n"); grid = -1; return; }
        if (hipOccupancyMaxActiveBlocksPerMultiprocessor(&per_cu, (const void*)hybrid_fwd, NTHREADS, LDS_BYTES) != hipSuccess || per_cu < 1) { fprintf(stderr, "kernel_launch: occupancy query says %d\n", per_cu); grid = -1; return; }
        grid = cus;
    }
    if (grid < 0) return;
    Params p{};
    p.x = (const float*)d_in[0]; p.c = (const float*)d_in[1]; p.w_ada = (const float*)d_in[2]; p.b_ada = (const float*)d_in[3]; p.g_mix = (const float*)d_in[4];
    p.w_in = (const float*)d_in[5]; p.ret_gn = (const float*)d_in[6]; p.hgrn_gn = (const float*)d_in[7]; p.lb_logits = (const float*)d_in[8]; p.w_out = (const float*)d_in[9];
    p.g_ffn = (const float*)d_in[10]; p.w_gu = (const float*)d_in[11]; p.w_down = (const float*)d_in[12]; p.g_final = (const float*)d_in[13];
    p.out = (float*)d_out; p.ws = (unsigned char*)d_ws;
#if ONE_LAUNCH
    p.ph_lo = 0; p.ph_hi = N_PHASES;
    void* args[] = {&p};
    hipError_t e = hipLaunchCooperativeKernel((const void*)hybrid_fwd, dim3(grid), dim3(NTHREADS), args, LDS_BYTES, stream);
    if (e != hipSuccess) fprintf(stderr, "cooperative launch failed: %s (grid %d)\n", hipGetErrorString(e), grid);
#else
    for (int ph = 0; ph < N_PHASES; ++ph) { p.ph_lo = ph; p.ph_hi = ph + 1; hipLaunchKernelGGL(hybrid_fwd, dim3(grid), dim3(NTHREADS), LDS_BYTES, stream, p); }
#endif
}
```

```cpp
#include <hip/hip_runtime.h>
#include <hip/hip_cooperative_groups.h>
#include <cstdio>
#include <cstdint>
namespace cg = cooperative_groups;
#ifndef ONE_LAUNCH
#define ONE_LAUNCH 1
#endif
__device__ __forceinline__ int opaque_tid() { int t = threadIdx.x; asm volatile("" : "+v"(t)); return t; }
#define LAS __attribute__((address_space(3)))
namespace pg8 {
#define PG8_LAS __attribute__((address_space(3)))
typedef unsigned short bf16_t;
typedef short bf16x8 __attribute__((ext_vector_type(8)));
typedef float f32x4 __attribute__((ext_vector_type(4)));
typedef unsigned u32x4 __attribute__((ext_vector_type(4)));
constexpr int BM = 256, BK = 64, HALF = 128, HTB = HALF * BK * 2  , STAGE_BYTES = 8 * HTB, NXCD = 8, WGM = 8;

__host__ __device__ __forceinline__ int lds_byte(int r, int c) { const int st = (r >> 4) * 2 + (c >> 5), rr = r & 15, cc = c & 31, ob = rr * 64 + cc * 2; return st * 1024 + (ob ^ (((ob >> 9) & 1) << 5)); }
__host__ __device__ __forceinline__ void stage_rc(int b, int& R, int& C) { const int st = b / 1024, sb = b % 1024, swz = sb ^ (((sb >> 9) & 1) << 5); R = (st >> 1) * 16 + swz / 64; C = (st & 1) * 32 + (swz % 64) / 2; }
__host__ __device__ __forceinline__ int perm32(int rho) { const int n = rho >> 4, i = rho & 15; return 8 * (i >> 2) + 4 * n + (i & 3); }

struct Unit { int pm, pn; };
struct Gemm { const bf16_t* A; const bf16_t* Bt; int M, N, K; };

struct StaticOrder {
    int nM, nN, nwg, G, c;
    __host__ __device__ void init(int M, int N, int G_, int c_) { nM = M / BM; nN = N / BM; nwg = nM * nN; G = G_; c = c_; }
    __host__ __device__ bool next(int i, Unit& u) const {
        const long L = (long)i * G + c; if (L >= nwg) return false;
        int wgid = (int)L; { const int q = nwg / NXCD, r = nwg % NXCD, xcd = wgid % NXCD, off = wgid / NXCD; wgid = (xcd < r ? xcd * (q + 1) : r * (q + 1) + (xcd - r) * q) + off; }
        const int nig = WGM * nN, gid = wgid / nig, fm = gid * WGM, gsz = (nM - fm) < WGM ? (nM - fm) : WGM;
        u.pm = fm + ((wgid % nig) % gsz); u.pn = (wgid % nig) / gsz; return true;
    }
    __device__ __forceinline__ void a_ready(const Unit&) const {}
    __device__ __forceinline__ void done(const Unit&) const {}
};
__device__ __forceinline__ unsigned cvt_pk_bf16(float lo, float hi) { unsigned r; asm volatile("v_cvt_pk_bf16_f32 %0, %1, %2" : "=v"(r) : "v"(lo), "v"(hi)); return r; }
typedef float f32x2 __attribute__((ext_vector_type(2)));
template <class Epi, class Sched, bool STAMP = false>
__device__ __forceinline__ void gemm_phase(PG8_LAS unsigned char* lds, const Gemm g, const Sched& S, const Epi& E, unsigned long long* stamps) {
    const int tid = opaque_tid(), wid = __builtin_amdgcn_readfirstlane(tid >> 6), lane = tid & 63, wr = wid >> 2, wc = wid & 3, fr = lane & 15, fq = lane >> 4;
    const int K = g.K, nt = K / BK;
    int ts_lo = 0, ts_hi = 0, nts = 0; const unsigned long long rt_entry = STAMP ? (unsigned long long)wall_clock64() : 0ull;
#define PG8_STAMP() do { if (STAMP && wid == 0 && nts < 64) { const unsigned long long _c = (unsigned long long)clock64(); \
        ts_lo = (lane == nts) ? (int)(unsigned)_c : ts_lo; ts_hi = (lane == nts) ? (int)(unsigned)(_c >> 32) : ts_hi; ++nts; } } while (0)
    PG8_STAMP();
    unsigned voffA[2], voffB[2];
#pragma unroll
    for (int i = 0; i < 2; ++i) { int R, C; stage_rc(tid * 16 + i * 8192, R, C); const int Rb = Epi::PERM ? ((R & ~31) + perm32(R & 31)) : R;
        voffA[i] = (unsigned)(R * K + C) * 2u; voffB[i] = (unsigned)(Rb * K + C) * 2u; }
    const size_t kstep = (size_t)(BK * 2);
    const size_t hstep = (size_t)HALF * K * 2;
    const size_t tstep = 2 * hstep;
    const unsigned ldsw = (unsigned)wid * 1024u;
    const int aoff = lds_byte(wr * 64 + fr, fq * 8), boff = lds_byte(wc * 32 + fr, fq * 8);
#define PG8_SA(b, h) (((b) * 2 + (h)) * HTB)
#define PG8_SB(b, h) ((4 + (b) * 2 + (h)) * HTB)
#define PG8_STAGE(bufoff, gbase, voff) do { _Pragma("unroll") for (int _i = 0; _i < 2; ++_i) \
        __builtin_amdgcn_global_load_lds((const unsigned*)((const char*)(gbase) + (voff)[_i]), (PG8_LAS unsigned*)(lds + (bufoff) + ldsw + _i * 8192), 16, 0, 0); } while (0)
#define PG8_LDA(dst, b, h) do { _Pragma("unroll") for (int m = 0; m < 4; ++m) _Pragma("unroll") for (int k = 0; k < 2; ++k) dst[m][k] = *(const PG8_LAS bf16x8*)(lds + PG8_SA(b, h) + aoff + m * 2048 + k * 1024); } while (0)
#define PG8_LDB(dst, b, h) do { _Pragma("unroll") for (int n = 0; n < 2; ++n) _Pragma("unroll") for (int k = 0; k < 2; ++k) dst[n][k] = *(const PG8_LAS bf16x8*)(lds + PG8_SB(b, h) + boff + n * 2048 + k * 1024); } while (0)
#define PG8_MMA(ai, bj, At, Bt) do { __builtin_amdgcn_s_setprio(1); _Pragma("unroll") for (int m = 0; m < 4; ++m) _Pragma("unroll") for (int n = 0; n < 2; ++n) _Pragma("unroll") for (int k = 0; k < 2; ++k) \
        acc[ai][bj][m][n] = __builtin_amdgcn_mfma_f32_16x16x32_bf16(Bt[n][k], At[m][k], acc[ai][bj][m][n], 0, 0, 0); __builtin_amdgcn_s_setprio(0); } while (0)
#define PG8_WAIT_V(n) asm volatile("s_waitcnt vmcnt(" #n ")" ::: "memory")
#define PG8_WAIT_L(n) asm volatile("s_waitcnt lgkmcnt(" #n ")" ::: "memory")
#define PG8_BAR __builtin_amdgcn_s_barrier()
#define PG8_SCHED __builtin_amdgcn_sched_barrier(0)
    Unit cur, nxt; int ui = 0;
    if (!S.next(0, cur)) return;
    f32x4 acc[2][2][4][2];
#pragma unroll
    for (int a = 0; a < 2; ++a)
#pragma unroll
        for (int b = 0; b < 2; ++b)
#pragma unroll
            for (int m = 0; m < 4; ++m)
#pragma unroll
                for (int n = 0; n < 2; ++n) acc[a][b][m][n] = (f32x4){0.f, 0.f, 0.f, 0.f};
    bf16x8 At[4][2], B0[2][2], B1[2][2];
    const char* cA = (const char*)g.A + (size_t)cur.pm * tstep; const char* cB = (const char*)g.Bt + (size_t)cur.pn * tstep;
    S.a_ready(cur);
    PG8_STAGE(PG8_SB(0, 0), cB, voffB); PG8_STAGE(PG8_SA(0, 0), cA, voffA); PG8_STAGE(PG8_SB(0, 1), cB + hstep, voffB); PG8_STAGE(PG8_SA(0, 1), cA + hstep, voffA);
    if (wr == 1) PG8_BAR;
    PG8_WAIT_V(4); PG8_BAR;
    PG8_STAGE(PG8_SB(1, 0), cB + kstep, voffB); PG8_STAGE(PG8_SA(1, 0), cA + kstep, voffA); PG8_STAGE(PG8_SB(1, 1), cB + hstep + kstep, voffB);
    PG8_WAIT_V(6); PG8_BAR;
    PG8_STAMP();
    for (;;) {
        const bool has_next = S.next(ui + 1, nxt);
        const char* nA = has_next ? (const char*)g.A + (size_t)nxt.pm * tstep : cA; const char* nB = has_next ? (const char*)g.Bt + (size_t)nxt.pn * tstep : cB;
        for (int t = 0; t < nt; t += 2) {
            const bool last = (t == nt - 2);
            const char* a1 = cA + (size_t)(t + 1) * kstep;
            const char* a2 = last ? nA : cA + (size_t)(t + 2) * kstep; const char* b2 = last ? nB : cB + (size_t)(t + 2) * kstep;
            const char* a3 = a2 + kstep; const char* b3 = b2 + kstep;
            if (last && has_next) S.a_ready(nxt);
            PG8_LDB(B0, 0, 0); PG8_SCHED; PG8_LDA(At, 0, 0); PG8_STAGE(PG8_SA(1, 1), a1 + hstep, voffA);
            PG8_WAIT_L(8); PG8_BAR; PG8_WAIT_L(0); PG8_MMA(0, 0, At, B0); PG8_BAR; PG8_SCHED;
            PG8_LDB(B1, 0, 1); PG8_STAGE(PG8_SB(0, 0), b2, voffB);
            PG8_BAR; PG8_WAIT_L(0); PG8_MMA(0, 1, At, B1); PG8_BAR;
            PG8_LDA(At, 0, 1); PG8_STAGE(PG8_SA(0, 0), a2, voffA);
            PG8_BAR; PG8_WAIT_L(0); PG8_MMA(1, 0, At, B0); PG8_BAR; PG8_SCHED;
            PG8_STAGE(PG8_SB(0, 1), b2 + hstep, voffB);
            PG8_WAIT_V(6); PG8_BAR; PG8_MMA(1, 1, At, B1); PG8_BAR;
            PG8_LDB(B0, 1, 0); PG8_SCHED; PG8_LDA(At, 1, 0); PG8_STAGE(PG8_SA(0, 1), a2 + hstep, voffA);
            PG8_WAIT_L(8); PG8_BAR; PG8_WAIT_L(0); PG8_MMA(0, 0, At, B0); PG8_BAR; PG8_SCHED;
            PG8_LDB(B1, 1, 1); PG8_STAGE(PG8_SB(1, 0), b3, voffB);
            PG8_BAR; PG8_WAIT_L(0); PG8_MMA(0, 1, At, B1); PG8_BAR;
            PG8_LDA(At, 1, 1); PG8_STAGE(PG8_SA(1, 0), a3, voffA);
            PG8_BAR; PG8_WAIT_L(0); PG8_MMA(1, 0, At, B0); PG8_BAR; PG8_SCHED;
            PG8_STAGE(PG8_SB(1, 1), b3 + hstep, voffB);
            PG8_WAIT_V(6); PG8_BAR; PG8_MMA(1, 1, At, B1); PG8_BAR;
        }
        PG8_STAMP();
        if constexpr (!Epi::AFTER_DRAIN) { E(acc, cur, wr, wc, fr, fq); S.done(cur); }
        PG8_STAMP();
        if (!has_next) break;
#pragma unroll
        for (int a = 0; a < 2; ++a)
#pragma unroll
            for (int b = 0; b < 2; ++b)
#pragma unroll
                for (int m = 0; m < 4; ++m)
#pragma unroll
                    for (int n = 0; n < 2; ++n) acc[a][b][m][n] = (f32x4){0.f, 0.f, 0.f, 0.f};
        cur = nxt; cA = nA; cB = nB; ++ui;
    }
    PG8_WAIT_V(0);
    if (wr == 0) PG8_BAR;
    PG8_BAR;
    if constexpr (Epi::AFTER_DRAIN) { E.fused(acc, cur, wr, wc, fr, fq, lds, wid, lane); S.done(cur); }
    PG8_STAMP();
    if (STAMP && wid == 0) { stamps[lane] = lane < nts ? (((unsigned long long)(unsigned)ts_hi << 32) | (unsigned)ts_lo) : 0ull;
        if (lane == 62) stamps[62] = rt_entry; if (lane == 63) stamps[63] = (unsigned long long)wall_clock64(); }
#undef PG8_STAMP
#undef PG8_SA
#undef PG8_SB
#undef PG8_STAGE
#undef PG8_LDA
#undef PG8_LDB
#undef PG8_MMA
#undef PG8_WAIT_V
#undef PG8_WAIT_L
#undef PG8_BAR
#undef PG8_SCHED
}
}
#define XB_TMO      128
#define XB_XCNT(j)  (256  + 64 * (j))
#define XB_XSUB(j)  (1280 + 64 * (j))
#define XB_XGEN(j)  (2304 + 64 * (j))
#define XB_TOP      3328
#define XB_TOPGEN   3392
#define XCD_BAR_WORDS 3456
#define XB_SPIN_CAP (1u << 18)

__device__ __forceinline__ unsigned xb_ld(unsigned* p)              { return __hip_atomic_load(p, __ATOMIC_RELAXED, __HIP_MEMORY_SCOPE_AGENT); }
__device__ __forceinline__ unsigned xb_add(unsigned* p, unsigned v) { return __hip_atomic_fetch_add(p, v, __ATOMIC_RELAXED, __HIP_MEMORY_SCOPE_AGENT); }
__device__ __forceinline__ unsigned xb_xcc_id() { return (unsigned)__builtin_amdgcn_s_getreg((3 << 11) | 20) & 0xFu; }
#define XB_SPIN(cond, bar) do { unsigned _sp = 0; while (cond) { __builtin_amdgcn_s_sleep(1); \
    if ((++_sp & 255u) == 0u) { if (xb_ld(&(bar)[XB_TMO])) break; if (_sp > XB_SPIN_CAP) { atomicAdd(&(bar)[XB_TMO], 1u); break; } } } } while (0)

struct XcdBarrier {
    unsigned* bar; unsigned x;
    volatile LAS unsigned* st;
};

__device__ __forceinline__ XcdBarrier xcd_barrier_post(unsigned* bar, volatile LAS unsigned* st) {
    XcdBarrier b; b.bar = bar; b.x = xb_xcc_id(); b.st = st;
    if (threadIdx.x == 0) (void)xb_add(&bar[XB_XCNT(b.x)], 1u);
    return b;
}
__device__ __forceinline__ void xcd_barrier_complete(unsigned* bar, unsigned x, unsigned& nloc, unsigned& nx) {
    const unsigned G = gridDim.x * gridDim.y * gridDim.z;
    unsigned sum, cnt, mine, sp = 0u;
    for (;;) {
        sum = 0u; cnt = 0u; mine = 0u;
#pragma unroll
        for (unsigned j = 0; j < 16; ++j) { const unsigned c = xb_ld(&bar[XB_XCNT(j)]); sum += c; cnt += (c > 0u) ? 1u : 0u; mine = (j == x) ? c : mine; }
        if (sum == G) break;
        __builtin_amdgcn_s_sleep(1);
        if ((++sp & 255u) == 0u) { if (xb_ld(&bar[XB_TMO])) break; if (sp > XB_SPIN_CAP) { atomicAdd(&bar[XB_TMO], 1u); break; } }
    }
    nloc = mine > 0u ? mine : 1u; nx = cnt > 0u ? cnt : 1u;
}

__device__ __forceinline__ void xcd_barrier(const XcdBarrier& b) {
    asm volatile("s_waitcnt vmcnt(0)" ::: "memory");
    __syncthreads();
    if (threadIdx.x == 0) {
        unsigned* bar = b.bar;
        __builtin_amdgcn_s_waitcnt(0);
        unsigned nloc = b.st[0], nx = b.st[1];
        if (nloc == 0u) { xcd_barrier_complete(bar, b.x, nloc, nx); b.st[0] = nloc; b.st[1] = nx; }
        const unsigned old = xb_add(&bar[XB_XSUB(b.x)], 1u);
        const unsigned gen = old / nloc;
        if (old + 1u == (gen + 1u) * nloc) {
            __builtin_amdgcn_fence(__ATOMIC_RELEASE, "agent");
            asm volatile("s_waitcnt vmcnt(0)" ::: "memory");
            const unsigned og = xb_add(&bar[XB_TOP], 1u);
            const unsigned tg = og / nx;
            if (og + 1u == (tg + 1u) * nx) xb_add(&bar[XB_TOPGEN], 1u);
            else XB_SPIN(xb_ld(&bar[XB_TOPGEN]) == tg, bar);
            __builtin_amdgcn_fence(__ATOMIC_ACQUIRE, "agent");
            xb_add(&bar[XB_XGEN(b.x)], 1u);
            asm volatile("s_waitcnt vmcnt(0)" ::: "memory");
        } else {
            XB_SPIN(xb_ld(&bar[XB_XGEN(b.x)]) == gen, bar);
            __builtin_amdgcn_fence(__ATOMIC_ACQUIRE, "agent");
            asm volatile("s_waitcnt vmcnt(0)" ::: "memory");
        }
    }
    __syncthreads();
}

typedef unsigned short bf16_t;
typedef short bf16x8 __attribute__((ext_vector_type(8)));
typedef short bf16x4 __attribute__((ext_vector_type(4)));
typedef float f32x4 __attribute__((ext_vector_type(4)));
typedef unsigned u32x4 __attribute__((ext_vector_type(4)));
typedef unsigned u32x2 __attribute__((ext_vector_type(2)));
constexpr int DM = 1024, NBATCH = 8, SEQ = 4096, NTOK = NBATCH * SEQ, DEPTH = 2;
constexpr int INW = 3968, INWP = 4096, FFN = 2816, NMOD = 6;
constexpr int C_AQ = 0, C_AK = 384, C_AV = 768, C_RQ = 1152, C_RK = 1536, C_RV = 1920, C_RG = 2304, C_HQ = 2688, C_HZF = 2944, C_HZB = 3200, C_HI = 3456, C_HG = 3712;
constexpr float NORM_EPS = 1e-6f;
constexpr int NTHREADS = 512;
constexpr int LDS_BYTES = 135168;
constexpr size_t WS_CTL = 0, WS_MOD = 16384, WS_LB = WS_MOD + 393216, WS_HGA = WS_LB + 2048, WS_LSE = WS_HGA + 524288, WS_WIN = WS_LSE + 2359296,
    WS_WOUT = WS_WIN + 16777216, WS_WGU = WS_WOUT + 4194304, WS_WDN = WS_WGU + 23068672, WS_HBUF = WS_WDN + 11534336, WS_PROJ = WS_HBUF + 67108864,
    WS_OB = WS_PROJ + 260046848, WS_RST = WS_OB + 75497472, WS_HGU = WS_RST + 25165824, WS_END = WS_HGU + 33554432;

struct Params {
    const float *x, *c, *w_ada, *b_ada, *g_mix, *w_in, *ret_gn, *hgrn_gn, *lb_logits, *w_out, *g_ffn, *w_gu, *w_down, *g_final;
    float* out; unsigned char* ws; int ph_lo, ph_hi;
};

__device__ __forceinline__ float bf2f(bf16_t v) { return __uint_as_float(((unsigned)v) << 16); }
__device__ __forceinline__ float bflo(unsigned w) { return __uint_as_float(w << 16); }
__device__ __forceinline__ float bfhi(unsigned w) { return __uint_as_float(w & 0xffff0000u); }
__device__ __forceinline__ bf16_t f2bf(float f) { unsigned u = __float_as_uint(f); u += 0x7fffu + ((u >> 16) & 1u); return (bf16_t)(u >> 16); }
__device__ __forceinline__ unsigned pk2(float lo, float hi) { return (unsigned)f2bf(lo) | ((unsigned)f2bf(hi) << 16); }
__device__ __forceinline__ bf16x4 pk4(f32x4 v) { u32x2 w; w.x = pk2(v[0], v[1]); w.y = pk2(v[2], v[3]); return __builtin_bit_cast(bf16x4, w); }
__device__ __forceinline__ float siluf(float v) { return v / (1.0f + __expf(-v)); }
__device__ __forceinline__ float wave_sum(float v) {
#pragma unroll
    for (int o = 1; o < 64; o <<= 1) v += __shfl_xor(v, o);
    return v;
}
#define MFMA32(a, b, c) __builtin_amdgcn_mfma_f32_16x16x32_bf16((a), (b), (c), 0, 0, 0)
#define MFMA16(a, b, c) __builtin_amdgcn_mfma_f32_16x16x16bf16_1k((a), (b), (c), 0, 0, 0)

struct EpiProj {
    static constexpr bool PERM = true, AFTER_DRAIN = false;
    bf16_t* O;
    __device__ __forceinline__ void operator()(const f32x4 (&acc)[2][2][4][2], const pg8::Unit& u, int wr, int wc, int fr, int fq) const {
        const int row0 = u.pm * 256 + wr * 64 + fr, col0 = u.pn * 256 + wc * 32 + 8 * fq;
#pragma unroll
        for (int ai = 0; ai < 2; ++ai)
#pragma unroll
            for (int m = 0; m < 4; ++m) { bf16_t* rowp = O + (size_t)(row0 + ai * 128 + m * 16) * INW + col0;
#pragma unroll
                for (int bj = 0; bj < 2; ++bj) { if (col0 + bj * 128 < INW) { const f32x4 v0 = acc[ai][bj][m][0], v1 = acc[ai][bj][m][1];
                    u32x4 w; w.x = pk2(v0[0], v0[1]); w.y = pk2(v0[2], v0[3]); w.z = pk2(v1[0], v1[1]); w.w = pk2(v1[2], v1[3]);
                    *(u32x4*)(rowp + bj * 128) = w; } } }
    }
};
struct EpiRes {
    static constexpr bool PERM = false, AFTER_DRAIN = false;
    const float* base; float* out; const float* gate;
    __device__ __forceinline__ void operator()(const f32x4 (&acc)[2][2][4][2], const pg8::Unit& u, int wr, int wc, int fr, int fq) const {
        const int row0 = u.pm * 256 + wr * 64 + fr, col0 = u.pn * 256 + wc * 32 + 4 * fq;
        const float* gp = gate + (size_t)((u.pm * 256) >> 12) * (NMOD * DM) + col0;
        f32x4 gv[2][2];
#pragma unroll
        for (int bj = 0; bj < 2; ++bj)
#pragma unroll
            for (int n = 0; n < 2; ++n) gv[bj][n] = *(const f32x4*)(gp + bj * 128 + n * 16);
#pragma unroll
        for (int ai = 0; ai < 2; ++ai)
#pragma unroll
            for (int m = 0; m < 4; ++m) { const size_t off = (size_t)(row0 + ai * 128 + m * 16) * DM + col0;
#pragma unroll
                for (int bj = 0; bj < 2; ++bj)
#pragma unroll
                    for (int n = 0; n < 2; ++n) { const f32x4 bs = *(const f32x4*)(base + off + bj * 128 + n * 16);
                        *(f32x4*)(out + off + bj * 128 + n * 16) = bs + gv[bj][n] * acc[ai][bj][m][n]; } }
    }
};
struct EpiSwiglu {
    static constexpr bool PERM = true, AFTER_DRAIN = false;
    bf16_t* O;
    __device__ __forceinline__ void operator()(const f32x4 (&acc)[2][2][4][2], const pg8::Unit& u, int wr, int wc, int fr, int fq) const {
        const int row0 = u.pm * 256 + wr * 64 + fr, col0 = u.pn * 128 + wc * 32 + 8 * fq;
#pragma unroll
        for (int ai = 0; ai < 2; ++ai)
#pragma unroll
            for (int m = 0; m < 4; ++m) { bf16_t* rowp = O + (size_t)(row0 + ai * 128 + m * 16) * FFN + col0;
                float r[8];
#pragma unroll
                for (int n = 0; n < 2; ++n)
#pragma unroll
                    for (int i = 0; i < 4; ++i) { const float g = acc[ai][0][m][n][i], uu = acc[ai][1][m][n][i]; r[n * 4 + i] = siluf(g) * uu; }
                u32x4 w; w.x = pk2(r[0], r[1]); w.y = pk2(r[2], r[3]); w.z = pk2(r[4], r[5]); w.w = pk2(r[6], r[7]);
                *(u32x4*)rowp = w; }
    }
};
__device__ __forceinline__ void transpose_item(const float* W, int K, int N, bf16_t* WT, int dst_row0, int src_col0, int k0, LAS float* scr, int lane) {
    if (src_col0 < 0) {
        const int c = lane & 7;
#pragma unroll
        for (int j = 0; j < 4; ++j) { const int n = (lane >> 3) + 8 * j; *(u32x4*)(WT + (size_t)(dst_row0 + n) * K + k0 + 8 * c) = (u32x4){0u, 0u, 0u, 0u}; }
        return;
    }
#pragma unroll 8
    for (int i = 0; i < 32; ++i) { const int kk = 2 * i + (lane >> 5); scr[kk * 33 + (lane & 31)] = W[(size_t)(k0 + kk) * N + src_col0 + (lane & 31)]; }
    __builtin_amdgcn_fence(__ATOMIC_RELEASE, "wavefront"); __builtin_amdgcn_wave_barrier(); __builtin_amdgcn_fence(__ATOMIC_ACQUIRE, "wavefront");
    const int c = lane & 7;
#pragma unroll
    for (int j = 0; j < 4; ++j) { const int n = (lane >> 3) + 8 * j; const LAS float* s = scr + (8 * c) * 33 + n;
        u32x4 o; o.x = pk2(s[0 * 33], s[1 * 33]); o.y = pk2(s[2 * 33], s[3 * 33]); o.z = pk2(s[4 * 33], s[5 * 33]); o.w = pk2(s[6 * 33], s[7 * 33]);
        *(u32x4*)(WT + (size_t)(dst_row0 + n) * K + k0 + 8 * c) = o; }
    __builtin_amdgcn_fence(__ATOMIC_RELEASE, "wavefront"); __builtin_amdgcn_wave_barrier(); __builtin_amdgcn_fence(__ATOMIC_ACQUIRE, "wavefront");
}

__device__ __forceinline__ void phase_prologue(const Params& P, LAS unsigned char* lds) {
    const int tid = opaque_tid(), lane = tid & 63, wave = __builtin_amdgcn_readfirstlane(tid >> 6);
    unsigned char* ws = P.ws;
    {
        LAS float* scr = (LAS float*)(lds + wave * 8704);
        const int gw = blockIdx.x * 8 + wave, NGW = gridDim.x * 8;
        constexpr int I_IN = 16 * 128, I_OUT = 16 * 32, I_GU = 16 * 176, I_DN = 44 * 32, I_L = I_IN + I_OUT + I_GU + I_DN;
        for (int it = gw; it < DEPTH * I_L; it += NGW) {
            const int l = it / I_L; int r = it % I_L;
            if (r < I_IN) { const int kb = r / 128, nb = r % 128, n0 = nb * 32;
                transpose_item(P.w_in + (size_t)l * DM * INW, DM, INW, (bf16_t*)(ws + WS_WIN) + (size_t)l * INWP * DM, n0, n0 < INW ? n0 : -1, kb * 64, scr, lane); continue; }
            r -= I_IN;
            if (r < I_OUT) { const int kb = r / 32, nb = r % 32;
                transpose_item(P.w_out + (size_t)l * DM * DM, DM, DM, (bf16_t*)(ws + WS_WOUT) + (size_t)l * DM * DM, nb * 32, nb * 32, kb * 64, scr, lane); continue; }
            r -= I_OUT;
            if (r < I_GU) { const int kb = r / 176, nb = r % 176, n0 = nb * 32; const int pn = n0 >> 8, half = (n0 >> 7) & 1, jj = n0 & 127;
                transpose_item(P.w_gu + (size_t)l * DM * 2 * FFN, DM, 2 * FFN, (bf16_t*)(ws + WS_WGU) + (size_t)l * 2 * FFN * DM, n0, half * FFN + pn * 128 + jj, kb * 64, scr, lane); continue; }
            r -= I_GU;
            { const int kb = r / 32, nb = r % 32;
                transpose_item(P.w_down + (size_t)l * FFN * DM, FFN, DM, (bf16_t*)(ws + WS_WDN) + (size_t)l * DM * FFN, nb * 32, nb * 32, kb * 64, scr, lane); }
        }
    }
    __syncthreads();
    {
        LAS float* sc = (LAS float*)lds;
        LAS float* red = (LAS float*)(lds + 32768);
        for (int i = tid; i < NBATCH * DM; i += NTHREADS) sc[i] = siluf(P.c[i]);
        __syncthreads();
        float* mod = (float*)(ws + WS_MOD);
        for (int u = blockIdx.x; u < DEPTH * 96; u += gridDim.x) {
            const int l = u / 96, j0 = (u % 96) * 64, col = tid & 63, kp = tid >> 6;
            float acc[8];
#pragma unroll
            for (int b = 0; b < 8; ++b) acc[b] = 0.f;
            const float* wp = P.w_ada + (size_t)l * DM * (NMOD * DM) + j0 + col;
            for (int k = kp * 128; k < kp * 128 + 128; ++k) { const float w = wp[(size_t)k * (NMOD * DM)];
#pragma unroll
                for (int b = 0; b < 8; ++b) acc[b] += sc[b * DM + k] * w; }
#pragma unroll
            for (int b = 0; b < 8; ++b) red[(kp * 8 + b) * 64 + col] = acc[b];
            __syncthreads();
            { const int b = tid >> 6; float s = 0.f;
#pragma unroll
              for (int p = 0; p < 8; ++p) s += red[(p * 8 + b) * 64 + col];
              mod[((size_t)l * NBATCH + b) * (NMOD * DM) + j0 + col] = s + P.b_ada[(size_t)l * NMOD * DM + j0 + col]; }
            __syncthreads();
        }
    }
    if (blockIdx.x == 0 && tid < 256) {
        const float l0 = P.lb_logits[tid], l1 = P.lb_logits[256 + tid], m = fmaxf(l0, l1), e0 = __expf(l0 - m), e1 = __expf(l1 - m);
        const float p0 = e0 / (e0 + e1), p1 = e1 / (e0 + e1);
        float* lb = (float*)(ws + WS_LB);
        lb[tid] = fminf(fmaxf(p0 - p0, 0.f), 1.0f - 1e-6f);
        lb[256 + tid] = fminf(fmaxf((p0 + p1) - p0, 0.f), 1.0f - 1e-6f);
    }
}

__device__ __forceinline__ void phase_norm_mod(const float* src, const float* g, const float* shift, const float* scale, bf16_t* dst) {
    const int tid = opaque_tid(), lane = tid & 63, wave = tid >> 6;
    const int gw = blockIdx.x * 8 + wave, NGW = gridDim.x * 8;
    f32x4 gv[4];
#pragma unroll
    for (int j = 0; j < 4; ++j) gv[j] = *(const f32x4*)(g + 4 * lane + 256 * j);
    for (int row = gw; row < NTOK; row += NGW) {
        const int b = row >> 12;
        const f32x4* xr = (const f32x4*)(src + (size_t)row * DM) + lane;
        f32x4 v[4]; float s = 0.f;
#pragma unroll
        for (int j = 0; j < 4; ++j) { v[j] = xr[64 * j]; s += (v[j][0] * v[j][0] + v[j][1] * v[j][1]) + (v[j][2] * v[j][2] + v[j][3] * v[j][3]); }
        const float rstd = rsqrtf(wave_sum(s) * (1.0f / DM) + NORM_EPS);
        unsigned long long* o8 = (unsigned long long*)(dst + (size_t)row * DM) + lane;
#pragma unroll
        for (int j = 0; j < 4; ++j) {
            const f32x4 sc = *(const f32x4*)(scale + (size_t)b * (NMOD * DM) + 4 * lane + 256 * j), sh = *(const f32x4*)(shift + (size_t)b * (NMOD * DM) + 4 * lane + 256 * j);
            const f32x4 h = v[j] * rstd * gv[j] * (sc + 1.0f) + sh;
            o8[64 * j] = (unsigned long long)pk2(h[0], h[1]) | ((unsigned long long)pk2(h[2], h[3]) << 32);
        }
    }
}
__device__ __forceinline__ void phase_norm_final(float* x, const float* g) {
    const int tid = opaque_tid(), lane = tid & 63, wave = tid >> 6;
    const int gw = blockIdx.x * 8 + wave, NGW = gridDim.x * 8;
    f32x4 gv[4];
#pragma unroll
    for (int j = 0; j < 4; ++j) gv[j] = *(const f32x4*)(g + 4 * lane + 256 * j);
    for (int row = gw; row < NTOK; row += NGW) {
        f32x4* xr = (f32x4*)(x + (size_t)row * DM) + lane;
        f32x4 v[4]; float s = 0.f;
#pragma unroll
        for (int j = 0; j < 4; ++j) { v[j] = xr[64 * j]; s += (v[j][0] * v[j][0] + v[j][1] * v[j][1]) + (v[j][2] * v[j][2] + v[j][3] * v[j][3]); }
        const float rstd = rsqrtf(wave_sum(s) * (1.0f / DM) + NORM_EPS);
#pragma unroll
        for (int j = 0; j < 4; ++j) xr[64 * j] = v[j] * rstd * gv[j];
    }
}
struct AttRegs { u32x4 kv[4], vv[4]; bf16x8 qf[2]; };
__device__ __forceinline__ void att_decode(int u, int& br, int& b, int& h, int& r, int& L, int& p0, int& tok0) {
    br = u / 1536; const int v = u % 1536; b = v / 192; h = (v >> 5) % 6; const int w = v & 31;
    const int lr = br * 2, nblk = 32 >> lr, rho = w / nblk, blk = w % nblk; r = 1 << lr; L = SEQ >> lr; p0 = blk * 128; tok0 = b * SEQ + rho;
}
__device__ __forceinline__ void att_load(const Params& P, int u, int tid, AttRegs& R) {
    int br, b, h, r, L, p0, tok0; att_decode(u, br, b, h, r, L, p0, tok0);
    const bf16_t* proj = (const bf16_t*)(P.ws + WS_PROJ);
    const int key = tid >> 1, half = tid & 1, kj = p0 - 64 + key;
    if (kj >= 0 && kj < L) {
        const bf16_t* src = proj + (size_t)(tok0 + r * kj) * INW + h * 64 + half * 32;
#pragma unroll
        for (int i = 0; i < 4; ++i) { R.kv[i] = *(const u32x4*)(src + C_AK + 8 * i); R.vv[i] = *(const u32x4*)(src + C_AV + 8 * i); }
    } else {
#pragma unroll
        for (int i = 0; i < 4; ++i) { R.kv[i] = (u32x4){0u, 0u, 0u, 0u}; R.vv[i] = (u32x4){0u, 0u, 0u, 0u}; }
    }
    const int lane = tid & 63, wave = tid >> 6, q = lane & 15, g = lane >> 4;
    const size_t tokq = (size_t)(tok0 + r * (p0 + 16 * wave + q));
#pragma unroll
    for (int kk = 0; kk < 2; ++kk) R.qf[kk] = *(const bf16x8*)(proj + tokq * INW + C_AQ + h * 64 + kk * 32 + 8 * g);
}
__device__ __forceinline__ void att_phase(const Params& P, LAS unsigned char* lds) {
    const int tid = opaque_tid(), lane = tid & 63, wave = __builtin_amdgcn_readfirstlane(tid >> 6), q = lane & 15, g = lane >> 4;
    LAS bf16_t* Ks = (LAS bf16_t*)lds;
    LAS bf16_t* Vs = (LAS bf16_t*)(lds + 36864);
    int u = blockIdx.x; if (u >= 4608) return;
    AttRegs R; att_load(P, u, tid, R);
    for (; u < 4608; u += gridDim.x) {
        int br, b, h, r, L, p0, tok0; att_decode(u, br, b, h, r, L, p0, tok0);
        {
            const int key = tid >> 1, half = tid & 1;
#pragma unroll
            for (int i = 0; i < 4; ++i) { *(LAS u32x4*)(Ks + key * 72 + half * 32 + 8 * i) = R.kv[i]; *(LAS u32x4*)(Vs + key * 72 + half * 32 + 8 * i) = R.vv[i]; }
        }
        bf16x8 qf[2]; qf[0] = R.qf[0]; qf[1] = R.qf[1];
        __syncthreads();
        if (u + (int)gridDim.x < 4608) att_load(P, u + gridDim.x, tid, R);
        const int p = p0 + 16 * wave + q; const size_t tokq = (size_t)(tok0 + r * p);
        const float slope_r = exp2f(-8.0f * (float)(h + 1) / 6.0f) * (float)r;
        f32x4 st[9]; float mx = -3.0e38f;
#pragma unroll
        for (int t = 0; t < 9; ++t) {
            f32x4 acc = {0.f, 0.f, 0.f, 0.f};
#pragma unroll
            for (int kk = 0; kk < 2; ++kk) { const bf16x8 a = *(const LAS bf16x8*)(Ks + (16 * wave + 16 * t + q) * 72 + kk * 32 + 8 * g); acc = MFMA32(a, qf[kk], acc); }
#pragma unroll
            for (int j = 0; j < 4; ++j) {
                const int kl = 16 * wave + 16 * t + 4 * g + j, kj = p0 - 64 + kl; int dist = p - kj; dist = dist < 0 ? -dist : dist;
                const bool valid = (kj >= 0) && (kj < L) && (dist <= 64);
                const float s = valid ? acc[j] * 0.125f - slope_r * (float)dist : -1.0e30f;
                acc[j] = s; mx = fmaxf(mx, s);
            }
            st[t] = acc;
        }
        mx = fmaxf(mx, __shfl_xor(mx, 16)); mx = fmaxf(mx, __shfl_xor(mx, 32));
        float ls = 0.f; bf16x4 pt[9];
#pragma unroll
        for (int t = 0; t < 9; ++t) { f32x4 e;
#pragma unroll
            for (int j = 0; j < 4; ++j) { e[j] = (st[t][j] > -1.0e29f) ? __expf(st[t][j] - mx) : 0.f; ls += e[j]; }
            pt[t] = pk4(e); }
        ls += __shfl_xor(ls, 16); ls += __shfl_xor(ls, 32);
        const float inv = 1.0f / ls;
        bf16_t* ob = (bf16_t*)(P.ws + WS_OB) + ((size_t)br * NTOK + tokq) * 384 + h * 64;
        const LAS bf16_t* vrd = Vs + (16 * wave + 4 * g + (q >> 2)) * 72 + 4 * (q & 3);
#pragma unroll
        for (int dt = 0; dt < 4; ++dt) {
            f32x4 acc = {0.f, 0.f, 0.f, 0.f};
#pragma unroll
            for (int t = 0; t < 9; ++t) { const bf16x4 a = __builtin_amdgcn_ds_read_tr16_b64_v4i16((LAS bf16x4*)(vrd + 16 * t * 72 + dt * 16)); acc = MFMA16(a, pt[t], acc); }
            acc = acc * inv;
            *(bf16x4*)(ob + dt * 16 + 4 * g) = pk4(acc);
        }
        if (g == 0) ((float*)(P.ws + WS_LSE))[((size_t)br * NTOK + tokq) * 6 + h] = mx + __logf(ls);
        __syncthreads();
    }
}
__device__ __forceinline__ void att_merge(const Params& P) {
    const bf16_t* ob = (const bf16_t*)(P.ws + WS_OB); const float* lse = (const float*)(P.ws + WS_LSE); bf16_t* mixed = (bf16_t*)(P.ws + WS_HBUF);
    for (size_t it = (size_t)blockIdx.x * NTHREADS + opaque_tid(); it < (size_t)NTOK * 48; it += (size_t)gridDim.x * NTHREADS) {
        const size_t tok = it / 48; const int grp = (int)(it % 48), h = grp >> 3;
        const float l0 = lse[tok * 6 + h], l1 = lse[((size_t)NTOK + tok) * 6 + h], l2 = lse[((size_t)2 * NTOK + tok) * 6 + h];
        const float m = fmaxf(l0, fmaxf(l1, l2)), e0 = __expf(l0 - m), e1 = __expf(l1 - m), e2 = __expf(l2 - m), is = 1.0f / (e0 + e1 + e2);
        const float w0 = e0 * is, w1 = e1 * is, w2 = e2 * is;
        const u32x4 a = *(const u32x4*)(ob + tok * 384 + grp * 8), bq = *(const u32x4*)(ob + ((size_t)NTOK + tok) * 384 + grp * 8), cq = *(const u32x4*)(ob + ((size_t)2 * NTOK + tok) * 384 + grp * 8);
        u32x4 o;
#pragma unroll
        for (int i = 0; i < 4; ++i) o[i] = pk2(w0 * bflo(a[i]) + w1 * bflo(bq[i]) + w2 * bflo(cq[i]), w0 * bfhi(a[i]) + w1 * bfhi(bq[i]) + w2 * bfhi(cq[i]));
        *(u32x4*)(mixed + tok * DM + grp * 8) = o;
    }
}

__device__ __forceinline__ float ret_logg(int h) { return log1pf(-exp2f(-5.0f - (float)h)); }
__device__ __forceinline__ void retA_unit(const Params& P, LAS unsigned char* lds, int u) {
    const int tid = opaque_tid(), lane = tid & 63, wave = __builtin_amdgcn_readfirstlane(tid >> 6), q = lane & 15, g = lane >> 4;
    const int bh = u >> 5, n = u & 31, b = bh / 6, h = bh % 6;
    const bf16_t* proj = (const bf16_t*)(P.ws + WS_PROJ);
    LAS bf16_t* Kft = (LAS bf16_t*)lds; LAS bf16_t* Kbt = (LAS bf16_t*)(lds + 17408); LAS bf16_t* Vt = (LAS bf16_t*)(lds + 34816);
    const float lg = ret_logg(h);
    {
        const int c = tid >> 2, qd = tid & 3; const bf16_t* src = proj + (size_t)(b * SEQ + n * 128 + c) * INW + h * 64 + qd * 16;
        const u32x4 k0 = *(const u32x4*)(src + C_RK), k1 = *(const u32x4*)(src + C_RK + 8), v0 = *(const u32x4*)(src + C_RV), v1 = *(const u32x4*)(src + C_RV + 8);
        const float wf = 0.125f * __expf(lg * (float)(127 - c)), wb = 0.125f * __expf(lg * (float)c);
#pragma unroll
        for (int e = 0; e < 8; ++e) { const unsigned kw = e < 4 ? k0[e & 3] : k1[e & 3], vw = e < 4 ? v0[e & 3] : v1[e & 3]; const int d = qd * 16 + 2 * e;
            const float ka = bflo(kw), kb = bfhi(kw);
            Kft[d * 136 + c] = f2bf(ka * wf); Kft[(d + 1) * 136 + c] = f2bf(kb * wf);
            Kbt[d * 136 + c] = f2bf(ka * wb); Kbt[(d + 1) * 136 + c] = f2bf(kb * wb);
            Vt[d * 136 + c] = (bf16_t)(vw & 0xffffu); Vt[(d + 1) * 136 + c] = (bf16_t)(vw >> 16); }
    }
    __syncthreads();
    const int dir = wave >> 2, dt = wave & 3; const LAS bf16_t* Kt = dir ? Kbt : Kft;
    bf16x8 afr[4];
#pragma unroll
    for (int kk = 0; kk < 4; ++kk) afr[kk] = *(const LAS bf16x8*)(Kt + (dt * 16 + q) * 136 + kk * 32 + 8 * g);
    bf16_t* dst = (bf16_t*)(P.ws + WS_RST) + ((size_t)(bh * 32 + n) * 2 + dir) * 4096;
#pragma unroll
    for (int et = 0; et < 4; ++et) {
        f32x4 acc = {0.f, 0.f, 0.f, 0.f};
#pragma unroll
        for (int kk = 0; kk < 4; ++kk) { const bf16x8 bfr = *(const LAS bf16x8*)(Vt + (et * 16 + q) * 136 + kk * 32 + 8 * g); acc = MFMA32(afr[kk], bfr, acc); }
        *(bf16x4*)(dst + (et * 16 + q) * 64 + dt * 16 + 4 * g) = pk4(acc);
    }
    __syncthreads();
}
__device__ __forceinline__ void ret_scan(const Params& P) {
    bf16_t* st = (bf16_t*)(P.ws + WS_RST);
    for (int it = blockIdx.x * NTHREADS + opaque_tid(); it < 48 * 2 * 512; it += gridDim.x * NTHREADS) {
        const int ch = it & 511, dir = (it >> 9) & 1, bh = it >> 10, h = bh % 6;
        const float cd = __expf(ret_logg(h) * 128.0f);
        float s[8];
#pragma unroll
        for (int e = 0; e < 8; ++e) s[e] = 0.f;
        for (int i0 = 0; i0 < 32; i0 += 8) {
            u32x4 v[8];
#pragma unroll
            for (int i = 0; i < 8; ++i) { const int n = dir ? 31 - (i0 + i) : (i0 + i); v[i] = *(const u32x4*)(st + ((size_t)(bh * 32 + n) * 2 + dir) * 4096 + 8 * ch); }
#pragma unroll
            for (int i = 0; i < 8; ++i) { const int n = dir ? 31 - (i0 + i) : (i0 + i);
                u32x4 o;
#pragma unroll
                for (int e = 0; e < 4; ++e) o[e] = pk2(s[2 * e], s[2 * e + 1]);
                *(u32x4*)(st + ((size_t)(bh * 32 + n) * 2 + dir) * 4096 + 8 * ch) = o;
#pragma unroll
                for (int e = 0; e < 4; ++e) { s[2 * e] = cd * s[2 * e] + bflo(v[i][e]); s[2 * e + 1] = cd * s[2 * e + 1] + bfhi(v[i][e]); } }
        }
    }
}
__device__ __forceinline__ void retB_unit(const Params& P, LAS unsigned char* lds, int u, int layer) {
    const int tid = opaque_tid(), lane = tid & 63, wave = __builtin_amdgcn_readfirstlane(tid >> 6), q = lane & 15, g = lane >> 4;
    const int bh = u >> 5, n = u & 31, b = bh / 6, h = bh % 6;
    const bf16_t* proj = (const bf16_t*)(P.ws + WS_PROJ);
    LAS bf16_t* Ks = (LAS bf16_t*)lds;
    LAS bf16_t* Vt = (LAS bf16_t*)(lds + 18432);
    LAS bf16_t* Rf = (LAS bf16_t*)(lds + 35840);
    LAS bf16_t* Rb = (LAS bf16_t*)(lds + 45056);
    const float lg = ret_logg(h);
    {
        const int c = tid >> 2, qd = tid & 3; const bf16_t* src = proj + (size_t)(b * SEQ + n * 128 + c) * INW + h * 64 + qd * 16;
        const u32x4 k0 = *(const u32x4*)(src + C_RK), k1 = *(const u32x4*)(src + C_RK + 8), v0 = *(const u32x4*)(src + C_RV), v1 = *(const u32x4*)(src + C_RV + 8);
        *(LAS u32x4*)(Ks + c * 72 + qd * 16) = k0; *(LAS u32x4*)(Ks + c * 72 + qd * 16 + 8) = k1;
#pragma unroll
        for (int e = 0; e < 8; ++e) { const unsigned vw = e < 4 ? v0[e & 3] : v1[e & 3]; const int d = qd * 16 + 2 * e;
            Vt[d * 136 + c] = (bf16_t)(vw & 0xffffu); Vt[(d + 1) * 136 + c] = (bf16_t)(vw >> 16); }
        const bf16_t* rs = (const bf16_t*)(P.ws + WS_RST) + (size_t)(bh * 32 + n) * 2 * 4096;
        const int e = tid >> 3, d8 = (tid & 7) * 8;
        *(LAS u32x4*)(Rf + e * 72 + d8) = *(const u32x4*)(rs + e * 64 + d8);
        *(LAS u32x4*)(Rb + e * 72 + d8) = *(const u32x4*)(rs + 4096 + e * 64 + d8);
    }
    __syncthreads();
    const int i = 16 * wave + q; const size_t tok = (size_t)(b * SEQ + n * 128 + i);
    bf16x8 qf[2], qff[2], qfb[2];
    {
        const float ff = __expf(lg * (float)(i + 1)), fb = __expf(lg * (float)(128 - i));
#pragma unroll
        for (int kk = 0; kk < 2; ++kk) { const u32x4 raw = *(const u32x4*)(proj + tok * INW + C_RQ + h * 64 + kk * 32 + 8 * g);
            qf[kk] = __builtin_bit_cast(bf16x8, raw); u32x4 a, c2;
#pragma unroll
            for (int e = 0; e < 4; ++e) { const float lo = bflo(raw[e]), hi = bfhi(raw[e]); a[e] = pk2(lo * ff, hi * ff); c2[e] = pk2(lo * fb, hi * fb); }
            qff[kk] = __builtin_bit_cast(bf16x8, a); qfb[kk] = __builtin_bit_cast(bf16x8, c2); }
    }
    bf16x4 pt[8];
#pragma unroll
    for (int jt = 0; jt < 8; ++jt) {
        f32x4 acc = {0.f, 0.f, 0.f, 0.f};
#pragma unroll
        for (int kk = 0; kk < 2; ++kk) { const bf16x8 a = *(const LAS bf16x8*)(Ks + (16 * jt + q) * 72 + kk * 32 + 8 * g); acc = MFMA32(a, qf[kk], acc); }
#pragma unroll
        for (int jj = 0; jj < 4; ++jj) { int dd = i - (16 * jt + 4 * g + jj); dd = dd < 0 ? -dd : dd; acc[jj] = acc[jj] * 0.125f * __expf(lg * (float)dd); }
        pt[jt] = pk4(acc);
    }
    f32x4 o[4];
#pragma unroll
    for (int et = 0; et < 4; ++et) {
        f32x4 acc = {0.f, 0.f, 0.f, 0.f};
#pragma unroll
        for (int jt = 0; jt < 8; ++jt) { const bf16x4 a = *(const LAS bf16x4*)(Vt + (et * 16 + q) * 136 + 16 * jt + 4 * g); acc = MFMA16(a, pt[jt], acc); }
#pragma unroll
        for (int kk = 0; kk < 2; ++kk) { const bf16x8 a = *(const LAS bf16x8*)(Rf + (et * 16 + q) * 72 + kk * 32 + 8 * g); acc = MFMA32(a, qff[kk], acc);
            const bf16x8 a2 = *(const LAS bf16x8*)(Rb + (et * 16 + q) * 72 + kk * 32 + 8 * g); acc = MFMA32(a2, qfb[kk], acc); }
        o[et] = acc;
    }
    float s = 0.f;
#pragma unroll
    for (int et = 0; et < 4; ++et) s += (o[et][0] + o[et][1]) + (o[et][2] + o[et][3]);
    s += __shfl_xor(s, 16); s += __shfl_xor(s, 32);
    const float mu = s * (1.0f / 64.0f); float vs = 0.f;
#pragma unroll
    for (int et = 0; et < 4; ++et) { o[et] = o[et] - mu; vs += (o[et][0] * o[et][0] + o[et][1] * o[et][1]) + (o[et][2] * o[et][2] + o[et][3] * o[et][3]); }
    vs += __shfl_xor(vs, 16); vs += __shfl_xor(vs, 32);
    const float rstd = rsqrtf(vs * (1.0f / 64.0f) + NORM_EPS);
    bf16_t* mixed = (bf16_t*)(P.ws + WS_HBUF) + tok * DM + 384 + h * 64;
#pragma unroll
    for (int et = 0; et < 4; ++et) {
        const f32x4 gn = *(const f32x4*)(P.ret_gn + layer * 384 + h * 64 + et * 16 + 4 * g);
        const u32x2 rg = *(const u32x2*)(proj + tok * INW + C_RG + h * 64 + et * 16 + 4 * g);
        f32x4 y; y[0] = o[et][0] * rstd * gn[0] * siluf(bflo(rg.x)); y[1] = o[et][1] * rstd * gn[1] * siluf(bfhi(rg.x));
        y[2] = o[et][2] * rstd * gn[2] * siluf(bflo(rg.y)); y[3] = o[et][3] * rstd * gn[3] * siluf(bfhi(rg.y));
        *(bf16x4*)(mixed + et * 16 + 4 * g) = pk4(y);
    }
    __syncthreads();
}
__device__ __forceinline__ void hgrn_gate(float z, float lbv, float& f, float& kk) {
    z = fminf(fmaxf(z, -30.f), 30.f);
    const float ez = __expf(-z), sg = __builtin_amdgcn_rcpf(1.0f + ez);
    f = lbv + (1.0f - lbv) * sg; kk = (1.0f - lbv) * ez * sg;
}
__device__ __forceinline__ void hgA_unit(const Params& P, LAS unsigned char* lds, int u, int layer) {
    const int tid = opaque_tid(), lane = tid & 63, wave = __builtin_amdgcn_readfirstlane(tid >> 6), q = lane & 15, g = lane >> 4;
    const int bh = u >> 5, n = u & 31, b = bh >> 2, h = bh & 3;
    const bf16_t* proj = (const bf16_t*)(P.ws + WS_PROJ);
    LAS bf16_t* Kt = (LAS bf16_t*)lds;
    LAS bf16_t* Vt = (LAS bf16_t*)(lds + 34816);
    LAS float* segs = (LAS float*)(lds + 52224);
    const size_t tokc = (size_t)(b * SEQ + n * 128);
    {
        const int c = tid >> 2, qd = tid & 3; const bf16_t* src = proj + (tokc + c) * INW + C_HI + h * 64 + qd * 16;
        const u32x4 v0 = *(const u32x4*)src, v1 = *(const u32x4*)(src + 8);
#pragma unroll
        for (int e = 0; e < 8; ++e) { const unsigned vw = e < 4 ? v0[e & 3] : v1[e & 3]; const int d = qd * 16 + 2 * e;
            Vt[d * 136 + c] = (bf16_t)(vw & 0xffffu); Vt[(d + 1) * 136 + c] = (bf16_t)(vw >> 16); }
    }
    const int d = tid & 63, dir = (tid >> 6) & 1, seg = tid >> 7;
    const float lbv = ((const float*)(P.ws + WS_LB))[layer * 256 + h * 64 + d];
    float lf[32], kk[32];
    {
        const bf16_t* zp = proj + (tokc + seg * 32) * INW + (dir ? C_HZB : C_HZF) + h * 64 + d;
        bf16_t zr[32];
#pragma unroll
        for (int i = 0; i < 32; ++i) zr[i] = zp[(size_t)i * INW];
#pragma unroll
        for (int i = 0; i < 32; ++i) hgrn_gate(bf2f(zr[i]), lbv, lf[i], kk[i]);
    }
    float ssum = 1.f;
#pragma unroll
    for (int i = 0; i < 32; ++i) ssum *= lf[i];
    segs[(dir * 4 + seg) * 64 + d] = ssum;
    __syncthreads();
    {
        float before = 1.f, after = 1.f;
#pragma unroll
        for (int s2 = 0; s2 < 4; ++s2) { const float v = segs[(dir * 4 + s2) * 64 + d]; if (s2 < seg) before *= v; if (s2 > seg) after *= v; }
        LAS bf16_t* kt = Kt + dir * (64 * 136) + d * 136 + seg * 32;
        if (dir == 0) {
            float run = after;
#pragma unroll
            for (int i = 31; i >= 0; --i) { kt[i] = f2bf(kk[i] * run); run *= lf[i]; }
        } else {
            float run = before;
#pragma unroll
            for (int i = 0; i < 32; ++i) { kt[i] = f2bf(kk[i] * run); run *= lf[i]; }
        }
        if (seg == 0) ((float*)(P.ws + WS_HGA))[((size_t)(bh * 2 + dir) * 32 + n) * 64 + d] = ssum * after;
    }
    __syncthreads();
    {
        const int wdir = wave >> 2, dt = wave & 3; const LAS bf16_t* kts = Kt + wdir * (64 * 136);
        bf16x8 afr[4];
#pragma unroll
        for (int kq = 0; kq < 4; ++kq) afr[kq] = *(const LAS bf16x8*)(kts + (dt * 16 + q) * 136 + kq * 32 + 8 * g);
        float* dst = (float*)(P.ws + WS_HGU) + ((size_t)(bh * 2 + wdir) * 32 + n) * 4096;
#pragma unroll
        for (int et = 0; et < 4; ++et) {
            f32x4 acc = {0.f, 0.f, 0.f, 0.f};
#pragma unroll
            for (int kq = 0; kq < 4; ++kq) { const bf16x8 bfr = *(const LAS bf16x8*)(Vt + (et * 16 + q) * 136 + kq * 32 + 8 * g); acc = MFMA32(afr[kq], bfr, acc); }
#pragma unroll
            for (int j = 0; j < 4; ++j) dst[(dt * 16 + 4 * g + j) * 64 + et * 16 + q] = acc[j];
        }
    }
    __syncthreads();
}
__device__ __forceinline__ void hg_scan(const Params& P) {
    float* U = (float*)(P.ws + WS_HGU); const float* A = (const float*)(P.ws + WS_HGA);
    for (int it = blockIdx.x * NTHREADS + opaque_tid(); it < 64 * 64 * 16; it += gridDim.x * NTHREADS) {
        const int e4 = it & 15, d = (it >> 4) & 63, bd = it >> 10, dir = bd & 1;
        f32x4 s = {0.f, 0.f, 0.f, 0.f};
        for (int i0 = 0; i0 < 32; i0 += 8) {
            f32x4 v[8]; float a[8];
#pragma unroll
            for (int i = 0; i < 8; ++i) { const int n = dir ? 31 - (i0 + i) : (i0 + i); v[i] = *(const f32x4*)(U + ((size_t)(bd * 32 + n) * 64 + d) * 64 + 4 * e4); a[i] = A[(size_t)(bd * 32 + n) * 64 + d]; }
#pragma unroll
            for (int i = 0; i < 8; ++i) { const int n = dir ? 31 - (i0 + i) : (i0 + i); *(f32x4*)(U + ((size_t)(bd * 32 + n) * 64 + d) * 64 + 4 * e4) = s; s = s * a[i] + v[i]; }
        }
    }
}
__device__ __forceinline__ void hgB_unit(const Params& P, LAS unsigned char* lds, int u, int layer) {
    const int tid = opaque_tid(), lane = tid & 63, wave = __builtin_amdgcn_readfirstlane(tid >> 6), q = lane & 15, g = lane >> 4;
    const int b = u >> 5, n = u & 31;
    const bf16_t* proj = (const bf16_t*)(P.ws + WS_PROJ);
    LAS bf16_t* Qi = (LAS bf16_t*)lds;
    LAS bf16_t* Ki = (LAS bf16_t*)(lds + 36864);
    LAS float* Al = (LAS float*)(lds + 73728);
    LAS bf16_t* Vt = (LAS bf16_t*)(lds + 77824);
    LAS float* obuf = (LAS float*)(lds + 95232);
    LAS float* ssq = (LAS float*)(lds + 130048);
    const size_t tokc = (size_t)(b * SEQ + n * 128);
    bf16_t* mixed = (bf16_t*)(P.ws + WS_HBUF);
    if (tid < 128) ssq[tid] = 0.f;
    for (int h = 0; h < 4; ++h) {
        const int bh = b * 4 + h;
        {
            const int c = tid >> 2, qd = tid & 3; const bf16_t* src = proj + (tokc + c) * INW + C_HI + h * 64 + qd * 16;
            const u32x4 v0 = *(const u32x4*)src, v1 = *(const u32x4*)(src + 8);
#pragma unroll
            for (int e = 0; e < 8; ++e) { const unsigned vw = e < 4 ? v0[e & 3] : v1[e & 3]; const int d = qd * 16 + 2 * e;
                Vt[d * 136 + c] = (bf16_t)(vw & 0xffffu); Vt[(d + 1) * 136 + c] = (bf16_t)(vw >> 16); }
        }
        {
            const int d = tid & 63, sc = tid >> 6;
            const float lbv = ((const float*)(P.ws + WS_LB))[layer * 256 + h * 64 + d];
            const bf16_t* base = proj + (tokc + sc * 16) * INW + h * 64 + d;
            bf16_t qr[16], zf[16], zb[16];
#pragma unroll
            for (int i = 0; i < 16; ++i) { qr[i] = base[(size_t)i * INW + C_HQ]; zf[i] = base[(size_t)i * INW + C_HZF]; zb[i] = base[(size_t)i * INW + C_HZB]; }
            float qv[16];
#pragma unroll
            for (int i = 0; i < 16; ++i) qv[i] = siluf(bf2f(qr[i]));
            float bp = 1.f;
#pragma unroll
            for (int i = 0; i < 16; ++i) { float f, kk; hgrn_gate(bf2f(zf[i]), lbv, f, kk); bp *= f;
                Qi[(sc * 16 + i) * 72 + d] = f2bf(qv[i] * bp); Ki[(sc * 16 + i) * 72 + d] = f2bf(kk * __builtin_amdgcn_rcpf(fmaxf(bp, 1.0e-30f))); }
            Al[sc * 64 + d] = bp;
            bp = 1.f;
#pragma unroll
            for (int i = 15; i >= 0; --i) { float f, kk; hgrn_gate(bf2f(zb[i]), lbv, f, kk); bp *= f;
                Qi[128 * 72 + (sc * 16 + i) * 72 + d] = f2bf(qv[i] * bp); Ki[128 * 72 + (sc * 16 + i) * 72 + d] = f2bf(kk * __builtin_amdgcn_rcpf(fmaxf(bp, 1.0e-30f))); }
            Al[512 + sc * 64 + d] = bp;
        }
        __syncthreads();
        const int dir = wave >> 2, et = wave & 3;
        const LAS bf16_t* Qd = Qi + dir * (128 * 72); const LAS bf16_t* Kd = Ki + dir * (128 * 72); const LAS float* Ald = Al + dir * 512;
        f32x4 S[4];
        {
            const float* sp = (const float*)(P.ws + WS_HGU) + ((size_t)(bh * 2 + dir) * 32 + n) * 4096;
#pragma unroll
            for (int dt = 0; dt < 4; ++dt)
#pragma unroll
                for (int j = 0; j < 4; ++j) S[dt][j] = sp[(dt * 16 + 4 * g + j) * 64 + et * 16 + q];
        }
        f32x4 outv[8];
#pragma unroll
        for (int i = 0; i < 8; ++i) {
            const int sc = dir ? 7 - i : i;
            f32x4 o = {0.f, 0.f, 0.f, 0.f};
#pragma unroll
            for (int dt = 0; dt < 4; ++dt) { const bf16x4 a4 = pk4(S[dt]); const bf16x4 b4 = *(const LAS bf16x4*)(Qd + (sc * 16 + q) * 72 + dt * 16 + 4 * g); o = MFMA16(a4, b4, o); }
            f32x4 at = {0.f, 0.f, 0.f, 0.f};
#pragma unroll
            for (int kq = 0; kq < 2; ++kq) { const bf16x8 a8 = *(const LAS bf16x8*)(Kd + (sc * 16 + q) * 72 + kq * 32 + 8 * g), b8 = *(const LAS bf16x8*)(Qd + (sc * 16 + q) * 72 + kq * 32 + 8 * g); at = MFMA32(a8, b8, at); }
#pragma unroll
            for (int j = 0; j < 4; ++j) { const int sl = 4 * g + j; const bool keep = dir ? (sl >= q) : (sl <= q); at[j] = keep ? at[j] : 0.f; }
            const bf16x4 p4 = pk4(at);
            const bf16x4 v4 = *(const LAS bf16x4*)(Vt + (et * 16 + q) * 136 + sc * 16 + 4 * g);
            o = MFMA16(v4, p4, o);
            outv[i] = o;
#pragma unroll
            for (int dt = 0; dt < 4; ++dt) {
                u32x2 kw; const LAS bf16_t* kp = Kd + (sc * 16 + 4 * g) * 72 + dt * 16 + q;
                kw.x = (unsigned)kp[0] | ((unsigned)kp[72] << 16); kw.y = (unsigned)kp[144] | ((unsigned)kp[216] << 16);
                f32x4 s2 = MFMA16(__builtin_bit_cast(bf16x4, kw), v4, S[dt]);
                const f32x4 al = *(const LAS f32x4*)(Ald + sc * 64 + dt * 16 + 4 * g);
                S[dt] = s2 * al;
            }
        }
        if (dir == 1) {
#pragma unroll
            for (int i = 0; i < 8; ++i) *(LAS f32x4*)(obuf + ((7 - i) * 16 + q) * 68 + et * 16 + 4 * g) = outv[i];
        }
        __syncthreads();
        if (dir == 0) {
#pragma unroll
            for (int i = 0; i < 8; ++i) {
                const int tau = i * 16 + q; const f32x4 ob = *(const LAS f32x4*)(obuf + tau * 68 + et * 16 + 4 * g); const f32x4 t = outv[i] + ob;
                float sq = (t[0] * t[0] + t[1] * t[1]) + (t[2] * t[2] + t[3] * t[3]);
                sq += __shfl_xor(sq, 16); sq += __shfl_xor(sq, 32);
                if (g == 0) atomicAdd((float*)(ssq + tau), sq);
                *(bf16x4*)(mixed + (tokc + tau) * DM + 768 + h * 64 + et * 16 + 4 * g) = pk4(t);
            }
        }
        __syncthreads();
    }
    __threadfence();
    __syncthreads();
    {
        const int tau = tid >> 2, qd = tid & 3;
        const float rstd = rsqrtf(ssq[tau] * (1.0f / 256.0f) + NORM_EPS);
        bf16_t* mp = mixed + (tokc + tau) * DM + 768 + qd * 64; const bf16_t* gp = proj + (tokc + tau) * INW + C_HG + qd * 64; const float* gn = P.hgrn_gn + layer * 256 + qd * 64;
#pragma unroll
        for (int c8 = 0; c8 < 8; ++c8) {
            const u32x4 ov = *(const u32x4*)(mp + c8 * 8), gv = *(const u32x4*)(gp + c8 * 8); const f32x4 g0 = *(const f32x4*)(gn + c8 * 8), g1 = *(const f32x4*)(gn + c8 * 8 + 4);
            u32x4 r;
            r.x = pk2(bflo(ov.x) * rstd * g0[0] * siluf(bflo(gv.x)), bfhi(ov.x) * rstd * g0[1] * siluf(bfhi(gv.x)));
            r.y = pk2(bflo(ov.y) * rstd * g0[2] * siluf(bflo(gv.y)), bfhi(ov.y) * rstd * g0[3] * siluf(bfhi(gv.y)));
            r.z = pk2(bflo(ov.z) * rstd * g1[0] * siluf(bflo(gv.z)), bfhi(ov.z) * rstd * g1[1] * siluf(bfhi(gv.z)));
            r.w = pk2(bflo(ov.w) * rstd * g1[2] * siluf(bflo(gv.w)), bfhi(ov.w) * rstd * g1[3] * siluf(bfhi(gv.w)));
            *(u32x4*)(mp + c8 * 8) = r;
        }
    }
    __syncthreads();
}
constexpr int N_PHASES = 20;
#ifndef PROBE_MASK
#define PROBE_MASK 0u
#endif
#ifndef PROBE_U
#define PROBE_U 0
#endif
#ifndef PROBE_SYNC2
#define PROBE_SYNC2 0
#endif
__device__ __forceinline__ void run_phase(const Params& P, LAS unsigned char* lds, int ph) {
    unsigned char* ws = P.ws;
    if (ph == 0) { phase_prologue(P, lds); return; }
    if (ph == N_PHASES - 1) { phase_norm_final(P.out, P.g_final); return; }
    const int l = (ph - 1) / 9, s = (ph - 1) % 9;
    const float* mod = (const float*)(ws + WS_MOD) + (size_t)l * NBATCH * NMOD * DM;
    bf16_t* hbuf = (bf16_t*)(ws + WS_HBUF); bf16_t* proj = (bf16_t*)(ws + WS_PROJ);
#ifdef PH_ONLY
    if (s != PH_ONLY) return;
#endif
    int kD = DM, kF = FFN; asm volatile("" : "+s"(kD), "+s"(kF));
    switch (s) {
    case 0: phase_norm_mod(l == 0 ? P.x : P.out, P.g_mix + l * DM, mod + 0 * DM, mod + 1 * DM, hbuf); break;
    case 1: { pg8::Gemm g{hbuf, (const bf16_t*)(ws + WS_WIN) + (size_t)l * INWP * DM, NTOK, INWP, kD}; pg8::StaticOrder S; S.init(NTOK, INWP, gridDim.x, blockIdx.x);
              EpiProj E{proj}; pg8::gemm_phase<EpiProj, pg8::StaticOrder>(lds, g, S, E, nullptr); } break;
    case 2: { for (int rp = 0; rp < (PROBE_U == 1 ? 2 : 1); ++rp) att_phase(P, lds);
              for (int rp = 0; rp < (PROBE_U == 2 ? 2 : 1); ++rp) for (int u = blockIdx.x; u < 1536; u += gridDim.x) retA_unit(P, lds, u);
              for (int rp = 0; rp < (PROBE_U == 3 ? 2 : 1); ++rp) for (int u = blockIdx.x; u < 1024; u += gridDim.x) hgA_unit(P, lds, u, l); } break;
    case 3: { ret_scan(P); hg_scan(P); att_merge(P); } break;
    case 4: { for (int rp = 0; rp < (PROBE_U == 4 ? 2 : 1); ++rp) for (int u = blockIdx.x; u < 256; u += gridDim.x) hgB_unit(P, lds, u, l);
              for (int rp = 0; rp < (PROBE_U == 5 ? 2 : 1); ++rp) for (int u = blockIdx.x; u < 1536; u += gridDim.x) retB_unit(P, lds, u, l); } break;
    case 5: { pg8::Gemm g{hbuf, (const bf16_t*)(ws + WS_WOUT) + (size_t)l * DM * DM, NTOK, DM, kD}; pg8::StaticOrder S; S.init(NTOK, DM, gridDim.x, blockIdx.x);
              EpiRes E{l == 0 ? P.x : P.out, P.out, mod + 2 * DM}; pg8::gemm_phase<EpiRes, pg8::StaticOrder>(lds, g, S, E, nullptr); } break;
    case 6: phase_norm_mod(P.out, P.g_ffn + l * DM, mod + 3 * DM, mod + 4 * DM, hbuf); break;
    case 7: { pg8::Gemm g{hbuf, (const bf16_t*)(ws + WS_WGU) + (size_t)l * 2 * FFN * DM, NTOK, 2 * FFN, kD}; pg8::StaticOrder S; S.init(NTOK, 2 * FFN, gridDim.x, blockIdx.x);
              EpiSwiglu E{proj}; pg8::gemm_phase<EpiSwiglu, pg8::StaticOrder>(lds, g, S, E, nullptr); } break;
    case 8: { pg8::Gemm g{proj, (const bf16_t*)(ws + WS_WDN) + (size_t)l * DM * FFN, NTOK, DM, kF}; pg8::StaticOrder S; S.init(NTOK, DM, gridDim.x, blockIdx.x);
              EpiRes E{P.out, P.out, mod + 5 * DM}; pg8::gemm_phase<EpiRes, pg8::StaticOrder>(lds, g, S, E, nullptr); } break;
    }
}
__global__ void __launch_bounds__(NTHREADS) hybrid_fwd(Params P) {
    extern __shared__ __attribute__((aligned(16))) unsigned char lds_raw[];
    __shared__ uint4 xb_words;
    LAS unsigned char* lds = (LAS unsigned char*)lds_raw;
    if (threadIdx.x == 0) xb_words = make_uint4(0u, 0u, 0u, 0u);
    __syncthreads();
    XcdBarrier bar = xcd_barrier_post((unsigned*)(P.ws + WS_CTL), (volatile LAS unsigned*)&xb_words);
    for (int ph = P.ph_lo; ph < P.ph_hi; ++ph) {
        const int reps = ((PROBE_MASK >> ph) & 1u) ? 2 : 1;
        for (int rep = 0; rep < reps; ++rep) { run_phase(P, lds, ph); if (rep + 1 < reps) __syncthreads(); }
        if (ph + 1 < P.ph_hi) {
            if (ph == P.ph_lo) cg::this_grid().sync(); else xcd_barrier(bar);
            if (PROBE_SYNC2) xcd_barrier(bar);
        }
    }
}

extern "C" void kernel_launch(void* const* d_in, const int* in_sizes, int n_in, void* d_out, int out_size, void* d_ws, size_t ws_size, hipStream_t stream) {
    static int grid = 0;
    if (grid == 0) {
        if (n_in != 14 || out_size != NTOK * DM || ws_size < WS_END) { fprintf(stderr, "kernel_launch: unexpected shapes (n_in %d out %d ws %zu need %zu)\n", n_in, out_size, ws_size, (size_t)WS_END); grid = -1; return; }
        int dev = 0, cus = 0, per_cu = 0;
        hipGetDevice(&dev); hipDeviceGetAttribute(&cus, hipDeviceAttributeMultiprocessorCount, dev);
        if (hipFuncSetAttribute((const void*)hybrid_fwd, hipFuncAttributeMaxDynamicSharedMemorySize, LDS_BYTES) != hipSuccess) { fprintf(stderr, "kernel_launch: hipFuncSetAttribute failed\n"); grid = -1; return; }
        if (hipOccupancyMaxActiveBlocksPerMultiprocessor(&per_cu, (const void*)hybrid_fwd, NTHREADS, LDS_BYTES) != hipSuccess || per_cu < 1) { fprintf(stderr, "kernel_launch: occupancy query says %d\n", per_cu); grid = -1; return; }
        grid = cus;
    }
    if (grid < 0) return;
    if (hipMemsetAsync((char*)d_ws + WS_CTL, 0, 16384, stream) != hipSuccess) { fprintf(stderr, "kernel_launch: memset failed\n"); return; }
    Params p{};
    p.x = (const float*)d_in[0]; p.c = (const float*)d_in[1]; p.w_ada = (const float*)d_in[2]; p.b_ada = (const float*)d_in[3]; p.g_mix = (const float*)d_in[4];
    p.w_in = (const float*)d_in[5]; p.ret_gn = (const float*)d_in[6]; p.hgrn_gn = (const float*)d_in[7]; p.lb_logits = (const float*)d_in[8]; p.w_out = (const float*)d_in[9];
    p.g_ffn = (const float*)d_in[10]; p.w_gu = (const float*)d_in[11]; p.w_down = (const float*)d_in[12]; p.g_final = (const float*)d_in[13];
    p.out = (float*)d_out; p.ws = (unsigned char*)d_ws;
#if ONE_LAUNCH
    p.ph_lo = 0; p.ph_hi = N_PHASES;
    void* args[] = {&p};
    hipError_t e = hipLaunchCooperativeKernel((const void*)hybrid_fwd, dim3(grid), dim3(NTHREADS), args, LDS_BYTES, stream);
    if (e != hipSuccess) fprintf(stderr, "cooperative launch failed: %s (grid %d)\n", hipGetErrorString(e), grid);
#else
    for (int ph = 0; ph < N_PHASES; ++ph) { p.ph_lo = ph; p.ph_hi = ph + 1; hipLaunchKernelGGL(hybrid_fwd, dim3(grid), dim3(NTHREADS), LDS_BYTES, stream, p); }
#endif
}
```

```cpp
#include <hip/hip_runtime.h>
#include <hip/hip_cooperative_groups.h>
#include <cstdio>
#include <cstdint>
namespace cg = cooperative_groups;
#ifndef ONE_LAUNCH
#define ONE_LAUNCH 1
#endif
__device__ __forceinline__ int opaque_tid() { int t = threadIdx.x; asm volatile("" : "+v"(t)); return t; }
#define LAS __attribute__((address_space(3)))
namespace pg8 {
#define PG8_LAS __attribute__((address_space(3)))
typedef unsigned short bf16_t;
typedef short bf16x8 __attribute__((ext_vector_type(8)));
typedef float f32x4 __attribute__((ext_vector_type(4)));
typedef unsigned u32x4 __attribute__((ext_vector_type(4)));
constexpr int BM = 256, BK = 64, HALF = 128, HTB = HALF * BK * 2  , STAGE_BYTES = 8 * HTB, NXCD = 8, WGM = 8;

__host__ __device__ __forceinline__ int lds_byte(int r, int c) { const int st = (r >> 4) * 2 + (c >> 5), rr = r & 15, cc = c & 31, ob = rr * 64 + cc * 2; return st * 1024 + (ob ^ (((ob >> 9) & 1) << 5)); }
__host__ __device__ __forceinline__ void stage_rc(int b, int& R, int& C) { const int st = b / 1024, sb = b % 1024, swz = sb ^ (((sb >> 9) & 1) << 5); R = (st >> 1) * 16 + swz / 64; C = (st & 1) * 32 + (swz % 64) / 2; }
__host__ __device__ __forceinline__ int perm32(int rho) { const int n = rho >> 4, i = rho & 15; return 8 * (i >> 2) + 4 * n + (i & 3); }

struct Unit { int pm, pn; };
struct Gemm { const bf16_t* A; const bf16_t* Bt; int M, N, K; };

struct StaticOrder {
    int nM, nN, nwg, G, c;
    __host__ __device__ void init(int M, int N, int G_, int c_) { nM = M / BM; nN = N / BM; nwg = nM * nN; G = G_; c = c_; }
    __host__ __device__ bool next(int i, Unit& u) const {
        const long L = (long)i * G + c; if (L >= nwg) return false;
        int wgid = (int)L; { const int q = nwg / NXCD, r = nwg % NXCD, xcd = wgid % NXCD, off = wgid / NXCD; wgid = (xcd < r ? xcd * (q + 1) : r * (q + 1) + (xcd - r) * q) + off; }
        const int nig = WGM * nN, gid = wgid / nig, fm = gid * WGM, gsz = (nM - fm) < WGM ? (nM - fm) : WGM;
        u.pm = fm + ((wgid % nig) % gsz); u.pn = (wgid % nig) / gsz; return true;
    }
    __device__ __forceinline__ void a_ready(const Unit&) const {}
    __device__ __forceinline__ void done(const Unit&) const {}
};
__device__ __forceinline__ unsigned cvt_pk_bf16(float lo, float hi) { unsigned r; asm volatile("v_cvt_pk_bf16_f32 %0, %1, %2" : "=v"(r) : "v"(lo), "v"(hi)); return r; }
typedef float f32x2 __attribute__((ext_vector_type(2)));
template <class Epi, class Sched, bool STAMP = false>
__device__ __forceinline__ void gemm_phase(PG8_LAS unsigned char* lds, const Gemm g, const Sched& S, const Epi& E, unsigned long long* stamps) {
    const int tid = opaque_tid(), wid = __builtin_amdgcn_readfirstlane(tid >> 6), lane = tid & 63, wr = wid >> 2, wc = wid & 3, fr = lane & 15, fq = lane >> 4;
    const int K = g.K, nt = K / BK;
    int ts_lo = 0, ts_hi = 0, nts = 0; const unsigned long long rt_entry = STAMP ? (unsigned long long)wall_clock64() : 0ull;
#define PG8_STAMP() do { if (STAMP && wid == 0 && nts < 64) { const unsigned long long _c = (unsigned long long)clock64(); \
        ts_lo = (lane == nts) ? (int)(unsigned)_c : ts_lo; ts_hi = (lane == nts) ? (int)(unsigned)(_c >> 32) : ts_hi; ++nts; } } while (0)
    PG8_STAMP();
    unsigned voffA[2], voffB[2];
#pragma unroll
    for (int i = 0; i < 2; ++i) { int R, C; stage_rc(tid * 16 + i * 8192, R, C); const int Rb = Epi::PERM ? ((R & ~31) + perm32(R & 31)) : R;
        voffA[i] = (unsigned)(R * K + C) * 2u; voffB[i] = (unsigned)(Rb * K + C) * 2u; }
    const size_t kstep = (size_t)(BK * 2);
    const size_t hstep = (size_t)HALF * K * 2;
    const size_t tstep = 2 * hstep;
    const unsigned ldsw = (unsigned)wid * 1024u;
    const int aoff = lds_byte(wr * 64 + fr, fq * 8), boff = lds_byte(wc * 32 + fr, fq * 8);
#define PG8_SA(b, h) (((b) * 2 + (h)) * HTB)
#define PG8_SB(b, h) ((4 + (b) * 2 + (h)) * HTB)
#define PG8_STAGE(bufoff, gbase, voff) do { _Pragma("unroll") for (int _i = 0; _i < 2; ++_i) \
        __builtin_amdgcn_global_load_lds((const unsigned*)((const char*)(gbase) + (voff)[_i]), (PG8_LAS unsigned*)(lds + (bufoff) + ldsw + _i * 8192), 16, 0, 0); } while (0)
#define PG8_LDA(dst, b, h) do { _Pragma("unroll") for (int m = 0; m < 4; ++m) _Pragma("unroll") for (int k = 0; k < 2; ++k) dst[m][k] = *(const PG8_LAS bf16x8*)(lds + PG8_SA(b, h) + aoff + m * 2048 + k * 1024); } while (0)
#define PG8_LDB(dst, b, h) do { _Pragma("unroll") for (int n = 0; n < 2; ++n) _Pragma("unroll") for (int k = 0; k < 2; ++k) dst[n][k] = *(const PG8_LAS bf16x8*)(lds + PG8_SB(b, h) + boff + n * 2048 + k * 1024); } while (0)
#define PG8_MMA(ai, bj, At, Bt) do { __builtin_amdgcn_s_setprio(1); _Pragma("unroll") for (int m = 0; m < 4; ++m) _Pragma("unroll") for (int n = 0; n < 2; ++n) _Pragma("unroll") for (int k = 0; k < 2; ++k) \
        acc[ai][bj][m][n] = __builtin_amdgcn_mfma_f32_16x16x32_bf16(Bt[n][k], At[m][k], acc[ai][bj][m][n], 0, 0, 0); __builtin_amdgcn_s_setprio(0); } while (0)
#define PG8_WAIT_V(n) asm volatile("s_waitcnt vmcnt(" #n ")" ::: "memory")
#define PG8_WAIT_L(n) asm volatile("s_waitcnt lgkmcnt(" #n ")" ::: "memory")
#define PG8_BAR __builtin_amdgcn_s_barrier()
#define PG8_SCHED __builtin_amdgcn_sched_barrier(0)
    Unit cur, nxt; int ui = 0;
    if (!S.next(0, cur)) return;
    f32x4 acc[2][2][4][2];
#pragma unroll
    for (int a = 0; a < 2; ++a)
#pragma unroll
        for (int b = 0; b < 2; ++b)
#pragma unroll
            for (int m = 0; m < 4; ++m)
#pragma unroll
                for (int n = 0; n < 2; ++n) acc[a][b][m][n] = (f32x4){0.f, 0.f, 0.f, 0.f};
    bf16x8 At[4][2], B0[2][2], B1[2][2];
    const char* cA = (const char*)g.A + (size_t)cur.pm * tstep; const char* cB = (const char*)g.Bt + (size_t)cur.pn * tstep;
    S.a_ready(cur);
    PG8_STAGE(PG8_SB(0, 0), cB, voffB); PG8_STAGE(PG8_SA(0, 0), cA, voffA); PG8_STAGE(PG8_SB(0, 1), cB + hstep, voffB); PG8_STAGE(PG8_SA(0, 1), cA + hstep, voffA);
    if (wr == 1) PG8_BAR;
    PG8_WAIT_V(4); PG8_BAR;
    PG8_STAGE(PG8_SB(1, 0), cB + kstep, voffB); PG8_STAGE(PG8_SA(1, 0), cA + kstep, voffA); PG8_STAGE(PG8_SB(1, 1), cB + hstep + kstep, voffB);
    PG8_WAIT_V(6); PG8_BAR;
    PG8_STAMP();
    for (;;) {
        const bool has_next = S.next(ui + 1, nxt);
        const char* nA = has_next ? (const char*)g.A + (size_t)nxt.pm * tstep : cA; const char* nB = has_next ? (const char*)g.Bt + (size_t)nxt.pn * tstep : cB;
        for (int t = 0; t < nt; t += 2) {
            const bool last = (t == nt - 2);
            const char* a1 = cA + (size_t)(t + 1) * kstep;
            const char* a2 = last ? nA : cA + (size_t)(t + 2) * kstep; const char* b2 = last ? nB : cB + (size_t)(t + 2) * kstep;
            const char* a3 = a2 + kstep; const char* b3 = b2 + kstep;
            if (last && has_next) S.a_ready(nxt);
            PG8_LDB(B0, 0, 0); PG8_SCHED; PG8_LDA(At, 0, 0); PG8_STAGE(PG8_SA(1, 1), a1 + hstep, voffA);
            PG8_WAIT_L(8); PG8_BAR; PG8_WAIT_L(0); PG8_MMA(0, 0, At, B0); PG8_BAR; PG8_SCHED;
            PG8_LDB(B1, 0, 1); PG8_STAGE(PG8_SB(0, 0), b2, voffB);
            PG8_BAR; PG8_WAIT_L(0); PG8_MMA(0, 1, At, B1); PG8_BAR;
            PG8_LDA(At, 0, 1); PG8_STAGE(PG8_SA(0, 0), a2, voffA);
            PG8_BAR; PG8_WAIT_L(0); PG8_MMA(1, 0, At, B0); PG8_BAR; PG8_SCHED;
            PG8_STAGE(PG8_SB(0, 1), b2 + hstep, voffB);
            PG8_WAIT_V(6); PG8_BAR; PG8_MMA(1, 1, At, B1); PG8_BAR;
            PG8_LDB(B0, 1, 0); PG8_SCHED; PG8_LDA(At, 1, 0); PG8_STAGE(PG8_SA(0, 1), a2 + hstep, voffA);
            PG8_WAIT_L(8); PG8_BAR; PG8_WAIT_L(0); PG8_MMA(0, 0, At, B0); PG8_BAR; PG8_SCHED;
            PG8_LDB(B1, 1, 1); PG8_STAGE(PG8_SB(1, 0), b3, voffB);
            PG8_BAR; PG8_WAIT_L(0); PG8_MMA(0, 1, At, B1); PG8_BAR;
            PG8_LDA(At, 1, 1); PG8_STAGE(PG8_SA(1, 0), a3, voffA);
            PG8_BAR; PG8_WAIT_L(0); PG8_MMA(1, 0, At, B0); PG8_BAR; PG8_SCHED;
            PG8_STAGE(PG8_SB(1, 1), b3 + hstep, voffB);
            PG8_WAIT_V(6); PG8_BAR; PG8_MMA(1, 1, At, B1); PG8_BAR;
        }
        PG8_STAMP();
        if constexpr (!Epi::AFTER_DRAIN) { E(acc, cur, wr, wc, fr, fq); S.done(cur); }
        PG8_STAMP();
        if (!has_next) break;
#pragma unroll
        for (int a = 0; a < 2; ++a)
#pragma unroll
            for (int b = 0; b < 2; ++b)
#pragma unroll
                for (int m = 0; m < 4; ++m)
#pragma unroll
                    for (int n = 0; n < 2; ++n) acc[a][b][m][n] = (f32x4){0.f, 0.f, 0.f, 0.f};
        cur = nxt; cA = nA; cB = nB; ++ui;
    }
    PG8_WAIT_V(0);
    if (wr == 0) PG8_BAR;
    PG8_BAR;
    if constexpr (Epi::AFTER_DRAIN) { E.fused(acc, cur, wr, wc, fr, fq, lds, wid, lane); S.done(cur); }
    PG8_STAMP();
    if (STAMP && wid == 0) { stamps[lane] = lane < nts ? (((unsigned long long)(unsigned)ts_hi << 32) | (unsigned)ts_lo) : 0ull;
        if (lane == 62) stamps[62] = rt_entry; if (lane == 63) stamps[63] = (unsigned long long)wall_clock64(); }
#undef PG8_STAMP
#undef PG8_SA
#undef PG8_SB
#undef PG8_STAGE
#undef PG8_LDA
#undef PG8_LDB
#undef PG8_MMA
#undef PG8_WAIT_V
#undef PG8_WAIT_L
#undef PG8_BAR
#undef PG8_SCHED
}
}
#define XB_TMO      128
#define XB_XCNT(j)  (256  + 64 * (j))
#define XB_XSUB(j)  (1280 + 64 * (j))
#define XB_XGEN(j)  (2304 + 64 * (j))
#define XB_TOP      3328
#define XB_TOPGEN   3392
#define XCD_BAR_WORDS 3456
#define XB_SPIN_CAP (1u << 18)

__device__ __forceinline__ unsigned xb_ld(unsigned* p)              { return __hip_atomic_load(p, __ATOMIC_RELAXED, __HIP_MEMORY_SCOPE_AGENT); }
__device__ __forceinline__ unsigned xb_add(unsigned* p, unsigned v) { return __hip_atomic_fetch_add(p, v, __ATOMIC_RELAXED, __HIP_MEMORY_SCOPE_AGENT); }
__device__ __forceinline__ unsigned xb_xcc_id() { return (unsigned)__builtin_amdgcn_s_getreg((3 << 11) | 20) & 0xFu; }
#define XB_SPIN(cond, bar) do { unsigned _sp = 0; while (cond) { __builtin_amdgcn_s_sleep(1); \
    if ((++_sp & 255u) == 0u) { if (xb_ld(&(bar)[XB_TMO])) break; if (_sp > XB_SPIN_CAP) { atomicAdd(&(bar)[XB_TMO], 1u); break; } } } } while (0)

struct XcdBarrier {
    unsigned* bar; unsigned x;
    volatile LAS unsigned* st;
};

__device__ __forceinline__ XcdBarrier xcd_barrier_post(unsigned* bar, volatile LAS unsigned* st) {
    XcdBarrier b; b.bar = bar; b.x = xb_xcc_id(); b.st = st;
    if (threadIdx.x == 0) (void)xb_add(&bar[XB_XCNT(b.x)], 1u);
    return b;
}
__device__ __forceinline__ void xcd_barrier_complete(unsigned* bar, unsigned x, unsigned& nloc, unsigned& nx) {
    const unsigned G = gridDim.x * gridDim.y * gridDim.z;
    unsigned sum, cnt, mine, sp = 0u;
    for (;;) {
        sum = 0u; cnt = 0u; mine = 0u;
#pragma unroll
        for (unsigned j = 0; j < 16; ++j) { const unsigned c = xb_ld(&bar[XB_XCNT(j)]); sum += c; cnt += (c > 0u) ? 1u : 0u; mine = (j == x) ? c : mine; }
        if (sum == G) break;
        __builtin_amdgcn_s_sleep(1);
        if ((++sp & 255u) == 0u) { if (xb_ld(&bar[XB_TMO])) break; if (sp > XB_SPIN_CAP) { atomicAdd(&bar[XB_TMO], 1u); break; } }
    }
    nloc = mine > 0u ? mine : 1u; nx = cnt > 0u ? cnt : 1u;
}

__device__ __forceinline__ void xcd_barrier(const XcdBarrier& b) {
    asm volatile("s_waitcnt vmcnt(0)" ::: "memory");
    __syncthreads();
    if (threadIdx.x == 0) {
        unsigned* bar = b.bar;
        __builtin_amdgcn_s_waitcnt(0);
        unsigned nloc = b.st[0], nx = b.st[1];
        if (nloc == 0u) { xcd_barrier_complete(bar, b.x, nloc, nx); b.st[0] = nloc; b.st[1] = nx; }
        const unsigned old = xb_add(&bar[XB_XSUB(b.x)], 1u);
        const unsigned gen = old / nloc;
        if (old + 1u == (gen + 1u) * nloc) {
            __builtin_amdgcn_fence(__ATOMIC_RELEASE, "agent");
            asm volatile("s_waitcnt vmcnt(0)" ::: "memory");
            const unsigned og = xb_add(&bar[XB_TOP], 1u);
            const unsigned tg = og / nx;
            if (og + 1u == (tg + 1u) * nx) xb_add(&bar[XB_TOPGEN], 1u);
            else XB_SPIN(xb_ld(&bar[XB_TOPGEN]) == tg, bar);
            __builtin_amdgcn_fence(__ATOMIC_ACQUIRE, "agent");
            xb_add(&bar[XB_XGEN(b.x)], 1u);
            asm volatile("s_waitcnt vmcnt(0)" ::: "memory");
        } else {
            XB_SPIN(xb_ld(&bar[XB_XGEN(b.x)]) == gen, bar);
            __builtin_amdgcn_fence(__ATOMIC_ACQUIRE, "agent");
            asm volatile("s_waitcnt vmcnt(0)" ::: "memory");
        }
    }
    __syncthreads();
}

typedef unsigned short bf16_t;
typedef short bf16x8 __attribute__((ext_vector_type(8)));
typedef short bf16x4 __attribute__((ext_vector_type(4)));
typedef float f32x4 __attribute__((ext_vector_type(4)));
typedef unsigned u32x4 __attribute__((ext_vector_type(4)));
typedef unsigned u32x2 __attribute__((ext_vector_type(2)));
constexpr int DM = 1024, NBATCH = 8, SEQ = 4096, NTOK = NBATCH * SEQ, DEPTH = 2;
constexpr int INW = 3968, INWP = 4096, FFN = 2816, NMOD = 6;
constexpr int C_AQ = 0, C_AK = 384, C_AV = 768, C_RQ = 1152, C_RK = 1536, C_RV = 1920, C_RG = 2304, C_HQ = 2688, C_HZF = 2944, C_HZB = 3200, C_HI = 3456, C_HG = 3712;
constexpr float NORM_EPS = 1e-6f;
constexpr int NTHREADS = 512;
constexpr int LDS_BYTES = 135168;
constexpr size_t WS_CTL = 0, WS_MOD = 16384, WS_LB = WS_MOD + 393216, WS_HGA = WS_LB + 2048, WS_LSE = WS_HGA + 524288, WS_WIN = WS_LSE + 2359296,
    WS_WOUT = WS_WIN + 16777216, WS_WGU = WS_WOUT + 4194304, WS_WDN = WS_WGU + 23068672, WS_HBUF = WS_WDN + 11534336, WS_PROJ = WS_HBUF + 67108864,
    WS_OB = WS_PROJ + 260046848, WS_RST = WS_OB + 75497472, WS_HGU = WS_RST + 25165824, WS_END = WS_HGU + 33554432;

struct Params {
    const float *x, *c, *w_ada, *b_ada, *g_mix, *w_in, *ret_gn, *hgrn_gn, *lb_logits, *w_out, *g_ffn, *w_gu, *w_down, *g_final;
    float* out; unsigned char* ws; int ph_lo, ph_hi;
};

__device__ __forceinline__ float bf2f(bf16_t v) { return __uint_as_float(((unsigned)v) << 16); }
__device__ __forceinline__ float bflo(unsigned w) { return __uint_as_float(w << 16); }
__device__ __forceinline__ float bfhi(unsigned w) { return __uint_as_float(w & 0xffff0000u); }
__device__ __forceinline__ bf16_t f2bf(float f) { unsigned u = __float_as_uint(f); u += 0x7fffu + ((u >> 16) & 1u); return (bf16_t)(u >> 16); }
typedef float f32x2c __attribute__((ext_vector_type(2)));
typedef __bf16 bf16v2c __attribute__((ext_vector_type(2)));
__device__ __forceinline__ unsigned pk2(float lo, float hi) { const f32x2c v = {lo, hi}; return __builtin_bit_cast(unsigned, __builtin_convertvector(v, bf16v2c)); }
__device__ __forceinline__ bf16x4 pk4(f32x4 v) { u32x2 w; w.x = pk2(v[0], v[1]); w.y = pk2(v[2], v[3]); return __builtin_bit_cast(bf16x4, w); }
__device__ __forceinline__ float siluf(float v) { return v / (1.0f + __expf(-v)); }
__device__ __forceinline__ float wave_sum(float v) {
#pragma unroll
    for (int o = 1; o < 64; o <<= 1) v += __shfl_xor(v, o);
    return v;
}
#define MFMA32(a, b, c) __builtin_amdgcn_mfma_f32_16x16x32_bf16((a), (b), (c), 0, 0, 0)
#define MFMA16(a, b, c) __builtin_amdgcn_mfma_f32_16x16x16bf16_1k((a), (b), (c), 0, 0, 0)

struct EpiProj {
    static constexpr bool PERM = true, AFTER_DRAIN = false;
    bf16_t* O;
    __device__ __forceinline__ void operator()(const f32x4 (&acc)[2][2][4][2], const pg8::Unit& u, int wr, int wc, int fr, int fq) const {
        const int row0 = u.pm * 256 + wr * 64 + fr, col0 = u.pn * 256 + wc * 32 + 8 * fq;
#pragma unroll
        for (int ai = 0; ai < 2; ++ai)
#pragma unroll
            for (int m = 0; m < 4; ++m) { bf16_t* rowp = O + (size_t)(row0 + ai * 128 + m * 16) * INW + col0;
#pragma unroll
                for (int bj = 0; bj < 2; ++bj) { if (col0 + bj * 128 < INW) { const f32x4 v0 = acc[ai][bj][m][0], v1 = acc[ai][bj][m][1];
                    u32x4 w; w.x = pk2(v0[0], v0[1]); w.y = pk2(v0[2], v0[3]); w.z = pk2(v1[0], v1[1]); w.w = pk2(v1[2], v1[3]);
                    *(u32x4*)(rowp + bj * 128) = w; } } }
    }
};
struct EpiRes {
    static constexpr bool PERM = false, AFTER_DRAIN = false;
    const float* base; float* out; const float* gate;
    __device__ __forceinline__ void operator()(const f32x4 (&acc)[2][2][4][2], const pg8::Unit& u, int wr, int wc, int fr, int fq) const {
        const int row0 = u.pm * 256 + wr * 64 + fr, col0 = u.pn * 256 + wc * 32 + 4 * fq;
        const float* gp = gate + (size_t)((u.pm * 256) >> 12) * (NMOD * DM) + col0;
        f32x4 gv[2][2];
#pragma unroll
        for (int bj = 0; bj < 2; ++bj)
#pragma unroll
            for (int n = 0; n < 2; ++n) gv[bj][n] = *(const f32x4*)(gp + bj * 128 + n * 16);
#pragma unroll
        for (int ai = 0; ai < 2; ++ai)
#pragma unroll
            for (int m = 0; m < 4; ++m) { const size_t off = (size_t)(row0 + ai * 128 + m * 16) * DM + col0;
#pragma unroll
                for (int bj = 0; bj < 2; ++bj)
#pragma unroll
                    for (int n = 0; n < 2; ++n) { const f32x4 bs = *(const f32x4*)(base + off + bj * 128 + n * 16);
                        *(f32x4*)(out + off + bj * 128 + n * 16) = bs + gv[bj][n] * acc[ai][bj][m][n]; } }
    }
};
struct EpiSwiglu {
    static constexpr bool PERM = true, AFTER_DRAIN = false;
    bf16_t* O;
    __device__ __forceinline__ void operator()(const f32x4 (&acc)[2][2][4][2], const pg8::Unit& u, int wr, int wc, int fr, int fq) const {
        const int row0 = u.pm * 256 + wr * 64 + fr, col0 = u.pn * 128 + wc * 32 + 8 * fq;
#pragma unroll
        for (int ai = 0; ai < 2; ++ai)
#pragma unroll
            for (int m = 0; m < 4; ++m) { bf16_t* rowp = O + (size_t)(row0 + ai * 128 + m * 16) * FFN + col0;
                float r[8];
#pragma unroll
                for (int n = 0; n < 2; ++n)
#pragma unroll
                    for (int i = 0; i < 4; ++i) { const float g = acc[ai][0][m][n][i], uu = acc[ai][1][m][n][i]; r[n * 4 + i] = siluf(g) * uu; }
                u32x4 w; w.x = pk2(r[0], r[1]); w.y = pk2(r[2], r[3]); w.z = pk2(r[4], r[5]); w.w = pk2(r[6], r[7]);
                *(u32x4*)rowp = w; }
    }
};
__device__ __forceinline__ void transpose_item(const float* W, int K, int N, bf16_t* WT, int dst_row0, int src_col0, int k0, LAS float* scr, int lane) {
    if (src_col0 < 0) {
        const int c = lane & 7;
#pragma unroll
        for (int j = 0; j < 4; ++j) { const int n = (lane >> 3) + 8 * j; *(u32x4*)(WT + (size_t)(dst_row0 + n) * K + k0 + 8 * c) = (u32x4){0u, 0u, 0u, 0u}; }
        return;
    }
#pragma unroll 8
    for (int i = 0; i < 32; ++i) { const int kk = 2 * i + (lane >> 5); scr[kk * 33 + (lane & 31)] = W[(size_t)(k0 + kk) * N + src_col0 + (lane & 31)]; }
    __builtin_amdgcn_fence(__ATOMIC_RELEASE, "wavefront"); __builtin_amdgcn_wave_barrier(); __builtin_amdgcn_fence(__ATOMIC_ACQUIRE, "wavefront");
    const int c = lane & 7;
#pragma unroll
    for (int j = 0; j < 4; ++j) { const int n = (lane >> 3) + 8 * j; const LAS float* s = scr + (8 * c) * 33 + n;
        u32x4 o; o.x = pk2(s[0 * 33], s[1 * 33]); o.y = pk2(s[2 * 33], s[3 * 33]); o.z = pk2(s[4 * 33], s[5 * 33]); o.w = pk2(s[6 * 33], s[7 * 33]);
        *(u32x4*)(WT + (size_t)(dst_row0 + n) * K + k0 + 8 * c) = o; }
    __builtin_amdgcn_fence(__ATOMIC_RELEASE, "wavefront"); __builtin_amdgcn_wave_barrier(); __builtin_amdgcn_fence(__ATOMIC_ACQUIRE, "wavefront");
}

__device__ __forceinline__ void phase_prologue(const Params& P, LAS unsigned char* lds) {
    const int tid = opaque_tid(), lane = tid & 63, wave = __builtin_amdgcn_readfirstlane(tid >> 6);
    unsigned char* ws = P.ws;
    {
        LAS float* scr = (LAS float*)(lds + wave * 8704);
        const int gw = blockIdx.x * 8 + wave, NGW = gridDim.x * 8;
        constexpr int I_IN = 16 * 128, I_OUT = 16 * 32, I_GU = 16 * 176, I_DN = 44 * 32, I_L = I_IN + I_OUT + I_GU + I_DN;
        for (int it = gw; it < DEPTH * I_L; it += NGW) {
            const int l = it / I_L; int r = it % I_L;
            if (r < I_IN) { const int kb = r / 128, nb = r % 128, n0 = nb * 32;
                transpose_item(P.w_in + (size_t)l * DM * INW, DM, INW, (bf16_t*)(ws + WS_WIN) + (size_t)l * INWP * DM, n0, n0 < INW ? n0 : -1, kb * 64, scr, lane); continue; }
            r -= I_IN;
            if (r < I_OUT) { const int kb = r / 32, nb = r % 32;
                transpose_item(P.w_out + (size_t)l * DM * DM, DM, DM, (bf16_t*)(ws + WS_WOUT) + (size_t)l * DM * DM, nb * 32, nb * 32, kb * 64, scr, lane); continue; }
            r -= I_OUT;
            if (r < I_GU) { const int kb = r / 176, nb = r % 176, n0 = nb * 32; const int pn = n0 >> 8, half = (n0 >> 7) & 1, jj = n0 & 127;
                transpose_item(P.w_gu + (size_t)l * DM * 2 * FFN, DM, 2 * FFN, (bf16_t*)(ws + WS_WGU) + (size_t)l * 2 * FFN * DM, n0, half * FFN + pn * 128 + jj, kb * 64, scr, lane); continue; }
            r -= I_GU;
            { const int kb = r / 32, nb = r % 32;
                transpose_item(P.w_down + (size_t)l * FFN * DM, FFN, DM, (bf16_t*)(ws + WS_WDN) + (size_t)l * DM * FFN, nb * 32, nb * 32, kb * 64, scr, lane); }
        }
    }
    __syncthreads();
    {
        LAS float* sc = (LAS float*)lds;
        LAS float* red = (LAS float*)(lds + 32768);
        for (int i = tid; i < NBATCH * DM; i += NTHREADS) sc[i] = siluf(P.c[i]);
        __syncthreads();
        float* mod = (float*)(ws + WS_MOD);
        for (int u = blockIdx.x; u < DEPTH * 96; u += gridDim.x) {
            const int l = u / 96, j0 = (u % 96) * 64, col = tid & 63, kp = tid >> 6;
            float acc[8];
#pragma unroll
            for (int b = 0; b < 8; ++b) acc[b] = 0.f;
            const float* wp = P.w_ada + (size_t)l * DM * (NMOD * DM) + j0 + col;
            for (int k = kp * 128; k < kp * 128 + 128; ++k) { const float w = wp[(size_t)k * (NMOD * DM)];
#pragma unroll
                for (int b = 0; b < 8; ++b) acc[b] += sc[b * DM + k] * w; }
#pragma unroll
            for (int b = 0; b < 8; ++b) red[(kp * 8 + b) * 64 + col] = acc[b];
            __syncthreads();
            { const int b = tid >> 6; float s = 0.f;
#pragma unroll
              for (int p = 0; p < 8; ++p) s += red[(p * 8 + b) * 64 + col];
              mod[((size_t)l * NBATCH + b) * (NMOD * DM) + j0 + col] = s + P.b_ada[(size_t)l * NMOD * DM + j0 + col]; }
            __syncthreads();
        }
    }
    if (blockIdx.x == 0 && tid < 256) {
        const float l0 = P.lb_logits[tid], l1 = P.lb_logits[256 + tid], m = fmaxf(l0, l1), e0 = __expf(l0 - m), e1 = __expf(l1 - m);
        const float p0 = e0 / (e0 + e1), p1 = e1 / (e0 + e1);
        float* lb = (float*)(ws + WS_LB);
        lb[tid] = fminf(fmaxf(p0 - p0, 0.f), 1.0f - 1e-6f);
        lb[256 + tid] = fminf(fmaxf((p0 + p1) - p0, 0.f), 1.0f - 1e-6f);
    }
}

__device__ __forceinline__ void phase_norm_mod(const float* src, const float* g, const float* shift, const float* scale, bf16_t* dst) {
    const int tid = opaque_tid(), lane = tid & 63, wave = tid >> 6;
    const int gw = blockIdx.x * 8 + wave, NGW = gridDim.x * 8;
    f32x4 gv[4];
#pragma unroll
    for (int j = 0; j < 4; ++j) gv[j] = *(const f32x4*)(g + 4 * lane + 256 * j);
    for (int row = gw; row < NTOK; row += NGW) {
        const int b = row >> 12;
        const f32x4* xr = (const f32x4*)(src + (size_t)row * DM) + lane;
        f32x4 v[4]; float s = 0.f;
#pragma unroll
        for (int j = 0; j < 4; ++j) { v[j] = xr[64 * j]; s += (v[j][0] * v[j][0] + v[j][1] * v[j][1]) + (v[j][2] * v[j][2] + v[j][3] * v[j][3]); }
        const float rstd = rsqrtf(wave_sum(s) * (1.0f / DM) + NORM_EPS);
        unsigned long long* o8 = (unsigned long long*)(dst + (size_t)row * DM) + lane;
#pragma unroll
        for (int j = 0; j < 4; ++j) {
            const f32x4 sc = *(const f32x4*)(scale + (size_t)b * (NMOD * DM) + 4 * lane + 256 * j), sh = *(const f32x4*)(shift + (size_t)b * (NMOD * DM) + 4 * lane + 256 * j);
            const f32x4 h = v[j] * rstd * gv[j] * (sc + 1.0f) + sh;
            o8[64 * j] = (unsigned long long)pk2(h[0], h[1]) | ((unsigned long long)pk2(h[2], h[3]) << 32);
        }
    }
}
__device__ __forceinline__ void phase_norm_final(float* x, const float* g) {
    const int tid = opaque_tid(), lane = tid & 63, wave = tid >> 6;
    const int gw = blockIdx.x * 8 + wave, NGW = gridDim.x * 8;
    f32x4 gv[4];
#pragma unroll
    for (int j = 0; j < 4; ++j) gv[j] = *(const f32x4*)(g + 4 * lane + 256 * j);
    for (int row = gw; row < NTOK; row += NGW) {
        f32x4* xr = (f32x4*)(x + (size_t)row * DM) + lane;
        f32x4 v[4]; float s = 0.f;
#pragma unroll
        for (int j = 0; j < 4; ++j) { v[j] = xr[64 * j]; s += (v[j][0] * v[j][0] + v[j][1] * v[j][1]) + (v[j][2] * v[j][2] + v[j][3] * v[j][3]); }
        const float rstd = rsqrtf(wave_sum(s) * (1.0f / DM) + NORM_EPS);
#pragma unroll
        for (int j = 0; j < 4; ++j) xr[64 * j] = v[j] * rstd * gv[j];
    }
}
__device__ __forceinline__ bf16x4 tr4(const LAS bf16_t* img, int pitch, int row0, int col0, int g, int q) {
    return __builtin_amdgcn_ds_read_tr16_b64_v4i16((LAS bf16x4*)(img + (row0 + 4 * g + (q >> 2)) * pitch + col0 + 4 * (q & 3)));
}
__device__ __forceinline__ bf16x8 tr8(const LAS bf16_t* img, int pitch, int row0, int col0, int g, int q) {
    const bf16x4 lo = __builtin_amdgcn_ds_read_tr16_b64_v4i16((LAS bf16x4*)(img + (row0 + 8 * g + (q >> 2)) * pitch + col0 + 4 * (q & 3)));
    const bf16x4 hi = __builtin_amdgcn_ds_read_tr16_b64_v4i16((LAS bf16x4*)(img + (row0 + 8 * g + 4 + (q >> 2)) * pitch + col0 + 4 * (q & 3)));
    return __builtin_shufflevector(lo, hi, 0, 1, 2, 3, 4, 5, 6, 7);
}
struct AttRegs { u32x4 kv[4], vv[4]; bf16x8 qf[2]; };
__device__ __forceinline__ void att_decode(int u, int& br, int& b, int& h, int& r, int& L, int& p0, int& tok0) {
    br = u / 1536; const int v = u % 1536; b = v / 192; h = (v >> 5) % 6; const int w = v & 31;
    const int lr = br * 2, nblk = 32 >> lr, rho = w / nblk, blk = w % nblk; r = 1 << lr; L = SEQ >> lr; p0 = blk * 128; tok0 = b * SEQ + rho;
}
__device__ __forceinline__ void att_load(const Params& P, int u, int tid, AttRegs& R) {
    int br, b, h, r, L, p0, tok0; att_decode(u, br, b, h, r, L, p0, tok0);
    const bf16_t* proj = (const bf16_t*)(P.ws + WS_PROJ);
    const int key = tid >> 1, half = tid & 1, kj = p0 - 64 + key;
    if (kj >= 0 && kj < L) {
        const bf16_t* src = proj + (size_t)(tok0 + r * kj) * INW + h * 64 + half * 32;
#pragma unroll
        for (int i = 0; i < 4; ++i) { R.kv[i] = *(const u32x4*)(src + C_AK + 8 * i); R.vv[i] = *(const u32x4*)(src + C_AV + 8 * i); }
    } else {
#pragma unroll
        for (int i = 0; i < 4; ++i) { R.kv[i] = (u32x4){0u, 0u, 0u, 0u}; R.vv[i] = (u32x4){0u, 0u, 0u, 0u}; }
    }
    const int lane = tid & 63, wave = tid >> 6, q = lane & 15, g = lane >> 4;
    const size_t tokq = (size_t)(tok0 + r * (p0 + 16 * wave + q));
#pragma unroll
    for (int kk = 0; kk < 2; ++kk) R.qf[kk] = *(const bf16x8*)(proj + tokq * INW + C_AQ + h * 64 + kk * 32 + 8 * g);
}
__device__ __forceinline__ void att_phase(const Params& P, LAS unsigned char* lds) {
    const int tid = opaque_tid(), lane = tid & 63, wave = __builtin_amdgcn_readfirstlane(tid >> 6), q = lane & 15, g = lane >> 4;
    LAS bf16_t* Ks = (LAS bf16_t*)lds;
    LAS bf16_t* Vs = (LAS bf16_t*)(lds + 36864);
    int u = blockIdx.x; if (u >= 4608) return;
    AttRegs R; att_load(P, u, tid, R);
    for (; u < 4608; u += gridDim.x) {
        int br, b, h, r, L, p0, tok0; att_decode(u, br, b, h, r, L, p0, tok0);
        {
            const int key = tid >> 1, half = tid & 1;
#pragma unroll
            for (int i = 0; i < 4; ++i) { *(LAS u32x4*)(Ks + key * 72 + half * 32 + 8 * i) = R.kv[i]; *(LAS u32x4*)(Vs + key * 72 + half * 32 + 8 * i) = R.vv[i]; }
        }
        bf16x8 qf[2]; qf[0] = R.qf[0]; qf[1] = R.qf[1];
        __syncthreads();
        if (u + (int)gridDim.x < 4608) att_load(P, u + gridDim.x, tid, R);
        const int p = p0 + 16 * wave + q; const size_t tokq = (size_t)(tok0 + r * p);
        const float slope_r = exp2f(-8.0f * (float)(h + 1) / 6.0f) * (float)r;
        f32x4 st[9]; float mx = -3.0e38f;
#pragma unroll
        for (int t = 0; t < 9; ++t) {
            f32x4 acc = {0.f, 0.f, 0.f, 0.f};
#pragma unroll
            for (int kk = 0; kk < 2; ++kk) { const bf16x8 a = *(const LAS bf16x8*)(Ks + (16 * wave + 16 * t + q) * 72 + kk * 32 + 8 * g); acc = MFMA32(a, qf[kk], acc); }
#pragma unroll
            for (int j = 0; j < 4; ++j) {
                const int kl = 16 * wave + 16 * t + 4 * g + j, kj = p0 - 64 + kl; int dist = p - kj; dist = dist < 0 ? -dist : dist;
                const bool valid = (kj >= 0) && (kj < L) && (dist <= 64);
                const float s = valid ? acc[j] * 0.125f - slope_r * (float)dist : -1.0e30f;
                acc[j] = s; mx = fmaxf(mx, s);
            }
            st[t] = acc;
        }
        mx = fmaxf(mx, __shfl_xor(mx, 16)); mx = fmaxf(mx, __shfl_xor(mx, 32));
        float ls = 0.f; bf16x4 pt[9];
#pragma unroll
        for (int t = 0; t < 9; ++t) { f32x4 e;
#pragma unroll
            for (int j = 0; j < 4; ++j) { e[j] = (st[t][j] > -1.0e29f) ? __expf(st[t][j] - mx) : 0.f; ls += e[j]; }
            pt[t] = pk4(e); }
        ls += __shfl_xor(ls, 16); ls += __shfl_xor(ls, 32);
        const float inv = 1.0f / ls;
        bf16_t* ob = (bf16_t*)(P.ws + WS_OB) + ((size_t)br * NTOK + tokq) * 384 + h * 64;
        const LAS bf16_t* vrd = Vs + (16 * wave + 4 * g + (q >> 2)) * 72 + 4 * (q & 3);
#pragma unroll
        for (int dt = 0; dt < 4; ++dt) {
            f32x4 acc = {0.f, 0.f, 0.f, 0.f};
#pragma unroll
            for (int t = 0; t < 9; ++t) { const bf16x4 a = __builtin_amdgcn_ds_read_tr16_b64_v4i16((LAS bf16x4*)(vrd + 16 * t * 72 + dt * 16)); acc = MFMA16(a, pt[t], acc); }
            acc = acc * inv;
            *(bf16x4*)(ob + dt * 16 + 4 * g) = pk4(acc);
        }
        if (g == 0) ((float*)(P.ws + WS_LSE))[((size_t)br * NTOK + tokq) * 6 + h] = mx + __logf(ls);
        __syncthreads();
    }
}
__device__ __forceinline__ void att_merge(const Params& P) {
    const bf16_t* ob = (const bf16_t*)(P.ws + WS_OB); const float* lse = (const float*)(P.ws + WS_LSE); bf16_t* mixed = (bf16_t*)(P.ws + WS_HBUF);
    for (size_t it = (size_t)blockIdx.x * NTHREADS + opaque_tid(); it < (size_t)NTOK * 48; it += (size_t)gridDim.x * NTHREADS) {
        const size_t tok = it / 48; const int grp = (int)(it % 48), h = grp >> 3;
        const float l0 = lse[tok * 6 + h], l1 = lse[((size_t)NTOK + tok) * 6 + h], l2 = lse[((size_t)2 * NTOK + tok) * 6 + h];
        const float m = fmaxf(l0, fmaxf(l1, l2)), e0 = __expf(l0 - m), e1 = __expf(l1 - m), e2 = __expf(l2 - m), is = 1.0f / (e0 + e1 + e2);
        const float w0 = e0 * is, w1 = e1 * is, w2 = e2 * is;
        const u32x4 a = *(const u32x4*)(ob + tok * 384 + grp * 8), bq = *(const u32x4*)(ob + ((size_t)NTOK + tok) * 384 + grp * 8), cq = *(const u32x4*)(ob + ((size_t)2 * NTOK + tok) * 384 + grp * 8);
        u32x4 o;
#pragma unroll
        for (int i = 0; i < 4; ++i) o[i] = pk2(w0 * bflo(a[i]) + w1 * bflo(bq[i]) + w2 * bflo(cq[i]), w0 * bfhi(a[i]) + w1 * bfhi(bq[i]) + w2 * bfhi(cq[i]));
        *(u32x4*)(mixed + tok * DM + grp * 8) = o;
    }
}

__device__ __forceinline__ float ret_logg(int h) { return log1pf(-exp2f(-5.0f - (float)h)); }
struct RetARegs { u32x4 k0, k1, v0, v1; };
__device__ __forceinline__ void retA_load(const Params& P, int u, int tid, RetARegs& R) {
    const int bh = u >> 5, n = u & 31, b = bh / 6, h = bh % 6, c = tid >> 2, qd = tid & 3;
    const bf16_t* src = (const bf16_t*)(P.ws + WS_PROJ) + (size_t)(b * SEQ + n * 128 + c) * INW + h * 64 + qd * 16;
    R.k0 = *(const u32x4*)(src + C_RK); R.k1 = *(const u32x4*)(src + C_RK + 8); R.v0 = *(const u32x4*)(src + C_RV); R.v1 = *(const u32x4*)(src + C_RV + 8);
}
__device__ __forceinline__ void retA_phase(const Params& P, LAS unsigned char* lds) {
    const int tid = opaque_tid(), lane = tid & 63, wave = __builtin_amdgcn_readfirstlane(tid >> 6), q = lane & 15, g = lane >> 4;
    LAS bf16_t* Kf = (LAS bf16_t*)lds; LAS bf16_t* Kb = (LAS bf16_t*)(lds + 18432); LAS bf16_t* Vs = (LAS bf16_t*)(lds + 36864);
    int u = blockIdx.x; if (u >= 1536) return;
    RetARegs R; retA_load(P, u, tid, R);
    for (; u < 1536; u += gridDim.x) {
        const int bh = u >> 5, n = u & 31, h = bh % 6;
        const float lg = ret_logg(h);
        {
            const int c = tid >> 2, qd = tid & 3;
            const float wf = 0.125f * __expf(lg * (float)(127 - c)), wb = 0.125f * __expf(lg * (float)c);
            u32x4 f0, f1, b0, b1;
#pragma unroll
            for (int e = 0; e < 4; ++e) { f0[e] = pk2(bflo(R.k0[e]) * wf, bfhi(R.k0[e]) * wf); f1[e] = pk2(bflo(R.k1[e]) * wf, bfhi(R.k1[e]) * wf);
                b0[e] = pk2(bflo(R.k0[e]) * wb, bfhi(R.k0[e]) * wb); b1[e] = pk2(bflo(R.k1[e]) * wb, bfhi(R.k1[e]) * wb); }
            *(LAS u32x4*)(Kf + c * 72 + qd * 16) = f0; *(LAS u32x4*)(Kf + c * 72 + qd * 16 + 8) = f1;
            *(LAS u32x4*)(Kb + c * 72 + qd * 16) = b0; *(LAS u32x4*)(Kb + c * 72 + qd * 16 + 8) = b1;
            *(LAS u32x4*)(Vs + c * 72 + qd * 16) = R.v0; *(LAS u32x4*)(Vs + c * 72 + qd * 16 + 8) = R.v1;
        }
        __syncthreads();
        if (u + (int)gridDim.x < 1536) retA_load(P, u + gridDim.x, tid, R);
        const int dir = wave >> 2, dt = wave & 3; const LAS bf16_t* Kt = dir ? Kb : Kf;
        bf16x8 afr[4];
#pragma unroll
        for (int kk = 0; kk < 4; ++kk) afr[kk] = tr8(Kt, 72, kk * 32, dt * 16, g, q);
        bf16_t* dst = (bf16_t*)(P.ws + WS_RST) + ((size_t)(bh * 32 + n) * 2 + dir) * 4096;
#pragma unroll
        for (int et = 0; et < 4; ++et) {
            f32x4 acc = {0.f, 0.f, 0.f, 0.f};
#pragma unroll
            for (int kk = 0; kk < 4; ++kk) { const bf16x8 bfr = tr8(Vs, 72, kk * 32, et * 16, g, q); acc = MFMA32(afr[kk], bfr, acc); }
            *(bf16x4*)(dst + (et * 16 + q) * 64 + dt * 16 + 4 * g) = pk4(acc);
        }
        __syncthreads();
    }
}
__device__ __forceinline__ void ret_scan(const Params& P) {
    bf16_t* st = (bf16_t*)(P.ws + WS_RST);
    for (int it = blockIdx.x * NTHREADS + opaque_tid(); it < 48 * 2 * 512; it += gridDim.x * NTHREADS) {
        const int ch = it & 511, dir = (it >> 9) & 1, bh = it >> 10, h = bh % 6;
        const float cd = __expf(ret_logg(h) * 128.0f);
        float s[8];
#pragma unroll
        for (int e = 0; e < 8; ++e) s[e] = 0.f;
        for (int i0 = 0; i0 < 32; i0 += 8) {
            u32x4 v[8];
#pragma unroll
            for (int i = 0; i < 8; ++i) { const int n = dir ? 31 - (i0 + i) : (i0 + i); v[i] = *(const u32x4*)(st + ((size_t)(bh * 32 + n) * 2 + dir) * 4096 + 8 * ch); }
#pragma unroll
            for (int i = 0; i < 8; ++i) { const int n = dir ? 31 - (i0 + i) : (i0 + i);
                u32x4 o;
#pragma unroll
                for (int e = 0; e < 4; ++e) o[e] = pk2(s[2 * e], s[2 * e + 1]);
                *(u32x4*)(st + ((size_t)(bh * 32 + n) * 2 + dir) * 4096 + 8 * ch) = o;
#pragma unroll
                for (int e = 0; e < 4; ++e) { s[2 * e] = cd * s[2 * e] + bflo(v[i][e]); s[2 * e + 1] = cd * s[2 * e + 1] + bfhi(v[i][e]); } }
        }
    }
}
struct RetBRegs { u32x4 k0, k1, v0, v1, rf, rb, q0, q1; };
__device__ __forceinline__ void retB_load(const Params& P, int u, int tid, RetBRegs& R) {
    const int bh = u >> 5, n = u & 31, b = bh / 6, h = bh % 6, c = tid >> 2, qd = tid & 3;
    const bf16_t* proj = (const bf16_t*)(P.ws + WS_PROJ);
    const bf16_t* src = proj + (size_t)(b * SEQ + n * 128 + c) * INW + h * 64 + qd * 16;
    R.k0 = *(const u32x4*)(src + C_RK); R.k1 = *(const u32x4*)(src + C_RK + 8); R.v0 = *(const u32x4*)(src + C_RV); R.v1 = *(const u32x4*)(src + C_RV + 8);
    const bf16_t* rs = (const bf16_t*)(P.ws + WS_RST) + (size_t)(bh * 32 + n) * 2 * 4096;
    const int e = tid >> 3, d8 = (tid & 7) * 8;
    R.rf = *(const u32x4*)(rs + e * 64 + d8); R.rb = *(const u32x4*)(rs + 4096 + e * 64 + d8);
    const int lane = tid & 63, wave = tid >> 6, q = lane & 15, g = lane >> 4;
    const bf16_t* qp = proj + (size_t)(b * SEQ + n * 128 + 16 * wave + q) * INW + C_RQ + h * 64 + 8 * g;
    R.q0 = *(const u32x4*)qp; R.q1 = *(const u32x4*)(qp + 32);
}
__device__ __forceinline__ void retB_phase(const Params& P, LAS unsigned char* lds, int layer) {
    const int tid = opaque_tid(), lane = tid & 63, wave = __builtin_amdgcn_readfirstlane(tid >> 6), q = lane & 15, g = lane >> 4;
    const bf16_t* proj = (const bf16_t*)(P.ws + WS_PROJ);
    LAS bf16_t* Ks = (LAS bf16_t*)lds;
    LAS bf16_t* Vs = (LAS bf16_t*)(lds + 18432);
    LAS bf16_t* Rf = (LAS bf16_t*)(lds + 36864);
    LAS bf16_t* Rb = (LAS bf16_t*)(lds + 46080);
    int u = blockIdx.x; if (u >= 1536) return;
    RetBRegs R; retB_load(P, u, tid, R);
    for (; u < 1536; u += gridDim.x) {
        const int bh = u >> 5, n = u & 31, b = bh / 6, h = bh % 6;
        const float lg = ret_logg(h);
        {
            const int c = tid >> 2, qd = tid & 3, e = tid >> 3, d8 = (tid & 7) * 8;
            *(LAS u32x4*)(Ks + c * 72 + qd * 16) = R.k0; *(LAS u32x4*)(Ks + c * 72 + qd * 16 + 8) = R.k1;
            *(LAS u32x4*)(Vs + c * 72 + qd * 16) = R.v0; *(LAS u32x4*)(Vs + c * 72 + qd * 16 + 8) = R.v1;
            *(LAS u32x4*)(Rf + e * 72 + d8) = R.rf; *(LAS u32x4*)(Rb + e * 72 + d8) = R.rb;
        }
        const u32x4 qraw[2] = {R.q0, R.q1};
        __syncthreads();
        if (u + (int)gridDim.x < 1536) retB_load(P, u + gridDim.x, tid, R);
        const int i = 16 * wave + q; const size_t tok = (size_t)(b * SEQ + n * 128 + i);
        bf16x8 qf[2], qff[2], qfb[2];
        {
            const float ff = __expf(lg * (float)(i + 1)), fb = __expf(lg * (float)(128 - i));
#pragma unroll
            for (int kk = 0; kk < 2; ++kk) { const u32x4 raw = qraw[kk];
                qf[kk] = __builtin_bit_cast(bf16x8, raw); u32x4 a, c2;
#pragma unroll
                for (int e = 0; e < 4; ++e) { const float lo = bflo(raw[e]), hi = bfhi(raw[e]); a[e] = pk2(lo * ff, hi * ff); c2[e] = pk2(lo * fb, hi * fb); }
                qff[kk] = __builtin_bit_cast(bf16x8, a); qfb[kk] = __builtin_bit_cast(bf16x8, c2); }
        }
        bf16x4 pt[8];
#pragma unroll
        for (int jt = 0; jt < 8; ++jt) {
            f32x4 acc = {0.f, 0.f, 0.f, 0.f};
#pragma unroll
            for (int kk = 0; kk < 2; ++kk) { const bf16x8 a = *(const LAS bf16x8*)(Ks + (16 * jt + q) * 72 + kk * 32 + 8 * g); acc = MFMA32(a, qf[kk], acc); }
#pragma unroll
            for (int jj = 0; jj < 4; ++jj) { int dd = i - (16 * jt + 4 * g + jj); dd = dd < 0 ? -dd : dd; acc[jj] = acc[jj] * 0.125f * __expf(lg * (float)dd); }
            pt[jt] = pk4(acc);
        }
        f32x4 o[4];
#pragma unroll
        for (int et = 0; et < 4; ++et) {
            f32x4 acc = {0.f, 0.f, 0.f, 0.f};
#pragma unroll
            for (int jt = 0; jt < 8; ++jt) { const bf16x4 a = tr4(Vs, 72, 16 * jt, et * 16, g, q); acc = MFMA16(a, pt[jt], acc); }
#pragma unroll
            for (int kk = 0; kk < 2; ++kk) { const bf16x8 a = *(const LAS bf16x8*)(Rf + (et * 16 + q) * 72 + kk * 32 + 8 * g); acc = MFMA32(a, qff[kk], acc);
                const bf16x8 a2 = *(const LAS bf16x8*)(Rb + (et * 16 + q) * 72 + kk * 32 + 8 * g); acc = MFMA32(a2, qfb[kk], acc); }
            o[et] = acc;
        }
        float s = 0.f;
#pragma unroll
        for (int et = 0; et < 4; ++et) s += (o[et][0] + o[et][1]) + (o[et][2] + o[et][3]);
        s += __shfl_xor(s, 16); s += __shfl_xor(s, 32);
        const float mu = s * (1.0f / 64.0f); float vs = 0.f;
#pragma unroll
        for (int et = 0; et < 4; ++et) { o[et] = o[et] - mu; vs += (o[et][0] * o[et][0] + o[et][1] * o[et][1]) + (o[et][2] * o[et][2] + o[et][3] * o[et][3]); }
        vs += __shfl_xor(vs, 16); vs += __shfl_xor(vs, 32);
        const float rstd = rsqrtf(vs * (1.0f / 64.0f) + NORM_EPS);
        bf16_t* mixed = (bf16_t*)(P.ws + WS_HBUF) + tok * DM + 384 + h * 64;
#pragma unroll
        for (int et = 0; et < 4; ++et) {
            const f32x4 gn = *(const f32x4*)(P.ret_gn + layer * 384 + h * 64 + et * 16 + 4 * g);
            const u32x2 rg = *(const u32x2*)(proj + tok * INW + C_RG + h * 64 + et * 16 + 4 * g);
            f32x4 y; y[0] = o[et][0] * rstd * gn[0] * siluf(bflo(rg.x)); y[1] = o[et][1] * rstd * gn[1] * siluf(bfhi(rg.x));
            y[2] = o[et][2] * rstd * gn[2] * siluf(bflo(rg.y)); y[3] = o[et][3] * rstd * gn[3] * siluf(bfhi(rg.y));
            *(bf16x4*)(mixed + et * 16 + 4 * g) = pk4(y);
        }
        __syncthreads();
    }
}
__device__ __forceinline__ void hgrn_gate(float z, float lbv, float& f, float& kk) {
    z = fminf(fmaxf(z, -30.f), 30.f);
    const float ez = __expf(-z), sg = __builtin_amdgcn_rcpf(1.0f + ez);
    f = lbv + (1.0f - lbv) * sg; kk = (1.0f - lbv) * ez * sg;
}
__device__ __forceinline__ void hgA_unit(const Params& P, LAS unsigned char* lds, int u, int layer) {
    const int tid = opaque_tid(), lane = tid & 63, wave = __builtin_amdgcn_readfirstlane(tid >> 6), q = lane & 15, g = lane >> 4;
    const int bh = u >> 5, n = u & 31, b = bh >> 2, h = bh & 3;
    const bf16_t* proj = (const bf16_t*)(P.ws + WS_PROJ);
    LAS bf16_t* Kt = (LAS bf16_t*)lds;
    LAS bf16_t* Vt = (LAS bf16_t*)(lds + 34816);
    LAS float* segs = (LAS float*)(lds + 52224);
    const size_t tokc = (size_t)(b * SEQ + n * 128);
    {
        const int c = tid >> 2, qd = tid & 3; const bf16_t* src = proj + (tokc + c) * INW + C_HI + h * 64 + qd * 16;
        const u32x4 v0 = *(const u32x4*)src, v1 = *(const u32x4*)(src + 8);
#pragma unroll
        for (int e = 0; e < 8; ++e) { const unsigned vw = e < 4 ? v0[e & 3] : v1[e & 3]; const int d = qd * 16 + 2 * e;
            Vt[d * 136 + c] = (bf16_t)(vw & 0xffffu); Vt[(d + 1) * 136 + c] = (bf16_t)(vw >> 16); }
    }
    const int d = tid & 63, dir = (tid >> 6) & 1, seg = tid >> 7;
    const float lbv = ((const float*)(P.ws + WS_LB))[layer * 256 + h * 64 + d];
    float lf[32], kk[32];
    {
        const bf16_t* zp = proj + (tokc + seg * 32) * INW + (dir ? C_HZB : C_HZF) + h * 64 + d;
        bf16_t zr[32];
#pragma unroll
        for (int i = 0; i < 32; ++i) zr[i] = zp[(size_t)i * INW];
#pragma unroll
        for (int i = 0; i < 32; ++i) hgrn_gate(bf2f(zr[i]), lbv, lf[i], kk[i]);
    }
    float ssum = 1.f;
#pragma unroll
    for (int i = 0; i < 32; ++i) ssum *= lf[i];
    segs[(dir * 4 + seg) * 64 + d] = ssum;
    __syncthreads();
    {
        float before = 1.f, after = 1.f;
#pragma unroll
        for (int s2 = 0; s2 < 4; ++s2) { const float v = segs[(dir * 4 + s2) * 64 + d]; if (s2 < seg) before *= v; if (s2 > seg) after *= v; }
        LAS bf16_t* kt = Kt + dir * (64 * 136) + d * 136 + seg * 32;
        if (dir == 0) {
            float run = after;
#pragma unroll
            for (int i = 31; i >= 0; --i) { kt[i] = f2bf(kk[i] * run); run *= lf[i]; }
        } else {
            float run = before;
#pragma unroll
            for (int i = 0; i < 32; ++i) { kt[i] = f2bf(kk[i] * run); run *= lf[i]; }
        }
        if (seg == 0) ((float*)(P.ws + WS_HGA))[((size_t)(bh * 2 + dir) * 32 + n) * 64 + d] = ssum * after;
    }
    __syncthreads();
    {
        const int wdir = wave >> 2, dt = wave & 3; const LAS bf16_t* kts = Kt + wdir * (64 * 136);
        bf16x8 afr[4];
#pragma unroll
        for (int kq = 0; kq < 4; ++kq) afr[kq] = *(const LAS bf16x8*)(kts + (dt * 16 + q) * 136 + kq * 32 + 8 * g);
        float* dst = (float*)(P.ws + WS_HGU) + ((size_t)(bh * 2 + wdir) * 32 + n) * 4096;
#pragma unroll
        for (int et = 0; et < 4; ++et) {
            f32x4 acc = {0.f, 0.f, 0.f, 0.f};
#pragma unroll
            for (int kq = 0; kq < 4; ++kq) { const bf16x8 bfr = *(const LAS bf16x8*)(Vt + (et * 16 + q) * 136 + kq * 32 + 8 * g); acc = MFMA32(afr[kq], bfr, acc); }
#pragma unroll
            for (int j = 0; j < 4; ++j) dst[(dt * 16 + 4 * g + j) * 64 + et * 16 + q] = acc[j];
        }
    }
    __syncthreads();
}
__device__ __forceinline__ void hg_scan(const Params& P) {
    float* U = (float*)(P.ws + WS_HGU); const float* A = (const float*)(P.ws + WS_HGA);
    for (int it = blockIdx.x * NTHREADS + opaque_tid(); it < 64 * 64 * 16; it += gridDim.x * NTHREADS) {
        const int e4 = it & 15, d = (it >> 4) & 63, bd = it >> 10, dir = bd & 1;
        f32x4 s = {0.f, 0.f, 0.f, 0.f};
        for (int i0 = 0; i0 < 32; i0 += 8) {
            f32x4 v[8]; float a[8];
#pragma unroll
            for (int i = 0; i < 8; ++i) { const int n = dir ? 31 - (i0 + i) : (i0 + i); v[i] = *(const f32x4*)(U + ((size_t)(bd * 32 + n) * 64 + d) * 64 + 4 * e4); a[i] = A[(size_t)(bd * 32 + n) * 64 + d]; }
#pragma unroll
            for (int i = 0; i < 8; ++i) { const int n = dir ? 31 - (i0 + i) : (i0 + i); *(f32x4*)(U + ((size_t)(bd * 32 + n) * 64 + d) * 64 + 4 * e4) = s; s = s * a[i] + v[i]; }
        }
    }
}
__device__ __forceinline__ unsigned pk2h(float lo, float hi) { return pk2(lo, hi); }
__device__ __forceinline__ bf16x4 pk4h(f32x4 v) { return pk4(v); }
__device__ __forceinline__ void hgB_unit(const Params& P, LAS unsigned char* lds, int u, int layer) {
    const int tid = opaque_tid(), lane = tid & 63, wave = __builtin_amdgcn_readfirstlane(tid >> 6), q = lane & 15, g = lane >> 4;
    const int b = u >> 5, n = u & 31, h = wave >> 1, dir = wave & 1, bh = b * 4 + h;
    bf16_t* proj = (bf16_t*)(P.ws + WS_PROJ);
    bf16_t* mixed = (bf16_t*)(P.ws + WS_HBUF);
    LAS unsigned char* wl = lds + wave * 7168;
    LAS bf16_t* Qi = (LAS bf16_t*)wl;
    LAS bf16_t* Ki = (LAS bf16_t*)(wl + 2304);
    LAS bf16_t* Vs = (LAS bf16_t*)(wl + 4608);
    LAS float* Al = (LAS float*)(wl + 6912);
    const size_t tokc = (size_t)(b * SEQ + n * 128);
    const float lbv = ((const float*)(P.ws + WS_LB))[layer * 256 + h * 64 + lane];
    f32x4 S[4][4];
    {
        const float* sp = (const float*)(P.ws + WS_HGU) + ((size_t)(bh * 2 + dir) * 32 + n) * 4096;
#pragma unroll
        for (int dt = 0; dt < 4; ++dt)
#pragma unroll
            for (int et = 0; et < 4; ++et)
#pragma unroll
                for (int j = 0; j < 4; ++j) S[dt][et][j] = sp[(dt * 16 + 4 * g + j) * 64 + et * 16 + q];
    }
    bf16_t* odst = dir ? (proj + C_AQ + h * 64) : (mixed + 768 + h * 64); const size_t opitch = dir ? INW : DM;
    bf16_t qr[16], zz[16]; u32x4 v0, v1;
#define HGB_LOAD(SC) do { const size_t toks_ = tokc + (SC) * 16; const bf16_t* base_ = proj + toks_ * INW + h * 64 + lane; \
        _Pragma("unroll") for (int ii = 0; ii < 16; ++ii) { const int t_ = dir ? 15 - ii : ii; qr[ii] = base_[(size_t)t_ * INW + C_HQ]; zz[ii] = base_[(size_t)t_ * INW + (dir ? C_HZB : C_HZF)]; } \
        const bf16_t* vsrc_ = proj + (toks_ + (lane >> 2)) * INW + C_HI + h * 64 + (lane & 3) * 16; v0 = *(const u32x4*)vsrc_; v1 = *(const u32x4*)(vsrc_ + 8); } while (0)
    HGB_LOAD(dir ? 7 : 0);
    for (int i = 0; i < 8; ++i) {
        const int sc = dir ? 7 - i : i; const size_t toks = tokc + sc * 16;
        {
            *(LAS u32x4*)(Vs + (lane >> 2) * 72 + (lane & 3) * 16) = v0; *(LAS u32x4*)(Vs + (lane >> 2) * 72 + (lane & 3) * 16 + 8) = v1;
            float bp = 1.f;
#pragma unroll
            for (int ii = 0; ii < 16; ++ii) {
                const int t = dir ? 15 - ii : ii;
                float f, kk; hgrn_gate(bf2f(zz[ii]), lbv, f, kk); const float qv = siluf(bf2f(qr[ii]));
                bp *= f;
                Qi[t * 72 + lane] = f2bf(qv * bp); Ki[t * 72 + lane] = f2bf(kk * __builtin_amdgcn_rcpf(fmaxf(bp, 1.0e-30f)));
            }
            Al[lane] = bp;
        }
        if (i + 1 < 8) HGB_LOAD(dir ? 6 - i : i + 1);
        __builtin_amdgcn_fence(__ATOMIC_RELEASE, "wavefront"); __builtin_amdgcn_wave_barrier(); __builtin_amdgcn_fence(__ATOMIC_ACQUIRE, "wavefront");
        f32x4 at = {0.f, 0.f, 0.f, 0.f};
#pragma unroll
        for (int kq = 0; kq < 2; ++kq) { const bf16x8 a8 = *(const LAS bf16x8*)(Ki + q * 72 + kq * 32 + 8 * g), b8 = *(const LAS bf16x8*)(Qi + q * 72 + kq * 32 + 8 * g); at = MFMA32(a8, b8, at); }
#pragma unroll
        for (int j = 0; j < 4; ++j) { const int sl = 4 * g + j; const bool keep = dir ? (sl >= q) : (sl <= q); at[j] = keep ? at[j] : 0.f; }
        const bf16x4 p4 = pk4h(at);
        bf16x4 b4[4], v4[4];
#pragma unroll
        for (int dt = 0; dt < 4; ++dt) b4[dt] = *(const LAS bf16x4*)(Qi + q * 72 + dt * 16 + 4 * g);
#pragma unroll
        for (int et = 0; et < 4; ++et) v4[et] = tr4(Vs, 72, 0, et * 16, g, q);
#pragma unroll
        for (int et = 0; et < 4; ++et) {
            f32x4 o = {0.f, 0.f, 0.f, 0.f};
#pragma unroll
            for (int dt = 0; dt < 4; ++dt) o = MFMA16(pk4h(S[dt][et]), b4[dt], o);
            o = MFMA16(v4[et], p4, o);
            *(bf16x4*)(odst + (toks + q) * opitch + et * 16 + 4 * g) = pk4(o);
        }
#pragma unroll
        for (int dt = 0; dt < 4; ++dt) {
            const bf16x4 kT4 = tr4(Ki, 72, 0, dt * 16, g, q);
            const f32x4 al4 = *(const LAS f32x4*)(Al + dt * 16 + 4 * g);
#pragma unroll
            for (int et = 0; et < 4; ++et) { const f32x4 s2 = MFMA16(kT4, v4[et], S[dt][et]); S[dt][et] = s2 * al4; }
        }
        __builtin_amdgcn_fence(__ATOMIC_RELEASE, "wavefront"); __builtin_amdgcn_wave_barrier(); __builtin_amdgcn_fence(__ATOMIC_ACQUIRE, "wavefront");
    }
    asm volatile("s_waitcnt vmcnt(0)" ::: "memory");
    __syncthreads();
    {
        const int tau = tid >> 2, qd = tid & 3;
        bf16_t* mp = mixed + (tokc + tau) * DM + 768 + qd * 64; const bf16_t* bp2 = proj + (tokc + tau) * INW + C_AQ + qd * 64;
        const bf16_t* gp = proj + (tokc + tau) * INW + C_HG + qd * 64; const float* gn = P.hgrn_gn + layer * 256 + qd * 64;
        float o[64]; float sq = 0.f;
#pragma unroll
        for (int c4 = 0; c4 < 16; ++c4) {
            const unsigned long long fv = __hip_atomic_load((const unsigned long long*)(mp + c4 * 4), __ATOMIC_RELAXED, __HIP_MEMORY_SCOPE_AGENT), bv = __hip_atomic_load((const unsigned long long*)(bp2 + c4 * 4), __ATOMIC_RELAXED, __HIP_MEMORY_SCOPE_AGENT);
            const unsigned f0 = (unsigned)fv, f1 = (unsigned)(fv >> 32), b0 = (unsigned)bv, b1 = (unsigned)(bv >> 32);
            const float x0 = bflo(f0) + bflo(b0), x1 = bfhi(f0) + bfhi(b0), x2 = bflo(f1) + bflo(b1), x3 = bfhi(f1) + bfhi(b1);
            o[c4 * 4 + 0] = x0; o[c4 * 4 + 1] = x1; o[c4 * 4 + 2] = x2; o[c4 * 4 + 3] = x3; sq += (x0 * x0 + x1 * x1) + (x2 * x2 + x3 * x3); }
        sq += __shfl_xor(sq, 1); sq += __shfl_xor(sq, 2);
        const float rstd = rsqrtf(sq * (1.0f / 256.0f) + NORM_EPS);
#pragma unroll
        for (int c8 = 0; c8 < 8; ++c8) {
            const u32x4 gv = *(const u32x4*)(gp + c8 * 8); const f32x4 g0 = *(const f32x4*)(gn + c8 * 8), g1 = *(const f32x4*)(gn + c8 * 8 + 4);
            u32x4 r;
            r.x = pk2h(o[c8 * 8 + 0] * rstd * g0[0] * siluf(bflo(gv.x)), o[c8 * 8 + 1] * rstd * g0[1] * siluf(bfhi(gv.x)));
            r.y = pk2h(o[c8 * 8 + 2] * rstd * g0[2] * siluf(bflo(gv.y)), o[c8 * 8 + 3] * rstd * g0[3] * siluf(bfhi(gv.y)));
            r.z = pk2h(o[c8 * 8 + 4] * rstd * g1[0] * siluf(bflo(gv.z)), o[c8 * 8 + 5] * rstd * g1[1] * siluf(bfhi(gv.z)));
            r.w = pk2h(o[c8 * 8 + 6] * rstd * g1[2] * siluf(bflo(gv.w)), o[c8 * 8 + 7] * rstd * g1[3] * siluf(bfhi(gv.w)));
            *(u32x4*)(mp + c8 * 8) = r;
        }
    }
    __syncthreads();
}
constexpr int N_PHASES = 20;
#ifndef PROBE_MASK
#define PROBE_MASK 0u
#endif
#ifndef PROBE_U
#define PROBE_U 0
#endif
#ifndef PROBE_SYNC2
#define PROBE_SYNC2 0
#endif
__device__ __forceinline__ void run_phase(const Params& P, LAS unsigned char* lds, int ph) {
    unsigned char* ws = P.ws;
    if (ph == 0) { phase_prologue(P, lds); return; }
    if (ph == N_PHASES - 1) { phase_norm_final(P.out, P.g_final); return; }
    const int l = (ph - 1) / 9, s = (ph - 1) % 9;
    const float* mod = (const float*)(ws + WS_MOD) + (size_t)l * NBATCH * NMOD * DM;
    bf16_t* hbuf = (bf16_t*)(ws + WS_HBUF); bf16_t* proj = (bf16_t*)(ws + WS_PROJ);
#ifdef PH_ONLY
    if (s != PH_ONLY) return;
#endif
    int kD = DM, kF = FFN; asm volatile("" : "+s"(kD), "+s"(kF));
    switch (s) {
    case 0: phase_norm_mod(l == 0 ? P.x : P.out, P.g_mix + l * DM, mod + 0 * DM, mod + 1 * DM, hbuf); break;
    case 1: { pg8::Gemm g{hbuf, (const bf16_t*)(ws + WS_WIN) + (size_t)l * INWP * DM, NTOK, INWP, kD}; pg8::StaticOrder S; S.init(NTOK, INWP, gridDim.x, blockIdx.x);
              EpiProj E{proj}; pg8::gemm_phase<EpiProj, pg8::StaticOrder>(lds, g, S, E, nullptr); } break;
    case 2: { for (int rp = 0; rp < (PROBE_U == 1 ? 2 : 1); ++rp) att_phase(P, lds);
              for (int rp = 0; rp < (PROBE_U == 2 ? 2 : 1); ++rp) retA_phase(P, lds);
              for (int rp = 0; rp < (PROBE_U == 3 ? 2 : 1); ++rp) for (int u = blockIdx.x; u < 1024; u += gridDim.x) hgA_unit(P, lds, u, l); } break;
    case 3: { ret_scan(P); hg_scan(P); att_merge(P); } break;
    case 4: { for (int rp = 0; rp < (PROBE_U == 4 ? 2 : 1); ++rp) for (int u = blockIdx.x; u < 256; u += gridDim.x) hgB_unit(P, lds, u, l);
              for (int rp = 0; rp < (PROBE_U == 5 ? 2 : 1); ++rp) retB_phase(P, lds, l); } break;
    case 5: { pg8::Gemm g{hbuf, (const bf16_t*)(ws + WS_WOUT) + (size_t)l * DM * DM, NTOK, DM, kD}; pg8::StaticOrder S; S.init(NTOK, DM, gridDim.x, blockIdx.x);
              EpiRes E{l == 0 ? P.x : P.out, P.out, mod + 2 * DM}; pg8::gemm_phase<EpiRes, pg8::StaticOrder>(lds, g, S, E, nullptr); } break;
    case 6: phase_norm_mod(P.out, P.g_ffn + l * DM, mod + 3 * DM, mod + 4 * DM, hbuf); break;
    case 7: { pg8::Gemm g{hbuf, (const bf16_t*)(ws + WS_WGU) + (size_t)l * 2 * FFN * DM, NTOK, 2 * FFN, kD}; pg8::StaticOrder S; S.init(NTOK, 2 * FFN, gridDim.x, blockIdx.x);
              EpiSwiglu E{proj}; pg8::gemm_phase<EpiSwiglu, pg8::StaticOrder>(lds, g, S, E, nullptr); } break;
    case 8: { pg8::Gemm g{proj, (const bf16_t*)(ws + WS_WDN) + (size_t)l * DM * FFN, NTOK, DM, kF}; pg8::StaticOrder S; S.init(NTOK, DM, gridDim.x, blockIdx.x);
              EpiRes E{P.out, P.out, mod + 5 * DM}; pg8::gemm_phase<EpiRes, pg8::StaticOrder>(lds, g, S, E, nullptr); } break;
    }
}
__global__ void __launch_bounds__(NTHREADS) hybrid_fwd(Params P) {
    extern __shared__ __attribute__((aligned(16))) unsigned char lds_raw[];
    __shared__ uint4 xb_words;
    LAS unsigned char* lds = (LAS unsigned char*)lds_raw;
    if (threadIdx.x == 0) xb_words = make_uint4(0u, 0u, 0u, 0u);
    __syncthreads();
    XcdBarrier bar = xcd_barrier_post((unsigned*)(P.ws + WS_CTL), (volatile LAS unsigned*)&xb_words);
    for (int ph = P.ph_lo; ph < P.ph_hi; ++ph) {
        const int reps = ((PROBE_MASK >> ph) & 1u) ? 2 : 1;
        for (int rep = 0; rep < reps; ++rep) { run_phase(P, lds, ph); if (rep + 1 < reps) __syncthreads(); }
        if (ph + 1 < P.ph_hi) {
            if (ph == P.ph_lo) cg::this_grid().sync(); else xcd_barrier(bar);
            if (PROBE_SYNC2) xcd_barrier(bar);
        }
    }
}

extern "C" void kernel_launch(void* const* d_in, const int* in_sizes, int n_in, void* d_out, int out_size, void* d_ws, size_t ws_size, hipStream_t stream) {
    static int grid = 0;
    if (grid == 0) {
        if (n_in != 14 || out_size != NTOK * DM || ws_size < WS_END) { fprintf(stderr, "kernel_launch: unexpected shapes (n_in %d out %d ws %zu need %zu)\n", n_in, out_size, ws_size, (size_t)WS_END); grid = -1; return; }
        int dev = 0, cus = 0, per_cu = 0;
        hipGetDevice(&dev); hipDeviceGetAttribute(&cus, hipDeviceAttributeMultiprocessorCount, dev);
        if (hipFuncSetAttribute((const void*)hybrid_fwd, hipFuncAttributeMaxDynamicSharedMemorySize, LDS_BYTES) != hipSuccess) { fprintf(stderr, "kernel_launch: hipFuncSetAttribute failed\n"); grid = -1; return; }
        if (hipOccupancyMaxActiveBlocksPerMultiprocessor(&per_cu, (const void*)hybrid_fwd, NTHREADS, LDS_BYTES) != hipSuccess || per_cu < 1) { fprintf(stderr, "kernel_launch: occupancy query says %d\n", per_cu); grid = -1; return; }
        grid = cus;
    }
    if (grid < 0) return;
    if (hipMemsetAsync((char*)d_ws + WS_CTL, 0, 16384, stream) != hipSuccess) { fprintf(stderr, "kernel_launch: memset failed\n"); return; }
    Params p{};
    p.x = (const float*)d_in[0]; p.c = (const float*)d_in[1]; p.w_ada = (const float*)d_in[2]; p.b_ada = (const float*)d_in[3]; p.g_mix = (const float*)d_in[4];
    p.w_in = (const float*)d_in[5]; p.ret_gn = (const float*)d_in[6]; p.hgrn_gn = (const float*)d_in[7]; p.lb_logits = (const float*)d_in[8]; p.w_out = (const float*)d_in[9];
    p.g_ffn = (const float*)d_in[10]; p.w_gu = (const float*)d_in[11]; p.w_down = (const float*)d_in[12]; p.g_final = (const float*)d_in[13];
    p.out = (float*)d_out; p.ws = (unsigned char*)d_ws;
#if ONE_LAUNCH
    p.ph_lo = 0; p.ph_hi = N_PHASES;
    void* args[] = {&p};
    hipError_t e = hipLaunchCooperativeKernel((const void*)hybrid_fwd, dim3(grid), dim3(NTHREADS), args, LDS_BYTES, stream);
    if (e != hipSuccess) fprintf(stderr, "cooperative launch failed: %s (grid %d)\n", hipGetErrorString(e), grid);
#else
    for (int ph = 0; ph < N_PHASES; ++ph) { p.ph_lo = ph; p.ph_hi = ph + 1; hipLaunchKernelGGL(hybrid_fwd, dim3(grid), dim3(NTHREADS), LDS_BYTES, stream, p); }
#endif
}
```

```cpp
#include <hip/hip_runtime.h>
#include <hip/hip_cooperative_groups.h>
#include <cstdio>
#include <cstdint>
namespace cg = cooperative_groups;
#ifndef ONE_LAUNCH
#define ONE_LAUNCH 1
#endif
__device__ __forceinline__ int opaque_tid() { int t = threadIdx.x; asm volatile("" : "+v"(t)); return t; }
#define LAS __attribute__((address_space(3)))
namespace pg8 {
#define PG8_LAS __attribute__((address_space(3)))
typedef unsigned short bf16_t;
typedef short bf16x8 __attribute__((ext_vector_type(8)));
typedef float f32x4 __attribute__((ext_vector_type(4)));
typedef unsigned u32x4 __attribute__((ext_vector_type(4)));
constexpr int BM = 256, BK = 64, HALF = 128, HTB = HALF * BK * 2  , STAGE_BYTES = 8 * HTB, NXCD = 8, WGM = 8;

__host__ __device__ __forceinline__ int lds_byte(int r, int c) { const int st = (r >> 4) * 2 + (c >> 5), rr = r & 15, cc = c & 31, ob = rr * 64 + cc * 2; return st * 1024 + (ob ^ (((ob >> 9) & 1) << 5)); }
__host__ __device__ __forceinline__ void stage_rc(int b, int& R, int& C) { const int st = b / 1024, sb = b % 1024, swz = sb ^ (((sb >> 9) & 1) << 5); R = (st >> 1) * 16 + swz / 64; C = (st & 1) * 32 + (swz % 64) / 2; }
__host__ __device__ __forceinline__ int perm32(int rho) { const int n = rho >> 4, i = rho & 15; return 8 * (i >> 2) + 4 * n + (i & 3); }

struct Unit { int pm, pn; };
struct Gemm { const bf16_t* A; const bf16_t* Bt; int M, N, K; };

struct StaticOrder {
    int nM, nN, nwg, G, c;
    __host__ __device__ void init(int M, int N, int G_, int c_) { nM = M / BM; nN = N / BM; nwg = nM * nN; G = G_; c = c_; }
    __host__ __device__ bool next(int i, Unit& u) const {
        const long L = (long)i * G + c; if (L >= nwg) return false;
        int wgid = (int)L; { const int q = nwg / NXCD, r = nwg % NXCD, xcd = wgid % NXCD, off = wgid / NXCD; wgid = (xcd < r ? xcd * (q + 1) : r * (q + 1) + (xcd - r) * q) + off; }
        const int nig = WGM * nN, gid = wgid / nig, fm = gid * WGM, gsz = (nM - fm) < WGM ? (nM - fm) : WGM;
        u.pm = fm + ((wgid % nig) % gsz); u.pn = (wgid % nig) / gsz; return true;
    }
    __device__ __forceinline__ void a_ready(const Unit&) const {}
    __device__ __forceinline__ void done(const Unit&) const {}
};
__device__ __forceinline__ unsigned cvt_pk_bf16(float lo, float hi) { unsigned r; asm volatile("v_cvt_pk_bf16_f32 %0, %1, %2" : "=v"(r) : "v"(lo), "v"(hi)); return r; }
typedef float f32x2 __attribute__((ext_vector_type(2)));
template <class Epi, class Sched, bool STAMP = false>
__device__ __forceinline__ void gemm_phase(PG8_LAS unsigned char* lds, const Gemm g, const Sched& S, const Epi& E, unsigned long long* stamps) {
    const int tid = opaque_tid(), wid = __builtin_amdgcn_readfirstlane(tid >> 6), lane = tid & 63, wr = wid >> 2, wc = wid & 3, fr = lane & 15, fq = lane >> 4;
    const int K = g.K, nt = K / BK;
    int ts_lo = 0, ts_hi = 0, nts = 0; const unsigned long long rt_entry = STAMP ? (unsigned long long)wall_clock64() : 0ull;
#define PG8_STAMP() do { if (STAMP && wid == 0 && nts < 64) { const unsigned long long _c = (unsigned long long)clock64(); \
        ts_lo = (lane == nts) ? (int)(unsigned)_c : ts_lo; ts_hi = (lane == nts) ? (int)(unsigned)(_c >> 32) : ts_hi; ++nts; } } while (0)
    PG8_STAMP();
    unsigned voffA[2], voffB[2];
#pragma unroll
    for (int i = 0; i < 2; ++i) { int R, C; stage_rc(tid * 16 + i * 8192, R, C); const int Rb = Epi::PERM ? ((R & ~31) + perm32(R & 31)) : R;
        voffA[i] = (unsigned)(R * K + C) * 2u; voffB[i] = (unsigned)(Rb * K + C) * 2u; }
    const size_t kstep = (size_t)(BK * 2);
    const size_t hstep = (size_t)HALF * K * 2;
    const size_t tstep = 2 * hstep;
    const unsigned ldsw = (unsigned)wid * 1024u;
    const int aoff = lds_byte(wr * 64 + fr, fq * 8), boff = lds_byte(wc * 32 + fr, fq * 8);
#define PG8_SA(b, h) (((b) * 2 + (h)) * HTB)
#define PG8_SB(b, h) ((4 + (b) * 2 + (h)) * HTB)
#define PG8_STAGE(bufoff, gbase, voff) do { _Pragma("unroll") for (int _i = 0; _i < 2; ++_i) \
        __builtin_amdgcn_global_load_lds((const unsigned*)((const char*)(gbase) + (voff)[_i]), (PG8_LAS unsigned*)(lds + (bufoff) + ldsw + _i * 8192), 16, 0, 0); } while (0)
#define PG8_LDA(dst, b, h) do { _Pragma("unroll") for (int m = 0; m < 4; ++m) _Pragma("unroll") for (int k = 0; k < 2; ++k) dst[m][k] = *(const PG8_LAS bf16x8*)(lds + PG8_SA(b, h) + aoff + m * 2048 + k * 1024); } while (0)
#define PG8_LDB(dst, b, h) do { _Pragma("unroll") for (int n = 0; n < 2; ++n) _Pragma("unroll") for (int k = 0; k < 2; ++k) dst[n][k] = *(const PG8_LAS bf16x8*)(lds + PG8_SB(b, h) + boff + n * 2048 + k * 1024); } while (0)
#define PG8_MMA(ai, bj, At, Bt) do { __builtin_amdgcn_s_setprio(1); _Pragma("unroll") for (int m = 0; m < 4; ++m) _Pragma("unroll") for (int n = 0; n < 2; ++n) _Pragma("unroll") for (int k = 0; k < 2; ++k) \
        acc[ai][bj][m][n] = __builtin_amdgcn_mfma_f32_16x16x32_bf16(Bt[n][k], At[m][k], acc[ai][bj][m][n], 0, 0, 0); __builtin_amdgcn_s_setprio(0); } while (0)
#define PG8_WAIT_V(n) asm volatile("s_waitcnt vmcnt(" #n ")" ::: "memory")
#define PG8_WAIT_L(n) asm volatile("s_waitcnt lgkmcnt(" #n ")" ::: "memory")
#define PG8_BAR __builtin_amdgcn_s_barrier()
#define PG8_SCHED __builtin_amdgcn_sched_barrier(0)
    Unit cur, nxt; int ui = 0;
    if (!S.next(0, cur)) return;
    f32x4 acc[2][2][4][2];
#pragma unroll
    for (int a = 0; a < 2; ++a)
#pragma unroll
        for (int b = 0; b < 2; ++b)
#pragma unroll
            for (int m = 0; m < 4; ++m)
#pragma unroll
                for (int n = 0; n < 2; ++n) acc[a][b][m][n] = (f32x4){0.f, 0.f, 0.f, 0.f};
    bf16x8 At[4][2], B0[2][2], B1[2][2];
    const char* cA = (const char*)g.A + (size_t)cur.pm * tstep; const char* cB = (const char*)g.Bt + (size_t)cur.pn * tstep;
    S.a_ready(cur);
    PG8_STAGE(PG8_SB(0, 0), cB, voffB); PG8_STAGE(PG8_SA(0, 0), cA, voffA); PG8_STAGE(PG8_SB(0, 1), cB + hstep, voffB); PG8_STAGE(PG8_SA(0, 1), cA + hstep, voffA);
    if (wr == 1) PG8_BAR;
    PG8_WAIT_V(4); PG8_BAR;
    PG8_STAGE(PG8_SB(1, 0), cB + kstep, voffB); PG8_STAGE(PG8_SA(1, 0), cA + kstep, voffA); PG8_STAGE(PG8_SB(1, 1), cB + hstep + kstep, voffB);
    PG8_WAIT_V(6); PG8_BAR;
    PG8_STAMP();
    for (;;) {
        const bool has_next = S.next(ui + 1, nxt);
        const char* nA = has_next ? (const char*)g.A + (size_t)nxt.pm * tstep : cA; const char* nB = has_next ? (const char*)g.Bt + (size_t)nxt.pn * tstep : cB;
        for (int t = 0; t < nt; t += 2) {
            const bool last = (t == nt - 2);
            const char* a1 = cA + (size_t)(t + 1) * kstep;
            const char* a2 = last ? nA : cA + (size_t)(t + 2) * kstep; const char* b2 = last ? nB : cB + (size_t)(t + 2) * kstep;
            const char* a3 = a2 + kstep; const char* b3 = b2 + kstep;
            if (last && has_next) S.a_ready(nxt);
            PG8_LDB(B0, 0, 0); PG8_SCHED; PG8_LDA(At, 0, 0); PG8_STAGE(PG8_SA(1, 1), a1 + hstep, voffA);
            PG8_WAIT_L(8); PG8_BAR; PG8_WAIT_L(0); PG8_MMA(0, 0, At, B0); PG8_BAR; PG8_SCHED;
            PG8_LDB(B1, 0, 1); PG8_STAGE(PG8_SB(0, 0), b2, voffB);
            PG8_BAR; PG8_WAIT_L(0); PG8_MMA(0, 1, At, B1); PG8_BAR;
            PG8_LDA(At, 0, 1); PG8_STAGE(PG8_SA(0, 0), a2, voffA);
            PG8_BAR; PG8_WAIT_L(0); PG8_MMA(1, 0, At, B0); PG8_BAR; PG8_SCHED;
            PG8_STAGE(PG8_SB(0, 1), b2 + hstep, voffB);
            PG8_WAIT_V(6); PG8_BAR; PG8_MMA(1, 1, At, B1); PG8_BAR;
            PG8_LDB(B0, 1, 0); PG8_SCHED; PG8_LDA(At, 1, 0); PG8_STAGE(PG8_SA(0, 1), a2 + hstep, voffA);
            PG8_WAIT_L(8); PG8_BAR; PG8_WAIT_L(0); PG8_MMA(0, 0, At, B0); PG8_BAR; PG8_SCHED;
            PG8_LDB(B1, 1, 1); PG8_STAGE(PG8_SB(1, 0), b3, voffB);
            PG8_BAR; PG8_WAIT_L(0); PG8_MMA(0, 1, At, B1); PG8_BAR;
            PG8_LDA(At, 1, 1); PG8_STAGE(PG8_SA(1, 0), a3, voffA);
            PG8_BAR; PG8_WAIT_L(0); PG8_MMA(1, 0, At, B0); PG8_BAR; PG8_SCHED;
            PG8_STAGE(PG8_SB(1, 1), b3 + hstep, voffB);
            PG8_WAIT_V(6); PG8_BAR; PG8_MMA(1, 1, At, B1); PG8_BAR;
        }
        PG8_STAMP();
        if constexpr (!Epi::AFTER_DRAIN) { E(acc, cur, wr, wc, fr, fq); S.done(cur); }
        PG8_STAMP();
        if (!has_next) break;
#pragma unroll
        for (int a = 0; a < 2; ++a)
#pragma unroll
            for (int b = 0; b < 2; ++b)
#pragma unroll
                for (int m = 0; m < 4; ++m)
#pragma unroll
                    for (int n = 0; n < 2; ++n) acc[a][b][m][n] = (f32x4){0.f, 0.f, 0.f, 0.f};
        cur = nxt; cA = nA; cB = nB; ++ui;
    }
    PG8_WAIT_V(0);
    if (wr == 0) PG8_BAR;
    PG8_BAR;
    if constexpr (Epi::AFTER_DRAIN) { E.fused(acc, cur, wr, wc, fr, fq, lds, wid, lane); S.done(cur); }
    PG8_STAMP();
    if (STAMP && wid == 0) { stamps[lane] = lane < nts ? (((unsigned long long)(unsigned)ts_hi << 32) | (unsigned)ts_lo) : 0ull;
        if (lane == 62) stamps[62] = rt_entry; if (lane == 63) stamps[63] = (unsigned long long)wall_clock64(); }
#undef PG8_STAMP
#undef PG8_SA
#undef PG8_SB
#undef PG8_STAGE
#undef PG8_LDA
#undef PG8_LDB
#undef PG8_MMA
#undef PG8_WAIT_V
#undef PG8_WAIT_L
#undef PG8_BAR
#undef PG8_SCHED
}
}
#define XB_TMO      128
#define XB_XCNT(j)  (256  + 64 * (j))
#define XB_XSUB(j)  (1280 + 64 * (j))
#define XB_XGEN(j)  (2304 + 64 * (j))
#define XB_TOP      3328
#define XB_TOPGEN   3392
#define XCD_BAR_WORDS 3456
#define XB_SPIN_CAP (1u << 18)

__device__ __forceinline__ unsigned xb_ld(unsigned* p)              { return __hip_atomic_load(p, __ATOMIC_RELAXED, __HIP_MEMORY_SCOPE_AGENT); }
__device__ __forceinline__ unsigned xb_add(unsigned* p, unsigned v) { return __hip_atomic_fetch_add(p, v, __ATOMIC_RELAXED, __HIP_MEMORY_SCOPE_AGENT); }
__device__ __forceinline__ unsigned xb_xcc_id() { return (unsigned)__builtin_amdgcn_s_getreg((3 << 11) | 20) & 0xFu; }
#define XB_SPIN(cond, bar) do { unsigned _sp = 0; while (cond) { __builtin_amdgcn_s_sleep(1); \
    if ((++_sp & 255u) == 0u) { if (xb_ld(&(bar)[XB_TMO])) break; if (_sp > XB_SPIN_CAP) { atomicAdd(&(bar)[XB_TMO], 1u); break; } } } } while (0)

struct XcdBarrier {
    unsigned* bar; unsigned x;
    volatile LAS unsigned* st;
};

__device__ __forceinline__ XcdBarrier xcd_barrier_post(unsigned* bar, volatile LAS unsigned* st) {
    XcdBarrier b; b.bar = bar; b.x = xb_xcc_id(); b.st = st;
    if (threadIdx.x == 0) (void)xb_add(&bar[XB_XCNT(b.x)], 1u);
    return b;
}
__device__ __forceinline__ void xcd_barrier_complete(unsigned* bar, unsigned x, unsigned& nloc, unsigned& nx) {
    const unsigned G = gridDim.x * gridDim.y * gridDim.z;
    unsigned sum, cnt, mine, sp = 0u;
    for (;;) {
        sum = 0u; cnt = 0u; mine = 0u;
#pragma unroll
        for (unsigned j = 0; j < 16; ++j) { const unsigned c = xb_ld(&bar[XB_XCNT(j)]); sum += c; cnt += (c > 0u) ? 1u : 0u; mine = (j == x) ? c : mine; }
        if (sum == G) break;
        __builtin_amdgcn_s_sleep(1);
        if ((++sp & 255u) == 0u) { if (xb_ld(&bar[XB_TMO])) break; if (sp > XB_SPIN_CAP) { atomicAdd(&bar[XB_TMO], 1u); break; } }
    }
    nloc = mine > 0u ? mine : 1u; nx = cnt > 0u ? cnt : 1u;
}

__device__ __forceinline__ void xcd_barrier(const XcdBarrier& b) {
    asm volatile("s_waitcnt vmcnt(0)" ::: "memory");
    __syncthreads();
    if (threadIdx.x == 0) {
        unsigned* bar = b.bar;
        __builtin_amdgcn_s_waitcnt(0);
        unsigned nloc = b.st[0], nx = b.st[1];
        if (nloc == 0u) { xcd_barrier_complete(bar, b.x, nloc, nx); b.st[0] = nloc; b.st[1] = nx; }
        const unsigned old = xb_add(&bar[XB_XSUB(b.x)], 1u);
        const unsigned gen = old / nloc;
        if (old + 1u == (gen + 1u) * nloc) {
            __builtin_amdgcn_fence(__ATOMIC_RELEASE, "agent");
            asm volatile("s_waitcnt vmcnt(0)" ::: "memory");
            const unsigned og = xb_add(&bar[XB_TOP], 1u);
            const unsigned tg = og / nx;
            if (og + 1u == (tg + 1u) * nx) xb_add(&bar[XB_TOPGEN], 1u);
            else XB_SPIN(xb_ld(&bar[XB_TOPGEN]) == tg, bar);
            __builtin_amdgcn_fence(__ATOMIC_ACQUIRE, "agent");
            xb_add(&bar[XB_XGEN(b.x)], 1u);
            asm volatile("s_waitcnt vmcnt(0)" ::: "memory");
        } else {
            XB_SPIN(xb_ld(&bar[XB_XGEN(b.x)]) == gen, bar);
            __builtin_amdgcn_fence(__ATOMIC_ACQUIRE, "agent");
            asm volatile("s_waitcnt vmcnt(0)" ::: "memory");
        }
    }
    __syncthreads();
}

typedef unsigned short bf16_t;
typedef short bf16x8 __attribute__((ext_vector_type(8)));
typedef short bf16x4 __attribute__((ext_vector_type(4)));
typedef float f32x4 __attribute__((ext_vector_type(4)));
typedef unsigned u32x4 __attribute__((ext_vector_type(4)));
typedef unsigned u32x2 __attribute__((ext_vector_type(2)));
constexpr int DM = 1024, NBATCH = 8, SEQ = 4096, NTOK = NBATCH * SEQ, DEPTH = 2;
constexpr int INW = 3968, INWP = 4096, FFN = 2816, NMOD = 6;
constexpr int C_AQ = 0, C_AK = 384, C_AV = 768, C_RQ = 1152, C_RK = 1536, C_RV = 1920, C_RG = 2304, C_HQ = 2688, C_HZF = 2944, C_HZB = 3200, C_HI = 3456, C_HG = 3712;
constexpr float NORM_EPS = 1e-6f;
constexpr int NTHREADS = 512;
constexpr int LDS_BYTES = 135168;
constexpr size_t WS_CTL = 0, WS_MOD = 16384, WS_LB = WS_MOD + 393216, WS_HGA = WS_LB + 2048, WS_LSE = WS_HGA + 524288, WS_WIN = WS_LSE + 2359296,
    WS_WOUT = WS_WIN + 16777216, WS_WGU = WS_WOUT + 4194304, WS_WDN = WS_WGU + 23068672, WS_HBUF = WS_WDN + 11534336, WS_PROJ = WS_HBUF + 67108864,
    WS_OB = WS_PROJ + 260046848, WS_RST = WS_OB + 75497472, WS_HGU = WS_RST + 25165824, WS_END = WS_HGU + 33554432;

struct Params {
    const float *x, *c, *w_ada, *b_ada, *g_mix, *w_in, *ret_gn, *hgrn_gn, *lb_logits, *w_out, *g_ffn, *w_gu, *w_down, *g_final;
    float* out; unsigned char* ws; int ph_lo, ph_hi;
};

__device__ __forceinline__ float bf2f(bf16_t v) { return __uint_as_float(((unsigned)v) << 16); }
__device__ __forceinline__ float bflo(unsigned w) { return __uint_as_float(w << 16); }
__device__ __forceinline__ float bfhi(unsigned w) { return __uint_as_float(w & 0xffff0000u); }
__device__ __forceinline__ bf16_t f2bf(float f) { unsigned u = __float_as_uint(f); u += 0x7fffu + ((u >> 16) & 1u); return (bf16_t)(u >> 16); }
typedef float f32x2c __attribute__((ext_vector_type(2)));
typedef __bf16 bf16v2c __attribute__((ext_vector_type(2)));
__device__ __forceinline__ unsigned pk2(float lo, float hi) { const f32x2c v = {lo, hi}; return __builtin_bit_cast(unsigned, __builtin_convertvector(v, bf16v2c)); }
__device__ __forceinline__ bf16x4 pk4(f32x4 v) { u32x2 w; w.x = pk2(v[0], v[1]); w.y = pk2(v[2], v[3]); return __builtin_bit_cast(bf16x4, w); }
__device__ __forceinline__ float siluf(float v) { return v / (1.0f + __expf(-v)); }
__device__ __forceinline__ float wave_sum(float v) {
#pragma unroll
    for (int o = 1; o < 64; o <<= 1) v += __shfl_xor(v, o);
    return v;
}
#define MFMA32(a, b, c) __builtin_amdgcn_mfma_f32_16x16x32_bf16((a), (b), (c), 0, 0, 0)
#define MFMA16(a, b, c) __builtin_amdgcn_mfma_f32_16x16x16bf16_1k((a), (b), (c), 0, 0, 0)

struct EpiProj {
    static constexpr bool PERM = true, AFTER_DRAIN = false;
    bf16_t* O; int ldc, ncols;
    __device__ __forceinline__ void operator()(const f32x4 (&acc)[2][2][4][2], const pg8::Unit& u, int wr, int wc, int fr, int fq) const {
        const int row0 = u.pm * 256 + wr * 64 + fr, col0 = u.pn * 256 + wc * 32 + 8 * fq;
#pragma unroll
        for (int ai = 0; ai < 2; ++ai)
#pragma unroll
            for (int m = 0; m < 4; ++m) { bf16_t* rowp = O + (size_t)(row0 + ai * 128 + m * 16) * ldc + col0;
#pragma unroll
                for (int bj = 0; bj < 2; ++bj) { if (col0 + bj * 128 < ncols) { const f32x4 v0 = acc[ai][bj][m][0], v1 = acc[ai][bj][m][1];
                    u32x4 w; w.x = pk2(v0[0], v0[1]); w.y = pk2(v0[2], v0[3]); w.z = pk2(v1[0], v1[1]); w.w = pk2(v1[2], v1[3]);
                    *(u32x4*)(rowp + bj * 128) = w; } } }
    }
};
struct EpiRes {
    static constexpr bool PERM = false, AFTER_DRAIN = false;
    const float* base; float* out; const float* gate;
    __device__ __forceinline__ void operator()(const f32x4 (&acc)[2][2][4][2], const pg8::Unit& u, int wr, int wc, int fr, int fq) const {
        const int row0 = u.pm * 256 + wr * 64 + fr, col0 = u.pn * 256 + wc * 32 + 4 * fq;
        const float* gp = gate + (size_t)((u.pm * 256) >> 12) * (NMOD * DM) + col0;
        f32x4 gv[2][2];
#pragma unroll
        for (int bj = 0; bj < 2; ++bj)
#pragma unroll
            for (int n = 0; n < 2; ++n) gv[bj][n] = *(const f32x4*)(gp + bj * 128 + n * 16);
#pragma unroll
        for (int ai = 0; ai < 2; ++ai)
#pragma unroll
            for (int m = 0; m < 4; ++m) { const size_t off = (size_t)(row0 + ai * 128 + m * 16) * DM + col0;
#pragma unroll
                for (int bj = 0; bj < 2; ++bj)
#pragma unroll
                    for (int n = 0; n < 2; ++n) { const f32x4 bs = *(const f32x4*)(base + off + bj * 128 + n * 16);
                        *(f32x4*)(out + off + bj * 128 + n * 16) = bs + gv[bj][n] * acc[ai][bj][m][n]; } }
    }
};
struct EpiSwiglu {
    static constexpr bool PERM = true, AFTER_DRAIN = false;
    bf16_t* O;
    __device__ __forceinline__ void operator()(const f32x4 (&acc)[2][2][4][2], const pg8::Unit& u, int wr, int wc, int fr, int fq) const {
        const int row0 = u.pm * 256 + wr * 64 + fr, col0 = u.pn * 128 + wc * 32 + 8 * fq;
#pragma unroll
        for (int ai = 0; ai < 2; ++ai)
#pragma unroll
            for (int m = 0; m < 4; ++m) { bf16_t* rowp = O + (size_t)(row0 + ai * 128 + m * 16) * FFN + col0;
                float r[8];
#pragma unroll
                for (int n = 0; n < 2; ++n)
#pragma unroll
                    for (int i = 0; i < 4; ++i) { const float g = acc[ai][0][m][n][i], uu = acc[ai][1][m][n][i]; r[n * 4 + i] = siluf(g) * uu; }
                u32x4 w; w.x = pk2(r[0], r[1]); w.y = pk2(r[2], r[3]); w.z = pk2(r[4], r[5]); w.w = pk2(r[6], r[7]);
                *(u32x4*)rowp = w; }
    }
};
__device__ __forceinline__ void transpose_item(const float* W, int K, int N, bf16_t* WT, int dst_row0, int src_col0, int k0, LAS float* scr, int lane) {
    if (src_col0 < 0) {
        const int c = lane & 7;
#pragma unroll
        for (int j = 0; j < 4; ++j) { const int n = (lane >> 3) + 8 * j; *(u32x4*)(WT + (size_t)(dst_row0 + n) * K + k0 + 8 * c) = (u32x4){0u, 0u, 0u, 0u}; }
        return;
    }
#pragma unroll 8
    for (int i = 0; i < 32; ++i) { const int kk = 2 * i + (lane >> 5); scr[kk * 33 + (lane & 31)] = W[(size_t)(k0 + kk) * N + src_col0 + (lane & 31)]; }
    __builtin_amdgcn_fence(__ATOMIC_RELEASE, "wavefront"); __builtin_amdgcn_wave_barrier(); __builtin_amdgcn_fence(__ATOMIC_ACQUIRE, "wavefront");
    const int c = lane & 7;
#pragma unroll
    for (int j = 0; j < 4; ++j) { const int n = (lane >> 3) + 8 * j; const LAS float* s = scr + (8 * c) * 33 + n;
        u32x4 o; o.x = pk2(s[0 * 33], s[1 * 33]); o.y = pk2(s[2 * 33], s[3 * 33]); o.z = pk2(s[4 * 33], s[5 * 33]); o.w = pk2(s[6 * 33], s[7 * 33]);
        *(u32x4*)(WT + (size_t)(dst_row0 + n) * K + k0 + 8 * c) = o; }
    __builtin_amdgcn_fence(__ATOMIC_RELEASE, "wavefront"); __builtin_amdgcn_wave_barrier(); __builtin_amdgcn_fence(__ATOMIC_ACQUIRE, "wavefront");
}

__device__ __forceinline__ void phase_weights(const Params& P, LAS unsigned char* lds) {
    const int tid = opaque_tid(), lane = tid & 63, wave = __builtin_amdgcn_readfirstlane(tid >> 6);
    unsigned char* ws = P.ws;
    {
        LAS float* scr = (LAS float*)(lds + wave * 8704);
        const int gw = blockIdx.x * 8 + wave, NGW = gridDim.x * 8;
        constexpr int I_IN = 16 * 128, I_OUT = 16 * 32, I_GU = 16 * 176, I_DN = 44 * 32, I_L = I_IN + I_OUT + I_GU + I_DN;
        for (int it = gw; it < DEPTH * I_L; it += NGW) {
            const int l = it / I_L; int r = it % I_L;
            if (r < I_IN) { const int kb = r / 128, nb = r % 128, n0 = nb * 32;
                transpose_item(P.w_in + (size_t)l * DM * INW, DM, INW, (bf16_t*)(ws + WS_WIN) + (size_t)l * INWP * DM, n0, n0 < INW ? n0 : -1, kb * 64, scr, lane); continue; }
            r -= I_IN;
            if (r < I_OUT) { const int kb = r / 32, nb = r % 32;
                transpose_item(P.w_out + (size_t)l * DM * DM, DM, DM, (bf16_t*)(ws + WS_WOUT) + (size_t)l * DM * DM, nb * 32, nb * 32, kb * 64, scr, lane); continue; }
            r -= I_OUT;
            if (r < I_GU) { const int kb = r / 176, nb = r % 176, n0 = nb * 32; const int pn = n0 >> 8, half = (n0 >> 7) & 1, jj = n0 & 127;
                transpose_item(P.w_gu + (size_t)l * DM * 2 * FFN, DM, 2 * FFN, (bf16_t*)(ws + WS_WGU) + (size_t)l * 2 * FFN * DM, n0, half * FFN + pn * 128 + jj, kb * 64, scr, lane); continue; }
            r -= I_GU;
            { const int kb = r / 32, nb = r % 32;
                transpose_item(P.w_down + (size_t)l * FFN * DM, FFN, DM, (bf16_t*)(ws + WS_WDN) + (size_t)l * DM * FFN, nb * 32, nb * 32, kb * 64, scr, lane); }
        }
    }
}
__device__ __forceinline__ void phase_prologue(const Params& P, LAS unsigned char* lds) {
    const int tid = opaque_tid();
    unsigned char* ws = P.ws;
    {
        LAS float* sc = (LAS float*)lds;
        LAS float* red = (LAS float*)(lds + 32768);
        for (int i = tid; i < NBATCH * DM; i += NTHREADS) sc[i] = siluf(P.c[i]);
        __syncthreads();
        float* mod = (float*)(ws + WS_MOD);
        for (int u = blockIdx.x; u < DEPTH * 96; u += gridDim.x) {
            const int l = u / 96, j0 = (u % 96) * 64, col = tid & 63, kp = tid >> 6;
            float acc[8];
#pragma unroll
            for (int b = 0; b < 8; ++b) acc[b] = 0.f;
            const float* wp = P.w_ada + (size_t)l * DM * (NMOD * DM) + j0 + col;
            for (int k = kp * 128; k < kp * 128 + 128; ++k) { const float w = wp[(size_t)k * (NMOD * DM)];
#pragma unroll
                for (int b = 0; b < 8; ++b) acc[b] += sc[b * DM + k] * w; }
#pragma unroll
            for (int b = 0; b < 8; ++b) red[(kp * 8 + b) * 64 + col] = acc[b];
            __syncthreads();
            { const int b = tid >> 6; float s = 0.f;
#pragma unroll
              for (int p = 0; p < 8; ++p) s += red[(p * 8 + b) * 64 + col];
              mod[((size_t)l * NBATCH + b) * (NMOD * DM) + j0 + col] = s + P.b_ada[(size_t)l * NMOD * DM + j0 + col]; }
            __syncthreads();
        }
    }
    if (blockIdx.x == 0 && tid < 256) {
        const float l0 = P.lb_logits[tid], l1 = P.lb_logits[256 + tid], m = fmaxf(l0, l1), e0 = __expf(l0 - m), e1 = __expf(l1 - m);
        const float p0 = e0 / (e0 + e1), p1 = e1 / (e0 + e1);
        float* lb = (float*)(ws + WS_LB);
        lb[tid] = fminf(fmaxf(p0 - p0, 0.f), 1.0f - 1e-6f);
        lb[256 + tid] = fminf(fmaxf((p0 + p1) - p0, 0.f), 1.0f - 1e-6f);
    }
}

template <bool HAS_Y, bool FINAL>
__device__ __forceinline__ void phase_norm(const float* src, const bf16_t* y, const float* gate, float* xout, const float* g, const float* shift, const float* scale, bf16_t* dst) {
    const int tid = opaque_tid(), lane = tid & 63, wave = tid >> 6;
    const int gw = blockIdx.x * 8 + wave, NGW = gridDim.x * 8;
    f32x4 gv[4];
#pragma unroll
    for (int j = 0; j < 4; ++j) gv[j] = *(const f32x4*)(g + 4 * lane + 256 * j);
    for (int row = gw; row < NTOK; row += NGW) {
        const int b = row >> 12;
        const f32x4* xr = (const f32x4*)(src + (size_t)row * DM) + lane;
        f32x4 v[4]; float s = 0.f;
#pragma unroll
        for (int j = 0; j < 4; ++j) v[j] = xr[64 * j];
        if (HAS_Y) {
            const u32x2* yr = (const u32x2*)(y + (size_t)row * DM) + lane;
#pragma unroll
            for (int j = 0; j < 4; ++j) { const u32x2 yw = yr[64 * j]; const f32x4 gt = *(const f32x4*)(gate + (size_t)b * (NMOD * DM) + 4 * lane + 256 * j);
                v[j][0] += gt[0] * bflo(yw.x); v[j][1] += gt[1] * bfhi(yw.x); v[j][2] += gt[2] * bflo(yw.y); v[j][3] += gt[3] * bfhi(yw.y); }
        }
#pragma unroll
        for (int j = 0; j < 4; ++j) s += (v[j][0] * v[j][0] + v[j][1] * v[j][1]) + (v[j][2] * v[j][2] + v[j][3] * v[j][3]);
        const float rstd = rsqrtf(wave_sum(s) * (1.0f / DM) + NORM_EPS);
        f32x4* xo = (f32x4*)(xout + (size_t)row * DM) + lane;
        if (FINAL) {
#pragma unroll
            for (int j = 0; j < 4; ++j) xo[64 * j] = v[j] * rstd * gv[j];
        } else {
            if (HAS_Y) {
#pragma unroll
                for (int j = 0; j < 4; ++j) xo[64 * j] = v[j];
            }
            unsigned long long* o8 = (unsigned long long*)(dst + (size_t)row * DM) + lane;
#pragma unroll
            for (int j = 0; j < 4; ++j) {
                const f32x4 sc = *(const f32x4*)(scale + (size_t)b * (NMOD * DM) + 4 * lane + 256 * j), sh = *(const f32x4*)(shift + (size_t)b * (NMOD * DM) + 4 * lane + 256 * j);
                const f32x4 h = v[j] * rstd * gv[j] * (sc + 1.0f) + sh;
                o8[64 * j] = (unsigned long long)pk2(h[0], h[1]) | ((unsigned long long)pk2(h[2], h[3]) << 32);
            }
        }
    }
}
__device__ __forceinline__ bf16x4 tr4(const LAS bf16_t* img, int pitch, int row0, int col0, int g, int q) {
    return __builtin_amdgcn_ds_read_tr16_b64_v4i16((LAS bf16x4*)(img + (row0 + 4 * g + (q >> 2)) * pitch + col0 + 4 * (q & 3)));
}
__device__ __forceinline__ bf16x8 tr8(const LAS bf16_t* img, int pitch, int row0, int col0, int g, int q) {
    const bf16x4 lo = __builtin_amdgcn_ds_read_tr16_b64_v4i16((LAS bf16x4*)(img + (row0 + 8 * g + (q >> 2)) * pitch + col0 + 4 * (q & 3)));
    const bf16x4 hi = __builtin_amdgcn_ds_read_tr16_b64_v4i16((LAS bf16x4*)(img + (row0 + 8 * g + 4 + (q >> 2)) * pitch + col0 + 4 * (q & 3)));
    return __builtin_shufflevector(lo, hi, 0, 1, 2, 3, 4, 5, 6, 7);
}
struct AttRegs { u32x4 kv[4], vv[4]; bf16x8 qf[2]; };
__device__ __forceinline__ void att_decode(int u, int& br, int& b, int& h, int& r, int& L, int& p0, int& tok0) {
    br = u / 1536; const int v = u % 1536; b = v / 192; h = (v >> 5) % 6; const int w = v & 31;
    const int lr = br * 2, nblk = 32 >> lr, rho = w / nblk, blk = w % nblk; r = 1 << lr; L = SEQ >> lr; p0 = blk * 128; tok0 = b * SEQ + rho;
}
__device__ __forceinline__ void att_load(const Params& P, int u, int tid, AttRegs& R) {
    int br, b, h, r, L, p0, tok0; att_decode(u, br, b, h, r, L, p0, tok0);
    const bf16_t* proj = (const bf16_t*)(P.ws + WS_PROJ);
    const int key = tid >> 1, half = tid & 1, kj = p0 - 64 + key;
    if (kj >= 0 && kj < L) {
        const bf16_t* src = proj + (size_t)(tok0 + r * kj) * INW + h * 64 + half * 32;
#pragma unroll
        for (int i = 0; i < 4; ++i) { R.kv[i] = *(const u32x4*)(src + C_AK + 8 * i); R.vv[i] = *(const u32x4*)(src + C_AV + 8 * i); }
    } else {
#pragma unroll
        for (int i = 0; i < 4; ++i) { R.kv[i] = (u32x4){0u, 0u, 0u, 0u}; R.vv[i] = (u32x4){0u, 0u, 0u, 0u}; }
    }
    const int lane = tid & 63, wave = tid >> 6, q = lane & 15, g = lane >> 4;
    const size_t tokq = (size_t)(tok0 + r * (p0 + 16 * wave + q));
#pragma unroll
    for (int kk = 0; kk < 2; ++kk) R.qf[kk] = *(const bf16x8*)(proj + tokq * INW + C_AQ + h * 64 + kk * 32 + 8 * g);
}
__device__ __forceinline__ void att_phase(const Params& P, LAS unsigned char* lds) {
    const int tid = opaque_tid(), lane = tid & 63, wave = __builtin_amdgcn_readfirstlane(tid >> 6), q = lane & 15, g = lane >> 4;
    LAS bf16_t* Ks = (LAS bf16_t*)lds;
    LAS bf16_t* Vs = (LAS bf16_t*)(lds + 36864);
    int u = blockIdx.x; if (u >= 4608) return;
    AttRegs R; att_load(P, u, tid, R);
    for (; u < 4608; u += gridDim.x) {
        int br, b, h, r, L, p0, tok0; att_decode(u, br, b, h, r, L, p0, tok0);
        {
            const int key = tid >> 1, half = tid & 1;
#pragma unroll
            for (int i = 0; i < 4; ++i) { *(LAS u32x4*)(Ks + key * 72 + half * 32 + 8 * i) = R.kv[i]; *(LAS u32x4*)(Vs + key * 72 + half * 32 + 8 * i) = R.vv[i]; }
        }
        bf16x8 qf[2]; qf[0] = R.qf[0]; qf[1] = R.qf[1];
        __syncthreads();
        if (u + (int)gridDim.x < 4608) att_load(P, u + gridDim.x, tid, R);
        const int p = p0 + 16 * wave + q; const size_t tokq = (size_t)(tok0 + r * p);
        const float slope_r = exp2f(-8.0f * (float)(h + 1) / 6.0f) * (float)r;
        f32x4 st[9]; float mx = -3.0e38f;
#pragma unroll
        for (int t = 0; t < 9; ++t) {
            f32x4 acc = {0.f, 0.f, 0.f, 0.f};
#pragma unroll
            for (int kk = 0; kk < 2; ++kk) { const bf16x8 a = *(const LAS bf16x8*)(Ks + (16 * wave + 16 * t + q) * 72 + kk * 32 + 8 * g); acc = MFMA32(a, qf[kk], acc); }
#pragma unroll
            for (int j = 0; j < 4; ++j) {
                const int kl = 16 * wave + 16 * t + 4 * g + j, kj = p0 - 64 + kl; int dist = p - kj; dist = dist < 0 ? -dist : dist;
                const bool valid = (kj >= 0) && (kj < L) && (dist <= 64);
                const float s = valid ? acc[j] * 0.125f - slope_r * (float)dist : -1.0e30f;
                acc[j] = s; mx = fmaxf(mx, s);
            }
            st[t] = acc;
        }
        mx = fmaxf(mx, __shfl_xor(mx, 16)); mx = fmaxf(mx, __shfl_xor(mx, 32));
        float ls = 0.f; bf16x4 pt[9];
#pragma unroll
        for (int t = 0; t < 9; ++t) { f32x4 e;
#pragma unroll
            for (int j = 0; j < 4; ++j) { e[j] = (st[t][j] > -1.0e29f) ? __expf(st[t][j] - mx) : 0.f; ls += e[j]; }
            pt[t] = pk4(e); }
        ls += __shfl_xor(ls, 16); ls += __shfl_xor(ls, 32);
        const float inv = 1.0f / ls;
        bf16_t* ob = (bf16_t*)(P.ws + WS_OB) + ((size_t)br * NTOK + tokq) * 384 + h * 64;
        const LAS bf16_t* vrd = Vs + (16 * wave + 4 * g + (q >> 2)) * 72 + 4 * (q & 3);
#pragma unroll
        for (int dt = 0; dt < 4; ++dt) {
            f32x4 acc = {0.f, 0.f, 0.f, 0.f};
#pragma unroll
            for (int t = 0; t < 9; ++t) { const bf16x4 a = __builtin_amdgcn_ds_read_tr16_b64_v4i16((LAS bf16x4*)(vrd + 16 * t * 72 + dt * 16)); acc = MFMA16(a, pt[t], acc); }
            acc = acc * inv;
            *(bf16x4*)(ob + dt * 16 + 4 * g) = pk4(acc);
        }
        if (g == 0) ((float*)(P.ws + WS_LSE))[((size_t)br * NTOK + tokq) * 6 + h] = mx + __logf(ls);
        __syncthreads();
    }
}
__device__ __forceinline__ void att_merge(const Params& P) {
    const bf16_t* ob = (const bf16_t*)(P.ws + WS_OB); const float* lse = (const float*)(P.ws + WS_LSE); bf16_t* mixed = (bf16_t*)(P.ws + WS_HBUF);
    for (size_t it = (size_t)blockIdx.x * NTHREADS + opaque_tid(); it < (size_t)NTOK * 48; it += (size_t)gridDim.x * NTHREADS) {
        const size_t tok = it / 48; const int grp = (int)(it % 48), h = grp >> 3;
        const float l0 = lse[tok * 6 + h], l1 = lse[((size_t)NTOK + tok) * 6 + h], l2 = lse[((size_t)2 * NTOK + tok) * 6 + h];
        const float m = fmaxf(l0, fmaxf(l1, l2)), e0 = __expf(l0 - m), e1 = __expf(l1 - m), e2 = __expf(l2 - m), is = 1.0f / (e0 + e1 + e2);
        const float w0 = e0 * is, w1 = e1 * is, w2 = e2 * is;
        const u32x4 a = *(const u32x4*)(ob + tok * 384 + grp * 8), bq = *(const u32x4*)(ob + ((size_t)NTOK + tok) * 384 + grp * 8), cq = *(const u32x4*)(ob + ((size_t)2 * NTOK + tok) * 384 + grp * 8);
        u32x4 o;
#pragma unroll
        for (int i = 0; i < 4; ++i) o[i] = pk2(w0 * bflo(a[i]) + w1 * bflo(bq[i]) + w2 * bflo(cq[i]), w0 * bfhi(a[i]) + w1 * bfhi(bq[i]) + w2 * bfhi(cq[i]));
        *(u32x4*)(mixed + tok * DM + grp * 8) = o;
    }
}

__device__ __forceinline__ float ret_logg(int h) { return log1pf(-exp2f(-5.0f - (float)h)); }
struct RetARegs { u32x4 k0, k1, v0, v1; };
__device__ __forceinline__ void retA_load(const Params& P, int u, int tid, RetARegs& R) {
    const int bh = u >> 5, n = u & 31, b = bh / 6, h = bh % 6, c = tid >> 2, qd = tid & 3;
    const bf16_t* src = (const bf16_t*)(P.ws + WS_PROJ) + (size_t)(b * SEQ + n * 128 + c) * INW + h * 64 + qd * 16;
    R.k0 = *(const u32x4*)(src + C_RK); R.k1 = *(const u32x4*)(src + C_RK + 8); R.v0 = *(const u32x4*)(src + C_RV); R.v1 = *(const u32x4*)(src + C_RV + 8);
}
__device__ __forceinline__ void retA_phase(const Params& P, LAS unsigned char* lds) {
    const int tid = opaque_tid(), lane = tid & 63, wave = __builtin_amdgcn_readfirstlane(tid >> 6), q = lane & 15, g = lane >> 4;
    LAS bf16_t* Kf = (LAS bf16_t*)lds; LAS bf16_t* Kb = (LAS bf16_t*)(lds + 18432); LAS bf16_t* Vs = (LAS bf16_t*)(lds + 36864);
    int u = blockIdx.x; if (u >= 1536) return;
    RetARegs R; retA_load(P, u, tid, R);
    for (; u < 1536; u += gridDim.x) {
        const int bh = u >> 5, n = u & 31, h = bh % 6;
        const float lg = ret_logg(h);
        {
            const int c = tid >> 2, qd = tid & 3;
            const float wf = 0.125f * __expf(lg * (float)(127 - c)), wb = 0.125f * __expf(lg * (float)c);
            u32x4 f0, f1, b0, b1;
#pragma unroll
            for (int e = 0; e < 4; ++e) { f0[e] = pk2(bflo(R.k0[e]) * wf, bfhi(R.k0[e]) * wf); f1[e] = pk2(bflo(R.k1[e]) * wf, bfhi(R.k1[e]) * wf);
                b0[e] = pk2(bflo(R.k0[e]) * wb, bfhi(R.k0[e]) * wb); b1[e] = pk2(bflo(R.k1[e]) * wb, bfhi(R.k1[e]) * wb); }
            *(LAS u32x4*)(Kf + c * 72 + qd * 16) = f0; *(LAS u32x4*)(Kf + c * 72 + qd * 16 + 8) = f1;
            *(LAS u32x4*)(Kb + c * 72 + qd * 16) = b0; *(LAS u32x4*)(Kb + c * 72 + qd * 16 + 8) = b1;
            *(LAS u32x4*)(Vs + c * 72 + qd * 16) = R.v0; *(LAS u32x4*)(Vs + c * 72 + qd * 16 + 8) = R.v1;
        }
        __syncthreads();
        if (u + (int)gridDim.x < 1536) retA_load(P, u + gridDim.x, tid, R);
        const int dir = wave >> 2, dt = wave & 3; const LAS bf16_t* Kt = dir ? Kb : Kf;
        bf16x8 afr[4];
#pragma unroll
        for (int kk = 0; kk < 4; ++kk) afr[kk] = tr8(Kt, 72, kk * 32, dt * 16, g, q);
        bf16_t* dst = (bf16_t*)(P.ws + WS_RST) + ((size_t)(bh * 32 + n) * 2 + dir) * 4096;
#pragma unroll
        for (int et = 0; et < 4; ++et) {
            f32x4 acc = {0.f, 0.f, 0.f, 0.f};
#pragma unroll
            for (int kk = 0; kk < 4; ++kk) { const bf16x8 bfr = tr8(Vs, 72, kk * 32, et * 16, g, q); acc = MFMA32(afr[kk], bfr, acc); }
            *(bf16x4*)(dst + (et * 16 + q) * 64 + dt * 16 + 4 * g) = pk4(acc);
        }
        __syncthreads();
    }
}
__device__ __forceinline__ void ret_scan(const Params& P) {
    bf16_t* st = (bf16_t*)(P.ws + WS_RST);
    for (int it = blockIdx.x * NTHREADS + opaque_tid(); it < 48 * 2 * 512; it += gridDim.x * NTHREADS) {
        const int ch = it & 511, dir = (it >> 9) & 1, bh = it >> 10, h = bh % 6;
        const float cd = __expf(ret_logg(h) * 128.0f);
        float s[8];
#pragma unroll
        for (int e = 0; e < 8; ++e) s[e] = 0.f;
        for (int i0 = 0; i0 < 32; i0 += 8) {
            u32x4 v[8];
#pragma unroll
            for (int i = 0; i < 8; ++i) { const int n = dir ? 31 - (i0 + i) : (i0 + i); v[i] = *(const u32x4*)(st + ((size_t)(bh * 32 + n) * 2 + dir) * 4096 + 8 * ch); }
#pragma unroll
            for (int i = 0; i < 8; ++i) { const int n = dir ? 31 - (i0 + i) : (i0 + i);
                u32x4 o;
#pragma unroll
                for (int e = 0; e < 4; ++e) o[e] = pk2(s[2 * e], s[2 * e + 1]);
                *(u32x4*)(st + ((size_t)(bh * 32 + n) * 2 + dir) * 4096 + 8 * ch) = o;
#pragma unroll
                for (int e = 0; e < 4; ++e) { s[2 * e] = cd * s[2 * e] + bflo(v[i][e]); s[2 * e + 1] = cd * s[2 * e + 1] + bfhi(v[i][e]); } }
        }
    }
}
struct RetBRegs { u32x4 k0, k1, v0, v1, rf, rb, q0, q1; };
__device__ __forceinline__ void retB_load(const Params& P, int u, int tid, RetBRegs& R) {
    const int bh = u >> 5, n = u & 31, b = bh / 6, h = bh % 6, c = tid >> 2, qd = tid & 3;
    const bf16_t* proj = (const bf16_t*)(P.ws + WS_PROJ);
    const bf16_t* src = proj + (size_t)(b * SEQ + n * 128 + c) * INW + h * 64 + qd * 16;
    R.k0 = *(const u32x4*)(src + C_RK); R.k1 = *(const u32x4*)(src + C_RK + 8); R.v0 = *(const u32x4*)(src + C_RV); R.v1 = *(const u32x4*)(src + C_RV + 8);
    const bf16_t* rs = (const bf16_t*)(P.ws + WS_RST) + (size_t)(bh * 32 + n) * 2 * 4096;
    const int e = tid >> 3, d8 = (tid & 7) * 8;
    R.rf = *(const u32x4*)(rs + e * 64 + d8); R.rb = *(const u32x4*)(rs + 4096 + e * 64 + d8);
    const int lane = tid & 63, wave = tid >> 6, q = lane & 15, g = lane >> 4;
    const bf16_t* qp = proj + (size_t)(b * SEQ + n * 128 + 16 * wave + q) * INW + C_RQ + h * 64 + 8 * g;
    R.q0 = *(const u32x4*)qp; R.q1 = *(const u32x4*)(qp + 32);
}
__device__ __forceinline__ void retB_phase(const Params& P, LAS unsigned char* lds, int layer) {
    const int tid = opaque_tid(), lane = tid & 63, wave = __builtin_amdgcn_readfirstlane(tid >> 6), q = lane & 15, g = lane >> 4;
    const bf16_t* proj = (const bf16_t*)(P.ws + WS_PROJ);
    LAS bf16_t* Ks = (LAS bf16_t*)lds;
    LAS bf16_t* Vs = (LAS bf16_t*)(lds + 18432);
    LAS bf16_t* Rf = (LAS bf16_t*)(lds + 36864);
    LAS bf16_t* Rb = (LAS bf16_t*)(lds + 46080);
    int u = blockIdx.x; if (u >= 1536) return;
    RetBRegs R; retB_load(P, u, tid, R);
    for (; u < 1536; u += gridDim.x) {
        const int bh = u >> 5, n = u & 31, b = bh / 6, h = bh % 6;
        const float lg = ret_logg(h);
        {
            const int c = tid >> 2, qd = tid & 3, e = tid >> 3, d8 = (tid & 7) * 8;
            *(LAS u32x4*)(Ks + c * 72 + qd * 16) = R.k0; *(LAS u32x4*)(Ks + c * 72 + qd * 16 + 8) = R.k1;
            *(LAS u32x4*)(Vs + c * 72 + qd * 16) = R.v0; *(LAS u32x4*)(Vs + c * 72 + qd * 16 + 8) = R.v1;
            *(LAS u32x4*)(Rf + e * 72 + d8) = R.rf; *(LAS u32x4*)(Rb + e * 72 + d8) = R.rb;
        }
        const u32x4 qraw[2] = {R.q0, R.q1};
        __syncthreads();
        if (u + (int)gridDim.x < 1536) retB_load(P, u + gridDim.x, tid, R);
        const int i = 16 * wave + q; const size_t tok = (size_t)(b * SEQ + n * 128 + i);
        bf16x8 qf[2], qff[2], qfb[2];
        {
            const float ff = __expf(lg * (float)(i + 1)), fb = __expf(lg * (float)(128 - i));
#pragma unroll
            for (int kk = 0; kk < 2; ++kk) { const u32x4 raw = qraw[kk];
                qf[kk] = __builtin_bit_cast(bf16x8, raw); u32x4 a, c2;
#pragma unroll
                for (int e = 0; e < 4; ++e) { const float lo = bflo(raw[e]), hi = bfhi(raw[e]); a[e] = pk2(lo * ff, hi * ff); c2[e] = pk2(lo * fb, hi * fb); }
                qff[kk] = __builtin_bit_cast(bf16x8, a); qfb[kk] = __builtin_bit_cast(bf16x8, c2); }
        }
        bf16x4 pt[8];
#pragma unroll
        for (int jt = 0; jt < 8; ++jt) {
            f32x4 acc = {0.f, 0.f, 0.f, 0.f};
#pragma unroll
            for (int kk = 0; kk < 2; ++kk) { const bf16x8 a = *(const LAS bf16x8*)(Ks + (16 * jt + q) * 72 + kk * 32 + 8 * g); acc = MFMA32(a, qf[kk], acc); }
#pragma unroll
            for (int jj = 0; jj < 4; ++jj) { int dd = i - (16 * jt + 4 * g + jj); dd = dd < 0 ? -dd : dd; acc[jj] = acc[jj] * 0.125f * __expf(lg * (float)dd); }
            pt[jt] = pk4(acc);
        }
        f32x4 o[4];
#pragma unroll
        for (int et = 0; et < 4; ++et) {
            f32x4 acc = {0.f, 0.f, 0.f, 0.f};
#pragma unroll
            for (int jt = 0; jt < 8; ++jt) { const bf16x4 a = tr4(Vs, 72, 16 * jt, et * 16, g, q); acc = MFMA16(a, pt[jt], acc); }
#pragma unroll
            for (int kk = 0; kk < 2; ++kk) { const bf16x8 a = *(const LAS bf16x8*)(Rf + (et * 16 + q) * 72 + kk * 32 + 8 * g); acc = MFMA32(a, qff[kk], acc);
                const bf16x8 a2 = *(const LAS bf16x8*)(Rb + (et * 16 + q) * 72 + kk * 32 + 8 * g); acc = MFMA32(a2, qfb[kk], acc); }
            o[et] = acc;
        }
        float s = 0.f;
#pragma unroll
        for (int et = 0; et < 4; ++et) s += (o[et][0] + o[et][1]) + (o[et][2] + o[et][3]);
        s += __shfl_xor(s, 16); s += __shfl_xor(s, 32);
        const float mu = s * (1.0f / 64.0f); float vs = 0.f;
#pragma unroll
        for (int et = 0; et < 4; ++et) { o[et] = o[et] - mu; vs += (o[et][0] * o[et][0] + o[et][1] * o[et][1]) + (o[et][2] * o[et][2] + o[et][3] * o[et][3]); }
        vs += __shfl_xor(vs, 16); vs += __shfl_xor(vs, 32);
        const float rstd = rsqrtf(vs * (1.0f / 64.0f) + NORM_EPS);
        bf16_t* mixed = (bf16_t*)(P.ws + WS_HBUF) + tok * DM + 384 + h * 64;
#pragma unroll
        for (int et = 0; et < 4; ++et) {
            const f32x4 gn = *(const f32x4*)(P.ret_gn + layer * 384 + h * 64 + et * 16 + 4 * g);
            const u32x2 rg = *(const u32x2*)(proj + tok * INW + C_RG + h * 64 + et * 16 + 4 * g);
            f32x4 y; y[0] = o[et][0] * rstd * gn[0] * siluf(bflo(rg.x)); y[1] = o[et][1] * rstd * gn[1] * siluf(bfhi(rg.x));
            y[2] = o[et][2] * rstd * gn[2] * siluf(bflo(rg.y)); y[3] = o[et][3] * rstd * gn[3] * siluf(bfhi(rg.y));
            *(bf16x4*)(mixed + et * 16 + 4 * g) = pk4(y);
        }
        __syncthreads();
    }
}
__device__ __forceinline__ void hgrn_gate(float z, float lbv, float& f, float& kk) {
    z = fminf(fmaxf(z, -30.f), 30.f);
    const float ez = __expf(-z), sg = __builtin_amdgcn_rcpf(1.0f + ez);
    f = lbv + (1.0f - lbv) * sg; kk = (1.0f - lbv) * ez * sg;
}
__device__ __forceinline__ void hgA_unit(const Params& P, LAS unsigned char* lds, int u, int layer) {
    const int tid = opaque_tid(), lane = tid & 63, wave = __builtin_amdgcn_readfirstlane(tid >> 6), q = lane & 15, g = lane >> 4;
    const int bh = u >> 5, n = u & 31, b = bh >> 2, h = bh & 3;
    const bf16_t* proj = (const bf16_t*)(P.ws + WS_PROJ);
    LAS bf16_t* Kt = (LAS bf16_t*)lds;
    LAS bf16_t* Vt = (LAS bf16_t*)(lds + 34816);
    LAS float* segs = (LAS float*)(lds + 52224);
    const size_t tokc = (size_t)(b * SEQ + n * 128);
    {
        const int c = tid >> 2, qd = tid & 3; const bf16_t* src = proj + (tokc + c) * INW + C_HI + h * 64 + qd * 16;
        const u32x4 v0 = *(const u32x4*)src, v1 = *(const u32x4*)(src + 8);
#pragma unroll
        for (int e = 0; e < 8; ++e) { const unsigned vw = e < 4 ? v0[e & 3] : v1[e & 3]; const int d = qd * 16 + 2 * e;
            Vt[d * 136 + c] = (bf16_t)(vw & 0xffffu); Vt[(d + 1) * 136 + c] = (bf16_t)(vw >> 16); }
    }
    const int d = tid & 63, dir = (tid >> 6) & 1, seg = tid >> 7;
    const float lbv = ((const float*)(P.ws + WS_LB))[layer * 256 + h * 64 + d];
    float lf[32], kk[32];
    {
        const bf16_t* zp = proj + (tokc + seg * 32) * INW + (dir ? C_HZB : C_HZF) + h * 64 + d;
        bf16_t zr[32];
#pragma unroll
        for (int i = 0; i < 32; ++i) zr[i] = zp[(size_t)i * INW];
#pragma unroll
        for (int i = 0; i < 32; ++i) hgrn_gate(bf2f(zr[i]), lbv, lf[i], kk[i]);
    }
    float ssum = 1.f;
#pragma unroll
    for (int i = 0; i < 32; ++i) ssum *= lf[i];
    segs[(dir * 4 + seg) * 64 + d] = ssum;
    __syncthreads();
    {
        float before = 1.f, after = 1.f;
#pragma unroll
        for (int s2 = 0; s2 < 4; ++s2) { const float v = segs[(dir * 4 + s2) * 64 + d]; if (s2 < seg) before *= v; if (s2 > seg) after *= v; }
        LAS bf16_t* kt = Kt + dir * (64 * 136) + d * 136 + seg * 32;
        if (dir == 0) {
            float run = after;
#pragma unroll
            for (int i = 31; i >= 0; --i) { kt[i] = f2bf(kk[i] * run); run *= lf[i]; }
        } else {
            float run = before;
#pragma unroll
            for (int i = 0; i < 32; ++i) { kt[i] = f2bf(kk[i] * run); run *= lf[i]; }
        }
        if (seg == 0) ((float*)(P.ws + WS_HGA))[((size_t)(bh * 2 + dir) * 32 + n) * 64 + d] = ssum * after;
    }
    __syncthreads();
    {
        const int wdir = wave >> 2, dt = wave & 3; const LAS bf16_t* kts = Kt + wdir * (64 * 136);
        bf16x8 afr[4];
#pragma unroll
        for (int kq = 0; kq < 4; ++kq) afr[kq] = *(const LAS bf16x8*)(kts + (dt * 16 + q) * 136 + kq * 32 + 8 * g);
        float* dst = (float*)(P.ws + WS_HGU) + ((size_t)(bh * 2 + wdir) * 32 + n) * 4096;
#pragma unroll
        for (int et = 0; et < 4; ++et) {
            f32x4 acc = {0.f, 0.f, 0.f, 0.f};
#pragma unroll
            for (int kq = 0; kq < 4; ++kq) { const bf16x8 bfr = *(const LAS bf16x8*)(Vt + (et * 16 + q) * 136 + kq * 32 + 8 * g); acc = MFMA32(afr[kq], bfr, acc); }
#pragma unroll
            for (int j = 0; j < 4; ++j) dst[(dt * 16 + 4 * g + j) * 64 + et * 16 + q] = acc[j];
        }
    }
    __syncthreads();
}
__device__ __forceinline__ void hg_scan(const Params& P) {
    float* U = (float*)(P.ws + WS_HGU); const float* A = (const float*)(P.ws + WS_HGA);
    for (int it = blockIdx.x * NTHREADS + opaque_tid(); it < 64 * 64 * 16; it += gridDim.x * NTHREADS) {
        const int e4 = it & 15, d = (it >> 4) & 63, bd = it >> 10, dir = bd & 1;
        f32x4 s = {0.f, 0.f, 0.f, 0.f};
        for (int i0 = 0; i0 < 32; i0 += 8) {
            f32x4 v[8]; float a[8];
#pragma unroll
            for (int i = 0; i < 8; ++i) { const int n = dir ? 31 - (i0 + i) : (i0 + i); v[i] = *(const f32x4*)(U + ((size_t)(bd * 32 + n) * 64 + d) * 64 + 4 * e4); a[i] = A[(size_t)(bd * 32 + n) * 64 + d]; }
#pragma unroll
            for (int i = 0; i < 8; ++i) { const int n = dir ? 31 - (i0 + i) : (i0 + i); *(f32x4*)(U + ((size_t)(bd * 32 + n) * 64 + d) * 64 + 4 * e4) = s; s = s * a[i] + v[i]; }
        }
    }
}
__device__ __forceinline__ unsigned pk2h(float lo, float hi) { return pk2(lo, hi); }
__device__ __forceinline__ bf16x4 pk4h(f32x4 v) { return pk4(v); }
__device__ __forceinline__ void hgB_unit(const Params& P, LAS unsigned char* lds, int u, int layer) {
    const int tid = opaque_tid(), lane = tid & 63, wave = __builtin_amdgcn_readfirstlane(tid >> 6), q = lane & 15, g = lane >> 4;
    const int b = u >> 5, n = u & 31, h = wave >> 1, dir = wave & 1, bh = b * 4 + h;
    bf16_t* proj = (bf16_t*)(P.ws + WS_PROJ);
    bf16_t* mixed = (bf16_t*)(P.ws + WS_HBUF);
    LAS unsigned char* wl = lds + wave * 7168;
    LAS bf16_t* Qi = (LAS bf16_t*)wl;
    LAS bf16_t* Ki = (LAS bf16_t*)(wl + 2304);
    LAS bf16_t* Vs = (LAS bf16_t*)(wl + 4608);
    LAS float* Al = (LAS float*)(wl + 6912);
    const size_t tokc = (size_t)(b * SEQ + n * 128);
    const float lbv = ((const float*)(P.ws + WS_LB))[layer * 256 + h * 64 + lane];
    f32x4 S[4][4];
    {
        const float* sp = (const float*)(P.ws + WS_HGU) + ((size_t)(bh * 2 + dir) * 32 + n) * 4096;
#pragma unroll
        for (int dt = 0; dt < 4; ++dt)
#pragma unroll
            for (int et = 0; et < 4; ++et)
#pragma unroll
                for (int j = 0; j < 4; ++j) S[dt][et][j] = sp[(dt * 16 + 4 * g + j) * 64 + et * 16 + q];
    }
    bf16_t* odst = dir ? (proj + C_AQ + h * 64) : (mixed + 768 + h * 64); const size_t opitch = dir ? INW : DM;
    bf16_t qr[16], zz[16]; u32x4 v0, v1;
#define HGB_LOAD(SC) do { const size_t toks_ = tokc + (SC) * 16; const bf16_t* base_ = proj + toks_ * INW + h * 64 + lane; \
        _Pragma("unroll") for (int ii = 0; ii < 16; ++ii) { const int t_ = dir ? 15 - ii : ii; qr[ii] = base_[(size_t)t_ * INW + C_HQ]; zz[ii] = base_[(size_t)t_ * INW + (dir ? C_HZB : C_HZF)]; } \
        const bf16_t* vsrc_ = proj + (toks_ + (lane >> 2)) * INW + C_HI + h * 64 + (lane & 3) * 16; v0 = *(const u32x4*)vsrc_; v1 = *(const u32x4*)(vsrc_ + 8); } while (0)
    HGB_LOAD(dir ? 7 : 0);
    for (int i = 0; i < 8; ++i) {
        const int sc = dir ? 7 - i : i; const size_t toks = tokc + sc * 16;
        {
            *(LAS u32x4*)(Vs + (lane >> 2) * 72 + (lane & 3) * 16) = v0; *(LAS u32x4*)(Vs + (lane >> 2) * 72 + (lane & 3) * 16 + 8) = v1;
            float bp = 1.f;
#pragma unroll
            for (int ii = 0; ii < 16; ++ii) {
                const int t = dir ? 15 - ii : ii;
                float f, kk; hgrn_gate(bf2f(zz[ii]), lbv, f, kk); const float qv = siluf(bf2f(qr[ii]));
                bp *= f;
                Qi[t * 72 + lane] = f2bf(qv * bp); Ki[t * 72 + lane] = f2bf(kk * __builtin_amdgcn_rcpf(fmaxf(bp, 1.0e-30f)));
            }
            Al[lane] = bp;
        }
        if (i + 1 < 8) HGB_LOAD(dir ? 6 - i : i + 1);
        __builtin_amdgcn_fence(__ATOMIC_RELEASE, "wavefront"); __builtin_amdgcn_wave_barrier(); __builtin_amdgcn_fence(__ATOMIC_ACQUIRE, "wavefront");
        f32x4 at = {0.f, 0.f, 0.f, 0.f};
#pragma unroll
        for (int kq = 0; kq < 2; ++kq) { const bf16x8 a8 = *(const LAS bf16x8*)(Ki + q * 72 + kq * 32 + 8 * g), b8 = *(const LAS bf16x8*)(Qi + q * 72 + kq * 32 + 8 * g); at = MFMA32(a8, b8, at); }
#pragma unroll
        for (int j = 0; j < 4; ++j) { const int sl = 4 * g + j; const bool keep = dir ? (sl >= q) : (sl <= q); at[j] = keep ? at[j] : 0.f; }
        const bf16x4 p4 = pk4h(at);
        bf16x4 b4[4], v4[4];
#pragma unroll
        for (int dt = 0; dt < 4; ++dt) b4[dt] = *(const LAS bf16x4*)(Qi + q * 72 + dt * 16 + 4 * g);
#pragma unroll
        for (int et = 0; et < 4; ++et) v4[et] = tr4(Vs, 72, 0, et * 16, g, q);
#pragma unroll
        for (int et = 0; et < 4; ++et) {
            f32x4 o = {0.f, 0.f, 0.f, 0.f};
#pragma unroll
            for (int dt = 0; dt < 4; ++dt) o = MFMA16(pk4h(S[dt][et]), b4[dt], o);
            o = MFMA16(v4[et], p4, o);
            *(bf16x4*)(odst + (toks + q) * opitch + et * 16 + 4 * g) = pk4(o);
        }
#pragma unroll
        for (int dt = 0; dt < 4; ++dt) {
            const bf16x4 kT4 = tr4(Ki, 72, 0, dt * 16, g, q);
            const f32x4 al4 = *(const LAS f32x4*)(Al + dt * 16 + 4 * g);
#pragma unroll
            for (int et = 0; et < 4; ++et) { const f32x4 s2 = MFMA16(kT4, v4[et], S[dt][et]); S[dt][et] = s2 * al4; }
        }
        __builtin_amdgcn_fence(__ATOMIC_RELEASE, "wavefront"); __builtin_amdgcn_wave_barrier(); __builtin_amdgcn_fence(__ATOMIC_ACQUIRE, "wavefront");
    }
    asm volatile("s_waitcnt vmcnt(0)" ::: "memory");
    __syncthreads();
    {
        const int tau = tid >> 2, qd = tid & 3;
        bf16_t* mp = mixed + (tokc + tau) * DM + 768 + qd * 64; const bf16_t* bp2 = proj + (tokc + tau) * INW + C_AQ + qd * 64;
        const bf16_t* gp = proj + (tokc + tau) * INW + C_HG + qd * 64; const float* gn = P.hgrn_gn + layer * 256 + qd * 64;
        float o[64]; float sq = 0.f;
#pragma unroll
        for (int c4 = 0; c4 < 16; ++c4) {
            const unsigned long long fv = __hip_atomic_load((const unsigned long long*)(mp + c4 * 4), __ATOMIC_RELAXED, __HIP_MEMORY_SCOPE_AGENT), bv = __hip_atomic_load((const unsigned long long*)(bp2 + c4 * 4), __ATOMIC_RELAXED, __HIP_MEMORY_SCOPE_AGENT);
            const unsigned f0 = (unsigned)fv, f1 = (unsigned)(fv >> 32), b0 = (unsigned)bv, b1 = (unsigned)(bv >> 32);
            const float x0 = bflo(f0) + bflo(b0), x1 = bfhi(f0) + bfhi(b0), x2 = bflo(f1) + bflo(b1), x3 = bfhi(f1) + bfhi(b1);
            o[c4 * 4 + 0] = x0; o[c4 * 4 + 1] = x1; o[c4 * 4 + 2] = x2; o[c4 * 4 + 3] = x3; sq += (x0 * x0 + x1 * x1) + (x2 * x2 + x3 * x3); }
        sq += __shfl_xor(sq, 1); sq += __shfl_xor(sq, 2);
        const float rstd = rsqrtf(sq * (1.0f / 256.0f) + NORM_EPS);
#pragma unroll
        for (int c8 = 0; c8 < 8; ++c8) {
            const u32x4 gv = *(const u32x4*)(gp + c8 * 8); const f32x4 g0 = *(const f32x4*)(gn + c8 * 8), g1 = *(const f32x4*)(gn + c8 * 8 + 4);
            u32x4 r;
            r.x = pk2h(o[c8 * 8 + 0] * rstd * g0[0] * siluf(bflo(gv.x)), o[c8 * 8 + 1] * rstd * g0[1] * siluf(bfhi(gv.x)));
            r.y = pk2h(o[c8 * 8 + 2] * rstd * g0[2] * siluf(bflo(gv.y)), o[c8 * 8 + 3] * rstd * g0[3] * siluf(bfhi(gv.y)));
            r.z = pk2h(o[c8 * 8 + 4] * rstd * g1[0] * siluf(bflo(gv.z)), o[c8 * 8 + 5] * rstd * g1[1] * siluf(bfhi(gv.z)));
            r.w = pk2h(o[c8 * 8 + 6] * rstd * g1[2] * siluf(bflo(gv.w)), o[c8 * 8 + 7] * rstd * g1[3] * siluf(bfhi(gv.w)));
            *(u32x4*)(mp + c8 * 8) = r;
        }
    }
    __syncthreads();
}
constexpr int N_PHASES = 20;
#ifndef PROBE_MASK
#define PROBE_MASK 0u
#endif
#ifndef PROBE_U
#define PROBE_U 0
#endif
#ifndef STAGGER
#define STAGGER 0
#endif
#ifndef STAGGER_TICKS
#define STAGGER_TICKS 1000u
#endif
#ifndef PROBE_SYNC2
#define PROBE_SYNC2 0
#endif
__device__ __forceinline__ void stagger_half(unsigned ticks) {
#if STAGGER
    if ((blockIdx.x >> 3) & 1) { const unsigned long long t0 = __builtin_amdgcn_s_memrealtime(); while (__builtin_amdgcn_s_memrealtime() - t0 < ticks) __builtin_amdgcn_s_sleep(32); }
    __syncthreads();
#endif
}
__device__ __forceinline__ void run_phase(const Params& P, LAS unsigned char* lds, int ph) {
    unsigned char* ws = P.ws;
    if (ph == 0) { phase_prologue(P, lds); return; }
    if (ph == N_PHASES - 1) { phase_norm<true, true>(P.out, (const bf16_t*)(ws + WS_OB), (const float*)(ws + WS_MOD) + (size_t)(DEPTH - 1) * NBATCH * NMOD * DM + 5 * DM, P.out, P.g_final, nullptr, nullptr, nullptr); return; }
    const int l = (ph - 1) / 9, s = (ph - 1) % 9;
    const float* mod = (const float*)(ws + WS_MOD) + (size_t)l * NBATCH * NMOD * DM;
    bf16_t* hbuf = (bf16_t*)(ws + WS_HBUF); bf16_t* proj = (bf16_t*)(ws + WS_PROJ); bf16_t* ybuf = (bf16_t*)(ws + WS_OB);
#ifdef PH_ONLY
    if (s != PH_ONLY) return;
#endif
    int kD = DM, kF = FFN; asm volatile("" : "+s"(kD), "+s"(kF));
    switch (s) {
    case 0: if (l == 0) { phase_norm<false, false>(P.x, nullptr, nullptr, nullptr, P.g_mix, mod + 0 * DM, mod + 1 * DM, hbuf); phase_weights(P, lds); }
            else phase_norm<true, false>(P.out, ybuf, mod - (size_t)NBATCH * NMOD * DM + 5 * DM, P.out, P.g_mix + l * DM, mod + 0 * DM, mod + 1 * DM, hbuf);
            break;
    case 1: { pg8::Gemm g{hbuf, (const bf16_t*)(ws + WS_WIN) + (size_t)l * INWP * DM, NTOK, INWP, kD}; pg8::StaticOrder S; S.init(NTOK, INWP, gridDim.x, blockIdx.x);
              EpiProj E{proj, INW, INW}; pg8::gemm_phase<EpiProj, pg8::StaticOrder>(lds, g, S, E, nullptr); } break;
    case 2: { for (int rp = 0; rp < (PROBE_U == 1 ? 2 : 1); ++rp) att_phase(P, lds);
              for (int rp = 0; rp < (PROBE_U == 2 ? 2 : 1); ++rp) retA_phase(P, lds);
              for (int rp = 0; rp < (PROBE_U == 3 ? 2 : 1); ++rp) for (int u = blockIdx.x; u < 1024; u += gridDim.x) hgA_unit(P, lds, u, l); } break;
    case 3: { ret_scan(P); hg_scan(P); att_merge(P); } break;
    case 4: { for (int rp = 0; rp < (PROBE_U == 4 ? 2 : 1); ++rp) for (int u = blockIdx.x; u < 256; u += gridDim.x) hgB_unit(P, lds, u, l);
              for (int rp = 0; rp < (PROBE_U == 5 ? 2 : 1); ++rp) retB_phase(P, lds, l); } break;
    case 5: { pg8::Gemm g{hbuf, (const bf16_t*)(ws + WS_WOUT) + (size_t)l * DM * DM, NTOK, DM, kD}; pg8::StaticOrder S; S.init(NTOK, DM, gridDim.x, blockIdx.x);
              EpiProj E{ybuf, DM, DM}; pg8::gemm_phase<EpiProj, pg8::StaticOrder>(lds, g, S, E, nullptr); } break;
    case 6: phase_norm<true, false>(l == 0 ? P.x : P.out, ybuf, mod + 2 * DM, P.out, P.g_ffn + l * DM, mod + 3 * DM, mod + 4 * DM, hbuf); break;
    case 7: { pg8::Gemm g{hbuf, (const bf16_t*)(ws + WS_WGU) + (size_t)l * 2 * FFN * DM, NTOK, 2 * FFN, kD}; pg8::StaticOrder S; S.init(NTOK, 2 * FFN, gridDim.x, blockIdx.x);
              EpiSwiglu E{proj}; pg8::gemm_phase<EpiSwiglu, pg8::StaticOrder>(lds, g, S, E, nullptr); } break;
    case 8: { pg8::Gemm g{proj, (const bf16_t*)(ws + WS_WDN) + (size_t)l * DM * FFN, NTOK, DM, kF}; pg8::StaticOrder S; S.init(NTOK, DM, gridDim.x, blockIdx.x);
              EpiProj E{ybuf, DM, DM}; pg8::gemm_phase<EpiProj, pg8::StaticOrder>(lds, g, S, E, nullptr); } break;
    }
}
__global__ void __launch_bounds__(NTHREADS) hybrid_fwd(Params P) {
    extern __shared__ __attribute__((aligned(16))) unsigned char lds_raw[];
    __shared__ uint4 xb_words;
    LAS unsigned char* lds = (LAS unsigned char*)lds_raw;
    if (threadIdx.x == 0) xb_words = make_uint4(0u, 0u, 0u, 0u);
    __syncthreads();
    XcdBarrier bar = xcd_barrier_post((unsigned*)(P.ws + WS_CTL), (volatile LAS unsigned*)&xb_words);
    for (int ph = P.ph_lo; ph < P.ph_hi; ++ph) {
        const int reps = ((PROBE_MASK >> ph) & 1u) ? 2 : 1;
        for (int rep = 0; rep < reps; ++rep) { run_phase(P, lds, ph); if (rep + 1 < reps) __syncthreads(); }
        if (ph + 1 < P.ph_hi) {
            if (ph == P.ph_lo) cg::this_grid().sync(); else xcd_barrier(bar);
            if (PROBE_SYNC2) xcd_barrier(bar);
        }
    }
}

extern "C" void kernel_launch(void* const* d_in, const int* in_sizes, int n_in, void* d_out, int out_size, void* d_ws, size_t ws_size, hipStream_t stream) {
    static int grid = 0;
    if (grid == 0) {
        if (n_in != 14 || out_size != NTOK * DM || ws_size < WS_END) { fprintf(stderr, "kernel_launch: unexpected shapes (n_in %d out %d ws %zu need %zu)\n", n_in, out_size, ws_size, (size_t)WS_END); grid = -1; return; }
        int dev = 0, cus = 0, per_cu = 0;
        hipGetDevice(&dev); hipDeviceGetAttribute(&cus, hipDeviceAttributeMultiprocessorCount, dev);
        if (hipFuncSetAttribute((const void*)hybrid_fwd, hipFuncAttributeMaxDynamicSharedMemorySize, LDS_BYTES) != hipSuccess) { fprintf(stderr, "kernel_launch: hipFuncSetAttribute failed\n"); grid = -1; return; }
        if (hipOccupancyMaxActiveBlocksPerMultiprocessor(&per_cu, (const void*)hybrid_fwd, NTHREADS, LDS_BYTES) != hipSuccess || per_cu < 1) { fprintf(stderr, "kernel_launch: occupancy query says %d\n", per_cu); grid = -1; return; }
        grid = cus;
    }
    if (grid < 0) return;
    if (hipMemsetAsync((char*)d_ws + WS_CTL, 0, 16384, stream) != hipSuccess) { fprintf(stderr, "kernel_launch: memset failed\n"); return; }
    Params p{};
    p.x = (const float*)d_in[0]; p.c = (const float*)d_in[1]; p.w_ada = (const float*)d_in[2]; p.b_ada = (const float*)d_in[3]; p.g_mix = (const float*)d_in[4];
    p.w_in = (const float*)d_in[5]; p.ret_gn = (const float*)d_in[6]; p.hgrn_gn = (const float*)d_in[7]; p.lb_logits = (const float*)d_in[8]; p.w_out = (const float*)d_in[9];
    p.g_ffn = (const float*)d_in[10]; p.w_gu = (const float*)d_in[11]; p.w_down = (const float*)d_in[12]; p.g_final = (const float*)d_in[13];
    p.out = (float*)d_out; p.ws = (unsigned char*)d_ws;
#if ONE_LAUNCH
    p.ph_lo = 0; p.ph_hi = N_PHASES;
    void* args[] = {&p};
    hipError_t e = hipLaunchCooperativeKernel((const void*)hybrid_fwd, dim3(grid), dim3(NTHREADS), args, LDS_BYTES, stream);
    if (e != hipSuccess) fprintf(stderr, "cooperative launch failed: %s (grid %d)\n", hipGetErrorString(e), grid);
#else
    for (int ph = 0; ph < N_PHASES; ++ph) { p.ph_lo = ph; p.ph_hi = ph + 1; hipLaunchKernelGGL(hybrid_fwd, dim3(grid), dim3(NTHREADS), LDS_BYTES, stream, p); }
#endif
}
```

```cpp
#include <hip/hip_runtime.h>
#include <hip/hip_cooperative_groups.h>
#include <cstdio>
#include <cstdint>
namespace cg = cooperative_groups;
#ifndef ONE_LAUNCH
#define ONE_LAUNCH 1
#endif
__device__ __forceinline__ int opaque_tid() { int t = threadIdx.x; asm volatile("" : "+v"(t)); return t; }
#define LAS __attribute__((address_space(3)))
namespace pg8 {
#define PG8_LAS __attribute__((address_space(3)))
typedef unsigned short bf16_t;
typedef short bf16x8 __attribute__((ext_vector_type(8)));
typedef float f32x4 __attribute__((ext_vector_type(4)));
typedef unsigned u32x4 __attribute__((ext_vector_type(4)));
constexpr int BM = 256, BK = 64, HALF = 128, HTB = HALF * BK * 2  , STAGE_BYTES = 8 * HTB, NXCD = 8, WGM = 8;

__host__ __device__ __forceinline__ int lds_byte(int r, int c) { const int st = (r >> 4) * 2 + (c >> 5), rr = r & 15, cc = c & 31, ob = rr * 64 + cc * 2; return st * 1024 + (ob ^ (((ob >> 9) & 1) << 5)); }
__host__ __device__ __forceinline__ void stage_rc(int b, int& R, int& C) { const int st = b / 1024, sb = b % 1024, swz = sb ^ (((sb >> 9) & 1) << 5); R = (st >> 1) * 16 + swz / 64; C = (st & 1) * 32 + (swz % 64) / 2; }
__host__ __device__ __forceinline__ int perm32(int rho) { const int n = rho >> 4, i = rho & 15; return 8 * (i >> 2) + 4 * n + (i & 3); }

struct Unit { int pm, pn; };
struct Gemm { const bf16_t* A; const bf16_t* Bt; int M, N, K; };

struct StaticOrder {
    int nM, nN, nwg, G, c;
    __host__ __device__ void init(int M, int N, int G_, int c_) { nM = M / BM; nN = N / BM; nwg = nM * nN; G = G_; c = c_; }
    __host__ __device__ bool next(int i, Unit& u) const {
        const long L = (long)i * G + c; if (L >= nwg) return false;
        int wgid = (int)L; { const int q = nwg / NXCD, r = nwg % NXCD, xcd = wgid % NXCD, off = wgid / NXCD; wgid = (xcd < r ? xcd * (q + 1) : r * (q + 1) + (xcd - r) * q) + off; }
        const int nig = WGM * nN, gid = wgid / nig, fm = gid * WGM, gsz = (nM - fm) < WGM ? (nM - fm) : WGM;
        u.pm = fm + ((wgid % nig) % gsz); u.pn = (wgid % nig) / gsz; return true;
    }
    __device__ __forceinline__ void a_ready(const Unit&) const {}
    __device__ __forceinline__ void done(const Unit&) const {}
};
__device__ __forceinline__ unsigned cvt_pk_bf16(float lo, float hi) { unsigned r; asm volatile("v_cvt_pk_bf16_f32 %0, %1, %2" : "=v"(r) : "v"(lo), "v"(hi)); return r; }
typedef float f32x2 __attribute__((ext_vector_type(2)));
template <class Epi, class Sched, bool STAMP = false>
__device__ __forceinline__ void gemm_phase(PG8_LAS unsigned char* lds, const Gemm g, const Sched& S, const Epi& E, unsigned long long* stamps) {
    const int tid = opaque_tid(), wid = __builtin_amdgcn_readfirstlane(tid >> 6), lane = tid & 63, wr = wid >> 2, wc = wid & 3, fr = lane & 15, fq = lane >> 4;
    const int K = g.K, nt = K / BK;
    int ts_lo = 0, ts_hi = 0, nts = 0; const unsigned long long rt_entry = STAMP ? (unsigned long long)wall_clock64() : 0ull;
#define PG8_STAMP() do { if (STAMP && wid == 0 && nts < 64) { const unsigned long long _c = (unsigned long long)clock64(); \
        ts_lo = (lane == nts) ? (int)(unsigned)_c : ts_lo; ts_hi = (lane == nts) ? (int)(unsigned)(_c >> 32) : ts_hi; ++nts; } } while (0)
    PG8_STAMP();
    unsigned voffA[2], voffB[2];
#pragma unroll
    for (int i = 0; i < 2; ++i) { int R, C; stage_rc(tid * 16 + i * 8192, R, C); const int Rb = Epi::PERM ? ((R & ~31) + perm32(R & 31)) : R;
        voffA[i] = (unsigned)(R * K + C) * 2u; voffB[i] = (unsigned)(Rb * K + C) * 2u; }
    const size_t kstep = (size_t)(BK * 2);
    const size_t hstep = (size_t)HALF * K * 2;
    const size_t tstep = 2 * hstep;
    const unsigned ldsw = (unsigned)wid * 1024u;
    const int aoff = lds_byte(wr * 64 + fr, fq * 8), boff = lds_byte(wc * 32 + fr, fq * 8);
#define PG8_SA(b, h) (((b) * 2 + (h)) * HTB)
#define PG8_SB(b, h) ((4 + (b) * 2 + (h)) * HTB)
#define PG8_STAGE(bufoff, gbase, voff) do { _Pragma("unroll") for (int _i = 0; _i < 2; ++_i) \
        __builtin_amdgcn_global_load_lds((const unsigned*)((const char*)(gbase) + (voff)[_i]), (PG8_LAS unsigned*)(lds + (bufoff) + ldsw + _i * 8192), 16, 0, 0); } while (0)
#define PG8_LDA(dst, b, h) do { _Pragma("unroll") for (int m = 0; m < 4; ++m) _Pragma("unroll") for (int k = 0; k < 2; ++k) dst[m][k] = *(const PG8_LAS bf16x8*)(lds + PG8_SA(b, h) + aoff + m * 2048 + k * 1024); } while (0)
#define PG8_LDB(dst, b, h) do { _Pragma("unroll") for (int n = 0; n < 2; ++n) _Pragma("unroll") for (int k = 0; k < 2; ++k) dst[n][k] = *(const PG8_LAS bf16x8*)(lds + PG8_SB(b, h) + boff + n * 2048 + k * 1024); } while (0)
#define PG8_MMA(ai, bj, At, Bt) do { __builtin_amdgcn_s_setprio(1); _Pragma("unroll") for (int m = 0; m < 4; ++m) _Pragma("unroll") for (int n = 0; n < 2; ++n) _Pragma("unroll") for (int k = 0; k < 2; ++k) \
        acc[ai][bj][m][n] = __builtin_amdgcn_mfma_f32_16x16x32_bf16(Bt[n][k], At[m][k], acc[ai][bj][m][n], 0, 0, 0); __builtin_amdgcn_s_setprio(0); } while (0)
#define PG8_WAIT_V(n) asm volatile("s_waitcnt vmcnt(" #n ")" ::: "memory")
#define PG8_WAIT_L(n) asm volatile("s_waitcnt lgkmcnt(" #n ")" ::: "memory")
#define PG8_BAR __builtin_amdgcn_s_barrier()
#define PG8_SCHED __builtin_amdgcn_sched_barrier(0)
    Unit cur, nxt; int ui = 0;
    if (!S.next(0, cur)) return;
    f32x4 acc[2][2][4][2];
#pragma unroll
    for (int a = 0; a < 2; ++a)
#pragma unroll
        for (int b = 0; b < 2; ++b)
#pragma unroll
            for (int m = 0; m < 4; ++m)
#pragma unroll
                for (int n = 0; n < 2; ++n) acc[a][b][m][n] = (f32x4){0.f, 0.f, 0.f, 0.f};
    bf16x8 At[4][2], B0[2][2], B1[2][2];
    const char* cA = (const char*)g.A + (size_t)cur.pm * tstep; const char* cB = (const char*)g.Bt + (size_t)cur.pn * tstep;
    S.a_ready(cur);
    PG8_STAGE(PG8_SB(0, 0), cB, voffB); PG8_STAGE(PG8_SA(0, 0), cA, voffA); PG8_STAGE(PG8_SB(0, 1), cB + hstep, voffB); PG8_STAGE(PG8_SA(0, 1), cA + hstep, voffA);
    if (wr == 1) PG8_BAR;
    PG8_WAIT_V(4); PG8_BAR;
    PG8_STAGE(PG8_SB(1, 0), cB + kstep, voffB); PG8_STAGE(PG8_SA(1, 0), cA + kstep, voffA); PG8_STAGE(PG8_SB(1, 1), cB + hstep + kstep, voffB);
    PG8_WAIT_V(6); PG8_BAR;
    PG8_STAMP();
    for (;;) {
        const bool has_next = S.next(ui + 1, nxt);
        const char* nA = has_next ? (const char*)g.A + (size_t)nxt.pm * tstep : cA; const char* nB = has_next ? (const char*)g.Bt + (size_t)nxt.pn * tstep : cB;
        for (int t = 0; t < nt; t += 2) {
            const bool last = (t == nt - 2);
            const char* a1 = cA + (size_t)(t + 1) * kstep;
            const char* a2 = last ? nA : cA + (size_t)(t + 2) * kstep; const char* b2 = last ? nB : cB + (size_t)(t + 2) * kstep;
            const char* a3 = a2 + kstep; const char* b3 = b2 + kstep;
            if (last && has_next) S.a_ready(nxt);
            PG8_LDB(B0, 0, 0); PG8_SCHED; PG8_LDA(At, 0, 0); PG8_STAGE(PG8_SA(1, 1), a1 + hstep, voffA);
            PG8_WAIT_L(8); PG8_BAR; PG8_WAIT_L(0); PG8_MMA(0, 0, At, B0); PG8_BAR; PG8_SCHED;
            PG8_LDB(B1, 0, 1); PG8_STAGE(PG8_SB(0, 0), b2, voffB);
            PG8_BAR; PG8_WAIT_L(0); PG8_MMA(0, 1, At, B1); PG8_BAR;
            PG8_LDA(At, 0, 1); PG8_STAGE(PG8_SA(0, 0), a2, voffA);
            PG8_BAR; PG8_WAIT_L(0); PG8_MMA(1, 0, At, B0); PG8_BAR; PG8_SCHED;
            PG8_STAGE(PG8_SB(0, 1), b2 + hstep, voffB);
            PG8_WAIT_V(6); PG8_BAR; PG8_MMA(1, 1, At, B1); PG8_BAR;
            PG8_LDB(B0, 1, 0); PG8_SCHED; PG8_LDA(At, 1, 0); PG8_STAGE(PG8_SA(0, 1), a2 + hstep, voffA);
            PG8_WAIT_L(8); PG8_BAR; PG8_WAIT_L(0); PG8_MMA(0, 0, At, B0); PG8_BAR; PG8_SCHED;
            PG8_LDB(B1, 1, 1); PG8_STAGE(PG8_SB(1, 0), b3, voffB);
            PG8_BAR; PG8_WAIT_L(0); PG8_MMA(0, 1, At, B1); PG8_BAR;
            PG8_LDA(At, 1, 1); PG8_STAGE(PG8_SA(1, 0), a3, voffA);
            PG8_BAR; PG8_WAIT_L(0); PG8_MMA(1, 0, At, B0); PG8_BAR; PG8_SCHED;
            PG8_STAGE(PG8_SB(1, 1), b3 + hstep, voffB);
            PG8_WAIT_V(6); PG8_BAR; PG8_MMA(1, 1, At, B1); PG8_BAR;
        }
        PG8_STAMP();
        if constexpr (!Epi::AFTER_DRAIN) { E(acc, cur, wr, wc, fr, fq); S.done(cur); }
        PG8_STAMP();
        if (!has_next) break;
#pragma unroll
        for (int a = 0; a < 2; ++a)
#pragma unroll
            for (int b = 0; b < 2; ++b)
#pragma unroll
                for (int m = 0; m < 4; ++m)
#pragma unroll
                    for (int n = 0; n < 2; ++n) acc[a][b][m][n] = (f32x4){0.f, 0.f, 0.f, 0.f};
        cur = nxt; cA = nA; cB = nB; ++ui;
    }
    PG8_WAIT_V(0);
    if (wr == 0) PG8_BAR;
    PG8_BAR;
    if constexpr (Epi::AFTER_DRAIN) { E.fused(acc, cur, wr, wc, fr, fq, lds, wid, lane); S.done(cur); }
    PG8_STAMP();
    if (STAMP && wid == 0) { stamps[lane] = lane < nts ? (((unsigned long long)(unsigned)ts_hi << 32) | (unsigned)ts_lo) : 0ull;
        if (lane == 62) stamps[62] = rt_entry; if (lane == 63) stamps[63] = (unsigned long long)wall_clock64(); }
#undef PG8_STAMP
#undef PG8_SA
#undef PG8_SB
#undef PG8_STAGE
#undef PG8_LDA
#undef PG8_LDB
#undef PG8_MMA
#undef PG8_WAIT_V
#undef PG8_WAIT_L
#undef PG8_BAR
#undef PG8_SCHED
}
}
#define XB_TMO      128
#define XB_XCNT(j)  (256  + 64 * (j))
#define XB_XSUB(j)  (1280 + 64 * (j))
#define XB_XGEN(j)  (2304 + 64 * (j))
#define XB_TOP      3328
#define XB_TOPGEN   3392
#define XCD_BAR_WORDS 3456
#define XB_SPIN_CAP (1u << 18)

__device__ __forceinline__ unsigned xb_ld(unsigned* p)              { return __hip_atomic_load(p, __ATOMIC_RELAXED, __HIP_MEMORY_SCOPE_AGENT); }
__device__ __forceinline__ unsigned xb_add(unsigned* p, unsigned v) { return __hip_atomic_fetch_add(p, v, __ATOMIC_RELAXED, __HIP_MEMORY_SCOPE_AGENT); }
__device__ __forceinline__ unsigned xb_xcc_id() { return (unsigned)__builtin_amdgcn_s_getreg((3 << 11) | 20) & 0xFu; }
#define XB_SPIN(cond, bar) do { unsigned _sp = 0; while (cond) { __builtin_amdgcn_s_sleep(1); \
    if ((++_sp & 255u) == 0u) { if (xb_ld(&(bar)[XB_TMO])) break; if (_sp > XB_SPIN_CAP) { atomicAdd(&(bar)[XB_TMO], 1u); break; } } } } while (0)

struct XcdBarrier {
    unsigned* bar; unsigned x;
    volatile LAS unsigned* st;
};

__device__ __forceinline__ XcdBarrier xcd_barrier_post(unsigned* bar, volatile LAS unsigned* st) {
    XcdBarrier b; b.bar = bar; b.x = xb_xcc_id(); b.st = st;
    if (threadIdx.x == 0) (void)xb_add(&bar[XB_XCNT(b.x)], 1u);
    return b;
}
__device__ __forceinline__ void xcd_barrier_complete(unsigned* bar, unsigned x, unsigned& nloc, unsigned& nx) {
    const unsigned G = gridDim.x * gridDim.y * gridDim.z;
    unsigned sum, cnt, mine, sp = 0u;
    for (;;) {
        sum = 0u; cnt = 0u; mine = 0u;
#pragma unroll
        for (unsigned j = 0; j < 16; ++j) { const unsigned c = xb_ld(&bar[XB_XCNT(j)]); sum += c; cnt += (c > 0u) ? 1u : 0u; mine = (j == x) ? c : mine; }
        if (sum == G) break;
        __builtin_amdgcn_s_sleep(1);
        if ((++sp & 255u) == 0u) { if (xb_ld(&bar[XB_TMO])) break; if (sp > XB_SPIN_CAP) { atomicAdd(&bar[XB_TMO], 1u); break; } }
    }
    nloc = mine > 0u ? mine : 1u; nx = cnt > 0u ? cnt : 1u;
}

__device__ __forceinline__ void xcd_barrier(const XcdBarrier& b) {
    asm volatile("s_waitcnt vmcnt(0)" ::: "memory");
    __syncthreads();
    if (threadIdx.x == 0) {
        unsigned* bar = b.bar;
        __builtin_amdgcn_s_waitcnt(0);
        unsigned nloc = b.st[0], nx = b.st[1];
        if (nloc == 0u) { xcd_barrier_complete(bar, b.x, nloc, nx); b.st[0] = nloc; b.st[1] = nx; }
        const unsigned old = xb_add(&bar[XB_XSUB(b.x)], 1u);
        const unsigned gen = old / nloc;
        if (old + 1u == (gen + 1u) * nloc) {
            __builtin_amdgcn_fence(__ATOMIC_RELEASE, "agent");
            asm volatile("s_waitcnt vmcnt(0)" ::: "memory");
            const unsigned og = xb_add(&bar[XB_TOP], 1u);
            const unsigned tg = og / nx;
            if (og + 1u == (tg + 1u) * nx) xb_add(&bar[XB_TOPGEN], 1u);
            else XB_SPIN(xb_ld(&bar[XB_TOPGEN]) == tg, bar);
            __builtin_amdgcn_fence(__ATOMIC_ACQUIRE, "agent");
            xb_add(&bar[XB_XGEN(b.x)], 1u);
            asm volatile("s_waitcnt vmcnt(0)" ::: "memory");
        } else {
            XB_SPIN(xb_ld(&bar[XB_XGEN(b.x)]) == gen, bar);
            __builtin_amdgcn_fence(__ATOMIC_ACQUIRE, "agent");
            asm volatile("s_waitcnt vmcnt(0)" ::: "memory");
        }
    }
    __syncthreads();
}

typedef unsigned short bf16_t;
typedef short bf16x8 __attribute__((ext_vector_type(8)));
typedef short bf16x4 __attribute__((ext_vector_type(4)));
typedef float f32x4 __attribute__((ext_vector_type(4)));
typedef unsigned u32x4 __attribute__((ext_vector_type(4)));
typedef unsigned u32x2 __attribute__((ext_vector_type(2)));
constexpr int DM = 1024, NBATCH = 8, SEQ = 4096, NTOK = NBATCH * SEQ, DEPTH = 2;
constexpr int INW = 3968, INWP = 4096, FFN = 2816, NMOD = 6;
constexpr int C_AQ = 0, C_AK = 384, C_AV = 768, C_RQ = 1152, C_RK = 1536, C_RV = 1920, C_RG = 2304, C_HQ = 2688, C_HZF = 2944, C_HZB = 3200, C_HI = 3456, C_HG = 3712;
constexpr float NORM_EPS = 1e-6f;
constexpr int NTHREADS = 512;
constexpr int LDS_BYTES = 135168;
constexpr size_t WS_CTL = 0, WS_MOD = 16384, WS_LB = WS_MOD + 393216, WS_HGA = WS_LB + 2048, WS_LSE = WS_HGA + 524288, WS_WIN = WS_LSE + 2359296,
    WS_WOUT = WS_WIN + 16777216, WS_WGU = WS_WOUT + 4194304, WS_WDN = WS_WGU + 23068672, WS_HBUF = WS_WDN + 11534336, WS_PROJ = WS_HBUF + 67108864,
    WS_OB = WS_PROJ + 260046848, WS_RST = WS_OB + 75497472, WS_HGU = WS_RST + 25165824, WS_END = WS_HGU + 33554432;

struct Params {
    const float *x, *c, *w_ada, *b_ada, *g_mix, *w_in, *ret_gn, *hgrn_gn, *lb_logits, *w_out, *g_ffn, *w_gu, *w_down, *g_final;
    float* out; unsigned char* ws; int ph_lo, ph_hi;
};

__device__ __forceinline__ float bf2f(bf16_t v) { return __uint_as_float(((unsigned)v) << 16); }
__device__ __forceinline__ float bflo(unsigned w) { return __uint_as_float(w << 16); }
__device__ __forceinline__ float bfhi(unsigned w) { return __uint_as_float(w & 0xffff0000u); }
__device__ __forceinline__ bf16_t f2bf(float f) { return __builtin_bit_cast(bf16_t, (__bf16)f); }
typedef float f32x2c __attribute__((ext_vector_type(2)));
typedef __bf16 bf16v2c __attribute__((ext_vector_type(2)));
__device__ __forceinline__ unsigned pk2(float lo, float hi) { const f32x2c v = {lo, hi}; return __builtin_bit_cast(unsigned, __builtin_convertvector(v, bf16v2c)); }
__device__ __forceinline__ bf16x4 pk4(f32x4 v) { u32x2 w; w.x = pk2(v[0], v[1]); w.y = pk2(v[2], v[3]); return __builtin_bit_cast(bf16x4, w); }
__device__ __forceinline__ float siluf(float v) { return v * __builtin_amdgcn_rcpf(1.0f + __expf(-v)); }
__device__ __forceinline__ float wave_sum(float v) {
#pragma unroll
    for (int o = 1; o < 64; o <<= 1) v += __shfl_xor(v, o);
    return v;
}
#define MFMA32(a, b, c) __builtin_amdgcn_mfma_f32_16x16x32_bf16((a), (b), (c), 0, 0, 0)
#define MFMA16(a, b, c) __builtin_amdgcn_mfma_f32_16x16x16bf16_1k((a), (b), (c), 0, 0, 0)

struct EpiProj {
    static constexpr bool PERM = true, AFTER_DRAIN = false;
    bf16_t* O; int ldc, ncols;
    __device__ __forceinline__ void operator()(const f32x4 (&acc)[2][2][4][2], const pg8::Unit& u, int wr, int wc, int fr, int fq) const {
        const int row0 = u.pm * 256 + wr * 64 + fr, col0 = u.pn * 256 + wc * 32 + 8 * fq;
#pragma unroll
        for (int ai = 0; ai < 2; ++ai)
#pragma unroll
            for (int m = 0; m < 4; ++m) { bf16_t* rowp = O + (size_t)(row0 + ai * 128 + m * 16) * ldc + col0;
#pragma unroll
                for (int bj = 0; bj < 2; ++bj) { if (col0 + bj * 128 < ncols) { const f32x4 v0 = acc[ai][bj][m][0], v1 = acc[ai][bj][m][1];
                    u32x4 w; w.x = pk2(v0[0], v0[1]); w.y = pk2(v0[2], v0[3]); w.z = pk2(v1[0], v1[1]); w.w = pk2(v1[2], v1[3]);
                    *(u32x4*)(rowp + bj * 128) = w; } } }
    }
};
struct EpiRes {
    static constexpr bool PERM = false, AFTER_DRAIN = false;
    const float* base; float* out; const float* gate;
    __device__ __forceinline__ void operator()(const f32x4 (&acc)[2][2][4][2], const pg8::Unit& u, int wr, int wc, int fr, int fq) const {
        const int row0 = u.pm * 256 + wr * 64 + fr, col0 = u.pn * 256 + wc * 32 + 4 * fq;
        const float* gp = gate + (size_t)((u.pm * 256) >> 12) * (NMOD * DM) + col0;
        f32x4 gv[2][2];
#pragma unroll
        for (int bj = 0; bj < 2; ++bj)
#pragma unroll
            for (int n = 0; n < 2; ++n) gv[bj][n] = *(const f32x4*)(gp + bj * 128 + n * 16);
#pragma unroll
        for (int ai = 0; ai < 2; ++ai)
#pragma unroll
            for (int m = 0; m < 4; ++m) { const size_t off = (size_t)(row0 + ai * 128 + m * 16) * DM + col0;
#pragma unroll
                for (int bj = 0; bj < 2; ++bj)
#pragma unroll
                    for (int n = 0; n < 2; ++n) { const f32x4 bs = *(const f32x4*)(base + off + bj * 128 + n * 16);
                        *(f32x4*)(out + off + bj * 128 + n * 16) = bs + gv[bj][n] * acc[ai][bj][m][n]; } }
    }
};
struct EpiSwiglu {
    static constexpr bool PERM = true, AFTER_DRAIN = false;
    bf16_t* O;
    __device__ __forceinline__ void operator()(const f32x4 (&acc)[2][2][4][2], const pg8::Unit& u, int wr, int wc, int fr, int fq) const {
        const int row0 = u.pm * 256 + wr * 64 + fr, col0 = u.pn * 128 + wc * 32 + 8 * fq;
#pragma unroll
        for (int ai = 0; ai < 2; ++ai)
#pragma unroll
            for (int m = 0; m < 4; ++m) { bf16_t* rowp = O + (size_t)(row0 + ai * 128 + m * 16) * FFN + col0;
                float r[8];
#pragma unroll
                for (int n = 0; n < 2; ++n)
#pragma unroll
                    for (int i = 0; i < 4; ++i) { const float g = acc[ai][0][m][n][i], uu = acc[ai][1][m][n][i]; r[n * 4 + i] = siluf(g) * uu; }
                u32x4 w; w.x = pk2(r[0], r[1]); w.y = pk2(r[2], r[3]); w.z = pk2(r[4], r[5]); w.w = pk2(r[6], r[7]);
                *(u32x4*)rowp = w; }
    }
};
__device__ __forceinline__ void transpose_item(const float* W, int K, int N, bf16_t* WT, int dst_row0, int src_col0, int k0, LAS float* scr, int lane) {
    if (src_col0 < 0) {
        const int c = lane & 7;
#pragma unroll
        for (int j = 0; j < 4; ++j) { const int n = (lane >> 3) + 8 * j; *(u32x4*)(WT + (size_t)(dst_row0 + n) * K + k0 + 8 * c) = (u32x4){0u, 0u, 0u, 0u}; }
        return;
    }
#pragma unroll 8
    for (int i = 0; i < 32; ++i) { const int kk = 2 * i + (lane >> 5); scr[kk * 33 + (lane & 31)] = W[(size_t)(k0 + kk) * N + src_col0 + (lane & 31)]; }
    __builtin_amdgcn_fence(__ATOMIC_RELEASE, "wavefront"); __builtin_amdgcn_wave_barrier(); __builtin_amdgcn_fence(__ATOMIC_ACQUIRE, "wavefront");
    const int c = lane & 7;
#pragma unroll
    for (int j = 0; j < 4; ++j) { const int n = (lane >> 3) + 8 * j; const LAS float* s = scr + (8 * c) * 33 + n;
        u32x4 o; o.x = pk2(s[0 * 33], s[1 * 33]); o.y = pk2(s[2 * 33], s[3 * 33]); o.z = pk2(s[4 * 33], s[5 * 33]); o.w = pk2(s[6 * 33], s[7 * 33]);
        *(u32x4*)(WT + (size_t)(dst_row0 + n) * K + k0 + 8 * c) = o; }
    __builtin_amdgcn_fence(__ATOMIC_RELEASE, "wavefront"); __builtin_amdgcn_wave_barrier(); __builtin_amdgcn_fence(__ATOMIC_ACQUIRE, "wavefront");
}

__device__ __forceinline__ void phase_weights(const Params& P, LAS unsigned char* lds) {
    const int tid = opaque_tid(), lane = tid & 63, wave = __builtin_amdgcn_readfirstlane(tid >> 6);
    unsigned char* ws = P.ws;
    {
        LAS float* scr = (LAS float*)(lds + wave * 8704);
        const int gw = blockIdx.x * 8 + wave, NGW = gridDim.x * 8;
        constexpr int I_IN = 16 * 128, I_OUT = 16 * 32, I_GU = 16 * 176, I_DN = 44 * 32, I_L = I_IN + I_OUT + I_GU + I_DN;
        for (int it = gw; it < DEPTH * I_L; it += NGW) {
            const int l = it / I_L; int r = it % I_L;
            if (r < I_IN) { const int kb = r / 128, nb = r % 128, n0 = nb * 32;
                transpose_item(P.w_in + (size_t)l * DM * INW, DM, INW, (bf16_t*)(ws + WS_WIN) + (size_t)l * INWP * DM, n0, n0 < INW ? n0 : -1, kb * 64, scr, lane); continue; }
            r -= I_IN;
            if (r < I_OUT) { const int kb = r / 32, nb = r % 32;
                transpose_item(P.w_out + (size_t)l * DM * DM, DM, DM, (bf16_t*)(ws + WS_WOUT) + (size_t)l * DM * DM, nb * 32, nb * 32, kb * 64, scr, lane); continue; }
            r -= I_OUT;
            if (r < I_GU) { const int kb = r / 176, nb = r % 176, n0 = nb * 32; const int pn = n0 >> 8, half = (n0 >> 7) & 1, jj = n0 & 127;
                transpose_item(P.w_gu + (size_t)l * DM * 2 * FFN, DM, 2 * FFN, (bf16_t*)(ws + WS_WGU) + (size_t)l * 2 * FFN * DM, n0, half * FFN + pn * 128 + jj, kb * 64, scr, lane); continue; }
            r -= I_GU;
            { const int kb = r / 32, nb = r % 32;
                transpose_item(P.w_down + (size_t)l * FFN * DM, FFN, DM, (bf16_t*)(ws + WS_WDN) + (size_t)l * DM * FFN, nb * 32, nb * 32, kb * 64, scr, lane); }
        }
    }
}
__device__ __forceinline__ void phase_prologue(const Params& P, LAS unsigned char* lds) {
    const int tid = opaque_tid();
    unsigned char* ws = P.ws;
    {
        LAS float* sc = (LAS float*)lds;
        LAS float* red = (LAS float*)(lds + 32768);
        for (int i = tid; i < NBATCH * DM; i += NTHREADS) sc[i] = siluf(P.c[i]);
        __syncthreads();
        float* mod = (float*)(ws + WS_MOD);
        for (int u = blockIdx.x; u < DEPTH * 96; u += gridDim.x) {
            const int l = u / 96, j0 = (u % 96) * 64, col = tid & 63, kp = tid >> 6;
            float acc[8];
#pragma unroll
            for (int b = 0; b < 8; ++b) acc[b] = 0.f;
            const float* wp = P.w_ada + (size_t)l * DM * (NMOD * DM) + j0 + col;
            for (int k = kp * 128; k < kp * 128 + 128; ++k) { const float w = wp[(size_t)k * (NMOD * DM)];
#pragma unroll
                for (int b = 0; b < 8; ++b) acc[b] += sc[b * DM + k] * w; }
#pragma unroll
            for (int b = 0; b < 8; ++b) red[(kp * 8 + b) * 64 + col] = acc[b];
            __syncthreads();
            { const int b = tid >> 6; float s = 0.f;
#pragma unroll
              for (int p = 0; p < 8; ++p) s += red[(p * 8 + b) * 64 + col];
              mod[((size_t)l * NBATCH + b) * (NMOD * DM) + j0 + col] = s + P.b_ada[(size_t)l * NMOD * DM + j0 + col]; }
            __syncthreads();
        }
    }
    if (blockIdx.x == 0 && tid < 256) {
        const float l0 = P.lb_logits[tid], l1 = P.lb_logits[256 + tid], m = fmaxf(l0, l1), e0 = __expf(l0 - m), e1 = __expf(l1 - m);
        const float p0 = e0 / (e0 + e1), p1 = e1 / (e0 + e1);
        float* lb = (float*)(ws + WS_LB);
        lb[tid] = fminf(fmaxf(p0 - p0, 0.f), 1.0f - 1e-6f);
        lb[256 + tid] = fminf(fmaxf((p0 + p1) - p0, 0.f), 1.0f - 1e-6f);
    }
}

template <bool HAS_Y, bool FINAL>
__device__ __forceinline__ void phase_norm(const float* src, const bf16_t* y, const float* gate, float* xout, const float* g, const float* shift, const float* scale, bf16_t* dst) {
    const int tid = opaque_tid(), lane = tid & 63, wave = tid >> 6;
    const int gw = blockIdx.x * 8 + wave, NGW = gridDim.x * 8;
    f32x4 gv[4];
#pragma unroll
    for (int j = 0; j < 4; ++j) gv[j] = *(const f32x4*)(g + 4 * lane + 256 * j);
    for (int row = gw; row < NTOK; row += NGW) {
        const int b = row >> 12;
        const f32x4* xr = (const f32x4*)(src + (size_t)row * DM) + lane;
        f32x4 v[4]; float s = 0.f;
#pragma unroll
        for (int j = 0; j < 4; ++j) v[j] = xr[64 * j];
        if (HAS_Y) {
            const u32x2* yr = (const u32x2*)(y + (size_t)row * DM) + lane;
#pragma unroll
            for (int j = 0; j < 4; ++j) { const u32x2 yw = yr[64 * j]; const f32x4 gt = *(const f32x4*)(gate + (size_t)b * (NMOD * DM) + 4 * lane + 256 * j);
                v[j][0] += gt[0] * bflo(yw.x); v[j][1] += gt[1] * bfhi(yw.x); v[j][2] += gt[2] * bflo(yw.y); v[j][3] += gt[3] * bfhi(yw.y); }
        }
#pragma unroll
        for (int j = 0; j < 4; ++j) s += (v[j][0] * v[j][0] + v[j][1] * v[j][1]) + (v[j][2] * v[j][2] + v[j][3] * v[j][3]);
        const float rstd = rsqrtf(wave_sum(s) * (1.0f / DM) + NORM_EPS);
        f32x4* xo = (f32x4*)(xout + (size_t)row * DM) + lane;
        if (FINAL) {
#pragma unroll
            for (int j = 0; j < 4; ++j) xo[64 * j] = v[j] * rstd * gv[j];
        } else {
            if (HAS_Y) {
#pragma unroll
                for (int j = 0; j < 4; ++j) xo[64 * j] = v[j];
            }
            unsigned long long* o8 = (unsigned long long*)(dst + (size_t)row * DM) + lane;
#pragma unroll
            for (int j = 0; j < 4; ++j) {
                const f32x4 sc = *(const f32x4*)(scale + (size_t)b * (NMOD * DM) + 4 * lane + 256 * j), sh = *(const f32x4*)(shift + (size_t)b * (NMOD * DM) + 4 * lane + 256 * j);
                const f32x4 h = v[j] * rstd * gv[j] * (sc + 1.0f) + sh;
                o8[64 * j] = (unsigned long long)pk2(h[0], h[1]) | ((unsigned long long)pk2(h[2], h[3]) << 32);
            }
        }
    }
}
__device__ __forceinline__ bf16x4 tr4(const LAS bf16_t* img, int pitch, int row0, int col0, int g, int q) {
    return __builtin_amdgcn_ds_read_tr16_b64_v4i16((LAS bf16x4*)(img + (row0 + 4 * g + (q >> 2)) * pitch + col0 + 4 * (q & 3)));
}
__device__ __forceinline__ bf16x8 tr8(const LAS bf16_t* img, int pitch, int row0, int col0, int g, int q) {
    const bf16x4 lo = __builtin_amdgcn_ds_read_tr16_b64_v4i16((LAS bf16x4*)(img + (row0 + 8 * g + (q >> 2)) * pitch + col0 + 4 * (q & 3)));
    const bf16x4 hi = __builtin_amdgcn_ds_read_tr16_b64_v4i16((LAS bf16x4*)(img + (row0 + 8 * g + 4 + (q >> 2)) * pitch + col0 + 4 * (q & 3)));
    return __builtin_shufflevector(lo, hi, 0, 1, 2, 3, 4, 5, 6, 7);
}
struct AttRegs { u32x4 kv[4], vv[4]; bf16x8 qf[2]; };
__device__ __forceinline__ void att_decode(int u, int& br, int& b, int& h, int& r, int& L, int& p0, int& tok0) {
    br = u / 1536; const int v = u % 1536; b = v / 192; h = (v >> 5) % 6; const int w = v & 31;
    const int lr = br * 2, nblk = 32 >> lr, rho = w >> (5 - lr), blk = w & (nblk - 1); r = 1 << lr; L = SEQ >> lr; p0 = blk * 128; tok0 = b * SEQ + rho;
}
__device__ __forceinline__ void att_load(const Params& P, int u, int tid, AttRegs& R) {
    int br, b, h, r, L, p0, tok0; att_decode(u, br, b, h, r, L, p0, tok0);
    const bf16_t* proj = (const bf16_t*)(P.ws + WS_PROJ);
    const int key = tid >> 1, half = tid & 1, kj = p0 - 64 + key;
    if (kj >= 0 && kj < L) {
        const bf16_t* src = proj + (size_t)(tok0 + r * kj) * INW + h * 64 + half * 32;
#pragma unroll
        for (int i = 0; i < 4; ++i) { R.kv[i] = *(const u32x4*)(src + C_AK + 8 * i); R.vv[i] = *(const u32x4*)(src + C_AV + 8 * i); }
    } else {
#pragma unroll
        for (int i = 0; i < 4; ++i) { R.kv[i] = (u32x4){0u, 0u, 0u, 0u}; R.vv[i] = (u32x4){0u, 0u, 0u, 0u}; }
    }
    const int lane = tid & 63, wave = tid >> 6, q = lane & 15, g = lane >> 4;
    const size_t tokq = (size_t)(tok0 + r * (p0 + 16 * wave + q));
#pragma unroll
    for (int kk = 0; kk < 2; ++kk) R.qf[kk] = *(const bf16x8*)(proj + tokq * INW + C_AQ + h * 64 + kk * 32 + 8 * g);
}
__device__ __forceinline__ void att_phase(const Params& P, LAS unsigned char* lds) {
    const int tid = opaque_tid(), lane = tid & 63, wave = __builtin_amdgcn_readfirstlane(tid >> 6), q = lane & 15, g = lane >> 4;
    LAS bf16_t* Ks = (LAS bf16_t*)lds;
    LAS bf16_t* Vs = (LAS bf16_t*)(lds + 36864);
    int u = blockIdx.x; if (u >= 4608) return;
    AttRegs R; att_load(P, u, tid, R);
    for (; u < 4608; u += gridDim.x) {
        int br, b, h, r, L, p0, tok0; att_decode(u, br, b, h, r, L, p0, tok0);
        {
            const int key = tid >> 1, half = tid & 1;
#pragma unroll
            for (int i = 0; i < 4; ++i) { *(LAS u32x4*)(Ks + key * 72 + half * 32 + 8 * i) = R.kv[i]; *(LAS u32x4*)(Vs + key * 72 + half * 32 + 8 * i) = R.vv[i]; }
        }
        bf16x8 qf[2]; qf[0] = R.qf[0]; qf[1] = R.qf[1];
        __syncthreads();
        if (u + (int)gridDim.x < 4608) att_load(P, u + gridDim.x, tid, R);
        const int p = p0 + 16 * wave + q; const size_t tokq = (size_t)(tok0 + r * p);
        const float slope_l2 = exp2f(-8.0f * (float)(h + 1) / 6.0f) * (float)r * 1.44269504f, qk_l2 = 0.125f * 1.44269504f;
        const float fbase = (float)(64 + q - 4 * g);
        const bool edge = (p0 < 64) || (p0 + 192 > L);
        f32x4 st[9]; float mx = -3.0e38f;
#pragma unroll
        for (int t = 0; t < 9; ++t) {
            f32x4 acc = {0.f, 0.f, 0.f, 0.f};
#pragma unroll
            for (int kk = 0; kk < 2; ++kk) { const bf16x8 a = *(const LAS bf16x8*)(Ks + (16 * wave + 16 * t + q) * 72 + kk * 32 + 8 * g); acc = MFMA32(a, qf[kk], acc); }
#pragma unroll
            for (int j = 0; j < 4; ++j) {
                const float d = fabsf(fbase - (float)(16 * t + j));
                float s = acc[j] * qk_l2 - slope_l2 * d;
                if (t == 0 || t == 8) s = (d <= 64.0f) ? s : -1.0e30f;
                acc[j] = s;
            }
            if (edge) {
#pragma unroll
                for (int j = 0; j < 4; ++j) { const int kj = p0 - 64 + 16 * wave + 16 * t + 4 * g + j; acc[j] = (kj >= 0 && kj < L) ? acc[j] : -1.0e30f; }
            }
#pragma unroll
            for (int j = 0; j < 4; ++j) mx = fmaxf(mx, acc[j]);
            st[t] = acc;
        }
        mx = fmaxf(mx, __shfl_xor(mx, 16)); mx = fmaxf(mx, __shfl_xor(mx, 32));
        float ls = 0.f; bf16x4 pt[9];
#pragma unroll
        for (int t = 0; t < 9; ++t) { f32x4 e;
#pragma unroll
            for (int j = 0; j < 4; ++j) { e[j] = __builtin_amdgcn_exp2f(st[t][j] - mx); ls += e[j]; }
            pt[t] = pk4(e); }
        ls += __shfl_xor(ls, 16); ls += __shfl_xor(ls, 32);
        const float inv = __builtin_amdgcn_rcpf(ls);
        bf16_t* ob = (bf16_t*)(P.ws + WS_OB) + ((size_t)br * NTOK + tokq) * 384 + h * 64;
        const LAS bf16_t* vrd = Vs + (16 * wave + 4 * g + (q >> 2)) * 72 + 4 * (q & 3);
#pragma unroll
        for (int dt = 0; dt < 4; ++dt) {
            f32x4 acc = {0.f, 0.f, 0.f, 0.f};
#pragma unroll
            for (int t = 0; t < 9; ++t) { const bf16x4 a = __builtin_amdgcn_ds_read_tr16_b64_v4i16((LAS bf16x4*)(vrd + 16 * t * 72 + dt * 16)); acc = MFMA16(a, pt[t], acc); }
            acc = acc * inv;
            *(bf16x4*)(ob + dt * 16 + 4 * g) = pk4(acc);
        }
        if (g == 0) ((float*)(P.ws + WS_LSE))[((size_t)br * NTOK + tokq) * 6 + h] = (mx + __log2f(ls)) * 0.69314718f;
        __syncthreads();
    }
}
__device__ __forceinline__ void att_merge(const Params& P) {
    const bf16_t* ob = (const bf16_t*)(P.ws + WS_OB); const float* lse = (const float*)(P.ws + WS_LSE); bf16_t* mixed = (bf16_t*)(P.ws + WS_HBUF);
    for (size_t it = (size_t)blockIdx.x * NTHREADS + opaque_tid(); it < (size_t)NTOK * 48; it += (size_t)gridDim.x * NTHREADS) {
        const size_t tok = it / 48; const int grp = (int)(it % 48), h = grp >> 3;
        const float l0 = lse[tok * 6 + h], l1 = lse[((size_t)NTOK + tok) * 6 + h], l2 = lse[((size_t)2 * NTOK + tok) * 6 + h];
        const float m = fmaxf(l0, fmaxf(l1, l2)), e0 = __expf(l0 - m), e1 = __expf(l1 - m), e2 = __expf(l2 - m), is = __builtin_amdgcn_rcpf(e0 + e1 + e2);
        const float w0 = e0 * is, w1 = e1 * is, w2 = e2 * is;
        const u32x4 a = *(const u32x4*)(ob + tok * 384 + grp * 8), bq = *(const u32x4*)(ob + ((size_t)NTOK + tok) * 384 + grp * 8), cq = *(const u32x4*)(ob + ((size_t)2 * NTOK + tok) * 384 + grp * 8);
        u32x4 o;
#pragma unroll
        for (int i = 0; i < 4; ++i) o[i] = pk2(w0 * bflo(a[i]) + w1 * bflo(bq[i]) + w2 * bflo(cq[i]), w0 * bfhi(a[i]) + w1 * bfhi(bq[i]) + w2 * bfhi(cq[i]));
        *(u32x4*)(mixed + tok * DM + grp * 8) = o;
    }
}

__device__ __forceinline__ float ret_logg(int h) { return log1pf(-exp2f(-5.0f - (float)h)); }
struct RetARegs { u32x4 k0, k1, v0, v1; };
__device__ __forceinline__ void retA_load(const Params& P, int u, int tid, RetARegs& R) {
    const int bh = u >> 5, n = u & 31, b = bh / 6, h = bh % 6, c = tid >> 2, qd = tid & 3;
    const bf16_t* src = (const bf16_t*)(P.ws + WS_PROJ) + (size_t)(b * SEQ + n * 128 + c) * INW + h * 64 + qd * 16;
    R.k0 = *(const u32x4*)(src + C_RK); R.k1 = *(const u32x4*)(src + C_RK + 8); R.v0 = *(const u32x4*)(src + C_RV); R.v1 = *(const u32x4*)(src + C_RV + 8);
}
__device__ __forceinline__ void retA_phase(const Params& P, LAS unsigned char* lds) {
    const int tid = opaque_tid(), lane = tid & 63, wave = __builtin_amdgcn_readfirstlane(tid >> 6), q = lane & 15, g = lane >> 4;
    LAS bf16_t* Kf = (LAS bf16_t*)lds; LAS bf16_t* Kb = (LAS bf16_t*)(lds + 18432); LAS bf16_t* Vs = (LAS bf16_t*)(lds + 36864);
    int u = blockIdx.x; if (u >= 1536) return;
    RetARegs R; retA_load(P, u, tid, R);
    for (; u < 1536; u += gridDim.x) {
        const int bh = u >> 5, n = u & 31, h = bh % 6;
        const float lg = ret_logg(h);
        {
            const int c = tid >> 2, qd = tid & 3;
            const float wf = 0.125f * __expf(lg * (float)(127 - c)), wb = 0.125f * __expf(lg * (float)c);
            u32x4 f0, f1, b0, b1;
#pragma unroll
            for (int e = 0; e < 4; ++e) { f0[e] = pk2(bflo(R.k0[e]) * wf, bfhi(R.k0[e]) * wf); f1[e] = pk2(bflo(R.k1[e]) * wf, bfhi(R.k1[e]) * wf);
                b0[e] = pk2(bflo(R.k0[e]) * wb, bfhi(R.k0[e]) * wb); b1[e] = pk2(bflo(R.k1[e]) * wb, bfhi(R.k1[e]) * wb); }
            *(LAS u32x4*)(Kf + c * 72 + qd * 16) = f0; *(LAS u32x4*)(Kf + c * 72 + qd * 16 + 8) = f1;
            *(LAS u32x4*)(Kb + c * 72 + qd * 16) = b0; *(LAS u32x4*)(Kb + c * 72 + qd * 16 + 8) = b1;
            *(LAS u32x4*)(Vs + c * 72 + qd * 16) = R.v0; *(LAS u32x4*)(Vs + c * 72 + qd * 16 + 8) = R.v1;
        }
        __syncthreads();
        if (u + (int)gridDim.x < 1536) retA_load(P, u + gridDim.x, tid, R);
        const int dir = wave >> 2, dt = wave & 3; const LAS bf16_t* Kt = dir ? Kb : Kf;
        bf16x8 afr[4];
#pragma unroll
        for (int kk = 0; kk < 4; ++kk) afr[kk] = tr8(Kt, 72, kk * 32, dt * 16, g, q);
        bf16_t* dst = (bf16_t*)(P.ws + WS_RST) + ((size_t)(bh * 32 + n) * 2 + dir) * 4096;
#pragma unroll
        for (int et = 0; et < 4; ++et) {
            f32x4 acc = {0.f, 0.f, 0.f, 0.f};
#pragma unroll
            for (int kk = 0; kk < 4; ++kk) { const bf16x8 bfr = tr8(Vs, 72, kk * 32, et * 16, g, q); acc = MFMA32(afr[kk], bfr, acc); }
            *(bf16x4*)(dst + (et * 16 + q) * 64 + dt * 16 + 4 * g) = pk4(acc);
        }
        __syncthreads();
    }
}
__device__ __forceinline__ void ret_scan(const Params& P) {
    bf16_t* st = (bf16_t*)(P.ws + WS_RST);
    for (int it = blockIdx.x * NTHREADS + opaque_tid(); it < 48 * 2 * 512; it += gridDim.x * NTHREADS) {
        const int ch = it & 511, dir = (it >> 9) & 1, bh = it >> 10, h = bh % 6;
        const float cd = __expf(ret_logg(h) * 128.0f);
        float s[8];
#pragma unroll
        for (int e = 0; e < 8; ++e) s[e] = 0.f;
        for (int i0 = 0; i0 < 32; i0 += 8) {
            u32x4 v[8];
#pragma unroll
            for (int i = 0; i < 8; ++i) { const int n = dir ? 31 - (i0 + i) : (i0 + i); v[i] = *(const u32x4*)(st + ((size_t)(bh * 32 + n) * 2 + dir) * 4096 + 8 * ch); }
#pragma unroll
            for (int i = 0; i < 8; ++i) { const int n = dir ? 31 - (i0 + i) : (i0 + i);
                u32x4 o;
#pragma unroll
                for (int e = 0; e < 4; ++e) o[e] = pk2(s[2 * e], s[2 * e + 1]);
                *(u32x4*)(st + ((size_t)(bh * 32 + n) * 2 + dir) * 4096 + 8 * ch) = o;
#pragma unroll
                for (int e = 0; e < 4; ++e) { s[2 * e] = cd * s[2 * e] + bflo(v[i][e]); s[2 * e + 1] = cd * s[2 * e + 1] + bfhi(v[i][e]); } }
        }
    }
}
struct RetBRegs { u32x4 k0, k1, v0, v1, rf, rb, q0, q1; };
__device__ __forceinline__ void retB_load(const Params& P, int u, int tid, RetBRegs& R) {
    const int bh = u >> 5, n = u & 31, b = bh / 6, h = bh % 6, c = tid >> 2, qd = tid & 3;
    const bf16_t* proj = (const bf16_t*)(P.ws + WS_PROJ);
    const bf16_t* src = proj + (size_t)(b * SEQ + n * 128 + c) * INW + h * 64 + qd * 16;
    R.k0 = *(const u32x4*)(src + C_RK); R.k1 = *(const u32x4*)(src + C_RK + 8); R.v0 = *(const u32x4*)(src + C_RV); R.v1 = *(const u32x4*)(src + C_RV + 8);
    const bf16_t* rs = (const bf16_t*)(P.ws + WS_RST) + (size_t)(bh * 32 + n) * 2 * 4096;
    const int e = tid >> 3, d8 = (tid & 7) * 8;
    R.rf = *(const u32x4*)(rs + e * 64 + d8); R.rb = *(const u32x4*)(rs + 4096 + e * 64 + d8);
    const int lane = tid & 63, wave = tid >> 6, q = lane & 15, g = lane >> 4;
    const bf16_t* qp = proj + (size_t)(b * SEQ + n * 128 + 16 * wave + q) * INW + C_RQ + h * 64 + 8 * g;
    R.q0 = *(const u32x4*)qp; R.q1 = *(const u32x4*)(qp + 32);
}
__device__ __forceinline__ void retB_phase(const Params& P, LAS unsigned char* lds, int layer) {
    const int tid = opaque_tid(), lane = tid & 63, wave = __builtin_amdgcn_readfirstlane(tid >> 6), q = lane & 15, g = lane >> 4;
    const bf16_t* proj = (const bf16_t*)(P.ws + WS_PROJ);
    LAS bf16_t* Ks = (LAS bf16_t*)lds;
    LAS bf16_t* Vs = (LAS bf16_t*)(lds + 18432);
    LAS bf16_t* Rf = (LAS bf16_t*)(lds + 36864);
    LAS bf16_t* Rb = (LAS bf16_t*)(lds + 46080);
    int u = blockIdx.x; if (u >= 1536) return;
    RetBRegs R; retB_load(P, u, tid, R);
    for (; u < 1536; u += gridDim.x) {
        const int bh = u >> 5, n = u & 31, b = bh / 6, h = bh % 6;
        const float lg = ret_logg(h);
        {
            const int c = tid >> 2, qd = tid & 3, e = tid >> 3, d8 = (tid & 7) * 8;
            *(LAS u32x4*)(Ks + c * 72 + qd * 16) = R.k0; *(LAS u32x4*)(Ks + c * 72 + qd * 16 + 8) = R.k1;
            *(LAS u32x4*)(Vs + c * 72 + qd * 16) = R.v0; *(LAS u32x4*)(Vs + c * 72 + qd * 16 + 8) = R.v1;
            *(LAS u32x4*)(Rf + e * 72 + d8) = R.rf; *(LAS u32x4*)(Rb + e * 72 + d8) = R.rb;
        }
        const u32x4 qraw[2] = {R.q0, R.q1};
        __syncthreads();
        if (u + (int)gridDim.x < 1536) retB_load(P, u + gridDim.x, tid, R);
        const int i = 16 * wave + q; const size_t tok = (size_t)(b * SEQ + n * 128 + i);
        bf16x8 qf[2], qff[2], qfb[2];
        {
            const float ff = __expf(lg * (float)(i + 1)), fb = __expf(lg * (float)(128 - i));
#pragma unroll
            for (int kk = 0; kk < 2; ++kk) { const u32x4 raw = qraw[kk];
                qf[kk] = __builtin_bit_cast(bf16x8, raw); u32x4 a, c2;
#pragma unroll
                for (int e = 0; e < 4; ++e) { const float lo = bflo(raw[e]), hi = bfhi(raw[e]); a[e] = pk2(lo * ff, hi * ff); c2[e] = pk2(lo * fb, hi * fb); }
                qff[kk] = __builtin_bit_cast(bf16x8, a); qfb[kk] = __builtin_bit_cast(bf16x8, c2); }
        }
        bf16x4 pt[8];
#pragma unroll
        for (int jt = 0; jt < 8; ++jt) {
            f32x4 acc = {0.f, 0.f, 0.f, 0.f};
#pragma unroll
            for (int kk = 0; kk < 2; ++kk) { const bf16x8 a = *(const LAS bf16x8*)(Ks + (16 * jt + q) * 72 + kk * 32 + 8 * g); acc = MFMA32(a, qf[kk], acc); }
#pragma unroll
            for (int jj = 0; jj < 4; ++jj) { int dd = i - (16 * jt + 4 * g + jj); dd = dd < 0 ? -dd : dd; acc[jj] = acc[jj] * 0.125f * __expf(lg * (float)dd); }
            pt[jt] = pk4(acc);
        }
        f32x4 o[4];
#pragma unroll
        for (int et = 0; et < 4; ++et) {
            f32x4 acc = {0.f, 0.f, 0.f, 0.f};
#pragma unroll
            for (int jt = 0; jt < 8; ++jt) { const bf16x4 a = tr4(Vs, 72, 16 * jt, et * 16, g, q); acc = MFMA16(a, pt[jt], acc); }
#pragma unroll
            for (int kk = 0; kk < 2; ++kk) { const bf16x8 a = *(const LAS bf16x8*)(Rf + (et * 16 + q) * 72 + kk * 32 + 8 * g); acc = MFMA32(a, qff[kk], acc);
                const bf16x8 a2 = *(const LAS bf16x8*)(Rb + (et * 16 + q) * 72 + kk * 32 + 8 * g); acc = MFMA32(a2, qfb[kk], acc); }
            o[et] = acc;
        }
        float s = 0.f;
#pragma unroll
        for (int et = 0; et < 4; ++et) s += (o[et][0] + o[et][1]) + (o[et][2] + o[et][3]);
        s += __shfl_xor(s, 16); s += __shfl_xor(s, 32);
        const float mu = s * (1.0f / 64.0f); float vs = 0.f;
#pragma unroll
        for (int et = 0; et < 4; ++et) { o[et] = o[et] - mu; vs += (o[et][0] * o[et][0] + o[et][1] * o[et][1]) + (o[et][2] * o[et][2] + o[et][3] * o[et][3]); }
        vs += __shfl_xor(vs, 16); vs += __shfl_xor(vs, 32);
        const float rstd = rsqrtf(vs * (1.0f / 64.0f) + NORM_EPS);
        bf16_t* mixed = (bf16_t*)(P.ws + WS_HBUF) + tok * DM + 384 + h * 64;
#pragma unroll
        for (int et = 0; et < 4; ++et) {
            const f32x4 gn = *(const f32x4*)(P.ret_gn + layer * 384 + h * 64 + et * 16 + 4 * g);
            const u32x2 rg = *(const u32x2*)(proj + tok * INW + C_RG + h * 64 + et * 16 + 4 * g);
            f32x4 y; y[0] = o[et][0] * rstd * gn[0] * siluf(bflo(rg.x)); y[1] = o[et][1] * rstd * gn[1] * siluf(bfhi(rg.x));
            y[2] = o[et][2] * rstd * gn[2] * siluf(bflo(rg.y)); y[3] = o[et][3] * rstd * gn[3] * siluf(bfhi(rg.y));
            *(bf16x4*)(mixed + et * 16 + 4 * g) = pk4(y);
        }
        __syncthreads();
    }
}
__device__ __forceinline__ void hgrn_gate(float z, float lbv, float& f, float& kk) {
    z = fminf(fmaxf(z, -30.f), 30.f);
    const float ez = __expf(-z), sg = __builtin_amdgcn_rcpf(1.0f + ez);
    f = lbv + (1.0f - lbv) * sg; kk = (1.0f - lbv) * ez * sg;
}
__device__ __forceinline__ void hgA_unit(const Params& P, LAS unsigned char* lds, int u, int layer) {
    const int tid = opaque_tid(), lane = tid & 63, wave = __builtin_amdgcn_readfirstlane(tid >> 6), q = lane & 15, g = lane >> 4;
    const int bh = u >> 5, n = u & 31, b = bh >> 2, h = bh & 3;
    const bf16_t* proj = (const bf16_t*)(P.ws + WS_PROJ);
    LAS bf16_t* Kt = (LAS bf16_t*)lds;
    LAS bf16_t* Vt = (LAS bf16_t*)(lds + 34816);
    LAS float* segs = (LAS float*)(lds + 52224);
    const size_t tokc = (size_t)(b * SEQ + n * 128);
    {
        const int c = tid >> 2, qd = tid & 3; const bf16_t* src = proj + (tokc + c) * INW + C_HI + h * 64 + qd * 16;
        const u32x4 v0 = *(const u32x4*)src, v1 = *(const u32x4*)(src + 8);
#pragma unroll
        for (int e = 0; e < 8; ++e) { const unsigned vw = e < 4 ? v0[e & 3] : v1[e & 3]; const int d = qd * 16 + 2 * e;
            Vt[d * 136 + c] = (bf16_t)(vw & 0xffffu); Vt[(d + 1) * 136 + c] = (bf16_t)(vw >> 16); }
    }
    const int d = tid & 63, dir = (tid >> 6) & 1, seg = tid >> 7;
    const float lbv = ((const float*)(P.ws + WS_LB))[layer * 256 + h * 64 + d];
    float lf[32], kk[32];
    {
        const bf16_t* zp = proj + (tokc + seg * 32) * INW + (dir ? C_HZB : C_HZF) + h * 64 + d;
        bf16_t zr[32];
#pragma unroll
        for (int i = 0; i < 32; ++i) zr[i] = zp[(size_t)i * INW];
#pragma unroll
        for (int i = 0; i < 32; ++i) hgrn_gate(bf2f(zr[i]), lbv, lf[i], kk[i]);
    }
    float ssum = 1.f;
#pragma unroll
    for (int i = 0; i < 32; ++i) ssum *= lf[i];
    segs[(dir * 4 + seg) * 64 + d] = ssum;
    __syncthreads();
    {
        float before = 1.f, after = 1.f;
#pragma unroll
        for (int s2 = 0; s2 < 4; ++s2) { const float v = segs[(dir * 4 + s2) * 64 + d]; if (s2 < seg) before *= v; if (s2 > seg) after *= v; }
        LAS bf16_t* kt = Kt + dir * (64 * 136) + d * 136 + seg * 32;
        if (dir == 0) {
            float run = after;
#pragma unroll
            for (int i = 31; i >= 0; --i) { kt[i] = f2bf(kk[i] * run); run *= lf[i]; }
        } else {
            float run = before;
#pragma unroll
            for (int i = 0; i < 32; ++i) { kt[i] = f2bf(kk[i] * run); run *= lf[i]; }
        }
        if (seg == 0) ((float*)(P.ws + WS_HGA))[((size_t)(bh * 2 + dir) * 32 + n) * 64 + d] = ssum * after;
    }
    __syncthreads();
    {
        const int wdir = wave >> 2, dt = wave & 3; const LAS bf16_t* kts = Kt + wdir * (64 * 136);
        bf16x8 afr[4];
#pragma unroll
        for (int kq = 0; kq < 4; ++kq) afr[kq] = *(const LAS bf16x8*)(kts + (dt * 16 + q) * 136 + kq * 32 + 8 * g);
        float* dst = (float*)(P.ws + WS_HGU) + ((size_t)(bh * 2 + wdir) * 32 + n) * 4096;
#pragma unroll
        for (int et = 0; et < 4; ++et) {
            f32x4 acc = {0.f, 0.f, 0.f, 0.f};
#pragma unroll
            for (int kq = 0; kq < 4; ++kq) { const bf16x8 bfr = *(const LAS bf16x8*)(Vt + (et * 16 + q) * 136 + kq * 32 + 8 * g); acc = MFMA32(afr[kq], bfr, acc); }
#pragma unroll
            for (int j = 0; j < 4; ++j) dst[(dt * 16 + 4 * g + j) * 64 + et * 16 + q] = acc[j];
        }
    }
    __syncthreads();
}
__device__ __forceinline__ void hg_scan(const Params& P) {
    float* U = (float*)(P.ws + WS_HGU); const float* A = (const float*)(P.ws + WS_HGA);
    for (int it = blockIdx.x * NTHREADS + opaque_tid(); it < 64 * 64 * 16; it += gridDim.x * NTHREADS) {
        const int e4 = it & 15, d = (it >> 4) & 63, bd = it >> 10, dir = bd & 1;
        f32x4 s = {0.f, 0.f, 0.f, 0.f};
        for (int i0 = 0; i0 < 32; i0 += 8) {
            f32x4 v[8]; float a[8];
#pragma unroll
            for (int i = 0; i < 8; ++i) { const int n = dir ? 31 - (i0 + i) : (i0 + i); v[i] = *(const f32x4*)(U + ((size_t)(bd * 32 + n) * 64 + d) * 64 + 4 * e4); a[i] = A[(size_t)(bd * 32 + n) * 64 + d]; }
#pragma unroll
            for (int i = 0; i < 8; ++i) { const int n = dir ? 31 - (i0 + i) : (i0 + i); *(f32x4*)(U + ((size_t)(bd * 32 + n) * 64 + d) * 64 + 4 * e4) = s; s = s * a[i] + v[i]; }
        }
    }
}
__device__ __forceinline__ unsigned pk2h(float lo, float hi) { return pk2(lo, hi); }
__device__ __forceinline__ bf16x4 pk4h(f32x4 v) { return pk4(v); }
__device__ __forceinline__ void hgB_unit(const Params& P, LAS unsigned char* lds, int u, int layer) {
    const int tid = opaque_tid(), lane = tid & 63, wave = __builtin_amdgcn_readfirstlane(tid >> 6), q = lane & 15, g = lane >> 4;
    const int b = u >> 5, n = u & 31, h = wave >> 1, dir = wave & 1, bh = b * 4 + h;
    bf16_t* proj = (bf16_t*)(P.ws + WS_PROJ);
    bf16_t* mixed = (bf16_t*)(P.ws + WS_HBUF);
    LAS unsigned char* wl = lds + wave * 7168;
    LAS bf16_t* Qi = (LAS bf16_t*)wl;
    LAS bf16_t* Ki = (LAS bf16_t*)(wl + 2304);
    LAS bf16_t* Vs = (LAS bf16_t*)(wl + 4608);
    LAS float* Al = (LAS float*)(wl + 6912);
    const size_t tokc = (size_t)(b * SEQ + n * 128);
    const float lbv = ((const float*)(P.ws + WS_LB))[layer * 256 + h * 64 + lane];
    f32x4 S[4][4];
    {
        const float* sp = (const float*)(P.ws + WS_HGU) + ((size_t)(bh * 2 + dir) * 32 + n) * 4096;
#pragma unroll
        for (int dt = 0; dt < 4; ++dt)
#pragma unroll
            for (int et = 0; et < 4; ++et)
#pragma unroll
                for (int j = 0; j < 4; ++j) S[dt][et][j] = sp[(dt * 16 + 4 * g + j) * 64 + et * 16 + q];
    }
    bf16_t* odst = dir ? (proj + C_AQ + h * 64) : (mixed + 768 + h * 64); const size_t opitch = dir ? INW : DM;
    bf16_t qr[16], zz[16]; u32x4 v0, v1;
#define HGB_LOAD(SC) do { const size_t toks_ = tokc + (SC) * 16; const bf16_t* base_ = proj + toks_ * INW + h * 64 + lane; \
        _Pragma("unroll") for (int ii = 0; ii < 16; ++ii) { const int t_ = dir ? 15 - ii : ii; qr[ii] = base_[(size_t)t_ * INW + C_HQ]; zz[ii] = base_[(size_t)t_ * INW + (dir ? C_HZB : C_HZF)]; } \
        const bf16_t* vsrc_ = proj + (toks_ + (lane >> 2)) * INW + C_HI + h * 64 + (lane & 3) * 16; v0 = *(const u32x4*)vsrc_; v1 = *(const u32x4*)(vsrc_ + 8); } while (0)
    HGB_LOAD(dir ? 7 : 0);
    for (int i = 0; i < 8; ++i) {
        const int sc = dir ? 7 - i : i; const size_t toks = tokc + sc * 16;
        {
            *(LAS u32x4*)(Vs + (lane >> 2) * 72 + (lane & 3) * 16) = v0; *(LAS u32x4*)(Vs + (lane >> 2) * 72 + (lane & 3) * 16 + 8) = v1;
            float bp = 1.f;
#pragma unroll
            for (int ii = 0; ii < 16; ++ii) {
                const int t = dir ? 15 - ii : ii;
                float f, kk; hgrn_gate(bf2f(zz[ii]), lbv, f, kk); const float qv = siluf(bf2f(qr[ii]));
                bp *= f;
                Qi[t * 72 + lane] = f2bf(qv * bp); Ki[t * 72 + lane] = f2bf(kk * __builtin_amdgcn_rcpf(fmaxf(bp, 1.0e-30f)));
            }
            Al[lane] = bp;
        }
        if (i + 1 < 8) HGB_LOAD(dir ? 6 - i : i + 1);
        __builtin_amdgcn_fence(__ATOMIC_RELEASE, "wavefront"); __builtin_amdgcn_wave_barrier(); __builtin_amdgcn_fence(__ATOMIC_ACQUIRE, "wavefront");
        f32x4 at = {0.f, 0.f, 0.f, 0.f};
#pragma unroll
        for (int kq = 0; kq < 2; ++kq) { const bf16x8 a8 = *(const LAS bf16x8*)(Ki + q * 72 + kq * 32 + 8 * g), b8 = *(const LAS bf16x8*)(Qi + q * 72 + kq * 32 + 8 * g); at = MFMA32(a8, b8, at); }
#pragma unroll
        for (int j = 0; j < 4; ++j) { const int sl = 4 * g + j; const bool keep = dir ? (sl >= q) : (sl <= q); at[j] = keep ? at[j] : 0.f; }
        const bf16x4 p4 = pk4h(at);
        bf16x4 b4[4], v4[4];
#pragma unroll
        for (int dt = 0; dt < 4; ++dt) b4[dt] = *(const LAS bf16x4*)(Qi + q * 72 + dt * 16 + 4 * g);
#pragma unroll
        for (int et = 0; et < 4; ++et) v4[et] = tr4(Vs, 72, 0, et * 16, g, q);
#pragma unroll
        for (int et = 0; et < 4; ++et) {
            f32x4 o = {0.f, 0.f, 0.f, 0.f};
#pragma unroll
            for (int dt = 0; dt < 4; ++dt) o = MFMA16(pk4h(S[dt][et]), b4[dt], o);
            o = MFMA16(v4[et], p4, o);
            *(bf16x4*)(odst + (toks + q) * opitch + et * 16 + 4 * g) = pk4(o);
        }
#pragma unroll
        for (int dt = 0; dt < 4; ++dt) {
            const bf16x4 kT4 = tr4(Ki, 72, 0, dt * 16, g, q);
            const f32x4 al4 = *(const LAS f32x4*)(Al + dt * 16 + 4 * g);
#pragma unroll
            for (int et = 0; et < 4; ++et) { const f32x4 s2 = MFMA16(kT4, v4[et], S[dt][et]); S[dt][et] = s2 * al4; }
        }
        __builtin_amdgcn_fence(__ATOMIC_RELEASE, "wavefront"); __builtin_amdgcn_wave_barrier(); __builtin_amdgcn_fence(__ATOMIC_ACQUIRE, "wavefront");
    }
    asm volatile("s_waitcnt vmcnt(0)" ::: "memory");
    __syncthreads();
    {
        const int tau = tid >> 2, qd = tid & 3;
        bf16_t* mp = mixed + (tokc + tau) * DM + 768 + qd * 64; const bf16_t* bp2 = proj + (tokc + tau) * INW + C_AQ + qd * 64;
        const bf16_t* gp = proj + (tokc + tau) * INW + C_HG + qd * 64; const float* gn = P.hgrn_gn + layer * 256 + qd * 64;
        float o[64]; float sq = 0.f;
#pragma unroll
        for (int c4 = 0; c4 < 16; ++c4) {
            const unsigned long long fv = __hip_atomic_load((const unsigned long long*)(mp + c4 * 4), __ATOMIC_RELAXED, __HIP_MEMORY_SCOPE_AGENT), bv = __hip_atomic_load((const unsigned long long*)(bp2 + c4 * 4), __ATOMIC_RELAXED, __HIP_MEMORY_SCOPE_AGENT);
            const unsigned f0 = (unsigned)fv, f1 = (unsigned)(fv >> 32), b0 = (unsigned)bv, b1 = (unsigned)(bv >> 32);
            const float x0 = bflo(f0) + bflo(b0), x1 = bfhi(f0) + bfhi(b0), x2 = bflo(f1) + bflo(b1), x3 = bfhi(f1) + bfhi(b1);
            o[c4 * 4 + 0] = x0; o[c4 * 4 + 1] = x1; o[c4 * 4 + 2] = x2; o[c4 * 4 + 3] = x3; sq += (x0 * x0 + x1 * x1) + (x2 * x2 + x3 * x3); }
        sq += __shfl_xor(sq, 1); sq += __shfl_xor(sq, 2);
        const float rstd = rsqrtf(sq * (1.0f / 256.0f) + NORM_EPS);
#pragma unroll
        for (int c8 = 0; c8 < 8; ++c8) {
            const u32x4 gv = *(const u32x4*)(gp + c8 * 8); const f32x4 g0 = *(const f32x4*)(gn + c8 * 8), g1 = *(const f32x4*)(gn + c8 * 8 + 4);
            u32x4 r;
            r.x = pk2h(o[c8 * 8 + 0] * rstd * g0[0] * siluf(bflo(gv.x)), o[c8 * 8 + 1] * rstd * g0[1] * siluf(bfhi(gv.x)));
            r.y = pk2h(o[c8 * 8 + 2] * rstd * g0[2] * siluf(bflo(gv.y)), o[c8 * 8 + 3] * rstd * g0[3] * siluf(bfhi(gv.y)));
            r.z = pk2h(o[c8 * 8 + 4] * rstd * g1[0] * siluf(bflo(gv.z)), o[c8 * 8 + 5] * rstd * g1[1] * siluf(bfhi(gv.z)));
            r.w = pk2h(o[c8 * 8 + 6] * rstd * g1[2] * siluf(bflo(gv.w)), o[c8 * 8 + 7] * rstd * g1[3] * siluf(bfhi(gv.w)));
            *(u32x4*)(mp + c8 * 8) = r;
        }
    }
    __syncthreads();
}
constexpr int N_PHASES = 20;
#ifndef PROBE_MASK
#define PROBE_MASK 0u
#endif
#ifndef PROBE_U
#define PROBE_U 0
#endif
#ifndef STAGGER
#define STAGGER 0
#endif
#ifndef STAGGER_TICKS
#define STAGGER_TICKS 1000u
#endif
#ifndef PROBE_SYNC2
#define PROBE_SYNC2 0
#endif
__device__ __forceinline__ void stagger_half(unsigned ticks) {
#if STAGGER
    if ((blockIdx.x >> 3) & 1) { const unsigned long long t0 = __builtin_amdgcn_s_memrealtime(); while (__builtin_amdgcn_s_memrealtime() - t0 < ticks) __builtin_amdgcn_s_sleep(32); }
    __syncthreads();
#endif
}
__device__ __forceinline__ void run_phase(const Params& P, LAS unsigned char* lds, int ph) {
    unsigned char* ws = P.ws;
    if (ph == 0) { phase_prologue(P, lds); return; }
    if (ph == N_PHASES - 1) { phase_norm<true, true>(P.out, (const bf16_t*)(ws + WS_OB), (const float*)(ws + WS_MOD) + (size_t)(DEPTH - 1) * NBATCH * NMOD * DM + 5 * DM, P.out, P.g_final, nullptr, nullptr, nullptr); return; }
    const int l = (ph - 1) / 9, s = (ph - 1) % 9;
    const float* mod = (const float*)(ws + WS_MOD) + (size_t)l * NBATCH * NMOD * DM;
    bf16_t* hbuf = (bf16_t*)(ws + WS_HBUF); bf16_t* proj = (bf16_t*)(ws + WS_PROJ); bf16_t* ybuf = (bf16_t*)(ws + WS_OB);
#ifdef PH_ONLY
    if (s != PH_ONLY) return;
#endif
    int kD = DM, kF = FFN; asm volatile("" : "+s"(kD), "+s"(kF));
    switch (s) {
    case 0: if (l == 0) { phase_norm<false, false>(P.x, nullptr, nullptr, nullptr, P.g_mix, mod + 0 * DM, mod + 1 * DM, hbuf); phase_weights(P, lds); }
            else phase_norm<true, false>(P.out, ybuf, mod - (size_t)NBATCH * NMOD * DM + 5 * DM, P.out, P.g_mix + l * DM, mod + 0 * DM, mod + 1 * DM, hbuf);
            break;
    case 1: { pg8::Gemm g{hbuf, (const bf16_t*)(ws + WS_WIN) + (size_t)l * INWP * DM, NTOK, INWP, kD}; pg8::StaticOrder S; S.init(NTOK, INWP, gridDim.x, blockIdx.x);
              EpiProj E{proj, INW, INW}; pg8::gemm_phase<EpiProj, pg8::StaticOrder>(lds, g, S, E, nullptr); } break;
    case 2: { for (int rp = 0; rp < (PROBE_U == 1 ? 2 : 1); ++rp) att_phase(P, lds);
              for (int rp = 0; rp < (PROBE_U == 2 ? 2 : 1); ++rp) retA_phase(P, lds);
              for (int rp = 0; rp < (PROBE_U == 3 ? 2 : 1); ++rp) for (int u = blockIdx.x; u < 1024; u += gridDim.x) hgA_unit(P, lds, u, l); } break;
    case 3: { ret_scan(P); hg_scan(P); } break;
    case 4: { for (int rp = 0; rp < (PROBE_U == 4 ? 2 : 1); ++rp) for (int u = blockIdx.x; u < 256; u += gridDim.x) hgB_unit(P, lds, u, l);
              for (int rp = 0; rp < (PROBE_U == 5 ? 2 : 1); ++rp) retB_phase(P, lds, l); att_merge(P); } break;
    case 5: { pg8::Gemm g{hbuf, (const bf16_t*)(ws + WS_WOUT) + (size_t)l * DM * DM, NTOK, DM, kD}; pg8::StaticOrder S; S.init(NTOK, DM, gridDim.x, blockIdx.x);
              EpiProj E{ybuf, DM, DM}; pg8::gemm_phase<EpiProj, pg8::StaticOrder>(lds, g, S, E, nullptr); } break;
    case 6: phase_norm<true, false>(l == 0 ? P.x : P.out, ybuf, mod + 2 * DM, P.out, P.g_ffn + l * DM, mod + 3 * DM, mod + 4 * DM, hbuf); break;
    case 7: { pg8::Gemm g{hbuf, (const bf16_t*)(ws + WS_WGU) + (size_t)l * 2 * FFN * DM, NTOK, 2 * FFN, kD}; pg8::StaticOrder S; S.init(NTOK, 2 * FFN, gridDim.x, blockIdx.x);
              EpiSwiglu E{proj}; pg8::gemm_phase<EpiSwiglu, pg8::StaticOrder>(lds, g, S, E, nullptr); } break;
    case 8: { pg8::Gemm g{proj, (const bf16_t*)(ws + WS_WDN) + (size_t)l * DM * FFN, NTOK, DM, kF}; pg8::StaticOrder S; S.init(NTOK, DM, gridDim.x, blockIdx.x);
              EpiProj E{ybuf, DM, DM}; pg8::gemm_phase<EpiProj, pg8::StaticOrder>(lds, g, S, E, nullptr); } break;
    }
}
__global__ void __launch_bounds__(NTHREADS) hybrid_fwd(Params P) {
    extern __shared__ __attribute__((aligned(16))) unsigned char lds_raw[];
    __shared__ uint4 xb_words;
    LAS unsigned char* lds = (LAS unsigned char*)lds_raw;
    if (threadIdx.x == 0) xb_words = make_uint4(0u, 0u, 0u, 0u);
    __syncthreads();
    XcdBarrier bar = xcd_barrier_post((unsigned*)(P.ws + WS_CTL), (volatile LAS unsigned*)&xb_words);
    for (int ph = P.ph_lo; ph < P.ph_hi; ++ph) {
        const int reps = ((PROBE_MASK >> ph) & 1u) ? 2 : 1;
        for (int rep = 0; rep < reps; ++rep) { run_phase(P, lds, ph); if (rep + 1 < reps) __syncthreads(); }
        if (ph + 1 < P.ph_hi) {
            if (P.ph_hi > N_PHASES) cg::this_grid().sync(); else xcd_barrier(bar);
            if (PROBE_SYNC2) xcd_barrier(bar);
        }
    }
}

extern "C" void kernel_launch(void* const* d_in, const int* in_sizes, int n_in, void* d_out, int out_size, void* d_ws, size_t ws_size, hipStream_t stream) {
    static int grid = 0;
    if (grid == 0) {
        if (n_in != 14 || out_size != NTOK * DM || ws_size < WS_END) { fprintf(stderr, "kernel_launch: unexpected shapes (n_in %d out %d ws %zu need %zu)\n", n_in, out_size, ws_size, (size_t)WS_END); grid = -1; return; }
        int dev = 0, cus = 0, per_cu = 0;
        hipGetDevice(&dev); hipDeviceGetAttribute(&cus, hipDeviceAttributeMultiprocessorCount, dev);
        if (hipFuncSetAttribute((const void*)hybrid_fwd, hipFuncAttributeMaxDynamicSharedMemorySize, LDS_BYTES) != hipSuccess) { fprintf(stderr, "kernel_launch: hipFuncSetAttribute failed\n"); grid = -1; return; }
        if (hipOccupancyMaxActiveBlocksPerMultiprocessor(&per_cu, (const void*)hybrid_fwd, NTHREADS, LDS_BYTES) != hipSuccess || per_cu < 1) { fprintf(stderr, "kernel_launch: occupancy query says %d\n", per_cu); grid = -1; return; }
        grid = cus;
    }
    if (grid < 0) return;
    if (hipMemsetAsync((char*)d_ws + WS_CTL, 0, 16384, stream) != hipSuccess) { fprintf(stderr, "kernel_launch: memset failed\n"); return; }
    Params p{};
    p.x = (const float*)d_in[0]; p.c = (const float*)d_in[1]; p.w_ada = (const float*)d_in[2]; p.b_ada = (const float*)d_in[3]; p.g_mix = (const float*)d_in[4];
    p.w_in = (const float*)d_in[5]; p.ret_gn = (const float*)d_in[6]; p.hgrn_gn = (const float*)d_in[7]; p.lb_logits = (const float*)d_in[8]; p.w_out = (const float*)d_in[9];
    p.g_ffn = (const float*)d_in[10]; p.w_gu = (const float*)d_in[11]; p.w_down = (const float*)d_in[12]; p.g_final = (const float*)d_in[13];
    p.out = (float*)d_out; p.ws = (unsigned char*)d_ws;
#if ONE_LAUNCH
    p.ph_lo = 0; p.ph_hi = N_PHASES;
    void* args[] = {&p};
    hipError_t e = hipLaunchCooperativeKernel((const void*)hybrid_fwd, dim3(grid), dim3(NTHREADS), args, LDS_BYTES, stream);
    if (e != hipSuccess) fprintf(stderr, "cooperative launch failed: %s (grid %d)\n", hipGetErrorString(e), grid);
#else
    for (int ph = 0; ph < N_PHASES; ++ph) { p.ph_lo = ph; p.ph_hi = ph + 1; hipLaunchKernelGGL(hybrid_fwd, dim3(grid), dim3(NTHREADS), LDS_BYTES, stream, p); }
#endif
}
```

```cpp
#include <hip/hip_runtime.h>
#include <hip/hip_cooperative_groups.h>
#include <cstdio>
#include <cstdint>
namespace cg = cooperative_groups;
#ifndef ONE_LAUNCH
#define ONE_LAUNCH 1
#endif
__device__ __forceinline__ int opaque_tid() { int t = threadIdx.x; asm volatile("" : "+v"(t)); return t; }
#define LAS __attribute__((address_space(3)))
namespace pg8 {
#define PG8_LAS __attribute__((address_space(3)))
typedef unsigned short bf16_t;
typedef short bf16x8 __attribute__((ext_vector_type(8)));
typedef float f32x4 __attribute__((ext_vector_type(4)));
typedef unsigned u32x4 __attribute__((ext_vector_type(4)));
constexpr int BM = 256, BK = 64, HALF = 128, HTB = HALF * BK * 2  , STAGE_BYTES = 8 * HTB, NXCD = 8, WGM = 8;

__host__ __device__ __forceinline__ int lds_byte(int r, int c) { const int st = (r >> 4) * 2 + (c >> 5), rr = r & 15, cc = c & 31, ob = rr * 64 + cc * 2; return st * 1024 + (ob ^ (((ob >> 9) & 1) << 5)); }
__host__ __device__ __forceinline__ void stage_rc(int b, int& R, int& C) { const int st = b / 1024, sb = b % 1024, swz = sb ^ (((sb >> 9) & 1) << 5); R = (st >> 1) * 16 + swz / 64; C = (st & 1) * 32 + (swz % 64) / 2; }
__host__ __device__ __forceinline__ int perm32(int rho) { const int n = rho >> 4, i = rho & 15; return 8 * (i >> 2) + 4 * n + (i & 3); }

struct Unit { int pm, pn; };
struct Gemm { const bf16_t* A; const bf16_t* Bt; int M, N, K; };

struct StaticOrder {
    int nM, nN, nwg, G, c;
    __host__ __device__ void init(int M, int N, int G_, int c_) { nM = M / BM; nN = N / BM; nwg = nM * nN; G = G_; c = c_; }
    __host__ __device__ bool next(int i, Unit& u) const {
        const long L = (long)i * G + c; if (L >= nwg) return false;
        int wgid = (int)L; { const int q = nwg / NXCD, r = nwg % NXCD, xcd = wgid % NXCD, off = wgid / NXCD; wgid = (xcd < r ? xcd * (q + 1) : r * (q + 1) + (xcd - r) * q) + off; }
        const int nig = WGM * nN, gid = wgid / nig, fm = gid * WGM, gsz = (nM - fm) < WGM ? (nM - fm) : WGM;
        u.pm = fm + ((wgid % nig) % gsz); u.pn = (wgid % nig) / gsz; return true;
    }
    __device__ __forceinline__ void a_ready(const Unit&) const {}
    __device__ __forceinline__ void done(const Unit&) const {}
};
__device__ __forceinline__ unsigned cvt_pk_bf16(float lo, float hi) { unsigned r; asm volatile("v_cvt_pk_bf16_f32 %0, %1, %2" : "=v"(r) : "v"(lo), "v"(hi)); return r; }
typedef float f32x2 __attribute__((ext_vector_type(2)));
template <class Epi, class Sched, bool STAMP = false>
__device__ __forceinline__ void gemm_phase(PG8_LAS unsigned char* lds, const Gemm g, const Sched& S, const Epi& E, unsigned long long* stamps) {
    const int tid = opaque_tid(), wid = __builtin_amdgcn_readfirstlane(tid >> 6), lane = tid & 63, wr = wid >> 2, wc = wid & 3, fr = lane & 15, fq = lane >> 4;
    const int K = g.K, nt = K / BK;
    int ts_lo = 0, ts_hi = 0, nts = 0; const unsigned long long rt_entry = STAMP ? (unsigned long long)wall_clock64() : 0ull;
#define PG8_STAMP() do { if (STAMP && wid == 0 && nts < 64) { const unsigned long long _c = (unsigned long long)clock64(); \
        ts_lo = (lane == nts) ? (int)(unsigned)_c : ts_lo; ts_hi = (lane == nts) ? (int)(unsigned)(_c >> 32) : ts_hi; ++nts; } } while (0)
    PG8_STAMP();
    unsigned voffA[2], voffB[2];
#pragma unroll
    for (int i = 0; i < 2; ++i) { int R, C; stage_rc(tid * 16 + i * 8192, R, C); const int Rb = Epi::PERM ? ((R & ~31) + perm32(R & 31)) : R;
        voffA[i] = (unsigned)(R * K + C) * 2u; voffB[i] = (unsigned)(Rb * K + C) * 2u; }
    const size_t kstep = (size_t)(BK * 2);
    const size_t hstep = (size_t)HALF * K * 2;
    const size_t tstep = 2 * hstep;
    const unsigned ldsw = (unsigned)wid * 1024u;
    const int aoff = lds_byte(wr * 64 + fr, fq * 8), boff = lds_byte(wc * 32 + fr, fq * 8);
#define PG8_SA(b, h) (((b) * 2 + (h)) * HTB)
#define PG8_SB(b, h) ((4 + (b) * 2 + (h)) * HTB)
#define PG8_STAGE(bufoff, gbase, voff) do { _Pragma("unroll") for (int _i = 0; _i < 2; ++_i) \
        __builtin_amdgcn_global_load_lds((const unsigned*)((const char*)(gbase) + (voff)[_i]), (PG8_LAS unsigned*)(lds + (bufoff) + ldsw + _i * 8192), 16, 0, 0); } while (0)
#define PG8_LDA(dst, b, h) do { _Pragma("unroll") for (int m = 0; m < 4; ++m) _Pragma("unroll") for (int k = 0; k < 2; ++k) dst[m][k] = *(const PG8_LAS bf16x8*)(lds + PG8_SA(b, h) + aoff + m * 2048 + k * 1024); } while (0)
#define PG8_LDB(dst, b, h) do { _Pragma("unroll") for (int n = 0; n < 2; ++n) _Pragma("unroll") for (int k = 0; k < 2; ++k) dst[n][k] = *(const PG8_LAS bf16x8*)(lds + PG8_SB(b, h) + boff + n * 2048 + k * 1024); } while (0)
#define PG8_MMA(ai, bj, At, Bt) do { __builtin_amdgcn_s_setprio(1); _Pragma("unroll") for (int m = 0; m < 4; ++m) _Pragma("unroll") for (int n = 0; n < 2; ++n) _Pragma("unroll") for (int k = 0; k < 2; ++k) \
        acc[ai][bj][m][n] = __builtin_amdgcn_mfma_f32_16x16x32_bf16(Bt[n][k], At[m][k], acc[ai][bj][m][n], 0, 0, 0); __builtin_amdgcn_s_setprio(0); } while (0)
#define PG8_WAIT_V(n) asm volatile("s_waitcnt vmcnt(" #n ")" ::: "memory")
#define PG8_WAIT_L(n) asm volatile("s_waitcnt lgkmcnt(" #n ")" ::: "memory")
#define PG8_BAR __builtin_amdgcn_s_barrier()
#define PG8_SCHED __builtin_amdgcn_sched_barrier(0)
    Unit cur, nxt; int ui = 0;
    if (!S.next(0, cur)) return;
    f32x4 acc[2][2][4][2];
#pragma unroll
    for (int a = 0; a < 2; ++a)
#pragma unroll
        for (int b = 0; b < 2; ++b)
#pragma unroll
            for (int m = 0; m < 4; ++m)
#pragma unroll
                for (int n = 0; n < 2; ++n) acc[a][b][m][n] = (f32x4){0.f, 0.f, 0.f, 0.f};
    bf16x8 At[4][2], B0[2][2], B1[2][2];
    const char* cA = (const char*)g.A + (size_t)cur.pm * tstep; const char* cB = (const char*)g.Bt + (size_t)cur.pn * tstep;
    S.a_ready(cur);
    PG8_STAGE(PG8_SB(0, 0), cB, voffB); PG8_STAGE(PG8_SA(0, 0), cA, voffA); PG8_STAGE(PG8_SB(0, 1), cB + hstep, voffB); PG8_STAGE(PG8_SA(0, 1), cA + hstep, voffA);
    if (wr == 1) PG8_BAR;
    PG8_WAIT_V(4); PG8_BAR;
    PG8_STAGE(PG8_SB(1, 0), cB + kstep, voffB); PG8_STAGE(PG8_SA(1, 0), cA + kstep, voffA); PG8_STAGE(PG8_SB(1, 1), cB + hstep + kstep, voffB);
    PG8_WAIT_V(6); PG8_BAR;
    PG8_STAMP();
    for (;;) {
        const bool has_next = S.next(ui + 1, nxt);
        const char* nA = has_next ? (const char*)g.A + (size_t)nxt.pm * tstep : cA; const char* nB = has_next ? (const char*)g.Bt + (size_t)nxt.pn * tstep : cB;
        for (int t = 0; t < nt; t += 2) {
            const bool last = (t == nt - 2);
            const char* a1 = cA + (size_t)(t + 1) * kstep;
            const char* a2 = last ? nA : cA + (size_t)(t + 2) * kstep; const char* b2 = last ? nB : cB + (size_t)(t + 2) * kstep;
            const char* a3 = a2 + kstep; const char* b3 = b2 + kstep;
            if (last && has_next) S.a_ready(nxt);
            PG8_LDB(B0, 0, 0); PG8_SCHED; PG8_LDA(At, 0, 0); PG8_STAGE(PG8_SA(1, 1), a1 + hstep, voffA);
            PG8_WAIT_L(8); PG8_BAR; PG8_WAIT_L(0); PG8_MMA(0, 0, At, B0); PG8_BAR; PG8_SCHED;
            PG8_LDB(B1, 0, 1); PG8_STAGE(PG8_SB(0, 0), b2, voffB);
            PG8_BAR; PG8_WAIT_L(0); PG8_MMA(0, 1, At, B1); PG8_BAR;
            PG8_LDA(At, 0, 1); PG8_STAGE(PG8_SA(0, 0), a2, voffA);
            PG8_BAR; PG8_WAIT_L(0); PG8_MMA(1, 0, At, B0); PG8_BAR; PG8_SCHED;
            PG8_STAGE(PG8_SB(0, 1), b2 + hstep, voffB);
            PG8_WAIT_V(6); PG8_BAR; PG8_MMA(1, 1, At, B1); PG8_BAR;
            PG8_LDB(B0, 1, 0); PG8_SCHED; PG8_LDA(At, 1, 0); PG8_STAGE(PG8_SA(0, 1), a2 + hstep, voffA);
            PG8_WAIT_L(8); PG8_BAR; PG8_WAIT_L(0); PG8_MMA(0, 0, At, B0); PG8_BAR; PG8_SCHED;
            PG8_LDB(B1, 1, 1); PG8_STAGE(PG8_SB(1, 0), b3, voffB);
            PG8_BAR; PG8_WAIT_L(0); PG8_MMA(0, 1, At, B1); PG8_BAR;
            PG8_LDA(At, 1, 1); PG8_STAGE(PG8_SA(1, 0), a3, voffA);
            PG8_BAR; PG8_WAIT_L(0); PG8_MMA(1, 0, At, B0); PG8_BAR; PG8_SCHED;
            PG8_STAGE(PG8_SB(1, 1), b3 + hstep, voffB);
            PG8_WAIT_V(6); PG8_BAR; PG8_MMA(1, 1, At, B1); PG8_BAR;
        }
        PG8_STAMP();
        if constexpr (!Epi::AFTER_DRAIN) { E(acc, cur, wr, wc, fr, fq); S.done(cur); }
        PG8_STAMP();
        if (!has_next) break;
#pragma unroll
        for (int a = 0; a < 2; ++a)
#pragma unroll
            for (int b = 0; b < 2; ++b)
#pragma unroll
                for (int m = 0; m < 4; ++m)
#pragma unroll
                    for (int n = 0; n < 2; ++n) acc[a][b][m][n] = (f32x4){0.f, 0.f, 0.f, 0.f};
        cur = nxt; cA = nA; cB = nB; ++ui;
    }
    PG8_WAIT_V(0);
    if (wr == 0) PG8_BAR;
    PG8_BAR;
    if constexpr (Epi::AFTER_DRAIN) { E.fused(acc, cur, wr, wc, fr, fq, lds, wid, lane); S.done(cur); }
    PG8_STAMP();
    if (STAMP && wid == 0) { stamps[lane] = lane < nts ? (((unsigned long long)(unsigned)ts_hi << 32) | (unsigned)ts_lo) : 0ull;
        if (lane == 62) stamps[62] = rt_entry; if (lane == 63) stamps[63] = (unsigned long long)wall_clock64(); }
#undef PG8_STAMP
#undef PG8_SA
#undef PG8_SB
#undef PG8_STAGE
#undef PG8_LDA
#undef PG8_LDB
#undef PG8_MMA
#undef PG8_WAIT_V
#undef PG8_WAIT_L
#undef PG8_BAR
#undef PG8_SCHED
}
}
#define XB_TMO      128
#define XB_XCNT(j)  (256  + 64 * (j))
#define XB_XSUB(j)  (1280 + 64 * (j))
#define XB_XGEN(j)  (2304 + 64 * (j))
#define XB_TOP      3328
#define XB_TOPGEN   3392
#define XCD_BAR_WORDS 3456
#define XB_SPIN_CAP (1u << 18)

__device__ __forceinline__ unsigned xb_ld(unsigned* p)              { return __hip_atomic_load(p, __ATOMIC_RELAXED, __HIP_MEMORY_SCOPE_AGENT); }
__device__ __forceinline__ unsigned xb_add(unsigned* p, unsigned v) { return __hip_atomic_fetch_add(p, v, __ATOMIC_RELAXED, __HIP_MEMORY_SCOPE_AGENT); }
__device__ __forceinline__ unsigned xb_xcc_id() { return (unsigned)__builtin_amdgcn_s_getreg((3 << 11) | 20) & 0xFu; }
#define XB_SPIN(cond, bar) do { unsigned _sp = 0; while (cond) { __builtin_amdgcn_s_sleep(1); \
    if ((++_sp & 255u) == 0u) { if (xb_ld(&(bar)[XB_TMO])) break; if (_sp > XB_SPIN_CAP) { atomicAdd(&(bar)[XB_TMO], 1u); break; } } } } while (0)

struct XcdBarrier {
    unsigned* bar; unsigned x;
    volatile LAS unsigned* st;
};

__device__ __forceinline__ XcdBarrier xcd_barrier_post(unsigned* bar, volatile LAS unsigned* st) {
    XcdBarrier b; b.bar = bar; b.x = xb_xcc_id(); b.st = st;
    if (threadIdx.x == 0) (void)xb_add(&bar[XB_XCNT(b.x)], 1u);
    return b;
}
__device__ __forceinline__ void xcd_barrier_complete(unsigned* bar, unsigned x, unsigned& nloc, unsigned& nx) {
    const unsigned G = gridDim.x * gridDim.y * gridDim.z;
    unsigned sum, cnt, mine, sp = 0u;
    for (;;) {
        sum = 0u; cnt = 0u; mine = 0u;
#pragma unroll
        for (unsigned j = 0; j < 16; ++j) { const unsigned c = xb_ld(&bar[XB_XCNT(j)]); sum += c; cnt += (c > 0u) ? 1u : 0u; mine = (j == x) ? c : mine; }
        if (sum == G) break;
        __builtin_amdgcn_s_sleep(1);
        if ((++sp & 255u) == 0u) { if (xb_ld(&bar[XB_TMO])) break; if (sp > XB_SPIN_CAP) { atomicAdd(&bar[XB_TMO], 1u); break; } }
    }
    nloc = mine > 0u ? mine : 1u; nx = cnt > 0u ? cnt : 1u;
}

__device__ __forceinline__ void xcd_barrier(const XcdBarrier& b) {
    asm volatile("s_waitcnt vmcnt(0)" ::: "memory");
    __syncthreads();
    if (threadIdx.x == 0) {
        unsigned* bar = b.bar;
        __builtin_amdgcn_s_waitcnt(0);
        unsigned nloc = b.st[0], nx = b.st[1];
        if (nloc == 0u) { xcd_barrier_complete(bar, b.x, nloc, nx); b.st[0] = nloc; b.st[1] = nx; }
        const unsigned old = xb_add(&bar[XB_XSUB(b.x)], 1u);
        const unsigned gen = old / nloc;
        if (old + 1u == (gen + 1u) * nloc) {
            __builtin_amdgcn_fence(__ATOMIC_RELEASE, "agent");
            asm volatile("s_waitcnt vmcnt(0)" ::: "memory");
            const unsigned og = xb_add(&bar[XB_TOP], 1u);
            const unsigned tg = og / nx;
            if (og + 1u == (tg + 1u) * nx) xb_add(&bar[XB_TOPGEN], 1u);
            else XB_SPIN(xb_ld(&bar[XB_TOPGEN]) == tg, bar);
            __builtin_amdgcn_fence(__ATOMIC_ACQUIRE, "agent");
            xb_add(&bar[XB_XGEN(b.x)], 1u);
            asm volatile("s_waitcnt vmcnt(0)" ::: "memory");
        } else {
            XB_SPIN(xb_ld(&bar[XB_XGEN(b.x)]) == gen, bar);
            __builtin_amdgcn_fence(__ATOMIC_ACQUIRE, "agent");
            asm volatile("s_waitcnt vmcnt(0)" ::: "memory");
        }
    }
    __syncthreads();
}

typedef unsigned short bf16_t;
typedef short bf16x8 __attribute__((ext_vector_type(8)));
typedef short bf16x4 __attribute__((ext_vector_type(4)));
typedef float f32x4 __attribute__((ext_vector_type(4)));
typedef unsigned u32x4 __attribute__((ext_vector_type(4)));
typedef unsigned u32x2 __attribute__((ext_vector_type(2)));
constexpr int DM = 1024, NBATCH = 8, SEQ = 4096, NTOK = NBATCH * SEQ, DEPTH = 2;
constexpr int INW = 3968, INWP = 4096, FFN = 2816, NMOD = 6;
constexpr int C_AQ = 0, C_AK = 384, C_AV = 768, C_RQ = 1152, C_RK = 1536, C_RV = 1920, C_RG = 2304, C_HQ = 2688, C_HZF = 2944, C_HZB = 3200, C_HI = 3456, C_HG = 3712;
constexpr float NORM_EPS = 1e-6f;
constexpr int NTHREADS = 512;
constexpr int LDS_BYTES = 135168;
constexpr size_t WS_CTL = 0, WS_MOD = 16384, WS_LB = WS_MOD + 393216, WS_HGA = WS_LB + 2048, WS_LSE = WS_HGA + 524288, WS_WIN = WS_LSE + 2359296,
    WS_WOUT = WS_WIN + 16777216, WS_WGU = WS_WOUT + 4194304, WS_WDN = WS_WGU + 23068672, WS_HBUF = WS_WDN + 11534336, WS_PROJ = WS_HBUF + 67108864,
    WS_OB = WS_PROJ + 260046848, WS_RST = WS_OB + 75497472, WS_HGU = WS_RST + 25165824, WS_END = WS_HGU + 33554432;

struct Params {
    const float *x, *c, *w_ada, *b_ada, *g_mix, *w_in, *ret_gn, *hgrn_gn, *lb_logits, *w_out, *g_ffn, *w_gu, *w_down, *g_final;
    float* out; unsigned char* ws; int ph_lo, ph_hi;
};

__device__ __forceinline__ float bf2f(bf16_t v) { return __uint_as_float(((unsigned)v) << 16); }
__device__ __forceinline__ float bflo(unsigned w) { return __uint_as_float(w << 16); }
__device__ __forceinline__ float bfhi(unsigned w) { return __uint_as_float(w & 0xffff0000u); }
__device__ __forceinline__ bf16_t f2bf(float f) { return __builtin_bit_cast(bf16_t, (__bf16)f); }
typedef float f32x2c __attribute__((ext_vector_type(2)));
typedef __bf16 bf16v2c __attribute__((ext_vector_type(2)));
__device__ __forceinline__ unsigned pk2(float lo, float hi) { const f32x2c v = {lo, hi}; return __builtin_bit_cast(unsigned, __builtin_convertvector(v, bf16v2c)); }
__device__ __forceinline__ bf16x4 pk4(f32x4 v) { u32x2 w; w.x = pk2(v[0], v[1]); w.y = pk2(v[2], v[3]); return __builtin_bit_cast(bf16x4, w); }
__device__ __forceinline__ float siluf(float v) { return v * __builtin_amdgcn_rcpf(1.0f + __expf(-v)); }
__device__ __forceinline__ float wave_sum(float v) {
#pragma unroll
    for (int o = 1; o < 64; o <<= 1) v += __shfl_xor(v, o);
    return v;
}
#define MFMA32(a, b, c) __builtin_amdgcn_mfma_f32_16x16x32_bf16((a), (b), (c), 0, 0, 0)
#define MFMA16(a, b, c) __builtin_amdgcn_mfma_f32_16x16x16bf16_1k((a), (b), (c), 0, 0, 0)

struct EpiProj {
    static constexpr bool PERM = true, AFTER_DRAIN = false;
    bf16_t* O; int ldc, ncols;
    __device__ __forceinline__ void operator()(const f32x4 (&acc)[2][2][4][2], const pg8::Unit& u, int wr, int wc, int fr, int fq) const {
        const int row0 = u.pm * 256 + wr * 64 + fr, col0 = u.pn * 256 + wc * 32 + 8 * fq;
#pragma unroll
        for (int ai = 0; ai < 2; ++ai)
#pragma unroll
            for (int m = 0; m < 4; ++m) { bf16_t* rowp = O + (size_t)(row0 + ai * 128 + m * 16) * ldc + col0;
#pragma unroll
                for (int bj = 0; bj < 2; ++bj) { if (col0 + bj * 128 < ncols) { const f32x4 v0 = acc[ai][bj][m][0], v1 = acc[ai][bj][m][1];
                    u32x4 w; w.x = pk2(v0[0], v0[1]); w.y = pk2(v0[2], v0[3]); w.z = pk2(v1[0], v1[1]); w.w = pk2(v1[2], v1[3]);
                    *(u32x4*)(rowp + bj * 128) = w; } } }
    }
};
struct EpiRes {
    static constexpr bool PERM = false, AFTER_DRAIN = false;
    const float* base; float* out; const float* gate;
    __device__ __forceinline__ void operator()(const f32x4 (&acc)[2][2][4][2], const pg8::Unit& u, int wr, int wc, int fr, int fq) const {
        const int row0 = u.pm * 256 + wr * 64 + fr, col0 = u.pn * 256 + wc * 32 + 4 * fq;
        const float* gp = gate + (size_t)((u.pm * 256) >> 12) * (NMOD * DM) + col0;
        f32x4 gv[2][2];
#pragma unroll
        for (int bj = 0; bj < 2; ++bj)
#pragma unroll
            for (int n = 0; n < 2; ++n) gv[bj][n] = *(const f32x4*)(gp + bj * 128 + n * 16);
#pragma unroll
        for (int ai = 0; ai < 2; ++ai)
#pragma unroll
            for (int m = 0; m < 4; ++m) { const size_t off = (size_t)(row0 + ai * 128 + m * 16) * DM + col0;
#pragma unroll
                for (int bj = 0; bj < 2; ++bj)
#pragma unroll
                    for (int n = 0; n < 2; ++n) { const f32x4 bs = *(const f32x4*)(base + off + bj * 128 + n * 16);
                        *(f32x4*)(out + off + bj * 128 + n * 16) = bs + gv[bj][n] * acc[ai][bj][m][n]; } }
    }
};
struct EpiSwiglu {
    static constexpr bool PERM = true, AFTER_DRAIN = false;
    bf16_t* O;
    __device__ __forceinline__ void operator()(const f32x4 (&acc)[2][2][4][2], const pg8::Unit& u, int wr, int wc, int fr, int fq) const {
        const int row0 = u.pm * 256 + wr * 64 + fr, col0 = u.pn * 128 + wc * 32 + 8 * fq;
#pragma unroll
        for (int ai = 0; ai < 2; ++ai)
#pragma unroll
            for (int m = 0; m < 4; ++m) { bf16_t* rowp = O + (size_t)(row0 + ai * 128 + m * 16) * FFN + col0;
                float r[8];
#pragma unroll
                for (int n = 0; n < 2; ++n)
#pragma unroll
                    for (int i = 0; i < 4; ++i) { const float g = acc[ai][0][m][n][i], uu = acc[ai][1][m][n][i]; r[n * 4 + i] = siluf(g) * uu; }
                u32x4 w; w.x = pk2(r[0], r[1]); w.y = pk2(r[2], r[3]); w.z = pk2(r[4], r[5]); w.w = pk2(r[6], r[7]);
                *(u32x4*)rowp = w; }
    }
};
__device__ __forceinline__ void transpose_item(const float* W, int K, int N, bf16_t* WT, int dst_row0, int src_col0, int k0, LAS float* scr, int lane) {
    if (src_col0 < 0) {
        const int c = lane & 7;
#pragma unroll
        for (int j = 0; j < 4; ++j) { const int n = (lane >> 3) + 8 * j; *(u32x4*)(WT + (size_t)(dst_row0 + n) * K + k0 + 8 * c) = (u32x4){0u, 0u, 0u, 0u}; }
        return;
    }
#pragma unroll 8
    for (int i = 0; i < 32; ++i) { const int kk = 2 * i + (lane >> 5); scr[kk * 33 + (lane & 31)] = W[(size_t)(k0 + kk) * N + src_col0 + (lane & 31)]; }
    __builtin_amdgcn_fence(__ATOMIC_RELEASE, "wavefront"); __builtin_amdgcn_wave_barrier(); __builtin_amdgcn_fence(__ATOMIC_ACQUIRE, "wavefront");
    const int c = lane & 7;
#pragma unroll
    for (int j = 0; j < 4; ++j) { const int n = (lane >> 3) + 8 * j; const LAS float* s = scr + (8 * c) * 33 + n;
        u32x4 o; o.x = pk2(s[0 * 33], s[1 * 33]); o.y = pk2(s[2 * 33], s[3 * 33]); o.z = pk2(s[4 * 33], s[5 * 33]); o.w = pk2(s[6 * 33], s[7 * 33]);
        *(u32x4*)(WT + (size_t)(dst_row0 + n) * K + k0 + 8 * c) = o; }
    __builtin_amdgcn_fence(__ATOMIC_RELEASE, "wavefront"); __builtin_amdgcn_wave_barrier(); __builtin_amdgcn_fence(__ATOMIC_ACQUIRE, "wavefront");
}

__device__ __forceinline__ void phase_weights(const Params& P, LAS unsigned char* lds) {
    const int tid = opaque_tid(), lane = tid & 63, wave = __builtin_amdgcn_readfirstlane(tid >> 6);
    unsigned char* ws = P.ws;
    {
        LAS float* scr = (LAS float*)(lds + wave * 8704);
        const int gw = blockIdx.x * 8 + wave, NGW = gridDim.x * 8;
        constexpr int I_IN = 16 * 128, I_OUT = 16 * 32, I_GU = 16 * 176, I_DN = 44 * 32, I_L = I_IN + I_OUT + I_GU + I_DN;
        for (int it = gw; it < DEPTH * I_L; it += NGW) {
            const int l = it / I_L; int r = it % I_L;
            if (r < I_IN) { const int kb = r / 128, nb = r % 128, n0 = nb * 32;
                transpose_item(P.w_in + (size_t)l * DM * INW, DM, INW, (bf16_t*)(ws + WS_WIN) + (size_t)l * INWP * DM, n0, n0 < INW ? n0 : -1, kb * 64, scr, lane); continue; }
            r -= I_IN;
            if (r < I_OUT) { const int kb = r / 32, nb = r % 32;
                transpose_item(P.w_out + (size_t)l * DM * DM, DM, DM, (bf16_t*)(ws + WS_WOUT) + (size_t)l * DM * DM, nb * 32, nb * 32, kb * 64, scr, lane); continue; }
            r -= I_OUT;
            if (r < I_GU) { const int kb = r / 176, nb = r % 176, n0 = nb * 32; const int pn = n0 >> 8, half = (n0 >> 7) & 1, jj = n0 & 127;
                transpose_item(P.w_gu + (size_t)l * DM * 2 * FFN, DM, 2 * FFN, (bf16_t*)(ws + WS_WGU) + (size_t)l * 2 * FFN * DM, n0, half * FFN + pn * 128 + jj, kb * 64, scr, lane); continue; }
            r -= I_GU;
            { const int kb = r / 32, nb = r % 32;
                transpose_item(P.w_down + (size_t)l * FFN * DM, FFN, DM, (bf16_t*)(ws + WS_WDN) + (size_t)l * DM * FFN, nb * 32, nb * 32, kb * 64, scr, lane); }
        }
    }
}
__device__ __forceinline__ void phase_prologue(const Params& P, LAS unsigned char* lds) {
    const int tid = opaque_tid();
    unsigned char* ws = P.ws;
    {
        LAS float* sc = (LAS float*)lds;
        LAS float* red = (LAS float*)(lds + 32768);
        for (int i = tid; i < NBATCH * DM; i += NTHREADS) sc[i] = siluf(P.c[i]);
        __syncthreads();
        float* mod = (float*)(ws + WS_MOD);
        for (int u = blockIdx.x; u < DEPTH * 96; u += gridDim.x) {
            const int l = u / 96, j0 = (u % 96) * 64, col = tid & 63, kp = tid >> 6;
            float acc[8];
#pragma unroll
            for (int b = 0; b < 8; ++b) acc[b] = 0.f;
            const float* wp = P.w_ada + (size_t)l * DM * (NMOD * DM) + j0 + col;
            for (int k = kp * 128; k < kp * 128 + 128; ++k) { const float w = wp[(size_t)k * (NMOD * DM)];
#pragma unroll
                for (int b = 0; b < 8; ++b) acc[b] += sc[b * DM + k] * w; }
#pragma unroll
            for (int b = 0; b < 8; ++b) red[(kp * 8 + b) * 64 + col] = acc[b];
            __syncthreads();
            { const int b = tid >> 6; float s = 0.f;
#pragma unroll
              for (int p = 0; p < 8; ++p) s += red[(p * 8 + b) * 64 + col];
              mod[((size_t)l * NBATCH + b) * (NMOD * DM) + j0 + col] = s + P.b_ada[(size_t)l * NMOD * DM + j0 + col]; }
            __syncthreads();
        }
    }
    if (blockIdx.x == 0 && tid < 256) {
        const float l0 = P.lb_logits[tid], l1 = P.lb_logits[256 + tid], m = fmaxf(l0, l1), e0 = __expf(l0 - m), e1 = __expf(l1 - m);
        const float p0 = e0 / (e0 + e1), p1 = e1 / (e0 + e1);
        float* lb = (float*)(ws + WS_LB);
        lb[tid] = fminf(fmaxf(p0 - p0, 0.f), 1.0f - 1e-6f);
        lb[256 + tid] = fminf(fmaxf((p0 + p1) - p0, 0.f), 1.0f - 1e-6f);
    }
}

template <bool HAS_Y, bool FINAL>
__device__ __forceinline__ void phase_norm(const float* src, const bf16_t* y, const float* gate, float* xout, const float* g, const float* shift, const float* scale, bf16_t* dst) {
    const int tid = opaque_tid(), lane = tid & 63, wave = tid >> 6;
    const int gw = blockIdx.x * 8 + wave, NGW = gridDim.x * 8;
    f32x4 gv[4];
#pragma unroll
    for (int j = 0; j < 4; ++j) gv[j] = *(const f32x4*)(g + 4 * lane + 256 * j);
    for (int row = gw; row < NTOK; row += NGW) {
        const int b = row >> 12;
        const f32x4* xr = (const f32x4*)(src + (size_t)row * DM) + lane;
        f32x4 v[4]; float s = 0.f;
#pragma unroll
        for (int j = 0; j < 4; ++j) v[j] = xr[64 * j];
        if (HAS_Y) {
            const u32x2* yr = (const u32x2*)(y + (size_t)row * DM) + lane;
#pragma unroll
            for (int j = 0; j < 4; ++j) { const u32x2 yw = yr[64 * j]; const f32x4 gt = *(const f32x4*)(gate + (size_t)b * (NMOD * DM) + 4 * lane + 256 * j);
                v[j][0] += gt[0] * bflo(yw.x); v[j][1] += gt[1] * bfhi(yw.x); v[j][2] += gt[2] * bflo(yw.y); v[j][3] += gt[3] * bfhi(yw.y); }
        }
#pragma unroll
        for (int j = 0; j < 4; ++j) s += (v[j][0] * v[j][0] + v[j][1] * v[j][1]) + (v[j][2] * v[j][2] + v[j][3] * v[j][3]);
        const float rstd = rsqrtf(wave_sum(s) * (1.0f / DM) + NORM_EPS);
        f32x4* xo = (f32x4*)(xout + (size_t)row * DM) + lane;
        if (FINAL) {
#pragma unroll
            for (int j = 0; j < 4; ++j) xo[64 * j] = v[j] * rstd * gv[j];
        } else {
            if (HAS_Y) {
#pragma unroll
                for (int j = 0; j < 4; ++j) xo[64 * j] = v[j];
            }
            unsigned long long* o8 = (unsigned long long*)(dst + (size_t)row * DM) + lane;
#pragma unroll
            for (int j = 0; j < 4; ++j) {
                const f32x4 sc = *(const f32x4*)(scale + (size_t)b * (NMOD * DM) + 4 * lane + 256 * j), sh = *(const f32x4*)(shift + (size_t)b * (NMOD * DM) + 4 * lane + 256 * j);
                const f32x4 h = v[j] * rstd * gv[j] * (sc + 1.0f) + sh;
                o8[64 * j] = (unsigned long long)pk2(h[0], h[1]) | ((unsigned long long)pk2(h[2], h[3]) << 32);
            }
        }
    }
}
__device__ __forceinline__ bf16x4 tr4(const LAS bf16_t* img, int pitch, int row0, int col0, int g, int q) {
    return __builtin_amdgcn_ds_read_tr16_b64_v4i16((LAS bf16x4*)(img + (row0 + 4 * g + (q >> 2)) * pitch + col0 + 4 * (q & 3)));
}
__device__ __forceinline__ bf16x8 tr8(const LAS bf16_t* img, int pitch, int row0, int col0, int g, int q) {
    const bf16x4 lo = __builtin_amdgcn_ds_read_tr16_b64_v4i16((LAS bf16x4*)(img + (row0 + 8 * g + (q >> 2)) * pitch + col0 + 4 * (q & 3)));
    const bf16x4 hi = __builtin_amdgcn_ds_read_tr16_b64_v4i16((LAS bf16x4*)(img + (row0 + 8 * g + 4 + (q >> 2)) * pitch + col0 + 4 * (q & 3)));
    return __builtin_shufflevector(lo, hi, 0, 1, 2, 3, 4, 5, 6, 7);
}
struct AttRegs { u32x4 kv[2][4], vv[2][4]; bf16x8 qf[2][2]; };
constexpr int ATT_UNITS = 2304;
__device__ __forceinline__ void att_decode(int u, int& br, int& b, int& h, int& r, int& L, int& p0, int& tok0) {
    br = u / 768; const int v = u % 768; b = v / 96; h = (v >> 4) % 6; const int w = v & 15;
    const int lr = br * 2, nblk = 16 >> lr, rho = w >> (4 - lr), blk = w & (nblk - 1); r = 1 << lr; L = SEQ >> lr; p0 = blk * 256; tok0 = b * SEQ + rho;
}
__device__ __forceinline__ void att_load(const Params& P, int u, int tid, AttRegs& R) {
    int br, b, h, r, L, p0, tok0; att_decode(u, br, b, h, r, L, p0, tok0);
    const bf16_t* proj = (const bf16_t*)(P.ws + WS_PROJ);
#pragma unroll
    for (int it = 0; it < 2; ++it) {
        const int item = tid + it * NTHREADS, key = item >> 1, half = item & 1, kj = p0 - 64 + key;
        if (item < 768 && kj >= 0 && kj < L) {
            const bf16_t* src = proj + (size_t)(tok0 + r * kj) * INW + h * 64 + half * 32;
#pragma unroll
            for (int i = 0; i < 4; ++i) { R.kv[it][i] = *(const u32x4*)(src + C_AK + 8 * i); R.vv[it][i] = *(const u32x4*)(src + C_AV + 8 * i); }
        } else {
#pragma unroll
            for (int i = 0; i < 4; ++i) { R.kv[it][i] = (u32x4){0u, 0u, 0u, 0u}; R.vv[it][i] = (u32x4){0u, 0u, 0u, 0u}; }
        }
    }
    const int lane = tid & 63, wave = tid >> 6, q = lane & 15, g = lane >> 4;
#pragma unroll
    for (int qt = 0; qt < 2; ++qt) {
        const size_t tokq = (size_t)(tok0 + r * (p0 + 32 * wave + 16 * qt + q));
#pragma unroll
        for (int kk = 0; kk < 2; ++kk) R.qf[qt][kk] = *(const bf16x8*)(proj + tokq * INW + C_AQ + h * 64 + kk * 32 + 8 * g);
    }
}
__device__ __forceinline__ void att_phase(const Params& P, LAS unsigned char* lds) {
    const int tid = opaque_tid(), lane = tid & 63, wave = __builtin_amdgcn_readfirstlane(tid >> 6), q = lane & 15, g = lane >> 4;
    LAS bf16_t* Ks = (LAS bf16_t*)lds;
    LAS bf16_t* Vs = (LAS bf16_t*)(lds + 55296);
    int u = blockIdx.x; if (u >= ATT_UNITS) return;
    AttRegs R; att_load(P, u, tid, R);
    for (; u < ATT_UNITS; u += gridDim.x) {
        int br, b, h, r, L, p0, tok0; att_decode(u, br, b, h, r, L, p0, tok0);
#pragma unroll
        for (int it = 0; it < 2; ++it) {
            const int item = tid + it * NTHREADS, key = item >> 1, half = item & 1;
            if (item < 768) {
#pragma unroll
                for (int i = 0; i < 4; ++i) { *(LAS u32x4*)(Ks + key * 72 + half * 32 + 8 * i) = R.kv[it][i]; *(LAS u32x4*)(Vs + key * 72 + half * 32 + 8 * i) = R.vv[it][i]; }
            }
        }
        bf16x8 qf[2][2]; qf[0][0] = R.qf[0][0]; qf[0][1] = R.qf[0][1]; qf[1][0] = R.qf[1][0]; qf[1][1] = R.qf[1][1];
        __syncthreads();
        if (u + (int)gridDim.x < ATT_UNITS) att_load(P, u + gridDim.x, tid, R);
        const float slope_l2 = exp2f(-8.0f * (float)(h + 1) / 6.0f) * (float)r * 1.44269504f, qk_l2 = 0.125f * 1.44269504f;
        const float fbase = (float)(64 + q - 4 * g);
        const bool edge = (p0 < 64) || (p0 + 320 > L);
#pragma unroll
        for (int qt = 0; qt < 2; ++qt) {
            const int kw = 32 * wave + 16 * qt;
            const int p = p0 + kw + q; const size_t tokq = (size_t)(tok0 + r * p);
            f32x4 st[9]; float mx = -3.0e38f;
#pragma unroll
            for (int t = 0; t < 9; ++t) {
                f32x4 acc = {0.f, 0.f, 0.f, 0.f};
#pragma unroll
                for (int kk = 0; kk < 2; ++kk) { const bf16x8 a = *(const LAS bf16x8*)(Ks + (kw + 16 * t + q) * 72 + kk * 32 + 8 * g); acc = MFMA32(a, qf[qt][kk], acc); }
#pragma unroll
                for (int j = 0; j < 4; ++j) {
                    const float d = fabsf(fbase - (float)(16 * t + j));
                    float s = acc[j] * qk_l2 - slope_l2 * d;
                    if (t == 0 || t == 8) s = (d <= 64.0f) ? s : -1.0e30f;
                    acc[j] = s;
                }
                if (edge) {
#pragma unroll
                    for (int j = 0; j < 4; ++j) { const int kj = p0 - 64 + kw + 16 * t + 4 * g + j; acc[j] = (kj >= 0 && kj < L) ? acc[j] : -1.0e30f; }
                }
#pragma unroll
                for (int j = 0; j < 4; ++j) mx = fmaxf(mx, acc[j]);
                st[t] = acc;
            }
            mx = fmaxf(mx, __shfl_xor(mx, 16)); mx = fmaxf(mx, __shfl_xor(mx, 32));
            float ls = 0.f; bf16x4 pt[9];
#pragma unroll
            for (int t = 0; t < 9; ++t) { f32x4 e;
#pragma unroll
                for (int j = 0; j < 4; ++j) { e[j] = __builtin_amdgcn_exp2f(st[t][j] - mx); ls += e[j]; }
                pt[t] = pk4(e); }
            ls += __shfl_xor(ls, 16); ls += __shfl_xor(ls, 32);
            const float inv = __builtin_amdgcn_rcpf(ls);
            bf16_t* ob = (bf16_t*)(P.ws + WS_OB) + ((size_t)br * NTOK + tokq) * 384 + h * 64;
            const LAS bf16_t* vrd = Vs + (kw + 4 * g + (q >> 2)) * 72 + 4 * (q & 3);
#pragma unroll
            for (int dt = 0; dt < 4; ++dt) {
                f32x4 acc = {0.f, 0.f, 0.f, 0.f};
#pragma unroll
                for (int t = 0; t < 9; ++t) { const bf16x4 a = __builtin_amdgcn_ds_read_tr16_b64_v4i16((LAS bf16x4*)(vrd + 16 * t * 72 + dt * 16)); acc = MFMA16(a, pt[t], acc); }
                acc = acc * inv;
                *(bf16x4*)(ob + dt * 16 + 4 * g) = pk4(acc);
            }
            if (g == 0) ((float*)(P.ws + WS_LSE))[((size_t)br * NTOK + tokq) * 6 + h] = (mx + __log2f(ls)) * 0.69314718f;
        }
        __syncthreads();
    }
}
__device__ __forceinline__ void att_merge(const Params& P) {
    const bf16_t* ob = (const bf16_t*)(P.ws + WS_OB); const float* lse = (const float*)(P.ws + WS_LSE); bf16_t* mixed = (bf16_t*)(P.ws + WS_HBUF);
    for (size_t it = (size_t)blockIdx.x * NTHREADS + opaque_tid(); it < (size_t)NTOK * 48; it += (size_t)gridDim.x * NTHREADS) {
        const size_t tok = it / 48; const int grp = (int)(it % 48), h = grp >> 3;
        const float l0 = lse[tok * 6 + h], l1 = lse[((size_t)NTOK + tok) * 6 + h], l2 = lse[((size_t)2 * NTOK + tok) * 6 + h];
        const float m = fmaxf(l0, fmaxf(l1, l2)), e0 = __expf(l0 - m), e1 = __expf(l1 - m), e2 = __expf(l2 - m), is = __builtin_amdgcn_rcpf(e0 + e1 + e2);
        const float w0 = e0 * is, w1 = e1 * is, w2 = e2 * is;
        const u32x4 a = *(const u32x4*)(ob + tok * 384 + grp * 8), bq = *(const u32x4*)(ob + ((size_t)NTOK + tok) * 384 + grp * 8), cq = *(const u32x4*)(ob + ((size_t)2 * NTOK + tok) * 384 + grp * 8);
        u32x4 o;
#pragma unroll
        for (int i = 0; i < 4; ++i) o[i] = pk2(w0 * bflo(a[i]) + w1 * bflo(bq[i]) + w2 * bflo(cq[i]), w0 * bfhi(a[i]) + w1 * bfhi(bq[i]) + w2 * bfhi(cq[i]));
        *(u32x4*)(mixed + tok * DM + grp * 8) = o;
    }
}

__device__ __forceinline__ float ret_logg(int h) { return log1pf(-exp2f(-5.0f - (float)h)); }
struct RetARegs { u32x4 k0, k1, v0, v1; };
__device__ __forceinline__ void retA_load(const Params& P, int u, int tid, RetARegs& R) {
    const int bh = u >> 5, n = u & 31, b = bh / 6, h = bh % 6, c = tid >> 2, qd = tid & 3;
    const bf16_t* src = (const bf16_t*)(P.ws + WS_PROJ) + (size_t)(b * SEQ + n * 128 + c) * INW + h * 64 + qd * 16;
    R.k0 = *(const u32x4*)(src + C_RK); R.k1 = *(const u32x4*)(src + C_RK + 8); R.v0 = *(const u32x4*)(src + C_RV); R.v1 = *(const u32x4*)(src + C_RV + 8);
}
__device__ __forceinline__ void retA_phase(const Params& P, LAS unsigned char* lds) {
    const int tid = opaque_tid(), lane = tid & 63, wave = __builtin_amdgcn_readfirstlane(tid >> 6), q = lane & 15, g = lane >> 4;
    LAS bf16_t* Kf = (LAS bf16_t*)lds; LAS bf16_t* Kb = (LAS bf16_t*)(lds + 18432); LAS bf16_t* Vs = (LAS bf16_t*)(lds + 36864);
    int u = blockIdx.x; if (u >= 1536) return;
    RetARegs R; retA_load(P, u, tid, R);
    for (; u < 1536; u += gridDim.x) {
        const int bh = u >> 5, n = u & 31, h = bh % 6;
        const float lg = ret_logg(h);
        {
            const int c = tid >> 2, qd = tid & 3;
            const float wf = 0.125f * __expf(lg * (float)(127 - c)), wb = 0.125f * __expf(lg * (float)c);
            u32x4 f0, f1, b0, b1;
#pragma unroll
            for (int e = 0; e < 4; ++e) { f0[e] = pk2(bflo(R.k0[e]) * wf, bfhi(R.k0[e]) * wf); f1[e] = pk2(bflo(R.k1[e]) * wf, bfhi(R.k1[e]) * wf);
                b0[e] = pk2(bflo(R.k0[e]) * wb, bfhi(R.k0[e]) * wb); b1[e] = pk2(bflo(R.k1[e]) * wb, bfhi(R.k1[e]) * wb); }
            *(LAS u32x4*)(Kf + c * 72 + qd * 16) = f0; *(LAS u32x4*)(Kf + c * 72 + qd * 16 + 8) = f1;
            *(LAS u32x4*)(Kb + c * 72 + qd * 16) = b0; *(LAS u32x4*)(Kb + c * 72 + qd * 16 + 8) = b1;
            *(LAS u32x4*)(Vs + c * 72 + qd * 16) = R.v0; *(LAS u32x4*)(Vs + c * 72 + qd * 16 + 8) = R.v1;
        }
        __syncthreads();
        if (u + (int)gridDim.x < 1536) retA_load(P, u + gridDim.x, tid, R);
        const int dir = wave >> 2, dt = wave & 3; const LAS bf16_t* Kt = dir ? Kb : Kf;
        bf16x8 afr[4];
#pragma unroll
        for (int kk = 0; kk < 4; ++kk) afr[kk] = tr8(Kt, 72, kk * 32, dt * 16, g, q);
        bf16_t* dst = (bf16_t*)(P.ws + WS_RST) + ((size_t)(bh * 32 + n) * 2 + dir) * 4096;
#pragma unroll
        for (int et = 0; et < 4; ++et) {
            f32x4 acc = {0.f, 0.f, 0.f, 0.f};
#pragma unroll
            for (int kk = 0; kk < 4; ++kk) { const bf16x8 bfr = tr8(Vs, 72, kk * 32, et * 16, g, q); acc = MFMA32(afr[kk], bfr, acc); }
            *(bf16x4*)(dst + (et * 16 + q) * 64 + dt * 16 + 4 * g) = pk4(acc);
        }
        __syncthreads();
    }
}
__device__ __forceinline__ void ret_scan(const Params& P) {
    bf16_t* st = (bf16_t*)(P.ws + WS_RST);
    for (int it = blockIdx.x * NTHREADS + opaque_tid(); it < 48 * 2 * 512; it += gridDim.x * NTHREADS) {
        const int ch = it & 511, dir = (it >> 9) & 1, bh = it >> 10, h = bh % 6;
        const float cd = __expf(ret_logg(h) * 128.0f);
        float s[8];
#pragma unroll
        for (int e = 0; e < 8; ++e) s[e] = 0.f;
        for (int i0 = 0; i0 < 32; i0 += 8) {
            u32x4 v[8];
#pragma unroll
            for (int i = 0; i < 8; ++i) { const int n = dir ? 31 - (i0 + i) : (i0 + i); v[i] = *(const u32x4*)(st + ((size_t)(bh * 32 + n) * 2 + dir) * 4096 + 8 * ch); }
#pragma unroll
            for (int i = 0; i < 8; ++i) { const int n = dir ? 31 - (i0 + i) : (i0 + i);
                u32x4 o;
#pragma unroll
                for (int e = 0; e < 4; ++e) o[e] = pk2(s[2 * e], s[2 * e + 1]);
                *(u32x4*)(st + ((size_t)(bh * 32 + n) * 2 + dir) * 4096 + 8 * ch) = o;
#pragma unroll
                for (int e = 0; e < 4; ++e) { s[2 * e] = cd * s[2 * e] + bflo(v[i][e]); s[2 * e + 1] = cd * s[2 * e + 1] + bfhi(v[i][e]); } }
        }
    }
}
struct RetBRegs { u32x4 k0, k1, v0, v1, rf, rb, q0, q1; };
__device__ __forceinline__ void retB_load(const Params& P, int u, int tid, RetBRegs& R) {
    const int bh = u >> 5, n = u & 31, b = bh / 6, h = bh % 6, c = tid >> 2, qd = tid & 3;
    const bf16_t* proj = (const bf16_t*)(P.ws + WS_PROJ);
    const bf16_t* src = proj + (size_t)(b * SEQ + n * 128 + c) * INW + h * 64 + qd * 16;
    R.k0 = *(const u32x4*)(src + C_RK); R.k1 = *(const u32x4*)(src + C_RK + 8); R.v0 = *(const u32x4*)(src + C_RV); R.v1 = *(const u32x4*)(src + C_RV + 8);
    const bf16_t* rs = (const bf16_t*)(P.ws + WS_RST) + (size_t)(bh * 32 + n) * 2 * 4096;
    const int e = tid >> 3, d8 = (tid & 7) * 8;
    R.rf = *(const u32x4*)(rs + e * 64 + d8); R.rb = *(const u32x4*)(rs + 4096 + e * 64 + d8);
    const int lane = tid & 63, wave = tid >> 6, q = lane & 15, g = lane >> 4;
    const bf16_t* qp = proj + (size_t)(b * SEQ + n * 128 + 16 * wave + q) * INW + C_RQ + h * 64 + 8 * g;
    R.q0 = *(const u32x4*)qp; R.q1 = *(const u32x4*)(qp + 32);
}
__device__ __forceinline__ void retB_phase(const Params& P, LAS unsigned char* lds, int layer) {
    const int tid = opaque_tid(), lane = tid & 63, wave = __builtin_amdgcn_readfirstlane(tid >> 6), q = lane & 15, g = lane >> 4;
    const bf16_t* proj = (const bf16_t*)(P.ws + WS_PROJ);
    LAS bf16_t* Ks = (LAS bf16_t*)lds;
    LAS bf16_t* Vs = (LAS bf16_t*)(lds + 18432);
    LAS bf16_t* Rf = (LAS bf16_t*)(lds + 36864);
    LAS bf16_t* Rb = (LAS bf16_t*)(lds + 46080);
    int u = blockIdx.x; if (u >= 1536) return;
    RetBRegs R; retB_load(P, u, tid, R);
    for (; u < 1536; u += gridDim.x) {
        const int bh = u >> 5, n = u & 31, b = bh / 6, h = bh % 6;
        const float lg = ret_logg(h);
        {
            const int c = tid >> 2, qd = tid & 3, e = tid >> 3, d8 = (tid & 7) * 8;
            *(LAS u32x4*)(Ks + c * 72 + qd * 16) = R.k0; *(LAS u32x4*)(Ks + c * 72 + qd * 16 + 8) = R.k1;
            *(LAS u32x4*)(Vs + c * 72 + qd * 16) = R.v0; *(LAS u32x4*)(Vs + c * 72 + qd * 16 + 8) = R.v1;
            *(LAS u32x4*)(Rf + e * 72 + d8) = R.rf; *(LAS u32x4*)(Rb + e * 72 + d8) = R.rb;
        }
        const u32x4 qraw[2] = {R.q0, R.q1};
        __syncthreads();
        if (u + (int)gridDim.x < 1536) retB_load(P, u + gridDim.x, tid, R);
        const int i = 16 * wave + q; const size_t tok = (size_t)(b * SEQ + n * 128 + i);
        bf16x8 qf[2], qff[2], qfb[2];
        {
            const float ff = __expf(lg * (float)(i + 1)), fb = __expf(lg * (float)(128 - i));
#pragma unroll
            for (int kk = 0; kk < 2; ++kk) { const u32x4 raw = qraw[kk];
                qf[kk] = __builtin_bit_cast(bf16x8, raw); u32x4 a, c2;
#pragma unroll
                for (int e = 0; e < 4; ++e) { const float lo = bflo(raw[e]), hi = bfhi(raw[e]); a[e] = pk2(lo * ff, hi * ff); c2[e] = pk2(lo * fb, hi * fb); }
                qff[kk] = __builtin_bit_cast(bf16x8, a); qfb[kk] = __builtin_bit_cast(bf16x8, c2); }
        }
        bf16x4 pt[8];
#pragma unroll
        for (int jt = 0; jt < 8; ++jt) {
            f32x4 acc = {0.f, 0.f, 0.f, 0.f};
#pragma unroll
            for (int kk = 0; kk < 2; ++kk) { const bf16x8 a = *(const LAS bf16x8*)(Ks + (16 * jt + q) * 72 + kk * 32 + 8 * g); acc = MFMA32(a, qf[kk], acc); }
#pragma unroll
            for (int jj = 0; jj < 4; ++jj) { int dd = i - (16 * jt + 4 * g + jj); dd = dd < 0 ? -dd : dd; acc[jj] = acc[jj] * 0.125f * __expf(lg * (float)dd); }
            pt[jt] = pk4(acc);
        }
        f32x4 o[4];
#pragma unroll
        for (int et = 0; et < 4; ++et) {
            f32x4 acc = {0.f, 0.f, 0.f, 0.f};
#pragma unroll
            for (int jt = 0; jt < 8; ++jt) { const bf16x4 a = tr4(Vs, 72, 16 * jt, et * 16, g, q); acc = MFMA16(a, pt[jt], acc); }
#pragma unroll
            for (int kk = 0; kk < 2; ++kk) { const bf16x8 a = *(const LAS bf16x8*)(Rf + (et * 16 + q) * 72 + kk * 32 + 8 * g); acc = MFMA32(a, qff[kk], acc);
                const bf16x8 a2 = *(const LAS bf16x8*)(Rb + (et * 16 + q) * 72 + kk * 32 + 8 * g); acc = MFMA32(a2, qfb[kk], acc); }
            o[et] = acc;
        }
        float s = 0.f;
#pragma unroll
        for (int et = 0; et < 4; ++et) s += (o[et][0] + o[et][1]) + (o[et][2] + o[et][3]);
        s += __shfl_xor(s, 16); s += __shfl_xor(s, 32);
        const float mu = s * (1.0f / 64.0f); float vs = 0.f;
#pragma unroll
        for (int et = 0; et < 4; ++et) { o[et] = o[et] - mu; vs += (o[et][0] * o[et][0] + o[et][1] * o[et][1]) + (o[et][2] * o[et][2] + o[et][3] * o[et][3]); }
        vs += __shfl_xor(vs, 16); vs += __shfl_xor(vs, 32);
        const float rstd = rsqrtf(vs * (1.0f / 64.0f) + NORM_EPS);
        bf16_t* mixed = (bf16_t*)(P.ws + WS_HBUF) + tok * DM + 384 + h * 64;
#pragma unroll
        for (int et = 0; et < 4; ++et) {
            const f32x4 gn = *(const f32x4*)(P.ret_gn + layer * 384 + h * 64 + et * 16 + 4 * g);
            const u32x2 rg = *(const u32x2*)(proj + tok * INW + C_RG + h * 64 + et * 16 + 4 * g);
            f32x4 y; y[0] = o[et][0] * rstd * gn[0] * siluf(bflo(rg.x)); y[1] = o[et][1] * rstd * gn[1] * siluf(bfhi(rg.x));
            y[2] = o[et][2] * rstd * gn[2] * siluf(bflo(rg.y)); y[3] = o[et][3] * rstd * gn[3] * siluf(bfhi(rg.y));
            *(bf16x4*)(mixed + et * 16 + 4 * g) = pk4(y);
        }
        __syncthreads();
    }
}
__device__ __forceinline__ void hgrn_gate(float z, float lbv, float& f, float& kk) {
    z = fminf(fmaxf(z, -30.f), 30.f);
    const float ez = __expf(-z), sg = __builtin_amdgcn_rcpf(1.0f + ez);
    f = lbv + (1.0f - lbv) * sg; kk = (1.0f - lbv) * ez * sg;
}
__device__ __forceinline__ void hgA_unit(const Params& P, LAS unsigned char* lds, int u, int layer) {
    const int tid = opaque_tid(), lane = tid & 63, wave = __builtin_amdgcn_readfirstlane(tid >> 6), q = lane & 15, g = lane >> 4;
    const int bh = u >> 5, n = u & 31, b = bh >> 2, h = bh & 3;
    const bf16_t* proj = (const bf16_t*)(P.ws + WS_PROJ);
    LAS bf16_t* Kt = (LAS bf16_t*)lds;
    LAS bf16_t* Vt = (LAS bf16_t*)(lds + 34816);
    LAS float* segs = (LAS float*)(lds + 52224);
    const size_t tokc = (size_t)(b * SEQ + n * 128);
    {
        const int c = tid >> 2, qd = tid & 3; const bf16_t* src = proj + (tokc + c) * INW + C_HI + h * 64 + qd * 16;
        const u32x4 v0 = *(const u32x4*)src, v1 = *(const u32x4*)(src + 8);
#pragma unroll
        for (int e = 0; e < 8; ++e) { const unsigned vw = e < 4 ? v0[e & 3] : v1[e & 3]; const int d = qd * 16 + 2 * e;
            Vt[d * 136 + c] = (bf16_t)(vw & 0xffffu); Vt[(d + 1) * 136 + c] = (bf16_t)(vw >> 16); }
    }
    const int d = tid & 63, dir = (tid >> 6) & 1, seg = tid >> 7;
    const float lbv = ((const float*)(P.ws + WS_LB))[layer * 256 + h * 64 + d];
    float lf[32], kk[32];
    {
        const bf16_t* zp = proj + (tokc + seg * 32) * INW + (dir ? C_HZB : C_HZF) + h * 64 + d;
        bf16_t zr[32];
#pragma unroll
        for (int i = 0; i < 32; ++i) zr[i] = zp[(size_t)i * INW];
#pragma unroll
        for (int i = 0; i < 32; ++i) hgrn_gate(bf2f(zr[i]), lbv, lf[i], kk[i]);
    }
    float ssum = 1.f;
#pragma unroll
    for (int i = 0; i < 32; ++i) ssum *= lf[i];
    segs[(dir * 4 + seg) * 64 + d] = ssum;
    __syncthreads();
    {
        float before = 1.f, after = 1.f;
#pragma unroll
        for (int s2 = 0; s2 < 4; ++s2) { const float v = segs[(dir * 4 + s2) * 64 + d]; if (s2 < seg) before *= v; if (s2 > seg) after *= v; }
        LAS bf16_t* kt = Kt + dir * (64 * 136) + d * 136 + seg * 32;
        if (dir == 0) {
            float run = after;
#pragma unroll
            for (int i = 31; i >= 0; --i) { kt[i] = f2bf(kk[i] * run); run *= lf[i]; }
        } else {
            float run = before;
#pragma unroll
            for (int i = 0; i < 32; ++i) { kt[i] = f2bf(kk[i] * run); run *= lf[i]; }
        }
        if (seg == 0) ((float*)(P.ws + WS_HGA))[((size_t)(bh * 2 + dir) * 32 + n) * 64 + d] = ssum * after;
    }
    __syncthreads();
    {
        const int wdir = wave >> 2, dt = wave & 3; const LAS bf16_t* kts = Kt + wdir * (64 * 136);
        bf16x8 afr[4];
#pragma unroll
        for (int kq = 0; kq < 4; ++kq) afr[kq] = *(const LAS bf16x8*)(kts + (dt * 16 + q) * 136 + kq * 32 + 8 * g);
        float* dst = (float*)(P.ws + WS_HGU) + ((size_t)(bh * 2 + wdir) * 32 + n) * 4096;
#pragma unroll
        for (int et = 0; et < 4; ++et) {
            f32x4 acc = {0.f, 0.f, 0.f, 0.f};
#pragma unroll
            for (int kq = 0; kq < 4; ++kq) { const bf16x8 bfr = *(const LAS bf16x8*)(Vt + (et * 16 + q) * 136 + kq * 32 + 8 * g); acc = MFMA32(afr[kq], bfr, acc); }
#pragma unroll
            for (int j = 0; j < 4; ++j) dst[(dt * 16 + 4 * g + j) * 64 + et * 16 + q] = acc[j];
        }
    }
    __syncthreads();
}
__device__ __forceinline__ void hg_scan(const Params& P) {
    float* U = (float*)(P.ws + WS_HGU); const float* A = (const float*)(P.ws + WS_HGA);
    const int nthr = gridDim.x * NTHREADS; int it0 = blockIdx.x * NTHREADS + opaque_tid() - 48 * 2 * 512; if (it0 < 0) it0 += nthr;
    for (int it = it0; it < 64 * 64 * 16; it += nthr) {
        const int e4 = it & 15, d = (it >> 4) & 63, bd = it >> 10, dir = bd & 1;
        f32x4 s = {0.f, 0.f, 0.f, 0.f};
        for (int i0 = 0; i0 < 32; i0 += 8) {
            f32x4 v[8]; float a[8];
#pragma unroll
            for (int i = 0; i < 8; ++i) { const int n = dir ? 31 - (i0 + i) : (i0 + i); v[i] = *(const f32x4*)(U + ((size_t)(bd * 32 + n) * 64 + d) * 64 + 4 * e4); a[i] = A[(size_t)(bd * 32 + n) * 64 + d]; }
#pragma unroll
            for (int i = 0; i < 8; ++i) { const int n = dir ? 31 - (i0 + i) : (i0 + i); *(f32x4*)(U + ((size_t)(bd * 32 + n) * 64 + d) * 64 + 4 * e4) = s; s = s * a[i] + v[i]; }
        }
    }
}
__device__ __forceinline__ unsigned pk2h(float lo, float hi) { return pk2(lo, hi); }
__device__ __forceinline__ bf16x4 pk4h(f32x4 v) { return pk4(v); }
__device__ __forceinline__ void hgB_unit(const Params& P, LAS unsigned char* lds, int u, int layer) {
    const int tid = opaque_tid(), lane = tid & 63, wave = __builtin_amdgcn_readfirstlane(tid >> 6), q = lane & 15, g = lane >> 4;
    const int b = u >> 5, n = u & 31, h = wave >> 1, dir = wave & 1, bh = b * 4 + h;
    bf16_t* proj = (bf16_t*)(P.ws + WS_PROJ);
    bf16_t* mixed = (bf16_t*)(P.ws + WS_HBUF);
    LAS unsigned char* wl = lds + wave * 7168;
    LAS bf16_t* Qi = (LAS bf16_t*)wl;
    LAS bf16_t* Ki = (LAS bf16_t*)(wl + 2304);
    LAS bf16_t* Vs = (LAS bf16_t*)(wl + 4608);
    LAS float* Al = (LAS float*)(wl + 6912);
    const size_t tokc = (size_t)(b * SEQ + n * 128);
    const float lbv = ((const float*)(P.ws + WS_LB))[layer * 256 + h * 64 + lane];
    f32x4 S[4][4];
    {
        const float* sp = (const float*)(P.ws + WS_HGU) + ((size_t)(bh * 2 + dir) * 32 + n) * 4096;
#pragma unroll
        for (int dt = 0; dt < 4; ++dt)
#pragma unroll
            for (int et = 0; et < 4; ++et)
#pragma unroll
                for (int j = 0; j < 4; ++j) S[dt][et][j] = sp[(dt * 16 + 4 * g + j) * 64 + et * 16 + q];
    }
    bf16_t* odst = dir ? (proj + C_AQ + h * 64) : (mixed + 768 + h * 64); const size_t opitch = dir ? INW : DM;
    bf16_t qr[16], zz[16]; u32x4 v0, v1;
#define HGB_LOAD(SC) do { const size_t toks_ = tokc + (SC) * 16; const bf16_t* base_ = proj + toks_ * INW + h * 64 + lane; \
        _Pragma("unroll") for (int ii = 0; ii < 16; ++ii) { const int t_ = dir ? 15 - ii : ii; qr[ii] = base_[(size_t)t_ * INW + C_HQ]; zz[ii] = base_[(size_t)t_ * INW + (dir ? C_HZB : C_HZF)]; } \
        const bf16_t* vsrc_ = proj + (toks_ + (lane >> 2)) * INW + C_HI + h * 64 + (lane & 3) * 16; v0 = *(const u32x4*)vsrc_; v1 = *(const u32x4*)(vsrc_ + 8); } while (0)
    HGB_LOAD(dir ? 7 : 0);
    for (int i = 0; i < 8; ++i) {
        const int sc = dir ? 7 - i : i; const size_t toks = tokc + sc * 16;
        {
            *(LAS u32x4*)(Vs + (lane >> 2) * 72 + (lane & 3) * 16) = v0; *(LAS u32x4*)(Vs + (lane >> 2) * 72 + (lane & 3) * 16 + 8) = v1;
            float bp = 1.f;
#pragma unroll
            for (int ii = 0; ii < 16; ++ii) {
                const int t = dir ? 15 - ii : ii;
                float f, kk; hgrn_gate(bf2f(zz[ii]), lbv, f, kk); const float qv = siluf(bf2f(qr[ii]));
                bp *= f;
                Qi[t * 72 + lane] = f2bf(qv * bp); Ki[t * 72 + lane] = f2bf(kk * __builtin_amdgcn_rcpf(fmaxf(bp, 1.0e-30f)));
            }
            Al[lane] = bp;
        }
        if (i + 1 < 8) HGB_LOAD(dir ? 6 - i : i + 1);
        __builtin_amdgcn_fence(__ATOMIC_RELEASE, "wavefront"); __builtin_amdgcn_wave_barrier(); __builtin_amdgcn_fence(__ATOMIC_ACQUIRE, "wavefront");
        f32x4 at = {0.f, 0.f, 0.f, 0.f};
#pragma unroll
        for (int kq = 0; kq < 2; ++kq) { const bf16x8 a8 = *(const LAS bf16x8*)(Ki + q * 72 + kq * 32 + 8 * g), b8 = *(const LAS bf16x8*)(Qi + q * 72 + kq * 32 + 8 * g); at = MFMA32(a8, b8, at); }
#pragma unroll
        for (int j = 0; j < 4; ++j) { const int sl = 4 * g + j; const bool keep = dir ? (sl >= q) : (sl <= q); at[j] = keep ? at[j] : 0.f; }
        const bf16x4 p4 = pk4h(at);
        bf16x4 b4[4], v4[4];
#pragma unroll
        for (int dt = 0; dt < 4; ++dt) b4[dt] = *(const LAS bf16x4*)(Qi + q * 72 + dt * 16 + 4 * g);
#pragma unroll
        for (int et = 0; et < 4; ++et) v4[et] = tr4(Vs, 72, 0, et * 16, g, q);
#pragma unroll
        for (int et = 0; et < 4; ++et) {
            f32x4 o = {0.f, 0.f, 0.f, 0.f};
#pragma unroll
            for (int dt = 0; dt < 4; ++dt) o = MFMA16(pk4h(S[dt][et]), b4[dt], o);
            o = MFMA16(v4[et], p4, o);
            *(bf16x4*)(odst + (toks + q) * opitch + et * 16 + 4 * g) = pk4(o);
        }
#pragma unroll
        for (int dt = 0; dt < 4; ++dt) {
            const bf16x4 kT4 = tr4(Ki, 72, 0, dt * 16, g, q);
            const f32x4 al4 = *(const LAS f32x4*)(Al + dt * 16 + 4 * g);
#pragma unroll
            for (int et = 0; et < 4; ++et) { const f32x4 s2 = MFMA16(kT4, v4[et], S[dt][et]); S[dt][et] = s2 * al4; }
        }
        __builtin_amdgcn_fence(__ATOMIC_RELEASE, "wavefront"); __builtin_amdgcn_wave_barrier(); __builtin_amdgcn_fence(__ATOMIC_ACQUIRE, "wavefront");
    }
    asm volatile("s_waitcnt vmcnt(0)" ::: "memory");
    __syncthreads();
    {
        const int tau = tid >> 2, qd = tid & 3;
        bf16_t* mp = mixed + (tokc + tau) * DM + 768 + qd * 64; const bf16_t* bp2 = proj + (tokc + tau) * INW + C_AQ + qd * 64;
        const bf16_t* gp = proj + (tokc + tau) * INW + C_HG + qd * 64; const float* gn = P.hgrn_gn + layer * 256 + qd * 64;
        float o[64]; float sq = 0.f;
#pragma unroll
        for (int c4 = 0; c4 < 16; ++c4) {
            const unsigned long long fv = __hip_atomic_load((const unsigned long long*)(mp + c4 * 4), __ATOMIC_RELAXED, __HIP_MEMORY_SCOPE_AGENT), bv = __hip_atomic_load((const unsigned long long*)(bp2 + c4 * 4), __ATOMIC_RELAXED, __HIP_MEMORY_SCOPE_AGENT);
            const unsigned f0 = (unsigned)fv, f1 = (unsigned)(fv >> 32), b0 = (unsigned)bv, b1 = (unsigned)(bv >> 32);
            const float x0 = bflo(f0) + bflo(b0), x1 = bfhi(f0) + bfhi(b0), x2 = bflo(f1) + bflo(b1), x3 = bfhi(f1) + bfhi(b1);
            o[c4 * 4 + 0] = x0; o[c4 * 4 + 1] = x1; o[c4 * 4 + 2] = x2; o[c4 * 4 + 3] = x3; sq += (x0 * x0 + x1 * x1) + (x2 * x2 + x3 * x3); }
        sq += __shfl_xor(sq, 1); sq += __shfl_xor(sq, 2);
        const float rstd = rsqrtf(sq * (1.0f / 256.0f) + NORM_EPS);
#pragma unroll
        for (int c8 = 0; c8 < 8; ++c8) {
            const u32x4 gv = *(const u32x4*)(gp + c8 * 8); const f32x4 g0 = *(const f32x4*)(gn + c8 * 8), g1 = *(const f32x4*)(gn + c8 * 8 + 4);
            u32x4 r;
            r.x = pk2h(o[c8 * 8 + 0] * rstd * g0[0] * siluf(bflo(gv.x)), o[c8 * 8 + 1] * rstd * g0[1] * siluf(bfhi(gv.x)));
            r.y = pk2h(o[c8 * 8 + 2] * rstd * g0[2] * siluf(bflo(gv.y)), o[c8 * 8 + 3] * rstd * g0[3] * siluf(bfhi(gv.y)));
            r.z = pk2h(o[c8 * 8 + 4] * rstd * g1[0] * siluf(bflo(gv.z)), o[c8 * 8 + 5] * rstd * g1[1] * siluf(bfhi(gv.z)));
            r.w = pk2h(o[c8 * 8 + 6] * rstd * g1[2] * siluf(bflo(gv.w)), o[c8 * 8 + 7] * rstd * g1[3] * siluf(bfhi(gv.w)));
            *(u32x4*)(mp + c8 * 8) = r;
        }
    }
    __syncthreads();
}
constexpr int N_PHASES = 20;
#ifndef PROBE_MASK
#define PROBE_MASK 0u
#endif
#ifndef PROBE_U
#define PROBE_U 0
#endif
#ifndef STAGGER
#define STAGGER 0
#endif
#ifndef STAGGER_TICKS
#define STAGGER_TICKS 1000u
#endif
#ifndef PROBE_SYNC2
#define PROBE_SYNC2 0
#endif
__device__ __forceinline__ void stagger_half(unsigned ticks) {
#if STAGGER
    if ((blockIdx.x >> 3) & 1) { const unsigned long long t0 = __builtin_amdgcn_s_memrealtime(); while (__builtin_amdgcn_s_memrealtime() - t0 < ticks) __builtin_amdgcn_s_sleep(32); }
    __syncthreads();
#endif
}
__device__ __forceinline__ void run_phase(const Params& P, LAS unsigned char* lds, int ph) {
    unsigned char* ws = P.ws;
    if (ph == 0) { phase_prologue(P, lds); return; }
    if (ph == N_PHASES - 1) { phase_norm<true, true>(P.out, (const bf16_t*)(ws + WS_OB), (const float*)(ws + WS_MOD) + (size_t)(DEPTH - 1) * NBATCH * NMOD * DM + 5 * DM, P.out, P.g_final, nullptr, nullptr, nullptr); return; }
    const int l = (ph - 1) / 9, s = (ph - 1) % 9;
    const float* mod = (const float*)(ws + WS_MOD) + (size_t)l * NBATCH * NMOD * DM;
    bf16_t* hbuf = (bf16_t*)(ws + WS_HBUF); bf16_t* proj = (bf16_t*)(ws + WS_PROJ); bf16_t* ybuf = (bf16_t*)(ws + WS_OB);
#ifdef PH_ONLY
    if (s != PH_ONLY) return;
#endif
    int kD = DM, kF = FFN; asm volatile("" : "+s"(kD), "+s"(kF));
    switch (s) {
    case 0: if (l == 0) { phase_norm<false, false>(P.x, nullptr, nullptr, nullptr, P.g_mix, mod + 0 * DM, mod + 1 * DM, hbuf); phase_weights(P, lds); }
            else phase_norm<true, false>(P.out, ybuf, mod - (size_t)NBATCH * NMOD * DM + 5 * DM, P.out, P.g_mix + l * DM, mod + 0 * DM, mod + 1 * DM, hbuf);
            break;
    case 1: { pg8::Gemm g{hbuf, (const bf16_t*)(ws + WS_WIN) + (size_t)l * INWP * DM, NTOK, INWP, kD}; pg8::StaticOrder S; S.init(NTOK, INWP, gridDim.x, blockIdx.x);
              EpiProj E{proj, INW, INW}; pg8::gemm_phase<EpiProj, pg8::StaticOrder>(lds, g, S, E, nullptr); } break;
    case 2: { for (int rp = 0; rp < (PROBE_U == 1 ? 2 : 1); ++rp) att_phase(P, lds);
              for (int rp = 0; rp < (PROBE_U == 2 ? 2 : 1); ++rp) retA_phase(P, lds);
              for (int rp = 0; rp < (PROBE_U == 3 ? 2 : 1); ++rp) for (int u = blockIdx.x; u < 1024; u += gridDim.x) hgA_unit(P, lds, u, l); } break;
    case 3: { ret_scan(P); hg_scan(P); } break;
    case 4: { for (int rp = 0; rp < (PROBE_U == 4 ? 2 : 1); ++rp) for (int u = blockIdx.x; u < 256; u += gridDim.x) hgB_unit(P, lds, u, l);
              for (int rp = 0; rp < (PROBE_U == 5 ? 2 : 1); ++rp) retB_phase(P, lds, l); att_merge(P); } break;
    case 5: { pg8::Gemm g{hbuf, (const bf16_t*)(ws + WS_WOUT) + (size_t)l * DM * DM, NTOK, DM, kD}; pg8::StaticOrder S; S.init(NTOK, DM, gridDim.x, blockIdx.x);
              EpiProj E{ybuf, DM, DM}; pg8::gemm_phase<EpiProj, pg8::StaticOrder>(lds, g, S, E, nullptr); } break;
    case 6: phase_norm<true, false>(l == 0 ? P.x : P.out, ybuf, mod + 2 * DM, P.out, P.g_ffn + l * DM, mod + 3 * DM, mod + 4 * DM, hbuf); break;
    case 7: { pg8::Gemm g{hbuf, (const bf16_t*)(ws + WS_WGU) + (size_t)l * 2 * FFN * DM, NTOK, 2 * FFN, kD}; pg8::StaticOrder S; S.init(NTOK, 2 * FFN, gridDim.x, blockIdx.x);
              EpiSwiglu E{proj}; pg8::gemm_phase<EpiSwiglu, pg8::StaticOrder>(lds, g, S, E, nullptr); } break;
    case 8: { pg8::Gemm g{proj, (const bf16_t*)(ws + WS_WDN) + (size_t)l * DM * FFN, NTOK, DM, kF}; pg8::StaticOrder S; S.init(NTOK, DM, gridDim.x, blockIdx.x);
              EpiProj E{ybuf, DM, DM}; pg8::gemm_phase<EpiProj, pg8::StaticOrder>(lds, g, S, E, nullptr); } break;
    }
}
__global__ void __launch_bounds__(NTHREADS) hybrid_fwd(Params P) {
    extern __shared__ __attribute__((aligned(16))) unsigned char lds_raw[];
    __shared__ uint4 xb_words;
    LAS unsigned char* lds = (LAS unsigned char*)lds_raw;
    if (threadIdx.x == 0) xb_words = make_uint4(0u, 0u, 0u, 0u);
    __syncthreads();
    XcdBarrier bar = xcd_barrier_post((unsigned*)(P.ws + WS_CTL), (volatile LAS unsigned*)&xb_words);
    for (int ph = P.ph_lo; ph < P.ph_hi; ++ph) {
        const int reps = ((PROBE_MASK >> ph) & 1u) ? 2 : 1;
        for (int rep = 0; rep < reps; ++rep) { run_phase(P, lds, ph); if (rep + 1 < reps) __syncthreads(); }
        if (ph + 1 < P.ph_hi) {
            if (P.ph_hi > N_PHASES) cg::this_grid().sync(); else xcd_barrier(bar);
            if (PROBE_SYNC2) xcd_barrier(bar);
        }
    }
}

extern "C" void kernel_launch(void* const* d_in, const int* in_sizes, int n_in, void* d_out, int out_size, void* d_ws, size_t ws_size, hipStream_t stream) {
    static int grid = 0;
    if (grid == 0) {
        if (n_in != 14 || out_size != NTOK * DM || ws_size < WS_END) { fprintf(stderr, "kernel_launch: unexpected shapes (n_in %d out %d ws %zu need %zu)\n", n_in, out_size, ws_size, (size_t)WS_END); grid = -1; return; }
        int dev = 0, cus = 0, per_cu = 0;
        hipGetDevice(&dev); hipDeviceGetAttribute(&cus, hipDeviceAttributeMultiprocessorCount, dev);
        if (hipFuncSetAttribute((const void*)hybrid_fwd, hipFuncAttributeMaxDynamicSharedMemorySize, LDS_BYTES) != hipSuccess) { fprintf(stderr, "kernel_launch: hipFuncSetAttribute failed\n"); grid = -1; return; }
        if (hipOccupancyMaxActiveBlocksPerMultiprocessor(&per_cu, (const void*)hybrid_fwd, NTHREADS, LDS_BYTES) != hipSuccess || per_cu < 1) { fprintf(stderr, "kernel_launch: occupancy query says %d\n", per_cu); grid = -1; return; }
        grid = cus;
    }
    if (grid < 0) return;
    if (hipMemsetAsync((char*)d_ws + WS_CTL, 0, 16384, stream) != hipSuccess) { fprintf(stderr, "kernel_launch: memset failed\n"); return; }
    Params p{};
    p.x = (const float*)d_in[0]; p.c = (const float*)d_in[1]; p.w_ada = (const float*)d_in[2]; p.b_ada = (const float*)d_in[3]; p.g_mix = (const float*)d_in[4];
    p.w_in = (const float*)d_in[5]; p.ret_gn = (const float*)d_in[6]; p.hgrn_gn = (const float*)d_in[7]; p.lb_logits = (const float*)d_in[8]; p.w_out = (const float*)d_in[9];
    p.g_ffn = (const float*)d_in[10]; p.w_gu = (const float*)d_in[11]; p.w_down = (const float*)d_in[12]; p.g_final = (const float*)d_in[13];
    p.out = (float*)d_out; p.ws = (unsigned char*)d_ws;
#if ONE_LAUNCH
    p.ph_lo = 0; p.ph_hi = N_PHASES;
    void* args[] = {&p};
    hipError_t e = hipLaunchCooperativeKernel((const void*)hybrid_fwd, dim3(grid), dim3(NTHREADS), args, LDS_BYTES, stream);
    if (e != hipSuccess) fprintf(stderr, "cooperative launch failed: %s (grid %d)\n", hipGetErrorString(e), grid);
#else
    for (int ph = 0; ph < N_PHASES; ++ph) { p.ph_lo = ph; p.ph_hi = ph + 1; hipLaunchKernelGGL(hybrid_fwd, dim3(grid), dim3(NTHREADS), LDS_BYTES, stream, p); }
#endif
}
```

```cpp
#include <hip/hip_runtime.h>
#include <hip/hip_cooperative_groups.h>
#include <cstdio>
#include <cstdint>
namespace cg = cooperative_groups;
#ifndef ONE_LAUNCH
#define ONE_LAUNCH 1
#endif
__device__ __forceinline__ int opaque_tid() { int t = threadIdx.x; asm volatile("" : "+v"(t)); return t; }
#define LAS __attribute__((address_space(3)))
namespace pg8 {
#define PG8_LAS __attribute__((address_space(3)))
typedef unsigned short bf16_t;
typedef short bf16x8 __attribute__((ext_vector_type(8)));
typedef float f32x4 __attribute__((ext_vector_type(4)));
typedef unsigned u32x4 __attribute__((ext_vector_type(4)));
constexpr int BM = 256, BK = 64, HALF = 128, HTB = HALF * BK * 2  , STAGE_BYTES = 8 * HTB, NXCD = 8, WGM = 8;

__host__ __device__ __forceinline__ int lds_byte(int r, int c) { const int st = (r >> 4) * 2 + (c >> 5), rr = r & 15, cc = c & 31, ob = rr * 64 + cc * 2; return st * 1024 + (ob ^ (((ob >> 9) & 1) << 5)); }
__host__ __device__ __forceinline__ void stage_rc(int b, int& R, int& C) { const int st = b / 1024, sb = b % 1024, swz = sb ^ (((sb >> 9) & 1) << 5); R = (st >> 1) * 16 + swz / 64; C = (st & 1) * 32 + (swz % 64) / 2; }
__host__ __device__ __forceinline__ int perm32(int rho) { const int n = rho >> 4, i = rho & 15; return 8 * (i >> 2) + 4 * n + (i & 3); }

struct Unit { int pm, pn; };
struct Gemm { const bf16_t* A; const bf16_t* Bt; int M, N, K; };

struct StaticOrder {
    int nM, nN, nwg, G, c;
    __host__ __device__ void init(int M, int N, int G_, int c_) { nM = M / BM; nN = N / BM; nwg = nM * nN; G = G_; c = c_; }
    __host__ __device__ bool next(int i, Unit& u) const {
        const long L = (long)i * G + c; if (L >= nwg) return false;
        int wgid = (int)L; { const int q = nwg / NXCD, r = nwg % NXCD, xcd = wgid % NXCD, off = wgid / NXCD; wgid = (xcd < r ? xcd * (q + 1) : r * (q + 1) + (xcd - r) * q) + off; }
        const int nig = WGM * nN, gid = wgid / nig, fm = gid * WGM, gsz = (nM - fm) < WGM ? (nM - fm) : WGM;
        u.pm = fm + ((wgid % nig) % gsz); u.pn = (wgid % nig) / gsz; return true;
    }
    __device__ __forceinline__ void a_ready(const Unit&) const {}
    __device__ __forceinline__ void done(const Unit&) const {}
};
__device__ __forceinline__ unsigned cvt_pk_bf16(float lo, float hi) { unsigned r; asm volatile("v_cvt_pk_bf16_f32 %0, %1, %2" : "=v"(r) : "v"(lo), "v"(hi)); return r; }
typedef float f32x2 __attribute__((ext_vector_type(2)));
template <class Epi, class Sched, bool STAMP = false>
__device__ __forceinline__ void gemm_phase(PG8_LAS unsigned char* lds, const Gemm g, const Sched& S, const Epi& E, unsigned long long* stamps) {
    const int tid = opaque_tid(), wid = __builtin_amdgcn_readfirstlane(tid >> 6), lane = tid & 63, wr = wid >> 2, wc = wid & 3, fr = lane & 15, fq = lane >> 4;
    const int K = g.K, nt = K / BK;
    int ts_lo = 0, ts_hi = 0, nts = 0; const unsigned long long rt_entry = STAMP ? (unsigned long long)wall_clock64() : 0ull;
#define PG8_STAMP() do { if (STAMP && wid == 0 && nts < 64) { const unsigned long long _c = (unsigned long long)clock64(); \
        ts_lo = (lane == nts) ? (int)(unsigned)_c : ts_lo; ts_hi = (lane == nts) ? (int)(unsigned)(_c >> 32) : ts_hi; ++nts; } } while (0)
    PG8_STAMP();
    unsigned voffA[2], voffB[2];
#pragma unroll
    for (int i = 0; i < 2; ++i) { int R, C; stage_rc(tid * 16 + i * 8192, R, C); const int Rb = Epi::PERM ? ((R & ~31) + perm32(R & 31)) : R;
        voffA[i] = (unsigned)(R * K + C) * 2u; voffB[i] = (unsigned)(Rb * K + C) * 2u; }
    const size_t kstep = (size_t)(BK * 2);
    const size_t hstep = (size_t)HALF * K * 2;
    const size_t tstep = 2 * hstep;
    const unsigned ldsw = (unsigned)wid * 1024u;
    const int aoff = lds_byte(wr * 64 + fr, fq * 8), boff = lds_byte(wc * 32 + fr, fq * 8);
#define PG8_SA(b, h) (((b) * 2 + (h)) * HTB)
#define PG8_SB(b, h) ((4 + (b) * 2 + (h)) * HTB)
#define PG8_STAGE(bufoff, gbase, voff) do { _Pragma("unroll") for (int _i = 0; _i < 2; ++_i) \
        __builtin_amdgcn_global_load_lds((const unsigned*)((const char*)(gbase) + (voff)[_i]), (PG8_LAS unsigned*)(lds + (bufoff) + ldsw + _i * 8192), 16, 0, 0); } while (0)
#define PG8_LDA(dst, b, h) do { _Pragma("unroll") for (int m = 0; m < 4; ++m) _Pragma("unroll") for (int k = 0; k < 2; ++k) dst[m][k] = *(const PG8_LAS bf16x8*)(lds + PG8_SA(b, h) + aoff + m * 2048 + k * 1024); } while (0)
#define PG8_LDB(dst, b, h) do { _Pragma("unroll") for (int n = 0; n < 2; ++n) _Pragma("unroll") for (int k = 0; k < 2; ++k) dst[n][k] = *(const PG8_LAS bf16x8*)(lds + PG8_SB(b, h) + boff + n * 2048 + k * 1024); } while (0)
#define PG8_MMA(ai, bj, At, Bt) do { __builtin_amdgcn_s_setprio(1); _Pragma("unroll") for (int m = 0; m < 4; ++m) _Pragma("unroll") for (int n = 0; n < 2; ++n) _Pragma("unroll") for (int k = 0; k < 2; ++k) \
        acc[ai][bj][m][n] = __builtin_amdgcn_mfma_f32_16x16x32_bf16(Bt[n][k], At[m][k], acc[ai][bj][m][n], 0, 0, 0); __builtin_amdgcn_s_setprio(0); } while (0)
#define PG8_WAIT_V(n) asm volatile("s_waitcnt vmcnt(" #n ")" ::: "memory")
#define PG8_WAIT_L(n) asm volatile("s_waitcnt lgkmcnt(" #n ")" ::: "memory")
#define PG8_BAR __builtin_amdgcn_s_barrier()
#define PG8_SCHED __builtin_amdgcn_sched_barrier(0)
    Unit cur, nxt; int ui = 0;
    if (!S.next(0, cur)) return;
    f32x4 acc[2][2][4][2];
#pragma unroll
    for (int a = 0; a < 2; ++a)
#pragma unroll
        for (int b = 0; b < 2; ++b)
#pragma unroll
            for (int m = 0; m < 4; ++m)
#pragma unroll
                for (int n = 0; n < 2; ++n) acc[a][b][m][n] = (f32x4){0.f, 0.f, 0.f, 0.f};
    bf16x8 At[4][2], B0[2][2], B1[2][2];
    const char* cA = (const char*)g.A + (size_t)cur.pm * tstep; const char* cB = (const char*)g.Bt + (size_t)cur.pn * tstep;
    S.a_ready(cur);
    PG8_STAGE(PG8_SB(0, 0), cB, voffB); PG8_STAGE(PG8_SA(0, 0), cA, voffA); PG8_STAGE(PG8_SB(0, 1), cB + hstep, voffB); PG8_STAGE(PG8_SA(0, 1), cA + hstep, voffA);
    if (wr == 1) PG8_BAR;
    PG8_WAIT_V(4); PG8_BAR;
    PG8_STAGE(PG8_SB(1, 0), cB + kstep, voffB); PG8_STAGE(PG8_SA(1, 0), cA + kstep, voffA); PG8_STAGE(PG8_SB(1, 1), cB + hstep + kstep, voffB);
    PG8_WAIT_V(6); PG8_BAR;
    PG8_STAMP();
    for (;;) {
        const bool has_next = S.next(ui + 1, nxt);
        const char* nA = has_next ? (const char*)g.A + (size_t)nxt.pm * tstep : cA; const char* nB = has_next ? (const char*)g.Bt + (size_t)nxt.pn * tstep : cB;
        for (int t = 0; t < nt; t += 2) {
            const bool last = (t == nt - 2);
            const char* a1 = cA + (size_t)(t + 1) * kstep;
            const char* a2 = last ? nA : cA + (size_t)(t + 2) * kstep; const char* b2 = last ? nB : cB + (size_t)(t + 2) * kstep;
            const char* a3 = a2 + kstep; const char* b3 = b2 + kstep;
            if (last && has_next) S.a_ready(nxt);
            PG8_LDB(B0, 0, 0); PG8_SCHED; PG8_LDA(At, 0, 0); PG8_STAGE(PG8_SA(1, 1), a1 + hstep, voffA);
            PG8_WAIT_L(8); PG8_BAR; PG8_WAIT_L(0); PG8_MMA(0, 0, At, B0); PG8_BAR; PG8_SCHED;
            PG8_LDB(B1, 0, 1); PG8_STAGE(PG8_SB(0, 0), b2, voffB);
            PG8_BAR; PG8_WAIT_L(0); PG8_MMA(0, 1, At, B1); PG8_BAR;
            PG8_LDA(At, 0, 1); PG8_STAGE(PG8_SA(0, 0), a2, voffA);
            PG8_BAR; PG8_WAIT_L(0); PG8_MMA(1, 0, At, B0); PG8_BAR; PG8_SCHED;
            PG8_STAGE(PG8_SB(0, 1), b2 + hstep, voffB);
            PG8_WAIT_V(6); PG8_BAR; PG8_MMA(1, 1, At, B1); PG8_BAR;
            PG8_LDB(B0, 1, 0); PG8_SCHED; PG8_LDA(At, 1, 0); PG8_STAGE(PG8_SA(0, 1), a2 + hstep, voffA);
            PG8_WAIT_L(8); PG8_BAR; PG8_WAIT_L(0); PG8_MMA(0, 0, At, B0); PG8_BAR; PG8_SCHED;
            PG8_LDB(B1, 1, 1); PG8_STAGE(PG8_SB(1, 0), b3, voffB);
            PG8_BAR; PG8_WAIT_L(0); PG8_MMA(0, 1, At, B1); PG8_BAR;
            PG8_LDA(At, 1, 1); PG8_STAGE(PG8_SA(1, 0), a3, voffA);
            PG8_BAR; PG8_WAIT_L(0); PG8_MMA(1, 0, At, B0); PG8_BAR; PG8_SCHED;
            PG8_STAGE(PG8_SB(1, 1), b3 + hstep, voffB);
            PG8_WAIT_V(6); PG8_BAR; PG8_MMA(1, 1, At, B1); PG8_BAR;
        }
        PG8_STAMP();
        if constexpr (!Epi::AFTER_DRAIN) { E(acc, cur, wr, wc, fr, fq); S.done(cur); }
        PG8_STAMP();
        if (!has_next) break;
#pragma unroll
        for (int a = 0; a < 2; ++a)
#pragma unroll
            for (int b = 0; b < 2; ++b)
#pragma unroll
                for (int m = 0; m < 4; ++m)
#pragma unroll
                    for (int n = 0; n < 2; ++n) acc[a][b][m][n] = (f32x4){0.f, 0.f, 0.f, 0.f};
        cur = nxt; cA = nA; cB = nB; ++ui;
    }
    PG8_WAIT_V(0);
    if (wr == 0) PG8_BAR;
    PG8_BAR;
    if constexpr (Epi::AFTER_DRAIN) { E.fused(acc, cur, wr, wc, fr, fq, lds, wid, lane); S.done(cur); }
    PG8_STAMP();
    if (STAMP && wid == 0) { stamps[lane] = lane < nts ? (((unsigned long long)(unsigned)ts_hi << 32) | (unsigned)ts_lo) : 0ull;
        if (lane == 62) stamps[62] = rt_entry; if (lane == 63) stamps[63] = (unsigned long long)wall_clock64(); }
#undef PG8_STAMP
#undef PG8_SA
#undef PG8_SB
#undef PG8_STAGE
#undef PG8_LDA
#undef PG8_LDB
#undef PG8_MMA
#undef PG8_WAIT_V
#undef PG8_WAIT_L
#undef PG8_BAR
#undef PG8_SCHED
}
}
#define XB_TMO      128
#define XB_XCNT(j)  (256  + 64 * (j))
#define XB_XSUB(j)  (1280 + 64 * (j))
#define XB_XGEN(j)  (2304 + 64 * (j))
#define XB_TOP      3328
#define XB_TOPGEN   3392
#define XCD_BAR_WORDS 3456
#define XB_SPIN_CAP (1u << 18)

__device__ __forceinline__ unsigned xb_ld(unsigned* p)              { return __hip_atomic_load(p, __ATOMIC_RELAXED, __HIP_MEMORY_SCOPE_AGENT); }
__device__ __forceinline__ unsigned xb_add(unsigned* p, unsigned v) { return __hip_atomic_fetch_add(p, v, __ATOMIC_RELAXED, __HIP_MEMORY_SCOPE_AGENT); }
__device__ __forceinline__ unsigned xb_xcc_id() { return (unsigned)__builtin_amdgcn_s_getreg((3 << 11) | 20) & 0xFu; }
#define XB_SPIN(cond, bar) do { unsigned _sp = 0; while (cond) { __builtin_amdgcn_s_sleep(1); \
    if ((++_sp & 255u) == 0u) { if (xb_ld(&(bar)[XB_TMO])) break; if (_sp > XB_SPIN_CAP) { atomicAdd(&(bar)[XB_TMO], 1u); break; } } } } while (0)

struct XcdBarrier {
    unsigned* bar; unsigned x;
    volatile LAS unsigned* st;
};

__device__ __forceinline__ XcdBarrier xcd_barrier_post(unsigned* bar, volatile LAS unsigned* st) {
    XcdBarrier b; b.bar = bar; b.x = xb_xcc_id(); b.st = st;
    if (threadIdx.x == 0) (void)xb_add(&bar[XB_XCNT(b.x)], 1u);
    return b;
}
__device__ __forceinline__ void xcd_barrier_complete(unsigned* bar, unsigned x, unsigned& nloc, unsigned& nx) {
    const unsigned G = gridDim.x * gridDim.y * gridDim.z;
    unsigned sum, cnt, mine, sp = 0u;
    for (;;) {
        sum = 0u; cnt = 0u; mine = 0u;
#pragma unroll
        for (unsigned j = 0; j < 16; ++j) { const unsigned c = xb_ld(&bar[XB_XCNT(j)]); sum += c; cnt += (c > 0u) ? 1u : 0u; mine = (j == x) ? c : mine; }
        if (sum == G) break;
        __builtin_amdgcn_s_sleep(1);
        if ((++sp & 255u) == 0u) { if (xb_ld(&bar[XB_TMO])) break; if (sp > XB_SPIN_CAP) { atomicAdd(&bar[XB_TMO], 1u); break; } }
    }
    nloc = mine > 0u ? mine : 1u; nx = cnt > 0u ? cnt : 1u;
}

__device__ __forceinline__ void xcd_barrier(const XcdBarrier& b) {
    asm volatile("s_waitcnt vmcnt(0)" ::: "memory");
    __syncthreads();
    if (threadIdx.x == 0) {
        unsigned* bar = b.bar;
        __builtin_amdgcn_s_waitcnt(0);
        unsigned nloc = b.st[0], nx = b.st[1];
        if (nloc == 0u) { xcd_barrier_complete(bar, b.x, nloc, nx); b.st[0] = nloc; b.st[1] = nx; }
        const unsigned old = xb_add(&bar[XB_XSUB(b.x)], 1u);
        const unsigned gen = old / nloc;
        if (old + 1u == (gen + 1u) * nloc) {
            __builtin_amdgcn_fence(__ATOMIC_RELEASE, "agent");
            asm volatile("s_waitcnt vmcnt(0)" ::: "memory");
            const unsigned og = xb_add(&bar[XB_TOP], 1u);
            const unsigned tg = og / nx;
            if (og + 1u == (tg + 1u) * nx) xb_add(&bar[XB_TOPGEN], 1u);
            else XB_SPIN(xb_ld(&bar[XB_TOPGEN]) == tg, bar);
            __builtin_amdgcn_fence(__ATOMIC_ACQUIRE, "agent");
            xb_add(&bar[XB_XGEN(b.x)], 1u);
            asm volatile("s_waitcnt vmcnt(0)" ::: "memory");
        } else {
            XB_SPIN(xb_ld(&bar[XB_XGEN(b.x)]) == gen, bar);
            __builtin_amdgcn_fence(__ATOMIC_ACQUIRE, "agent");
            asm volatile("s_waitcnt vmcnt(0)" ::: "memory");
        }
    }
    __syncthreads();
}

typedef unsigned short bf16_t;
typedef short bf16x8 __attribute__((ext_vector_type(8)));
typedef short bf16x4 __attribute__((ext_vector_type(4)));
typedef float f32x4 __attribute__((ext_vector_type(4)));
typedef unsigned u32x4 __attribute__((ext_vector_type(4)));
typedef unsigned u32x2 __attribute__((ext_vector_type(2)));
constexpr int DM = 1024, NBATCH = 8, SEQ = 4096, NTOK = NBATCH * SEQ, DEPTH = 2;
constexpr int INW = 3968, INWP = 4096, FFN = 2816, NMOD = 6;
constexpr int C_AQ = 0, C_AK = 384, C_AV = 768, C_RQ = 1152, C_RK = 1536, C_RV = 1920, C_RG = 2304, C_HQ = 2688, C_HZF = 2944, C_HZB = 3200, C_HI = 3456, C_HG = 3712;
constexpr float NORM_EPS = 1e-6f;
constexpr int NTHREADS = 512;
constexpr int LDS_BYTES = 135168;
constexpr size_t WS_CTL = 0, WS_MOD = 16384, WS_LB = WS_MOD + 393216, WS_HGA = WS_LB + 2048, WS_LSE = WS_HGA + 524288, WS_WIN = WS_LSE + 2359296,
    WS_WOUT = WS_WIN + 16777216, WS_WGU = WS_WOUT + 4194304, WS_WDN = WS_WGU + 23068672, WS_HBUF = WS_WDN + 11534336, WS_PROJ = WS_HBUF + 67108864,
    WS_OB = WS_PROJ + 260046848, WS_RST = WS_OB + 75497472, WS_HGU = WS_RST + 25165824, WS_END = WS_HGU + 33554432;

struct Params {
    const float *x, *c, *w_ada, *b_ada, *g_mix, *w_in, *ret_gn, *hgrn_gn, *lb_logits, *w_out, *g_ffn, *w_gu, *w_down, *g_final;
    float* out; unsigned char* ws; int ph_lo, ph_hi;
};

__device__ __forceinline__ float bf2f(bf16_t v) { return __uint_as_float(((unsigned)v) << 16); }
__device__ __forceinline__ float bflo(unsigned w) { return __uint_as_float(w << 16); }
__device__ __forceinline__ float bfhi(unsigned w) { return __uint_as_float(w & 0xffff0000u); }
__device__ __forceinline__ bf16_t f2bf(float f) { return __builtin_bit_cast(bf16_t, (__bf16)f); }
typedef float f32x2c __attribute__((ext_vector_type(2)));
typedef __bf16 bf16v2c __attribute__((ext_vector_type(2)));
__device__ __forceinline__ unsigned pk2(float lo, float hi) { const f32x2c v = {lo, hi}; return __builtin_bit_cast(unsigned, __builtin_convertvector(v, bf16v2c)); }
__device__ __forceinline__ bf16x4 pk4(f32x4 v) { u32x2 w; w.x = pk2(v[0], v[1]); w.y = pk2(v[2], v[3]); return __builtin_bit_cast(bf16x4, w); }
__device__ __forceinline__ float siluf(float v) { return v * __builtin_amdgcn_rcpf(1.0f + __expf(-v)); }
__device__ __forceinline__ float wave_sum(float v) {
#pragma unroll
    for (int o = 1; o < 64; o <<= 1) v += __shfl_xor(v, o);
    return v;
}
#define MFMA32(a, b, c) __builtin_amdgcn_mfma_f32_16x16x32_bf16((a), (b), (c), 0, 0, 0)
#define MFMA16(a, b, c) __builtin_amdgcn_mfma_f32_16x16x16bf16_1k((a), (b), (c), 0, 0, 0)

struct EpiProj {
    static constexpr bool PERM = true, AFTER_DRAIN = false;
    bf16_t* O; int ldc, ncols;
    __device__ __forceinline__ void operator()(const f32x4 (&acc)[2][2][4][2], const pg8::Unit& u, int wr, int wc, int fr, int fq) const {
        const int row0 = u.pm * 256 + wr * 64 + fr, col0 = u.pn * 256 + wc * 32 + 8 * fq;
#pragma unroll
        for (int ai = 0; ai < 2; ++ai)
#pragma unroll
            for (int m = 0; m < 4; ++m) { bf16_t* rowp = O + (size_t)(row0 + ai * 128 + m * 16) * ldc + col0;
#pragma unroll
                for (int bj = 0; bj < 2; ++bj) { if (col0 + bj * 128 < ncols) { const f32x4 v0 = acc[ai][bj][m][0], v1 = acc[ai][bj][m][1];
                    u32x4 w; w.x = pk2(v0[0], v0[1]); w.y = pk2(v0[2], v0[3]); w.z = pk2(v1[0], v1[1]); w.w = pk2(v1[2], v1[3]);
                    *(u32x4*)(rowp + bj * 128) = w; } } }
    }
};
struct EpiRes {
    static constexpr bool PERM = false, AFTER_DRAIN = false;
    const float* base; float* out; const float* gate;
    __device__ __forceinline__ void operator()(const f32x4 (&acc)[2][2][4][2], const pg8::Unit& u, int wr, int wc, int fr, int fq) const {
        const int row0 = u.pm * 256 + wr * 64 + fr, col0 = u.pn * 256 + wc * 32 + 4 * fq;
        const float* gp = gate + (size_t)((u.pm * 256) >> 12) * (NMOD * DM) + col0;
        f32x4 gv[2][2];
#pragma unroll
        for (int bj = 0; bj < 2; ++bj)
#pragma unroll
            for (int n = 0; n < 2; ++n) gv[bj][n] = *(const f32x4*)(gp + bj * 128 + n * 16);
#pragma unroll
        for (int ai = 0; ai < 2; ++ai)
#pragma unroll
            for (int m = 0; m < 4; ++m) { const size_t off = (size_t)(row0 + ai * 128 + m * 16) * DM + col0;
#pragma unroll
                for (int bj = 0; bj < 2; ++bj)
#pragma unroll
                    for (int n = 0; n < 2; ++n) { const f32x4 bs = *(const f32x4*)(base + off + bj * 128 + n * 16);
                        *(f32x4*)(out + off + bj * 128 + n * 16) = bs + gv[bj][n] * acc[ai][bj][m][n]; } }
    }
};
struct EpiSwiglu {
    static constexpr bool PERM = true, AFTER_DRAIN = false;
    bf16_t* O;
    __device__ __forceinline__ void operator()(const f32x4 (&acc)[2][2][4][2], const pg8::Unit& u, int wr, int wc, int fr, int fq) const {
        const int row0 = u.pm * 256 + wr * 64 + fr, col0 = u.pn * 128 + wc * 32 + 8 * fq;
#pragma unroll
        for (int ai = 0; ai < 2; ++ai)
#pragma unroll
            for (int m = 0; m < 4; ++m) { bf16_t* rowp = O + (size_t)(row0 + ai * 128 + m * 16) * FFN + col0;
                float r[8];
#pragma unroll
                for (int n = 0; n < 2; ++n)
#pragma unroll
                    for (int i = 0; i < 4; ++i) { const float g = acc[ai][0][m][n][i], uu = acc[ai][1][m][n][i]; r[n * 4 + i] = siluf(g) * uu; }
                u32x4 w; w.x = pk2(r[0], r[1]); w.y = pk2(r[2], r[3]); w.z = pk2(r[4], r[5]); w.w = pk2(r[6], r[7]);
                *(u32x4*)rowp = w; }
    }
};
__device__ __forceinline__ void transpose_item(const float* W, int K, int N, bf16_t* WT, int dst_row0, int src_col0, int k0, LAS float* scr, int lane) {
    if (src_col0 < 0) {
        const int c = lane & 7;
#pragma unroll
        for (int j = 0; j < 4; ++j) { const int n = (lane >> 3) + 8 * j; *(u32x4*)(WT + (size_t)(dst_row0 + n) * K + k0 + 8 * c) = (u32x4){0u, 0u, 0u, 0u}; }
        return;
    }
#pragma unroll 8
    for (int i = 0; i < 32; ++i) { const int kk = 2 * i + (lane >> 5); scr[kk * 33 + (lane & 31)] = W[(size_t)(k0 + kk) * N + src_col0 + (lane & 31)]; }
    __builtin_amdgcn_fence(__ATOMIC_RELEASE, "wavefront"); __builtin_amdgcn_wave_barrier(); __builtin_amdgcn_fence(__ATOMIC_ACQUIRE, "wavefront");
    const int c = lane & 7;
#pragma unroll
    for (int j = 0; j < 4; ++j) { const int n = (lane >> 3) + 8 * j; const LAS float* s = scr + (8 * c) * 33 + n;
        u32x4 o; o.x = pk2(s[0 * 33], s[1 * 33]); o.y = pk2(s[2 * 33], s[3 * 33]); o.z = pk2(s[4 * 33], s[5 * 33]); o.w = pk2(s[6 * 33], s[7 * 33]);
        *(u32x4*)(WT + (size_t)(dst_row0 + n) * K + k0 + 8 * c) = o; }
    __builtin_amdgcn_fence(__ATOMIC_RELEASE, "wavefront"); __builtin_amdgcn_wave_barrier(); __builtin_amdgcn_fence(__ATOMIC_ACQUIRE, "wavefront");
}

__device__ __forceinline__ void phase_weights(const Params& P, LAS unsigned char* lds) {
    const int tid = opaque_tid(), lane = tid & 63, wave = __builtin_amdgcn_readfirstlane(tid >> 6);
    unsigned char* ws = P.ws;
    {
        LAS float* scr = (LAS float*)(lds + wave * 8704);
        const int gw = blockIdx.x * 8 + wave, NGW = gridDim.x * 8;
        constexpr int I_IN = 16 * 128, I_OUT = 16 * 32, I_GU = 16 * 176, I_DN = 44 * 32, I_L = I_IN + I_OUT + I_GU + I_DN;
        for (int it = gw; it < DEPTH * I_L; it += NGW) {
            const int l = it / I_L; int r = it % I_L;
            if (r < I_IN) { const int kb = r / 128, nb = r % 128, n0 = nb * 32;
                transpose_item(P.w_in + (size_t)l * DM * INW, DM, INW, (bf16_t*)(ws + WS_WIN) + (size_t)l * INWP * DM, n0, n0 < INW ? n0 : -1, kb * 64, scr, lane); continue; }
            r -= I_IN;
            if (r < I_OUT) { const int kb = r / 32, nb = r % 32;
                transpose_item(P.w_out + (size_t)l * DM * DM, DM, DM, (bf16_t*)(ws + WS_WOUT) + (size_t)l * DM * DM, nb * 32, nb * 32, kb * 64, scr, lane); continue; }
            r -= I_OUT;
            if (r < I_GU) { const int kb = r / 176, nb = r % 176, n0 = nb * 32; const int pn = n0 >> 8, half = (n0 >> 7) & 1, jj = n0 & 127;
                transpose_item(P.w_gu + (size_t)l * DM * 2 * FFN, DM, 2 * FFN, (bf16_t*)(ws + WS_WGU) + (size_t)l * 2 * FFN * DM, n0, half * FFN + pn * 128 + jj, kb * 64, scr, lane); continue; }
            r -= I_GU;
            { const int kb = r / 32, nb = r % 32;
                transpose_item(P.w_down + (size_t)l * FFN * DM, FFN, DM, (bf16_t*)(ws + WS_WDN) + (size_t)l * DM * FFN, nb * 32, nb * 32, kb * 64, scr, lane); }
        }
    }
}
__device__ __forceinline__ void phase_prologue(const Params& P, LAS unsigned char* lds) {
    const int tid = opaque_tid();
    unsigned char* ws = P.ws;
    {
        LAS float* sc = (LAS float*)lds;
        LAS float* red = (LAS float*)(lds + 32768);
        for (int i = tid; i < NBATCH * DM; i += NTHREADS) sc[i] = siluf(P.c[i]);
        __syncthreads();
        float* mod = (float*)(ws + WS_MOD);
        for (int u = blockIdx.x; u < DEPTH * 96; u += gridDim.x) {
            const int l = u / 96, j0 = (u % 96) * 64, col = tid & 63, kp = tid >> 6;
            float acc[8];
#pragma unroll
            for (int b = 0; b < 8; ++b) acc[b] = 0.f;
            const float* wp = P.w_ada + (size_t)l * DM * (NMOD * DM) + j0 + col;
            for (int k = kp * 128; k < kp * 128 + 128; ++k) { const float w = wp[(size_t)k * (NMOD * DM)];
#pragma unroll
                for (int b = 0; b < 8; ++b) acc[b] += sc[b * DM + k] * w; }
#pragma unroll
            for (int b = 0; b < 8; ++b) red[(kp * 8 + b) * 64 + col] = acc[b];
            __syncthreads();
            { const int b = tid >> 6; float s = 0.f;
#pragma unroll
              for (int p = 0; p < 8; ++p) s += red[(p * 8 + b) * 64 + col];
              mod[((size_t)l * NBATCH + b) * (NMOD * DM) + j0 + col] = s + P.b_ada[(size_t)l * NMOD * DM + j0 + col]; }
            __syncthreads();
        }
    }
    if (blockIdx.x == 0 && tid < 256) {
        const float l0 = P.lb_logits[tid], l1 = P.lb_logits[256 + tid], m = fmaxf(l0, l1), e0 = __expf(l0 - m), e1 = __expf(l1 - m);
        const float p0 = e0 / (e0 + e1), p1 = e1 / (e0 + e1);
        float* lb = (float*)(ws + WS_LB);
        lb[tid] = fminf(fmaxf(p0 - p0, 0.f), 1.0f - 1e-6f);
        lb[256 + tid] = fminf(fmaxf((p0 + p1) - p0, 0.f), 1.0f - 1e-6f);
    }
}

template <bool HAS_Y, bool FINAL>
__device__ __forceinline__ void phase_norm(const float* src, const bf16_t* y, const float* gate, float* xout, const float* g, const float* shift, const float* scale, bf16_t* dst) {
    const int tid = opaque_tid(), lane = tid & 63, wave = tid >> 6;
    const int gw = blockIdx.x * 8 + wave, NGW = gridDim.x * 8;
    f32x4 gv[4];
#pragma unroll
    for (int j = 0; j < 4; ++j) gv[j] = *(const f32x4*)(g + 4 * lane + 256 * j);
    const int WPB = NGW / NBATCH, b = gw / WPB;
    if (b >= NBATCH) return;
    f32x4 gtv[4], scv[4], shv[4];
#pragma unroll
    for (int j = 0; j < 4; ++j) {
        if (HAS_Y) gtv[j] = *(const f32x4*)(gate + (size_t)b * (NMOD * DM) + 4 * lane + 256 * j);
        if (!FINAL) { scv[j] = *(const f32x4*)(scale + (size_t)b * (NMOD * DM) + 4 * lane + 256 * j) + 1.0f; shv[j] = *(const f32x4*)(shift + (size_t)b * (NMOD * DM) + 4 * lane + 256 * j); }
    }
    for (int row = b * SEQ + (gw - b * WPB); row < (b + 1) * SEQ; row += WPB) {
        const f32x4* xr = (const f32x4*)(src + (size_t)row * DM) + lane;
        f32x4 v[4]; float s = 0.f;
#pragma unroll
        for (int j = 0; j < 4; ++j) v[j] = xr[64 * j];
        if (HAS_Y) {
            const u32x2* yr = (const u32x2*)(y + (size_t)row * DM) + lane;
#pragma unroll
            for (int j = 0; j < 4; ++j) { const u32x2 yw = yr[64 * j]; const f32x4 gt = gtv[j];
                v[j][0] += gt[0] * bflo(yw.x); v[j][1] += gt[1] * bfhi(yw.x); v[j][2] += gt[2] * bflo(yw.y); v[j][3] += gt[3] * bfhi(yw.y); }
        }
#pragma unroll
        for (int j = 0; j < 4; ++j) s += (v[j][0] * v[j][0] + v[j][1] * v[j][1]) + (v[j][2] * v[j][2] + v[j][3] * v[j][3]);
        const float rstd = rsqrtf(wave_sum(s) * (1.0f / DM) + NORM_EPS);
        f32x4* xo = (f32x4*)(xout + (size_t)row * DM) + lane;
        if (FINAL) {
#pragma unroll
            for (int j = 0; j < 4; ++j) xo[64 * j] = v[j] * rstd * gv[j];
        } else {
            if (HAS_Y) {
#pragma unroll
                for (int j = 0; j < 4; ++j) xo[64 * j] = v[j];
            }
            unsigned long long* o8 = (unsigned long long*)(dst + (size_t)row * DM) + lane;
#pragma unroll
            for (int j = 0; j < 4; ++j) {
                const f32x4 h = v[j] * rstd * gv[j] * scv[j] + shv[j];
                o8[64 * j] = (unsigned long long)pk2(h[0], h[1]) | ((unsigned long long)pk2(h[2], h[3]) << 32);
            }
        }
    }
}
__device__ __forceinline__ bf16x4 tr4(const LAS bf16_t* img, int pitch, int row0, int col0, int g, int q) {
    return __builtin_amdgcn_ds_read_tr16_b64_v4i16((LAS bf16x4*)(img + (row0 + 4 * g + (q >> 2)) * pitch + col0 + 4 * (q & 3)));
}
__device__ __forceinline__ bf16x8 tr8(const LAS bf16_t* img, int pitch, int row0, int col0, int g, int q) {
    const bf16x4 lo = __builtin_amdgcn_ds_read_tr16_b64_v4i16((LAS bf16x4*)(img + (row0 + 8 * g + (q >> 2)) * pitch + col0 + 4 * (q & 3)));
    const bf16x4 hi = __builtin_amdgcn_ds_read_tr16_b64_v4i16((LAS bf16x4*)(img + (row0 + 8 * g + 4 + (q >> 2)) * pitch + col0 + 4 * (q & 3)));
    return __builtin_shufflevector(lo, hi, 0, 1, 2, 3, 4, 5, 6, 7);
}
struct AttRegs { u32x4 kv[2][4], vv[2][4]; bf16x8 qf[2][2]; };
constexpr int ATT_UNITS = 2304;
__device__ __forceinline__ void att_decode(int u, int& br, int& b, int& h, int& r, int& L, int& p0, int& tok0) {
    br = u / 768; const int v = u % 768; b = v / 96; h = (v >> 4) % 6; const int w = v & 15;
    const int lr = br * 2, nblk = 16 >> lr, rho = w >> (4 - lr), blk = w & (nblk - 1); r = 1 << lr; L = SEQ >> lr; p0 = blk * 256; tok0 = b * SEQ + rho;
}
__device__ __forceinline__ void att_load(const Params& P, int u, int tid, AttRegs& R) {
    int br, b, h, r, L, p0, tok0; att_decode(u, br, b, h, r, L, p0, tok0);
    const bf16_t* proj = (const bf16_t*)(P.ws + WS_PROJ);
#pragma unroll
    for (int it = 0; it < 2; ++it) {
        const int item = tid + it * NTHREADS, key = item >> 1, half = item & 1, kj = p0 - 64 + key;
        if (item < 768 && kj >= 0 && kj < L) {
            const bf16_t* src = proj + (size_t)(tok0 + r * kj) * INW + h * 64 + half * 32;
#pragma unroll
            for (int i = 0; i < 4; ++i) { R.kv[it][i] = *(const u32x4*)(src + C_AK + 8 * i); R.vv[it][i] = *(const u32x4*)(src + C_AV + 8 * i); }
        } else {
#pragma unroll
            for (int i = 0; i < 4; ++i) { R.kv[it][i] = (u32x4){0u, 0u, 0u, 0u}; R.vv[it][i] = (u32x4){0u, 0u, 0u, 0u}; }
        }
    }
    const int lane = tid & 63, wave = tid >> 6, q = lane & 15, g = lane >> 4;
#pragma unroll
    for (int qt = 0; qt < 2; ++qt) {
        const size_t tokq = (size_t)(tok0 + r * (p0 + 32 * wave + 16 * qt + q));
#pragma unroll
        for (int kk = 0; kk < 2; ++kk) R.qf[qt][kk] = *(const bf16x8*)(proj + tokq * INW + C_AQ + h * 64 + kk * 32 + 8 * g);
    }
}
__device__ __forceinline__ void att_phase(const Params& P, LAS unsigned char* lds) {
    const int tid = opaque_tid(), lane = tid & 63, wave = __builtin_amdgcn_readfirstlane(tid >> 6), q = lane & 15, g = lane >> 4;
    LAS bf16_t* Ks = (LAS bf16_t*)lds;
    LAS bf16_t* Vs = (LAS bf16_t*)(lds + 55296);
    int u = blockIdx.x; if (u >= ATT_UNITS) return;
    AttRegs R; att_load(P, u, tid, R);
    for (; u < ATT_UNITS; u += gridDim.x) {
        int br, b, h, r, L, p0, tok0; att_decode(u, br, b, h, r, L, p0, tok0);
#pragma unroll
        for (int it = 0; it < 2; ++it) {
            const int item = tid + it * NTHREADS, key = item >> 1, half = item & 1;
            if (item < 768) {
#pragma unroll
                for (int i = 0; i < 4; ++i) { *(LAS u32x4*)(Ks + key * 72 + half * 32 + 8 * i) = R.kv[it][i]; *(LAS u32x4*)(Vs + key * 72 + half * 32 + 8 * i) = R.vv[it][i]; }
            }
        }
        bf16x8 qf[2][2]; qf[0][0] = R.qf[0][0]; qf[0][1] = R.qf[0][1]; qf[1][0] = R.qf[1][0]; qf[1][1] = R.qf[1][1];
        __syncthreads();
        if (u + (int)gridDim.x < ATT_UNITS) att_load(P, u + gridDim.x, tid, R);
        const float slope_l2 = exp2f(-8.0f * (float)(h + 1) / 6.0f) * (float)r * 1.44269504f, qk_l2 = 0.125f * 1.44269504f;
        const float fbase = (float)(64 + q - 4 * g);
        const bool edge = (p0 < 64) || (p0 + 320 > L);
#pragma unroll
        for (int qt = 0; qt < 2; ++qt) {
            const int kw = 32 * wave + 16 * qt;
            const int p = p0 + kw + q; const size_t tokq = (size_t)(tok0 + r * p);
            f32x4 st[9]; float mx = -3.0e38f;
#pragma unroll
            for (int t = 0; t < 9; ++t) {
                f32x4 acc = {0.f, 0.f, 0.f, 0.f};
#pragma unroll
                for (int kk = 0; kk < 2; ++kk) { const bf16x8 a = *(const LAS bf16x8*)(Ks + (kw + 16 * t + q) * 72 + kk * 32 + 8 * g); acc = MFMA32(a, qf[qt][kk], acc); }
#pragma unroll
                for (int j = 0; j < 4; ++j) {
                    const float d = fabsf(fbase - (float)(16 * t + j));
                    float s = acc[j] * qk_l2 - slope_l2 * d;
                    if (t == 0 || t == 8) s = (d <= 64.0f) ? s : -1.0e30f;
                    acc[j] = s;
                }
                if (edge) {
#pragma unroll
                    for (int j = 0; j < 4; ++j) { const int kj = p0 - 64 + kw + 16 * t + 4 * g + j; acc[j] = (kj >= 0 && kj < L) ? acc[j] : -1.0e30f; }
                }
#pragma unroll
                for (int j = 0; j < 4; ++j) mx = fmaxf(mx, acc[j]);
                st[t] = acc;
            }
            mx = fmaxf(mx, __shfl_xor(mx, 16)); mx = fmaxf(mx, __shfl_xor(mx, 32));
            float ls = 0.f; bf16x4 pt[9];
#pragma unroll
            for (int t = 0; t < 9; ++t) { f32x4 e;
#pragma unroll
                for (int j = 0; j < 4; ++j) { e[j] = __builtin_amdgcn_exp2f(st[t][j] - mx); ls += e[j]; }
                pt[t] = pk4(e); }
            ls += __shfl_xor(ls, 16); ls += __shfl_xor(ls, 32);
            const float inv = __builtin_amdgcn_rcpf(ls);
            bf16_t* ob = (bf16_t*)(P.ws + WS_OB) + ((size_t)br * NTOK + tokq) * 384 + h * 64;
            const LAS bf16_t* vrd = Vs + (kw + 4 * g + (q >> 2)) * 72 + 4 * (q & 3);
#pragma unroll
            for (int dt = 0; dt < 4; ++dt) {
                f32x4 acc = {0.f, 0.f, 0.f, 0.f};
#pragma unroll
                for (int t = 0; t < 9; ++t) { const bf16x4 a = __builtin_amdgcn_ds_read_tr16_b64_v4i16((LAS bf16x4*)(vrd + 16 * t * 72 + dt * 16)); acc = MFMA16(a, pt[t], acc); }
                acc = acc * inv;
                *(bf16x4*)(ob + dt * 16 + 4 * g) = pk4(acc);
            }
            if (g == 0) ((float*)(P.ws + WS_LSE))[((size_t)br * NTOK + tokq) * 6 + h] = (mx + __log2f(ls)) * 0.69314718f;
        }
        __syncthreads();
    }
}
__device__ __forceinline__ void att_merge(const Params& P) {
    const bf16_t* ob = (const bf16_t*)(P.ws + WS_OB); const float* lse = (const float*)(P.ws + WS_LSE); bf16_t* mixed = (bf16_t*)(P.ws + WS_HBUF);
    for (size_t it = (size_t)blockIdx.x * NTHREADS + opaque_tid(); it < (size_t)NTOK * 48; it += (size_t)gridDim.x * NTHREADS) {
        const size_t tok = it / 48; const int grp = (int)(it % 48), h = grp >> 3;
        const float l0 = lse[tok * 6 + h], l1 = lse[((size_t)NTOK + tok) * 6 + h], l2 = lse[((size_t)2 * NTOK + tok) * 6 + h];
        const float m = fmaxf(l0, fmaxf(l1, l2)), e0 = __expf(l0 - m), e1 = __expf(l1 - m), e2 = __expf(l2 - m), is = __builtin_amdgcn_rcpf(e0 + e1 + e2);
        const float w0 = e0 * is, w1 = e1 * is, w2 = e2 * is;
        const u32x4 a = *(const u32x4*)(ob + tok * 384 + grp * 8), bq = *(const u32x4*)(ob + ((size_t)NTOK + tok) * 384 + grp * 8), cq = *(const u32x4*)(ob + ((size_t)2 * NTOK + tok) * 384 + grp * 8);
        u32x4 o;
#pragma unroll
        for (int i = 0; i < 4; ++i) o[i] = pk2(w0 * bflo(a[i]) + w1 * bflo(bq[i]) + w2 * bflo(cq[i]), w0 * bfhi(a[i]) + w1 * bfhi(bq[i]) + w2 * bfhi(cq[i]));
        *(u32x4*)(mixed + tok * DM + grp * 8) = o;
    }
}

__device__ __forceinline__ float ret_logg(int h) { return log1pf(-exp2f(-5.0f - (float)h)); }
struct RetARegs { u32x4 k0, k1, v0, v1; };
__device__ __forceinline__ void retA_load(const Params& P, int u, int tid, RetARegs& R) {
    const int bh = u >> 5, n = u & 31, b = bh / 6, h = bh % 6, c = tid >> 2, qd = tid & 3;
    const bf16_t* src = (const bf16_t*)(P.ws + WS_PROJ) + (size_t)(b * SEQ + n * 128 + c) * INW + h * 64 + qd * 16;
    R.k0 = *(const u32x4*)(src + C_RK); R.k1 = *(const u32x4*)(src + C_RK + 8); R.v0 = *(const u32x4*)(src + C_RV); R.v1 = *(const u32x4*)(src + C_RV + 8);
}
__device__ __forceinline__ void retA_phase(const Params& P, LAS unsigned char* lds) {
    const int tid = opaque_tid(), lane = tid & 63, wave = __builtin_amdgcn_readfirstlane(tid >> 6), q = lane & 15, g = lane >> 4;
    LAS bf16_t* Kf = (LAS bf16_t*)lds; LAS bf16_t* Kb = (LAS bf16_t*)(lds + 18432); LAS bf16_t* Vs = (LAS bf16_t*)(lds + 36864);
    int u = blockIdx.x; if (u >= 1536) return;
    RetARegs R; retA_load(P, u, tid, R);
    for (; u < 1536; u += gridDim.x) {
        const int bh = u >> 5, n = u & 31, h = bh % 6;
        const float lg = ret_logg(h);
        {
            const int c = tid >> 2, qd = tid & 3;
            const float wf = 0.125f * __expf(lg * (float)(127 - c)), wb = 0.125f * __expf(lg * (float)c);
            u32x4 f0, f1, b0, b1;
#pragma unroll
            for (int e = 0; e < 4; ++e) { f0[e] = pk2(bflo(R.k0[e]) * wf, bfhi(R.k0[e]) * wf); f1[e] = pk2(bflo(R.k1[e]) * wf, bfhi(R.k1[e]) * wf);
                b0[e] = pk2(bflo(R.k0[e]) * wb, bfhi(R.k0[e]) * wb); b1[e] = pk2(bflo(R.k1[e]) * wb, bfhi(R.k1[e]) * wb); }
            *(LAS u32x4*)(Kf + c * 72 + qd * 16) = f0; *(LAS u32x4*)(Kf + c * 72 + qd * 16 + 8) = f1;
            *(LAS u32x4*)(Kb + c * 72 + qd * 16) = b0; *(LAS u32x4*)(Kb + c * 72 + qd * 16 + 8) = b1;
            *(LAS u32x4*)(Vs + c * 72 + qd * 16) = R.v0; *(LAS u32x4*)(Vs + c * 72 + qd * 16 + 8) = R.v1;
        }
        __syncthreads();
        if (u + (int)gridDim.x < 1536) retA_load(P, u + gridDim.x, tid, R);
        const int dir = wave >> 2, dt = wave & 3; const LAS bf16_t* Kt = dir ? Kb : Kf;
        bf16x8 afr[4];
#pragma unroll
        for (int kk = 0; kk < 4; ++kk) afr[kk] = tr8(Kt, 72, kk * 32, dt * 16, g, q);
        bf16_t* dst = (bf16_t*)(P.ws + WS_RST) + ((size_t)(bh * 32 + n) * 2 + dir) * 4096;
#pragma unroll
        for (int et = 0; et < 4; ++et) {
            f32x4 acc = {0.f, 0.f, 0.f, 0.f};
#pragma unroll
            for (int kk = 0; kk < 4; ++kk) { const bf16x8 bfr = tr8(Vs, 72, kk * 32, et * 16, g, q); acc = MFMA32(afr[kk], bfr, acc); }
            *(bf16x4*)(dst + (et * 16 + q) * 64 + dt * 16 + 4 * g) = pk4(acc);
        }
        __syncthreads();
    }
}
__device__ __forceinline__ void ret_scan(const Params& P) {
    bf16_t* st = (bf16_t*)(P.ws + WS_RST);
    for (int it = blockIdx.x * NTHREADS + opaque_tid(); it < 48 * 2 * 512; it += gridDim.x * NTHREADS) {
        const int ch = it & 511, dir = (it >> 9) & 1, bh = it >> 10, h = bh % 6;
        const float cd = __expf(ret_logg(h) * 128.0f);
        float s[8];
#pragma unroll
        for (int e = 0; e < 8; ++e) s[e] = 0.f;
        for (int i0 = 0; i0 < 32; i0 += 8) {
            u32x4 v[8];
#pragma unroll
            for (int i = 0; i < 8; ++i) { const int n = dir ? 31 - (i0 + i) : (i0 + i); v[i] = *(const u32x4*)(st + ((size_t)(bh * 32 + n) * 2 + dir) * 4096 + 8 * ch); }
#pragma unroll
            for (int i = 0; i < 8; ++i) { const int n = dir ? 31 - (i0 + i) : (i0 + i);
                u32x4 o;
#pragma unroll
                for (int e = 0; e < 4; ++e) o[e] = pk2(s[2 * e], s[2 * e + 1]);
                *(u32x4*)(st + ((size_t)(bh * 32 + n) * 2 + dir) * 4096 + 8 * ch) = o;
#pragma unroll
                for (int e = 0; e < 4; ++e) { s[2 * e] = cd * s[2 * e] + bflo(v[i][e]); s[2 * e + 1] = cd * s[2 * e + 1] + bfhi(v[i][e]); } }
        }
    }
}
struct RetBRegs { u32x4 k0, k1, v0, v1, rf, rb, q0, q1; };
__device__ __forceinline__ void retB_load(const Params& P, int u, int tid, RetBRegs& R) {
    const int bh = u >> 5, n = u & 31, b = bh / 6, h = bh % 6, c = tid >> 2, qd = tid & 3;
    const bf16_t* proj = (const bf16_t*)(P.ws + WS_PROJ);
    const bf16_t* src = proj + (size_t)(b * SEQ + n * 128 + c) * INW + h * 64 + qd * 16;
    R.k0 = *(const u32x4*)(src + C_RK); R.k1 = *(const u32x4*)(src + C_RK + 8); R.v0 = *(const u32x4*)(src + C_RV); R.v1 = *(const u32x4*)(src + C_RV + 8);
    const bf16_t* rs = (const bf16_t*)(P.ws + WS_RST) + (size_t)(bh * 32 + n) * 2 * 4096;
    const int e = tid >> 3, d8 = (tid & 7) * 8;
    R.rf = *(const u32x4*)(rs + e * 64 + d8); R.rb = *(const u32x4*)(rs + 4096 + e * 64 + d8);
    const int lane = tid & 63, wave = tid >> 6, q = lane & 15, g = lane >> 4;
    const bf16_t* qp = proj + (size_t)(b * SEQ + n * 128 + 16 * wave + q) * INW + C_RQ + h * 64 + 8 * g;
    R.q0 = *(const u32x4*)qp; R.q1 = *(const u32x4*)(qp + 32);
}
__device__ __forceinline__ void retB_phase(const Params& P, LAS unsigned char* lds, int layer) {
    const int tid = opaque_tid(), lane = tid & 63, wave = __builtin_amdgcn_readfirstlane(tid >> 6), q = lane & 15, g = lane >> 4;
    const bf16_t* proj = (const bf16_t*)(P.ws + WS_PROJ);
    LAS bf16_t* Ks = (LAS bf16_t*)lds;
    LAS bf16_t* Vs = (LAS bf16_t*)(lds + 18432);
    LAS bf16_t* Rf = (LAS bf16_t*)(lds + 36864);
    LAS bf16_t* Rb = (LAS bf16_t*)(lds + 46080);
    int u = blockIdx.x; if (u >= 1536) return;
    RetBRegs R; retB_load(P, u, tid, R);
    for (; u < 1536; u += gridDim.x) {
        const int bh = u >> 5, n = u & 31, b = bh / 6, h = bh % 6;
        const float lg = ret_logg(h);
        {
            const int c = tid >> 2, qd = tid & 3, e = tid >> 3, d8 = (tid & 7) * 8;
            *(LAS u32x4*)(Ks + c * 72 + qd * 16) = R.k0; *(LAS u32x4*)(Ks + c * 72 + qd * 16 + 8) = R.k1;
            *(LAS u32x4*)(Vs + c * 72 + qd * 16) = R.v0; *(LAS u32x4*)(Vs + c * 72 + qd * 16 + 8) = R.v1;
            *(LAS u32x4*)(Rf + e * 72 + d8) = R.rf; *(LAS u32x4*)(Rb + e * 72 + d8) = R.rb;
        }
        const u32x4 qraw[2] = {R.q0, R.q1};
        __syncthreads();
        if (u + (int)gridDim.x < 1536) retB_load(P, u + gridDim.x, tid, R);
        const int i = 16 * wave + q; const size_t tok = (size_t)(b * SEQ + n * 128 + i);
        bf16x8 qf[2], qff[2], qfb[2];
        {
            const float ff = __expf(lg * (float)(i + 1)), fb = __expf(lg * (float)(128 - i));
#pragma unroll
            for (int kk = 0; kk < 2; ++kk) { const u32x4 raw = qraw[kk];
                qf[kk] = __builtin_bit_cast(bf16x8, raw); u32x4 a, c2;
#pragma unroll
                for (int e = 0; e < 4; ++e) { const float lo = bflo(raw[e]), hi = bfhi(raw[e]); a[e] = pk2(lo * ff, hi * ff); c2[e] = pk2(lo * fb, hi * fb); }
                qff[kk] = __builtin_bit_cast(bf16x8, a); qfb[kk] = __builtin_bit_cast(bf16x8, c2); }
        }
        bf16x4 pt[8];
#pragma unroll
        for (int jt = 0; jt < 8; ++jt) {
            f32x4 acc = {0.f, 0.f, 0.f, 0.f};
#pragma unroll
            for (int kk = 0; kk < 2; ++kk) { const bf16x8 a = *(const LAS bf16x8*)(Ks + (16 * jt + q) * 72 + kk * 32 + 8 * g); acc = MFMA32(a, qf[kk], acc); }
#pragma unroll
            for (int jj = 0; jj < 4; ++jj) { int dd = i - (16 * jt + 4 * g + jj); dd = dd < 0 ? -dd : dd; acc[jj] = acc[jj] * 0.125f * __expf(lg * (float)dd); }
            pt[jt] = pk4(acc);
        }
        f32x4 o[4];
#pragma unroll
        for (int et = 0; et < 4; ++et) {
            f32x4 acc = {0.f, 0.f, 0.f, 0.f};
#pragma unroll
            for (int jt = 0; jt < 8; ++jt) { const bf16x4 a = tr4(Vs, 72, 16 * jt, et * 16, g, q); acc = MFMA16(a, pt[jt], acc); }
#pragma unroll
            for (int kk = 0; kk < 2; ++kk) { const bf16x8 a = *(const LAS bf16x8*)(Rf + (et * 16 + q) * 72 + kk * 32 + 8 * g); acc = MFMA32(a, qff[kk], acc);
                const bf16x8 a2 = *(const LAS bf16x8*)(Rb + (et * 16 + q) * 72 + kk * 32 + 8 * g); acc = MFMA32(a2, qfb[kk], acc); }
            o[et] = acc;
        }
        float s = 0.f;
#pragma unroll
        for (int et = 0; et < 4; ++et) s += (o[et][0] + o[et][1]) + (o[et][2] + o[et][3]);
        s += __shfl_xor(s, 16); s += __shfl_xor(s, 32);
        const float mu = s * (1.0f / 64.0f); float vs = 0.f;
#pragma unroll
        for (int et = 0; et < 4; ++et) { o[et] = o[et] - mu; vs += (o[et][0] * o[et][0] + o[et][1] * o[et][1]) + (o[et][2] * o[et][2] + o[et][3] * o[et][3]); }
        vs += __shfl_xor(vs, 16); vs += __shfl_xor(vs, 32);
        const float rstd = rsqrtf(vs * (1.0f / 64.0f) + NORM_EPS);
        bf16_t* mixed = (bf16_t*)(P.ws + WS_HBUF) + tok * DM + 384 + h * 64;
#pragma unroll
        for (int et = 0; et < 4; ++et) {
            const f32x4 gn = *(const f32x4*)(P.ret_gn + layer * 384 + h * 64 + et * 16 + 4 * g);
            const u32x2 rg = *(const u32x2*)(proj + tok * INW + C_RG + h * 64 + et * 16 + 4 * g);
            f32x4 y; y[0] = o[et][0] * rstd * gn[0] * siluf(bflo(rg.x)); y[1] = o[et][1] * rstd * gn[1] * siluf(bfhi(rg.x));
            y[2] = o[et][2] * rstd * gn[2] * siluf(bflo(rg.y)); y[3] = o[et][3] * rstd * gn[3] * siluf(bfhi(rg.y));
            *(bf16x4*)(mixed + et * 16 + 4 * g) = pk4(y);
        }
        __syncthreads();
    }
}
__device__ __forceinline__ void hgrn_gate(float z, float lbv, float& f, float& kk) {
    z = fminf(fmaxf(z, -30.f), 30.f);
    const float ez = __expf(-z), sg = __builtin_amdgcn_rcpf(1.0f + ez);
    f = lbv + (1.0f - lbv) * sg; kk = (1.0f - lbv) * ez * sg;
}
__device__ __forceinline__ void hgA_unit(const Params& P, LAS unsigned char* lds, int u, int layer) {
    const int tid = opaque_tid(), lane = tid & 63, wave = __builtin_amdgcn_readfirstlane(tid >> 6), q = lane & 15, g = lane >> 4;
    const int bh = u >> 5, n = u & 31, b = bh >> 2, h = bh & 3;
    const bf16_t* proj = (const bf16_t*)(P.ws + WS_PROJ);
    LAS bf16_t* Kt = (LAS bf16_t*)lds;
    LAS bf16_t* Vt = (LAS bf16_t*)(lds + 34816);
    LAS float* segs = (LAS float*)(lds + 52224);
    const size_t tokc = (size_t)(b * SEQ + n * 128);
    {
        const int c = tid >> 2, qd = tid & 3; const bf16_t* src = proj + (tokc + c) * INW + C_HI + h * 64 + qd * 16;
        const u32x4 v0 = *(const u32x4*)src, v1 = *(const u32x4*)(src + 8);
#pragma unroll
        for (int e = 0; e < 8; ++e) { const unsigned vw = e < 4 ? v0[e & 3] : v1[e & 3]; const int d = qd * 16 + 2 * e;
            Vt[d * 136 + c] = (bf16_t)(vw & 0xffffu); Vt[(d + 1) * 136 + c] = (bf16_t)(vw >> 16); }
    }
    const int d = tid & 63, dir = (tid >> 6) & 1, seg = tid >> 7;
    const float lbv = ((const float*)(P.ws + WS_LB))[layer * 256 + h * 64 + d];
    float lf[32], kk[32];
    {
        const bf16_t* zp = proj + (tokc + seg * 32) * INW + (dir ? C_HZB : C_HZF) + h * 64 + d;
        bf16_t zr[32];
#pragma unroll
        for (int i = 0; i < 32; ++i) zr[i] = zp[(size_t)i * INW];
#pragma unroll
        for (int i = 0; i < 32; ++i) hgrn_gate(bf2f(zr[i]), lbv, lf[i], kk[i]);
    }
    float ssum = 1.f;
#pragma unroll
    for (int i = 0; i < 32; ++i) ssum *= lf[i];
    segs[(dir * 4 + seg) * 64 + d] = ssum;
    __syncthreads();
    {
        float before = 1.f, after = 1.f;
#pragma unroll
        for (int s2 = 0; s2 < 4; ++s2) { const float v = segs[(dir * 4 + s2) * 64 + d]; if (s2 < seg) before *= v; if (s2 > seg) after *= v; }
        LAS bf16_t* kt = Kt + dir * (64 * 136) + d * 136 + seg * 32;
        if (dir == 0) {
            float run = after;
#pragma unroll
            for (int i = 31; i >= 0; --i) { kt[i] = f2bf(kk[i] * run); run *= lf[i]; }
        } else {
            float run = before;
#pragma unroll
            for (int i = 0; i < 32; ++i) { kt[i] = f2bf(kk[i] * run); run *= lf[i]; }
        }
        if (seg == 0) ((float*)(P.ws + WS_HGA))[((size_t)(bh * 2 + dir) * 32 + n) * 64 + d] = ssum * after;
    }
    __syncthreads();
    {
        const int wdir = wave >> 2, dt = wave & 3; const LAS bf16_t* kts = Kt + wdir * (64 * 136);
        bf16x8 afr[4];
#pragma unroll
        for (int kq = 0; kq < 4; ++kq) afr[kq] = *(const LAS bf16x8*)(kts + (dt * 16 + q) * 136 + kq * 32 + 8 * g);
        float* dst = (float*)(P.ws + WS_HGU) + ((size_t)(bh * 2 + wdir) * 32 + n) * 4096;
#pragma unroll
        for (int et = 0; et < 4; ++et) {
            f32x4 acc = {0.f, 0.f, 0.f, 0.f};
#pragma unroll
            for (int kq = 0; kq < 4; ++kq) { const bf16x8 bfr = *(const LAS bf16x8*)(Vt + (et * 16 + q) * 136 + kq * 32 + 8 * g); acc = MFMA32(afr[kq], bfr, acc); }
#pragma unroll
            for (int j = 0; j < 4; ++j) dst[(dt * 16 + 4 * g + j) * 64 + et * 16 + q] = acc[j];
        }
    }
    __syncthreads();
}
__device__ __forceinline__ void hg_scan(const Params& P) {
    float* U = (float*)(P.ws + WS_HGU); const float* A = (const float*)(P.ws + WS_HGA);
    const int nthr = gridDim.x * NTHREADS; int it0 = blockIdx.x * NTHREADS + opaque_tid() - 48 * 2 * 512; if (it0 < 0) it0 += nthr;
    for (int it = it0; it < 64 * 64 * 16; it += nthr) {
        const int e4 = it & 15, d = (it >> 4) & 63, bd = it >> 10, dir = bd & 1;
        f32x4 s = {0.f, 0.f, 0.f, 0.f};
        for (int i0 = 0; i0 < 32; i0 += 8) {
            f32x4 v[8]; float a[8];
#pragma unroll
            for (int i = 0; i < 8; ++i) { const int n = dir ? 31 - (i0 + i) : (i0 + i); v[i] = *(const f32x4*)(U + ((size_t)(bd * 32 + n) * 64 + d) * 64 + 4 * e4); a[i] = A[(size_t)(bd * 32 + n) * 64 + d]; }
#pragma unroll
            for (int i = 0; i < 8; ++i) { const int n = dir ? 31 - (i0 + i) : (i0 + i); *(f32x4*)(U + ((size_t)(bd * 32 + n) * 64 + d) * 64 + 4 * e4) = s; s = s * a[i] + v[i]; }
        }
    }
}
__device__ __forceinline__ unsigned pk2h(float lo, float hi) { return pk2(lo, hi); }
__device__ __forceinline__ bf16x4 pk4h(f32x4 v) { return pk4(v); }
__device__ __forceinline__ void hgB_unit(const Params& P, LAS unsigned char* lds, int u, int layer) {
    const int tid = opaque_tid(), lane = tid & 63, wave = __builtin_amdgcn_readfirstlane(tid >> 6), q = lane & 15, g = lane >> 4;
    const int b = u >> 5, n = u & 31, h = wave >> 1, dir = wave & 1, bh = b * 4 + h;
    bf16_t* proj = (bf16_t*)(P.ws + WS_PROJ);
    bf16_t* mixed = (bf16_t*)(P.ws + WS_HBUF);
    LAS unsigned char* wl = lds + wave * 7168;
    LAS bf16_t* Qi = (LAS bf16_t*)wl;
    LAS bf16_t* Ki = (LAS bf16_t*)(wl + 2304);
    LAS bf16_t* Vs = (LAS bf16_t*)(wl + 4608);
    LAS float* Al = (LAS float*)(wl + 6912);
    const size_t tokc = (size_t)(b * SEQ + n * 128);
    const float lbv = ((const float*)(P.ws + WS_LB))[layer * 256 + h * 64 + lane];
    f32x4 S[4][4];
    {
        const float* sp = (const float*)(P.ws + WS_HGU) + ((size_t)(bh * 2 + dir) * 32 + n) * 4096;
#pragma unroll
        for (int dt = 0; dt < 4; ++dt)
#pragma unroll
            for (int et = 0; et < 4; ++et)
#pragma unroll
                for (int j = 0; j < 4; ++j) S[dt][et][j] = sp[(dt * 16 + 4 * g + j) * 64 + et * 16 + q];
    }
    bf16_t* odst = dir ? (proj + C_AQ + h * 64) : (mixed + 768 + h * 64); const size_t opitch = dir ? INW : DM;
    bf16_t qr[16], zz[16]; u32x4 v0, v1;
#define HGB_LOAD(SC) do { const size_t toks_ = tokc + (SC) * 16; const bf16_t* base_ = proj + toks_ * INW + h * 64 + lane; \
        _Pragma("unroll") for (int ii = 0; ii < 16; ++ii) { const int t_ = dir ? 15 - ii : ii; qr[ii] = base_[(size_t)t_ * INW + C_HQ]; zz[ii] = base_[(size_t)t_ * INW + (dir ? C_HZB : C_HZF)]; } \
        const bf16_t* vsrc_ = proj + (toks_ + (lane >> 2)) * INW + C_HI + h * 64 + (lane & 3) * 16; v0 = *(const u32x4*)vsrc_; v1 = *(const u32x4*)(vsrc_ + 8); } while (0)
    HGB_LOAD(dir ? 7 : 0);
    for (int i = 0; i < 8; ++i) {
        const int sc = dir ? 7 - i : i; const size_t toks = tokc + sc * 16;
        {
            *(LAS u32x4*)(Vs + (lane >> 2) * 72 + (lane & 3) * 16) = v0; *(LAS u32x4*)(Vs + (lane >> 2) * 72 + (lane & 3) * 16 + 8) = v1;
            float bp = 1.f;
#pragma unroll
            for (int ii = 0; ii < 16; ++ii) {
                const int t = dir ? 15 - ii : ii;
                float f, kk; hgrn_gate(bf2f(zz[ii]), lbv, f, kk); const float qv = siluf(bf2f(qr[ii]));
                bp *= f;
                Qi[t * 72 + lane] = f2bf(qv * bp); Ki[t * 72 + lane] = f2bf(kk * __builtin_amdgcn_rcpf(fmaxf(bp, 1.0e-30f)));
            }
            Al[lane] = bp;
        }
        if (i + 1 < 8) HGB_LOAD(dir ? 6 - i : i + 1);
        __builtin_amdgcn_fence(__ATOMIC_RELEASE, "wavefront"); __builtin_amdgcn_wave_barrier(); __builtin_amdgcn_fence(__ATOMIC_ACQUIRE, "wavefront");
        f32x4 at = {0.f, 0.f, 0.f, 0.f};
#pragma unroll
        for (int kq = 0; kq < 2; ++kq) { const bf16x8 a8 = *(const LAS bf16x8*)(Ki + q * 72 + kq * 32 + 8 * g), b8 = *(const LAS bf16x8*)(Qi + q * 72 + kq * 32 + 8 * g); at = MFMA32(a8, b8, at); }
#pragma unroll
        for (int j = 0; j < 4; ++j) { const int sl = 4 * g + j; const bool keep = dir ? (sl >= q) : (sl <= q); at[j] = keep ? at[j] : 0.f; }
        const bf16x4 p4 = pk4h(at);
        bf16x4 b4[4], v4[4];
#pragma unroll
        for (int dt = 0; dt < 4; ++dt) b4[dt] = *(const LAS bf16x4*)(Qi + q * 72 + dt * 16 + 4 * g);
#pragma unroll
        for (int et = 0; et < 4; ++et) v4[et] = tr4(Vs, 72, 0, et * 16, g, q);
#pragma unroll
        for (int et = 0; et < 4; ++et) {
            f32x4 o = {0.f, 0.f, 0.f, 0.f};
#pragma unroll
            for (int dt = 0; dt < 4; ++dt) o = MFMA16(pk4h(S[dt][et]), b4[dt], o);
            o = MFMA16(v4[et], p4, o);
            *(bf16x4*)(odst + (toks + q) * opitch + et * 16 + 4 * g) = pk4(o);
        }
#pragma unroll
        for (int dt = 0; dt < 4; ++dt) {
            const bf16x4 kT4 = tr4(Ki, 72, 0, dt * 16, g, q);
            const f32x4 al4 = *(const LAS f32x4*)(Al + dt * 16 + 4 * g);
#pragma unroll
            for (int et = 0; et < 4; ++et) { const f32x4 s2 = MFMA16(kT4, v4[et], S[dt][et]); S[dt][et] = s2 * al4; }
        }
        __builtin_amdgcn_fence(__ATOMIC_RELEASE, "wavefront"); __builtin_amdgcn_wave_barrier(); __builtin_amdgcn_fence(__ATOMIC_ACQUIRE, "wavefront");
    }
    asm volatile("s_waitcnt vmcnt(0)" ::: "memory");
    __syncthreads();
    {
        const int tau = tid >> 2, qd = tid & 3;
        bf16_t* mp = mixed + (tokc + tau) * DM + 768 + qd * 64; const bf16_t* bp2 = proj + (tokc + tau) * INW + C_AQ + qd * 64;
        const bf16_t* gp = proj + (tokc + tau) * INW + C_HG + qd * 64; const float* gn = P.hgrn_gn + layer * 256 + qd * 64;
        float o[64]; float sq = 0.f;
#pragma unroll
        for (int c4 = 0; c4 < 16; ++c4) {
            const unsigned long long fv = __hip_atomic_load((const unsigned long long*)(mp + c4 * 4), __ATOMIC_RELAXED, __HIP_MEMORY_SCOPE_AGENT), bv = __hip_atomic_load((const unsigned long long*)(bp2 + c4 * 4), __ATOMIC_RELAXED, __HIP_MEMORY_SCOPE_AGENT);
            const unsigned f0 = (unsigned)fv, f1 = (unsigned)(fv >> 32), b0 = (unsigned)bv, b1 = (unsigned)(bv >> 32);
            const float x0 = bflo(f0) + bflo(b0), x1 = bfhi(f0) + bfhi(b0), x2 = bflo(f1) + bflo(b1), x3 = bfhi(f1) + bfhi(b1);
            o[c4 * 4 + 0] = x0; o[c4 * 4 + 1] = x1; o[c4 * 4 + 2] = x2; o[c4 * 4 + 3] = x3; sq += (x0 * x0 + x1 * x1) + (x2 * x2 + x3 * x3); }
        sq += __shfl_xor(sq, 1); sq += __shfl_xor(sq, 2);
        const float rstd = rsqrtf(sq * (1.0f / 256.0f) + NORM_EPS);
#pragma unroll
        for (int c8 = 0; c8 < 8; ++c8) {
            const u32x4 gv = *(const u32x4*)(gp + c8 * 8); const f32x4 g0 = *(const f32x4*)(gn + c8 * 8), g1 = *(const f32x4*)(gn + c8 * 8 + 4);
            u32x4 r;
            r.x = pk2h(o[c8 * 8 + 0] * rstd * g0[0] * siluf(bflo(gv.x)), o[c8 * 8 + 1] * rstd * g0[1] * siluf(bfhi(gv.x)));
            r.y = pk2h(o[c8 * 8 + 2] * rstd * g0[2] * siluf(bflo(gv.y)), o[c8 * 8 + 3] * rstd * g0[3] * siluf(bfhi(gv.y)));
            r.z = pk2h(o[c8 * 8 + 4] * rstd * g1[0] * siluf(bflo(gv.z)), o[c8 * 8 + 5] * rstd * g1[1] * siluf(bfhi(gv.z)));
            r.w = pk2h(o[c8 * 8 + 6] * rstd * g1[2] * siluf(bflo(gv.w)), o[c8 * 8 + 7] * rstd * g1[3] * siluf(bfhi(gv.w)));
            *(u32x4*)(mp + c8 * 8) = r;
        }
    }
    __syncthreads();
}
constexpr int N_PHASES = 20;
#ifndef PROBE_MASK
#define PROBE_MASK 0u
#endif
#ifndef PROBE_U
#define PROBE_U 0
#endif
#ifndef STAGGER
#define STAGGER 0
#endif
#ifndef STAGGER_TICKS
#define STAGGER_TICKS 1000u
#endif
#ifndef PROBE_SYNC2
#define PROBE_SYNC2 0
#endif
__device__ __forceinline__ void stagger_half(unsigned ticks) {
#if STAGGER
    if ((blockIdx.x >> 3) & 1) { const unsigned long long t0 = __builtin_amdgcn_s_memrealtime(); while (__builtin_amdgcn_s_memrealtime() - t0 < ticks) __builtin_amdgcn_s_sleep(32); }
    __syncthreads();
#endif
}
__device__ __forceinline__ void run_phase(const Params& P, LAS unsigned char* lds, int ph) {
    unsigned char* ws = P.ws;
    if (ph == 0) { phase_prologue(P, lds); return; }
    if (ph == N_PHASES - 1) { phase_norm<true, true>(P.out, (const bf16_t*)(ws + WS_OB), (const float*)(ws + WS_MOD) + (size_t)(DEPTH - 1) * NBATCH * NMOD * DM + 5 * DM, P.out, P.g_final, nullptr, nullptr, nullptr); return; }
    const int l = (ph - 1) / 9, s = (ph - 1) % 9;
    const float* mod = (const float*)(ws + WS_MOD) + (size_t)l * NBATCH * NMOD * DM;
    bf16_t* hbuf = (bf16_t*)(ws + WS_HBUF); bf16_t* proj = (bf16_t*)(ws + WS_PROJ); bf16_t* ybuf = (bf16_t*)(ws + WS_OB);
#ifdef PH_ONLY
    if (s != PH_ONLY) return;
#endif
    int kD = DM, kF = FFN; asm volatile("" : "+s"(kD), "+s"(kF));
    switch (s) {
    case 0: if (l == 0) { phase_norm<false, false>(P.x, nullptr, nullptr, nullptr, P.g_mix, mod + 0 * DM, mod + 1 * DM, hbuf); phase_weights(P, lds); }
            else phase_norm<true, false>(P.out, ybuf, mod - (size_t)NBATCH * NMOD * DM + 5 * DM, P.out, P.g_mix + l * DM, mod + 0 * DM, mod + 1 * DM, hbuf);
            break;
    case 1: { pg8::Gemm g{hbuf, (const bf16_t*)(ws + WS_WIN) + (size_t)l * INWP * DM, NTOK, INWP, kD}; pg8::StaticOrder S; S.init(NTOK, INWP, gridDim.x, blockIdx.x);
              EpiProj E{proj, INW, INW}; pg8::gemm_phase<EpiProj, pg8::StaticOrder>(lds, g, S, E, nullptr); } break;
    case 2: { for (int rp = 0; rp < (PROBE_U == 1 ? 2 : 1); ++rp) att_phase(P, lds);
              for (int rp = 0; rp < (PROBE_U == 2 ? 2 : 1); ++rp) retA_phase(P, lds);
              for (int rp = 0; rp < (PROBE_U == 3 ? 2 : 1); ++rp) for (int u = blockIdx.x; u < 1024; u += gridDim.x) hgA_unit(P, lds, u, l); } break;
    case 3: { ret_scan(P); hg_scan(P); } break;
    case 4: { for (int rp = 0; rp < (PROBE_U == 4 ? 2 : 1); ++rp) for (int u = blockIdx.x; u < 256; u += gridDim.x) hgB_unit(P, lds, u, l);
              for (int rp = 0; rp < (PROBE_U == 5 ? 2 : 1); ++rp) retB_phase(P, lds, l); att_merge(P); } break;
    case 5: { pg8::Gemm g{hbuf, (const bf16_t*)(ws + WS_WOUT) + (size_t)l * DM * DM, NTOK, DM, kD}; pg8::StaticOrder S; S.init(NTOK, DM, gridDim.x, blockIdx.x);
              EpiProj E{ybuf, DM, DM}; pg8::gemm_phase<EpiProj, pg8::StaticOrder>(lds, g, S, E, nullptr); } break;
    case 6: phase_norm<true, false>(l == 0 ? P.x : P.out, ybuf, mod + 2 * DM, P.out, P.g_ffn + l * DM, mod + 3 * DM, mod + 4 * DM, hbuf); break;
    case 7: { pg8::Gemm g{hbuf, (const bf16_t*)(ws + WS_WGU) + (size_t)l * 2 * FFN * DM, NTOK, 2 * FFN, kD}; pg8::StaticOrder S; S.init(NTOK, 2 * FFN, gridDim.x, blockIdx.x);
              EpiSwiglu E{proj}; pg8::gemm_phase<EpiSwiglu, pg8::StaticOrder>(lds, g, S, E, nullptr); } break;
    case 8: { pg8::Gemm g{proj, (const bf16_t*)(ws + WS_WDN) + (size_t)l * DM * FFN, NTOK, DM, kF}; pg8::StaticOrder S; S.init(NTOK, DM, gridDim.x, blockIdx.x);
              EpiProj E{ybuf, DM, DM}; pg8::gemm_phase<EpiProj, pg8::StaticOrder>(lds, g, S, E, nullptr); } break;
    }
}
__global__ void __launch_bounds__(NTHREADS) hybrid_fwd(Params P) {
    extern __shared__ __attribute__((aligned(16))) unsigned char lds_raw[];
    __shared__ uint4 xb_words;
    LAS unsigned char* lds = (LAS unsigned char*)lds_raw;
    if (threadIdx.x == 0) xb_words = make_uint4(0u, 0u, 0u, 0u);
    __syncthreads();
    XcdBarrier bar = xcd_barrier_post((unsigned*)(P.ws + WS_CTL), (volatile LAS unsigned*)&xb_words);
    for (int ph = P.ph_lo; ph < P.ph_hi; ++ph) {
        const int reps = ((PROBE_MASK >> ph) & 1u) ? 2 : 1;
        for (int rep = 0; rep < reps; ++rep) { run_phase(P, lds, ph); if (rep + 1 < reps) __syncthreads(); }
        if (ph + 1 < P.ph_hi) {
            if (P.ph_hi > N_PHASES) cg::this_grid().sync(); else xcd_barrier(bar);
            if (PROBE_SYNC2) xcd_barrier(bar);
        }
    }
}

extern "C" void kernel_launch(void* const* d_in, const int* in_sizes, int n_in, void* d_out, int out_size, void* d_ws, size_t ws_size, hipStream_t stream) {
    static int grid = 0;
    if (grid == 0) {
        if (n_in != 14 || out_size != NTOK * DM || ws_size < WS_END) { fprintf(stderr, "kernel_launch: unexpected shapes (n_in %d out %d ws %zu need %zu)\n", n_in, out_size, ws_size, (size_t)WS_END); grid = -1; return; }
        int dev = 0, cus = 0, per_cu = 0;
        hipGetDevice(&dev); hipDeviceGetAttribute(&cus, hipDeviceAttributeMultiprocessorCount, dev);
        if (hipFuncSetAttribute((const void*)hybrid_fwd, hipFuncAttributeMaxDynamicSharedMemorySize, LDS_BYTES) != hipSuccess) { fprintf(stderr, "kernel_launch: hipFuncSetAttribute failed\n"); grid = -1; return; }
        if (hipOccupancyMaxActiveBlocksPerMultiprocessor(&per_cu, (const void*)hybrid_fwd, NTHREADS, LDS_BYTES) != hipSuccess || per_cu < 1) { fprintf(stderr, "kernel_launch: occupancy query says %d\n", per_cu); grid = -1; return; }
        grid = cus;
    }
    if (grid < 0) return;
    if (hipMemsetAsync((char*)d_ws + WS_CTL, 0, 16384, stream) != hipSuccess) { fprintf(stderr, "kernel_launch: memset failed\n"); return; }
    Params p{};
    p.x = (const float*)d_in[0]; p.c = (const float*)d_in[1]; p.w_ada = (const float*)d_in[2]; p.b_ada = (const float*)d_in[3]; p.g_mix = (const float*)d_in[4];
    p.w_in = (const float*)d_in[5]; p.ret_gn = (const float*)d_in[6]; p.hgrn_gn = (const float*)d_in[7]; p.lb_logits = (const float*)d_in[8]; p.w_out = (const float*)d_in[9];
    p.g_ffn = (const float*)d_in[10]; p.w_gu = (const float*)d_in[11]; p.w_down = (const float*)d_in[12]; p.g_final = (const float*)d_in[13];
    p.out = (float*)d_out; p.ws = (unsigned char*)d_ws;
#if ONE_LAUNCH
    p.ph_lo = 0; p.ph_hi = N_PHASES;
    void* args[] = {&p};
    hipError_t e = hipLaunchCooperativeKernel((const void*)hybrid_fwd, dim3(grid), dim3(NTHREADS), args, LDS_BYTES, stream);
    if (e != hipSuccess) fprintf(stderr, "cooperative launch failed: %s (grid %d)\n", hipGetErrorString(e), grid);
#else
    for (int ph = 0; ph < N_PHASES; ++ph) { p.ph_lo = ph; p.ph_hi = ph + 1; hipLaunchKernelGGL(hybrid_fwd, dim3(grid), dim3(NTHREADS), LDS_BYTES, stream, p); }
#endif
}
```

```cpp
#include <hip/hip_runtime.h>
#include <hip/hip_cooperative_groups.h>
#include <cstdio>
#include <cstdint>
namespace cg = cooperative_groups;
#ifndef ONE_LAUNCH
#define ONE_LAUNCH 1
#endif
__device__ __forceinline__ int opaque_tid() { int t = threadIdx.x; asm volatile("" : "+v"(t)); return t; }
#define LAS __attribute__((address_space(3)))
namespace pg8 {
#define PG8_LAS __attribute__((address_space(3)))
typedef unsigned short bf16_t;
typedef short bf16x8 __attribute__((ext_vector_type(8)));
typedef float f32x4 __attribute__((ext_vector_type(4)));
typedef unsigned u32x4 __attribute__((ext_vector_type(4)));
constexpr int BM = 256, BK = 64, HALF = 128, HTB = HALF * BK * 2  , STAGE_BYTES = 8 * HTB, NXCD = 8, WGM = 8;

__host__ __device__ __forceinline__ int lds_byte(int r, int c) { const int st = (r >> 4) * 2 + (c >> 5), rr = r & 15, cc = c & 31, ob = rr * 64 + cc * 2; return st * 1024 + (ob ^ (((ob >> 9) & 1) << 5)); }
__host__ __device__ __forceinline__ void stage_rc(int b, int& R, int& C) { const int st = b / 1024, sb = b % 1024, swz = sb ^ (((sb >> 9) & 1) << 5); R = (st >> 1) * 16 + swz / 64; C = (st & 1) * 32 + (swz % 64) / 2; }
__host__ __device__ __forceinline__ int perm32(int rho) { const int n = rho >> 4, i = rho & 15; return 8 * (i >> 2) + 4 * n + (i & 3); }

struct Unit { int pm, pn; };
struct Gemm { const bf16_t* A; const bf16_t* Bt; int M, N, K; };

struct StaticOrder {
    int nM, nN, nwg, G, c;
    __host__ __device__ void init(int M, int N, int G_, int c_) { nM = M / BM; nN = N / BM; nwg = nM * nN; G = G_; c = c_; }
    __host__ __device__ bool next(int i, Unit& u) const {
        const long L = (long)i * G + c; if (L >= nwg) return false;
        int wgid = (int)L; { const int q = nwg / NXCD, r = nwg % NXCD, xcd = wgid % NXCD, off = wgid / NXCD; wgid = (xcd < r ? xcd * (q + 1) : r * (q + 1) + (xcd - r) * q) + off; }
        const int nig = WGM * nN, gid = wgid / nig, fm = gid * WGM, gsz = (nM - fm) < WGM ? (nM - fm) : WGM;
        u.pm = fm + ((wgid % nig) % gsz); u.pn = (wgid % nig) / gsz; return true;
    }
    __device__ __forceinline__ void a_ready(const Unit&) const {}
    __device__ __forceinline__ void done(const Unit&) const {}
};
__device__ __forceinline__ unsigned cvt_pk_bf16(float lo, float hi) { unsigned r; asm volatile("v_cvt_pk_bf16_f32 %0, %1, %2" : "=v"(r) : "v"(lo), "v"(hi)); return r; }
typedef float f32x2 __attribute__((ext_vector_type(2)));
template <class Epi, class Sched, bool STAMP = false>
__device__ __forceinline__ void gemm_phase(PG8_LAS unsigned char* lds, const Gemm g, const Sched& S, const Epi& E, unsigned long long* stamps) {
    const int tid = opaque_tid(), wid = __builtin_amdgcn_readfirstlane(tid >> 6), lane = tid & 63, wr = wid >> 2, wc = wid & 3, fr = lane & 15, fq = lane >> 4;
    const int K = g.K, nt = K / BK;
    int ts_lo = 0, ts_hi = 0, nts = 0; const unsigned long long rt_entry = STAMP ? (unsigned long long)wall_clock64() : 0ull;
#define PG8_STAMP() do { if (STAMP && wid == 0 && nts < 64) { const unsigned long long _c = (unsigned long long)clock64(); \
        ts_lo = (lane == nts) ? (int)(unsigned)_c : ts_lo; ts_hi = (lane == nts) ? (int)(unsigned)(_c >> 32) : ts_hi; ++nts; } } while (0)
    PG8_STAMP();
    unsigned voffA[2], voffB[2];
#pragma unroll
    for (int i = 0; i < 2; ++i) { int R, C; stage_rc(tid * 16 + i * 8192, R, C); const int Rb = Epi::PERM ? ((R & ~31) + perm32(R & 31)) : R;
        voffA[i] = (unsigned)(R * K + C) * 2u; voffB[i] = (unsigned)(Rb * K + C) * 2u; }
    const size_t kstep = (size_t)(BK * 2);
    const size_t hstep = (size_t)HALF * K * 2;
    const size_t tstep = 2 * hstep;
    const unsigned ldsw = (unsigned)wid * 1024u;
    const int aoff = lds_byte(wr * 64 + fr, fq * 8), boff = lds_byte(wc * 32 + fr, fq * 8);
#define PG8_SA(b, h) (((b) * 2 + (h)) * HTB)
#define PG8_SB(b, h) ((4 + (b) * 2 + (h)) * HTB)
#define PG8_STAGE(bufoff, gbase, voff) do { _Pragma("unroll") for (int _i = 0; _i < 2; ++_i) \
        __builtin_amdgcn_global_load_lds((const unsigned*)((const char*)(gbase) + (voff)[_i]), (PG8_LAS unsigned*)(lds + (bufoff) + ldsw + _i * 8192), 16, 0, 0); } while (0)
#define PG8_LDA(dst, b, h) do { _Pragma("unroll") for (int m = 0; m < 4; ++m) _Pragma("unroll") for (int k = 0; k < 2; ++k) dst[m][k] = *(const PG8_LAS bf16x8*)(lds + PG8_SA(b, h) + aoff + m * 2048 + k * 1024); } while (0)
#define PG8_LDB(dst, b, h) do { _Pragma("unroll") for (int n = 0; n < 2; ++n) _Pragma("unroll") for (int k = 0; k < 2; ++k) dst[n][k] = *(const PG8_LAS bf16x8*)(lds + PG8_SB(b, h) + boff + n * 2048 + k * 1024); } while (0)
#define PG8_MMA(ai, bj, At, Bt) do { __builtin_amdgcn_s_setprio(1); _Pragma("unroll") for (int m = 0; m < 4; ++m) _Pragma("unroll") for (int n = 0; n < 2; ++n) _Pragma("unroll") for (int k = 0; k < 2; ++k) \
        acc[ai][bj][m][n] = __builtin_amdgcn_mfma_f32_16x16x32_bf16(Bt[n][k], At[m][k], acc[ai][bj][m][n], 0, 0, 0); __builtin_amdgcn_s_setprio(0); } while (0)
#define PG8_WAIT_V(n) asm volatile("s_waitcnt vmcnt(" #n ")" ::: "memory")
#define PG8_WAIT_L(n) asm volatile("s_waitcnt lgkmcnt(" #n ")" ::: "memory")
#define PG8_BAR __builtin_amdgcn_s_barrier()
#define PG8_SCHED __builtin_amdgcn_sched_barrier(0)
    Unit cur, nxt; int ui = 0;
    if (!S.next(0, cur)) return;
    f32x4 acc[2][2][4][2];
#pragma unroll
    for (int a = 0; a < 2; ++a)
#pragma unroll
        for (int b = 0; b < 2; ++b)
#pragma unroll
            for (int m = 0; m < 4; ++m)
#pragma unroll
                for (int n = 0; n < 2; ++n) acc[a][b][m][n] = (f32x4){0.f, 0.f, 0.f, 0.f};
    bf16x8 At[4][2], B0[2][2], B1[2][2];
    const char* cA = (const char*)g.A + (size_t)cur.pm * tstep; const char* cB = (const char*)g.Bt + (size_t)cur.pn * tstep;
    S.a_ready(cur);
    PG8_STAGE(PG8_SB(0, 0), cB, voffB); PG8_STAGE(PG8_SA(0, 0), cA, voffA); PG8_STAGE(PG8_SB(0, 1), cB + hstep, voffB); PG8_STAGE(PG8_SA(0, 1), cA + hstep, voffA);
    if (wr == 1) PG8_BAR;
    PG8_WAIT_V(4); PG8_BAR;
    PG8_STAGE(PG8_SB(1, 0), cB + kstep, voffB); PG8_STAGE(PG8_SA(1, 0), cA + kstep, voffA); PG8_STAGE(PG8_SB(1, 1), cB + hstep + kstep, voffB);
    PG8_WAIT_V(6); PG8_BAR;
    PG8_STAMP();
    for (;;) {
        const bool has_next = S.next(ui + 1, nxt);
        const char* nA = has_next ? (const char*)g.A + (size_t)nxt.pm * tstep : cA; const char* nB = has_next ? (const char*)g.Bt + (size_t)nxt.pn * tstep : cB;
        for (int t = 0; t < nt; t += 2) {
            const bool last = (t == nt - 2);
            const char* a1 = cA + (size_t)(t + 1) * kstep;
            const char* a2 = last ? nA : cA + (size_t)(t + 2) * kstep; const char* b2 = last ? nB : cB + (size_t)(t + 2) * kstep;
            const char* a3 = a2 + kstep; const char* b3 = b2 + kstep;
            if (last && has_next) S.a_ready(nxt);
            PG8_LDB(B0, 0, 0); PG8_SCHED; PG8_LDA(At, 0, 0); PG8_STAGE(PG8_SA(1, 1), a1 + hstep, voffA);
            PG8_WAIT_L(8); PG8_BAR; PG8_WAIT_L(0); PG8_MMA(0, 0, At, B0); PG8_BAR; PG8_SCHED;
            PG8_LDB(B1, 0, 1); PG8_STAGE(PG8_SB(0, 0), b2, voffB);
            PG8_BAR; PG8_WAIT_L(0); PG8_MMA(0, 1, At, B1); PG8_BAR;
            PG8_LDA(At, 0, 1); PG8_STAGE(PG8_SA(0, 0), a2, voffA);
            PG8_BAR; PG8_WAIT_L(0); PG8_MMA(1, 0, At, B0); PG8_BAR; PG8_SCHED;
            PG8_STAGE(PG8_SB(0, 1), b2 + hstep, voffB);
            PG8_WAIT_V(6); PG8_BAR; PG8_MMA(1, 1, At, B1); PG8_BAR;
            PG8_LDB(B0, 1, 0); PG8_SCHED; PG8_LDA(At, 1, 0); PG8_STAGE(PG8_SA(0, 1), a2 + hstep, voffA);
            PG8_WAIT_L(8); PG8_BAR; PG8_WAIT_L(0); PG8_MMA(0, 0, At, B0); PG8_BAR; PG8_SCHED;
            PG8_LDB(B1, 1, 1); PG8_STAGE(PG8_SB(1, 0), b3, voffB);
            PG8_BAR; PG8_WAIT_L(0); PG8_MMA(0, 1, At, B1); PG8_BAR;
            PG8_LDA(At, 1, 1); PG8_STAGE(PG8_SA(1, 0), a3, voffA);
            PG8_BAR; PG8_WAIT_L(0); PG8_MMA(1, 0, At, B0); PG8_BAR; PG8_SCHED;
            PG8_STAGE(PG8_SB(1, 1), b3 + hstep, voffB);
            PG8_WAIT_V(6); PG8_BAR; PG8_MMA(1, 1, At, B1); PG8_BAR;
        }
        PG8_STAMP();
        if constexpr (!Epi::AFTER_DRAIN) { E(acc, cur, wr, wc, fr, fq); S.done(cur); }
        PG8_STAMP();
        if (!has_next) break;
#pragma unroll
        for (int a = 0; a < 2; ++a)
#pragma unroll
            for (int b = 0; b < 2; ++b)
#pragma unroll
                for (int m = 0; m < 4; ++m)
#pragma unroll
                    for (int n = 0; n < 2; ++n) acc[a][b][m][n] = (f32x4){0.f, 0.f, 0.f, 0.f};
        cur = nxt; cA = nA; cB = nB; ++ui;
    }
    PG8_WAIT_V(0);
    if (wr == 0) PG8_BAR;
    PG8_BAR;
    if constexpr (Epi::AFTER_DRAIN) { E.fused(acc, cur, wr, wc, fr, fq, lds, wid, lane); S.done(cur); }
    PG8_STAMP();
    if (STAMP && wid == 0) { stamps[lane] = lane < nts ? (((unsigned long long)(unsigned)ts_hi << 32) | (unsigned)ts_lo) : 0ull;
        if (lane == 62) stamps[62] = rt_entry; if (lane == 63) stamps[63] = (unsigned long long)wall_clock64(); }
#undef PG8_STAMP
#undef PG8_SA
#undef PG8_SB
#undef PG8_STAGE
#undef PG8_LDA
#undef PG8_LDB
#undef PG8_MMA
#undef PG8_WAIT_V
#undef PG8_WAIT_L
#undef PG8_BAR
#undef PG8_SCHED
}
}
#define XB_TMO      128
#define XB_XCNT(j)  (256  + 64 * (j))
#define XB_XSUB(j)  (1280 + 64 * (j))
#define XB_XGEN(j)  (2304 + 64 * (j))
#define XB_TOP      3328
#define XB_TOPGEN   3392
#define XCD_BAR_WORDS 3456
#define XB_SPIN_CAP (1u << 18)

__device__ __forceinline__ unsigned xb_ld(unsigned* p)              { return __hip_atomic_load(p, __ATOMIC_RELAXED, __HIP_MEMORY_SCOPE_AGENT); }
__device__ __forceinline__ unsigned xb_add(unsigned* p, unsigned v) { return __hip_atomic_fetch_add(p, v, __ATOMIC_RELAXED, __HIP_MEMORY_SCOPE_AGENT); }
__device__ __forceinline__ unsigned xb_xcc_id() { return (unsigned)__builtin_amdgcn_s_getreg((3 << 11) | 20) & 0xFu; }
#define XB_SPIN(cond, bar) do { unsigned _sp = 0; while (cond) { __builtin_amdgcn_s_sleep(1); \
    if ((++_sp & 255u) == 0u) { if (xb_ld(&(bar)[XB_TMO])) break; if (_sp > XB_SPIN_CAP) { atomicAdd(&(bar)[XB_TMO], 1u); break; } } } } while (0)

struct XcdBarrier {
    unsigned* bar; unsigned x;
    volatile LAS unsigned* st;
};

__device__ __forceinline__ XcdBarrier xcd_barrier_post(unsigned* bar, volatile LAS unsigned* st) {
    XcdBarrier b; b.bar = bar; b.x = xb_xcc_id(); b.st = st;
    if (threadIdx.x == 0) (void)xb_add(&bar[XB_XCNT(b.x)], 1u);
    return b;
}
__device__ __forceinline__ void xcd_barrier_complete(unsigned* bar, unsigned x, unsigned& nloc, unsigned& nx) {
    const unsigned G = gridDim.x * gridDim.y * gridDim.z;
    unsigned sum, cnt, mine, sp = 0u;
    for (;;) {
        sum = 0u; cnt = 0u; mine = 0u;
#pragma unroll
        for (unsigned j = 0; j < 16; ++j) { const unsigned c = xb_ld(&bar[XB_XCNT(j)]); sum += c; cnt += (c > 0u) ? 1u : 0u; mine = (j == x) ? c : mine; }
        if (sum == G) break;
        __builtin_amdgcn_s_sleep(1);
        if ((++sp & 255u) == 0u) { if (xb_ld(&bar[XB_TMO])) break; if (sp > XB_SPIN_CAP) { atomicAdd(&bar[XB_TMO], 1u); break; } }
    }
    nloc = mine > 0u ? mine : 1u; nx = cnt > 0u ? cnt : 1u;
}

__device__ __forceinline__ void xcd_barrier(const XcdBarrier& b) {
    asm volatile("s_waitcnt vmcnt(0)" ::: "memory");
    __syncthreads();
    if (threadIdx.x == 0) {
        unsigned* bar = b.bar;
        __builtin_amdgcn_s_waitcnt(0);
        unsigned nloc = b.st[0], nx = b.st[1];
        if (nloc == 0u) { xcd_barrier_complete(bar, b.x, nloc, nx); b.st[0] = nloc; b.st[1] = nx; }
        const unsigned old = xb_add(&bar[XB_XSUB(b.x)], 1u);
        const unsigned gen = old / nloc;
        if (old + 1u == (gen + 1u) * nloc) {
            __builtin_amdgcn_fence(__ATOMIC_RELEASE, "agent");
            asm volatile("s_waitcnt vmcnt(0)" ::: "memory");
            const unsigned og = xb_add(&bar[XB_TOP], 1u);
            const unsigned tg = og / nx;
            if (og + 1u == (tg + 1u) * nx) xb_add(&bar[XB_TOPGEN], 1u);
            else XB_SPIN(xb_ld(&bar[XB_TOPGEN]) == tg, bar);
            __builtin_amdgcn_fence(__ATOMIC_ACQUIRE, "agent");
            xb_add(&bar[XB_XGEN(b.x)], 1u);
            asm volatile("s_waitcnt vmcnt(0)" ::: "memory");
        } else {
            XB_SPIN(xb_ld(&bar[XB_XGEN(b.x)]) == gen, bar);
            __builtin_amdgcn_fence(__ATOMIC_ACQUIRE, "agent");
            asm volatile("s_waitcnt vmcnt(0)" ::: "memory");
        }
    }
    __syncthreads();
}

typedef unsigned short bf16_t;
typedef short bf16x8 __attribute__((ext_vector_type(8)));
typedef short bf16x4 __attribute__((ext_vector_type(4)));
typedef float f32x4 __attribute__((ext_vector_type(4)));
typedef unsigned u32x4 __attribute__((ext_vector_type(4)));
typedef unsigned u32x2 __attribute__((ext_vector_type(2)));
constexpr int DM = 1024, NBATCH = 8, SEQ = 4096, NTOK = NBATCH * SEQ, DEPTH = 2;
constexpr int INW = 3968, INWP = 4096, FFN = 2816, NMOD = 6;
constexpr int C_AQ = 0, C_AK = 384, C_AV = 768, C_RQ = 1152, C_RK = 1536, C_RV = 1920, C_RG = 2304, C_HQ = 2688, C_HZF = 2944, C_HZB = 3200, C_HI = 3456, C_HG = 3712;
constexpr float NORM_EPS = 1e-6f;
constexpr int NTHREADS = 512;
constexpr int LDS_BYTES = 135168;
constexpr size_t WS_CTL = 0, WS_MOD = 16384, WS_LB = WS_MOD + 393216, WS_HGA = WS_LB + 2048, WS_LSE = WS_HGA + 524288, WS_WIN = WS_LSE + 2359296,
    WS_WOUT = WS_WIN + 16777216, WS_WGU = WS_WOUT + 4194304, WS_WDN = WS_WGU + 23068672, WS_HBUF = WS_WDN + 11534336, WS_PROJ = WS_HBUF + 67108864,
    WS_OB = WS_PROJ + 260046848, WS_RST = WS_OB + 75497472, WS_HGU = WS_RST + 25165824, WS_END = WS_HGU + 33554432;

struct Params {
    const float *x, *c, *w_ada, *b_ada, *g_mix, *w_in, *ret_gn, *hgrn_gn, *lb_logits, *w_out, *g_ffn, *w_gu, *w_down, *g_final;
    float* out; unsigned char* ws; int ph_lo, ph_hi;
};

__device__ __forceinline__ float bf2f(bf16_t v) { return __uint_as_float(((unsigned)v) << 16); }
__device__ __forceinline__ float bflo(unsigned w) { return __uint_as_float(w << 16); }
__device__ __forceinline__ float bfhi(unsigned w) { return __uint_as_float(w & 0xffff0000u); }
__device__ __forceinline__ bf16_t f2bf(float f) { return __builtin_bit_cast(bf16_t, (__bf16)f); }
typedef float f32x2c __attribute__((ext_vector_type(2)));
typedef __bf16 bf16v2c __attribute__((ext_vector_type(2)));
__device__ __forceinline__ unsigned pk2(float lo, float hi) { const f32x2c v = {lo, hi}; return __builtin_bit_cast(unsigned, __builtin_convertvector(v, bf16v2c)); }
__device__ __forceinline__ bf16x4 pk4(f32x4 v) { u32x2 w; w.x = pk2(v[0], v[1]); w.y = pk2(v[2], v[3]); return __builtin_bit_cast(bf16x4, w); }
__device__ __forceinline__ float siluf(float v) { return v * __builtin_amdgcn_rcpf(1.0f + __expf(-v)); }
__device__ __forceinline__ float wave_sum(float v) {
#pragma unroll
    for (int o = 1; o < 64; o <<= 1) v += __shfl_xor(v, o);
    return v;
}
#define MFMA32(a, b, c) __builtin_amdgcn_mfma_f32_16x16x32_bf16((a), (b), (c), 0, 0, 0)
#define MFMA16(a, b, c) __builtin_amdgcn_mfma_f32_16x16x16bf16_1k((a), (b), (c), 0, 0, 0)

struct EpiProj {
    static constexpr bool PERM = true, AFTER_DRAIN = false;
    bf16_t* O; int ldc, ncols;
    __device__ __forceinline__ void operator()(const f32x4 (&acc)[2][2][4][2], const pg8::Unit& u, int wr, int wc, int fr, int fq) const {
        const int row0 = u.pm * 256 + wr * 64 + fr, col0 = u.pn * 256 + wc * 32 + 8 * fq;
#pragma unroll
        for (int ai = 0; ai < 2; ++ai)
#pragma unroll
            for (int m = 0; m < 4; ++m) { bf16_t* rowp = O + (size_t)(row0 + ai * 128 + m * 16) * ldc + col0;
#pragma unroll
                for (int bj = 0; bj < 2; ++bj) { if (col0 + bj * 128 < ncols) { const f32x4 v0 = acc[ai][bj][m][0], v1 = acc[ai][bj][m][1];
                    u32x4 w; w.x = pk2(v0[0], v0[1]); w.y = pk2(v0[2], v0[3]); w.z = pk2(v1[0], v1[1]); w.w = pk2(v1[2], v1[3]);
                    *(u32x4*)(rowp + bj * 128) = w; } } }
    }
};
struct EpiRes {
    static constexpr bool PERM = false, AFTER_DRAIN = false;
    const float* base; float* out; const float* gate;
    __device__ __forceinline__ void operator()(const f32x4 (&acc)[2][2][4][2], const pg8::Unit& u, int wr, int wc, int fr, int fq) const {
        const int row0 = u.pm * 256 + wr * 64 + fr, col0 = u.pn * 256 + wc * 32 + 4 * fq;
        const float* gp = gate + (size_t)((u.pm * 256) >> 12) * (NMOD * DM) + col0;
        f32x4 gv[2][2];
#pragma unroll
        for (int bj = 0; bj < 2; ++bj)
#pragma unroll
            for (int n = 0; n < 2; ++n) gv[bj][n] = *(const f32x4*)(gp + bj * 128 + n * 16);
#pragma unroll
        for (int ai = 0; ai < 2; ++ai)
#pragma unroll
            for (int m = 0; m < 4; ++m) { const size_t off = (size_t)(row0 + ai * 128 + m * 16) * DM + col0;
#pragma unroll
                for (int bj = 0; bj < 2; ++bj)
#pragma unroll
                    for (int n = 0; n < 2; ++n) { const f32x4 bs = *(const f32x4*)(base + off + bj * 128 + n * 16);
                        *(f32x4*)(out + off + bj * 128 + n * 16) = bs + gv[bj][n] * acc[ai][bj][m][n]; } }
    }
};
struct EpiSwiglu {
    static constexpr bool PERM = true, AFTER_DRAIN = false;
    bf16_t* O;
    __device__ __forceinline__ void operator()(const f32x4 (&acc)[2][2][4][2], const pg8::Unit& u, int wr, int wc, int fr, int fq) const {
        const int row0 = u.pm * 256 + wr * 64 + fr, col0 = u.pn * 128 + wc * 32 + 8 * fq;
#pragma unroll
        for (int ai = 0; ai < 2; ++ai)
#pragma unroll
            for (int m = 0; m < 4; ++m) { bf16_t* rowp = O + (size_t)(row0 + ai * 128 + m * 16) * FFN + col0;
                float r[8];
#pragma unroll
                for (int n = 0; n < 2; ++n)
#pragma unroll
                    for (int i = 0; i < 4; ++i) { const float g = acc[ai][0][m][n][i], uu = acc[ai][1][m][n][i]; r[n * 4 + i] = siluf(g) * uu; }
                u32x4 w; w.x = pk2(r[0], r[1]); w.y = pk2(r[2], r[3]); w.z = pk2(r[4], r[5]); w.w = pk2(r[6], r[7]);
                *(u32x4*)rowp = w; }
    }
};
__device__ __forceinline__ void transpose_item(const float* W, int K, int N, bf16_t* WT, int dst_row0, int src_col0, int k0, LAS float* scr, int lane) {
    const int c = lane & 7, nr = lane >> 3;
    if (src_col0 < 0) {
#pragma unroll
        for (int j = 0; j < 8; ++j) *(u32x4*)(WT + (size_t)(dst_row0 + nr + 8 * j) * K + k0 + 8 * c) = (u32x4){0u, 0u, 0u, 0u};
        return;
    }
    const int kr = lane >> 4, c4 = lane & 15;
    f32x4 v[16];
#pragma unroll
    for (int i = 0; i < 16; ++i) v[i] = *(const f32x4*)(W + (size_t)(k0 + 4 * i + kr) * N + src_col0 + 4 * c4);
#pragma unroll
    for (int i = 0; i < 16; ++i) { LAS float* d = scr + (4 * i + kr) * 65 + 4 * c4; d[0] = v[i][0]; d[1] = v[i][1]; d[2] = v[i][2]; d[3] = v[i][3]; }
    __builtin_amdgcn_fence(__ATOMIC_RELEASE, "wavefront"); __builtin_amdgcn_wave_barrier(); __builtin_amdgcn_fence(__ATOMIC_ACQUIRE, "wavefront");
#pragma unroll
    for (int j = 0; j < 8; ++j) { const int n = nr + 8 * j; const LAS float* sp = scr + (8 * c) * 65 + n;
        u32x4 o; o.x = pk2(sp[0 * 65], sp[1 * 65]); o.y = pk2(sp[2 * 65], sp[3 * 65]); o.z = pk2(sp[4 * 65], sp[5 * 65]); o.w = pk2(sp[6 * 65], sp[7 * 65]);
        *(u32x4*)(WT + (size_t)(dst_row0 + n) * K + k0 + 8 * c) = o; }
    __builtin_amdgcn_fence(__ATOMIC_RELEASE, "wavefront"); __builtin_amdgcn_wave_barrier(); __builtin_amdgcn_fence(__ATOMIC_ACQUIRE, "wavefront");
}

__device__ __forceinline__ void phase_weights(const Params& P, LAS unsigned char* lds) {
    const int tid = opaque_tid(), lane = tid & 63, wave = __builtin_amdgcn_readfirstlane(tid >> 6);
    unsigned char* ws = P.ws;
    {
        LAS float* scr = (LAS float*)(lds + wave * 16640);
        const int gw = blockIdx.x * 8 + wave, NGW = gridDim.x * 8;
        constexpr int I_IN = 16 * 64, I_OUT = 16 * 16, I_GU = 16 * 88, I_DN = 44 * 16, I_L = I_IN + I_OUT + I_GU + I_DN;
        for (int it = gw; it < DEPTH * I_L; it += NGW) {
            const int l = it / I_L; int r = it % I_L;
            if (r < I_IN) { const int kb = r / 64, nb = r % 64, n0 = nb * 64;
                transpose_item(P.w_in + (size_t)l * DM * INW, DM, INW, (bf16_t*)(ws + WS_WIN) + (size_t)l * INWP * DM, n0, n0 < INW ? n0 : -1, kb * 64, scr, lane); continue; }
            r -= I_IN;
            if (r < I_OUT) { const int kb = r / 16, nb = r % 16;
                transpose_item(P.w_out + (size_t)l * DM * DM, DM, DM, (bf16_t*)(ws + WS_WOUT) + (size_t)l * DM * DM, nb * 64, nb * 64, kb * 64, scr, lane); continue; }
            r -= I_OUT;
            if (r < I_GU) { const int kb = r / 88, nb = r % 88, n0 = nb * 64; const int pn = n0 >> 8, half = (n0 >> 7) & 1, jj = n0 & 127;
                transpose_item(P.w_gu + (size_t)l * DM * 2 * FFN, DM, 2 * FFN, (bf16_t*)(ws + WS_WGU) + (size_t)l * 2 * FFN * DM, n0, half * FFN + pn * 128 + jj, kb * 64, scr, lane); continue; }
            r -= I_GU;
            { const int kb = r / 16, nb = r % 16;
                transpose_item(P.w_down + (size_t)l * FFN * DM, FFN, DM, (bf16_t*)(ws + WS_WDN) + (size_t)l * DM * FFN, nb * 64, nb * 64, kb * 64, scr, lane); }
        }
    }
}
__device__ __forceinline__ void phase_prologue(const Params& P, LAS unsigned char* lds) {
    const int tid = opaque_tid();
    unsigned char* ws = P.ws;
    {
        LAS float* sc = (LAS float*)lds;
        LAS float* red = (LAS float*)(lds + 32768);
        for (int i = tid; i < NBATCH * DM; i += NTHREADS) sc[i] = siluf(P.c[i]);
        __syncthreads();
        float* mod = (float*)(ws + WS_MOD);
        for (int u = blockIdx.x; u < DEPTH * 96; u += gridDim.x) {
            const int l = u / 96, j0 = (u % 96) * 64, col = tid & 63, kp = tid >> 6;
            float acc[8];
#pragma unroll
            for (int b = 0; b < 8; ++b) acc[b] = 0.f;
            const float* wp = P.w_ada + (size_t)l * DM * (NMOD * DM) + j0 + col;
            for (int k = kp * 128; k < kp * 128 + 128; ++k) { const float w = wp[(size_t)k * (NMOD * DM)];
#pragma unroll
                for (int b = 0; b < 8; ++b) acc[b] += sc[b * DM + k] * w; }
#pragma unroll
            for (int b = 0; b < 8; ++b) red[(kp * 8 + b) * 64 + col] = acc[b];
            __syncthreads();
            { const int b = tid >> 6; float s = 0.f;
#pragma unroll
              for (int p = 0; p < 8; ++p) s += red[(p * 8 + b) * 64 + col];
              mod[((size_t)l * NBATCH + b) * (NMOD * DM) + j0 + col] = s + P.b_ada[(size_t)l * NMOD * DM + j0 + col]; }
            __syncthreads();
        }
    }
    if (blockIdx.x == 0 && tid < 256) {
        const float l0 = P.lb_logits[tid], l1 = P.lb_logits[256 + tid], m = fmaxf(l0, l1), e0 = __expf(l0 - m), e1 = __expf(l1 - m);
        const float p0 = e0 / (e0 + e1), p1 = e1 / (e0 + e1);
        float* lb = (float*)(ws + WS_LB);
        lb[tid] = fminf(fmaxf(p0 - p0, 0.f), 1.0f - 1e-6f);
        lb[256 + tid] = fminf(fmaxf((p0 + p1) - p0, 0.f), 1.0f - 1e-6f);
    }
}

template <bool HAS_Y, bool FINAL>
__device__ __forceinline__ void phase_norm(const float* src, const bf16_t* y, const float* gate, float* xout, const float* g, const float* shift, const float* scale, bf16_t* dst) {
    const int tid = opaque_tid(), lane = tid & 63, wave = tid >> 6;
    const int gw = blockIdx.x * 8 + wave, NGW = gridDim.x * 8;
    f32x4 gv[4];
#pragma unroll
    for (int j = 0; j < 4; ++j) gv[j] = *(const f32x4*)(g + 4 * lane + 256 * j);
    const int WPB = NGW / NBATCH, b = gw / WPB;
    if (b >= NBATCH) return;
    f32x4 gtv[4], scv[4], shv[4];
#pragma unroll
    for (int j = 0; j < 4; ++j) {
        if (HAS_Y) gtv[j] = *(const f32x4*)(gate + (size_t)b * (NMOD * DM) + 4 * lane + 256 * j);
        if (!FINAL) { scv[j] = *(const f32x4*)(scale + (size_t)b * (NMOD * DM) + 4 * lane + 256 * j) + 1.0f; shv[j] = *(const f32x4*)(shift + (size_t)b * (NMOD * DM) + 4 * lane + 256 * j); }
    }
    for (int row = b * SEQ + (gw - b * WPB); row < (b + 1) * SEQ; row += WPB) {
        const f32x4* xr = (const f32x4*)(src + (size_t)row * DM) + lane;
        f32x4 v[4]; float s = 0.f;
#pragma unroll
        for (int j = 0; j < 4; ++j) v[j] = xr[64 * j];
        if (HAS_Y) {
            const u32x2* yr = (const u32x2*)(y + (size_t)row * DM) + lane;
#pragma unroll
            for (int j = 0; j < 4; ++j) { const u32x2 yw = yr[64 * j]; const f32x4 gt = gtv[j];
                v[j][0] += gt[0] * bflo(yw.x); v[j][1] += gt[1] * bfhi(yw.x); v[j][2] += gt[2] * bflo(yw.y); v[j][3] += gt[3] * bfhi(yw.y); }
        }
#pragma unroll
        for (int j = 0; j < 4; ++j) s += (v[j][0] * v[j][0] + v[j][1] * v[j][1]) + (v[j][2] * v[j][2] + v[j][3] * v[j][3]);
        const float rstd = rsqrtf(wave_sum(s) * (1.0f / DM) + NORM_EPS);
        f32x4* xo = (f32x4*)(xout + (size_t)row * DM) + lane;
        if (FINAL) {
#pragma unroll
            for (int j = 0; j < 4; ++j) xo[64 * j] = v[j] * rstd * gv[j];
        } else {
            if (HAS_Y) {
#pragma unroll
                for (int j = 0; j < 4; ++j) xo[64 * j] = v[j];
            }
            unsigned long long* o8 = (unsigned long long*)(dst + (size_t)row * DM) + lane;
#pragma unroll
            for (int j = 0; j < 4; ++j) {
                const f32x4 h = v[j] * rstd * gv[j] * scv[j] + shv[j];
                o8[64 * j] = (unsigned long long)pk2(h[0], h[1]) | ((unsigned long long)pk2(h[2], h[3]) << 32);
            }
        }
    }
}
__device__ __forceinline__ bf16x4 tr4(const LAS bf16_t* img, int pitch, int row0, int col0, int g, int q) {
    return __builtin_amdgcn_ds_read_tr16_b64_v4i16((LAS bf16x4*)(img + (row0 + 4 * g + (q >> 2)) * pitch + col0 + 4 * (q & 3)));
}
__device__ __forceinline__ bf16x8 tr8(const LAS bf16_t* img, int pitch, int row0, int col0, int g, int q) {
    const bf16x4 lo = __builtin_amdgcn_ds_read_tr16_b64_v4i16((LAS bf16x4*)(img + (row0 + 8 * g + (q >> 2)) * pitch + col0 + 4 * (q & 3)));
    const bf16x4 hi = __builtin_amdgcn_ds_read_tr16_b64_v4i16((LAS bf16x4*)(img + (row0 + 8 * g + 4 + (q >> 2)) * pitch + col0 + 4 * (q & 3)));
    return __builtin_shufflevector(lo, hi, 0, 1, 2, 3, 4, 5, 6, 7);
}
struct AttRegs { u32x4 kv[2][4], vv[2][4]; bf16x8 qf[2][2]; };
constexpr int ATT_UNITS = 2304;
__device__ __forceinline__ void att_decode(int u, int& br, int& b, int& h, int& r, int& L, int& p0, int& tok0) {
    const int pi = u >> 6, k = u & 63; b = pi / 6; h = pi % 6; br = k >> 4; const int w = k & 15;
    const int lr = br * 2, nblk = 16 >> lr, rho = w >> (4 - lr), blk = w & (nblk - 1); r = 1 << lr; L = SEQ >> lr; p0 = blk * 256; tok0 = b * SEQ + rho;
}
__device__ __forceinline__ int att_unit(int li, int x) { const int pl = li / 48, k = li - pl * 48; return ((x + 8 * pl) << 6) | k; }
__device__ __forceinline__ void att_load(const Params& P, int u, int tid, AttRegs& R) {
    int br, b, h, r, L, p0, tok0; att_decode(u, br, b, h, r, L, p0, tok0);
    const bf16_t* proj = (const bf16_t*)(P.ws + WS_PROJ);
#pragma unroll
    for (int it = 0; it < 2; ++it) {
        const int item = tid + it * NTHREADS, key = item >> 1, half = item & 1, kj = p0 - 64 + key;
        if (item < 768 && kj >= 0 && kj < L) {
            const bf16_t* src = proj + (size_t)(tok0 + r * kj) * INW + h * 64 + half * 32;
#pragma unroll
            for (int i = 0; i < 4; ++i) { R.kv[it][i] = *(const u32x4*)(src + C_AK + 8 * i); R.vv[it][i] = *(const u32x4*)(src + C_AV + 8 * i); }
        } else {
#pragma unroll
            for (int i = 0; i < 4; ++i) { R.kv[it][i] = (u32x4){0u, 0u, 0u, 0u}; R.vv[it][i] = (u32x4){0u, 0u, 0u, 0u}; }
        }
    }
    const int lane = tid & 63, wave = tid >> 6, q = lane & 15, g = lane >> 4;
#pragma unroll
    for (int qt = 0; qt < 2; ++qt) {
        const size_t tokq = (size_t)(tok0 + r * (p0 + 32 * wave + 16 * qt + q));
#pragma unroll
        for (int kk = 0; kk < 2; ++kk) R.qf[qt][kk] = *(const bf16x8*)(proj + tokq * INW + C_AQ + h * 64 + kk * 32 + 8 * g);
    }
}
__device__ __forceinline__ void att_phase(const Params& P, LAS unsigned char* lds) {
    const int tid = opaque_tid(), lane = tid & 63, wave = __builtin_amdgcn_readfirstlane(tid >> 6), q = lane & 15, g = lane >> 4;
    LAS bf16_t* Ks = (LAS bf16_t*)lds;
    LAS bf16_t* Vs = (LAS bf16_t*)(lds + 55296);
    const int xq = blockIdx.x & 7, nj = ((int)gridDim.x + 7 - xq) >> 3;
    int li = blockIdx.x >> 3; if (li >= 288) return;
    AttRegs R; att_load(P, att_unit(li, xq), tid, R);
    for (; li < 288; li += nj) {
        const int u = att_unit(li, xq);
        int br, b, h, r, L, p0, tok0; att_decode(u, br, b, h, r, L, p0, tok0);
#pragma unroll
        for (int it = 0; it < 2; ++it) {
            const int item = tid + it * NTHREADS, key = item >> 1, half = item & 1;
            if (item < 768) {
#pragma unroll
                for (int i = 0; i < 4; ++i) { *(LAS u32x4*)(Ks + key * 72 + half * 32 + 8 * i) = R.kv[it][i]; *(LAS u32x4*)(Vs + key * 72 + half * 32 + 8 * i) = R.vv[it][i]; }
            }
        }
        bf16x8 qf[2][2]; qf[0][0] = R.qf[0][0]; qf[0][1] = R.qf[0][1]; qf[1][0] = R.qf[1][0]; qf[1][1] = R.qf[1][1];
        __syncthreads();
        if (li + nj < 288) att_load(P, att_unit(li + nj, xq), tid, R);
        const float slope_l2 = exp2f(-8.0f * (float)(h + 1) / 6.0f) * (float)r * 1.44269504f, qk_l2 = 0.125f * 1.44269504f;
        const float fbase = (float)(64 + q - 4 * g);
        const bool edge = (p0 < 64) || (p0 + 320 > L);
#pragma unroll
        for (int qt = 0; qt < 2; ++qt) {
            const int kw = 32 * wave + 16 * qt;
            const int p = p0 + kw + q; const size_t tokq = (size_t)(tok0 + r * p);
            f32x4 st[9]; float mx = -3.0e38f;
#pragma unroll
            for (int t = 0; t < 9; ++t) {
                f32x4 acc = {0.f, 0.f, 0.f, 0.f};
#pragma unroll
                for (int kk = 0; kk < 2; ++kk) { const bf16x8 a = *(const LAS bf16x8*)(Ks + (kw + 16 * t + q) * 72 + kk * 32 + 8 * g); acc = MFMA32(a, qf[qt][kk], acc); }
#pragma unroll
                for (int j = 0; j < 4; ++j) {
                    const float d = fabsf(fbase - (float)(16 * t + j));
                    float s = acc[j] * qk_l2 - slope_l2 * d;
                    if (t == 0 || t == 8) s = (d <= 64.0f) ? s : -1.0e30f;
                    acc[j] = s;
                }
                if (edge) {
#pragma unroll
                    for (int j = 0; j < 4; ++j) { const int kj = p0 - 64 + kw + 16 * t + 4 * g + j; acc[j] = (kj >= 0 && kj < L) ? acc[j] : -1.0e30f; }
                }
#pragma unroll
                for (int j = 0; j < 4; ++j) mx = fmaxf(mx, acc[j]);
                st[t] = acc;
            }
            mx = fmaxf(mx, __shfl_xor(mx, 16)); mx = fmaxf(mx, __shfl_xor(mx, 32));
            float ls = 0.f; bf16x4 pt[9];
#pragma unroll
            for (int t = 0; t < 9; ++t) { f32x4 e;
#pragma unroll
                for (int j = 0; j < 4; ++j) { e[j] = __builtin_amdgcn_exp2f(st[t][j] - mx); ls += e[j]; }
                pt[t] = pk4(e); }
            ls += __shfl_xor(ls, 16); ls += __shfl_xor(ls, 32);
            const float inv = __builtin_amdgcn_rcpf(ls);
            bf16_t* ob = (bf16_t*)(P.ws + WS_OB) + ((size_t)br * NTOK + tokq) * 384 + h * 64;
            const LAS bf16_t* vrd = Vs + (kw + 4 * g + (q >> 2)) * 72 + 4 * (q & 3);
#pragma unroll
            for (int dt = 0; dt < 4; ++dt) {
                f32x4 acc = {0.f, 0.f, 0.f, 0.f};
#pragma unroll
                for (int t = 0; t < 9; ++t) { const bf16x4 a = __builtin_amdgcn_ds_read_tr16_b64_v4i16((LAS bf16x4*)(vrd + 16 * t * 72 + dt * 16)); acc = MFMA16(a, pt[t], acc); }
                acc = acc * inv;
                *(bf16x4*)(ob + dt * 16 + 4 * g) = pk4(acc);
            }
            if (g == 0) ((float*)(P.ws + WS_LSE))[((size_t)br * NTOK + tokq) * 6 + h] = (mx + __log2f(ls)) * 0.69314718f;
        }
        __syncthreads();
    }
}
__device__ __forceinline__ void att_merge(const Params& P) {
    const bf16_t* ob = (const bf16_t*)(P.ws + WS_OB); const float* lse = (const float*)(P.ws + WS_LSE); bf16_t* mixed = (bf16_t*)(P.ws + WS_HBUF);
    for (size_t it = (size_t)blockIdx.x * NTHREADS + opaque_tid(); it < (size_t)NTOK * 48; it += (size_t)gridDim.x * NTHREADS) {
        const size_t tok = it / 48; const int grp = (int)(it % 48), h = grp >> 3;
        const float l0 = lse[tok * 6 + h], l1 = lse[((size_t)NTOK + tok) * 6 + h], l2 = lse[((size_t)2 * NTOK + tok) * 6 + h];
        const float m = fmaxf(l0, fmaxf(l1, l2)), e0 = __expf(l0 - m), e1 = __expf(l1 - m), e2 = __expf(l2 - m), is = __builtin_amdgcn_rcpf(e0 + e1 + e2);
        const float w0 = e0 * is, w1 = e1 * is, w2 = e2 * is;
        const u32x4 a = *(const u32x4*)(ob + tok * 384 + grp * 8), bq = *(const u32x4*)(ob + ((size_t)NTOK + tok) * 384 + grp * 8), cq = *(const u32x4*)(ob + ((size_t)2 * NTOK + tok) * 384 + grp * 8);
        u32x4 o;
#pragma unroll
        for (int i = 0; i < 4; ++i) o[i] = pk2(w0 * bflo(a[i]) + w1 * bflo(bq[i]) + w2 * bflo(cq[i]), w0 * bfhi(a[i]) + w1 * bfhi(bq[i]) + w2 * bfhi(cq[i]));
        *(u32x4*)(mixed + tok * DM + grp * 8) = o;
    }
}

__device__ __forceinline__ float ret_logg(int h) { return log1pf(-exp2f(-5.0f - (float)h)); }
struct RetARegs { u32x4 k0, k1, v0, v1; };
__device__ __forceinline__ void retA_load(const Params& P, int u, int tid, RetARegs& R) {
    const int bh = u >> 5, n = u & 31, b = bh / 6, h = bh % 6, c = tid >> 2, qd = tid & 3;
    const bf16_t* src = (const bf16_t*)(P.ws + WS_PROJ) + (size_t)(b * SEQ + n * 128 + c) * INW + h * 64 + qd * 16;
    R.k0 = *(const u32x4*)(src + C_RK); R.k1 = *(const u32x4*)(src + C_RK + 8); R.v0 = *(const u32x4*)(src + C_RV); R.v1 = *(const u32x4*)(src + C_RV + 8);
}
__device__ __forceinline__ void retA_phase(const Params& P, LAS unsigned char* lds) {
    const int tid = opaque_tid(), lane = tid & 63, wave = __builtin_amdgcn_readfirstlane(tid >> 6), q = lane & 15, g = lane >> 4;
    LAS bf16_t* Kf = (LAS bf16_t*)lds; LAS bf16_t* Kb = (LAS bf16_t*)(lds + 18432); LAS bf16_t* Vs = (LAS bf16_t*)(lds + 36864);
    int u = blockIdx.x; if (u >= 1536) return;
    RetARegs R; retA_load(P, u, tid, R);
    for (; u < 1536; u += gridDim.x) {
        const int bh = u >> 5, n = u & 31, h = bh % 6;
        const float lg = ret_logg(h);
        {
            const int c = tid >> 2, qd = tid & 3;
            const float wf = 0.125f * __expf(lg * (float)(127 - c)), wb = 0.125f * __expf(lg * (float)c);
            u32x4 f0, f1, b0, b1;
#pragma unroll
            for (int e = 0; e < 4; ++e) { f0[e] = pk2(bflo(R.k0[e]) * wf, bfhi(R.k0[e]) * wf); f1[e] = pk2(bflo(R.k1[e]) * wf, bfhi(R.k1[e]) * wf);
                b0[e] = pk2(bflo(R.k0[e]) * wb, bfhi(R.k0[e]) * wb); b1[e] = pk2(bflo(R.k1[e]) * wb, bfhi(R.k1[e]) * wb); }
            *(LAS u32x4*)(Kf + c * 72 + qd * 16) = f0; *(LAS u32x4*)(Kf + c * 72 + qd * 16 + 8) = f1;
            *(LAS u32x4*)(Kb + c * 72 + qd * 16) = b0; *(LAS u32x4*)(Kb + c * 72 + qd * 16 + 8) = b1;
            *(LAS u32x4*)(Vs + c * 72 + qd * 16) = R.v0; *(LAS u32x4*)(Vs + c * 72 + qd * 16 + 8) = R.v1;
        }
        __syncthreads();
        if (u + (int)gridDim.x < 1536) retA_load(P, u + gridDim.x, tid, R);
        const int dir = wave >> 2, dt = wave & 3; const LAS bf16_t* Kt = dir ? Kb : Kf;
        bf16x8 afr[4];
#pragma unroll
        for (int kk = 0; kk < 4; ++kk) afr[kk] = tr8(Kt, 72, kk * 32, dt * 16, g, q);
        bf16_t* dst = (bf16_t*)(P.ws + WS_RST) + ((size_t)(bh * 32 + n) * 2 + dir) * 4096;
#pragma unroll
        for (int et = 0; et < 4; ++et) {
            f32x4 acc = {0.f, 0.f, 0.f, 0.f};
#pragma unroll
            for (int kk = 0; kk < 4; ++kk) { const bf16x8 bfr = tr8(Vs, 72, kk * 32, et * 16, g, q); acc = MFMA32(afr[kk], bfr, acc); }
            *(bf16x4*)(dst + (et * 16 + q) * 64 + dt * 16 + 4 * g) = pk4(acc);
        }
        __syncthreads();
    }
}
__device__ __forceinline__ void ret_scan(const Params& P) {
    bf16_t* st = (bf16_t*)(P.ws + WS_RST);
    for (int it = blockIdx.x * NTHREADS + opaque_tid(); it < 48 * 2 * 512; it += gridDim.x * NTHREADS) {
        const int ch = it & 511, dir = (it >> 9) & 1, bh = it >> 10, h = bh % 6;
        const float cd = __expf(ret_logg(h) * 128.0f);
        float s[8];
#pragma unroll
        for (int e = 0; e < 8; ++e) s[e] = 0.f;
        for (int i0 = 0; i0 < 32; i0 += 8) {
            u32x4 v[8];
#pragma unroll
            for (int i = 0; i < 8; ++i) { const int n = dir ? 31 - (i0 + i) : (i0 + i); v[i] = *(const u32x4*)(st + ((size_t)(bh * 32 + n) * 2 + dir) * 4096 + 8 * ch); }
#pragma unroll
            for (int i = 0; i < 8; ++i) { const int n = dir ? 31 - (i0 + i) : (i0 + i);
                u32x4 o;
#pragma unroll
                for (int e = 0; e < 4; ++e) o[e] = pk2(s[2 * e], s[2 * e + 1]);
                *(u32x4*)(st + ((size_t)(bh * 32 + n) * 2 + dir) * 4096 + 8 * ch) = o;
#pragma unroll
                for (int e = 0; e < 4; ++e) { s[2 * e] = cd * s[2 * e] + bflo(v[i][e]); s[2 * e + 1] = cd * s[2 * e + 1] + bfhi(v[i][e]); } }
        }
    }
}
struct RetBRegs { u32x4 k0, k1, v0, v1, rf, rb, q0, q1; };
__device__ __forceinline__ void retB_load(const Params& P, int u, int tid, RetBRegs& R) {
    const int bh = u >> 5, n = u & 31, b = bh / 6, h = bh % 6, c = tid >> 2, qd = tid & 3;
    const bf16_t* proj = (const bf16_t*)(P.ws + WS_PROJ);
    const bf16_t* src = proj + (size_t)(b * SEQ + n * 128 + c) * INW + h * 64 + qd * 16;
    R.k0 = *(const u32x4*)(src + C_RK); R.k1 = *(const u32x4*)(src + C_RK + 8); R.v0 = *(const u32x4*)(src + C_RV); R.v1 = *(const u32x4*)(src + C_RV + 8);
    const bf16_t* rs = (const bf16_t*)(P.ws + WS_RST) + (size_t)(bh * 32 + n) * 2 * 4096;
    const int e = tid >> 3, d8 = (tid & 7) * 8;
    R.rf = *(const u32x4*)(rs + e * 64 + d8); R.rb = *(const u32x4*)(rs + 4096 + e * 64 + d8);
    const int lane = tid & 63, wave = tid >> 6, q = lane & 15, g = lane >> 4;
    const bf16_t* qp = proj + (size_t)(b * SEQ + n * 128 + 16 * wave + q) * INW + C_RQ + h * 64 + 8 * g;
    R.q0 = *(const u32x4*)qp; R.q1 = *(const u32x4*)(qp + 32);
}
__device__ __forceinline__ void retB_phase(const Params& P, LAS unsigned char* lds, int layer) {
    const int tid = opaque_tid(), lane = tid & 63, wave = __builtin_amdgcn_readfirstlane(tid >> 6), q = lane & 15, g = lane >> 4;
    const bf16_t* proj = (const bf16_t*)(P.ws + WS_PROJ);
    LAS bf16_t* Ks = (LAS bf16_t*)lds;
    LAS bf16_t* Vs = (LAS bf16_t*)(lds + 18432);
    LAS bf16_t* Rf = (LAS bf16_t*)(lds + 36864);
    LAS bf16_t* Rb = (LAS bf16_t*)(lds + 46080);
    int u = blockIdx.x; if (u >= 1536) return;
    RetBRegs R; retB_load(P, u, tid, R);
    for (; u < 1536; u += gridDim.x) {
        const int bh = u >> 5, n = u & 31, b = bh / 6, h = bh % 6;
        const float lg = ret_logg(h);
        {
            const int c = tid >> 2, qd = tid & 3, e = tid >> 3, d8 = (tid & 7) * 8;
            *(LAS u32x4*)(Ks + c * 72 + qd * 16) = R.k0; *(LAS u32x4*)(Ks + c * 72 + qd * 16 + 8) = R.k1;
            *(LAS u32x4*)(Vs + c * 72 + qd * 16) = R.v0; *(LAS u32x4*)(Vs + c * 72 + qd * 16 + 8) = R.v1;
            *(LAS u32x4*)(Rf + e * 72 + d8) = R.rf; *(LAS u32x4*)(Rb + e * 72 + d8) = R.rb;
        }
        const u32x4 qraw[2] = {R.q0, R.q1};
        __syncthreads();
        if (u + (int)gridDim.x < 1536) retB_load(P, u + gridDim.x, tid, R);
        const int i = 16 * wave + q; const size_t tok = (size_t)(b * SEQ + n * 128 + i);
        u32x2 rgv[4]; f32x4 gnv[4];
#pragma unroll
        for (int et = 0; et < 4; ++et) { rgv[et] = *(const u32x2*)(proj + tok * INW + C_RG + h * 64 + et * 16 + 4 * g); gnv[et] = *(const f32x4*)(P.ret_gn + layer * 384 + h * 64 + et * 16 + 4 * g); }
        bf16x8 qf[2], qff[2], qfb[2];
        {
            const float ff = __expf(lg * (float)(i + 1)), fb = __expf(lg * (float)(128 - i));
#pragma unroll
            for (int kk = 0; kk < 2; ++kk) { const u32x4 raw = qraw[kk];
                qf[kk] = __builtin_bit_cast(bf16x8, raw); u32x4 a, c2;
#pragma unroll
                for (int e = 0; e < 4; ++e) { const float lo = bflo(raw[e]), hi = bfhi(raw[e]); a[e] = pk2(lo * ff, hi * ff); c2[e] = pk2(lo * fb, hi * fb); }
                qff[kk] = __builtin_bit_cast(bf16x8, a); qfb[kk] = __builtin_bit_cast(bf16x8, c2); }
        }
        bf16x4 pt[8];
#pragma unroll
        for (int jt = 0; jt < 8; ++jt) {
            f32x4 acc = {0.f, 0.f, 0.f, 0.f};
#pragma unroll
            for (int kk = 0; kk < 2; ++kk) { const bf16x8 a = *(const LAS bf16x8*)(Ks + (16 * jt + q) * 72 + kk * 32 + 8 * g); acc = MFMA32(a, qf[kk], acc); }
#pragma unroll
            for (int jj = 0; jj < 4; ++jj) { int dd = i - (16 * jt + 4 * g + jj); dd = dd < 0 ? -dd : dd; acc[jj] = acc[jj] * 0.125f * __expf(lg * (float)dd); }
            pt[jt] = pk4(acc);
        }
        f32x4 o[4];
#pragma unroll
        for (int et = 0; et < 4; ++et) {
            f32x4 acc = {0.f, 0.f, 0.f, 0.f};
#pragma unroll
            for (int jt = 0; jt < 8; ++jt) { const bf16x4 a = tr4(Vs, 72, 16 * jt, et * 16, g, q); acc = MFMA16(a, pt[jt], acc); }
#pragma unroll
            for (int kk = 0; kk < 2; ++kk) { const bf16x8 a = *(const LAS bf16x8*)(Rf + (et * 16 + q) * 72 + kk * 32 + 8 * g); acc = MFMA32(a, qff[kk], acc);
                const bf16x8 a2 = *(const LAS bf16x8*)(Rb + (et * 16 + q) * 72 + kk * 32 + 8 * g); acc = MFMA32(a2, qfb[kk], acc); }
            o[et] = acc;
        }
        float s = 0.f;
#pragma unroll
        for (int et = 0; et < 4; ++et) s += (o[et][0] + o[et][1]) + (o[et][2] + o[et][3]);
        s += __shfl_xor(s, 16); s += __shfl_xor(s, 32);
        const float mu = s * (1.0f / 64.0f); float vs = 0.f;
#pragma unroll
        for (int et = 0; et < 4; ++et) { o[et] = o[et] - mu; vs += (o[et][0] * o[et][0] + o[et][1] * o[et][1]) + (o[et][2] * o[et][2] + o[et][3] * o[et][3]); }
        vs += __shfl_xor(vs, 16); vs += __shfl_xor(vs, 32);
        const float rstd = rsqrtf(vs * (1.0f / 64.0f) + NORM_EPS);
        bf16_t* mixed = (bf16_t*)(P.ws + WS_HBUF) + tok * DM + 384 + h * 64;
#pragma unroll
        for (int et = 0; et < 4; ++et) {
            const f32x4 gn = gnv[et]; const u32x2 rg = rgv[et];
            f32x4 y; y[0] = o[et][0] * rstd * gn[0] * siluf(bflo(rg.x)); y[1] = o[et][1] * rstd * gn[1] * siluf(bfhi(rg.x));
            y[2] = o[et][2] * rstd * gn[2] * siluf(bflo(rg.y)); y[3] = o[et][3] * rstd * gn[3] * siluf(bfhi(rg.y));
            *(bf16x4*)(mixed + et * 16 + 4 * g) = pk4(y);
        }
        __syncthreads();
    }
}
__device__ __forceinline__ void hgrn_gate(float z, float lbv, float& f, float& kk) {
    z = fminf(fmaxf(z, -30.f), 30.f);
    const float ez = __expf(-z), sg = __builtin_amdgcn_rcpf(1.0f + ez);
    f = lbv + (1.0f - lbv) * sg; kk = (1.0f - lbv) * ez * sg;
}
__device__ __forceinline__ void hgA_unit(const Params& P, LAS unsigned char* lds, int u, int layer) {
    const int tid = opaque_tid(), lane = tid & 63, wave = __builtin_amdgcn_readfirstlane(tid >> 6), q = lane & 15, g = lane >> 4;
    const int bh = u >> 5, n = u & 31, b = bh >> 2, h = bh & 3;
    const bf16_t* proj = (const bf16_t*)(P.ws + WS_PROJ);
    LAS bf16_t* Kt = (LAS bf16_t*)lds;
    LAS bf16_t* Vt = (LAS bf16_t*)(lds + 34816);
    LAS float* segs = (LAS float*)(lds + 52224);
    const size_t tokc = (size_t)(b * SEQ + n * 128);
    {
        const int c = tid >> 2, qd = tid & 3; const bf16_t* src = proj + (tokc + c) * INW + C_HI + h * 64 + qd * 16;
        const u32x4 v0 = *(const u32x4*)src, v1 = *(const u32x4*)(src + 8);
#pragma unroll
        for (int e = 0; e < 8; ++e) { const unsigned vw = e < 4 ? v0[e & 3] : v1[e & 3]; const int d = qd * 16 + 2 * e;
            Vt[d * 136 + c] = (bf16_t)(vw & 0xffffu); Vt[(d + 1) * 136 + c] = (bf16_t)(vw >> 16); }
    }
    const int d = tid & 63, dir = (tid >> 6) & 1, seg = tid >> 7;
    const float lbv = ((const float*)(P.ws + WS_LB))[layer * 256 + h * 64 + d];
    float lf[32], kk[32];
    {
        const bf16_t* zp = proj + (tokc + seg * 32) * INW + (dir ? C_HZB : C_HZF) + h * 64 + d;
        bf16_t zr[32];
#pragma unroll
        for (int i = 0; i < 32; ++i) zr[i] = zp[(size_t)i * INW];
#pragma unroll
        for (int i = 0; i < 32; ++i) hgrn_gate(bf2f(zr[i]), lbv, lf[i], kk[i]);
    }
    float ssum = 1.f;
#pragma unroll
    for (int i = 0; i < 32; ++i) ssum *= lf[i];
    segs[(dir * 4 + seg) * 64 + d] = ssum;
    __syncthreads();
    {
        float before = 1.f, after = 1.f;
#pragma unroll
        for (int s2 = 0; s2 < 4; ++s2) { const float v = segs[(dir * 4 + s2) * 64 + d]; if (s2 < seg) before *= v; if (s2 > seg) after *= v; }
        LAS bf16_t* kt = Kt + dir * (64 * 136) + d * 136 + seg * 32;
        if (dir == 0) {
            float run = after;
#pragma unroll
            for (int i = 31; i >= 0; --i) { kt[i] = f2bf(kk[i] * run); run *= lf[i]; }
        } else {
            float run = before;
#pragma unroll
            for (int i = 0; i < 32; ++i) { kt[i] = f2bf(kk[i] * run); run *= lf[i]; }
        }
        if (seg == 0) ((float*)(P.ws + WS_HGA))[((size_t)(bh * 2 + dir) * 32 + n) * 64 + d] = ssum * after;
    }
    __syncthreads();
    {
        const int wdir = wave >> 2, dt = wave & 3; const LAS bf16_t* kts = Kt + wdir * (64 * 136);
        bf16x8 afr[4];
#pragma unroll
        for (int kq = 0; kq < 4; ++kq) afr[kq] = *(const LAS bf16x8*)(kts + (dt * 16 + q) * 136 + kq * 32 + 8 * g);
        float* dst = (float*)(P.ws + WS_HGU) + ((size_t)(bh * 2 + wdir) * 32 + n) * 4096;
#pragma unroll
        for (int et = 0; et < 4; ++et) {
            f32x4 acc = {0.f, 0.f, 0.f, 0.f};
#pragma unroll
            for (int kq = 0; kq < 4; ++kq) { const bf16x8 bfr = *(const LAS bf16x8*)(Vt + (et * 16 + q) * 136 + kq * 32 + 8 * g); acc = MFMA32(afr[kq], bfr, acc); }
#pragma unroll
            for (int j = 0; j < 4; ++j) dst[(dt * 16 + 4 * g + j) * 64 + et * 16 + q] = acc[j];
        }
    }
    __syncthreads();
}
__device__ __forceinline__ void hg_scan(const Params& P) {
    float* U = (float*)(P.ws + WS_HGU); const float* A = (const float*)(P.ws + WS_HGA);
    const int nthr = gridDim.x * NTHREADS; int it0 = blockIdx.x * NTHREADS + opaque_tid() - 48 * 2 * 512; if (it0 < 0) it0 += nthr;
    for (int it = it0; it < 64 * 64 * 16; it += nthr) {
        const int e4 = it & 15, d = (it >> 4) & 63, bd = it >> 10, dir = bd & 1;
        f32x4 s = {0.f, 0.f, 0.f, 0.f};
        for (int i0 = 0; i0 < 32; i0 += 8) {
            f32x4 v[8]; float a[8];
#pragma unroll
            for (int i = 0; i < 8; ++i) { const int n = dir ? 31 - (i0 + i) : (i0 + i); v[i] = *(const f32x4*)(U + ((size_t)(bd * 32 + n) * 64 + d) * 64 + 4 * e4); a[i] = A[(size_t)(bd * 32 + n) * 64 + d]; }
#pragma unroll
            for (int i = 0; i < 8; ++i) { const int n = dir ? 31 - (i0 + i) : (i0 + i); *(f32x4*)(U + ((size_t)(bd * 32 + n) * 64 + d) * 64 + 4 * e4) = s; s = s * a[i] + v[i]; }
        }
    }
}
__device__ __forceinline__ unsigned pk2h(float lo, float hi) { return pk2(lo, hi); }
__device__ __forceinline__ bf16x4 pk4h(f32x4 v) { return pk4(v); }
__device__ __forceinline__ void hgB_unit(const Params& P, LAS unsigned char* lds, int u, int layer) {
    const int tid = opaque_tid(), lane = tid & 63, wave = __builtin_amdgcn_readfirstlane(tid >> 6), q = lane & 15, g = lane >> 4;
    const int b = u >> 5, n = u & 31, h = wave >> 1, dir = wave & 1, bh = b * 4 + h;
    bf16_t* proj = (bf16_t*)(P.ws + WS_PROJ);
    bf16_t* mixed = (bf16_t*)(P.ws + WS_HBUF);
    LAS unsigned char* wl = lds + wave * 7168;
    LAS bf16_t* Qi = (LAS bf16_t*)wl;
    LAS bf16_t* Ki = (LAS bf16_t*)(wl + 2304);
    LAS bf16_t* Vs = (LAS bf16_t*)(wl + 4608);
    LAS float* Al = (LAS float*)(wl + 6912);
    const size_t tokc = (size_t)(b * SEQ + n * 128);
    const float lbv = ((const float*)(P.ws + WS_LB))[layer * 256 + h * 64 + lane];
    f32x4 S[4][4];
    {
        const float* sp = (const float*)(P.ws + WS_HGU) + ((size_t)(bh * 2 + dir) * 32 + n) * 4096;
#pragma unroll
        for (int dt = 0; dt < 4; ++dt)
#pragma unroll
            for (int et = 0; et < 4; ++et)
#pragma unroll
                for (int j = 0; j < 4; ++j) S[dt][et][j] = sp[(dt * 16 + 4 * g + j) * 64 + et * 16 + q];
    }
    bf16_t* odst = dir ? (proj + C_AQ + h * 64) : (mixed + 768 + h * 64); const size_t opitch = dir ? INW : DM;
    bf16_t qr[16], zz[16]; u32x4 v0, v1;
#define HGB_LOAD(SC) do { const size_t toks_ = tokc + (SC) * 16; const bf16_t* base_ = proj + toks_ * INW + h * 64 + lane; \
        _Pragma("unroll") for (int ii = 0; ii < 16; ++ii) { const int t_ = dir ? 15 - ii : ii; qr[ii] = base_[(size_t)t_ * INW + C_HQ]; zz[ii] = base_[(size_t)t_ * INW + (dir ? C_HZB : C_HZF)]; } \
        const bf16_t* vsrc_ = proj + (toks_ + (lane >> 2)) * INW + C_HI + h * 64 + (lane & 3) * 16; v0 = *(const u32x4*)vsrc_; v1 = *(const u32x4*)(vsrc_ + 8); } while (0)
    HGB_LOAD(dir ? 7 : 0);
    for (int i = 0; i < 8; ++i) {
        const int sc = dir ? 7 - i : i; const size_t toks = tokc + sc * 16;
        {
            *(LAS u32x4*)(Vs + (lane >> 2) * 72 + (lane & 3) * 16) = v0; *(LAS u32x4*)(Vs + (lane >> 2) * 72 + (lane & 3) * 16 + 8) = v1;
            float bp = 1.f;
#pragma unroll
            for (int ii = 0; ii < 16; ++ii) {
                const int t = dir ? 15 - ii : ii;
                float f, kk; hgrn_gate(bf2f(zz[ii]), lbv, f, kk); const float qv = siluf(bf2f(qr[ii]));
                bp *= f;
                Qi[t * 72 + lane] = f2bf(qv * bp); Ki[t * 72 + lane] = f2bf(kk * __builtin_amdgcn_rcpf(fmaxf(bp, 1.0e-30f)));
            }
            Al[lane] = bp;
        }
        if (i + 1 < 8) HGB_LOAD(dir ? 6 - i : i + 1);
        __builtin_amdgcn_fence(__ATOMIC_RELEASE, "wavefront"); __builtin_amdgcn_wave_barrier(); __builtin_amdgcn_fence(__ATOMIC_ACQUIRE, "wavefront");
        f32x4 at = {0.f, 0.f, 0.f, 0.f};
#pragma unroll
        for (int kq = 0; kq < 2; ++kq) { const bf16x8 a8 = *(const LAS bf16x8*)(Ki + q * 72 + kq * 32 + 8 * g), b8 = *(const LAS bf16x8*)(Qi + q * 72 + kq * 32 + 8 * g); at = MFMA32(a8, b8, at); }
#pragma unroll
        for (int j = 0; j < 4; ++j) { const int sl = 4 * g + j; const bool keep = dir ? (sl >= q) : (sl <= q); at[j] = keep ? at[j] : 0.f; }
        const bf16x4 p4 = pk4h(at);
        bf16x4 b4[4], v4[4];
#pragma unroll
        for (int dt = 0; dt < 4; ++dt) b4[dt] = *(const LAS bf16x4*)(Qi + q * 72 + dt * 16 + 4 * g);
#pragma unroll
        for (int et = 0; et < 4; ++et) v4[et] = tr4(Vs, 72, 0, et * 16, g, q);
#pragma unroll
        for (int et = 0; et < 4; ++et) {
            f32x4 o = {0.f, 0.f, 0.f, 0.f};
#pragma unroll
            for (int dt = 0; dt < 4; ++dt) o = MFMA16(pk4h(S[dt][et]), b4[dt], o);
            o = MFMA16(v4[et], p4, o);
            *(bf16x4*)(odst + (toks + q) * opitch + et * 16 + 4 * g) = pk4(o);
        }
#pragma unroll
        for (int dt = 0; dt < 4; ++dt) {
            const bf16x4 kT4 = tr4(Ki, 72, 0, dt * 16, g, q);
            const f32x4 al4 = *(const LAS f32x4*)(Al + dt * 16 + 4 * g);
#pragma unroll
            for (int et = 0; et < 4; ++et) { const f32x4 s2 = MFMA16(kT4, v4[et], S[dt][et]); S[dt][et] = s2 * al4; }
        }
        __builtin_amdgcn_fence(__ATOMIC_RELEASE, "wavefront"); __builtin_amdgcn_wave_barrier(); __builtin_amdgcn_fence(__ATOMIC_ACQUIRE, "wavefront");
    }
    asm volatile("s_waitcnt vmcnt(0)" ::: "memory");
    __syncthreads();
    {
        const int tau = tid >> 2, qd = tid & 3;
        bf16_t* mp = mixed + (tokc + tau) * DM + 768 + qd * 64; const bf16_t* bp2 = proj + (tokc + tau) * INW + C_AQ + qd * 64;
        const bf16_t* gp = proj + (tokc + tau) * INW + C_HG + qd * 64; const float* gn = P.hgrn_gn + layer * 256 + qd * 64;
        float o[64]; float sq = 0.f;
#pragma unroll
        for (int c4 = 0; c4 < 16; ++c4) {
            const unsigned long long fv = __hip_atomic_load((const unsigned long long*)(mp + c4 * 4), __ATOMIC_RELAXED, __HIP_MEMORY_SCOPE_AGENT), bv = __hip_atomic_load((const unsigned long long*)(bp2 + c4 * 4), __ATOMIC_RELAXED, __HIP_MEMORY_SCOPE_AGENT);
            const unsigned f0 = (unsigned)fv, f1 = (unsigned)(fv >> 32), b0 = (unsigned)bv, b1 = (unsigned)(bv >> 32);
            const float x0 = bflo(f0) + bflo(b0), x1 = bfhi(f0) + bfhi(b0), x2 = bflo(f1) + bflo(b1), x3 = bfhi(f1) + bfhi(b1);
            o[c4 * 4 + 0] = x0; o[c4 * 4 + 1] = x1; o[c4 * 4 + 2] = x2; o[c4 * 4 + 3] = x3; sq += (x0 * x0 + x1 * x1) + (x2 * x2 + x3 * x3); }
        sq += __shfl_xor(sq, 1); sq += __shfl_xor(sq, 2);
        const float rstd = rsqrtf(sq * (1.0f / 256.0f) + NORM_EPS);
#pragma unroll
        for (int c8 = 0; c8 < 8; ++c8) {
            const u32x4 gv = *(const u32x4*)(gp + c8 * 8); const f32x4 g0 = *(const f32x4*)(gn + c8 * 8), g1 = *(const f32x4*)(gn + c8 * 8 + 4);
            u32x4 r;
            r.x = pk2h(o[c8 * 8 + 0] * rstd * g0[0] * siluf(bflo(gv.x)), o[c8 * 8 + 1] * rstd * g0[1] * siluf(bfhi(gv.x)));
            r.y = pk2h(o[c8 * 8 + 2] * rstd * g0[2] * siluf(bflo(gv.y)), o[c8 * 8 + 3] * rstd * g0[3] * siluf(bfhi(gv.y)));
            r.z = pk2h(o[c8 * 8 + 4] * rstd * g1[0] * siluf(bflo(gv.z)), o[c8 * 8 + 5] * rstd * g1[1] * siluf(bfhi(gv.z)));
            r.w = pk2h(o[c8 * 8 + 6] * rstd * g1[2] * siluf(bflo(gv.w)), o[c8 * 8 + 7] * rstd * g1[3] * siluf(bfhi(gv.w)));
            *(u32x4*)(mp + c8 * 8) = r;
        }
    }
    __syncthreads();
}
constexpr int N_PHASES = 20;
#ifndef PROBE_MASK
#define PROBE_MASK 0u
#endif
#ifndef PROBE_U
#define PROBE_U 0
#endif
#ifndef STAGGER
#define STAGGER 0
#endif
#ifndef STAGGER_TICKS
#define STAGGER_TICKS 1000u
#endif
#ifndef PROBE_SYNC2
#define PROBE_SYNC2 0
#endif
__device__ __forceinline__ void stagger_half(unsigned ticks) {
#if STAGGER
    if ((blockIdx.x >> 3) & 1) { const unsigned long long t0 = __builtin_amdgcn_s_memrealtime(); while (__builtin_amdgcn_s_memrealtime() - t0 < ticks) __builtin_amdgcn_s_sleep(32); }
    __syncthreads();
#endif
}
__device__ __forceinline__ void run_phase(const Params& P, LAS unsigned char* lds, int ph) {
    unsigned char* ws = P.ws;
    if (ph == 0) { phase_prologue(P, lds); return; }
    if (ph == N_PHASES - 1) { phase_norm<true, true>(P.out, (const bf16_t*)(ws + WS_OB), (const float*)(ws + WS_MOD) + (size_t)(DEPTH - 1) * NBATCH * NMOD * DM + 5 * DM, P.out, P.g_final, nullptr, nullptr, nullptr); return; }
    const int l = (ph - 1) / 9, s = (ph - 1) % 9;
    const float* mod = (const float*)(ws + WS_MOD) + (size_t)l * NBATCH * NMOD * DM;
    bf16_t* hbuf = (bf16_t*)(ws + WS_HBUF); bf16_t* proj = (bf16_t*)(ws + WS_PROJ); bf16_t* ybuf = (bf16_t*)(ws + WS_OB);
#ifdef PH_ONLY
    if (s != PH_ONLY) return;
#endif
    int kD = DM, kF = FFN; asm volatile("" : "+s"(kD), "+s"(kF));
    switch (s) {
    case 0: if (l == 0) { phase_norm<false, false>(P.x, nullptr, nullptr, nullptr, P.g_mix, mod + 0 * DM, mod + 1 * DM, hbuf); phase_weights(P, lds); }
            else phase_norm<true, false>(P.out, ybuf, mod - (size_t)NBATCH * NMOD * DM + 5 * DM, P.out, P.g_mix + l * DM, mod + 0 * DM, mod + 1 * DM, hbuf);
            break;
    case 1: { pg8::Gemm g{hbuf, (const bf16_t*)(ws + WS_WIN) + (size_t)l * INWP * DM, NTOK, INWP, kD}; pg8::StaticOrder S; S.init(NTOK, INWP, gridDim.x, blockIdx.x);
              EpiProj E{proj, INW, INW}; pg8::gemm_phase<EpiProj, pg8::StaticOrder>(lds, g, S, E, nullptr); } break;
    case 2: { for (int rp = 0; rp < (PROBE_U == 1 ? 2 : 1); ++rp) att_phase(P, lds);
              for (int rp = 0; rp < (PROBE_U == 2 ? 2 : 1); ++rp) retA_phase(P, lds);
              for (int rp = 0; rp < (PROBE_U == 3 ? 2 : 1); ++rp) for (int u = blockIdx.x; u < 1024; u += gridDim.x) hgA_unit(P, lds, u, l); } break;
    case 3: { ret_scan(P); hg_scan(P); } break;
    case 4: { for (int rp = 0; rp < (PROBE_U == 4 ? 2 : 1); ++rp) for (int u = blockIdx.x; u < 256; u += gridDim.x) hgB_unit(P, lds, u, l);
              for (int rp = 0; rp < (PROBE_U == 5 ? 2 : 1); ++rp) retB_phase(P, lds, l); att_merge(P); } break;
    case 5: { pg8::Gemm g{hbuf, (const bf16_t*)(ws + WS_WOUT) + (size_t)l * DM * DM, NTOK, DM, kD}; pg8::StaticOrder S; S.init(NTOK, DM, gridDim.x, blockIdx.x);
              EpiProj E{ybuf, DM, DM}; pg8::gemm_phase<EpiProj, pg8::StaticOrder>(lds, g, S, E, nullptr); } break;
    case 6: phase_norm<true, false>(l == 0 ? P.x : P.out, ybuf, mod + 2 * DM, P.out, P.g_ffn + l * DM, mod + 3 * DM, mod + 4 * DM, hbuf); break;
    case 7: { pg8::Gemm g{hbuf, (const bf16_t*)(ws + WS_WGU) + (size_t)l * 2 * FFN * DM, NTOK, 2 * FFN, kD}; pg8::StaticOrder S; S.init(NTOK, 2 * FFN, gridDim.x, blockIdx.x);
              EpiSwiglu E{proj}; pg8::gemm_phase<EpiSwiglu, pg8::StaticOrder>(lds, g, S, E, nullptr); } break;
    case 8: { pg8::Gemm g{proj, (const bf16_t*)(ws + WS_WDN) + (size_t)l * DM * FFN, NTOK, DM, kF}; pg8::StaticOrder S; S.init(NTOK, DM, gridDim.x, blockIdx.x);
              EpiProj E{ybuf, DM, DM}; pg8::gemm_phase<EpiProj, pg8::StaticOrder>(lds, g, S, E, nullptr); } break;
    }
}
__global__ void __launch_bounds__(NTHREADS) hybrid_fwd(Params P) {
    extern __shared__ __attribute__((aligned(16))) unsigned char lds_raw[];
    __shared__ uint4 xb_words;
    LAS unsigned char* lds = (LAS unsigned char*)lds_raw;
    if (threadIdx.x == 0) xb_words = make_uint4(0u, 0u, 0u, 0u);
    __syncthreads();
    XcdBarrier bar = xcd_barrier_post((unsigned*)(P.ws + WS_CTL), (volatile LAS unsigned*)&xb_words);
    for (int ph = P.ph_lo; ph < P.ph_hi; ++ph) {
        const int reps = ((PROBE_MASK >> ph) & 1u) ? 2 : 1;
        for (int rep = 0; rep < reps; ++rep) { run_phase(P, lds, ph); if (rep + 1 < reps) __syncthreads(); }
        if (ph + 1 < P.ph_hi) {
            if (P.ph_hi > N_PHASES) cg::this_grid().sync(); else xcd_barrier(bar);
            if (PROBE_SYNC2) xcd_barrier(bar);
        }
    }
}

extern "C" void kernel_launch(void* const* d_in, const int* in_sizes, int n_in, void* d_out, int out_size, void* d_ws, size_t ws_size, hipStream_t stream) {
    static int grid = 0;
    if (grid == 0) {
        if (n_in != 14 || out_size != NTOK * DM || ws_size < WS_END) { fprintf(stderr, "kernel_launch: unexpected shapes (n_in %d out %d ws %zu need %zu)\n", n_in, out_size, ws_size, (size_t)WS_END); grid = -1; return; }
        int dev = 0, cus = 0, per_cu = 0;
        hipGetDevice(&dev); hipDeviceGetAttribute(&cus, hipDeviceAttributeMultiprocessorCount, dev);
        if (hipFuncSetAttribute((const void*)hybrid_fwd, hipFuncAttributeMaxDynamicSharedMemorySize, LDS_BYTES) != hipSuccess) { fprintf(stderr, "kernel_launch: hipFuncSetAttribute failed\n"); grid = -1; return; }
        if (hipOccupancyMaxActiveBlocksPerMultiprocessor(&per_cu, (const void*)hybrid_fwd, NTHREADS, LDS_BYTES) != hipSuccess || per_cu < 1) { fprintf(stderr, "kernel_launch: occupancy query says %d\n", per_cu); grid = -1; return; }
        grid = cus;
    }
    if (grid < 0) return;
    if (hipMemsetAsync((char*)d_ws + WS_CTL, 0, 16384, stream) != hipSuccess) { fprintf(stderr, "kernel_launch: memset failed\n"); return; }
    Params p{};
    p.x = (const float*)d_in[0]; p.c = (const float*)d_in[1]; p.w_ada = (const float*)d_in[2]; p.b_ada = (const float*)d_in[3]; p.g_mix = (const float*)d_in[4];
    p.w_in = (const float*)d_in[5]; p.ret_gn = (const float*)d_in[6]; p.hgrn_gn = (const float*)d_in[7]; p.lb_logits = (const float*)d_in[8]; p.w_out = (const float*)d_in[9];
    p.g_ffn = (const float*)d_in[10]; p.w_gu = (const float*)d_in[11]; p.w_down = (const float*)d_in[12]; p.g_final = (const float*)d_in[13];
    p.out = (float*)d_out; p.ws = (unsigned char*)d_ws;
#if ONE_LAUNCH
    p.ph_lo = 0; p.ph_hi = N_PHASES;
    void* args[] = {&p};
    hipError_t e = hipLaunchCooperativeKernel((const void*)hybrid_fwd, dim3(grid), dim3(NTHREADS), args, LDS_BYTES, stream);
    if (e != hipSuccess) fprintf(stderr, "cooperative launch failed: %s (grid %d)\n", hipGetErrorString(e), grid);
#else
    for (int ph = 0; ph < N_PHASES; ++ph) { p.ph_lo = ph; p.ph_hi = ph + 1; hipLaunchKernelGGL(hybrid_fwd, dim3(grid), dim3(NTHREADS), LDS_BYTES, stream, p); }
#endif
}
```

```cpp
#include <hip/hip_runtime.h>
#include <hip/hip_cooperative_groups.h>
#include <cstdio>
#include <cstdint>
namespace cg = cooperative_groups;
#ifndef ONE_LAUNCH
#define ONE_LAUNCH 1
#endif
__device__ __forceinline__ int opaque_tid() { int t = threadIdx.x; asm volatile("" : "+v"(t)); return t; }
#define LAS __attribute__((address_space(3)))
namespace pg8 {
#define PG8_LAS __attribute__((address_space(3)))
typedef unsigned short bf16_t;
typedef short bf16x8 __attribute__((ext_vector_type(8)));
typedef float f32x4 __attribute__((ext_vector_type(4)));
typedef unsigned u32x4 __attribute__((ext_vector_type(4)));
constexpr int BM = 256, BK = 64, HALF = 128, HTB = HALF * BK * 2  , STAGE_BYTES = 8 * HTB, NXCD = 8, WGM = 8;

__host__ __device__ __forceinline__ int lds_byte(int r, int c) { const int st = (r >> 4) * 2 + (c >> 5), rr = r & 15, cc = c & 31, ob = rr * 64 + cc * 2; return st * 1024 + (ob ^ (((ob >> 9) & 1) << 5)); }
__host__ __device__ __forceinline__ void stage_rc(int b, int& R, int& C) { const int st = b / 1024, sb = b % 1024, swz = sb ^ (((sb >> 9) & 1) << 5); R = (st >> 1) * 16 + swz / 64; C = (st & 1) * 32 + (swz % 64) / 2; }
__host__ __device__ __forceinline__ int perm32(int rho) { const int n = rho >> 4, i = rho & 15; return 8 * (i >> 2) + 4 * n + (i & 3); }

struct Unit { int pm, pn; };
struct Gemm { const bf16_t* A; const bf16_t* Bt; int M, N, K; };

struct StaticOrder {
    int nM, nN, nwg, G, c;
    __host__ __device__ void init(int M, int N, int G_, int c_) { nM = M / BM; nN = N / BM; nwg = nM * nN; G = G_; c = c_; }
    __host__ __device__ bool next(int i, Unit& u) const {
        const long L = (long)i * G + c; if (L >= nwg) return false;
        int wgid = (int)L; { const int q = nwg / NXCD, r = nwg % NXCD, xcd = wgid % NXCD, off = wgid / NXCD; wgid = (xcd < r ? xcd * (q + 1) : r * (q + 1) + (xcd - r) * q) + off; }
        const int nig = WGM * nN, gid = wgid / nig, fm = gid * WGM, gsz = (nM - fm) < WGM ? (nM - fm) : WGM;
        u.pm = fm + ((wgid % nig) % gsz); u.pn = (wgid % nig) / gsz; return true;
    }
    __device__ __forceinline__ void a_ready(const Unit&) const {}
    __device__ __forceinline__ void done(const Unit&) const {}
};
__device__ __forceinline__ unsigned cvt_pk_bf16(float lo, float hi) { unsigned r; asm volatile("v_cvt_pk_bf16_f32 %0, %1, %2" : "=v"(r) : "v"(lo), "v"(hi)); return r; }
typedef float f32x2 __attribute__((ext_vector_type(2)));
template <class Epi, class Sched, bool STAMP = false>
__device__ __forceinline__ void gemm_phase(PG8_LAS unsigned char* lds, const Gemm g, const Sched& S, const Epi& E, unsigned long long* stamps) {
    const int tid = opaque_tid(), wid = __builtin_amdgcn_readfirstlane(tid >> 6), lane = tid & 63, wr = wid >> 2, wc = wid & 3, fr = lane & 15, fq = lane >> 4;
    const int K = g.K, nt = K / BK;
    int ts_lo = 0, ts_hi = 0, nts = 0; const unsigned long long rt_entry = STAMP ? (unsigned long long)wall_clock64() : 0ull;
#define PG8_STAMP() do { if (STAMP && wid == 0 && nts < 64) { const unsigned long long _c = (unsigned long long)clock64(); \
        ts_lo = (lane == nts) ? (int)(unsigned)_c : ts_lo; ts_hi = (lane == nts) ? (int)(unsigned)(_c >> 32) : ts_hi; ++nts; } } while (0)
    PG8_STAMP();
    unsigned voffA[2], voffB[2];
#pragma unroll
    for (int i = 0; i < 2; ++i) { int R, C; stage_rc(tid * 16 + i * 8192, R, C); const int Rb = Epi::PERM ? ((R & ~31) + perm32(R & 31)) : R;
        voffA[i] = (unsigned)(R * K + C) * 2u; voffB[i] = (unsigned)(Rb * K + C) * 2u; }
    const size_t kstep = (size_t)(BK * 2);
    const size_t hstep = (size_t)HALF * K * 2;
    const size_t tstep = 2 * hstep;
    const unsigned ldsw = (unsigned)wid * 1024u;
    const int aoff = lds_byte(wr * 64 + fr, fq * 8), boff = lds_byte(wc * 32 + fr, fq * 8);
#define PG8_SA(b, h) (((b) * 2 + (h)) * HTB)
#define PG8_SB(b, h) ((4 + (b) * 2 + (h)) * HTB)
#define PG8_STAGE(bufoff, gbase, voff) do { _Pragma("unroll") for (int _i = 0; _i < 2; ++_i) \
        __builtin_amdgcn_global_load_lds((const unsigned*)((const char*)(gbase) + (voff)[_i]), (PG8_LAS unsigned*)(lds + (bufoff) + ldsw + _i * 8192), 16, 0, 0); } while (0)
#define PG8_LDA(dst, b, h) do { _Pragma("unroll") for (int m = 0; m < 4; ++m) _Pragma("unroll") for (int k = 0; k < 2; ++k) dst[m][k] = *(const PG8_LAS bf16x8*)(lds + PG8_SA(b, h) + aoff + m * 2048 + k * 1024); } while (0)
#define PG8_LDB(dst, b, h) do { _Pragma("unroll") for (int n = 0; n < 2; ++n) _Pragma("unroll") for (int k = 0; k < 2; ++k) dst[n][k] = *(const PG8_LAS bf16x8*)(lds + PG8_SB(b, h) + boff + n * 2048 + k * 1024); } while (0)
#define PG8_MMA(ai, bj, At, Bt) do { __builtin_amdgcn_s_setprio(1); _Pragma("unroll") for (int m = 0; m < 4; ++m) _Pragma("unroll") for (int n = 0; n < 2; ++n) _Pragma("unroll") for (int k = 0; k < 2; ++k) \
        acc[ai][bj][m][n] = __builtin_amdgcn_mfma_f32_16x16x32_bf16(Bt[n][k], At[m][k], acc[ai][bj][m][n], 0, 0, 0); __builtin_amdgcn_s_setprio(0); } while (0)
#define PG8_WAIT_V(n) asm volatile("s_waitcnt vmcnt(" #n ")" ::: "memory")
#define PG8_WAIT_L(n) asm volatile("s_waitcnt lgkmcnt(" #n ")" ::: "memory")
#define PG8_BAR __builtin_amdgcn_s_barrier()
#define PG8_SCHED __builtin_amdgcn_sched_barrier(0)
    Unit cur, nxt; int ui = 0;
    if (!S.next(0, cur)) return;
    f32x4 acc[2][2][4][2];
#pragma unroll
    for (int a = 0; a < 2; ++a)
#pragma unroll
        for (int b = 0; b < 2; ++b)
#pragma unroll
            for (int m = 0; m < 4; ++m)
#pragma unroll
                for (int n = 0; n < 2; ++n) acc[a][b][m][n] = (f32x4){0.f, 0.f, 0.f, 0.f};
    bf16x8 At[4][2], B0[2][2], B1[2][2];
    const char* cA = (const char*)g.A + (size_t)cur.pm * tstep; const char* cB = (const char*)g.Bt + (size_t)cur.pn * tstep;
    S.a_ready(cur);
    PG8_STAGE(PG8_SB(0, 0), cB, voffB); PG8_STAGE(PG8_SA(0, 0), cA, voffA); PG8_STAGE(PG8_SB(0, 1), cB + hstep, voffB); PG8_STAGE(PG8_SA(0, 1), cA + hstep, voffA);
    if (wr == 1) PG8_BAR;
    PG8_WAIT_V(4); PG8_BAR;
    PG8_STAGE(PG8_SB(1, 0), cB + kstep, voffB); PG8_STAGE(PG8_SA(1, 0), cA + kstep, voffA); PG8_STAGE(PG8_SB(1, 1), cB + hstep + kstep, voffB);
    PG8_WAIT_V(6); PG8_BAR;
    PG8_STAMP();
    for (;;) {
        const bool has_next = S.next(ui + 1, nxt);
        const char* nA = has_next ? (const char*)g.A + (size_t)nxt.pm * tstep : cA; const char* nB = has_next ? (const char*)g.Bt + (size_t)nxt.pn * tstep : cB;
        for (int t = 0; t < nt; t += 2) {
            const bool last = (t == nt - 2);
            const char* a1 = cA + (size_t)(t + 1) * kstep;
            const char* a2 = last ? nA : cA + (size_t)(t + 2) * kstep; const char* b2 = last ? nB : cB + (size_t)(t + 2) * kstep;
            const char* a3 = a2 + kstep; const char* b3 = b2 + kstep;
            if (last && has_next) S.a_ready(nxt);
            PG8_LDB(B0, 0, 0); PG8_SCHED; PG8_LDA(At, 0, 0); PG8_STAGE(PG8_SA(1, 1), a1 + hstep, voffA);
            PG8_WAIT_L(8); PG8_BAR; PG8_WAIT_L(0); PG8_MMA(0, 0, At, B0); PG8_BAR; PG8_SCHED;
            PG8_LDB(B1, 0, 1); PG8_STAGE(PG8_SB(0, 0), b2, voffB);
            PG8_BAR; PG8_WAIT_L(0); PG8_MMA(0, 1, At, B1); PG8_BAR;
            PG8_LDA(At, 0, 1); PG8_STAGE(PG8_SA(0, 0), a2, voffA);
            PG8_BAR; PG8_WAIT_L(0); PG8_MMA(1, 0, At, B0); PG8_BAR; PG8_SCHED;
            PG8_STAGE(PG8_SB(0, 1), b2 + hstep, voffB);
            PG8_WAIT_V(6); PG8_BAR; PG8_MMA(1, 1, At, B1); PG8_BAR;
            PG8_LDB(B0, 1, 0); PG8_SCHED; PG8_LDA(At, 1, 0); PG8_STAGE(PG8_SA(0, 1), a2 + hstep, voffA);
            PG8_WAIT_L(8); PG8_BAR; PG8_WAIT_L(0); PG8_MMA(0, 0, At, B0); PG8_BAR; PG8_SCHED;
            PG8_LDB(B1, 1, 1); PG8_STAGE(PG8_SB(1, 0), b3, voffB);
            PG8_BAR; PG8_WAIT_L(0); PG8_MMA(0, 1, At, B1); PG8_BAR;
            PG8_LDA(At, 1, 1); PG8_STAGE(PG8_SA(1, 0), a3, voffA);
            PG8_BAR; PG8_WAIT_L(0); PG8_MMA(1, 0, At, B0); PG8_BAR; PG8_SCHED;
            PG8_STAGE(PG8_SB(1, 1), b3 + hstep, voffB);
            PG8_WAIT_V(6); PG8_BAR; PG8_MMA(1, 1, At, B1); PG8_BAR;
        }
        PG8_STAMP();
        if constexpr (!Epi::AFTER_DRAIN) { E(acc, cur, wr, wc, fr, fq); S.done(cur); }
        PG8_STAMP();
        if (!has_next) break;
#pragma unroll
        for (int a = 0; a < 2; ++a)
#pragma unroll
            for (int b = 0; b < 2; ++b)
#pragma unroll
                for (int m = 0; m < 4; ++m)
#pragma unroll
                    for (int n = 0; n < 2; ++n) acc[a][b][m][n] = (f32x4){0.f, 0.f, 0.f, 0.f};
        cur = nxt; cA = nA; cB = nB; ++ui;
    }
    PG8_WAIT_V(0);
    if (wr == 0) PG8_BAR;
    PG8_BAR;
    if constexpr (Epi::AFTER_DRAIN) { E.fused(acc, cur, wr, wc, fr, fq, lds, wid, lane); S.done(cur); }
    PG8_STAMP();
    if (STAMP && wid == 0) { stamps[lane] = lane < nts ? (((unsigned long long)(unsigned)ts_hi << 32) | (unsigned)ts_lo) : 0ull;
        if (lane == 62) stamps[62] = rt_entry; if (lane == 63) stamps[63] = (unsigned long long)wall_clock64(); }
#undef PG8_STAMP
#undef PG8_SA
#undef PG8_SB
#undef PG8_STAGE
#undef PG8_LDA
#undef PG8_LDB
#undef PG8_MMA
#undef PG8_WAIT_V
#undef PG8_WAIT_L
#undef PG8_BAR
#undef PG8_SCHED
}
}
#define XB_TMO      128
#define XB_XCNT(j)  (256  + 64 * (j))
#define XB_XSUB(j)  (1280 + 64 * (j))
#define XB_XGEN(j)  (2304 + 64 * (j))
#define XB_TOP      3328
#define XB_TOPGEN   3392
#define XCD_BAR_WORDS 3456
#define XB_SPIN_CAP (1u << 18)

__device__ __forceinline__ unsigned xb_ld(unsigned* p)              { return __hip_atomic_load(p, __ATOMIC_RELAXED, __HIP_MEMORY_SCOPE_AGENT); }
__device__ __forceinline__ unsigned xb_add(unsigned* p, unsigned v) { return __hip_atomic_fetch_add(p, v, __ATOMIC_RELAXED, __HIP_MEMORY_SCOPE_AGENT); }
__device__ __forceinline__ unsigned xb_xcc_id() { return (unsigned)__builtin_amdgcn_s_getreg((3 << 11) | 20) & 0xFu; }
#define XB_SPIN(cond, bar) do { unsigned _sp = 0; while (cond) { __builtin_amdgcn_s_sleep(1); \
    if ((++_sp & 255u) == 0u) { if (xb_ld(&(bar)[XB_TMO])) break; if (_sp > XB_SPIN_CAP) { atomicAdd(&(bar)[XB_TMO], 1u); break; } } } } while (0)

struct XcdBarrier {
    unsigned* bar; unsigned x;
    volatile LAS unsigned* st;
};

__device__ __forceinline__ XcdBarrier xcd_barrier_post(unsigned* bar, volatile LAS unsigned* st) {
    XcdBarrier b; b.bar = bar; b.x = xb_xcc_id(); b.st = st;
    if (threadIdx.x == 0) (void)xb_add(&bar[XB_XCNT(b.x)], 1u);
    return b;
}
__device__ __forceinline__ void xcd_barrier_complete(unsigned* bar, unsigned x, unsigned& nloc, unsigned& nx) {
    const unsigned G = gridDim.x * gridDim.y * gridDim.z;
    unsigned sum, cnt, mine, sp = 0u;
    for (;;) {
        sum = 0u; cnt = 0u; mine = 0u;
#pragma unroll
        for (unsigned j = 0; j < 16; ++j) { const unsigned c = xb_ld(&bar[XB_XCNT(j)]); sum += c; cnt += (c > 0u) ? 1u : 0u; mine = (j == x) ? c : mine; }
        if (sum == G) break;
        __builtin_amdgcn_s_sleep(1);
        if ((++sp & 255u) == 0u) { if (xb_ld(&bar[XB_TMO])) break; if (sp > XB_SPIN_CAP) { atomicAdd(&bar[XB_TMO], 1u); break; } }
    }
    nloc = mine > 0u ? mine : 1u; nx = cnt > 0u ? cnt : 1u;
}

__device__ __forceinline__ void xcd_barrier(const XcdBarrier& b) {
    asm volatile("s_waitcnt vmcnt(0)" ::: "memory");
    __syncthreads();
    if (threadIdx.x == 0) {
        unsigned* bar = b.bar;
        __builtin_amdgcn_s_waitcnt(0);
        unsigned nloc = b.st[0], nx = b.st[1];
        if (nloc == 0u) { xcd_barrier_complete(bar, b.x, nloc, nx); b.st[0] = nloc; b.st[1] = nx; }
        const unsigned old = xb_add(&bar[XB_XSUB(b.x)], 1u);
        const unsigned gen = old / nloc;
        if (old + 1u == (gen + 1u) * nloc) {
            __builtin_amdgcn_fence(__ATOMIC_RELEASE, "agent");
            asm volatile("s_waitcnt vmcnt(0)" ::: "memory");
            const unsigned og = xb_add(&bar[XB_TOP], 1u);
            const unsigned tg = og / nx;
            if (og + 1u == (tg + 1u) * nx) xb_add(&bar[XB_TOPGEN], 1u);
            else XB_SPIN(xb_ld(&bar[XB_TOPGEN]) == tg, bar);
            __builtin_amdgcn_fence(__ATOMIC_ACQUIRE, "agent");
            xb_add(&bar[XB_XGEN(b.x)], 1u);
            asm volatile("s_waitcnt vmcnt(0)" ::: "memory");
        } else {
            XB_SPIN(xb_ld(&bar[XB_XGEN(b.x)]) == gen, bar);
            __builtin_amdgcn_fence(__ATOMIC_ACQUIRE, "agent");
            asm volatile("s_waitcnt vmcnt(0)" ::: "memory");
        }
    }
    __syncthreads();
}

typedef unsigned short bf16_t;
typedef short bf16x8 __attribute__((ext_vector_type(8)));
typedef short bf16x4 __attribute__((ext_vector_type(4)));
typedef float f32x4 __attribute__((ext_vector_type(4)));
typedef unsigned u32x4 __attribute__((ext_vector_type(4)));
typedef unsigned u32x2 __attribute__((ext_vector_type(2)));
constexpr int DM = 1024, NBATCH = 8, SEQ = 4096, NTOK = NBATCH * SEQ, DEPTH = 2;
constexpr int INW = 3968, INWP = 4096, FFN = 2816, NMOD = 6;
constexpr int C_AQ = 0, C_AK = 384, C_AV = 768, C_RQ = 1152, C_RK = 1536, C_RV = 1920, C_RG = 2304, C_HQ = 2688, C_HZF = 2944, C_HZB = 3200, C_HI = 3456, C_HG = 3712;
constexpr float NORM_EPS = 1e-6f;
constexpr int NTHREADS = 512;
constexpr int LDS_BYTES = 135168;
constexpr size_t WS_CTL = 0, WS_MOD = 16384, WS_LB = WS_MOD + 393216, WS_HGA = WS_LB + 2048, WS_LSE = WS_HGA + 524288, WS_WIN = WS_LSE + 2359296,
    WS_WOUT = WS_WIN + 16777216, WS_WGU = WS_WOUT + 4194304, WS_WDN = WS_WGU + 23068672, WS_HBUF = WS_WDN + 11534336, WS_PROJ = WS_HBUF + 67108864,
    WS_OB = WS_PROJ + 260046848, WS_RST = WS_OB + 75497472, WS_HGU = WS_RST + 25165824, WS_END = WS_HGU + 33554432;

struct Params {
    const float *x, *c, *w_ada, *b_ada, *g_mix, *w_in, *ret_gn, *hgrn_gn, *lb_logits, *w_out, *g_ffn, *w_gu, *w_down, *g_final;
    float* out; unsigned char* ws; int ph_lo, ph_hi;
};

__device__ __forceinline__ float bf2f(bf16_t v) { return __uint_as_float(((unsigned)v) << 16); }
__device__ __forceinline__ float bflo(unsigned w) { return __uint_as_float(w << 16); }
__device__ __forceinline__ float bfhi(unsigned w) { return __uint_as_float(w & 0xffff0000u); }
__device__ __forceinline__ bf16_t f2bf(float f) { return __builtin_bit_cast(bf16_t, (__bf16)f); }
typedef float f32x2c __attribute__((ext_vector_type(2)));
typedef __bf16 bf16v2c __attribute__((ext_vector_type(2)));
__device__ __forceinline__ unsigned pk2(float lo, float hi) { const f32x2c v = {lo, hi}; return __builtin_bit_cast(unsigned, __builtin_convertvector(v, bf16v2c)); }
__device__ __forceinline__ bf16x4 pk4(f32x4 v) { u32x2 w; w.x = pk2(v[0], v[1]); w.y = pk2(v[2], v[3]); return __builtin_bit_cast(bf16x4, w); }
__device__ __forceinline__ float siluf(float v) { return v * __builtin_amdgcn_rcpf(1.0f + __expf(-v)); }
__device__ __forceinline__ float wave_sum(float v) {
#pragma unroll
    for (int o = 1; o < 64; o <<= 1) v += __shfl_xor(v, o);
    return v;
}
#define MFMA32(a, b, c) __builtin_amdgcn_mfma_f32_16x16x32_bf16((a), (b), (c), 0, 0, 0)
#define MFMA16(a, b, c) __builtin_amdgcn_mfma_f32_16x16x16bf16_1k((a), (b), (c), 0, 0, 0)

struct EpiProj {
    static constexpr bool PERM = true, AFTER_DRAIN = false;
    bf16_t* O; int ldc, ncols;
    __device__ __forceinline__ void operator()(const f32x4 (&acc)[2][2][4][2], const pg8::Unit& u, int wr, int wc, int fr, int fq) const {
        const int row0 = u.pm * 256 + wr * 64 + fr, col0 = u.pn * 256 + wc * 32 + 8 * fq;
#pragma unroll
        for (int ai = 0; ai < 2; ++ai)
#pragma unroll
            for (int m = 0; m < 4; ++m) { bf16_t* rowp = O + (size_t)(row0 + ai * 128 + m * 16) * ldc + col0;
#pragma unroll
                for (int bj = 0; bj < 2; ++bj) { if (col0 + bj * 128 < ncols) { const f32x4 v0 = acc[ai][bj][m][0], v1 = acc[ai][bj][m][1];
                    u32x4 w; w.x = pk2(v0[0], v0[1]); w.y = pk2(v0[2], v0[3]); w.z = pk2(v1[0], v1[1]); w.w = pk2(v1[2], v1[3]);
                    *(u32x4*)(rowp + bj * 128) = w; } } }
    }
};
struct EpiRes {
    static constexpr bool PERM = false, AFTER_DRAIN = false;
    const float* base; float* out; const float* gate;
    __device__ __forceinline__ void operator()(const f32x4 (&acc)[2][2][4][2], const pg8::Unit& u, int wr, int wc, int fr, int fq) const {
        const int row0 = u.pm * 256 + wr * 64 + fr, col0 = u.pn * 256 + wc * 32 + 4 * fq;
        const float* gp = gate + (size_t)((u.pm * 256) >> 12) * (NMOD * DM) + col0;
        f32x4 gv[2][2];
#pragma unroll
        for (int bj = 0; bj < 2; ++bj)
#pragma unroll
            for (int n = 0; n < 2; ++n) gv[bj][n] = *(const f32x4*)(gp + bj * 128 + n * 16);
#pragma unroll
        for (int ai = 0; ai < 2; ++ai)
#pragma unroll
            for (int m = 0; m < 4; ++m) { const size_t off = (size_t)(row0 + ai * 128 + m * 16) * DM + col0;
#pragma unroll
                for (int bj = 0; bj < 2; ++bj)
#pragma unroll
                    for (int n = 0; n < 2; ++n) { const f32x4 bs = *(const f32x4*)(base + off + bj * 128 + n * 16);
                        *(f32x4*)(out + off + bj * 128 + n * 16) = bs + gv[bj][n] * acc[ai][bj][m][n]; } }
    }
};
struct EpiSwiglu {
    static constexpr bool PERM = true, AFTER_DRAIN = false;
    bf16_t* O;
    __device__ __forceinline__ void operator()(const f32x4 (&acc)[2][2][4][2], const pg8::Unit& u, int wr, int wc, int fr, int fq) const {
        const int row0 = u.pm * 256 + wr * 64 + fr, col0 = u.pn * 128 + wc * 32 + 8 * fq;
#pragma unroll
        for (int ai = 0; ai < 2; ++ai)
#pragma unroll
            for (int m = 0; m < 4; ++m) { bf16_t* rowp = O + (size_t)(row0 + ai * 128 + m * 16) * FFN + col0;
                float r[8];
#pragma unroll
                for (int n = 0; n < 2; ++n)
#pragma unroll
                    for (int i = 0; i < 4; ++i) { const float g = acc[ai][0][m][n][i], uu = acc[ai][1][m][n][i]; r[n * 4 + i] = siluf(g) * uu; }
                u32x4 w; w.x = pk2(r[0], r[1]); w.y = pk2(r[2], r[3]); w.z = pk2(r[4], r[5]); w.w = pk2(r[6], r[7]);
                *(u32x4*)rowp = w; }
    }
};
__device__ __forceinline__ void transpose_item(const float* W, int K, int N, bf16_t* WT, int dst_row0, int src_col0, int k0, LAS float* scr, int lane) {
    const int c = lane & 7, nr = lane >> 3;
    if (src_col0 < 0) {
#pragma unroll
        for (int j = 0; j < 8; ++j) *(u32x4*)(WT + (size_t)(dst_row0 + nr + 8 * j) * K + k0 + 8 * c) = (u32x4){0u, 0u, 0u, 0u};
        return;
    }
    const int kr = lane >> 4, c4 = lane & 15;
    f32x4 v[16];
#pragma unroll
    for (int i = 0; i < 16; ++i) v[i] = *(const f32x4*)(W + (size_t)(k0 + 4 * i + kr) * N + src_col0 + 4 * c4);
#pragma unroll
    for (int i = 0; i < 16; ++i) { LAS float* d = scr + (4 * i + kr) * 65 + 4 * c4; d[0] = v[i][0]; d[1] = v[i][1]; d[2] = v[i][2]; d[3] = v[i][3]; }
    __builtin_amdgcn_fence(__ATOMIC_RELEASE, "wavefront"); __builtin_amdgcn_wave_barrier(); __builtin_amdgcn_fence(__ATOMIC_ACQUIRE, "wavefront");
#pragma unroll
    for (int j = 0; j < 8; ++j) { const int n = nr + 8 * j; const LAS float* sp = scr + (8 * c) * 65 + n;
        u32x4 o; o.x = pk2(sp[0 * 65], sp[1 * 65]); o.y = pk2(sp[2 * 65], sp[3 * 65]); o.z = pk2(sp[4 * 65], sp[5 * 65]); o.w = pk2(sp[6 * 65], sp[7 * 65]);
        *(u32x4*)(WT + (size_t)(dst_row0 + n) * K + k0 + 8 * c) = o; }
    __builtin_amdgcn_fence(__ATOMIC_RELEASE, "wavefront"); __builtin_amdgcn_wave_barrier(); __builtin_amdgcn_fence(__ATOMIC_ACQUIRE, "wavefront");
}

__device__ __forceinline__ void phase_weights(const Params& P, LAS unsigned char* lds) {
    const int tid = opaque_tid(), lane = tid & 63, wave = __builtin_amdgcn_readfirstlane(tid >> 6);
    unsigned char* ws = P.ws;
    {
        LAS float* scr = (LAS float*)(lds + wave * 16640);
        const int gw = blockIdx.x * 8 + wave, NGW = gridDim.x * 8;
        constexpr int I_IN = 16 * 64, I_OUT = 16 * 16, I_GU = 16 * 88, I_DN = 44 * 16, I_L = I_IN + I_OUT + I_GU + I_DN;
        for (int it = gw; it < DEPTH * I_L; it += NGW) {
            const int l = it / I_L; int r = it % I_L;
            if (r < I_IN) { const int kb = r / 64, nb = r % 64, n0 = nb * 64;
                transpose_item(P.w_in + (size_t)l * DM * INW, DM, INW, (bf16_t*)(ws + WS_WIN) + (size_t)l * INWP * DM, n0, n0 < INW ? n0 : -1, kb * 64, scr, lane); continue; }
            r -= I_IN;
            if (r < I_OUT) { const int kb = r / 16, nb = r % 16;
                transpose_item(P.w_out + (size_t)l * DM * DM, DM, DM, (bf16_t*)(ws + WS_WOUT) + (size_t)l * DM * DM, nb * 64, nb * 64, kb * 64, scr, lane); continue; }
            r -= I_OUT;
            if (r < I_GU) { const int kb = r / 88, nb = r % 88, n0 = nb * 64; const int pn = n0 >> 8, half = (n0 >> 7) & 1, jj = n0 & 127;
                transpose_item(P.w_gu + (size_t)l * DM * 2 * FFN, DM, 2 * FFN, (bf16_t*)(ws + WS_WGU) + (size_t)l * 2 * FFN * DM, n0, half * FFN + pn * 128 + jj, kb * 64, scr, lane); continue; }
            r -= I_GU;
            { const int kb = r / 16, nb = r % 16;
                transpose_item(P.w_down + (size_t)l * FFN * DM, FFN, DM, (bf16_t*)(ws + WS_WDN) + (size_t)l * DM * FFN, nb * 64, nb * 64, kb * 64, scr, lane); }
        }
    }
}
__device__ __forceinline__ void phase_prologue(const Params& P, LAS unsigned char* lds) {
    const int tid = opaque_tid();
    unsigned char* ws = P.ws;
    {
        LAS float* sc = (LAS float*)lds;
        LAS float* red = (LAS float*)(lds + 32768);
        for (int i = tid; i < NBATCH * DM; i += NTHREADS) sc[i] = siluf(P.c[i]);
        __syncthreads();
        float* mod = (float*)(ws + WS_MOD);
        for (int u = blockIdx.x; u < DEPTH * 96; u += gridDim.x) {
            const int l = u / 96, j0 = (u % 96) * 64, col = tid & 63, kp = tid >> 6;
            float acc[8];
#pragma unroll
            for (int b = 0; b < 8; ++b) acc[b] = 0.f;
            const float* wp = P.w_ada + (size_t)l * DM * (NMOD * DM) + j0 + col;
            for (int k = kp * 128; k < kp * 128 + 128; ++k) { const float w = wp[(size_t)k * (NMOD * DM)];
#pragma unroll
                for (int b = 0; b < 8; ++b) acc[b] += sc[b * DM + k] * w; }
#pragma unroll
            for (int b = 0; b < 8; ++b) red[(kp * 8 + b) * 64 + col] = acc[b];
            __syncthreads();
            { const int b = tid >> 6; float s = 0.f;
#pragma unroll
              for (int p = 0; p < 8; ++p) s += red[(p * 8 + b) * 64 + col];
              mod[((size_t)l * NBATCH + b) * (NMOD * DM) + j0 + col] = s + P.b_ada[(size_t)l * NMOD * DM + j0 + col]; }
            __syncthreads();
        }
    }
    if (blockIdx.x == 0 && tid < 256) {
        const float l0 = P.lb_logits[tid], l1 = P.lb_logits[256 + tid], m = fmaxf(l0, l1), e0 = __expf(l0 - m), e1 = __expf(l1 - m);
        const float p0 = e0 / (e0 + e1), p1 = e1 / (e0 + e1);
        float* lb = (float*)(ws + WS_LB);
        lb[tid] = fminf(fmaxf(p0 - p0, 0.f), 1.0f - 1e-6f);
        lb[256 + tid] = fminf(fmaxf((p0 + p1) - p0, 0.f), 1.0f - 1e-6f);
    }
}

template <int NY, bool WRITE_X, bool FINAL>
__device__ __forceinline__ void phase_norm(const float* src, const bf16_t* y, const float* gate, const bf16_t* y2, const float* gate2, float* xout, const float* g, const float* shift, const float* scale, bf16_t* dst) {
    constexpr bool HAS_Y = NY > 0;
    const int tid = opaque_tid(), lane = tid & 63, wave = tid >> 6;
    const int gw = blockIdx.x * 8 + wave, NGW = gridDim.x * 8;
    f32x4 gv[4];
#pragma unroll
    for (int j = 0; j < 4; ++j) gv[j] = *(const f32x4*)(g + 4 * lane + 256 * j);
    const int WPB = NGW / NBATCH, b = gw / WPB;
    if (b >= NBATCH) return;
    f32x4 gtv[4], gtv2[4], scv[4], shv[4];
#pragma unroll
    for (int j = 0; j < 4; ++j) {
        if (HAS_Y) gtv[j] = *(const f32x4*)(gate + (size_t)b * (NMOD * DM) + 4 * lane + 256 * j);
        if (NY > 1) gtv2[j] = *(const f32x4*)(gate2 + (size_t)b * (NMOD * DM) + 4 * lane + 256 * j);
        if (!FINAL) { scv[j] = *(const f32x4*)(scale + (size_t)b * (NMOD * DM) + 4 * lane + 256 * j) + 1.0f; shv[j] = *(const f32x4*)(shift + (size_t)b * (NMOD * DM) + 4 * lane + 256 * j); }
    }
    for (int row = b * SEQ + (gw - b * WPB); row < (b + 1) * SEQ; row += WPB) {
        const f32x4* xr = (const f32x4*)(src + (size_t)row * DM) + lane;
        f32x4 v[4]; float s = 0.f;
#pragma unroll
        for (int j = 0; j < 4; ++j) v[j] = xr[64 * j];
        if (HAS_Y) {
            const u32x2* yr = (const u32x2*)(y + (size_t)row * DM) + lane;
#pragma unroll
            for (int j = 0; j < 4; ++j) { const u32x2 yw = yr[64 * j]; const f32x4 gt = gtv[j];
                v[j][0] += gt[0] * bflo(yw.x); v[j][1] += gt[1] * bfhi(yw.x); v[j][2] += gt[2] * bflo(yw.y); v[j][3] += gt[3] * bfhi(yw.y); }
        }
        if (NY > 1) {
            const u32x2* yr2 = (const u32x2*)(y2 + (size_t)row * DM) + lane;
#pragma unroll
            for (int j = 0; j < 4; ++j) { const u32x2 yw = yr2[64 * j]; const f32x4 gt = gtv2[j];
                v[j][0] += gt[0] * bflo(yw.x); v[j][1] += gt[1] * bfhi(yw.x); v[j][2] += gt[2] * bflo(yw.y); v[j][3] += gt[3] * bfhi(yw.y); }
        }
#pragma unroll
        for (int j = 0; j < 4; ++j) s += (v[j][0] * v[j][0] + v[j][1] * v[j][1]) + (v[j][2] * v[j][2] + v[j][3] * v[j][3]);
        const float rstd = rsqrtf(wave_sum(s) * (1.0f / DM) + NORM_EPS);
        f32x4* xo = (f32x4*)(xout + (size_t)row * DM) + lane;
        if (FINAL) {
#pragma unroll
            for (int j = 0; j < 4; ++j) xo[64 * j] = v[j] * rstd * gv[j];
        } else {
            if (WRITE_X) {
#pragma unroll
                for (int j = 0; j < 4; ++j) xo[64 * j] = v[j];
            }
            unsigned long long* o8 = (unsigned long long*)(dst + (size_t)row * DM) + lane;
#pragma unroll
            for (int j = 0; j < 4; ++j) {
                const f32x4 h = v[j] * rstd * gv[j] * scv[j] + shv[j];
                o8[64 * j] = (unsigned long long)pk2(h[0], h[1]) | ((unsigned long long)pk2(h[2], h[3]) << 32);
            }
        }
    }
}
__device__ __forceinline__ bf16x4 tr4(const LAS bf16_t* img, int pitch, int row0, int col0, int g, int q) {
    return __builtin_amdgcn_ds_read_tr16_b64_v4i16((LAS bf16x4*)(img + (row0 + 4 * g + (q >> 2)) * pitch + col0 + 4 * (q & 3)));
}
__device__ __forceinline__ bf16x8 tr8(const LAS bf16_t* img, int pitch, int row0, int col0, int g, int q) {
    const bf16x4 lo = __builtin_amdgcn_ds_read_tr16_b64_v4i16((LAS bf16x4*)(img + (row0 + 8 * g + (q >> 2)) * pitch + col0 + 4 * (q & 3)));
    const bf16x4 hi = __builtin_amdgcn_ds_read_tr16_b64_v4i16((LAS bf16x4*)(img + (row0 + 8 * g + 4 + (q >> 2)) * pitch + col0 + 4 * (q & 3)));
    return __builtin_shufflevector(lo, hi, 0, 1, 2, 3, 4, 5, 6, 7);
}
struct AttRegs { u32x4 kv[2][4], vv[2][4]; bf16x8 qf[2][2]; };
constexpr int ATT_UNITS = 2304;
__device__ __forceinline__ void att_decode(int u, int& br, int& b, int& h, int& r, int& L, int& p0, int& tok0) {
    const int pi = u >> 6, k = u & 63; b = pi / 6; h = pi % 6; br = k >> 4; const int w = k & 15;
    const int lr = br * 2, nblk = 16 >> lr, rho = w >> (4 - lr), blk = w & (nblk - 1); r = 1 << lr; L = SEQ >> lr; p0 = blk * 256; tok0 = b * SEQ + rho;
}
__device__ __forceinline__ int att_unit(int li, int x) { const int pl = li / 48, k = li - pl * 48; return ((x + 8 * pl) << 6) | k; }
__device__ __forceinline__ void att_load(const Params& P, int u, int tid, AttRegs& R) {
    int br, b, h, r, L, p0, tok0; att_decode(u, br, b, h, r, L, p0, tok0);
    const bf16_t* proj = (const bf16_t*)(P.ws + WS_PROJ);
#pragma unroll
    for (int it = 0; it < 2; ++it) {
        const int item = tid + it * NTHREADS, key = item >> 1, half = item & 1, kj = p0 - 64 + key;
        if (item < 768 && kj >= 0 && kj < L) {
            const bf16_t* src = proj + (size_t)(tok0 + r * kj) * INW + h * 64 + half * 32;
#pragma unroll
            for (int i = 0; i < 4; ++i) { R.kv[it][i] = *(const u32x4*)(src + C_AK + 8 * i); R.vv[it][i] = *(const u32x4*)(src + C_AV + 8 * i); }
        } else {
#pragma unroll
            for (int i = 0; i < 4; ++i) { R.kv[it][i] = (u32x4){0u, 0u, 0u, 0u}; R.vv[it][i] = (u32x4){0u, 0u, 0u, 0u}; }
        }
    }
    const int lane = tid & 63, wave = tid >> 6, q = lane & 15, g = lane >> 4;
#pragma unroll
    for (int qt = 0; qt < 2; ++qt) {
        const size_t tokq = (size_t)(tok0 + r * (p0 + 32 * wave + 16 * qt + q));
#pragma unroll
        for (int kk = 0; kk < 2; ++kk) R.qf[qt][kk] = *(const bf16x8*)(proj + tokq * INW + C_AQ + h * 64 + kk * 32 + 8 * g);
    }
}
__device__ __forceinline__ void att_phase(const Params& P, LAS unsigned char* lds) {
    const int tid = opaque_tid(), lane = tid & 63, wave = __builtin_amdgcn_readfirstlane(tid >> 6), q = lane & 15, g = lane >> 4;
    LAS bf16_t* Ks = (LAS bf16_t*)lds;
    LAS bf16_t* Vs = (LAS bf16_t*)(lds + 55296);
    const int xq = blockIdx.x & 7, nj = ((int)gridDim.x + 7 - xq) >> 3;
    int li = blockIdx.x >> 3; if (li >= 288) return;
    AttRegs R; att_load(P, att_unit(li, xq), tid, R);
    for (; li < 288; li += nj) {
        const int u = att_unit(li, xq);
        int br, b, h, r, L, p0, tok0; att_decode(u, br, b, h, r, L, p0, tok0);
#pragma unroll
        for (int it = 0; it < 2; ++it) {
            const int item = tid + it * NTHREADS, key = item >> 1, half = item & 1;
            if (item < 768) {
#pragma unroll
                for (int i = 0; i < 4; ++i) { *(LAS u32x4*)(Ks + key * 72 + half * 32 + 8 * i) = R.kv[it][i]; *(LAS u32x4*)(Vs + key * 72 + half * 32 + 8 * i) = R.vv[it][i]; }
            }
        }
        bf16x8 qf[2][2]; qf[0][0] = R.qf[0][0]; qf[0][1] = R.qf[0][1]; qf[1][0] = R.qf[1][0]; qf[1][1] = R.qf[1][1];
        __syncthreads();
        if (li + nj < 288) att_load(P, att_unit(li + nj, xq), tid, R);
        const float slope_l2 = exp2f(-8.0f * (float)(h + 1) / 6.0f) * (float)r * 1.44269504f, qk_l2 = 0.125f * 1.44269504f;
        const float fbase = (float)(64 + q - 4 * g);
        const bool edge = (p0 < 64) || (p0 + 320 > L);
#pragma unroll
        for (int qt = 0; qt < 2; ++qt) {
            const int kw = 32 * wave + 16 * qt;
            const int p = p0 + kw + q; const size_t tokq = (size_t)(tok0 + r * p);
            f32x4 st[9]; float mx = -3.0e38f;
#pragma unroll
            for (int t = 0; t < 9; ++t) {
                f32x4 acc = {0.f, 0.f, 0.f, 0.f};
#pragma unroll
                for (int kk = 0; kk < 2; ++kk) { const bf16x8 a = *(const LAS bf16x8*)(Ks + (kw + 16 * t + q) * 72 + kk * 32 + 8 * g); acc = MFMA32(a, qf[qt][kk], acc); }
#pragma unroll
                for (int j = 0; j < 4; ++j) {
                    const float d = fabsf(fbase - (float)(16 * t + j));
                    float s = acc[j] * qk_l2 - slope_l2 * d;
                    if (t == 0 || t == 8) s = (d <= 64.0f) ? s : -1.0e30f;
                    acc[j] = s;
                }
                if (edge) {
#pragma unroll
                    for (int j = 0; j < 4; ++j) { const int kj = p0 - 64 + kw + 16 * t + 4 * g + j; acc[j] = (kj >= 0 && kj < L) ? acc[j] : -1.0e30f; }
                }
#pragma unroll
                for (int j = 0; j < 4; ++j) mx = fmaxf(mx, acc[j]);
                st[t] = acc;
            }
            mx = fmaxf(mx, __shfl_xor(mx, 16)); mx = fmaxf(mx, __shfl_xor(mx, 32));
            float ls = 0.f; bf16x4 pt[9];
#pragma unroll
            for (int t = 0; t < 9; ++t) { f32x4 e;
#pragma unroll
                for (int j = 0; j < 4; ++j) { e[j] = __builtin_amdgcn_exp2f(st[t][j] - mx); ls += e[j]; }
                pt[t] = pk4(e); }
            ls += __shfl_xor(ls, 16); ls += __shfl_xor(ls, 32);
            const float inv = __builtin_amdgcn_rcpf(ls);
            bf16_t* ob = (bf16_t*)(P.ws + WS_OB) + ((size_t)br * NTOK + tokq) * 384 + h * 64;
            const LAS bf16_t* vrd = Vs + (kw + 4 * g + (q >> 2)) * 72 + 4 * (q & 3);
#pragma unroll
            for (int dt = 0; dt < 4; ++dt) {
                f32x4 acc = {0.f, 0.f, 0.f, 0.f};
#pragma unroll
                for (int t = 0; t < 9; ++t) { const bf16x4 a = __builtin_amdgcn_ds_read_tr16_b64_v4i16((LAS bf16x4*)(vrd + 16 * t * 72 + dt * 16)); acc = MFMA16(a, pt[t], acc); }
                acc = acc * inv;
                *(bf16x4*)(ob + dt * 16 + 4 * g) = pk4(acc);
            }
            if (g == 0) ((float*)(P.ws + WS_LSE))[((size_t)br * NTOK + tokq) * 6 + h] = (mx + __log2f(ls)) * 0.69314718f;
        }
        __syncthreads();
    }
}
__device__ __forceinline__ void att_merge(const Params& P) {
    const bf16_t* ob = (const bf16_t*)(P.ws + WS_OB); const float* lse = (const float*)(P.ws + WS_LSE); bf16_t* mixed = (bf16_t*)(P.ws + WS_HBUF);
    for (size_t it = (size_t)blockIdx.x * NTHREADS + opaque_tid(); it < (size_t)NTOK * 48; it += (size_t)gridDim.x * NTHREADS) {
        const size_t tok = it / 48; const int grp = (int)(it % 48), h = grp >> 3;
        const float l0 = lse[tok * 6 + h], l1 = lse[((size_t)NTOK + tok) * 6 + h], l2 = lse[((size_t)2 * NTOK + tok) * 6 + h];
        const float m = fmaxf(l0, fmaxf(l1, l2)), e0 = __expf(l0 - m), e1 = __expf(l1 - m), e2 = __expf(l2 - m), is = __builtin_amdgcn_rcpf(e0 + e1 + e2);
        const float w0 = e0 * is, w1 = e1 * is, w2 = e2 * is;
        const u32x4 a = *(const u32x4*)(ob + tok * 384 + grp * 8), bq = *(const u32x4*)(ob + ((size_t)NTOK + tok) * 384 + grp * 8), cq = *(const u32x4*)(ob + ((size_t)2 * NTOK + tok) * 384 + grp * 8);
        u32x4 o;
#pragma unroll
        for (int i = 0; i < 4; ++i) o[i] = pk2(w0 * bflo(a[i]) + w1 * bflo(bq[i]) + w2 * bflo(cq[i]), w0 * bfhi(a[i]) + w1 * bfhi(bq[i]) + w2 * bfhi(cq[i]));
        *(u32x4*)(mixed + tok * DM + grp * 8) = o;
    }
}

__device__ __forceinline__ float ret_logg(int h) { return log1pf(-exp2f(-5.0f - (float)h)); }
struct RetARegs { u32x4 k0, k1, v0, v1; };
__device__ __forceinline__ void retA_load(const Params& P, int u, int tid, RetARegs& R) {
    const int bh = u >> 5, n = u & 31, b = bh / 6, h = bh % 6, c = tid >> 2, qd = tid & 3;
    const bf16_t* src = (const bf16_t*)(P.ws + WS_PROJ) + (size_t)(b * SEQ + n * 128 + c) * INW + h * 64 + qd * 16;
    R.k0 = *(const u32x4*)(src + C_RK); R.k1 = *(const u32x4*)(src + C_RK + 8); R.v0 = *(const u32x4*)(src + C_RV); R.v1 = *(const u32x4*)(src + C_RV + 8);
}
__device__ __forceinline__ void retA_phase(const Params& P, LAS unsigned char* lds) {
    const int tid = opaque_tid(), lane = tid & 63, wave = __builtin_amdgcn_readfirstlane(tid >> 6), q = lane & 15, g = lane >> 4;
    LAS bf16_t* Kf = (LAS bf16_t*)lds; LAS bf16_t* Kb = (LAS bf16_t*)(lds + 18432); LAS bf16_t* Vs = (LAS bf16_t*)(lds + 36864);
    int u = blockIdx.x; if (u >= 1536) return;
    RetARegs R; retA_load(P, u, tid, R);
    for (; u < 1536; u += gridDim.x) {
        const int bh = u >> 5, n = u & 31, h = bh % 6;
        const float lg = ret_logg(h);
        {
            const int c = tid >> 2, qd = tid & 3;
            const float wf = 0.125f * __expf(lg * (float)(127 - c)), wb = 0.125f * __expf(lg * (float)c);
            u32x4 f0, f1, b0, b1;
#pragma unroll
            for (int e = 0; e < 4; ++e) { f0[e] = pk2(bflo(R.k0[e]) * wf, bfhi(R.k0[e]) * wf); f1[e] = pk2(bflo(R.k1[e]) * wf, bfhi(R.k1[e]) * wf);
                b0[e] = pk2(bflo(R.k0[e]) * wb, bfhi(R.k0[e]) * wb); b1[e] = pk2(bflo(R.k1[e]) * wb, bfhi(R.k1[e]) * wb); }
            *(LAS u32x4*)(Kf + c * 72 + qd * 16) = f0; *(LAS u32x4*)(Kf + c * 72 + qd * 16 + 8) = f1;
            *(LAS u32x4*)(Kb + c * 72 + qd * 16) = b0; *(LAS u32x4*)(Kb + c * 72 + qd * 16 + 8) = b1;
            *(LAS u32x4*)(Vs + c * 72 + qd * 16) = R.v0; *(LAS u32x4*)(Vs + c * 72 + qd * 16 + 8) = R.v1;
        }
        __syncthreads();
        if (u + (int)gridDim.x < 1536) retA_load(P, u + gridDim.x, tid, R);
        const int dir = wave >> 2, dt = wave & 3; const LAS bf16_t* Kt = dir ? Kb : Kf;
        bf16x8 afr[4];
#pragma unroll
        for (int kk = 0; kk < 4; ++kk) afr[kk] = tr8(Kt, 72, kk * 32, dt * 16, g, q);
        bf16_t* dst = (bf16_t*)(P.ws + WS_RST) + ((size_t)(bh * 32 + n) * 2 + dir) * 4096;
#pragma unroll
        for (int et = 0; et < 4; ++et) {
            f32x4 acc = {0.f, 0.f, 0.f, 0.f};
#pragma unroll
            for (int kk = 0; kk < 4; ++kk) { const bf16x8 bfr = tr8(Vs, 72, kk * 32, et * 16, g, q); acc = MFMA32(afr[kk], bfr, acc); }
            *(bf16x4*)(dst + (et * 16 + q) * 64 + dt * 16 + 4 * g) = pk4(acc);
        }
        __syncthreads();
    }
}
__device__ __forceinline__ void ret_scan(const Params& P) {
    bf16_t* st = (bf16_t*)(P.ws + WS_RST);
    for (int it = blockIdx.x * NTHREADS + opaque_tid(); it < 48 * 2 * 512; it += gridDim.x * NTHREADS) {
        const int ch = it & 511, dir = (it >> 9) & 1, bh = it >> 10, h = bh % 6;
        const float cd = __expf(ret_logg(h) * 128.0f);
        float s[8];
#pragma unroll
        for (int e = 0; e < 8; ++e) s[e] = 0.f;
        for (int i0 = 0; i0 < 32; i0 += 8) {
            u32x4 v[8];
#pragma unroll
            for (int i = 0; i < 8; ++i) { const int n = dir ? 31 - (i0 + i) : (i0 + i); v[i] = *(const u32x4*)(st + ((size_t)(bh * 32 + n) * 2 + dir) * 4096 + 8 * ch); }
#pragma unroll
            for (int i = 0; i < 8; ++i) { const int n = dir ? 31 - (i0 + i) : (i0 + i);
                u32x4 o;
#pragma unroll
                for (int e = 0; e < 4; ++e) o[e] = pk2(s[2 * e], s[2 * e + 1]);
                *(u32x4*)(st + ((size_t)(bh * 32 + n) * 2 + dir) * 4096 + 8 * ch) = o;
#pragma unroll
                for (int e = 0; e < 4; ++e) { s[2 * e] = cd * s[2 * e] + bflo(v[i][e]); s[2 * e + 1] = cd * s[2 * e + 1] + bfhi(v[i][e]); } }
        }
    }
}
struct RetBRegs { u32x4 k0, k1, v0, v1, rf, rb, q0, q1; };
__device__ __forceinline__ void retB_load(const Params& P, int u, int tid, RetBRegs& R) {
    const int bh = u >> 5, n = u & 31, b = bh / 6, h = bh % 6, c = tid >> 2, qd = tid & 3;
    const bf16_t* proj = (const bf16_t*)(P.ws + WS_PROJ);
    const bf16_t* src = proj + (size_t)(b * SEQ + n * 128 + c) * INW + h * 64 + qd * 16;
    R.k0 = *(const u32x4*)(src + C_RK); R.k1 = *(const u32x4*)(src + C_RK + 8); R.v0 = *(const u32x4*)(src + C_RV); R.v1 = *(const u32x4*)(src + C_RV + 8);
    const bf16_t* rs = (const bf16_t*)(P.ws + WS_RST) + (size_t)(bh * 32 + n) * 2 * 4096;
    const int e = tid >> 3, d8 = (tid & 7) * 8;
    R.rf = *(const u32x4*)(rs + e * 64 + d8); R.rb = *(const u32x4*)(rs + 4096 + e * 64 + d8);
    const int lane = tid & 63, wave = tid >> 6, q = lane & 15, g = lane >> 4;
    const bf16_t* qp = proj + (size_t)(b * SEQ + n * 128 + 16 * wave + q) * INW + C_RQ + h * 64 + 8 * g;
    R.q0 = *(const u32x4*)qp; R.q1 = *(const u32x4*)(qp + 32);
}
__device__ __forceinline__ void retB_phase(const Params& P, LAS unsigned char* lds, int layer) {
    const int tid = opaque_tid(), lane = tid & 63, wave = __builtin_amdgcn_readfirstlane(tid >> 6), q = lane & 15, g = lane >> 4;
    const bf16_t* proj = (const bf16_t*)(P.ws + WS_PROJ);
    LAS bf16_t* Ks = (LAS bf16_t*)lds;
    LAS bf16_t* Vs = (LAS bf16_t*)(lds + 18432);
    LAS bf16_t* Rf = (LAS bf16_t*)(lds + 36864);
    LAS bf16_t* Rb = (LAS bf16_t*)(lds + 46080);
    int u = blockIdx.x; if (u >= 1536) return;
    RetBRegs R; retB_load(P, u, tid, R);
    for (; u < 1536; u += gridDim.x) {
        const int bh = u >> 5, n = u & 31, b = bh / 6, h = bh % 6;
        const float lg = ret_logg(h);
        {
            const int c = tid >> 2, qd = tid & 3, e = tid >> 3, d8 = (tid & 7) * 8;
            *(LAS u32x4*)(Ks + c * 72 + qd * 16) = R.k0; *(LAS u32x4*)(Ks + c * 72 + qd * 16 + 8) = R.k1;
            *(LAS u32x4*)(Vs + c * 72 + qd * 16) = R.v0; *(LAS u32x4*)(Vs + c * 72 + qd * 16 + 8) = R.v1;
            *(LAS u32x4*)(Rf + e * 72 + d8) = R.rf; *(LAS u32x4*)(Rb + e * 72 + d8) = R.rb;
        }
        const u32x4 qraw[2] = {R.q0, R.q1};
        __syncthreads();
        if (u + (int)gridDim.x < 1536) retB_load(P, u + gridDim.x, tid, R);
        const int i = 16 * wave + q; const size_t tok = (size_t)(b * SEQ + n * 128 + i);
        u32x2 rgv[4]; f32x4 gnv[4];
#pragma unroll
        for (int et = 0; et < 4; ++et) { rgv[et] = *(const u32x2*)(proj + tok * INW + C_RG + h * 64 + et * 16 + 4 * g); gnv[et] = *(const f32x4*)(P.ret_gn + layer * 384 + h * 64 + et * 16 + 4 * g); }
        bf16x8 qf[2], qff[2], qfb[2];
        {
            const float ff = __expf(lg * (float)(i + 1)), fb = __expf(lg * (float)(128 - i));
#pragma unroll
            for (int kk = 0; kk < 2; ++kk) { const u32x4 raw = qraw[kk];
                qf[kk] = __builtin_bit_cast(bf16x8, raw); u32x4 a, c2;
#pragma unroll
                for (int e = 0; e < 4; ++e) { const float lo = bflo(raw[e]), hi = bfhi(raw[e]); a[e] = pk2(lo * ff, hi * ff); c2[e] = pk2(lo * fb, hi * fb); }
                qff[kk] = __builtin_bit_cast(bf16x8, a); qfb[kk] = __builtin_bit_cast(bf16x8, c2); }
        }
        bf16x4 pt[8];
#pragma unroll
        for (int jt = 0; jt < 8; ++jt) {
            f32x4 acc = {0.f, 0.f, 0.f, 0.f};
#pragma unroll
            for (int kk = 0; kk < 2; ++kk) { const bf16x8 a = *(const LAS bf16x8*)(Ks + (16 * jt + q) * 72 + kk * 32 + 8 * g); acc = MFMA32(a, qf[kk], acc); }
#pragma unroll
            for (int jj = 0; jj < 4; ++jj) { int dd = i - (16 * jt + 4 * g + jj); dd = dd < 0 ? -dd : dd; acc[jj] = acc[jj] * 0.125f * __expf(lg * (float)dd); }
            pt[jt] = pk4(acc);
        }
        f32x4 o[4];
#pragma unroll
        for (int et = 0; et < 4; ++et) {
            f32x4 acc = {0.f, 0.f, 0.f, 0.f};
#pragma unroll
            for (int jt = 0; jt < 8; ++jt) { const bf16x4 a = tr4(Vs, 72, 16 * jt, et * 16, g, q); acc = MFMA16(a, pt[jt], acc); }
#pragma unroll
            for (int kk = 0; kk < 2; ++kk) { const bf16x8 a = *(const LAS bf16x8*)(Rf + (et * 16 + q) * 72 + kk * 32 + 8 * g); acc = MFMA32(a, qff[kk], acc);
                const bf16x8 a2 = *(const LAS bf16x8*)(Rb + (et * 16 + q) * 72 + kk * 32 + 8 * g); acc = MFMA32(a2, qfb[kk], acc); }
            o[et] = acc;
        }
        float s = 0.f;
#pragma unroll
        for (int et = 0; et < 4; ++et) s += (o[et][0] + o[et][1]) + (o[et][2] + o[et][3]);
        s += __shfl_xor(s, 16); s += __shfl_xor(s, 32);
        const float mu = s * (1.0f / 64.0f); float vs = 0.f;
#pragma unroll
        for (int et = 0; et < 4; ++et) { o[et] = o[et] - mu; vs += (o[et][0] * o[et][0] + o[et][1] * o[et][1]) + (o[et][2] * o[et][2] + o[et][3] * o[et][3]); }
        vs += __shfl_xor(vs, 16); vs += __shfl_xor(vs, 32);
        const float rstd = rsqrtf(vs * (1.0f / 64.0f) + NORM_EPS);
        bf16_t* mixed = (bf16_t*)(P.ws + WS_HBUF) + tok * DM + 384 + h * 64;
#pragma unroll
        for (int et = 0; et < 4; ++et) {
            const f32x4 gn = gnv[et]; const u32x2 rg = rgv[et];
            f32x4 y; y[0] = o[et][0] * rstd * gn[0] * siluf(bflo(rg.x)); y[1] = o[et][1] * rstd * gn[1] * siluf(bfhi(rg.x));
            y[2] = o[et][2] * rstd * gn[2] * siluf(bflo(rg.y)); y[3] = o[et][3] * rstd * gn[3] * siluf(bfhi(rg.y));
            *(bf16x4*)(mixed + et * 16 + 4 * g) = pk4(y);
        }
        __syncthreads();
    }
}
__device__ __forceinline__ void hgrn_gate(float z, float lbv, float& f, float& kk) {
    z = fminf(fmaxf(z, -30.f), 30.f);
    const float ez = __expf(-z), sg = __builtin_amdgcn_rcpf(1.0f + ez);
    f = lbv + (1.0f - lbv) * sg; kk = (1.0f - lbv) * ez * sg;
}
__device__ __forceinline__ void hgA_unit(const Params& P, LAS unsigned char* lds, int u, int layer) {
    const int tid = opaque_tid(), lane = tid & 63, wave = __builtin_amdgcn_readfirstlane(tid >> 6), q = lane & 15, g = lane >> 4;
    const int bh = u >> 5, n = u & 31, b = bh >> 2, h = bh & 3;
    const bf16_t* proj = (const bf16_t*)(P.ws + WS_PROJ);
    LAS bf16_t* Kt = (LAS bf16_t*)lds;
    LAS bf16_t* Vt = (LAS bf16_t*)(lds + 34816);
    LAS float* segs = (LAS float*)(lds + 52224);
    const size_t tokc = (size_t)(b * SEQ + n * 128);
    {
        const int c = tid >> 2, qd = tid & 3; const bf16_t* src = proj + (tokc + c) * INW + C_HI + h * 64 + qd * 16;
        const u32x4 v0 = *(const u32x4*)src, v1 = *(const u32x4*)(src + 8);
#pragma unroll
        for (int e = 0; e < 8; ++e) { const unsigned vw = e < 4 ? v0[e & 3] : v1[e & 3]; const int d = qd * 16 + 2 * e;
            Vt[d * 136 + c] = (bf16_t)(vw & 0xffffu); Vt[(d + 1) * 136 + c] = (bf16_t)(vw >> 16); }
    }
    const int d = tid & 63, dir = (tid >> 6) & 1, seg = tid >> 7;
    const float lbv = ((const float*)(P.ws + WS_LB))[layer * 256 + h * 64 + d];
    float lf[32], kk[32];
    {
        const bf16_t* zp = proj + (tokc + seg * 32) * INW + (dir ? C_HZB : C_HZF) + h * 64 + d;
        bf16_t zr[32];
#pragma unroll
        for (int i = 0; i < 32; ++i) zr[i] = zp[(size_t)i * INW];
#pragma unroll
        for (int i = 0; i < 32; ++i) hgrn_gate(bf2f(zr[i]), lbv, lf[i], kk[i]);
    }
    float ssum = 1.f;
#pragma unroll
    for (int i = 0; i < 32; ++i) ssum *= lf[i];
    segs[(dir * 4 + seg) * 64 + d] = ssum;
    __syncthreads();
    {
        float before = 1.f, after = 1.f;
#pragma unroll
        for (int s2 = 0; s2 < 4; ++s2) { const float v = segs[(dir * 4 + s2) * 64 + d]; if (s2 < seg) before *= v; if (s2 > seg) after *= v; }
        LAS bf16_t* kt = Kt + dir * (64 * 136) + d * 136 + seg * 32;
        if (dir == 0) {
            float run = after;
#pragma unroll
            for (int i = 31; i >= 0; --i) { kt[i] = f2bf(kk[i] * run); run *= lf[i]; }
        } else {
            float run = before;
#pragma unroll
            for (int i = 0; i < 32; ++i) { kt[i] = f2bf(kk[i] * run); run *= lf[i]; }
        }
        if (seg == 0) ((float*)(P.ws + WS_HGA))[((size_t)(bh * 2 + dir) * 32 + n) * 64 + d] = ssum * after;
    }
    __syncthreads();
    {
        const int wdir = wave >> 2, dt = wave & 3; const LAS bf16_t* kts = Kt + wdir * (64 * 136);
        bf16x8 afr[4];
#pragma unroll
        for (int kq = 0; kq < 4; ++kq) afr[kq] = *(const LAS bf16x8*)(kts + (dt * 16 + q) * 136 + kq * 32 + 8 * g);
        float* dst = (float*)(P.ws + WS_HGU) + ((size_t)(bh * 2 + wdir) * 32 + n) * 4096;
#pragma unroll
        for (int et = 0; et < 4; ++et) {
            f32x4 acc = {0.f, 0.f, 0.f, 0.f};
#pragma unroll
            for (int kq = 0; kq < 4; ++kq) { const bf16x8 bfr = *(const LAS bf16x8*)(Vt + (et * 16 + q) * 136 + kq * 32 + 8 * g); acc = MFMA32(afr[kq], bfr, acc); }
#pragma unroll
            for (int j = 0; j < 4; ++j) dst[(dt * 16 + 4 * g + j) * 64 + et * 16 + q] = acc[j];
        }
    }
    __syncthreads();
}
__device__ __forceinline__ void hg_scan(const Params& P) {
    float* U = (float*)(P.ws + WS_HGU); const float* A = (const float*)(P.ws + WS_HGA);
    const int nthr = gridDim.x * NTHREADS; int it0 = blockIdx.x * NTHREADS + opaque_tid() - 48 * 2 * 512; if (it0 < 0) it0 += nthr;
    for (int it = it0; it < 64 * 64 * 16; it += nthr) {
        const int e4 = it & 15, d = (it >> 4) & 63, bd = it >> 10, dir = bd & 1;
        f32x4 s = {0.f, 0.f, 0.f, 0.f};
        for (int i0 = 0; i0 < 32; i0 += 8) {
            f32x4 v[8]; float a[8];
#pragma unroll
            for (int i = 0; i < 8; ++i) { const int n = dir ? 31 - (i0 + i) : (i0 + i); v[i] = *(const f32x4*)(U + ((size_t)(bd * 32 + n) * 64 + d) * 64 + 4 * e4); a[i] = A[(size_t)(bd * 32 + n) * 64 + d]; }
#pragma unroll
            for (int i = 0; i < 8; ++i) { const int n = dir ? 31 - (i0 + i) : (i0 + i); *(f32x4*)(U + ((size_t)(bd * 32 + n) * 64 + d) * 64 + 4 * e4) = s; s = s * a[i] + v[i]; }
        }
    }
}
__device__ __forceinline__ unsigned pk2h(float lo, float hi) { return pk2(lo, hi); }
__device__ __forceinline__ bf16x4 pk4h(f32x4 v) { return pk4(v); }
__device__ __forceinline__ void hgB_unit(const Params& P, LAS unsigned char* lds, int u, int layer) {
    const int tid = opaque_tid(), lane = tid & 63, wave = __builtin_amdgcn_readfirstlane(tid >> 6), q = lane & 15, g = lane >> 4;
    const int b = u >> 5, n = u & 31, h = wave >> 1, dir = wave & 1, bh = b * 4 + h;
    bf16_t* proj = (bf16_t*)(P.ws + WS_PROJ);
    bf16_t* mixed = (bf16_t*)(P.ws + WS_HBUF);
    LAS unsigned char* wl = lds + wave * 7168;
    LAS bf16_t* Qi = (LAS bf16_t*)wl;
    LAS bf16_t* Ki = (LAS bf16_t*)(wl + 2304);
    LAS bf16_t* Vs = (LAS bf16_t*)(wl + 4608);
    LAS float* Al = (LAS float*)(wl + 6912);
    const size_t tokc = (size_t)(b * SEQ + n * 128);
    const float lbv = ((const float*)(P.ws + WS_LB))[layer * 256 + h * 64 + lane];
    f32x4 S[4][4];
    {
        const float* sp = (const float*)(P.ws + WS_HGU) + ((size_t)(bh * 2 + dir) * 32 + n) * 4096;
#pragma unroll
        for (int dt = 0; dt < 4; ++dt)
#pragma unroll
            for (int et = 0; et < 4; ++et)
#pragma unroll
                for (int j = 0; j < 4; ++j) S[dt][et][j] = sp[(dt * 16 + 4 * g + j) * 64 + et * 16 + q];
    }
    bf16_t* odst = dir ? (proj + C_AQ + h * 64) : (mixed + 768 + h * 64); const size_t opitch = dir ? INW : DM;
    bf16_t qr[16], zz[16]; u32x4 v0, v1;
#define HGB_LOAD(SC) do { const size_t toks_ = tokc + (SC) * 16; const bf16_t* base_ = proj + toks_ * INW + h * 64 + lane; \
        _Pragma("unroll") for (int ii = 0; ii < 16; ++ii) { const int t_ = dir ? 15 - ii : ii; qr[ii] = base_[(size_t)t_ * INW + C_HQ]; zz[ii] = base_[(size_t)t_ * INW + (dir ? C_HZB : C_HZF)]; } \
        const bf16_t* vsrc_ = proj + (toks_ + (lane >> 2)) * INW + C_HI + h * 64 + (lane & 3) * 16; v0 = *(const u32x4*)vsrc_; v1 = *(const u32x4*)(vsrc_ + 8); } while (0)
    HGB_LOAD(dir ? 7 : 0);
    for (int i = 0; i < 8; ++i) {
        const int sc = dir ? 7 - i : i; const size_t toks = tokc + sc * 16;
        {
            *(LAS u32x4*)(Vs + (lane >> 2) * 72 + (lane & 3) * 16) = v0; *(LAS u32x4*)(Vs + (lane >> 2) * 72 + (lane & 3) * 16 + 8) = v1;
            float bp = 1.f;
#pragma unroll
            for (int ii = 0; ii < 16; ++ii) {
                const int t = dir ? 15 - ii : ii;
                float f, kk; hgrn_gate(bf2f(zz[ii]), lbv, f, kk); const float qv = siluf(bf2f(qr[ii]));
                bp *= f;
                Qi[t * 72 + lane] = f2bf(qv * bp); Ki[t * 72 + lane] = f2bf(kk * __builtin_amdgcn_rcpf(fmaxf(bp, 1.0e-30f)));
            }
            Al[lane] = bp;
        }
        if (i + 1 < 8) HGB_LOAD(dir ? 6 - i : i + 1);
        __builtin_amdgcn_fence(__ATOMIC_RELEASE, "wavefront"); __builtin_amdgcn_wave_barrier(); __builtin_amdgcn_fence(__ATOMIC_ACQUIRE, "wavefront");
        f32x4 at = {0.f, 0.f, 0.f, 0.f};
#pragma unroll
        for (int kq = 0; kq < 2; ++kq) { const bf16x8 a8 = *(const LAS bf16x8*)(Ki + q * 72 + kq * 32 + 8 * g), b8 = *(const LAS bf16x8*)(Qi + q * 72 + kq * 32 + 8 * g); at = MFMA32(a8, b8, at); }
#pragma unroll
        for (int j = 0; j < 4; ++j) { const int sl = 4 * g + j; const bool keep = dir ? (sl >= q) : (sl <= q); at[j] = keep ? at[j] : 0.f; }
        const bf16x4 p4 = pk4h(at);
        bf16x4 b4[4], v4[4];
#pragma unroll
        for (int dt = 0; dt < 4; ++dt) b4[dt] = *(const LAS bf16x4*)(Qi + q * 72 + dt * 16 + 4 * g);
#pragma unroll
        for (int et = 0; et < 4; ++et) v4[et] = tr4(Vs, 72, 0, et * 16, g, q);
#pragma unroll
        for (int et = 0; et < 4; ++et) {
            f32x4 o = {0.f, 0.f, 0.f, 0.f};
#pragma unroll
            for (int dt = 0; dt < 4; ++dt) o = MFMA16(pk4h(S[dt][et]), b4[dt], o);
            o = MFMA16(v4[et], p4, o);
            *(bf16x4*)(odst + (toks + q) * opitch + et * 16 + 4 * g) = pk4(o);
        }
#pragma unroll
        for (int dt = 0; dt < 4; ++dt) {
            const bf16x4 kT4 = tr4(Ki, 72, 0, dt * 16, g, q);
            const f32x4 al4 = *(const LAS f32x4*)(Al + dt * 16 + 4 * g);
#pragma unroll
            for (int et = 0; et < 4; ++et) { const f32x4 s2 = MFMA16(kT4, v4[et], S[dt][et]); S[dt][et] = s2 * al4; }
        }
        __builtin_amdgcn_fence(__ATOMIC_RELEASE, "wavefront"); __builtin_amdgcn_wave_barrier(); __builtin_amdgcn_fence(__ATOMIC_ACQUIRE, "wavefront");
    }
    asm volatile("s_waitcnt vmcnt(0)" ::: "memory");
    __syncthreads();
    {
        const int tau = tid >> 2, qd = tid & 3;
        bf16_t* mp = mixed + (tokc + tau) * DM + 768 + qd * 64; const bf16_t* bp2 = proj + (tokc + tau) * INW + C_AQ + qd * 64;
        const bf16_t* gp = proj + (tokc + tau) * INW + C_HG + qd * 64; const float* gn = P.hgrn_gn + layer * 256 + qd * 64;
        float o[64]; float sq = 0.f;
#pragma unroll
        for (int c4 = 0; c4 < 16; ++c4) {
            const unsigned long long fv = __hip_atomic_load((const unsigned long long*)(mp + c4 * 4), __ATOMIC_RELAXED, __HIP_MEMORY_SCOPE_AGENT), bv = __hip_atomic_load((const unsigned long long*)(bp2 + c4 * 4), __ATOMIC_RELAXED, __HIP_MEMORY_SCOPE_AGENT);
            const unsigned f0 = (unsigned)fv, f1 = (unsigned)(fv >> 32), b0 = (unsigned)bv, b1 = (unsigned)(bv >> 32);
            const float x0 = bflo(f0) + bflo(b0), x1 = bfhi(f0) + bfhi(b0), x2 = bflo(f1) + bflo(b1), x3 = bfhi(f1) + bfhi(b1);
            o[c4 * 4 + 0] = x0; o[c4 * 4 + 1] = x1; o[c4 * 4 + 2] = x2; o[c4 * 4 + 3] = x3; sq += (x0 * x0 + x1 * x1) + (x2 * x2 + x3 * x3); }
        sq += __shfl_xor(sq, 1); sq += __shfl_xor(sq, 2);
        const float rstd = rsqrtf(sq * (1.0f / 256.0f) + NORM_EPS);
#pragma unroll
        for (int c8 = 0; c8 < 8; ++c8) {
            const u32x4 gv = *(const u32x4*)(gp + c8 * 8); const f32x4 g0 = *(const f32x4*)(gn + c8 * 8), g1 = *(const f32x4*)(gn + c8 * 8 + 4);
            u32x4 r;
            r.x = pk2h(o[c8 * 8 + 0] * rstd * g0[0] * siluf(bflo(gv.x)), o[c8 * 8 + 1] * rstd * g0[1] * siluf(bfhi(gv.x)));
            r.y = pk2h(o[c8 * 8 + 2] * rstd * g0[2] * siluf(bflo(gv.y)), o[c8 * 8 + 3] * rstd * g0[3] * siluf(bfhi(gv.y)));
            r.z = pk2h(o[c8 * 8 + 4] * rstd * g1[0] * siluf(bflo(gv.z)), o[c8 * 8 + 5] * rstd * g1[1] * siluf(bfhi(gv.z)));
            r.w = pk2h(o[c8 * 8 + 6] * rstd * g1[2] * siluf(bflo(gv.w)), o[c8 * 8 + 7] * rstd * g1[3] * siluf(bfhi(gv.w)));
            *(u32x4*)(mp + c8 * 8) = r;
        }
    }
    __syncthreads();
}
constexpr int N_PHASES = 20;
#ifndef PROBE_MASK
#define PROBE_MASK 0u
#endif
#ifndef PROBE_U
#define PROBE_U 0
#endif
#ifndef STAGGER
#define STAGGER 0
#endif
#ifndef STAGGER_TICKS
#define STAGGER_TICKS 1000u
#endif
#ifndef PROBE_SYNC2
#define PROBE_SYNC2 0
#endif
__device__ __forceinline__ void stagger_half(unsigned ticks) {
#if STAGGER
    if ((blockIdx.x >> 3) & 1) { const unsigned long long t0 = __builtin_amdgcn_s_memrealtime(); while (__builtin_amdgcn_s_memrealtime() - t0 < ticks) __builtin_amdgcn_s_sleep(32); }
    __syncthreads();
#endif
}
__device__ __forceinline__ void run_phase(const Params& P, LAS unsigned char* lds, int ph) {
    unsigned char* ws = P.ws;
    if (ph == 0) { phase_prologue(P, lds); return; }
    if (ph == N_PHASES - 1) { const float* ml = (const float*)(ws + WS_MOD) + (size_t)(DEPTH - 1) * NBATCH * NMOD * DM;
        phase_norm<2, false, true>(P.out, (const bf16_t*)(ws + WS_OB), ml + 2 * DM, (const bf16_t*)(ws + WS_HBUF), ml + 5 * DM, P.out, P.g_final, nullptr, nullptr, nullptr); return; }
    const int l = (ph - 1) / 9, s = (ph - 1) % 9;
    const float* mod = (const float*)(ws + WS_MOD) + (size_t)l * NBATCH * NMOD * DM; const float* modp = mod - (size_t)NBATCH * NMOD * DM;
    const float* xprev = (l == 1) ? P.x : P.out;
    bf16_t* hbuf = (bf16_t*)(ws + WS_HBUF); bf16_t* proj = (bf16_t*)(ws + WS_PROJ); bf16_t* ybuf = (bf16_t*)(ws + WS_OB);
#ifdef PH_ONLY
    if (s != PH_ONLY) return;
#endif
    int kD = DM, kF = FFN; asm volatile("" : "+s"(kD), "+s"(kF));
    switch (s) {
    case 0: if (l == 0) { phase_norm<0, false, false>(P.x, nullptr, nullptr, nullptr, nullptr, nullptr, P.g_mix, mod + 0 * DM, mod + 1 * DM, hbuf); phase_weights(P, lds); }
            else phase_norm<2, true, false>(xprev, ybuf, modp + 2 * DM, hbuf, modp + 5 * DM, P.out, P.g_mix + l * DM, mod + 0 * DM, mod + 1 * DM, hbuf);
            break;
    case 1: { pg8::Gemm g{hbuf, (const bf16_t*)(ws + WS_WIN) + (size_t)l * INWP * DM, NTOK, INWP, kD}; pg8::StaticOrder S; S.init(NTOK, INWP, gridDim.x, blockIdx.x);
              EpiProj E{proj, INW, INW}; pg8::gemm_phase<EpiProj, pg8::StaticOrder>(lds, g, S, E, nullptr); } break;
    case 2: { for (int rp = 0; rp < (PROBE_U == 1 ? 2 : 1); ++rp) att_phase(P, lds);
              for (int rp = 0; rp < (PROBE_U == 2 ? 2 : 1); ++rp) retA_phase(P, lds);
              for (int rp = 0; rp < (PROBE_U == 3 ? 2 : 1); ++rp) for (int u = blockIdx.x; u < 1024; u += gridDim.x) hgA_unit(P, lds, u, l); } break;
    case 3: { ret_scan(P); hg_scan(P); } break;
    case 4: { for (int rp = 0; rp < (PROBE_U == 4 ? 2 : 1); ++rp) for (int u = blockIdx.x; u < 256; u += gridDim.x) hgB_unit(P, lds, u, l);
              for (int rp = 0; rp < (PROBE_U == 5 ? 2 : 1); ++rp) retB_phase(P, lds, l); att_merge(P); } break;
    case 5: { pg8::Gemm g{hbuf, (const bf16_t*)(ws + WS_WOUT) + (size_t)l * DM * DM, NTOK, DM, kD}; pg8::StaticOrder S; S.init(NTOK, DM, gridDim.x, blockIdx.x);
              EpiProj E{ybuf, DM, DM}; pg8::gemm_phase<EpiProj, pg8::StaticOrder>(lds, g, S, E, nullptr); } break;
    case 6: phase_norm<1, false, false>(l == 0 ? P.x : P.out, ybuf, mod + 2 * DM, nullptr, nullptr, nullptr, P.g_ffn + l * DM, mod + 3 * DM, mod + 4 * DM, hbuf); break;
    case 7: { pg8::Gemm g{hbuf, (const bf16_t*)(ws + WS_WGU) + (size_t)l * 2 * FFN * DM, NTOK, 2 * FFN, kD}; pg8::StaticOrder S; S.init(NTOK, 2 * FFN, gridDim.x, blockIdx.x);
              EpiSwiglu E{proj}; pg8::gemm_phase<EpiSwiglu, pg8::StaticOrder>(lds, g, S, E, nullptr); } break;
    case 8: { pg8::Gemm g{proj, (const bf16_t*)(ws + WS_WDN) + (size_t)l * DM * FFN, NTOK, DM, kF}; pg8::StaticOrder S; S.init(NTOK, DM, gridDim.x, blockIdx.x);
              EpiProj E{hbuf, DM, DM}; pg8::gemm_phase<EpiProj, pg8::StaticOrder>(lds, g, S, E, nullptr); } break;
    }
}
__global__ void __launch_bounds__(NTHREADS) hybrid_fwd(Params P) {
    extern __shared__ __attribute__((aligned(16))) unsigned char lds_raw[];
    __shared__ uint4 xb_words;
    LAS unsigned char* lds = (LAS unsigned char*)lds_raw;
    if (threadIdx.x == 0) xb_words = make_uint4(0u, 0u, 0u, 0u);
    __syncthreads();
    XcdBarrier bar = xcd_barrier_post((unsigned*)(P.ws + WS_CTL), (volatile LAS unsigned*)&xb_words);
    for (int ph = P.ph_lo; ph < P.ph_hi; ++ph) {
        const int reps = ((PROBE_MASK >> ph) & 1u) ? 2 : 1;
        for (int rep = 0; rep < reps; ++rep) { run_phase(P, lds, ph); if (rep + 1 < reps) __syncthreads(); }
        if (ph + 1 < P.ph_hi) {
            if (P.ph_hi > N_PHASES) cg::this_grid().sync(); else xcd_barrier(bar);
            if (PROBE_SYNC2) xcd_barrier(bar);
        }
    }
}

extern "C" void kernel_launch(void* const* d_in, const int* in_sizes, int n_in, void* d_out, int out_size, void* d_ws, size_t ws_size, hipStream_t stream) {
    static int grid = 0;
    if (grid == 0) {
        if (n_in != 14 || out_size != NTOK * DM || ws_size < WS_END) { fprintf(stderr, "kernel_launch: unexpected shapes (n_in %d out %d ws %zu need %zu)\n", n_in, out_size, ws_size, (size_t)WS_END); grid = -1; return; }
        int dev = 0, cus = 0, per_cu = 0;
        hipGetDevice(&dev); hipDeviceGetAttribute(&cus, hipDeviceAttributeMultiprocessorCount, dev);
        if (hipFuncSetAttribute((const void*)hybrid_fwd, hipFuncAttributeMaxDynamicSharedMemorySize, LDS_BYTES) != hipSuccess) { fprintf(stderr, "kernel_launch: hipFuncSetAttribute failed\n"); grid = -1; return; }
        if (hipOccupancyMaxActiveBlocksPerMultiprocessor(&per_cu, (const void*)hybrid_fwd, NTHREADS, LDS_BYTES) != hipSuccess || per_cu < 1) { fprintf(stderr, "kernel_launch: occupancy query says %d\n", per_cu); grid = -1; return; }
        grid = cus;
    }
    if (grid < 0) return;
    if (hipMemsetAsync((char*)d_ws + WS_CTL, 0, 16384, stream) != hipSuccess) { fprintf(stderr, "kernel_launch: memset failed\n"); return; }
    Params p{};
    p.x = (const float*)d_in[0]; p.c = (const float*)d_in[1]; p.w_ada = (const float*)d_in[2]; p.b_ada = (const float*)d_in[3]; p.g_mix = (const float*)d_in[4];
    p.w_in = (const float*)d_in[5]; p.ret_gn = (const float*)d_in[6]; p.hgrn_gn = (const float*)d_in[7]; p.lb_logits = (const float*)d_in[8]; p.w_out = (const float*)d_in[9];
    p.g_ffn = (const float*)d_in[10]; p.w_gu = (const float*)d_in[11]; p.w_down = (const float*)d_in[12]; p.g_final = (const float*)d_in[13];
    p.out = (float*)d_out; p.ws = (unsigned char*)d_ws;
#if ONE_LAUNCH
    p.ph_lo = 0; p.ph_hi = N_PHASES;
    void* args[] = {&p};
    hipError_t e = hipLaunchCooperativeKernel((const void*)hybrid_fwd, dim3(grid), dim3(NTHREADS), args, LDS_BYTES, stream);
    if (e != hipSuccess) fprintf(stderr, "cooperative launch failed: %s (grid %d)\n", hipGetErrorString(e), grid);
#else
    for (int ph = 0; ph < N_PHASES; ++ph) { p.ph_lo = ph; p.ph_hi = ph + 1; hipLaunchKernelGGL(hybrid_fwd, dim3(grid), dim3(NTHREADS), LDS_BYTES, stream, p); }
#endif
}
```

```cpp
#include <hip/hip_runtime.h>
#include <hip/hip_cooperative_groups.h>
#include <cstdio>
#include <cstdint>
namespace cg = cooperative_groups;
#ifndef ONE_LAUNCH
#define ONE_LAUNCH 1
#endif
__device__ __forceinline__ int opaque_tid() { int t = threadIdx.x; asm volatile("" : "+v"(t)); return t; }
#define LAS __attribute__((address_space(3)))
namespace pg8 {
#define PG8_LAS __attribute__((address_space(3)))
typedef unsigned short bf16_t;
typedef short bf16x8 __attribute__((ext_vector_type(8)));
typedef float f32x4 __attribute__((ext_vector_type(4)));
typedef unsigned u32x4 __attribute__((ext_vector_type(4)));
constexpr int BM = 256, BK = 64, HALF = 128, HTB = HALF * BK * 2  , STAGE_BYTES = 8 * HTB, NXCD = 8, WGM = 8;

__host__ __device__ __forceinline__ int lds_byte(int r, int c) { const int st = (r >> 4) * 2 + (c >> 5), rr = r & 15, cc = c & 31, ob = rr * 64 + cc * 2; return st * 1024 + (ob ^ (((ob >> 9) & 1) << 5)); }
__host__ __device__ __forceinline__ void stage_rc(int b, int& R, int& C) { const int st = b / 1024, sb = b % 1024, swz = sb ^ (((sb >> 9) & 1) << 5); R = (st >> 1) * 16 + swz / 64; C = (st & 1) * 32 + (swz % 64) / 2; }
__host__ __device__ __forceinline__ int perm32(int rho) { const int n = rho >> 4, i = rho & 15; return 8 * (i >> 2) + 4 * n + (i & 3); }

struct Unit { int pm, pn; };
struct Gemm { const bf16_t* A; const bf16_t* Bt; int M, N, K; };

struct StaticOrder {
    int nM, nN, nwg, G, c;
    __host__ __device__ void init(int M, int N, int G_, int c_) { nM = M / BM; nN = N / BM; nwg = nM * nN; G = G_; c = c_; }
    __host__ __device__ bool next(int i, Unit& u) const {
        const long L = (long)i * G + c; if (L >= nwg) return false;
        int wgid = (int)L; { const int q = nwg / NXCD, r = nwg % NXCD, xcd = wgid % NXCD, off = wgid / NXCD; wgid = (xcd < r ? xcd * (q + 1) : r * (q + 1) + (xcd - r) * q) + off; }
        const int nig = WGM * nN, gid = wgid / nig, fm = gid * WGM, gsz = (nM - fm) < WGM ? (nM - fm) : WGM;
        u.pm = fm + ((wgid % nig) % gsz); u.pn = (wgid % nig) / gsz; return true;
    }
    __device__ __forceinline__ void a_ready(const Unit&) const {}
    __device__ __forceinline__ void done(const Unit&) const {}
};
__device__ __forceinline__ unsigned cvt_pk_bf16(float lo, float hi) { unsigned r; asm volatile("v_cvt_pk_bf16_f32 %0, %1, %2" : "=v"(r) : "v"(lo), "v"(hi)); return r; }
typedef float f32x2 __attribute__((ext_vector_type(2)));
template <class Epi, class Sched, bool STAMP = false>
__device__ __forceinline__ void gemm_phase(PG8_LAS unsigned char* lds, const Gemm g, const Sched& S, const Epi& E, unsigned long long* stamps) {
    const int tid = opaque_tid(), wid = __builtin_amdgcn_readfirstlane(tid >> 6), lane = tid & 63, wr = wid >> 2, wc = wid & 3, fr = lane & 15, fq = lane >> 4;
    const int K = g.K, nt = K / BK;
    int ts_lo = 0, ts_hi = 0, nts = 0; const unsigned long long rt_entry = STAMP ? (unsigned long long)wall_clock64() : 0ull;
#define PG8_STAMP() do { if (STAMP && wid == 0 && nts < 64) { const unsigned long long _c = (unsigned long long)clock64(); \
        ts_lo = (lane == nts) ? (int)(unsigned)_c : ts_lo; ts_hi = (lane == nts) ? (int)(unsigned)(_c >> 32) : ts_hi; ++nts; } } while (0)
    PG8_STAMP();
    unsigned voffA[2], voffB[2];
#pragma unroll
    for (int i = 0; i < 2; ++i) { int R, C; stage_rc(tid * 16 + i * 8192, R, C); const int Rb = Epi::PERM ? ((R & ~31) + perm32(R & 31)) : R;
        voffA[i] = (unsigned)(R * K + C) * 2u; voffB[i] = (unsigned)(Rb * K + C) * 2u; }
    const size_t kstep = (size_t)(BK * 2);
    const size_t hstep = (size_t)HALF * K * 2;
    const size_t tstep = 2 * hstep;
    const unsigned ldsw = (unsigned)wid * 1024u;
    const int aoff = lds_byte(wr * 64 + fr, fq * 8), boff = lds_byte(wc * 32 + fr, fq * 8);
#define PG8_SA(b, h) (((b) * 2 + (h)) * HTB)
#define PG8_SB(b, h) ((4 + (b) * 2 + (h)) * HTB)
#define PG8_STAGE(bufoff, gbase, voff) do { _Pragma("unroll") for (int _i = 0; _i < 2; ++_i) \
        __builtin_amdgcn_global_load_lds((const unsigned*)((const char*)(gbase) + (voff)[_i]), (PG8_LAS unsigned*)(lds + (bufoff) + ldsw + _i * 8192), 16, 0, 0); } while (0)
#define PG8_LDA(dst, b, h) do { _Pragma("unroll") for (int m = 0; m < 4; ++m) _Pragma("unroll") for (int k = 0; k < 2; ++k) dst[m][k] = *(const PG8_LAS bf16x8*)(lds + PG8_SA(b, h) + aoff + m * 2048 + k * 1024); } while (0)
#define PG8_LDB(dst, b, h) do { _Pragma("unroll") for (int n = 0; n < 2; ++n) _Pragma("unroll") for (int k = 0; k < 2; ++k) dst[n][k] = *(const PG8_LAS bf16x8*)(lds + PG8_SB(b, h) + boff + n * 2048 + k * 1024); } while (0)
#define PG8_MMA(ai, bj, At, Bt) do { __builtin_amdgcn_s_setprio(1); _Pragma("unroll") for (int m = 0; m < 4; ++m) _Pragma("unroll") for (int n = 0; n < 2; ++n) _Pragma("unroll") for (int k = 0; k < 2; ++k) \
        acc[ai][bj][m][n] = __builtin_amdgcn_mfma_f32_16x16x32_bf16(Bt[n][k], At[m][k], acc[ai][bj][m][n], 0, 0, 0); __builtin_amdgcn_s_setprio(0); } while (0)
#define PG8_WAIT_V(n) asm volatile("s_waitcnt vmcnt(" #n ")" ::: "memory")
#define PG8_WAIT_L(n) asm volatile("s_waitcnt lgkmcnt(" #n ")" ::: "memory")
#define PG8_BAR __builtin_amdgcn_s_barrier()
#define PG8_SCHED __builtin_amdgcn_sched_barrier(0)
    Unit cur, nxt; int ui = 0;
    if (!S.next(0, cur)) return;
    f32x4 acc[2][2][4][2];
#pragma unroll
    for (int a = 0; a < 2; ++a)
#pragma unroll
        for (int b = 0; b < 2; ++b)
#pragma unroll
            for (int m = 0; m < 4; ++m)
#pragma unroll
                for (int n = 0; n < 2; ++n) acc[a][b][m][n] = (f32x4){0.f, 0.f, 0.f, 0.f};
    bf16x8 At[4][2], B0[2][2], B1[2][2];
    const char* cA = (const char*)g.A + (size_t)cur.pm * tstep; const char* cB = (const char*)g.Bt + (size_t)cur.pn * tstep;
    S.a_ready(cur);
    PG8_STAGE(PG8_SB(0, 0), cB, voffB); PG8_STAGE(PG8_SA(0, 0), cA, voffA); PG8_STAGE(PG8_SB(0, 1), cB + hstep, voffB); PG8_STAGE(PG8_SA(0, 1), cA + hstep, voffA);
    if (wr == 1) PG8_BAR;
    PG8_WAIT_V(4); PG8_BAR;
    PG8_STAGE(PG8_SB(1, 0), cB + kstep, voffB); PG8_STAGE(PG8_SA(1, 0), cA + kstep, voffA); PG8_STAGE(PG8_SB(1, 1), cB + hstep + kstep, voffB);
    PG8_WAIT_V(6); PG8_BAR;
    PG8_STAMP();
    for (;;) {
        const bool has_next = S.next(ui + 1, nxt);
        const char* nA = has_next ? (const char*)g.A + (size_t)nxt.pm * tstep : cA; const char* nB = has_next ? (const char*)g.Bt + (size_t)nxt.pn * tstep : cB;
        for (int t = 0; t < nt; t += 2) {
            const bool last = (t == nt - 2);
            const char* a1 = cA + (size_t)(t + 1) * kstep;
            const char* a2 = last ? nA : cA + (size_t)(t + 2) * kstep; const char* b2 = last ? nB : cB + (size_t)(t + 2) * kstep;
            const char* a3 = a2 + kstep; const char* b3 = b2 + kstep;
            if (last && has_next) S.a_ready(nxt);
            PG8_LDB(B0, 0, 0); PG8_SCHED; PG8_LDA(At, 0, 0); PG8_STAGE(PG8_SA(1, 1), a1 + hstep, voffA);
            PG8_WAIT_L(8); PG8_BAR; PG8_WAIT_L(0); PG8_MMA(0, 0, At, B0); PG8_BAR; PG8_SCHED;
            PG8_LDB(B1, 0, 1); PG8_STAGE(PG8_SB(0, 0), b2, voffB);
            PG8_BAR; PG8_WAIT_L(0); PG8_MMA(0, 1, At, B1); PG8_BAR;
            PG8_LDA(At, 0, 1); PG8_STAGE(PG8_SA(0, 0), a2, voffA);
            PG8_BAR; PG8_WAIT_L(0); PG8_MMA(1, 0, At, B0); PG8_BAR; PG8_SCHED;
            PG8_STAGE(PG8_SB(0, 1), b2 + hstep, voffB);
            PG8_WAIT_V(6); PG8_BAR; PG8_MMA(1, 1, At, B1); PG8_BAR;
            PG8_LDB(B0, 1, 0); PG8_SCHED; PG8_LDA(At, 1, 0); PG8_STAGE(PG8_SA(0, 1), a2 + hstep, voffA);
            PG8_WAIT_L(8); PG8_BAR; PG8_WAIT_L(0); PG8_MMA(0, 0, At, B0); PG8_BAR; PG8_SCHED;
            PG8_LDB(B1, 1, 1); PG8_STAGE(PG8_SB(1, 0), b3, voffB);
            PG8_BAR; PG8_WAIT_L(0); PG8_MMA(0, 1, At, B1); PG8_BAR;
            PG8_LDA(At, 1, 1); PG8_STAGE(PG8_SA(1, 0), a3, voffA);
            PG8_BAR; PG8_WAIT_L(0); PG8_MMA(1, 0, At, B0); PG8_BAR; PG8_SCHED;
            PG8_STAGE(PG8_SB(1, 1), b3 + hstep, voffB);
            PG8_WAIT_V(6); PG8_BAR; PG8_MMA(1, 1, At, B1); PG8_BAR;
        }
        PG8_STAMP();
        if constexpr (!Epi::AFTER_DRAIN) { E(acc, cur, wr, wc, fr, fq); S.done(cur); }
        PG8_STAMP();
        if (!has_next) break;
#pragma unroll
        for (int a = 0; a < 2; ++a)
#pragma unroll
            for (int b = 0; b < 2; ++b)
#pragma unroll
                for (int m = 0; m < 4; ++m)
#pragma unroll
                    for (int n = 0; n < 2; ++n) acc[a][b][m][n] = (f32x4){0.f, 0.f, 0.f, 0.f};
        cur = nxt; cA = nA; cB = nB; ++ui;
    }
    PG8_WAIT_V(0);
    if (wr == 0) PG8_BAR;
    PG8_BAR;
    if constexpr (Epi::AFTER_DRAIN) { E.fused(acc, cur, wr, wc, fr, fq, lds, wid, lane); S.done(cur); }
    PG8_STAMP();
    if (STAMP && wid == 0) { stamps[lane] = lane < nts ? (((unsigned long long)(unsigned)ts_hi << 32) | (unsigned)ts_lo) : 0ull;
        if (lane == 62) stamps[62] = rt_entry; if (lane == 63) stamps[63] = (unsigned long long)wall_clock64(); }
#undef PG8_STAMP
#undef PG8_SA
#undef PG8_SB
#undef PG8_STAGE
#undef PG8_LDA
#undef PG8_LDB
#undef PG8_MMA
#undef PG8_WAIT_V
#undef PG8_WAIT_L
#undef PG8_BAR
#undef PG8_SCHED
}
}
#define XB_TMO      128
#define XB_XCNT(j)  (256  + 64 * (j))
#define XB_XSUB(j)  (1280 + 64 * (j))
#define XB_XGEN(j)  (2304 + 64 * (j))
#define XB_TOP      3328
#define XB_TOPGEN   3392
#define XCD_BAR_WORDS 3456
#define XB_SPIN_CAP (1u << 18)

__device__ __forceinline__ unsigned xb_ld(unsigned* p)              { return __hip_atomic_load(p, __ATOMIC_RELAXED, __HIP_MEMORY_SCOPE_AGENT); }
__device__ __forceinline__ unsigned xb_add(unsigned* p, unsigned v) { return __hip_atomic_fetch_add(p, v, __ATOMIC_RELAXED, __HIP_MEMORY_SCOPE_AGENT); }
__device__ __forceinline__ unsigned xb_xcc_id() { return (unsigned)__builtin_amdgcn_s_getreg((3 << 11) | 20) & 0xFu; }
#define XB_SPIN(cond, bar) do { unsigned _sp = 0; while (cond) { __builtin_amdgcn_s_sleep(1); \
    if ((++_sp & 255u) == 0u) { if (xb_ld(&(bar)[XB_TMO])) break; if (_sp > XB_SPIN_CAP) { atomicAdd(&(bar)[XB_TMO], 1u); break; } } } } while (0)

struct XcdBarrier {
    unsigned* bar; unsigned x;
    volatile LAS unsigned* st;
};

__device__ __forceinline__ XcdBarrier xcd_barrier_post(unsigned* bar, volatile LAS unsigned* st) {
    XcdBarrier b; b.bar = bar; b.x = xb_xcc_id(); b.st = st;
    if (threadIdx.x == 0) (void)xb_add(&bar[XB_XCNT(b.x)], 1u);
    return b;
}
__device__ __forceinline__ void xcd_barrier_complete(unsigned* bar, unsigned x, unsigned& nloc, unsigned& nx) {
    const unsigned G = gridDim.x * gridDim.y * gridDim.z;
    unsigned sum, cnt, mine, sp = 0u;
    for (;;) {
        sum = 0u; cnt = 0u; mine = 0u;
#pragma unroll
        for (unsigned j = 0; j < 16; ++j) { const unsigned c = xb_ld(&bar[XB_XCNT(j)]); sum += c; cnt += (c > 0u) ? 1u : 0u; mine = (j == x) ? c : mine; }
        if (sum == G) break;
        __builtin_amdgcn_s_sleep(1);
        if ((++sp & 255u) == 0u) { if (xb_ld(&bar[XB_TMO])) break; if (sp > XB_SPIN_CAP) { atomicAdd(&bar[XB_TMO], 1u); break; } }
    }
    nloc = mine > 0u ? mine : 1u; nx = cnt > 0u ? cnt : 1u;
}

__device__ __forceinline__ void xcd_barrier(const XcdBarrier& b) {
    asm volatile("s_waitcnt vmcnt(0)" ::: "memory");
    __syncthreads();
    if (threadIdx.x == 0) {
        unsigned* bar = b.bar;
        __builtin_amdgcn_s_waitcnt(0);
        unsigned nloc = b.st[0], nx = b.st[1];
        if (nloc == 0u) { xcd_barrier_complete(bar, b.x, nloc, nx); b.st[0] = nloc; b.st[1] = nx; }
        const unsigned old = xb_add(&bar[XB_XSUB(b.x)], 1u);
        const unsigned gen = old / nloc;
        if (old + 1u == (gen + 1u) * nloc) {
            __builtin_amdgcn_fence(__ATOMIC_RELEASE, "agent");
            asm volatile("s_waitcnt vmcnt(0)" ::: "memory");
            const unsigned og = xb_add(&bar[XB_TOP], 1u);
            const unsigned tg = og / nx;
            if (og + 1u == (tg + 1u) * nx) xb_add(&bar[XB_TOPGEN], 1u);
            else XB_SPIN(xb_ld(&bar[XB_TOPGEN]) == tg, bar);
            __builtin_amdgcn_fence(__ATOMIC_ACQUIRE, "agent");
            xb_add(&bar[XB_XGEN(b.x)], 1u);
            asm volatile("s_waitcnt vmcnt(0)" ::: "memory");
        } else {
            XB_SPIN(xb_ld(&bar[XB_XGEN(b.x)]) == gen, bar);
            __builtin_amdgcn_fence(__ATOMIC_ACQUIRE, "agent");
            asm volatile("s_waitcnt vmcnt(0)" ::: "memory");
        }
    }
    __syncthreads();
}

typedef unsigned short bf16_t;
typedef short bf16x8 __attribute__((ext_vector_type(8)));
typedef short bf16x4 __attribute__((ext_vector_type(4)));
typedef float f32x4 __attribute__((ext_vector_type(4)));
typedef unsigned u32x4 __attribute__((ext_vector_type(4)));
typedef unsigned u32x2 __attribute__((ext_vector_type(2)));
constexpr int DM = 1024, NBATCH = 8, SEQ = 4096, NTOK = NBATCH * SEQ, DEPTH = 2;
constexpr int INW = 3968, INWP = 4096, FFN = 2816, NMOD = 6;
constexpr int C_AQ = 0, C_AK = 384, C_AV = 768, C_RQ = 1152, C_RK = 1536, C_RV = 1920, C_RG = 2304, C_HQ = 2688, C_HZF = 2944, C_HZB = 3200, C_HI = 3456, C_HG = 3712;
constexpr float NORM_EPS = 1e-6f;
constexpr int NTHREADS = 512;
constexpr int LDS_BYTES = 135168;
constexpr size_t WS_CTL = 0, WS_MOD = 16384, WS_LB = WS_MOD + 393216, WS_HGA = WS_LB + 2048, WS_LSE = WS_HGA + 524288, WS_WIN = WS_LSE + 2359296,
    WS_WOUT = WS_WIN + 16777216, WS_WGU = WS_WOUT + 4194304, WS_WDN = WS_WGU + 23068672, WS_HBUF = WS_WDN + 11534336, WS_PROJ = WS_HBUF + 67108864,
    WS_OB = WS_PROJ + 260046848, WS_RST = WS_OB + 75497472, WS_HGU = WS_RST + 25165824, WS_END = WS_HGU + 33554432;

struct Params {
    const float *x, *c, *w_ada, *b_ada, *g_mix, *w_in, *ret_gn, *hgrn_gn, *lb_logits, *w_out, *g_ffn, *w_gu, *w_down, *g_final;
    float* out; unsigned char* ws; int ph_lo, ph_hi;
};

__device__ __forceinline__ float bf2f(bf16_t v) { return __uint_as_float(((unsigned)v) << 16); }
__device__ __forceinline__ float bflo(unsigned w) { return __uint_as_float(w << 16); }
__device__ __forceinline__ float bfhi(unsigned w) { return __uint_as_float(w & 0xffff0000u); }
__device__ __forceinline__ bf16_t f2bf(float f) { return __builtin_bit_cast(bf16_t, (__bf16)f); }
typedef float f32x2c __attribute__((ext_vector_type(2)));
typedef __bf16 bf16v2c __attribute__((ext_vector_type(2)));
__device__ __forceinline__ unsigned pk2(float lo, float hi) { const f32x2c v = {lo, hi}; return __builtin_bit_cast(unsigned, __builtin_convertvector(v, bf16v2c)); }
__device__ __forceinline__ bf16x4 pk4(f32x4 v) { u32x2 w; w.x = pk2(v[0], v[1]); w.y = pk2(v[2], v[3]); return __builtin_bit_cast(bf16x4, w); }
__device__ __forceinline__ float siluf(float v) { return v * __builtin_amdgcn_rcpf(1.0f + __expf(-v)); }
__device__ __forceinline__ float wave_sum(float v) {
#pragma unroll
    for (int o = 1; o < 64; o <<= 1) v += __shfl_xor(v, o);
    return v;
}
#define MFMA32(a, b, c) __builtin_amdgcn_mfma_f32_16x16x32_bf16((a), (b), (c), 0, 0, 0)
#define MFMA16(a, b, c) __builtin_amdgcn_mfma_f32_16x16x16bf16_1k((a), (b), (c), 0, 0, 0)

struct EpiProj {
    static constexpr bool PERM = true, AFTER_DRAIN = false;
    bf16_t* O; int ldc, ncols;
    __device__ __forceinline__ void operator()(const f32x4 (&acc)[2][2][4][2], const pg8::Unit& u, int wr, int wc, int fr, int fq) const {
        const int row0 = u.pm * 256 + wr * 64 + fr, col0 = u.pn * 256 + wc * 32 + 8 * fq;
#pragma unroll
        for (int ai = 0; ai < 2; ++ai)
#pragma unroll
            for (int m = 0; m < 4; ++m) { bf16_t* rowp = O + (size_t)(row0 + ai * 128 + m * 16) * ldc + col0;
#pragma unroll
                for (int bj = 0; bj < 2; ++bj) { if (col0 + bj * 128 < ncols) { const f32x4 v0 = acc[ai][bj][m][0], v1 = acc[ai][bj][m][1];
                    u32x4 w; w.x = pk2(v0[0], v0[1]); w.y = pk2(v0[2], v0[3]); w.z = pk2(v1[0], v1[1]); w.w = pk2(v1[2], v1[3]);
                    *(u32x4*)(rowp + bj * 128) = w; } } }
    }
};
struct EpiRes {
    static constexpr bool PERM = false, AFTER_DRAIN = false;
    const float* base; float* out; const float* gate;
    __device__ __forceinline__ void operator()(const f32x4 (&acc)[2][2][4][2], const pg8::Unit& u, int wr, int wc, int fr, int fq) const {
        const int row0 = u.pm * 256 + wr * 64 + fr, col0 = u.pn * 256 + wc * 32 + 4 * fq;
        const float* gp = gate + (size_t)((u.pm * 256) >> 12) * (NMOD * DM) + col0;
        f32x4 gv[2][2];
#pragma unroll
        for (int bj = 0; bj < 2; ++bj)
#pragma unroll
            for (int n = 0; n < 2; ++n) gv[bj][n] = *(const f32x4*)(gp + bj * 128 + n * 16);
#pragma unroll
        for (int ai = 0; ai < 2; ++ai)
#pragma unroll
            for (int m = 0; m < 4; ++m) { const size_t off = (size_t)(row0 + ai * 128 + m * 16) * DM + col0;
#pragma unroll
                for (int bj = 0; bj < 2; ++bj)
#pragma unroll
                    for (int n = 0; n < 2; ++n) { const f32x4 bs = *(const f32x4*)(base + off + bj * 128 + n * 16);
                        *(f32x4*)(out + off + bj * 128 + n * 16) = bs + gv[bj][n] * acc[ai][bj][m][n]; } }
    }
};
struct EpiSwiglu {
    static constexpr bool PERM = true, AFTER_DRAIN = false;
    bf16_t* O;
    __device__ __forceinline__ void operator()(const f32x4 (&acc)[2][2][4][2], const pg8::Unit& u, int wr, int wc, int fr, int fq) const {
        const int row0 = u.pm * 256 + wr * 64 + fr, col0 = u.pn * 128 + wc * 32 + 8 * fq;
#pragma unroll
        for (int ai = 0; ai < 2; ++ai)
#pragma unroll
            for (int m = 0; m < 4; ++m) { bf16_t* rowp = O + (size_t)(row0 + ai * 128 + m * 16) * FFN + col0;
                float r[8];
#pragma unroll
                for (int n = 0; n < 2; ++n)
#pragma unroll
                    for (int i = 0; i < 4; ++i) { const float g = acc[ai][0][m][n][i], uu = acc[ai][1][m][n][i]; r[n * 4 + i] = siluf(g) * uu; }
                u32x4 w; w.x = pk2(r[0], r[1]); w.y = pk2(r[2], r[3]); w.z = pk2(r[4], r[5]); w.w = pk2(r[6], r[7]);
                *(u32x4*)rowp = w; }
    }
};
__device__ __forceinline__ void transpose_item(const float* W, int K, int N, bf16_t* WT, int dst_row0, int src_col0, int k0, LAS float* scr, int lane) {
    const int c = lane & 7, nr = lane >> 3;
    if (src_col0 < 0) {
#pragma unroll
        for (int j = 0; j < 8; ++j) *(u32x4*)(WT + (size_t)(dst_row0 + nr + 8 * j) * K + k0 + 8 * c) = (u32x4){0u, 0u, 0u, 0u};
        return;
    }
    const int kr = lane >> 4, c4 = lane & 15;
    f32x4 v[16];
#pragma unroll
    for (int i = 0; i < 16; ++i) v[i] = *(const f32x4*)(W + (size_t)(k0 + 4 * i + kr) * N + src_col0 + 4 * c4);
#pragma unroll
    for (int i = 0; i < 16; ++i) { LAS float* d = scr + (4 * i + kr) * 65 + 4 * c4; d[0] = v[i][0]; d[1] = v[i][1]; d[2] = v[i][2]; d[3] = v[i][3]; }
    __builtin_amdgcn_fence(__ATOMIC_RELEASE, "wavefront"); __builtin_amdgcn_wave_barrier(); __builtin_amdgcn_fence(__ATOMIC_ACQUIRE, "wavefront");
#pragma unroll
    for (int j = 0; j < 8; ++j) { const int n = nr + 8 * j; const LAS float* sp = scr + (8 * c) * 65 + n;
        u32x4 o; o.x = pk2(sp[0 * 65], sp[1 * 65]); o.y = pk2(sp[2 * 65], sp[3 * 65]); o.z = pk2(sp[4 * 65], sp[5 * 65]); o.w = pk2(sp[6 * 65], sp[7 * 65]);
        *(u32x4*)(WT + (size_t)(dst_row0 + n) * K + k0 + 8 * c) = o; }
    __builtin_amdgcn_fence(__ATOMIC_RELEASE, "wavefront"); __builtin_amdgcn_wave_barrier(); __builtin_amdgcn_fence(__ATOMIC_ACQUIRE, "wavefront");
}

__device__ __forceinline__ void phase_weights(const Params& P, LAS unsigned char* lds) {
    const int tid = opaque_tid(), lane = tid & 63, wave = __builtin_amdgcn_readfirstlane(tid >> 6);
    unsigned char* ws = P.ws;
    {
        LAS float* scr = (LAS float*)(lds + wave * 16640);
        const int gw = blockIdx.x * 8 + wave, NGW = gridDim.x * 8;
        constexpr int I_IN = 16 * 64, I_OUT = 16 * 16, I_GU = 16 * 88, I_DN = 44 * 16, I_L = I_IN + I_OUT + I_GU + I_DN;
        for (int it = gw; it < DEPTH * I_L; it += NGW) {
            const int l = it / I_L; int r = it % I_L;
            if (r < I_IN) { const int kb = r / 64, nb = r % 64, n0 = nb * 64;
                transpose_item(P.w_in + (size_t)l * DM * INW, DM, INW, (bf16_t*)(ws + WS_WIN) + (size_t)l * INWP * DM, n0, n0 < INW ? n0 : -1, kb * 64, scr, lane); continue; }
            r -= I_IN;
            if (r < I_OUT) { const int kb = r / 16, nb = r % 16;
                transpose_item(P.w_out + (size_t)l * DM * DM, DM, DM, (bf16_t*)(ws + WS_WOUT) + (size_t)l * DM * DM, nb * 64, nb * 64, kb * 64, scr, lane); continue; }
            r -= I_OUT;
            if (r < I_GU) { const int kb = r / 88, nb = r % 88, n0 = nb * 64; const int pn = n0 >> 8, half = (n0 >> 7) & 1, jj = n0 & 127;
                transpose_item(P.w_gu + (size_t)l * DM * 2 * FFN, DM, 2 * FFN, (bf16_t*)(ws + WS_WGU) + (size_t)l * 2 * FFN * DM, n0, half * FFN + pn * 128 + jj, kb * 64, scr, lane); continue; }
            r -= I_GU;
            { const int kb = r / 16, nb = r % 16;
                transpose_item(P.w_down + (size_t)l * FFN * DM, FFN, DM, (bf16_t*)(ws + WS_WDN) + (size_t)l * DM * FFN, nb * 64, nb * 64, kb * 64, scr, lane); }
        }
    }
}
__device__ __forceinline__ void phase_prologue(const Params& P, LAS unsigned char* lds) {
    const int tid = opaque_tid();
    unsigned char* ws = P.ws;
    {
        LAS float* sc = (LAS float*)lds;
        LAS float* red = (LAS float*)(lds + 32768);
        for (int i = tid; i < NBATCH * DM; i += NTHREADS) sc[i] = siluf(P.c[i]);
        __syncthreads();
        float* mod = (float*)(ws + WS_MOD);
        for (int u = blockIdx.x; u < DEPTH * 96; u += gridDim.x) {
            const int l = u / 96, j0 = (u % 96) * 64, col = tid & 63, kp = tid >> 6;
            float acc[8];
#pragma unroll
            for (int b = 0; b < 8; ++b) acc[b] = 0.f;
            const float* wp = P.w_ada + (size_t)l * DM * (NMOD * DM) + j0 + col;
            for (int k = kp * 128; k < kp * 128 + 128; ++k) { const float w = wp[(size_t)k * (NMOD * DM)];
#pragma unroll
                for (int b = 0; b < 8; ++b) acc[b] += sc[b * DM + k] * w; }
#pragma unroll
            for (int b = 0; b < 8; ++b) red[(kp * 8 + b) * 64 + col] = acc[b];
            __syncthreads();
            { const int b = tid >> 6; float s = 0.f;
#pragma unroll
              for (int p = 0; p < 8; ++p) s += red[(p * 8 + b) * 64 + col];
              mod[((size_t)l * NBATCH + b) * (NMOD * DM) + j0 + col] = s + P.b_ada[(size_t)l * NMOD * DM + j0 + col]; }
            __syncthreads();
        }
    }
    if (blockIdx.x == 0 && tid < 256) {
        const float l0 = P.lb_logits[tid], l1 = P.lb_logits[256 + tid], m = fmaxf(l0, l1), e0 = __expf(l0 - m), e1 = __expf(l1 - m);
        const float p0 = e0 / (e0 + e1), p1 = e1 / (e0 + e1);
        float* lb = (float*)(ws + WS_LB);
        lb[tid] = fminf(fmaxf(p0 - p0, 0.f), 1.0f - 1e-6f);
        lb[256 + tid] = fminf(fmaxf((p0 + p1) - p0, 0.f), 1.0f - 1e-6f);
    }
}

template <int NY, bool WRITE_X, bool FINAL>
__device__ __forceinline__ void phase_norm(const float* src, const bf16_t* y, const float* gate, const bf16_t* y2, const float* gate2, float* xout, const float* g, const float* shift, const float* scale, bf16_t* dst) {
    constexpr bool HAS_Y = NY > 0;
    const int tid = opaque_tid(), lane = tid & 63, wave = tid >> 6;
    const int gw = blockIdx.x * 8 + wave, NGW = gridDim.x * 8;
    f32x4 gv[4];
#pragma unroll
    for (int j = 0; j < 4; ++j) gv[j] = *(const f32x4*)(g + 4 * lane + 256 * j);
    const int WPB = NGW / NBATCH, b = gw / WPB;
    if (b >= NBATCH) return;
    f32x4 gtv[4], gtv2[4], scv[4], shv[4];
#pragma unroll
    for (int j = 0; j < 4; ++j) {
        if (HAS_Y) gtv[j] = *(const f32x4*)(gate + (size_t)b * (NMOD * DM) + 4 * lane + 256 * j);
        if (NY > 1) gtv2[j] = *(const f32x4*)(gate2 + (size_t)b * (NMOD * DM) + 4 * lane + 256 * j);
        if (!FINAL) { scv[j] = *(const f32x4*)(scale + (size_t)b * (NMOD * DM) + 4 * lane + 256 * j) + 1.0f; shv[j] = *(const f32x4*)(shift + (size_t)b * (NMOD * DM) + 4 * lane + 256 * j); }
    }
    for (int row = b * SEQ + (gw - b * WPB); row < (b + 1) * SEQ; row += WPB) {
        const f32x4* xr = (const f32x4*)(src + (size_t)row * DM) + lane;
        f32x4 v[4]; float s = 0.f;
#pragma unroll
        for (int j = 0; j < 4; ++j) v[j] = xr[64 * j];
        if (HAS_Y) {
            const u32x2* yr = (const u32x2*)(y + (size_t)row * DM) + lane;
#pragma unroll
            for (int j = 0; j < 4; ++j) { const u32x2 yw = yr[64 * j]; const f32x4 gt = gtv[j];
                v[j][0] += gt[0] * bflo(yw.x); v[j][1] += gt[1] * bfhi(yw.x); v[j][2] += gt[2] * bflo(yw.y); v[j][3] += gt[3] * bfhi(yw.y); }
        }
        if (NY > 1) {
            const u32x2* yr2 = (const u32x2*)(y2 + (size_t)row * DM) + lane;
#pragma unroll
            for (int j = 0; j < 4; ++j) { const u32x2 yw = yr2[64 * j]; const f32x4 gt = gtv2[j];
                v[j][0] += gt[0] * bflo(yw.x); v[j][1] += gt[1] * bfhi(yw.x); v[j][2] += gt[2] * bflo(yw.y); v[j][3] += gt[3] * bfhi(yw.y); }
        }
#pragma unroll
        for (int j = 0; j < 4; ++j) s += (v[j][0] * v[j][0] + v[j][1] * v[j][1]) + (v[j][2] * v[j][2] + v[j][3] * v[j][3]);
        const float rstd = rsqrtf(wave_sum(s) * (1.0f / DM) + NORM_EPS);
        f32x4* xo = (f32x4*)(xout + (size_t)row * DM) + lane;
        if (FINAL) {
#pragma unroll
            for (int j = 0; j < 4; ++j) xo[64 * j] = v[j] * rstd * gv[j];
        } else {
            if (WRITE_X) {
#pragma unroll
                for (int j = 0; j < 4; ++j) xo[64 * j] = v[j];
            }
            unsigned long long* o8 = (unsigned long long*)(dst + (size_t)row * DM) + lane;
#pragma unroll
            for (int j = 0; j < 4; ++j) {
                const f32x4 h = v[j] * rstd * gv[j] * scv[j] + shv[j];
                o8[64 * j] = (unsigned long long)pk2(h[0], h[1]) | ((unsigned long long)pk2(h[2], h[3]) << 32);
            }
        }
    }
}
__device__ __forceinline__ bf16x4 tr4(const LAS bf16_t* img, int pitch, int row0, int col0, int g, int q) {
    return __builtin_amdgcn_ds_read_tr16_b64_v4i16((LAS bf16x4*)(img + (row0 + 4 * g + (q >> 2)) * pitch + col0 + 4 * (q & 3)));
}
__device__ __forceinline__ bf16x8 tr8(const LAS bf16_t* img, int pitch, int row0, int col0, int g, int q) {
    const bf16x4 lo = __builtin_amdgcn_ds_read_tr16_b64_v4i16((LAS bf16x4*)(img + (row0 + 8 * g + (q >> 2)) * pitch + col0 + 4 * (q & 3)));
    const bf16x4 hi = __builtin_amdgcn_ds_read_tr16_b64_v4i16((LAS bf16x4*)(img + (row0 + 8 * g + 4 + (q >> 2)) * pitch + col0 + 4 * (q & 3)));
    return __builtin_shufflevector(lo, hi, 0, 1, 2, 3, 4, 5, 6, 7);
}
struct AttRegs { u32x4 kv[2][4], vv[2][4]; bf16x8 qf[2][2]; };
constexpr int ATT_UNITS = 2304;
__device__ __forceinline__ void att_decode(int u, int& br, int& b, int& h, int& r, int& L, int& p0, int& tok0) {
    const int pi = u >> 6, k = u & 63; b = pi / 6; h = pi % 6; br = k >> 4; const int w = k & 15;
    const int lr = br * 2, nblk = 16 >> lr, rho = w >> (4 - lr), blk = w & (nblk - 1); r = 1 << lr; L = SEQ >> lr; p0 = blk * 256; tok0 = b * SEQ + rho;
}
__device__ __forceinline__ int att_unit(int li, int x) { const int pl = li / 48, k = li - pl * 48; return ((x + 8 * pl) << 6) | k; }
__device__ __forceinline__ void att_load(const Params& P, int u, int tid, AttRegs& R) {
    int br, b, h, r, L, p0, tok0; att_decode(u, br, b, h, r, L, p0, tok0);
    const bf16_t* proj = (const bf16_t*)(P.ws + WS_PROJ);
#pragma unroll
    for (int it = 0; it < 2; ++it) {
        const int item = tid + it * NTHREADS, key = item >> 1, half = item & 1, kj = p0 - 64 + key;
        if (item < 768 && kj >= 0 && kj < L) {
            const bf16_t* src = proj + (size_t)(tok0 + r * kj) * INW + h * 64 + half * 32;
#pragma unroll
            for (int i = 0; i < 4; ++i) { R.kv[it][i] = *(const u32x4*)(src + C_AK + 8 * i); R.vv[it][i] = *(const u32x4*)(src + C_AV + 8 * i); }
        } else {
#pragma unroll
            for (int i = 0; i < 4; ++i) { R.kv[it][i] = (u32x4){0u, 0u, 0u, 0u}; R.vv[it][i] = (u32x4){0u, 0u, 0u, 0u}; }
        }
    }
    const int lane = tid & 63, wave = tid >> 6, q = lane & 15, g = lane >> 4;
#pragma unroll
    for (int qt = 0; qt < 2; ++qt) {
        const size_t tokq = (size_t)(tok0 + r * (p0 + 32 * wave + 16 * qt + q));
#pragma unroll
        for (int kk = 0; kk < 2; ++kk) R.qf[qt][kk] = *(const bf16x8*)(proj + tokq * INW + C_AQ + h * 64 + kk * 32 + 8 * g);
    }
}
__device__ __forceinline__ void att_phase(const Params& P, LAS unsigned char* lds) {
    const int tid = opaque_tid(), lane = tid & 63, wave = __builtin_amdgcn_readfirstlane(tid >> 6), q = lane & 15, g = lane >> 4;
    LAS bf16_t* Ks = (LAS bf16_t*)lds;
    LAS bf16_t* Vs = (LAS bf16_t*)(lds + 55296);
    const int xq = blockIdx.x & 7, nj = ((int)gridDim.x + 7 - xq) >> 3;
    int li = blockIdx.x >> 3; if (li >= 288) return;
    AttRegs R; att_load(P, att_unit(li, xq), tid, R);
    for (; li < 288; li += nj) {
        const int u = att_unit(li, xq);
        int br, b, h, r, L, p0, tok0; att_decode(u, br, b, h, r, L, p0, tok0);
#pragma unroll
        for (int it = 0; it < 2; ++it) {
            const int item = tid + it * NTHREADS, key = item >> 1, half = item & 1;
            if (item < 768) {
#pragma unroll
                for (int i = 0; i < 4; ++i) { *(LAS u32x4*)(Ks + key * 72 + half * 32 + 8 * i) = R.kv[it][i]; *(LAS u32x4*)(Vs + key * 72 + half * 32 + 8 * i) = R.vv[it][i]; }
            }
        }
        bf16x8 qf[2][2]; qf[0][0] = R.qf[0][0]; qf[0][1] = R.qf[0][1]; qf[1][0] = R.qf[1][0]; qf[1][1] = R.qf[1][1];
        __syncthreads();
        if (li + nj < 288) att_load(P, att_unit(li + nj, xq), tid, R);
        const float slope_l2 = exp2f(-8.0f * (float)(h + 1) / 6.0f) * (float)r * 1.44269504f, qk_l2 = 0.125f * 1.44269504f;
        const float fbase = (float)(64 + q - 4 * g);
        const bool edge = (p0 < 64) || (p0 + 320 > L);
#pragma unroll
        for (int qt = 0; qt < 2; ++qt) {
            const int kw = 32 * wave + 16 * qt;
            const int p = p0 + kw + q; const size_t tokq = (size_t)(tok0 + r * p);
            f32x4 st[9]; float mx = -3.0e38f;
#pragma unroll
            for (int t = 0; t < 9; ++t) {
                f32x4 acc = {0.f, 0.f, 0.f, 0.f};
#pragma unroll
                for (int kk = 0; kk < 2; ++kk) { const bf16x8 a = *(const LAS bf16x8*)(Ks + (kw + 16 * t + q) * 72 + kk * 32 + 8 * g); acc = MFMA32(a, qf[qt][kk], acc); }
#pragma unroll
                for (int j = 0; j < 4; ++j) {
                    const float d = fabsf(fbase - (float)(16 * t + j));
                    float s = acc[j] * qk_l2 - slope_l2 * d;
                    if (t == 0 || t == 8) s = (d <= 64.0f) ? s : -1.0e30f;
                    acc[j] = s;
                }
                if (edge) {
#pragma unroll
                    for (int j = 0; j < 4; ++j) { const int kj = p0 - 64 + kw + 16 * t + 4 * g + j; acc[j] = (kj >= 0 && kj < L) ? acc[j] : -1.0e30f; }
                }
#pragma unroll
                for (int j = 0; j < 4; ++j) mx = fmaxf(mx, acc[j]);
                st[t] = acc;
            }
            mx = fmaxf(mx, __shfl_xor(mx, 16)); mx = fmaxf(mx, __shfl_xor(mx, 32));
            float ls = 0.f; bf16x4 pt[9];
#pragma unroll
            for (int t = 0; t < 9; ++t) { f32x4 e;
#pragma unroll
                for (int j = 0; j < 4; ++j) { e[j] = __builtin_amdgcn_exp2f(st[t][j] - mx); ls += e[j]; }
                pt[t] = pk4(e); }
            ls += __shfl_xor(ls, 16); ls += __shfl_xor(ls, 32);
            const float inv = __builtin_amdgcn_rcpf(ls);
            bf16_t* ob = (bf16_t*)(P.ws + WS_OB) + ((size_t)br * NTOK + tokq) * 384 + h * 64;
            const LAS bf16_t* vrd = Vs + (kw + 4 * g + (q >> 2)) * 72 + 4 * (q & 3);
#pragma unroll
            for (int dt = 0; dt < 4; ++dt) {
                f32x4 acc = {0.f, 0.f, 0.f, 0.f};
#pragma unroll
                for (int t = 0; t < 9; ++t) { const bf16x4 a = __builtin_amdgcn_ds_read_tr16_b64_v4i16((LAS bf16x4*)(vrd + 16 * t * 72 + dt * 16)); acc = MFMA16(a, pt[t], acc); }
                acc = acc * inv;
                *(bf16x4*)(ob + dt * 16 + 4 * g) = pk4(acc);
            }
            if (g == 0) ((float*)(P.ws + WS_LSE))[((size_t)br * NTOK + tokq) * 6 + h] = (mx + __log2f(ls)) * 0.69314718f;
        }
        __syncthreads();
    }
}
__device__ __forceinline__ void att_merge(const Params& P) {
    const bf16_t* ob = (const bf16_t*)(P.ws + WS_OB); const float* lse = (const float*)(P.ws + WS_LSE); bf16_t* mixed = (bf16_t*)(P.ws + WS_HBUF);
    for (size_t it = (size_t)blockIdx.x * NTHREADS + opaque_tid(); it < (size_t)NTOK * 48; it += (size_t)gridDim.x * NTHREADS) {
        const size_t tok = it / 48; const int grp = (int)(it % 48), h = grp >> 3;
        const float l0 = lse[tok * 6 + h], l1 = lse[((size_t)NTOK + tok) * 6 + h], l2 = lse[((size_t)2 * NTOK + tok) * 6 + h];
        const float m = fmaxf(l0, fmaxf(l1, l2)), e0 = __expf(l0 - m), e1 = __expf(l1 - m), e2 = __expf(l2 - m), is = __builtin_amdgcn_rcpf(e0 + e1 + e2);
        const float w0 = e0 * is, w1 = e1 * is, w2 = e2 * is;
        const u32x4 a = *(const u32x4*)(ob + tok * 384 + grp * 8), bq = *(const u32x4*)(ob + ((size_t)NTOK + tok) * 384 + grp * 8), cq = *(const u32x4*)(ob + ((size_t)2 * NTOK + tok) * 384 + grp * 8);
        u32x4 o;
#pragma unroll
        for (int i = 0; i < 4; ++i) o[i] = pk2(w0 * bflo(a[i]) + w1 * bflo(bq[i]) + w2 * bflo(cq[i]), w0 * bfhi(a[i]) + w1 * bfhi(bq[i]) + w2 * bfhi(cq[i]));
        *(u32x4*)(mixed + tok * DM + grp * 8) = o;
    }
}

__device__ __forceinline__ float ret_logg(int h) { return log1pf(-exp2f(-5.0f - (float)h)); }
struct RetARegs { u32x4 k0, k1, v0, v1; };
__device__ __forceinline__ void retA_load(const Params& P, int u, int tid, RetARegs& R) {
    const int bh = u >> 5, n = u & 31, b = bh / 6, h = bh % 6, c = tid >> 2, qd = tid & 3;
    const bf16_t* src = (const bf16_t*)(P.ws + WS_PROJ) + (size_t)(b * SEQ + n * 128 + c) * INW + h * 64 + qd * 16;
    R.k0 = *(const u32x4*)(src + C_RK); R.k1 = *(const u32x4*)(src + C_RK + 8); R.v0 = *(const u32x4*)(src + C_RV); R.v1 = *(const u32x4*)(src + C_RV + 8);
}
__device__ __forceinline__ void retA_phase(const Params& P, LAS unsigned char* lds) {
    const int tid = opaque_tid(), lane = tid & 63, wave = __builtin_amdgcn_readfirstlane(tid >> 6), q = lane & 15, g = lane >> 4;
    LAS bf16_t* Kf = (LAS bf16_t*)lds; LAS bf16_t* Kb = (LAS bf16_t*)(lds + 18432); LAS bf16_t* Vs = (LAS bf16_t*)(lds + 36864);
    int u = blockIdx.x; if (u >= 1536) return;
    RetARegs R; retA_load(P, u, tid, R);
    for (; u < 1536; u += gridDim.x) {
        const int bh = u >> 5, n = u & 31, h = bh % 6;
        const float lg = ret_logg(h);
        {
            const int c = tid >> 2, qd = tid & 3;
            const float wf = 0.125f * __expf(lg * (float)(127 - c)), wb = 0.125f * __expf(lg * (float)c);
            u32x4 f0, f1, b0, b1;
#pragma unroll
            for (int e = 0; e < 4; ++e) { f0[e] = pk2(bflo(R.k0[e]) * wf, bfhi(R.k0[e]) * wf); f1[e] = pk2(bflo(R.k1[e]) * wf, bfhi(R.k1[e]) * wf);
                b0[e] = pk2(bflo(R.k0[e]) * wb, bfhi(R.k0[e]) * wb); b1[e] = pk2(bflo(R.k1[e]) * wb, bfhi(R.k1[e]) * wb); }
            *(LAS u32x4*)(Kf + c * 72 + qd * 16) = f0; *(LAS u32x4*)(Kf + c * 72 + qd * 16 + 8) = f1;
            *(LAS u32x4*)(Kb + c * 72 + qd * 16) = b0; *(LAS u32x4*)(Kb + c * 72 + qd * 16 + 8) = b1;
            *(LAS u32x4*)(Vs + c * 72 + qd * 16) = R.v0; *(LAS u32x4*)(Vs + c * 72 + qd * 16 + 8) = R.v1;
        }
        __syncthreads();
        if (u + (int)gridDim.x < 1536) retA_load(P, u + gridDim.x, tid, R);
        const int dir = wave >> 2, dt = wave & 3; const LAS bf16_t* Kt = dir ? Kb : Kf;
        bf16x8 afr[4];
#pragma unroll
        for (int kk = 0; kk < 4; ++kk) afr[kk] = tr8(Kt, 72, kk * 32, dt * 16, g, q);
        bf16_t* dst = (bf16_t*)(P.ws + WS_RST) + ((size_t)(bh * 32 + n) * 2 + dir) * 4096;
#pragma unroll
        for (int et = 0; et < 4; ++et) {
            f32x4 acc = {0.f, 0.f, 0.f, 0.f};
#pragma unroll
            for (int kk = 0; kk < 4; ++kk) { const bf16x8 bfr = tr8(Vs, 72, kk * 32, et * 16, g, q); acc = MFMA32(afr[kk], bfr, acc); }
            *(bf16x4*)(dst + (et * 16 + q) * 64 + dt * 16 + 4 * g) = pk4(acc);
        }
        __syncthreads();
    }
}
__device__ __forceinline__ void ret_scan(const Params& P) {
    bf16_t* st = (bf16_t*)(P.ws + WS_RST);
    for (int it = blockIdx.x * NTHREADS + opaque_tid(); it < 48 * 2 * 512; it += gridDim.x * NTHREADS) {
        const int ch = it & 511, dir = (it >> 9) & 1, bh = it >> 10, h = bh % 6;
        const float cd = __expf(ret_logg(h) * 128.0f);
        float s[8];
#pragma unroll
        for (int e = 0; e < 8; ++e) s[e] = 0.f;
        for (int i0 = 0; i0 < 32; i0 += 8) {
            u32x4 v[8];
#pragma unroll
            for (int i = 0; i < 8; ++i) { const int n = dir ? 31 - (i0 + i) : (i0 + i); v[i] = *(const u32x4*)(st + ((size_t)(bh * 32 + n) * 2 + dir) * 4096 + 8 * ch); }
#pragma unroll
            for (int i = 0; i < 8; ++i) { const int n = dir ? 31 - (i0 + i) : (i0 + i);
                u32x4 o;
#pragma unroll
                for (int e = 0; e < 4; ++e) o[e] = pk2(s[2 * e], s[2 * e + 1]);
                *(u32x4*)(st + ((size_t)(bh * 32 + n) * 2 + dir) * 4096 + 8 * ch) = o;
#pragma unroll
                for (int e = 0; e < 4; ++e) { s[2 * e] = cd * s[2 * e] + bflo(v[i][e]); s[2 * e + 1] = cd * s[2 * e + 1] + bfhi(v[i][e]); } }
        }
    }
}
struct RetBRegs { u32x4 k0, k1, v0, v1, rf, rb, q0, q1; };
__device__ __forceinline__ void retB_load(const Params& P, int u, int tid, RetBRegs& R) {
    const int bh = u >> 5, n = u & 31, b = bh / 6, h = bh % 6, c = tid >> 2, qd = tid & 3;
    const bf16_t* proj = (const bf16_t*)(P.ws + WS_PROJ);
    const bf16_t* src = proj + (size_t)(b * SEQ + n * 128 + c) * INW + h * 64 + qd * 16;
    R.k0 = *(const u32x4*)(src + C_RK); R.k1 = *(const u32x4*)(src + C_RK + 8); R.v0 = *(const u32x4*)(src + C_RV); R.v1 = *(const u32x4*)(src + C_RV + 8);
    const bf16_t* rs = (const bf16_t*)(P.ws + WS_RST) + (size_t)(bh * 32 + n) * 2 * 4096;
    const int e = tid >> 3, d8 = (tid & 7) * 8;
    R.rf = *(const u32x4*)(rs + e * 64 + d8); R.rb = *(const u32x4*)(rs + 4096 + e * 64 + d8);
    const int lane = tid & 63, wave = tid >> 6, q = lane & 15, g = lane >> 4;
    const bf16_t* qp = proj + (size_t)(b * SEQ + n * 128 + 16 * wave + q) * INW + C_RQ + h * 64 + 8 * g;
    R.q0 = *(const u32x4*)qp; R.q1 = *(const u32x4*)(qp + 32);
}
__device__ __forceinline__ void retB_phase(const Params& P, LAS unsigned char* lds, int layer) {
    const int tid = opaque_tid(), lane = tid & 63, wave = __builtin_amdgcn_readfirstlane(tid >> 6), q = lane & 15, g = lane >> 4;
    const bf16_t* proj = (const bf16_t*)(P.ws + WS_PROJ);
    LAS bf16_t* Ks = (LAS bf16_t*)lds;
    LAS bf16_t* Vs = (LAS bf16_t*)(lds + 18432);
    LAS bf16_t* Rf = (LAS bf16_t*)(lds + 36864);
    LAS bf16_t* Rb = (LAS bf16_t*)(lds + 46080);
    int u = blockIdx.x; if (u >= 1536) return;
    RetBRegs R; retB_load(P, u, tid, R);
    for (; u < 1536; u += gridDim.x) {
        const int bh = u >> 5, n = u & 31, b = bh / 6, h = bh % 6;
        const float lg = ret_logg(h);
        {
            const int c = tid >> 2, qd = tid & 3, e = tid >> 3, d8 = (tid & 7) * 8;
            *(LAS u32x4*)(Ks + c * 72 + qd * 16) = R.k0; *(LAS u32x4*)(Ks + c * 72 + qd * 16 + 8) = R.k1;
            *(LAS u32x4*)(Vs + c * 72 + qd * 16) = R.v0; *(LAS u32x4*)(Vs + c * 72 + qd * 16 + 8) = R.v1;
            *(LAS u32x4*)(Rf + e * 72 + d8) = R.rf; *(LAS u32x4*)(Rb + e * 72 + d8) = R.rb;
        }
        const u32x4 qraw[2] = {R.q0, R.q1};
        __syncthreads();
        if (u + (int)gridDim.x < 1536) retB_load(P, u + gridDim.x, tid, R);
        const int i = 16 * wave + q; const size_t tok = (size_t)(b * SEQ + n * 128 + i);
        u32x2 rgv[4]; f32x4 gnv[4];
#pragma unroll
        for (int et = 0; et < 4; ++et) { rgv[et] = *(const u32x2*)(proj + tok * INW + C_RG + h * 64 + et * 16 + 4 * g); gnv[et] = *(const f32x4*)(P.ret_gn + layer * 384 + h * 64 + et * 16 + 4 * g); }
        bf16x8 qf[2], qff[2], qfb[2];
        {
            const float ff = __expf(lg * (float)(i + 1)), fb = __expf(lg * (float)(128 - i));
#pragma unroll
            for (int kk = 0; kk < 2; ++kk) { const u32x4 raw = qraw[kk];
                qf[kk] = __builtin_bit_cast(bf16x8, raw); u32x4 a, c2;
#pragma unroll
                for (int e = 0; e < 4; ++e) { const float lo = bflo(raw[e]), hi = bfhi(raw[e]); a[e] = pk2(lo * ff, hi * ff); c2[e] = pk2(lo * fb, hi * fb); }
                qff[kk] = __builtin_bit_cast(bf16x8, a); qfb[kk] = __builtin_bit_cast(bf16x8, c2); }
        }
        bf16x4 pt[8];
#pragma unroll
        for (int jt = 0; jt < 8; ++jt) {
            f32x4 acc = {0.f, 0.f, 0.f, 0.f};
#pragma unroll
            for (int kk = 0; kk < 2; ++kk) { const bf16x8 a = *(const LAS bf16x8*)(Ks + (16 * jt + q) * 72 + kk * 32 + 8 * g); acc = MFMA32(a, qf[kk], acc); }
#pragma unroll
            for (int jj = 0; jj < 4; ++jj) { int dd = i - (16 * jt + 4 * g + jj); dd = dd < 0 ? -dd : dd; acc[jj] = acc[jj] * 0.125f * __expf(lg * (float)dd); }
            pt[jt] = pk4(acc);
        }
        f32x4 o[4];
#pragma unroll
        for (int et = 0; et < 4; ++et) {
            f32x4 acc = {0.f, 0.f, 0.f, 0.f};
#pragma unroll
            for (int jt = 0; jt < 8; ++jt) { const bf16x4 a = tr4(Vs, 72, 16 * jt, et * 16, g, q); acc = MFMA16(a, pt[jt], acc); }
#pragma unroll
            for (int kk = 0; kk < 2; ++kk) { const bf16x8 a = *(const LAS bf16x8*)(Rf + (et * 16 + q) * 72 + kk * 32 + 8 * g); acc = MFMA32(a, qff[kk], acc);
                const bf16x8 a2 = *(const LAS bf16x8*)(Rb + (et * 16 + q) * 72 + kk * 32 + 8 * g); acc = MFMA32(a2, qfb[kk], acc); }
            o[et] = acc;
        }
        float s = 0.f;
#pragma unroll
        for (int et = 0; et < 4; ++et) s += (o[et][0] + o[et][1]) + (o[et][2] + o[et][3]);
        s += __shfl_xor(s, 16); s += __shfl_xor(s, 32);
        const float mu = s * (1.0f / 64.0f); float vs = 0.f;
#pragma unroll
        for (int et = 0; et < 4; ++et) { o[et] = o[et] - mu; vs += (o[et][0] * o[et][0] + o[et][1] * o[et][1]) + (o[et][2] * o[et][2] + o[et][3] * o[et][3]); }
        vs += __shfl_xor(vs, 16); vs += __shfl_xor(vs, 32);
        const float rstd = rsqrtf(vs * (1.0f / 64.0f) + NORM_EPS);
        bf16_t* mixed = (bf16_t*)(P.ws + WS_HBUF) + tok * DM + 384 + h * 64;
#pragma unroll
        for (int et = 0; et < 4; ++et) {
            const f32x4 gn = gnv[et]; const u32x2 rg = rgv[et];
            f32x4 y; y[0] = o[et][0] * rstd * gn[0] * siluf(bflo(rg.x)); y[1] = o[et][1] * rstd * gn[1] * siluf(bfhi(rg.x));
            y[2] = o[et][2] * rstd * gn[2] * siluf(bflo(rg.y)); y[3] = o[et][3] * rstd * gn[3] * siluf(bfhi(rg.y));
            *(bf16x4*)(mixed + et * 16 + 4 * g) = pk4(y);
        }
        __syncthreads();
    }
}
__device__ __forceinline__ void hgrn_gate(float z, float lbv, float& f, float& kk) {
    z = fminf(fmaxf(z, -30.f), 30.f);
    const float ez = __expf(-z), sg = __builtin_amdgcn_rcpf(1.0f + ez);
    f = lbv + (1.0f - lbv) * sg; kk = (1.0f - lbv) * ez * sg;
}
__device__ __forceinline__ void hgA_unit(const Params& P, LAS unsigned char* lds, int u, int layer) {
    const int tid = opaque_tid(), lane = tid & 63, wave = __builtin_amdgcn_readfirstlane(tid >> 6), q = lane & 15, g = lane >> 4;
    const int bh = u >> 5, n = u & 31, b = bh >> 2, h = bh & 3;
    const bf16_t* proj = (const bf16_t*)(P.ws + WS_PROJ);
    LAS bf16_t* Kr = (LAS bf16_t*)lds;
    LAS bf16_t* Vs = (LAS bf16_t*)(lds + 36864);
    LAS float* segs = (LAS float*)(lds + 55296);
    const size_t tokc = (size_t)(b * SEQ + n * 128);
    {
        const int c = tid >> 2, qd = tid & 3; const bf16_t* src = proj + (tokc + c) * INW + C_HI + h * 64 + qd * 16;
        const u32x4 v0 = *(const u32x4*)src, v1 = *(const u32x4*)(src + 8);
        *(LAS u32x4*)(Vs + c * 72 + qd * 16) = v0; *(LAS u32x4*)(Vs + c * 72 + qd * 16 + 8) = v1;
    }
    const int d = tid & 63, dir = (tid >> 6) & 1, seg = tid >> 7;
    const float lbv = ((const float*)(P.ws + WS_LB))[layer * 256 + h * 64 + d];
    float lf[32], kk[32];
    {
        const bf16_t* zp = proj + (tokc + seg * 32) * INW + (dir ? C_HZB : C_HZF) + h * 64 + d;
        bf16_t zr[32];
#pragma unroll
        for (int i = 0; i < 32; ++i) zr[i] = zp[(size_t)i * INW];
#pragma unroll
        for (int i = 0; i < 32; ++i) hgrn_gate(bf2f(zr[i]), lbv, lf[i], kk[i]);
    }
    float ssum = 1.f;
#pragma unroll
    for (int i = 0; i < 32; ++i) ssum *= lf[i];
    segs[(dir * 4 + seg) * 64 + d] = ssum;
    __syncthreads();
    {
        float before = 1.f, after = 1.f;
#pragma unroll
        for (int s2 = 0; s2 < 4; ++s2) { const float v = segs[(dir * 4 + s2) * 64 + d]; if (s2 < seg) before *= v; if (s2 > seg) after *= v; }
        LAS bf16_t* kt = Kr + dir * (128 * 72) + (seg * 32) * 72 + d;
        if (dir == 0) {
            float run = after;
#pragma unroll
            for (int i = 31; i >= 0; --i) { kt[i * 72] = f2bf(kk[i] * run); run *= lf[i]; }
        } else {
            float run = before;
#pragma unroll
            for (int i = 0; i < 32; ++i) { kt[i * 72] = f2bf(kk[i] * run); run *= lf[i]; }
        }
        if (seg == 0) ((float*)(P.ws + WS_HGA))[((size_t)(bh * 2 + dir) * 32 + n) * 64 + d] = ssum * after;
    }
    __syncthreads();
    {
        const int wdir = wave >> 2, dt = wave & 3; const LAS bf16_t* krs = Kr + wdir * (128 * 72);
        bf16x8 afr[4];
#pragma unroll
        for (int kq = 0; kq < 4; ++kq) afr[kq] = tr8(krs, 72, kq * 32, dt * 16, g, q);
        float* dst = (float*)(P.ws + WS_HGU) + ((size_t)(bh * 2 + wdir) * 32 + n) * 4096;
#pragma unroll
        for (int et = 0; et < 4; ++et) {
            f32x4 acc = {0.f, 0.f, 0.f, 0.f};
#pragma unroll
            for (int kq = 0; kq < 4; ++kq) { const bf16x8 bfr = tr8(Vs, 72, kq * 32, et * 16, g, q); acc = MFMA32(afr[kq], bfr, acc); }
#pragma unroll
            for (int j = 0; j < 4; ++j) dst[(dt * 16 + 4 * g + j) * 64 + et * 16 + q] = acc[j];
        }
    }
    __syncthreads();
}
__device__ __forceinline__ void hg_scan(const Params& P) {
    float* U = (float*)(P.ws + WS_HGU); const float* A = (const float*)(P.ws + WS_HGA);
    const int nthr = gridDim.x * NTHREADS; int it0 = blockIdx.x * NTHREADS + opaque_tid() - 48 * 2 * 512; if (it0 < 0) it0 += nthr;
    for (int it = it0; it < 64 * 64 * 16; it += nthr) {
        const int e4 = it & 15, d = (it >> 4) & 63, bd = it >> 10, dir = bd & 1;
        f32x4 s = {0.f, 0.f, 0.f, 0.f};
        for (int i0 = 0; i0 < 32; i0 += 8) {
            f32x4 v[8]; float a[8];
#pragma unroll
            for (int i = 0; i < 8; ++i) { const int n = dir ? 31 - (i0 + i) : (i0 + i); v[i] = *(const f32x4*)(U + ((size_t)(bd * 32 + n) * 64 + d) * 64 + 4 * e4); a[i] = A[(size_t)(bd * 32 + n) * 64 + d]; }
#pragma unroll
            for (int i = 0; i < 8; ++i) { const int n = dir ? 31 - (i0 + i) : (i0 + i); *(f32x4*)(U + ((size_t)(bd * 32 + n) * 64 + d) * 64 + 4 * e4) = s; s = s * a[i] + v[i]; }
        }
    }
}
__device__ __forceinline__ unsigned pk2h(float lo, float hi) { return pk2(lo, hi); }
__device__ __forceinline__ bf16x4 pk4h(f32x4 v) { return pk4(v); }
__device__ __forceinline__ void hgB_unit(const Params& P, LAS unsigned char* lds, int u, int layer) {
    const int tid = opaque_tid(), lane = tid & 63, wave = __builtin_amdgcn_readfirstlane(tid >> 6), q = lane & 15, g = lane >> 4;
    const int b = u >> 5, n = u & 31, h = wave >> 1, dir = wave & 1, bh = b * 4 + h;
    bf16_t* proj = (bf16_t*)(P.ws + WS_PROJ);
    bf16_t* mixed = (bf16_t*)(P.ws + WS_HBUF);
    LAS unsigned char* wl = lds + wave * 7168;
    LAS bf16_t* Qi = (LAS bf16_t*)wl;
    LAS bf16_t* Ki = (LAS bf16_t*)(wl + 2304);
    LAS bf16_t* Vs = (LAS bf16_t*)(wl + 4608);
    LAS float* Al = (LAS float*)(wl + 6912);
    const size_t tokc = (size_t)(b * SEQ + n * 128);
    const float lbv = ((const float*)(P.ws + WS_LB))[layer * 256 + h * 64 + lane];
    f32x4 S[4][4];
    {
        const float* sp = (const float*)(P.ws + WS_HGU) + ((size_t)(bh * 2 + dir) * 32 + n) * 4096;
#pragma unroll
        for (int dt = 0; dt < 4; ++dt)
#pragma unroll
            for (int et = 0; et < 4; ++et)
#pragma unroll
                for (int j = 0; j < 4; ++j) S[dt][et][j] = sp[(dt * 16 + 4 * g + j) * 64 + et * 16 + q];
    }
    bf16_t* odst = dir ? (proj + C_AQ + h * 64) : (mixed + 768 + h * 64); const size_t opitch = dir ? INW : DM;
    bf16_t qr[16], zz[16]; u32x4 v0, v1;
#define HGB_LOAD(SC) do { const size_t toks_ = tokc + (SC) * 16; const bf16_t* base_ = proj + toks_ * INW + h * 64 + lane; \
        _Pragma("unroll") for (int ii = 0; ii < 16; ++ii) { const int t_ = dir ? 15 - ii : ii; qr[ii] = base_[(size_t)t_ * INW + C_HQ]; zz[ii] = base_[(size_t)t_ * INW + (dir ? C_HZB : C_HZF)]; } \
        const bf16_t* vsrc_ = proj + (toks_ + (lane >> 2)) * INW + C_HI + h * 64 + (lane & 3) * 16; v0 = *(const u32x4*)vsrc_; v1 = *(const u32x4*)(vsrc_ + 8); } while (0)
    HGB_LOAD(dir ? 7 : 0);
    for (int i = 0; i < 8; ++i) {
        const int sc = dir ? 7 - i : i; const size_t toks = tokc + sc * 16;
        {
            *(LAS u32x4*)(Vs + (lane >> 2) * 72 + (lane & 3) * 16) = v0; *(LAS u32x4*)(Vs + (lane >> 2) * 72 + (lane & 3) * 16 + 8) = v1;
            float bp = 1.f;
#pragma unroll
            for (int ii = 0; ii < 16; ++ii) {
                const int t = dir ? 15 - ii : ii;
                float f, kk; hgrn_gate(bf2f(zz[ii]), lbv, f, kk); const float qv = siluf(bf2f(qr[ii]));
                bp *= f;
                Qi[t * 72 + lane] = f2bf(qv * bp); Ki[t * 72 + lane] = f2bf(kk * __builtin_amdgcn_rcpf(fmaxf(bp, 1.0e-30f)));
            }
            Al[lane] = bp;
        }
        if (i + 1 < 8) HGB_LOAD(dir ? 6 - i : i + 1);
        __builtin_amdgcn_fence(__ATOMIC_RELEASE, "wavefront"); __builtin_amdgcn_wave_barrier(); __builtin_amdgcn_fence(__ATOMIC_ACQUIRE, "wavefront");
        f32x4 at = {0.f, 0.f, 0.f, 0.f};
#pragma unroll
        for (int kq = 0; kq < 2; ++kq) { const bf16x8 a8 = *(const LAS bf16x8*)(Ki + q * 72 + kq * 32 + 8 * g), b8 = *(const LAS bf16x8*)(Qi + q * 72 + kq * 32 + 8 * g); at = MFMA32(a8, b8, at); }
#pragma unroll
        for (int j = 0; j < 4; ++j) { const int sl = 4 * g + j; const bool keep = dir ? (sl >= q) : (sl <= q); at[j] = keep ? at[j] : 0.f; }
        const bf16x4 p4 = pk4h(at);
        bf16x4 b4[4], v4[4];
#pragma unroll
        for (int dt = 0; dt < 4; ++dt) b4[dt] = *(const LAS bf16x4*)(Qi + q * 72 + dt * 16 + 4 * g);
#pragma unroll
        for (int et = 0; et < 4; ++et) v4[et] = tr4(Vs, 72, 0, et * 16, g, q);
#pragma unroll
        for (int et = 0; et < 4; ++et) {
            f32x4 o = {0.f, 0.f, 0.f, 0.f};
#pragma unroll
            for (int dt = 0; dt < 4; ++dt) o = MFMA16(pk4h(S[dt][et]), b4[dt], o);
            o = MFMA16(v4[et], p4, o);
            *(bf16x4*)(odst + (toks + q) * opitch + et * 16 + 4 * g) = pk4(o);
        }
#pragma unroll
        for (int dt = 0; dt < 4; ++dt) {
            const bf16x4 kT4 = tr4(Ki, 72, 0, dt * 16, g, q);
            const f32x4 al4 = *(const LAS f32x4*)(Al + dt * 16 + 4 * g);
#pragma unroll
            for (int et = 0; et < 4; ++et) { const f32x4 s2 = MFMA16(kT4, v4[et], S[dt][et]); S[dt][et] = s2 * al4; }
        }
        __builtin_amdgcn_fence(__ATOMIC_RELEASE, "wavefront"); __builtin_amdgcn_wave_barrier(); __builtin_amdgcn_fence(__ATOMIC_ACQUIRE, "wavefront");
    }
    asm volatile("s_waitcnt vmcnt(0)" ::: "memory");
    __syncthreads();
    {
        const int tau = tid >> 2, qd = tid & 3;
        bf16_t* mp = mixed + (tokc + tau) * DM + 768 + qd * 64; const bf16_t* bp2 = proj + (tokc + tau) * INW + C_AQ + qd * 64;
        const bf16_t* gp = proj + (tokc + tau) * INW + C_HG + qd * 64; const float* gn = P.hgrn_gn + layer * 256 + qd * 64;
        float o[64]; float sq = 0.f;
#pragma unroll
        for (int c4 = 0; c4 < 16; ++c4) {
            const unsigned long long fv = __hip_atomic_load((const unsigned long long*)(mp + c4 * 4), __ATOMIC_RELAXED, __HIP_MEMORY_SCOPE_AGENT), bv = __hip_atomic_load((const unsigned long long*)(bp2 + c4 * 4), __ATOMIC_RELAXED, __HIP_MEMORY_SCOPE_AGENT);
            const unsigned f0 = (unsigned)fv, f1 = (unsigned)(fv >> 32), b0 = (unsigned)bv, b1 = (unsigned)(bv >> 32);
            const float x0 = bflo(f0) + bflo(b0), x1 = bfhi(f0) + bfhi(b0), x2 = bflo(f1) + bflo(b1), x3 = bfhi(f1) + bfhi(b1);
            o[c4 * 4 + 0] = x0; o[c4 * 4 + 1] = x1; o[c4 * 4 + 2] = x2; o[c4 * 4 + 3] = x3; sq += (x0 * x0 + x1 * x1) + (x2 * x2 + x3 * x3); }
        sq += __shfl_xor(sq, 1); sq += __shfl_xor(sq, 2);
        const float rstd = rsqrtf(sq * (1.0f / 256.0f) + NORM_EPS);
#pragma unroll
        for (int c8 = 0; c8 < 8; ++c8) {
            const u32x4 gv = *(const u32x4*)(gp + c8 * 8); const f32x4 g0 = *(const f32x4*)(gn + c8 * 8), g1 = *(const f32x4*)(gn + c8 * 8 + 4);
            u32x4 r;
            r.x = pk2h(o[c8 * 8 + 0] * rstd * g0[0] * siluf(bflo(gv.x)), o[c8 * 8 + 1] * rstd * g0[1] * siluf(bfhi(gv.x)));
            r.y = pk2h(o[c8 * 8 + 2] * rstd * g0[2] * siluf(bflo(gv.y)), o[c8 * 8 + 3] * rstd * g0[3] * siluf(bfhi(gv.y)));
            r.z = pk2h(o[c8 * 8 + 4] * rstd * g1[0] * siluf(bflo(gv.z)), o[c8 * 8 + 5] * rstd * g1[1] * siluf(bfhi(gv.z)));
            r.w = pk2h(o[c8 * 8 + 6] * rstd * g1[2] * siluf(bflo(gv.w)), o[c8 * 8 + 7] * rstd * g1[3] * siluf(bfhi(gv.w)));
            *(u32x4*)(mp + c8 * 8) = r;
        }
    }
    __syncthreads();
}
constexpr int N_PHASES = 20;
#ifndef PROBE_MASK
#define PROBE_MASK 0u
#endif
#ifndef PROBE_U
#define PROBE_U 0
#endif
#ifndef STAGGER
#define STAGGER 0
#endif
#ifndef STAGGER_TICKS
#define STAGGER_TICKS 1000u
#endif
#ifndef PROBE_SYNC2
#define PROBE_SYNC2 0
#endif
__device__ __forceinline__ void stagger_half(unsigned ticks) {
#if STAGGER
    if ((blockIdx.x >> 3) & 1) { const unsigned long long t0 = __builtin_amdgcn_s_memrealtime(); while (__builtin_amdgcn_s_memrealtime() - t0 < ticks) __builtin_amdgcn_s_sleep(32); }
    __syncthreads();
#endif
}
__device__ __forceinline__ void run_phase(const Params& P, LAS unsigned char* lds, int ph) {
    unsigned char* ws = P.ws;
    if (ph == 0) { phase_prologue(P, lds); return; }
    if (ph == N_PHASES - 1) { const float* ml = (const float*)(ws + WS_MOD) + (size_t)(DEPTH - 1) * NBATCH * NMOD * DM;
        phase_norm<2, false, true>(P.out, (const bf16_t*)(ws + WS_OB), ml + 2 * DM, (const bf16_t*)(ws + WS_HBUF), ml + 5 * DM, P.out, P.g_final, nullptr, nullptr, nullptr); return; }
    const int l = (ph - 1) / 9, s = (ph - 1) % 9;
    const float* mod = (const float*)(ws + WS_MOD) + (size_t)l * NBATCH * NMOD * DM; const float* modp = mod - (size_t)NBATCH * NMOD * DM;
    const float* xprev = (l == 1) ? P.x : P.out;
    bf16_t* hbuf = (bf16_t*)(ws + WS_HBUF); bf16_t* proj = (bf16_t*)(ws + WS_PROJ); bf16_t* ybuf = (bf16_t*)(ws + WS_OB);
#ifdef PH_ONLY
    if (s != PH_ONLY) return;
#endif
    int kD = DM, kF = FFN; asm volatile("" : "+s"(kD), "+s"(kF));
    switch (s) {
    case 0: if (l == 0) { phase_norm<0, false, false>(P.x, nullptr, nullptr, nullptr, nullptr, nullptr, P.g_mix, mod + 0 * DM, mod + 1 * DM, hbuf); phase_weights(P, lds); }
            else phase_norm<2, true, false>(xprev, ybuf, modp + 2 * DM, hbuf, modp + 5 * DM, P.out, P.g_mix + l * DM, mod + 0 * DM, mod + 1 * DM, hbuf);
            break;
    case 1: { pg8::Gemm g{hbuf, (const bf16_t*)(ws + WS_WIN) + (size_t)l * INWP * DM, NTOK, INWP, kD}; pg8::StaticOrder S; S.init(NTOK, INWP, gridDim.x, blockIdx.x);
              EpiProj E{proj, INW, INW}; pg8::gemm_phase<EpiProj, pg8::StaticOrder>(lds, g, S, E, nullptr); } break;
    case 2: { for (int rp = 0; rp < (PROBE_U == 1 ? 2 : 1); ++rp) att_phase(P, lds);
              for (int rp = 0; rp < (PROBE_U == 2 ? 2 : 1); ++rp) retA_phase(P, lds);
              for (int rp = 0; rp < (PROBE_U == 3 ? 2 : 1); ++rp) for (int u = blockIdx.x; u < 1024; u += gridDim.x) hgA_unit(P, lds, u, l); } break;
    case 3: { ret_scan(P); hg_scan(P); } break;
    case 4: { for (int rp = 0; rp < (PROBE_U == 4 ? 2 : 1); ++rp) for (int u = blockIdx.x; u < 256; u += gridDim.x) hgB_unit(P, lds, u, l);
              for (int rp = 0; rp < (PROBE_U == 5 ? 2 : 1); ++rp) retB_phase(P, lds, l); att_merge(P); } break;
    case 5: { pg8::Gemm g{hbuf, (const bf16_t*)(ws + WS_WOUT) + (size_t)l * DM * DM, NTOK, DM, kD}; pg8::StaticOrder S; S.init(NTOK, DM, gridDim.x, blockIdx.x);
              EpiProj E{ybuf, DM, DM}; pg8::gemm_phase<EpiProj, pg8::StaticOrder>(lds, g, S, E, nullptr); } break;
    case 6: phase_norm<1, false, false>(l == 0 ? P.x : P.out, ybuf, mod + 2 * DM, nullptr, nullptr, nullptr, P.g_ffn + l * DM, mod + 3 * DM, mod + 4 * DM, hbuf); break;
    case 7: { pg8::Gemm g{hbuf, (const bf16_t*)(ws + WS_WGU) + (size_t)l * 2 * FFN * DM, NTOK, 2 * FFN, kD}; pg8::StaticOrder S; S.init(NTOK, 2 * FFN, gridDim.x, blockIdx.x);
              EpiSwiglu E{proj}; pg8::gemm_phase<EpiSwiglu, pg8::StaticOrder>(lds, g, S, E, nullptr); } break;
    case 8: { pg8::Gemm g{proj, (const bf16_t*)(ws + WS_WDN) + (size_t)l * DM * FFN, NTOK, DM, kF}; pg8::StaticOrder S; S.init(NTOK, DM, gridDim.x, blockIdx.x);
              EpiProj E{hbuf, DM, DM}; pg8::gemm_phase<EpiProj, pg8::StaticOrder>(lds, g, S, E, nullptr); } break;
    }
}
__global__ void __launch_bounds__(NTHREADS) hybrid_fwd(Params P) {
    extern __shared__ __attribute__((aligned(16))) unsigned char lds_raw[];
    __shared__ uint4 xb_words;
    LAS unsigned char* lds = (LAS unsigned char*)lds_raw;
    if (threadIdx.x == 0) xb_words = make_uint4(0u, 0u, 0u, 0u);
    __syncthreads();
    XcdBarrier bar = xcd_barrier_post((unsigned*)(P.ws + WS_CTL), (volatile LAS unsigned*)&xb_words);
    for (int ph = P.ph_lo; ph < P.ph_hi; ++ph) {
        const int reps = ((PROBE_MASK >> ph) & 1u) ? 2 : 1;
        for (int rep = 0; rep < reps; ++rep) { run_phase(P, lds, ph); if (rep + 1 < reps) __syncthreads(); }
        if (ph + 1 < P.ph_hi) {
            if (P.ph_hi > N_PHASES) cg::this_grid().sync(); else xcd_barrier(bar);
            if (PROBE_SYNC2) xcd_barrier(bar);
        }
    }
}

extern "C" void kernel_launch(void* const* d_in, const int* in_sizes, int n_in, void* d_out, int out_size, void* d_ws, size_t ws_size, hipStream_t stream) {
    static int grid = 0;
    if (grid == 0) {
        if (n_in != 14 || out_size != NTOK * DM || ws_size < WS_END) { fprintf(stderr, "kernel_launch: unexpected shapes (n_in %d out %d ws %zu need %zu)\n", n_in, out_size, ws_size, (size_t)WS_END); grid = -1; return; }
        int dev = 0, cus = 0, per_cu = 0;
        hipGetDevice(&dev); hipDeviceGetAttribute(&cus, hipDeviceAttributeMultiprocessorCount, dev);
        if (hipFuncSetAttribute((const void*)hybrid_fwd, hipFuncAttributeMaxDynamicSharedMemorySize, LDS_BYTES) != hipSuccess) { fprintf(stderr, "kernel_launch: hipFuncSetAttribute failed\n"); grid = -1; return; }
        if (hipOccupancyMaxActiveBlocksPerMultiprocessor(&per_cu, (const void*)hybrid_fwd, NTHREADS, LDS_BYTES) != hipSuccess || per_cu < 1) { fprintf(stderr, "kernel_launch: occupancy query says %d\n", per_cu); grid = -1; return; }
        grid = cus;
    }
    if (grid < 0) return;
    if (hipMemsetAsync((char*)d_ws + WS_CTL, 0, 16384, stream) != hipSuccess) { fprintf(stderr, "kernel_launch: memset failed\n"); return; }
    Params p{};
    p.x = (const float*)d_in[0]; p.c = (const float*)d_in[1]; p.w_ada = (const float*)d_in[2]; p.b_ada = (const float*)d_in[3]; p.g_mix = (const float*)d_in[4];
    p.w_in = (const float*)d_in[5]; p.ret_gn = (const float*)d_in[6]; p.hgrn_gn = (const float*)d_in[7]; p.lb_logits = (const float*)d_in[8]; p.w_out = (const float*)d_in[9];
    p.g_ffn = (const float*)d_in[10]; p.w_gu = (const float*)d_in[11]; p.w_down = (const float*)d_in[12]; p.g_final = (const float*)d_in[13];
    p.out = (float*)d_out; p.ws = (unsigned char*)d_ws;
#if ONE_LAUNCH
    p.ph_lo = 0; p.ph_hi = N_PHASES;
    void* args[] = {&p};
    hipError_t e = hipLaunchCooperativeKernel((const void*)hybrid_fwd, dim3(grid), dim3(NTHREADS), args, LDS_BYTES, stream);
    if (e != hipSuccess) fprintf(stderr, "cooperative launch failed: %s (grid %d)\n", hipGetErrorString(e), grid);
#else
    for (int ph = 0; ph < N_PHASES; ++ph) { p.ph_lo = ph; p.ph_hi = ph + 1; hipLaunchKernelGGL(hybrid_fwd, dim3(grid), dim3(NTHREADS), LDS_BYTES, stream, p); }
#endif
}
```

```cpp
#include <hip/hip_runtime.h>
#include <hip/hip_cooperative_groups.h>
#include <cstdio>
#include <cstdint>
namespace cg = cooperative_groups;
#ifndef ONE_LAUNCH
#define ONE_LAUNCH 1
#endif
__device__ __forceinline__ int opaque_tid() { int t = threadIdx.x; asm volatile("" : "+v"(t)); return t; }
#define LAS __attribute__((address_space(3)))
namespace pg8 {
#define PG8_LAS __attribute__((address_space(3)))
typedef unsigned short bf16_t;
typedef short bf16x8 __attribute__((ext_vector_type(8)));
typedef float f32x4 __attribute__((ext_vector_type(4)));
typedef unsigned u32x4 __attribute__((ext_vector_type(4)));
constexpr int BM = 256, BK = 64, HALF = 128, HTB = HALF * BK * 2  , STAGE_BYTES = 8 * HTB, NXCD = 8, WGM = 8;

__host__ __device__ __forceinline__ int lds_byte(int r, int c) { const int st = (r >> 4) * 2 + (c >> 5), rr = r & 15, cc = c & 31, ob = rr * 64 + cc * 2; return st * 1024 + (ob ^ (((ob >> 9) & 1) << 5)); }
__host__ __device__ __forceinline__ void stage_rc(int b, int& R, int& C) { const int st = b / 1024, sb = b % 1024, swz = sb ^ (((sb >> 9) & 1) << 5); R = (st >> 1) * 16 + swz / 64; C = (st & 1) * 32 + (swz % 64) / 2; }
__host__ __device__ __forceinline__ int perm32(int rho) { const int n = rho >> 4, i = rho & 15; return 8 * (i >> 2) + 4 * n + (i & 3); }

struct Unit { int pm, pn; };
struct Gemm { const bf16_t* A; const bf16_t* Bt; int M, N, K; };

struct StaticOrder {
    int nM, nN, nwg, G, c;
    __host__ __device__ void init(int M, int N, int G_, int c_) { nM = M / BM; nN = N / BM; nwg = nM * nN; G = G_; c = c_; }
    __host__ __device__ bool next(int i, Unit& u) const {
        const long L = (long)i * G + c; if (L >= nwg) return false;
        int wgid = (int)L; { const int q = nwg / NXCD, r = nwg % NXCD, xcd = wgid % NXCD, off = wgid / NXCD; wgid = (xcd < r ? xcd * (q + 1) : r * (q + 1) + (xcd - r) * q) + off; }
        const int nig = WGM * nN, gid = wgid / nig, fm = gid * WGM, gsz = (nM - fm) < WGM ? (nM - fm) : WGM;
        u.pm = fm + ((wgid % nig) % gsz); u.pn = (wgid % nig) / gsz; return true;
    }
    __device__ __forceinline__ void a_ready(const Unit&) const {}
    __device__ __forceinline__ void done(const Unit&) const {}
};
__device__ __forceinline__ unsigned cvt_pk_bf16(float lo, float hi) { unsigned r; asm volatile("v_cvt_pk_bf16_f32 %0, %1, %2" : "=v"(r) : "v"(lo), "v"(hi)); return r; }
typedef float f32x2 __attribute__((ext_vector_type(2)));
template <class Epi, class Sched, bool ALIGN_EPI = false, bool SP2 = false>
__device__ __forceinline__ void gemm_phase(PG8_LAS unsigned char* lds, const Gemm g, const Sched& S, const Epi& E) {
    const int tid = opaque_tid(), wid = __builtin_amdgcn_readfirstlane(tid >> 6), lane = tid & 63, wr = wid >> 2, wc = wid & 3, fr = lane & 15, fq = lane >> 4;
    const int K = g.K, nt = K / BK;
    unsigned voffA[2], voffB[2];
#pragma unroll
    for (int i = 0; i < 2; ++i) { int R, C; stage_rc(tid * 16 + i * 8192, R, C); const int Rb = Epi::PERM ? ((R & ~31) + perm32(R & 31)) : R;
        voffA[i] = (unsigned)(R * K + C) * 2u; voffB[i] = (unsigned)(Rb * K + C) * 2u; }
    const size_t kstep = (size_t)(BK * 2);
    const size_t hstep = (size_t)HALF * K * 2;
    const size_t tstep = 2 * hstep;
    const unsigned ldsw = (unsigned)wid * 1024u;
    const int aoff = lds_byte(wr * 64 + fr, fq * 8), boff = lds_byte(wc * 32 + fr, fq * 8);
#define PG8_SA(b, h) (((b) * 2 + (h)) * HTB)
#define PG8_SB(b, h) ((4 + (b) * 2 + (h)) * HTB)
#define PG8_STAGE(bufoff, gbase, voff) do { _Pragma("unroll") for (int _i = 0; _i < 2; ++_i) \
        __builtin_amdgcn_global_load_lds((const unsigned*)((const char*)(gbase) + (voff)[_i]), (PG8_LAS unsigned*)(lds + (bufoff) + ldsw + _i * 8192), 16, 0, 0); } while (0)
#define PG8_LDA(dst, b, h) do { _Pragma("unroll") for (int m = 0; m < 4; ++m) _Pragma("unroll") for (int k = 0; k < 2; ++k) dst[m][k] = *(const PG8_LAS bf16x8*)(lds + PG8_SA(b, h) + aoff + m * 2048 + k * 1024); } while (0)
#define PG8_LDB(dst, b, h) do { _Pragma("unroll") for (int n = 0; n < 2; ++n) _Pragma("unroll") for (int k = 0; k < 2; ++k) dst[n][k] = *(const PG8_LAS bf16x8*)(lds + PG8_SB(b, h) + boff + n * 2048 + k * 1024); } while (0)
#define PG8_MMA(ai, bj, At, Bt) do { __builtin_amdgcn_s_setprio(1); _Pragma("unroll") for (int m = 0; m < 4; ++m) _Pragma("unroll") for (int n = 0; n < 2; ++n) _Pragma("unroll") for (int k = 0; k < 2; ++k) \
        acc[ai][bj][m][n] = __builtin_amdgcn_mfma_f32_16x16x32_bf16(Bt[n][k], At[m][k], acc[ai][bj][m][n], 0, 0, 0); __builtin_amdgcn_s_setprio(0); } while (0)
#define PG8_WAIT_V(n) asm volatile("s_waitcnt vmcnt(" #n ")" ::: "memory")
#define PG8_WAIT_L(n) asm volatile("s_waitcnt lgkmcnt(" #n ")" ::: "memory")
#define PG8_BAR __builtin_amdgcn_s_barrier()
#define PG8_SCHED __builtin_amdgcn_sched_barrier(0)
    Unit cur, nxt; int ui = 0;
    if (!S.next(0, cur)) return;
    f32x4 acc[2][2][4][2];
#pragma unroll
    for (int a = 0; a < 2; ++a)
#pragma unroll
        for (int b = 0; b < 2; ++b)
#pragma unroll
            for (int m = 0; m < 4; ++m)
#pragma unroll
                for (int n = 0; n < 2; ++n) acc[a][b][m][n] = (f32x4){0.f, 0.f, 0.f, 0.f};
    bf16x8 At[4][2], B0[2][2], B1[2][2];
    const char* cA = (const char*)g.A + (size_t)cur.pm * tstep; const char* cB = (const char*)g.Bt + (size_t)cur.pn * tstep;
    S.a_ready(cur);
    if constexpr (SP2) {
        PG8_STAGE(PG8_SB(0, 0), cB, voffB); PG8_STAGE(PG8_SB(0, 1), cB + hstep, voffB); PG8_STAGE(PG8_SA(0, 0), cA, voffA); PG8_STAGE(PG8_SA(0, 1), cA + hstep, voffA);
        if (wr == 1) PG8_BAR;
        PG8_WAIT_V(2); PG8_BAR;
        PG8_STAGE(PG8_SB(1, 0), cB + kstep, voffB); PG8_STAGE(PG8_SA(1, 0), cA + kstep, voffA); PG8_STAGE(PG8_SB(1, 1), cB + hstep + kstep, voffB);
        PG8_WAIT_V(6); PG8_BAR;
    } else {
        PG8_STAGE(PG8_SB(0, 0), cB, voffB); PG8_STAGE(PG8_SA(0, 0), cA, voffA); PG8_STAGE(PG8_SB(0, 1), cB + hstep, voffB); PG8_STAGE(PG8_SA(0, 1), cA + hstep, voffA);
        if (wr == 1) PG8_BAR;
        PG8_WAIT_V(4); PG8_BAR;
        PG8_STAGE(PG8_SB(1, 0), cB + kstep, voffB); PG8_STAGE(PG8_SA(1, 0), cA + kstep, voffA); PG8_STAGE(PG8_SB(1, 1), cB + hstep + kstep, voffB);
        PG8_WAIT_V(6); PG8_BAR;
    }
    for (;;) {
        const bool has_next = S.next(ui + 1, nxt);
        const char* nA = has_next ? (const char*)g.A + (size_t)nxt.pm * tstep : cA; const char* nB = has_next ? (const char*)g.Bt + (size_t)nxt.pn * tstep : cB;
        for (int t = 0; t < nt; t += 2) {
            const bool last = (t == nt - 2);
            const char* a1 = cA + (size_t)(t + 1) * kstep;
            const char* a2 = last ? nA : cA + (size_t)(t + 2) * kstep; const char* b2 = last ? nB : cB + (size_t)(t + 2) * kstep;
            const char* a3 = a2 + kstep; const char* b3 = b2 + kstep;
            if (last && has_next) S.a_ready(nxt);
            if constexpr (SP2) {
            PG8_LDB(B0, 0, 0); PG8_LDB(B1, 0, 1); PG8_SCHED; PG8_LDA(At, 0, 0); PG8_STAGE(PG8_SA(1, 1), a1 + hstep, voffA);
            PG8_WAIT_V(8); PG8_WAIT_L(0); PG8_BAR; PG8_MMA(0, 0, At, B0); PG8_MMA(0, 1, At, B1); PG8_BAR; PG8_SCHED;
            PG8_LDA(At, 0, 1); PG8_STAGE(PG8_SB(0, 0), b2, voffB); PG8_STAGE(PG8_SB(0, 1), b2 + hstep, voffB); PG8_STAGE(PG8_SA(0, 0), a2, voffA);
            PG8_WAIT_V(8); PG8_WAIT_L(0); PG8_BAR; PG8_MMA(1, 0, At, B0); PG8_MMA(1, 1, At, B1); PG8_BAR; PG8_SCHED;
            PG8_LDB(B0, 1, 0); PG8_LDB(B1, 1, 1); PG8_SCHED; PG8_LDA(At, 1, 0); PG8_STAGE(PG8_SA(0, 1), a2 + hstep, voffA);
            PG8_WAIT_V(8); PG8_WAIT_L(0); PG8_BAR; PG8_MMA(0, 0, At, B0); PG8_MMA(0, 1, At, B1); PG8_BAR; PG8_SCHED;
            PG8_LDA(At, 1, 1); PG8_STAGE(PG8_SB(1, 0), b3, voffB); PG8_STAGE(PG8_SB(1, 1), b3 + hstep, voffB); PG8_STAGE(PG8_SA(1, 0), a3, voffA);
            PG8_WAIT_V(8); PG8_WAIT_L(0); PG8_BAR; PG8_MMA(1, 0, At, B0); PG8_MMA(1, 1, At, B1); PG8_BAR; PG8_SCHED;
            } else {
            PG8_LDB(B0, 0, 0); PG8_SCHED; PG8_LDA(At, 0, 0); PG8_STAGE(PG8_SA(1, 1), a1 + hstep, voffA);
            PG8_WAIT_L(8); PG8_BAR; PG8_WAIT_L(0); PG8_MMA(0, 0, At, B0); PG8_BAR; PG8_SCHED;
            PG8_LDB(B1, 0, 1); PG8_STAGE(PG8_SB(0, 0), b2, voffB);
            PG8_BAR; PG8_WAIT_L(0); PG8_MMA(0, 1, At, B1); PG8_BAR;
            PG8_LDA(At, 0, 1); PG8_STAGE(PG8_SA(0, 0), a2, voffA);
            PG8_BAR; PG8_WAIT_L(0); PG8_MMA(1, 0, At, B0); PG8_BAR; PG8_SCHED;
            PG8_STAGE(PG8_SB(0, 1), b2 + hstep, voffB);
            PG8_WAIT_V(6); PG8_BAR; PG8_MMA(1, 1, At, B1); PG8_BAR;
            PG8_LDB(B0, 1, 0); PG8_SCHED; PG8_LDA(At, 1, 0); PG8_STAGE(PG8_SA(0, 1), a2 + hstep, voffA);
            PG8_WAIT_L(8); PG8_BAR; PG8_WAIT_L(0); PG8_MMA(0, 0, At, B0); PG8_BAR; PG8_SCHED;
            PG8_LDB(B1, 1, 1); PG8_STAGE(PG8_SB(1, 0), b3, voffB);
            PG8_BAR; PG8_WAIT_L(0); PG8_MMA(0, 1, At, B1); PG8_BAR;
            PG8_LDA(At, 1, 1); PG8_STAGE(PG8_SA(1, 0), a3, voffA);
            PG8_BAR; PG8_WAIT_L(0); PG8_MMA(1, 0, At, B0); PG8_BAR; PG8_SCHED;
            PG8_STAGE(PG8_SB(1, 1), b3 + hstep, voffB);
            PG8_WAIT_V(6); PG8_BAR; PG8_MMA(1, 1, At, B1); PG8_BAR;
            }
        }
        if constexpr (ALIGN_EPI) { if (wr == 0) PG8_BAR; }
        if constexpr (!Epi::AFTER_DRAIN) { E(acc, cur, wr, wc, fr, fq); S.done(cur); }
        if (!has_next) break;
#pragma unroll
        for (int a = 0; a < 2; ++a)
#pragma unroll
            for (int b = 0; b < 2; ++b)
#pragma unroll
                for (int m = 0; m < 4; ++m)
#pragma unroll
                    for (int n = 0; n < 2; ++n) acc[a][b][m][n] = (f32x4){0.f, 0.f, 0.f, 0.f};
        cur = nxt; cA = nA; cB = nB; ++ui;
        if constexpr (ALIGN_EPI) { if (wr == 1) PG8_BAR; }
    }
    PG8_WAIT_V(0);
    if constexpr (!ALIGN_EPI) { if (wr == 0) PG8_BAR; }
    PG8_BAR;
    if constexpr (Epi::AFTER_DRAIN) { E.fused(acc, cur, wr, wc, fr, fq, lds, wid, lane); S.done(cur); }
#undef PG8_SA
#undef PG8_SB
#undef PG8_STAGE
#undef PG8_LDA
#undef PG8_LDB
#undef PG8_MMA
#undef PG8_WAIT_V
#undef PG8_WAIT_L
#undef PG8_BAR
#undef PG8_SCHED
}
}

#define XB_TMO      128
#define XB_XCNT(j)  (256  + 64 * (j))
#define XB_XSUB(j)  (1280 + 64 * (j))
#define XB_XGEN(j)  (2304 + 64 * (j))
#define XB_TOP      3328
#define XB_TOPGEN   3392
#define XCD_BAR_WORDS 3456
#define XB_SPIN_CAP (1u << 18)

__device__ __forceinline__ unsigned xb_ld(unsigned* p)              { return __hip_atomic_load(p, __ATOMIC_RELAXED, __HIP_MEMORY_SCOPE_AGENT); }
__device__ __forceinline__ unsigned xb_add(unsigned* p, unsigned v) { return __hip_atomic_fetch_add(p, v, __ATOMIC_RELAXED, __HIP_MEMORY_SCOPE_AGENT); }
__device__ __forceinline__ unsigned xb_xcc_id() { return (unsigned)__builtin_amdgcn_s_getreg((3 << 11) | 20) & 0xFu; }
#define XB_SPIN(cond, bar) do { unsigned _sp = 0; while (cond) { __builtin_amdgcn_s_sleep(1); \
    if ((++_sp & 255u) == 0u) { if (xb_ld(&(bar)[XB_TMO])) break; if (_sp > XB_SPIN_CAP) { atomicAdd(&(bar)[XB_TMO], 1u); break; } } } } while (0)

struct XcdBarrier {
    unsigned* bar; unsigned x;
    volatile LAS unsigned* st;
};

__device__ __forceinline__ XcdBarrier xcd_barrier_post(unsigned* bar, volatile LAS unsigned* st) {
    XcdBarrier b; b.bar = bar; b.x = xb_xcc_id(); b.st = st;
    if (threadIdx.x == 0) (void)xb_add(&bar[XB_XCNT(b.x)], 1u);
    return b;
}
__device__ __forceinline__ void xcd_barrier_complete(unsigned* bar, unsigned x, unsigned& nloc, unsigned& nx) {
    const unsigned G = gridDim.x * gridDim.y * gridDim.z;
    unsigned sum, cnt, mine, sp = 0u;
    for (;;) {
        sum = 0u; cnt = 0u; mine = 0u;
#pragma unroll
        for (unsigned j = 0; j < 16; ++j) { const unsigned c = xb_ld(&bar[XB_XCNT(j)]); sum += c; cnt += (c > 0u) ? 1u : 0u; mine = (j == x) ? c : mine; }
        if (sum == G) break;
        __builtin_amdgcn_s_sleep(1);
        if ((++sp & 255u) == 0u) { if (xb_ld(&bar[XB_TMO])) break; if (sp > XB_SPIN_CAP) { atomicAdd(&bar[XB_TMO], 1u); break; } }
    }
    nloc = mine > 0u ? mine : 1u; nx = cnt > 0u ? cnt : 1u;
}

__device__ __forceinline__ void xcd_barrier(const XcdBarrier& b) {
    asm volatile("s_waitcnt vmcnt(0)" ::: "memory");
    __syncthreads();
    if (threadIdx.x == 0) {
        unsigned* bar = b.bar;
        __builtin_amdgcn_s_waitcnt(0);
        unsigned nloc = b.st[0], nx = b.st[1];
        if (nloc == 0u) { xcd_barrier_complete(bar, b.x, nloc, nx); b.st[0] = nloc; b.st[1] = nx; }
        const unsigned old = xb_add(&bar[XB_XSUB(b.x)], 1u);
        const unsigned gen = old / nloc;
        if (old + 1u == (gen + 1u) * nloc) {
            __builtin_amdgcn_fence(__ATOMIC_RELEASE, "agent");
            asm volatile("s_waitcnt vmcnt(0)" ::: "memory");
            const unsigned og = xb_add(&bar[XB_TOP], 1u);
            const unsigned tg = og / nx;
            if (og + 1u == (tg + 1u) * nx) xb_add(&bar[XB_TOPGEN], 1u);
            else XB_SPIN(xb_ld(&bar[XB_TOPGEN]) == tg, bar);
            __builtin_amdgcn_fence(__ATOMIC_ACQUIRE, "agent");
            xb_add(&bar[XB_XGEN(b.x)], 1u);
            asm volatile("s_waitcnt vmcnt(0)" ::: "memory");
        } else {
            XB_SPIN(xb_ld(&bar[XB_XGEN(b.x)]) == gen, bar);
            __builtin_amdgcn_fence(__ATOMIC_ACQUIRE, "agent");
            asm volatile("s_waitcnt vmcnt(0)" ::: "memory");
        }
    }
    __syncthreads();
}

typedef unsigned short bf16_t;
typedef short bf16x8 __attribute__((ext_vector_type(8)));
typedef short bf16x4 __attribute__((ext_vector_type(4)));
typedef float f32x4 __attribute__((ext_vector_type(4)));
typedef unsigned u32x4 __attribute__((ext_vector_type(4)));
typedef unsigned u32x2 __attribute__((ext_vector_type(2)));
constexpr int DM = 1024, NBATCH = 8, SEQ = 4096, NTOK = NBATCH * SEQ, DEPTH = 2;
constexpr int INW = 3968, INWP = 4096, FFN = 2816, NMOD = 6;
constexpr int C_AQ = 0, C_AK = 384, C_AV = 768, C_RQ = 1152, C_RK = 1536, C_RV = 1920, C_RG = 2304, C_HQ = 2688, C_HZF = 2944, C_HZB = 3200, C_HI = 3456, C_HG = 3712;
constexpr float NORM_EPS = 1e-6f;
constexpr int NTHREADS = 512;
constexpr int LDS_BYTES = 135168;
constexpr size_t WS_CTL = 0, WS_MOD = 16384, WS_LB = WS_MOD + 393216, WS_HGA = WS_LB + 2048, WS_LSE = WS_HGA + 524288, WS_WIN = WS_LSE + 2359296,
    WS_WOUT = WS_WIN + 16777216, WS_WGU = WS_WOUT + 4194304, WS_WDN = WS_WGU + 23068672, WS_HBUF = WS_WDN + 11534336, WS_PROJ = WS_HBUF + 67108864,
    WS_OB = WS_PROJ + 260046848, WS_RST = WS_OB + 75497472, WS_HGU = WS_RST + 25165824, WS_END = WS_HGU + 33554432;

struct Params {
    const float *x, *c, *w_ada, *b_ada, *g_mix, *w_in, *ret_gn, *hgrn_gn, *lb_logits, *w_out, *g_ffn, *w_gu, *w_down, *g_final;
    float* out; unsigned char* ws; int ph_lo, ph_hi;
};

__device__ __forceinline__ float bf2f(bf16_t v) { return __uint_as_float(((unsigned)v) << 16); }
__device__ __forceinline__ float bflo(unsigned w) { return __uint_as_float(w << 16); }
__device__ __forceinline__ float bfhi(unsigned w) { return __uint_as_float(w & 0xffff0000u); }
__device__ __forceinline__ bf16_t f2bf(float f) { return __builtin_bit_cast(bf16_t, (__bf16)f); }
typedef float f32x2c __attribute__((ext_vector_type(2)));
typedef __bf16 bf16v2c __attribute__((ext_vector_type(2)));
__device__ __forceinline__ unsigned pk2(float lo, float hi) { const f32x2c v = {lo, hi}; return __builtin_bit_cast(unsigned, __builtin_convertvector(v, bf16v2c)); }
__device__ __forceinline__ bf16x4 pk4(f32x4 v) { u32x2 w; w.x = pk2(v[0], v[1]); w.y = pk2(v[2], v[3]); return __builtin_bit_cast(bf16x4, w); }
__device__ __forceinline__ float siluf(float v) { return v * __builtin_amdgcn_rcpf(1.0f + __expf(-v)); }
__device__ __forceinline__ float wave_sum(float v) {
#pragma unroll
    for (int o = 1; o < 64; o <<= 1) v += __shfl_xor(v, o);
    return v;
}
#define MFMA32(a, b, c) __builtin_amdgcn_mfma_f32_16x16x32_bf16((a), (b), (c), 0, 0, 0)
#define MFMA16(a, b, c) __builtin_amdgcn_mfma_f32_16x16x16bf16_1k((a), (b), (c), 0, 0, 0)

struct EpiProj {
    static constexpr bool PERM = true, AFTER_DRAIN = false;
    bf16_t* O; int ldc, ncols;
    __device__ __forceinline__ void operator()(const f32x4 (&acc)[2][2][4][2], const pg8::Unit& u, int wr, int wc, int fr, int fq) const {
        const int row0 = u.pm * 256 + wr * 64 + fr, col0 = u.pn * 256 + wc * 32 + 8 * fq;
#pragma unroll
        for (int ai = 0; ai < 2; ++ai)
#pragma unroll
            for (int m = 0; m < 4; ++m) { bf16_t* rowp = O + (size_t)(row0 + ai * 128 + m * 16) * ldc + col0;
#pragma unroll
                for (int bj = 0; bj < 2; ++bj) { if (col0 + bj * 128 < ncols) { const f32x4 v0 = acc[ai][bj][m][0], v1 = acc[ai][bj][m][1];
                    u32x4 w; w.x = pk2(v0[0], v0[1]); w.y = pk2(v0[2], v0[3]); w.z = pk2(v1[0], v1[1]); w.w = pk2(v1[2], v1[3]);
                    *(u32x4*)(rowp + bj * 128) = w; } } }
    }
};
struct EpiRes {
    static constexpr bool PERM = false, AFTER_DRAIN = false;
    const float* base; float* out; const float* gate;
    __device__ __forceinline__ void operator()(const f32x4 (&acc)[2][2][4][2], const pg8::Unit& u, int wr, int wc, int fr, int fq) const {
        const int row0 = u.pm * 256 + wr * 64 + fr, col0 = u.pn * 256 + wc * 32 + 4 * fq;
        const float* gp = gate + (size_t)((u.pm * 256) >> 12) * (NMOD * DM) + col0;
        f32x4 gv[2][2];
#pragma unroll
        for (int bj = 0; bj < 2; ++bj)
#pragma unroll
            for (int n = 0; n < 2; ++n) gv[bj][n] = *(const f32x4*)(gp + bj * 128 + n * 16);
#pragma unroll
        for (int ai = 0; ai < 2; ++ai)
#pragma unroll
            for (int m = 0; m < 4; ++m) { const size_t off = (size_t)(row0 + ai * 128 + m * 16) * DM + col0;
#pragma unroll
                for (int bj = 0; bj < 2; ++bj)
#pragma unroll
                    for (int n = 0; n < 2; ++n) { const f32x4 bs = *(const f32x4*)(base + off + bj * 128 + n * 16);
                        *(f32x4*)(out + off + bj * 128 + n * 16) = bs + gv[bj][n] * acc[ai][bj][m][n]; } }
    }
};
struct EpiSwiglu {
    static constexpr bool PERM = true, AFTER_DRAIN = false;
    bf16_t* O;
    __device__ __forceinline__ void operator()(const f32x4 (&acc)[2][2][4][2], const pg8::Unit& u, int wr, int wc, int fr, int fq) const {
        const int row0 = u.pm * 256 + wr * 64 + fr, col0 = u.pn * 128 + wc * 32 + 8 * fq;
#pragma unroll
        for (int ai = 0; ai < 2; ++ai)
#pragma unroll
            for (int m = 0; m < 4; ++m) { bf16_t* rowp = O + (size_t)(row0 + ai * 128 + m * 16) * FFN + col0;
                float r[8];
#pragma unroll
                for (int n = 0; n < 2; ++n)
#pragma unroll
                    for (int i = 0; i < 4; ++i) { const float g = acc[ai][0][m][n][i], uu = acc[ai][1][m][n][i]; r[n * 4 + i] = siluf(g) * uu; }
                u32x4 w; w.x = pk2(r[0], r[1]); w.y = pk2(r[2], r[3]); w.z = pk2(r[4], r[5]); w.w = pk2(r[6], r[7]);
                *(u32x4*)rowp = w; }
    }
};
__device__ __forceinline__ void transpose_item(const float* W, int K, int N, bf16_t* WT, int dst_row0, int src_col0, int k0, LAS float* scr, int lane) {
    const int c = lane & 7, nr = lane >> 3;
    if (src_col0 < 0) {
#pragma unroll
        for (int j = 0; j < 8; ++j) *(u32x4*)(WT + (size_t)(dst_row0 + nr + 8 * j) * K + k0 + 8 * c) = (u32x4){0u, 0u, 0u, 0u};
        return;
    }
    const int kr = lane >> 4, c4 = lane & 15;
    f32x4 v[16];
#pragma unroll
    for (int i = 0; i < 16; ++i) v[i] = *(const f32x4*)(W + (size_t)(k0 + 4 * i + kr) * N + src_col0 + 4 * c4);
#pragma unroll
    for (int i = 0; i < 16; ++i) { LAS float* d = scr + (4 * i + kr) * 65 + 4 * c4; d[0] = v[i][0]; d[1] = v[i][1]; d[2] = v[i][2]; d[3] = v[i][3]; }
    __builtin_amdgcn_fence(__ATOMIC_RELEASE, "wavefront"); __builtin_amdgcn_wave_barrier(); __builtin_amdgcn_fence(__ATOMIC_ACQUIRE, "wavefront");
#pragma unroll
    for (int j = 0; j < 8; ++j) { const int n = nr + 8 * j; const LAS float* sp = scr + (8 * c) * 65 + n;
        u32x4 o; o.x = pk2(sp[0 * 65], sp[1 * 65]); o.y = pk2(sp[2 * 65], sp[3 * 65]); o.z = pk2(sp[4 * 65], sp[5 * 65]); o.w = pk2(sp[6 * 65], sp[7 * 65]);
        *(u32x4*)(WT + (size_t)(dst_row0 + n) * K + k0 + 8 * c) = o; }
    __builtin_amdgcn_fence(__ATOMIC_RELEASE, "wavefront"); __builtin_amdgcn_wave_barrier(); __builtin_amdgcn_fence(__ATOMIC_ACQUIRE, "wavefront");
}

__device__ __forceinline__ void phase_weights(const Params& P, LAS unsigned char* lds) {
    const int tid = opaque_tid(), lane = tid & 63, wave = __builtin_amdgcn_readfirstlane(tid >> 6);
    unsigned char* ws = P.ws;
    {
        LAS float* scr = (LAS float*)(lds + wave * 16640);
        const int gw = blockIdx.x * 8 + wave, NGW = gridDim.x * 8;
        constexpr int I_IN = 16 * 64, I_OUT = 16 * 16, I_GU = 16 * 88, I_DN = 44 * 16, I_L = I_IN + I_OUT + I_GU + I_DN;
        for (int it = gw; it < DEPTH * I_L; it += NGW) {
            const int l = it / I_L; int r = it % I_L;
            if (r < I_IN) { const int kb = r / 64, nb = r % 64, n0 = nb * 64;
                transpose_item(P.w_in + (size_t)l * DM * INW, DM, INW, (bf16_t*)(ws + WS_WIN) + (size_t)l * INWP * DM, n0, n0 < INW ? n0 : -1, kb * 64, scr, lane); continue; }
            r -= I_IN;
            if (r < I_OUT) { const int kb = r / 16, nb = r % 16;
                transpose_item(P.w_out + (size_t)l * DM * DM, DM, DM, (bf16_t*)(ws + WS_WOUT) + (size_t)l * DM * DM, nb * 64, nb * 64, kb * 64, scr, lane); continue; }
            r -= I_OUT;
            if (r < I_GU) { const int kb = r / 88, nb = r % 88, n0 = nb * 64; const int pn = n0 >> 8, half = (n0 >> 7) & 1, jj = n0 & 127;
                transpose_item(P.w_gu + (size_t)l * DM * 2 * FFN, DM, 2 * FFN, (bf16_t*)(ws + WS_WGU) + (size_t)l * 2 * FFN * DM, n0, half * FFN + pn * 128 + jj, kb * 64, scr, lane); continue; }
            r -= I_GU;
            { const int kb = r / 16, nb = r % 16;
                transpose_item(P.w_down + (size_t)l * FFN * DM, FFN, DM, (bf16_t*)(ws + WS_WDN) + (size_t)l * DM * FFN, nb * 64, nb * 64, kb * 64, scr, lane); }
        }
    }
}
__device__ __forceinline__ void phase_prologue(const Params& P, LAS unsigned char* lds) {
    const int tid = opaque_tid();
    unsigned char* ws = P.ws;
    {
        LAS float* sc = (LAS float*)lds;
        LAS float* red = (LAS float*)(lds + 32768);
        for (int i = tid; i < NBATCH * DM; i += NTHREADS) sc[i] = siluf(P.c[i]);
        __syncthreads();
        float* mod = (float*)(ws + WS_MOD);
        for (int u = blockIdx.x; u < DEPTH * 96; u += gridDim.x) {
            const int l = u / 96, j0 = (u % 96) * 64, col = tid & 63, kp = tid >> 6;
            float acc[8];
#pragma unroll
            for (int b = 0; b < 8; ++b) acc[b] = 0.f;
            const float* wp = P.w_ada + (size_t)l * DM * (NMOD * DM) + j0 + col;
            for (int k = kp * 128; k < kp * 128 + 128; ++k) { const float w = wp[(size_t)k * (NMOD * DM)];
#pragma unroll
                for (int b = 0; b < 8; ++b) acc[b] += sc[b * DM + k] * w; }
#pragma unroll
            for (int b = 0; b < 8; ++b) red[(kp * 8 + b) * 64 + col] = acc[b];
            __syncthreads();
            { const int b = tid >> 6; float s = 0.f;
#pragma unroll
              for (int p = 0; p < 8; ++p) s += red[(p * 8 + b) * 64 + col];
              mod[((size_t)l * NBATCH + b) * (NMOD * DM) + j0 + col] = s + P.b_ada[(size_t)l * NMOD * DM + j0 + col]; }
            __syncthreads();
        }
    }
    if (blockIdx.x == 0 && tid < 256) {
        const float l0 = P.lb_logits[tid], l1 = P.lb_logits[256 + tid], m = fmaxf(l0, l1), e0 = __expf(l0 - m), e1 = __expf(l1 - m);
        const float p0 = e0 / (e0 + e1), p1 = e1 / (e0 + e1);
        float* lb = (float*)(ws + WS_LB);
        lb[tid] = fminf(fmaxf(p0 - p0, 0.f), 1.0f - 1e-6f);
        lb[256 + tid] = fminf(fmaxf((p0 + p1) - p0, 0.f), 1.0f - 1e-6f);
    }
}

template <int NY, bool WRITE_X, bool FINAL>
__device__ __forceinline__ void phase_norm(const float* src, const bf16_t* y, const float* gate, const bf16_t* y2, const float* gate2, float* xout, const float* g, const float* shift, const float* scale, bf16_t* dst) {
    constexpr bool HAS_Y = NY > 0;
    const int tid = opaque_tid(), lane = tid & 63, wave = tid >> 6;
    const int gw = blockIdx.x * 8 + wave, NGW = gridDim.x * 8;
    f32x4 gv[4];
#pragma unroll
    for (int j = 0; j < 4; ++j) gv[j] = *(const f32x4*)(g + 4 * lane + 256 * j);
    const int WPB = NGW / NBATCH, b = gw / WPB;
    if (b >= NBATCH) return;
    f32x4 gtv[4], gtv2[4], scv[4], shv[4];
#pragma unroll
    for (int j = 0; j < 4; ++j) {
        if (HAS_Y) gtv[j] = *(const f32x4*)(gate + (size_t)b * (NMOD * DM) + 4 * lane + 256 * j);
        if (NY > 1) gtv2[j] = *(const f32x4*)(gate2 + (size_t)b * (NMOD * DM) + 4 * lane + 256 * j);
        if (!FINAL) { scv[j] = *(const f32x4*)(scale + (size_t)b * (NMOD * DM) + 4 * lane + 256 * j) + 1.0f; shv[j] = *(const f32x4*)(shift + (size_t)b * (NMOD * DM) + 4 * lane + 256 * j); }
    }
    for (int row = b * SEQ + (gw - b * WPB); row < (b + 1) * SEQ; row += WPB) {
        const f32x4* xr = (const f32x4*)(src + (size_t)row * DM) + lane;
        f32x4 v[4]; float s = 0.f;
#pragma unroll
        for (int j = 0; j < 4; ++j) v[j] = xr[64 * j];
        if (HAS_Y) {
            const u32x2* yr = (const u32x2*)(y + (size_t)row * DM) + lane;
#pragma unroll
            for (int j = 0; j < 4; ++j) { const u32x2 yw = yr[64 * j]; const f32x4 gt = gtv[j];
                v[j][0] += gt[0] * bflo(yw.x); v[j][1] += gt[1] * bfhi(yw.x); v[j][2] += gt[2] * bflo(yw.y); v[j][3] += gt[3] * bfhi(yw.y); }
        }
        if (NY > 1) {
            const u32x2* yr2 = (const u32x2*)(y2 + (size_t)row * DM) + lane;
#pragma unroll
            for (int j = 0; j < 4; ++j) { const u32x2 yw = yr2[64 * j]; const f32x4 gt = gtv2[j];
                v[j][0] += gt[0] * bflo(yw.x); v[j][1] += gt[1] * bfhi(yw.x); v[j][2] += gt[2] * bflo(yw.y); v[j][3] += gt[3] * bfhi(yw.y); }
        }
#pragma unroll
        for (int j = 0; j < 4; ++j) s += (v[j][0] * v[j][0] + v[j][1] * v[j][1]) + (v[j][2] * v[j][2] + v[j][3] * v[j][3]);
        const float rstd = rsqrtf(wave_sum(s) * (1.0f / DM) + NORM_EPS);
        f32x4* xo = (f32x4*)(xout + (size_t)row * DM) + lane;
        if (FINAL) {
#pragma unroll
            for (int j = 0; j < 4; ++j) xo[64 * j] = v[j] * rstd * gv[j];
        } else {
            if (WRITE_X) {
#pragma unroll
                for (int j = 0; j < 4; ++j) xo[64 * j] = v[j];
            }
            unsigned long long* o8 = (unsigned long long*)(dst + (size_t)row * DM) + lane;
#pragma unroll
            for (int j = 0; j < 4; ++j) {
                const f32x4 h = v[j] * rstd * gv[j] * scv[j] + shv[j];
                o8[64 * j] = (unsigned long long)pk2(h[0], h[1]) | ((unsigned long long)pk2(h[2], h[3]) << 32);
            }
        }
    }
}
__device__ __forceinline__ bf16x4 tr4(const LAS bf16_t* img, int pitch, int row0, int col0, int g, int q) {
    return __builtin_amdgcn_ds_read_tr16_b64_v4i16((LAS bf16x4*)(img + (row0 + 4 * g + (q >> 2)) * pitch + col0 + 4 * (q & 3)));
}
__device__ __forceinline__ bf16x8 tr8(const LAS bf16_t* img, int pitch, int row0, int col0, int g, int q) {
    const bf16x4 lo = __builtin_amdgcn_ds_read_tr16_b64_v4i16((LAS bf16x4*)(img + (row0 + 8 * g + (q >> 2)) * pitch + col0 + 4 * (q & 3)));
    const bf16x4 hi = __builtin_amdgcn_ds_read_tr16_b64_v4i16((LAS bf16x4*)(img + (row0 + 8 * g + 4 + (q >> 2)) * pitch + col0 + 4 * (q & 3)));
    return __builtin_shufflevector(lo, hi, 0, 1, 2, 3, 4, 5, 6, 7);
}
struct AttRegs { u32x4 kv[2][4], vv[2][4]; bf16x8 qf[2][2]; };
constexpr int ATT_UNITS = 2304;
__device__ __forceinline__ void att_decode(int u, int& br, int& b, int& h, int& r, int& L, int& p0, int& tok0) {
    const int pi = u >> 6, k = u & 63; b = pi / 6; h = pi % 6; br = k >> 4; const int w = k & 15;
    const int lr = br * 2, nblk = 16 >> lr, rho = w >> (4 - lr), blk = w & (nblk - 1); r = 1 << lr; L = SEQ >> lr; p0 = blk * 256; tok0 = b * SEQ + rho;
}
__device__ __forceinline__ int att_unit(int li, int x) { const int pl = li / 48, k = li - pl * 48; return ((x + 8 * pl) << 6) | k; }
__device__ __forceinline__ void att_load(const Params& P, int u, int tid, AttRegs& R) {
    int br, b, h, r, L, p0, tok0; att_decode(u, br, b, h, r, L, p0, tok0);
    const bf16_t* proj = (const bf16_t*)(P.ws + WS_PROJ);
#pragma unroll
    for (int it = 0; it < 2; ++it) {
        const int item = tid + it * NTHREADS, key = item >> 1, half = item & 1, kj = p0 - 64 + key;
        if (item < 768 && kj >= 0 && kj < L) {
            const bf16_t* src = proj + (size_t)(tok0 + r * kj) * INW + h * 64 + half * 32;
#pragma unroll
            for (int i = 0; i < 4; ++i) { R.kv[it][i] = *(const u32x4*)(src + C_AK + 8 * i); R.vv[it][i] = *(const u32x4*)(src + C_AV + 8 * i); }
        } else {
#pragma unroll
            for (int i = 0; i < 4; ++i) { R.kv[it][i] = (u32x4){0u, 0u, 0u, 0u}; R.vv[it][i] = (u32x4){0u, 0u, 0u, 0u}; }
        }
    }
    const int lane = tid & 63, wave = tid >> 6, q = lane & 15, g = lane >> 4;
#pragma unroll
    for (int qt = 0; qt < 2; ++qt) {
        const size_t tokq = (size_t)(tok0 + r * (p0 + 32 * wave + 16 * qt + q));
#pragma unroll
        for (int kk = 0; kk < 2; ++kk) R.qf[qt][kk] = *(const bf16x8*)(proj + tokq * INW + C_AQ + h * 64 + kk * 32 + 8 * g);
    }
}
__device__ __forceinline__ void att_phase(const Params& P, LAS unsigned char* lds) {
    const int tid = opaque_tid(), lane = tid & 63, wave = __builtin_amdgcn_readfirstlane(tid >> 6), q = lane & 15, g = lane >> 4;
    LAS bf16_t* Ks = (LAS bf16_t*)lds;
    LAS bf16_t* Vs = (LAS bf16_t*)(lds + 55296);
    const int xq = blockIdx.x & 7, nj = ((int)gridDim.x + 7 - xq) >> 3;
    int li = blockIdx.x >> 3; if (li >= 288) return;
    AttRegs R; att_load(P, att_unit(li, xq), tid, R);
    for (; li < 288; li += nj) {
        const int u = att_unit(li, xq);
        int br, b, h, r, L, p0, tok0; att_decode(u, br, b, h, r, L, p0, tok0);
#pragma unroll
        for (int it = 0; it < 2; ++it) {
            const int item = tid + it * NTHREADS, key = item >> 1, half = item & 1;
            if (item < 768) {
#pragma unroll
                for (int i = 0; i < 4; ++i) { *(LAS u32x4*)(Ks + key * 72 + half * 32 + 8 * i) = R.kv[it][i]; *(LAS u32x4*)(Vs + key * 72 + half * 32 + 8 * i) = R.vv[it][i]; }
            }
        }
        bf16x8 qf[2][2]; qf[0][0] = R.qf[0][0]; qf[0][1] = R.qf[0][1]; qf[1][0] = R.qf[1][0]; qf[1][1] = R.qf[1][1];
        __syncthreads();
        if (li + nj < 288) att_load(P, att_unit(li + nj, xq), tid, R);
        const float slope_l2 = exp2f(-8.0f * (float)(h + 1) / 6.0f) * (float)r * 1.44269504f, qk_l2 = 0.125f * 1.44269504f;
        const float fbase = (float)(64 + q - 4 * g);
        const bool edge = (p0 < 64) || (p0 + 320 > L);
#pragma unroll
        for (int qt = 0; qt < 2; ++qt) {
            const int kw = 32 * wave + 16 * qt;
            const int p = p0 + kw + q; const size_t tokq = (size_t)(tok0 + r * p);
            f32x4 st[9]; float mx = -3.0e38f;
#pragma unroll
            for (int t = 0; t < 9; ++t) {
                f32x4 acc = {0.f, 0.f, 0.f, 0.f};
#pragma unroll
                for (int kk = 0; kk < 2; ++kk) { const bf16x8 a = *(const LAS bf16x8*)(Ks + (kw + 16 * t + q) * 72 + kk * 32 + 8 * g); acc = MFMA32(a, qf[qt][kk], acc); }
#pragma unroll
                for (int j = 0; j < 4; ++j) {
                    const float d = fabsf(fbase - (float)(16 * t + j));
                    float s = acc[j] * qk_l2 - slope_l2 * d;
                    if (t == 0 || t == 8) s = (d <= 64.0f) ? s : -1.0e30f;
                    acc[j] = s;
                }
                if (edge) {
#pragma unroll
                    for (int j = 0; j < 4; ++j) { const int kj = p0 - 64 + kw + 16 * t + 4 * g + j; acc[j] = (kj >= 0 && kj < L) ? acc[j] : -1.0e30f; }
                }
#pragma unroll
                for (int j = 0; j < 4; ++j) mx = fmaxf(mx, acc[j]);
                st[t] = acc;
            }
            mx = fmaxf(mx, __shfl_xor(mx, 16)); mx = fmaxf(mx, __shfl_xor(mx, 32));
            float ls = 0.f; bf16x4 pt[9];
#pragma unroll
            for (int t = 0; t < 9; ++t) { f32x4 e;
#pragma unroll
                for (int j = 0; j < 4; ++j) { e[j] = __builtin_amdgcn_exp2f(st[t][j] - mx); ls += e[j]; }
                pt[t] = pk4(e); }
            ls += __shfl_xor(ls, 16); ls += __shfl_xor(ls, 32);
            const float inv = __builtin_amdgcn_rcpf(ls);
            bf16_t* ob = (bf16_t*)(P.ws + WS_OB) + ((size_t)br * NTOK + tokq) * 384 + h * 64;
            const LAS bf16_t* vrd = Vs + (kw + 4 * g + (q >> 2)) * 72 + 4 * (q & 3);
#pragma unroll
            for (int dt = 0; dt < 4; ++dt) {
                f32x4 acc = {0.f, 0.f, 0.f, 0.f};
#pragma unroll
                for (int t = 0; t < 9; ++t) { const bf16x4 a = __builtin_amdgcn_ds_read_tr16_b64_v4i16((LAS bf16x4*)(vrd + 16 * t * 72 + dt * 16)); acc = MFMA16(a, pt[t], acc); }
                acc = acc * inv;
                *(bf16x4*)(ob + dt * 16 + 4 * g) = pk4(acc);
            }
            if (g == 0) ((float*)(P.ws + WS_LSE))[((size_t)br * NTOK + tokq) * 6 + h] = (mx + __log2f(ls)) * 0.69314718f;
        }
        __syncthreads();
    }
}
__device__ __forceinline__ void att_merge(const Params& P) {
    const bf16_t* ob = (const bf16_t*)(P.ws + WS_OB); const float* lse = (const float*)(P.ws + WS_LSE); bf16_t* mixed = (bf16_t*)(P.ws + WS_HBUF);
    for (size_t it = (size_t)blockIdx.x * NTHREADS + opaque_tid(); it < (size_t)NTOK * 48; it += (size_t)gridDim.x * NTHREADS) {
        const size_t tok = it / 48; const int grp = (int)(it % 48), h = grp >> 3;
        const float l0 = lse[tok * 6 + h], l1 = lse[((size_t)NTOK + tok) * 6 + h], l2 = lse[((size_t)2 * NTOK + tok) * 6 + h];
        const float m = fmaxf(l0, fmaxf(l1, l2)), e0 = __expf(l0 - m), e1 = __expf(l1 - m), e2 = __expf(l2 - m), is = __builtin_amdgcn_rcpf(e0 + e1 + e2);
        const float w0 = e0 * is, w1 = e1 * is, w2 = e2 * is;
        const u32x4 a = *(const u32x4*)(ob + tok * 384 + grp * 8), bq = *(const u32x4*)(ob + ((size_t)NTOK + tok) * 384 + grp * 8), cq = *(const u32x4*)(ob + ((size_t)2 * NTOK + tok) * 384 + grp * 8);
        u32x4 o;
#pragma unroll
        for (int i = 0; i < 4; ++i) o[i] = pk2(w0 * bflo(a[i]) + w1 * bflo(bq[i]) + w2 * bflo(cq[i]), w0 * bfhi(a[i]) + w1 * bfhi(bq[i]) + w2 * bfhi(cq[i]));
        *(u32x4*)(mixed + tok * DM + grp * 8) = o;
    }
}

__device__ __forceinline__ float ret_logg(int h) { return log1pf(-exp2f(-5.0f - (float)h)); }
struct RetARegs { u32x4 k0, k1, v0, v1; };
__device__ __forceinline__ void retA_load(const Params& P, int u, int tid, RetARegs& R) {
    const int bh = u >> 5, n = u & 31, b = bh / 6, h = bh % 6, c = tid >> 2, qd = tid & 3;
    const bf16_t* src = (const bf16_t*)(P.ws + WS_PROJ) + (size_t)(b * SEQ + n * 128 + c) * INW + h * 64 + qd * 16;
    R.k0 = *(const u32x4*)(src + C_RK); R.k1 = *(const u32x4*)(src + C_RK + 8); R.v0 = *(const u32x4*)(src + C_RV); R.v1 = *(const u32x4*)(src + C_RV + 8);
}
__device__ __forceinline__ void retA_phase(const Params& P, LAS unsigned char* lds) {
    const int tid = opaque_tid(), lane = tid & 63, wave = __builtin_amdgcn_readfirstlane(tid >> 6), q = lane & 15, g = lane >> 4;
    LAS bf16_t* Kf = (LAS bf16_t*)lds; LAS bf16_t* Kb = (LAS bf16_t*)(lds + 18432); LAS bf16_t* Vs = (LAS bf16_t*)(lds + 36864);
    int u = blockIdx.x; if (u >= 1536) return;
    RetARegs R; retA_load(P, u, tid, R);
    for (; u < 1536; u += gridDim.x) {
        const int bh = u >> 5, n = u & 31, h = bh % 6;
        const float lg = ret_logg(h);
        {
            const int c = tid >> 2, qd = tid & 3;
            const float wf = 0.125f * __expf(lg * (float)(127 - c)), wb = 0.125f * __expf(lg * (float)c);
            u32x4 f0, f1, b0, b1;
#pragma unroll
            for (int e = 0; e < 4; ++e) { f0[e] = pk2(bflo(R.k0[e]) * wf, bfhi(R.k0[e]) * wf); f1[e] = pk2(bflo(R.k1[e]) * wf, bfhi(R.k1[e]) * wf);
                b0[e] = pk2(bflo(R.k0[e]) * wb, bfhi(R.k0[e]) * wb); b1[e] = pk2(bflo(R.k1[e]) * wb, bfhi(R.k1[e]) * wb); }
            *(LAS u32x4*)(Kf + c * 72 + qd * 16) = f0; *(LAS u32x4*)(Kf + c * 72 + qd * 16 + 8) = f1;
            *(LAS u32x4*)(Kb + c * 72 + qd * 16) = b0; *(LAS u32x4*)(Kb + c * 72 + qd * 16 + 8) = b1;
            *(LAS u32x4*)(Vs + c * 72 + qd * 16) = R.v0; *(LAS u32x4*)(Vs + c * 72 + qd * 16 + 8) = R.v1;
        }
        __syncthreads();
        if (u + (int)gridDim.x < 1536) retA_load(P, u + gridDim.x, tid, R);
        const int dir = wave >> 2, dt = wave & 3; const LAS bf16_t* Kt = dir ? Kb : Kf;
        bf16x8 afr[4];
#pragma unroll
        for (int kk = 0; kk < 4; ++kk) afr[kk] = tr8(Kt, 72, kk * 32, dt * 16, g, q);
        bf16_t* dst = (bf16_t*)(P.ws + WS_RST) + ((size_t)(bh * 32 + n) * 2 + dir) * 4096;
#pragma unroll
        for (int et = 0; et < 4; ++et) {
            f32x4 acc = {0.f, 0.f, 0.f, 0.f};
#pragma unroll
            for (int kk = 0; kk < 4; ++kk) { const bf16x8 bfr = tr8(Vs, 72, kk * 32, et * 16, g, q); acc = MFMA32(afr[kk], bfr, acc); }
            *(bf16x4*)(dst + (et * 16 + q) * 64 + dt * 16 + 4 * g) = pk4(acc);
        }
        __syncthreads();
    }
}
__device__ __forceinline__ void ret_scan(const Params& P) {
    bf16_t* st = (bf16_t*)(P.ws + WS_RST);
    for (int it = blockIdx.x * NTHREADS + opaque_tid(); it < 48 * 2 * 512; it += gridDim.x * NTHREADS) {
        const int ch = it & 511, dir = (it >> 9) & 1, bh = it >> 10, h = bh % 6;
        const float cd = __expf(ret_logg(h) * 128.0f);
        float s[8];
#pragma unroll
        for (int e = 0; e < 8; ++e) s[e] = 0.f;
        for (int i0 = 0; i0 < 32; i0 += 8) {
            u32x4 v[8];
#pragma unroll
            for (int i = 0; i < 8; ++i) { const int n = dir ? 31 - (i0 + i) : (i0 + i); v[i] = *(const u32x4*)(st + ((size_t)(bh * 32 + n) * 2 + dir) * 4096 + 8 * ch); }
#pragma unroll
            for (int i = 0; i < 8; ++i) { const int n = dir ? 31 - (i0 + i) : (i0 + i);
                u32x4 o;
#pragma unroll
                for (int e = 0; e < 4; ++e) o[e] = pk2(s[2 * e], s[2 * e + 1]);
                *(u32x4*)(st + ((size_t)(bh * 32 + n) * 2 + dir) * 4096 + 8 * ch) = o;
#pragma unroll
                for (int e = 0; e < 4; ++e) { s[2 * e] = cd * s[2 * e] + bflo(v[i][e]); s[2 * e + 1] = cd * s[2 * e + 1] + bfhi(v[i][e]); } }
        }
    }
}
struct RetBRegs { u32x4 k0, k1, v0, v1, rf, rb, q0, q1; };
__device__ __forceinline__ void retB_load(const Params& P, int u, int tid, RetBRegs& R) {
    const int bh = u >> 5, n = u & 31, b = bh / 6, h = bh % 6, c = tid >> 2, qd = tid & 3;
    const bf16_t* proj = (const bf16_t*)(P.ws + WS_PROJ);
    const bf16_t* src = proj + (size_t)(b * SEQ + n * 128 + c) * INW + h * 64 + qd * 16;
    R.k0 = *(const u32x4*)(src + C_RK); R.k1 = *(const u32x4*)(src + C_RK + 8); R.v0 = *(const u32x4*)(src + C_RV); R.v1 = *(const u32x4*)(src + C_RV + 8);
    const bf16_t* rs = (const bf16_t*)(P.ws + WS_RST) + (size_t)(bh * 32 + n) * 2 * 4096;
    const int e = tid >> 3, d8 = (tid & 7) * 8;
    R.rf = *(const u32x4*)(rs + e * 64 + d8); R.rb = *(const u32x4*)(rs + 4096 + e * 64 + d8);
    const int lane = tid & 63, wave = tid >> 6, q = lane & 15, g = lane >> 4;
    const bf16_t* qp = proj + (size_t)(b * SEQ + n * 128 + 16 * wave + q) * INW + C_RQ + h * 64 + 8 * g;
    R.q0 = *(const u32x4*)qp; R.q1 = *(const u32x4*)(qp + 32);
}
__device__ __forceinline__ void retB_phase(const Params& P, LAS unsigned char* lds, int layer) {
    const int tid = opaque_tid(), lane = tid & 63, wave = __builtin_amdgcn_readfirstlane(tid >> 6), q = lane & 15, g = lane >> 4;
    const bf16_t* proj = (const bf16_t*)(P.ws + WS_PROJ);
    LAS bf16_t* Ks = (LAS bf16_t*)lds;
    LAS bf16_t* Vs = (LAS bf16_t*)(lds + 18432);
    LAS bf16_t* Rf = (LAS bf16_t*)(lds + 36864);
    LAS bf16_t* Rb = (LAS bf16_t*)(lds + 46080);
    int u = blockIdx.x; if (u >= 1536) return;
    RetBRegs R; retB_load(P, u, tid, R);
    for (; u < 1536; u += gridDim.x) {
        const int bh = u >> 5, n = u & 31, b = bh / 6, h = bh % 6;
        const float lg = ret_logg(h);
        {
            const int c = tid >> 2, qd = tid & 3, e = tid >> 3, d8 = (tid & 7) * 8;
            *(LAS u32x4*)(Ks + c * 72 + qd * 16) = R.k0; *(LAS u32x4*)(Ks + c * 72 + qd * 16 + 8) = R.k1;
            *(LAS u32x4*)(Vs + c * 72 + qd * 16) = R.v0; *(LAS u32x4*)(Vs + c * 72 + qd * 16 + 8) = R.v1;
            *(LAS u32x4*)(Rf + e * 72 + d8) = R.rf; *(LAS u32x4*)(Rb + e * 72 + d8) = R.rb;
        }
        const u32x4 qraw[2] = {R.q0, R.q1};
        __syncthreads();
        if (u + (int)gridDim.x < 1536) retB_load(P, u + gridDim.x, tid, R);
        const int i = 16 * wave + q; const size_t tok = (size_t)(b * SEQ + n * 128 + i);
        u32x2 rgv[4]; f32x4 gnv[4];
#pragma unroll
        for (int et = 0; et < 4; ++et) { rgv[et] = *(const u32x2*)(proj + tok * INW + C_RG + h * 64 + et * 16 + 4 * g); gnv[et] = *(const f32x4*)(P.ret_gn + layer * 384 + h * 64 + et * 16 + 4 * g); }
        bf16x8 qf[2], qff[2], qfb[2];
        {
            const float ff = __expf(lg * (float)(i + 1)), fb = __expf(lg * (float)(128 - i));
#pragma unroll
            for (int kk = 0; kk < 2; ++kk) { const u32x4 raw = qraw[kk];
                qf[kk] = __builtin_bit_cast(bf16x8, raw); u32x4 a, c2;
#pragma unroll
                for (int e = 0; e < 4; ++e) { const float lo = bflo(raw[e]), hi = bfhi(raw[e]); a[e] = pk2(lo * ff, hi * ff); c2[e] = pk2(lo * fb, hi * fb); }
                qff[kk] = __builtin_bit_cast(bf16x8, a); qfb[kk] = __builtin_bit_cast(bf16x8, c2); }
        }
        bf16x4 pt[8];
#pragma unroll
        for (int jt = 0; jt < 8; ++jt) {
            f32x4 acc = {0.f, 0.f, 0.f, 0.f};
#pragma unroll
            for (int kk = 0; kk < 2; ++kk) { const bf16x8 a = *(const LAS bf16x8*)(Ks + (16 * jt + q) * 72 + kk * 32 + 8 * g); acc = MFMA32(a, qf[kk], acc); }
#pragma unroll
            for (int jj = 0; jj < 4; ++jj) { int dd = i - (16 * jt + 4 * g + jj); dd = dd < 0 ? -dd : dd; acc[jj] = acc[jj] * 0.125f * __expf(lg * (float)dd); }
            pt[jt] = pk4(acc);
        }
        f32x4 o[4];
#pragma unroll
        for (int et = 0; et < 4; ++et) {
            f32x4 acc = {0.f, 0.f, 0.f, 0.f};
#pragma unroll
            for (int jt = 0; jt < 8; ++jt) { const bf16x4 a = tr4(Vs, 72, 16 * jt, et * 16, g, q); acc = MFMA16(a, pt[jt], acc); }
#pragma unroll
            for (int kk = 0; kk < 2; ++kk) { const bf16x8 a = *(const LAS bf16x8*)(Rf + (et * 16 + q) * 72 + kk * 32 + 8 * g); acc = MFMA32(a, qff[kk], acc);
                const bf16x8 a2 = *(const LAS bf16x8*)(Rb + (et * 16 + q) * 72 + kk * 32 + 8 * g); acc = MFMA32(a2, qfb[kk], acc); }
            o[et] = acc;
        }
        float s = 0.f;
#pragma unroll
        for (int et = 0; et < 4; ++et) s += (o[et][0] + o[et][1]) + (o[et][2] + o[et][3]);
        s += __shfl_xor(s, 16); s += __shfl_xor(s, 32);
        const float mu = s * (1.0f / 64.0f); float vs = 0.f;
#pragma unroll
        for (int et = 0; et < 4; ++et) { o[et] = o[et] - mu; vs += (o[et][0] * o[et][0] + o[et][1] * o[et][1]) + (o[et][2] * o[et][2] + o[et][3] * o[et][3]); }
        vs += __shfl_xor(vs, 16); vs += __shfl_xor(vs, 32);
        const float rstd = rsqrtf(vs * (1.0f / 64.0f) + NORM_EPS);
        bf16_t* mixed = (bf16_t*)(P.ws + WS_HBUF) + tok * DM + 384 + h * 64;
#pragma unroll
        for (int et = 0; et < 4; ++et) {
            const f32x4 gn = gnv[et]; const u32x2 rg = rgv[et];
            f32x4 y; y[0] = o[et][0] * rstd * gn[0] * siluf(bflo(rg.x)); y[1] = o[et][1] * rstd * gn[1] * siluf(bfhi(rg.x));
            y[2] = o[et][2] * rstd * gn[2] * siluf(bflo(rg.y)); y[3] = o[et][3] * rstd * gn[3] * siluf(bfhi(rg.y));
            *(bf16x4*)(mixed + et * 16 + 4 * g) = pk4(y);
        }
        __syncthreads();
    }
}
__device__ __forceinline__ void hgrn_gate(float z, float lbv, float& f, float& kk) {
    z = fminf(fmaxf(z, -30.f), 30.f);
    const float ez = __expf(-z), sg = __builtin_amdgcn_rcpf(1.0f + ez);
    f = lbv + (1.0f - lbv) * sg; kk = (1.0f - lbv) * ez * sg;
}
__device__ __forceinline__ void hgA_unit(const Params& P, LAS unsigned char* lds, int u, int layer) {
    const int tid = opaque_tid(), lane = tid & 63, wave = __builtin_amdgcn_readfirstlane(tid >> 6), q = lane & 15, g = lane >> 4;
    const int bh = u >> 5, n = u & 31, b = bh >> 2, h = bh & 3;
    const bf16_t* proj = (const bf16_t*)(P.ws + WS_PROJ);
    LAS bf16_t* Kr = (LAS bf16_t*)lds;
    LAS bf16_t* Vs = (LAS bf16_t*)(lds + 36864);
    LAS float* segs = (LAS float*)(lds + 55296);
    const size_t tokc = (size_t)(b * SEQ + n * 128);
    {
        const int c = tid >> 2, qd = tid & 3; const bf16_t* src = proj + (tokc + c) * INW + C_HI + h * 64 + qd * 16;
        const u32x4 v0 = *(const u32x4*)src, v1 = *(const u32x4*)(src + 8);
        *(LAS u32x4*)(Vs + c * 72 + qd * 16) = v0; *(LAS u32x4*)(Vs + c * 72 + qd * 16 + 8) = v1;
    }
    const int d = tid & 63, dir = (tid >> 6) & 1, seg = tid >> 7;
    const float lbv = ((const float*)(P.ws + WS_LB))[layer * 256 + h * 64 + d];
    float lf[32], kk[32];
    {
        const bf16_t* zp = proj + (tokc + seg * 32) * INW + (dir ? C_HZB : C_HZF) + h * 64 + d;
        bf16_t zr[32];
#pragma unroll
        for (int i = 0; i < 32; ++i) zr[i] = zp[(size_t)i * INW];
#pragma unroll
        for (int i = 0; i < 32; ++i) hgrn_gate(bf2f(zr[i]), lbv, lf[i], kk[i]);
    }
    float ssum = 1.f;
#pragma unroll
    for (int i = 0; i < 32; ++i) ssum *= lf[i];
    segs[(dir * 4 + seg) * 64 + d] = ssum;
    __syncthreads();
    {
        float before = 1.f, after = 1.f;
#pragma unroll
        for (int s2 = 0; s2 < 4; ++s2) { const float v = segs[(dir * 4 + s2) * 64 + d]; if (s2 < seg) before *= v; if (s2 > seg) after *= v; }
        LAS bf16_t* kt = Kr + dir * (128 * 72) + (seg * 32) * 72 + d;
        if (dir == 0) {
            float run = after;
#pragma unroll
            for (int i = 31; i >= 0; --i) { kt[i * 72] = f2bf(kk[i] * run); run *= lf[i]; }
        } else {
            float run = before;
#pragma unroll
            for (int i = 0; i < 32; ++i) { kt[i * 72] = f2bf(kk[i] * run); run *= lf[i]; }
        }
        if (seg == 0) ((float*)(P.ws + WS_HGA))[((size_t)(bh * 2 + dir) * 32 + n) * 64 + d] = ssum * after;
    }
    __syncthreads();
    {
        const int wdir = wave >> 2, dt = wave & 3; const LAS bf16_t* krs = Kr + wdir * (128 * 72);
        bf16x8 afr[4];
#pragma unroll
        for (int kq = 0; kq < 4; ++kq) afr[kq] = tr8(krs, 72, kq * 32, dt * 16, g, q);
        float* dst = (float*)(P.ws + WS_HGU) + ((size_t)(bh * 2 + wdir) * 32 + n) * 4096;
#pragma unroll
        for (int et = 0; et < 4; ++et) {
            f32x4 acc = {0.f, 0.f, 0.f, 0.f};
#pragma unroll
            for (int kq = 0; kq < 4; ++kq) { const bf16x8 bfr = tr8(Vs, 72, kq * 32, et * 16, g, q); acc = MFMA32(afr[kq], bfr, acc); }
#pragma unroll
            for (int j = 0; j < 4; ++j) dst[(dt * 16 + 4 * g + j) * 64 + et * 16 + q] = acc[j];
        }
    }
    __syncthreads();
}
__device__ __forceinline__ void hg_scan(const Params& P) {
    float* U = (float*)(P.ws + WS_HGU); const float* A = (const float*)(P.ws + WS_HGA);
    const int nthr = gridDim.x * NTHREADS; int it0 = blockIdx.x * NTHREADS + opaque_tid() - 48 * 2 * 512; if (it0 < 0) it0 += nthr;
    for (int it = it0; it < 64 * 64 * 16; it += nthr) {
        const int e4 = it & 15, d = (it >> 4) & 63, bd = it >> 10, dir = bd & 1;
        f32x4 s = {0.f, 0.f, 0.f, 0.f};
        for (int i0 = 0; i0 < 32; i0 += 8) {
            f32x4 v[8]; float a[8];
#pragma unroll
            for (int i = 0; i < 8; ++i) { const int n = dir ? 31 - (i0 + i) : (i0 + i); v[i] = *(const f32x4*)(U + ((size_t)(bd * 32 + n) * 64 + d) * 64 + 4 * e4); a[i] = A[(size_t)(bd * 32 + n) * 64 + d]; }
#pragma unroll
            for (int i = 0; i < 8; ++i) { const int n = dir ? 31 - (i0 + i) : (i0 + i); *(f32x4*)(U + ((size_t)(bd * 32 + n) * 64 + d) * 64 + 4 * e4) = s; s = s * a[i] + v[i]; }
        }
    }
}
__device__ __forceinline__ unsigned pk2h(float lo, float hi) { return pk2(lo, hi); }
__device__ __forceinline__ bf16x4 pk4h(f32x4 v) { return pk4(v); }
__device__ __forceinline__ void hgB_unit(const Params& P, LAS unsigned char* lds, int u, int layer) {
    const int tid = opaque_tid(), lane = tid & 63, wave = __builtin_amdgcn_readfirstlane(tid >> 6), q = lane & 15, g = lane >> 4;
    const int b = u >> 5, n = u & 31, h = wave >> 1, dir = wave & 1, bh = b * 4 + h;
    bf16_t* proj = (bf16_t*)(P.ws + WS_PROJ);
    bf16_t* mixed = (bf16_t*)(P.ws + WS_HBUF);
    LAS unsigned char* wl = lds + wave * 7168;
    LAS bf16_t* Qi = (LAS bf16_t*)wl;
    LAS bf16_t* Ki = (LAS bf16_t*)(wl + 2304);
    LAS bf16_t* Vs = (LAS bf16_t*)(wl + 4608);
    LAS float* Al = (LAS float*)(wl + 6912);
    const size_t tokc = (size_t)(b * SEQ + n * 128);
    const float lbv = ((const float*)(P.ws + WS_LB))[layer * 256 + h * 64 + lane];
    f32x4 S[4][4];
    {
        const float* sp = (const float*)(P.ws + WS_HGU) + ((size_t)(bh * 2 + dir) * 32 + n) * 4096;
#pragma unroll
        for (int dt = 0; dt < 4; ++dt)
#pragma unroll
            for (int et = 0; et < 4; ++et)
#pragma unroll
                for (int j = 0; j < 4; ++j) S[dt][et][j] = sp[(dt * 16 + 4 * g + j) * 64 + et * 16 + q];
    }
    bf16_t* odst = dir ? (proj + C_AQ + h * 64) : (mixed + 768 + h * 64); const size_t opitch = dir ? INW : DM;
    bf16_t qr[16], zz[16]; u32x4 v0, v1;
#define HGB_LOAD(SC) do { const size_t toks_ = tokc + (SC) * 16; const bf16_t* base_ = proj + toks_ * INW + h * 64 + lane; \
        _Pragma("unroll") for (int ii = 0; ii < 16; ++ii) { const int t_ = dir ? 15 - ii : ii; qr[ii] = base_[(size_t)t_ * INW + C_HQ]; zz[ii] = base_[(size_t)t_ * INW + (dir ? C_HZB : C_HZF)]; } \
        const bf16_t* vsrc_ = proj + (toks_ + (lane >> 2)) * INW + C_HI + h * 64 + (lane & 3) * 16; v0 = *(const u32x4*)vsrc_; v1 = *(const u32x4*)(vsrc_ + 8); } while (0)
    HGB_LOAD(dir ? 7 : 0);
    for (int i = 0; i < 8; ++i) {
        const int sc = dir ? 7 - i : i; const size_t toks = tokc + sc * 16;
        {
            *(LAS u32x4*)(Vs + (lane >> 2) * 72 + (lane & 3) * 16) = v0; *(LAS u32x4*)(Vs + (lane >> 2) * 72 + (lane & 3) * 16 + 8) = v1;
            float bp = 1.f;
#pragma unroll
            for (int ii = 0; ii < 16; ++ii) {
                const int t = dir ? 15 - ii : ii;
                float f, kk; hgrn_gate(bf2f(zz[ii]), lbv, f, kk); const float qv = siluf(bf2f(qr[ii]));
                bp *= f;
                Qi[t * 72 + lane] = f2bf(qv * bp); Ki[t * 72 + lane] = f2bf(kk * __builtin_amdgcn_rcpf(fmaxf(bp, 1.0e-30f)));
            }
            Al[lane] = bp;
        }
        if (i + 1 < 8) HGB_LOAD(dir ? 6 - i : i + 1);
        __builtin_amdgcn_fence(__ATOMIC_RELEASE, "wavefront"); __builtin_amdgcn_wave_barrier(); __builtin_amdgcn_fence(__ATOMIC_ACQUIRE, "wavefront");
        f32x4 at = {0.f, 0.f, 0.f, 0.f};
#pragma unroll
        for (int kq = 0; kq < 2; ++kq) { const bf16x8 a8 = *(const LAS bf16x8*)(Ki + q * 72 + kq * 32 + 8 * g), b8 = *(const LAS bf16x8*)(Qi + q * 72 + kq * 32 + 8 * g); at = MFMA32(a8, b8, at); }
#pragma unroll
        for (int j = 0; j < 4; ++j) { const int sl = 4 * g + j; const bool keep = dir ? (sl >= q) : (sl <= q); at[j] = keep ? at[j] : 0.f; }
        const bf16x4 p4 = pk4h(at);
        bf16x4 b4[4], v4[4];
#pragma unroll
        for (int dt = 0; dt < 4; ++dt) b4[dt] = *(const LAS bf16x4*)(Qi + q * 72 + dt * 16 + 4 * g);
#pragma unroll
        for (int et = 0; et < 4; ++et) v4[et] = tr4(Vs, 72, 0, et * 16, g, q);
#pragma unroll
        for (int et = 0; et < 4; ++et) {
            f32x4 o = {0.f, 0.f, 0.f, 0.f};
#pragma unroll
            for (int dt = 0; dt < 4; ++dt) o = MFMA16(pk4h(S[dt][et]), b4[dt], o);
            o = MFMA16(v4[et], p4, o);
            *(bf16x4*)(odst + (toks + q) * opitch + et * 16 + 4 * g) = pk4(o);
        }
#pragma unroll
        for (int dt = 0; dt < 4; ++dt) {
            const bf16x4 kT4 = tr4(Ki, 72, 0, dt * 16, g, q);
            const f32x4 al4 = *(const LAS f32x4*)(Al + dt * 16 + 4 * g);
#pragma unroll
            for (int et = 0; et < 4; ++et) { const f32x4 s2 = MFMA16(kT4, v4[et], S[dt][et]); S[dt][et] = s2 * al4; }
        }
        __builtin_amdgcn_fence(__ATOMIC_RELEASE, "wavefront"); __builtin_amdgcn_wave_barrier(); __builtin_amdgcn_fence(__ATOMIC_ACQUIRE, "wavefront");
    }
    asm volatile("s_waitcnt vmcnt(0)" ::: "memory");
    __syncthreads();
    {
        const int tau = tid >> 2, qd = tid & 3;
        bf16_t* mp = mixed + (tokc + tau) * DM + 768 + qd * 64; const bf16_t* bp2 = proj + (tokc + tau) * INW + C_AQ + qd * 64;
        const bf16_t* gp = proj + (tokc + tau) * INW + C_HG + qd * 64; const float* gn = P.hgrn_gn + layer * 256 + qd * 64;
        float o[64]; float sq = 0.f;
#pragma unroll
        for (int c4 = 0; c4 < 16; ++c4) {
            const unsigned long long fv = __hip_atomic_load((const unsigned long long*)(mp + c4 * 4), __ATOMIC_RELAXED, __HIP_MEMORY_SCOPE_AGENT), bv = __hip_atomic_load((const unsigned long long*)(bp2 + c4 * 4), __ATOMIC_RELAXED, __HIP_MEMORY_SCOPE_AGENT);
            const unsigned f0 = (unsigned)fv, f1 = (unsigned)(fv >> 32), b0 = (unsigned)bv, b1 = (unsigned)(bv >> 32);
            const float x0 = bflo(f0) + bflo(b0), x1 = bfhi(f0) + bfhi(b0), x2 = bflo(f1) + bflo(b1), x3 = bfhi(f1) + bfhi(b1);
            o[c4 * 4 + 0] = x0; o[c4 * 4 + 1] = x1; o[c4 * 4 + 2] = x2; o[c4 * 4 + 3] = x3; sq += (x0 * x0 + x1 * x1) + (x2 * x2 + x3 * x3); }
        sq += __shfl_xor(sq, 1); sq += __shfl_xor(sq, 2);
        const float rstd = rsqrtf(sq * (1.0f / 256.0f) + NORM_EPS);
#pragma unroll
        for (int c8 = 0; c8 < 8; ++c8) {
            const u32x4 gv = *(const u32x4*)(gp + c8 * 8); const f32x4 g0 = *(const f32x4*)(gn + c8 * 8), g1 = *(const f32x4*)(gn + c8 * 8 + 4);
            u32x4 r;
            r.x = pk2h(o[c8 * 8 + 0] * rstd * g0[0] * siluf(bflo(gv.x)), o[c8 * 8 + 1] * rstd * g0[1] * siluf(bfhi(gv.x)));
            r.y = pk2h(o[c8 * 8 + 2] * rstd * g0[2] * siluf(bflo(gv.y)), o[c8 * 8 + 3] * rstd * g0[3] * siluf(bfhi(gv.y)));
            r.z = pk2h(o[c8 * 8 + 4] * rstd * g1[0] * siluf(bflo(gv.z)), o[c8 * 8 + 5] * rstd * g1[1] * siluf(bfhi(gv.z)));
            r.w = pk2h(o[c8 * 8 + 6] * rstd * g1[2] * siluf(bflo(gv.w)), o[c8 * 8 + 7] * rstd * g1[3] * siluf(bfhi(gv.w)));
            *(u32x4*)(mp + c8 * 8) = r;
        }
    }
    __syncthreads();
}
constexpr int N_PHASES = 20;
#ifndef PROBE_MASK
#define PROBE_MASK 0u
#endif
#ifndef PROBE_U
#define PROBE_U 0
#endif
#ifndef STAGGER
#define STAGGER 0
#endif
#ifndef STAGGER_TICKS
#define STAGGER_TICKS 1000u
#endif
#ifndef GEMM_SP2
#define GEMM_SP2 true
#endif
#ifndef GEMM_ALIGN
#define GEMM_ALIGN true
#endif
#ifndef PROBE_SYNC2
#define PROBE_SYNC2 0
#endif
__device__ __forceinline__ void stagger_half(unsigned ticks) {
#if STAGGER
    if ((blockIdx.x >> 3) & 1) { const unsigned long long t0 = __builtin_amdgcn_s_memrealtime(); while (__builtin_amdgcn_s_memrealtime() - t0 < ticks) __builtin_amdgcn_s_sleep(32); }
    __syncthreads();
#endif
}
__device__ __forceinline__ void run_phase(const Params& P, LAS unsigned char* lds, int ph) {
    unsigned char* ws = P.ws;
    if (ph == 0) { phase_prologue(P, lds); return; }
    if (ph == N_PHASES - 1) { const float* ml = (const float*)(ws + WS_MOD) + (size_t)(DEPTH - 1) * NBATCH * NMOD * DM;
        phase_norm<2, false, true>(P.out, (const bf16_t*)(ws + WS_OB), ml + 2 * DM, (const bf16_t*)(ws + WS_HBUF), ml + 5 * DM, P.out, P.g_final, nullptr, nullptr, nullptr); return; }
    const int l = (ph - 1) / 9, s = (ph - 1) % 9;
    const float* mod = (const float*)(ws + WS_MOD) + (size_t)l * NBATCH * NMOD * DM; const float* modp = mod - (size_t)NBATCH * NMOD * DM;
    const float* xprev = (l == 1) ? P.x : P.out;
    bf16_t* hbuf = (bf16_t*)(ws + WS_HBUF); bf16_t* proj = (bf16_t*)(ws + WS_PROJ); bf16_t* ybuf = (bf16_t*)(ws + WS_OB);
#ifdef PH_ONLY
    if (s != PH_ONLY) return;
#endif
    int kD = DM, kF = FFN; asm volatile("" : "+s"(kD), "+s"(kF));
    switch (s) {
    case 0: if (l == 0) { phase_norm<0, false, false>(P.x, nullptr, nullptr, nullptr, nullptr, nullptr, P.g_mix, mod + 0 * DM, mod + 1 * DM, hbuf); phase_weights(P, lds); }
            else phase_norm<2, true, false>(xprev, ybuf, modp + 2 * DM, hbuf, modp + 5 * DM, P.out, P.g_mix + l * DM, mod + 0 * DM, mod + 1 * DM, hbuf);
            break;
    case 1: { pg8::Gemm g{hbuf, (const bf16_t*)(ws + WS_WIN) + (size_t)l * INWP * DM, NTOK, INWP, kD}; pg8::StaticOrder S; S.init(NTOK, INWP, gridDim.x, blockIdx.x);
              EpiProj E{proj, INW, INW}; pg8::gemm_phase<EpiProj, pg8::StaticOrder, GEMM_ALIGN, GEMM_SP2>(lds, g, S, E); } break;
    case 2: { for (int rp = 0; rp < (PROBE_U == 1 ? 2 : 1); ++rp) att_phase(P, lds);
              for (int rp = 0; rp < (PROBE_U == 2 ? 2 : 1); ++rp) retA_phase(P, lds);
              for (int rp = 0; rp < (PROBE_U == 3 ? 2 : 1); ++rp) for (int u = blockIdx.x; u < 1024; u += gridDim.x) hgA_unit(P, lds, u, l); } break;
    case 3: { ret_scan(P); hg_scan(P); } break;
    case 4: { for (int rp = 0; rp < (PROBE_U == 4 ? 2 : 1); ++rp) for (int u = blockIdx.x; u < 256; u += gridDim.x) hgB_unit(P, lds, u, l);
              for (int rp = 0; rp < (PROBE_U == 5 ? 2 : 1); ++rp) retB_phase(P, lds, l); att_merge(P); } break;
    case 5: { pg8::Gemm g{hbuf, (const bf16_t*)(ws + WS_WOUT) + (size_t)l * DM * DM, NTOK, DM, kD}; pg8::StaticOrder S; S.init(NTOK, DM, gridDim.x, blockIdx.x);
              EpiProj E{ybuf, DM, DM}; pg8::gemm_phase<EpiProj, pg8::StaticOrder, GEMM_ALIGN, GEMM_SP2>(lds, g, S, E); } break;
    case 6: phase_norm<1, false, false>(l == 0 ? P.x : P.out, ybuf, mod + 2 * DM, nullptr, nullptr, nullptr, P.g_ffn + l * DM, mod + 3 * DM, mod + 4 * DM, hbuf); break;
    case 7: { pg8::Gemm g{hbuf, (const bf16_t*)(ws + WS_WGU) + (size_t)l * 2 * FFN * DM, NTOK, 2 * FFN, kD}; pg8::StaticOrder S; S.init(NTOK, 2 * FFN, gridDim.x, blockIdx.x);
              EpiSwiglu E{proj}; pg8::gemm_phase<EpiSwiglu, pg8::StaticOrder, GEMM_ALIGN, GEMM_SP2>(lds, g, S, E); } break;
    case 8: { pg8::Gemm g{proj, (const bf16_t*)(ws + WS_WDN) + (size_t)l * DM * FFN, NTOK, DM, kF}; pg8::StaticOrder S; S.init(NTOK, DM, gridDim.x, blockIdx.x);
              EpiProj E{hbuf, DM, DM}; pg8::gemm_phase<EpiProj, pg8::StaticOrder, GEMM_ALIGN, GEMM_SP2>(lds, g, S, E); } break;
    }
}
__global__ void __launch_bounds__(NTHREADS) hybrid_fwd(Params P) {
    extern __shared__ __attribute__((aligned(16))) unsigned char lds_raw[];
    __shared__ uint4 xb_words;
    LAS unsigned char* lds = (LAS unsigned char*)lds_raw;
    if (threadIdx.x == 0) xb_words = make_uint4(0u, 0u, 0u, 0u);
    __syncthreads();
    XcdBarrier bar = xcd_barrier_post((unsigned*)(P.ws + WS_CTL), (volatile LAS unsigned*)&xb_words);
    for (int ph = P.ph_lo; ph < P.ph_hi; ++ph) {
        const int reps = ((PROBE_MASK >> ph) & 1u) ? 2 : 1;
        for (int rep = 0; rep < reps; ++rep) { run_phase(P, lds, ph); if (rep + 1 < reps) __syncthreads(); }
        if (ph + 1 < P.ph_hi) {
            if (P.ph_hi > N_PHASES) cg::this_grid().sync(); else xcd_barrier(bar);
            if (PROBE_SYNC2) xcd_barrier(bar);
        }
    }
}

extern "C" void kernel_launch(void* const* d_in, const int* in_sizes, int n_in, void* d_out, int out_size, void* d_ws, size_t ws_size, hipStream_t stream) {
    static int grid = 0;
    if (grid == 0) {
        if (n_in != 14 || out_size != NTOK * DM || ws_size < WS_END) { fprintf(stderr, "kernel_launch: unexpected shapes (n_in %d out %d ws %zu need %zu)\n", n_in, out_size, ws_size, (size_t)WS_END); grid = -1; return; }
        int dev = 0, cus = 0, per_cu = 0;
        hipGetDevice(&dev); hipDeviceGetAttribute(&cus, hipDeviceAttributeMultiprocessorCount, dev);
        if (hipFuncSetAttribute((const void*)hybrid_fwd, hipFuncAttributeMaxDynamicSharedMemorySize, LDS_BYTES) != hipSuccess) { fprintf(stderr, "kernel_launch: hipFuncSetAttribute failed\n"); grid = -1; return; }
        if (hipOccupancyMaxActiveBlocksPerMultiprocessor(&per_cu, (const void*)hybrid_fwd, NTHREADS, LDS_BYTES) != hipSuccess || per_cu < 1) { fprintf(stderr, "kernel_launch: occupancy query says %d\n", per_cu); grid = -1; return; }
        grid = cus;
    }
    if (grid < 0) return;
    if (hipMemsetAsync((char*)d_ws + WS_CTL, 0, 16384, stream) != hipSuccess) { fprintf(stderr, "kernel_launch: memset failed\n"); return; }
    Params p{};
    p.x = (const float*)d_in[0]; p.c = (const float*)d_in[1]; p.w_ada = (const float*)d_in[2]; p.b_ada = (const float*)d_in[3]; p.g_mix = (const float*)d_in[4];
    p.w_in = (const float*)d_in[5]; p.ret_gn = (const float*)d_in[6]; p.hgrn_gn = (const float*)d_in[7]; p.lb_logits = (const float*)d_in[8]; p.w_out = (const float*)d_in[9];
    p.g_ffn = (const float*)d_in[10]; p.w_gu = (const float*)d_in[11]; p.w_down = (const float*)d_in[12]; p.g_final = (const float*)d_in[13];
    p.out = (float*)d_out; p.ws = (unsigned char*)d_ws;
#if ONE_LAUNCH
    p.ph_lo = 0; p.ph_hi = N_PHASES;
    void* args[] = {&p};
    hipError_t e = hipLaunchCooperativeKernel((const void*)hybrid_fwd, dim3(grid), dim3(NTHREADS), args, LDS_BYTES, stream);
    if (e != hipSuccess) fprintf(stderr, "cooperative launch failed: %s (grid %d)\n", hipGetErrorString(e), grid);
#else
    for (int ph = 0; ph < N_PHASES; ++ph) { p.ph_lo = ph; p.ph_hi = ph + 1; hipLaunchKernelGGL(hybrid_fwd, dim3(grid), dim3(NTHREADS), LDS_BYTES, stream, p); }
#endif
}
```

```cpp
#include <hip/hip_runtime.h>
#include <hip/hip_cooperative_groups.h>
#include <cstdio>
#include <cstdint>
namespace cg = cooperative_groups;
#ifndef ONE_LAUNCH
#define ONE_LAUNCH 1
#endif
__device__ __forceinline__ int opaque_tid() { int t = threadIdx.x; asm volatile("" : "+v"(t)); return t; }
#define LAS __attribute__((address_space(3)))
namespace pg8 {
#define PG8_LAS __attribute__((address_space(3)))
typedef unsigned short bf16_t;
typedef short bf16x8 __attribute__((ext_vector_type(8)));
typedef float f32x4 __attribute__((ext_vector_type(4)));
typedef unsigned u32x4 __attribute__((ext_vector_type(4)));
constexpr int BM = 256, BK = 64, HALF = 128, HTB = HALF * BK * 2  , STAGE_BYTES = 8 * HTB, NXCD = 8, WGM = 8;

__host__ __device__ __forceinline__ int lds_byte(int r, int c) { const int st = (r >> 4) * 2 + (c >> 5), rr = r & 15, cc = c & 31, ob = rr * 64 + cc * 2; return st * 1024 + (ob ^ (((ob >> 9) & 1) << 5)); }
__host__ __device__ __forceinline__ void stage_rc(int b, int& R, int& C) { const int st = b / 1024, sb = b % 1024, swz = sb ^ (((sb >> 9) & 1) << 5); R = (st >> 1) * 16 + swz / 64; C = (st & 1) * 32 + (swz % 64) / 2; }
__host__ __device__ __forceinline__ int perm32(int rho) { const int n = rho >> 4, i = rho & 15; return 8 * (i >> 2) + 4 * n + (i & 3); }

struct Unit { int pm, pn; };
struct Gemm { const bf16_t* A; const bf16_t* Bt; int M, N, K; };

struct StaticOrder {
    int nM, nN, nwg, G, c;
    __host__ __device__ void init(int M, int N, int G_, int c_) { nM = M / BM; nN = N / BM; nwg = nM * nN; G = G_; c = c_; }
    __host__ __device__ bool next(int i, Unit& u) const {
        const long L = (long)i * G + c; if (L >= nwg) return false;
        int wgid = (int)L; { const int q = nwg / NXCD, r = nwg % NXCD, xcd = wgid % NXCD, off = wgid / NXCD; wgid = (xcd < r ? xcd * (q + 1) : r * (q + 1) + (xcd - r) * q) + off; }
        const int nig = WGM * nN, gid = wgid / nig, fm = gid * WGM, gsz = (nM - fm) < WGM ? (nM - fm) : WGM;
        u.pm = fm + ((wgid % nig) % gsz); u.pn = (wgid % nig) / gsz; return true;
    }
    __device__ __forceinline__ void a_ready(const Unit&) const {}
    __device__ __forceinline__ void done(const Unit&) const {}
};
__device__ __forceinline__ unsigned cvt_pk_bf16(float lo, float hi) { unsigned r; asm volatile("v_cvt_pk_bf16_f32 %0, %1, %2" : "=v"(r) : "v"(lo), "v"(hi)); return r; }
typedef float f32x2 __attribute__((ext_vector_type(2)));
template <class Epi, class Sched, bool ALIGN_EPI = false, bool SP2 = false>
__device__ __forceinline__ void gemm_phase(PG8_LAS unsigned char* lds, const Gemm g, const Sched& S, const Epi& E) {
    const int tid = opaque_tid(), wid = __builtin_amdgcn_readfirstlane(tid >> 6), lane = tid & 63, wr = wid >> 2, wc = wid & 3, fr = lane & 15, fq = lane >> 4;
    const int K = g.K, nt = K / BK;
    unsigned voffA[2], voffB[2];
#pragma unroll
    for (int i = 0; i < 2; ++i) { int R, C; stage_rc(tid * 16 + i * 8192, R, C); const int Rb = Epi::PERM ? ((R & ~31) + perm32(R & 31)) : R;
        voffA[i] = (unsigned)(R * K + C) * 2u; voffB[i] = (unsigned)(Rb * K + C) * 2u; }
    const size_t kstep = (size_t)(BK * 2);
    const size_t hstep = (size_t)HALF * K * 2;
    const size_t tstep = 2 * hstep;
    const unsigned ldsw = (unsigned)wid * 1024u;
    const int aoff = lds_byte(wr * 64 + fr, fq * 8), boff = lds_byte(wc * 32 + fr, fq * 8);
#define PG8_SA(b, h) (((b) * 2 + (h)) * HTB)
#define PG8_SB(b, h) ((4 + (b) * 2 + (h)) * HTB)
#define PG8_STAGE(bufoff, gbase, voff) do { _Pragma("unroll") for (int _i = 0; _i < 2; ++_i) \
        __builtin_amdgcn_global_load_lds((const unsigned*)((const char*)(gbase) + (voff)[_i]), (PG8_LAS unsigned*)(lds + (bufoff) + ldsw + _i * 8192), 16, 0, 0); } while (0)
#define PG8_LDA(dst, b, h) do { _Pragma("unroll") for (int m = 0; m < 4; ++m) _Pragma("unroll") for (int k = 0; k < 2; ++k) dst[m][k] = *(const PG8_LAS bf16x8*)(lds + PG8_SA(b, h) + aoff + m * 2048 + k * 1024); } while (0)
#define PG8_LDB(dst, b, h) do { _Pragma("unroll") for (int n = 0; n < 2; ++n) _Pragma("unroll") for (int k = 0; k < 2; ++k) dst[n][k] = *(const PG8_LAS bf16x8*)(lds + PG8_SB(b, h) + boff + n * 2048 + k * 1024); } while (0)
#define PG8_MMA(ai, bj, At, Bt) do { __builtin_amdgcn_s_setprio(1); _Pragma("unroll") for (int m = 0; m < 4; ++m) _Pragma("unroll") for (int n = 0; n < 2; ++n) _Pragma("unroll") for (int k = 0; k < 2; ++k) \
        acc[ai][bj][m][n] = __builtin_amdgcn_mfma_f32_16x16x32_bf16(Bt[n][k], At[m][k], acc[ai][bj][m][n], 0, 0, 0); __builtin_amdgcn_s_setprio(0); } while (0)
#define PG8_WAIT_V(n) asm volatile("s_waitcnt vmcnt(" #n ")" ::: "memory")
#define PG8_WAIT_L(n) asm volatile("s_waitcnt lgkmcnt(" #n ")" ::: "memory")
#define PG8_BAR __builtin_amdgcn_s_barrier()
#define PG8_SCHED __builtin_amdgcn_sched_barrier(0)
    Unit cur, nxt; int ui = 0;
    if (!S.next(0, cur)) return;
    f32x4 acc[2][2][4][2];
#pragma unroll
    for (int a = 0; a < 2; ++a)
#pragma unroll
        for (int b = 0; b < 2; ++b)
#pragma unroll
            for (int m = 0; m < 4; ++m)
#pragma unroll
                for (int n = 0; n < 2; ++n) acc[a][b][m][n] = (f32x4){0.f, 0.f, 0.f, 0.f};
    bf16x8 At[4][2], B0[2][2], B1[2][2];
    const char* cA = (const char*)g.A + (size_t)cur.pm * tstep; const char* cB = (const char*)g.Bt + (size_t)cur.pn * tstep;
    S.a_ready(cur);
    if constexpr (SP2) {
        PG8_STAGE(PG8_SB(0, 0), cB, voffB); PG8_STAGE(PG8_SB(0, 1), cB + hstep, voffB); PG8_STAGE(PG8_SA(0, 0), cA, voffA); PG8_STAGE(PG8_SA(0, 1), cA + hstep, voffA);
        if (wr == 1) PG8_BAR;
        PG8_WAIT_V(2); PG8_BAR;
        PG8_STAGE(PG8_SB(1, 0), cB + kstep, voffB); PG8_STAGE(PG8_SA(1, 0), cA + kstep, voffA); PG8_STAGE(PG8_SB(1, 1), cB + hstep + kstep, voffB);
        PG8_WAIT_V(6); PG8_BAR;
    } else {
        PG8_STAGE(PG8_SB(0, 0), cB, voffB); PG8_STAGE(PG8_SA(0, 0), cA, voffA); PG8_STAGE(PG8_SB(0, 1), cB + hstep, voffB); PG8_STAGE(PG8_SA(0, 1), cA + hstep, voffA);
        if (wr == 1) PG8_BAR;
        PG8_WAIT_V(4); PG8_BAR;
        PG8_STAGE(PG8_SB(1, 0), cB + kstep, voffB); PG8_STAGE(PG8_SA(1, 0), cA + kstep, voffA); PG8_STAGE(PG8_SB(1, 1), cB + hstep + kstep, voffB);
        PG8_WAIT_V(6); PG8_BAR;
    }
    for (;;) {
        const bool has_next = S.next(ui + 1, nxt);
        const char* nA = has_next ? (const char*)g.A + (size_t)nxt.pm * tstep : cA; const char* nB = has_next ? (const char*)g.Bt + (size_t)nxt.pn * tstep : cB;
        for (int t = 0; t < nt; t += 2) {
            const bool last = (t == nt - 2);
            const char* a1 = cA + (size_t)(t + 1) * kstep;
            const char* a2 = last ? nA : cA + (size_t)(t + 2) * kstep; const char* b2 = last ? nB : cB + (size_t)(t + 2) * kstep;
            const char* a3 = a2 + kstep; const char* b3 = b2 + kstep;
            if (last && has_next) S.a_ready(nxt);
            if constexpr (SP2) {
            PG8_LDB(B0, 0, 0); PG8_LDB(B1, 0, 1); PG8_SCHED; PG8_LDA(At, 0, 0); PG8_STAGE(PG8_SA(1, 1), a1 + hstep, voffA);
            PG8_WAIT_V(8); PG8_WAIT_L(0); PG8_BAR; PG8_MMA(0, 0, At, B0); PG8_MMA(0, 1, At, B1); PG8_BAR; PG8_SCHED;
            PG8_LDA(At, 0, 1); PG8_STAGE(PG8_SB(0, 0), b2, voffB); PG8_STAGE(PG8_SB(0, 1), b2 + hstep, voffB); PG8_STAGE(PG8_SA(0, 0), a2, voffA);
            PG8_WAIT_V(8); PG8_WAIT_L(0); PG8_BAR; PG8_MMA(1, 0, At, B0); PG8_MMA(1, 1, At, B1); PG8_BAR; PG8_SCHED;
            PG8_LDB(B0, 1, 0); PG8_LDB(B1, 1, 1); PG8_SCHED; PG8_LDA(At, 1, 0); PG8_STAGE(PG8_SA(0, 1), a2 + hstep, voffA);
            PG8_WAIT_V(8); PG8_WAIT_L(0); PG8_BAR; PG8_MMA(0, 0, At, B0); PG8_MMA(0, 1, At, B1); PG8_BAR; PG8_SCHED;
            PG8_LDA(At, 1, 1); PG8_STAGE(PG8_SB(1, 0), b3, voffB); PG8_STAGE(PG8_SB(1, 1), b3 + hstep, voffB); PG8_STAGE(PG8_SA(1, 0), a3, voffA);
            PG8_WAIT_V(8); PG8_WAIT_L(0); PG8_BAR; PG8_MMA(1, 0, At, B0); PG8_MMA(1, 1, At, B1); PG8_BAR; PG8_SCHED;
            } else {
            PG8_LDB(B0, 0, 0); PG8_SCHED; PG8_LDA(At, 0, 0); PG8_STAGE(PG8_SA(1, 1), a1 + hstep, voffA);
            PG8_WAIT_L(8); PG8_BAR; PG8_WAIT_L(0); PG8_MMA(0, 0, At, B0); PG8_BAR; PG8_SCHED;
            PG8_LDB(B1, 0, 1); PG8_STAGE(PG8_SB(0, 0), b2, voffB);
            PG8_BAR; PG8_WAIT_L(0); PG8_MMA(0, 1, At, B1); PG8_BAR;
            PG8_LDA(At, 0, 1); PG8_STAGE(PG8_SA(0, 0), a2, voffA);
            PG8_BAR; PG8_WAIT_L(0); PG8_MMA(1, 0, At, B0); PG8_BAR; PG8_SCHED;
            PG8_STAGE(PG8_SB(0, 1), b2 + hstep, voffB);
            PG8_WAIT_V(6); PG8_BAR; PG8_MMA(1, 1, At, B1); PG8_BAR;
            PG8_LDB(B0, 1, 0); PG8_SCHED; PG8_LDA(At, 1, 0); PG8_STAGE(PG8_SA(0, 1), a2 + hstep, voffA);
            PG8_WAIT_L(8); PG8_BAR; PG8_WAIT_L(0); PG8_MMA(0, 0, At, B0); PG8_BAR; PG8_SCHED;
            PG8_LDB(B1, 1, 1); PG8_STAGE(PG8_SB(1, 0), b3, voffB);
            PG8_BAR; PG8_WAIT_L(0); PG8_MMA(0, 1, At, B1); PG8_BAR;
            PG8_LDA(At, 1, 1); PG8_STAGE(PG8_SA(1, 0), a3, voffA);
            PG8_BAR; PG8_WAIT_L(0); PG8_MMA(1, 0, At, B0); PG8_BAR; PG8_SCHED;
            PG8_STAGE(PG8_SB(1, 1), b3 + hstep, voffB);
            PG8_WAIT_V(6); PG8_BAR; PG8_MMA(1, 1, At, B1); PG8_BAR;
            }
        }
        if constexpr (ALIGN_EPI) { if (wr == 0) PG8_BAR; }
        if constexpr (!Epi::AFTER_DRAIN) { E(acc, cur, wr, wc, fr, fq); S.done(cur); }
        if (!has_next) break;
#pragma unroll
        for (int a = 0; a < 2; ++a)
#pragma unroll
            for (int b = 0; b < 2; ++b)
#pragma unroll
                for (int m = 0; m < 4; ++m)
#pragma unroll
                    for (int n = 0; n < 2; ++n) acc[a][b][m][n] = (f32x4){0.f, 0.f, 0.f, 0.f};
        cur = nxt; cA = nA; cB = nB; ++ui;
        if constexpr (ALIGN_EPI) { if (wr == 1) PG8_BAR; }
    }
    PG8_WAIT_V(0);
    if constexpr (!ALIGN_EPI) { if (wr == 0) PG8_BAR; }
    PG8_BAR;
    if constexpr (Epi::AFTER_DRAIN) { E.fused(acc, cur, wr, wc, fr, fq, lds, wid, lane); S.done(cur); }
#undef PG8_SA
#undef PG8_SB
#undef PG8_STAGE
#undef PG8_LDA
#undef PG8_LDB
#undef PG8_MMA
#undef PG8_WAIT_V
#undef PG8_WAIT_L
#undef PG8_BAR
#undef PG8_SCHED
}
}

#define XB_TMO      128
#define XB_XCNT(j)  (256  + 64 * (j))
#define XB_XSUB(j)  (1280 + 64 * (j))
#define XB_XGEN(j)  (2304 + 64 * (j))
#define XB_TOP      3328
#define XB_TOPGEN   3392
#define XCD_BAR_WORDS 3456
#define XB_SPIN_CAP (1u << 18)

__device__ __forceinline__ unsigned xb_ld(unsigned* p)              { return __hip_atomic_load(p, __ATOMIC_RELAXED, __HIP_MEMORY_SCOPE_AGENT); }
__device__ __forceinline__ unsigned xb_add(unsigned* p, unsigned v) { return __hip_atomic_fetch_add(p, v, __ATOMIC_RELAXED, __HIP_MEMORY_SCOPE_AGENT); }
__device__ __forceinline__ unsigned xb_xcc_id() { return (unsigned)__builtin_amdgcn_s_getreg((3 << 11) | 20) & 0xFu; }
#define XB_SPIN(cond, bar) do { unsigned _sp = 0; while (cond) { __builtin_amdgcn_s_sleep(1); \
    if ((++_sp & 255u) == 0u) { if (xb_ld(&(bar)[XB_TMO])) break; if (_sp > XB_SPIN_CAP) { atomicAdd(&(bar)[XB_TMO], 1u); break; } } } } while (0)

struct XcdBarrier {
    unsigned* bar; unsigned x;
    volatile LAS unsigned* st;
};

__device__ __forceinline__ XcdBarrier xcd_barrier_post(unsigned* bar, volatile LAS unsigned* st) {
    XcdBarrier b; b.bar = bar; b.x = xb_xcc_id(); b.st = st;
    if (threadIdx.x == 0) (void)xb_add(&bar[XB_XCNT(b.x)], 1u);
    return b;
}
__device__ __forceinline__ void xcd_barrier_complete(unsigned* bar, unsigned x, unsigned& nloc, unsigned& nx) {
    const unsigned G = gridDim.x * gridDim.y * gridDim.z;
    unsigned sum, cnt, mine, sp = 0u;
    for (;;) {
        sum = 0u; cnt = 0u; mine = 0u;
#pragma unroll
        for (unsigned j = 0; j < 16; ++j) { const unsigned c = xb_ld(&bar[XB_XCNT(j)]); sum += c; cnt += (c > 0u) ? 1u : 0u; mine = (j == x) ? c : mine; }
        if (sum == G) break;
        __builtin_amdgcn_s_sleep(1);
        if ((++sp & 255u) == 0u) { if (xb_ld(&bar[XB_TMO])) break; if (sp > XB_SPIN_CAP) { atomicAdd(&bar[XB_TMO], 1u); break; } }
    }
    nloc = mine > 0u ? mine : 1u; nx = cnt > 0u ? cnt : 1u;
}

__device__ __forceinline__ void xcd_barrier(const XcdBarrier& b) {
    asm volatile("s_waitcnt vmcnt(0)" ::: "memory");
    __syncthreads();
    if (threadIdx.x == 0) {
        unsigned* bar = b.bar;
        __builtin_amdgcn_s_waitcnt(0);
        unsigned nloc = b.st[0], nx = b.st[1];
        if (nloc == 0u) { xcd_barrier_complete(bar, b.x, nloc, nx); b.st[0] = nloc; b.st[1] = nx; }
        const unsigned old = xb_add(&bar[XB_XSUB(b.x)], 1u);
        const unsigned gen = old / nloc;
        if (old + 1u == (gen + 1u) * nloc) {
            __builtin_amdgcn_fence(__ATOMIC_RELEASE, "agent");
            asm volatile("s_waitcnt vmcnt(0)" ::: "memory");
            const unsigned og = xb_add(&bar[XB_TOP], 1u);
            const unsigned tg = og / nx;
            if (og + 1u == (tg + 1u) * nx) xb_add(&bar[XB_TOPGEN], 1u);
            else XB_SPIN(xb_ld(&bar[XB_TOPGEN]) == tg, bar);
            __builtin_amdgcn_fence(__ATOMIC_ACQUIRE, "agent");
            xb_add(&bar[XB_XGEN(b.x)], 1u);
            asm volatile("s_waitcnt vmcnt(0)" ::: "memory");
        } else {
            XB_SPIN(xb_ld(&bar[XB_XGEN(b.x)]) == gen, bar);
            __builtin_amdgcn_fence(__ATOMIC_ACQUIRE, "agent");
            asm volatile("s_waitcnt vmcnt(0)" ::: "memory");
        }
    }
    __syncthreads();
}

typedef unsigned short bf16_t;
typedef short bf16x8 __attribute__((ext_vector_type(8)));
typedef short bf16x4 __attribute__((ext_vector_type(4)));
typedef float f32x4 __attribute__((ext_vector_type(4)));
typedef unsigned u32x4 __attribute__((ext_vector_type(4)));
typedef unsigned u32x2 __attribute__((ext_vector_type(2)));
constexpr int DM = 1024, NBATCH = 8, SEQ = 4096, NTOK = NBATCH * SEQ, DEPTH = 2;
constexpr int INW = 3968, INWP = 4096, FFN = 2816, NMOD = 6;
constexpr int C_AQ = 0, C_AK = 384, C_AV = 768, C_RQ = 1152, C_RK = 1536, C_RV = 1920, C_RG = 2304, C_HQ = 2688, C_HZF = 2944, C_HZB = 3200, C_HI = 3456, C_HG = 3712;
constexpr float NORM_EPS = 1e-6f;
constexpr int NTHREADS = 512;
constexpr int LDS_BYTES = 135168;
constexpr size_t WS_CTL = 0, WS_MOD = 16384, WS_LB = WS_MOD + 393216, WS_HGA = WS_LB + 2048, WS_LSE = WS_HGA + 524288, WS_WIN = WS_LSE + 2359296,
    WS_WOUT = WS_WIN + 16777216, WS_WGU = WS_WOUT + 4194304, WS_WDN = WS_WGU + 23068672, WS_HBUF = WS_WDN + 11534336, WS_PROJ = WS_HBUF + 67108864,
    WS_OB = WS_PROJ + 260046848, WS_RST = WS_OB + 75497472, WS_HGU = WS_RST + 25165824, WS_END = WS_HGU + 33554432;

struct Params {
    const float *x, *c, *w_ada, *b_ada, *g_mix, *w_in, *ret_gn, *hgrn_gn, *lb_logits, *w_out, *g_ffn, *w_gu, *w_down, *g_final;
    float* out; unsigned char* ws; int ph_lo, ph_hi;
};

__device__ __forceinline__ float bf2f(bf16_t v) { return __uint_as_float(((unsigned)v) << 16); }
__device__ __forceinline__ float bflo(unsigned w) { return __uint_as_float(w << 16); }
__device__ __forceinline__ float bfhi(unsigned w) { return __uint_as_float(w & 0xffff0000u); }
__device__ __forceinline__ bf16_t f2bf(float f) { return __builtin_bit_cast(bf16_t, (__bf16)f); }
typedef float f32x2c __attribute__((ext_vector_type(2)));
typedef __bf16 bf16v2c __attribute__((ext_vector_type(2)));
__device__ __forceinline__ unsigned pk2(float lo, float hi) { const f32x2c v = {lo, hi}; return __builtin_bit_cast(unsigned, __builtin_convertvector(v, bf16v2c)); }
__device__ __forceinline__ bf16x4 pk4(f32x4 v) { u32x2 w; w.x = pk2(v[0], v[1]); w.y = pk2(v[2], v[3]); return __builtin_bit_cast(bf16x4, w); }
__device__ __forceinline__ float siluf(float v) { return v * __builtin_amdgcn_rcpf(1.0f + __expf(-v)); }
__device__ __forceinline__ float wave_sum(float v) {
#pragma unroll
    for (int o = 1; o < 64; o <<= 1) v += __shfl_xor(v, o);
    return v;
}
#define MFMA32(a, b, c) __builtin_amdgcn_mfma_f32_16x16x32_bf16((a), (b), (c), 0, 0, 0)
#define MFMA16(a, b, c) __builtin_amdgcn_mfma_f32_16x16x16bf16_1k((a), (b), (c), 0, 0, 0)

struct EpiProj {
    static constexpr bool PERM = true, AFTER_DRAIN = false;
    bf16_t* O; int ldc, ncols;
    __device__ __forceinline__ void operator()(const f32x4 (&acc)[2][2][4][2], const pg8::Unit& u, int wr, int wc, int fr, int fq) const {
        const int row0 = u.pm * 256 + wr * 64 + fr, col0 = u.pn * 256 + wc * 32 + 8 * fq;
#pragma unroll
        for (int ai = 0; ai < 2; ++ai)
#pragma unroll
            for (int m = 0; m < 4; ++m) { bf16_t* rowp = O + (size_t)(row0 + ai * 128 + m * 16) * ldc + col0;
#pragma unroll
                for (int bj = 0; bj < 2; ++bj) { if (col0 + bj * 128 < ncols) { const f32x4 v0 = acc[ai][bj][m][0], v1 = acc[ai][bj][m][1];
                    u32x4 w; w.x = pk2(v0[0], v0[1]); w.y = pk2(v0[2], v0[3]); w.z = pk2(v1[0], v1[1]); w.w = pk2(v1[2], v1[3]);
                    *(u32x4*)(rowp + bj * 128) = w; } } }
    }
};
struct EpiRes {
    static constexpr bool PERM = false, AFTER_DRAIN = false;
    const float* base; float* out; const float* gate;
    __device__ __forceinline__ void operator()(const f32x4 (&acc)[2][2][4][2], const pg8::Unit& u, int wr, int wc, int fr, int fq) const {
        const int row0 = u.pm * 256 + wr * 64 + fr, col0 = u.pn * 256 + wc * 32 + 4 * fq;
        const float* gp = gate + (size_t)((u.pm * 256) >> 12) * (NMOD * DM) + col0;
        f32x4 gv[2][2];
#pragma unroll
        for (int bj = 0; bj < 2; ++bj)
#pragma unroll
            for (int n = 0; n < 2; ++n) gv[bj][n] = *(const f32x4*)(gp + bj * 128 + n * 16);
#pragma unroll
        for (int ai = 0; ai < 2; ++ai)
#pragma unroll
            for (int m = 0; m < 4; ++m) { const size_t off = (size_t)(row0 + ai * 128 + m * 16) * DM + col0;
#pragma unroll
                for (int bj = 0; bj < 2; ++bj)
#pragma unroll
                    for (int n = 0; n < 2; ++n) { const f32x4 bs = *(const f32x4*)(base + off + bj * 128 + n * 16);
                        *(f32x4*)(out + off + bj * 128 + n * 16) = bs + gv[bj][n] * acc[ai][bj][m][n]; } }
    }
};
struct EpiSwiglu {
    static constexpr bool PERM = true, AFTER_DRAIN = false;
    bf16_t* O;
    __device__ __forceinline__ void operator()(const f32x4 (&acc)[2][2][4][2], const pg8::Unit& u, int wr, int wc, int fr, int fq) const {
        const int row0 = u.pm * 256 + wr * 64 + fr, col0 = u.pn * 128 + wc * 32 + 8 * fq;
#pragma unroll
        for (int ai = 0; ai < 2; ++ai)
#pragma unroll
            for (int m = 0; m < 4; ++m) { bf16_t* rowp = O + (size_t)(row0 + ai * 128 + m * 16) * FFN + col0;
                float r[8];
#pragma unroll
                for (int n = 0; n < 2; ++n)
#pragma unroll
                    for (int i = 0; i < 4; ++i) { const float g = acc[ai][0][m][n][i], uu = acc[ai][1][m][n][i]; r[n * 4 + i] = siluf(g) * uu; }
                u32x4 w; w.x = pk2(r[0], r[1]); w.y = pk2(r[2], r[3]); w.z = pk2(r[4], r[5]); w.w = pk2(r[6], r[7]);
                *(u32x4*)rowp = w; }
    }
};
__device__ __forceinline__ void transpose_item(const float* W, int K, int N, bf16_t* WT, int dst_row0, int src_col0, int k0, LAS float* scr, int lane) {
    const int c = lane & 7, nr = lane >> 3;
    if (src_col0 < 0) {
#pragma unroll
        for (int j = 0; j < 8; ++j) *(u32x4*)(WT + (size_t)(dst_row0 + nr + 8 * j) * K + k0 + 8 * c) = (u32x4){0u, 0u, 0u, 0u};
        return;
    }
    const int kr = lane >> 4, c4 = lane & 15;
    f32x4 v[16];
#pragma unroll
    for (int i = 0; i < 16; ++i) v[i] = *(const f32x4*)(W + (size_t)(k0 + 4 * i + kr) * N + src_col0 + 4 * c4);
#pragma unroll
    for (int i = 0; i < 16; ++i) { LAS float* d = scr + (4 * i + kr) * 65 + 4 * c4; d[0] = v[i][0]; d[1] = v[i][1]; d[2] = v[i][2]; d[3] = v[i][3]; }
    __builtin_amdgcn_fence(__ATOMIC_RELEASE, "wavefront"); __builtin_amdgcn_wave_barrier(); __builtin_amdgcn_fence(__ATOMIC_ACQUIRE, "wavefront");
#pragma unroll
    for (int j = 0; j < 8; ++j) { const int n = nr + 8 * j; const LAS float* sp = scr + (8 * c) * 65 + n;
        u32x4 o; o.x = pk2(sp[0 * 65], sp[1 * 65]); o.y = pk2(sp[2 * 65], sp[3 * 65]); o.z = pk2(sp[4 * 65], sp[5 * 65]); o.w = pk2(sp[6 * 65], sp[7 * 65]);
        *(u32x4*)(WT + (size_t)(dst_row0 + n) * K + k0 + 8 * c) = o; }
    __builtin_amdgcn_fence(__ATOMIC_RELEASE, "wavefront"); __builtin_amdgcn_wave_barrier(); __builtin_amdgcn_fence(__ATOMIC_ACQUIRE, "wavefront");
}

__device__ __forceinline__ void phase_weights(const Params& P, LAS unsigned char* lds) {
    const int tid = opaque_tid(), lane = tid & 63, wave = __builtin_amdgcn_readfirstlane(tid >> 6);
    unsigned char* ws = P.ws;
    {
        LAS float* scr = (LAS float*)(lds + wave * 16640);
        const int gw = blockIdx.x * 8 + wave, NGW = gridDim.x * 8;
        constexpr int I_IN = 16 * 64, I_OUT = 16 * 16, I_GU = 16 * 88, I_DN = 44 * 16, I_L = I_IN + I_OUT + I_GU + I_DN;
        for (int it = gw; it < DEPTH * I_L; it += NGW) {
            const int l = it / I_L; int r = it % I_L;
            if (r < I_IN) { const int kb = r / 64, nb = r % 64, n0 = nb * 64;
                transpose_item(P.w_in + (size_t)l * DM * INW, DM, INW, (bf16_t*)(ws + WS_WIN) + (size_t)l * INWP * DM, n0, n0 < INW ? n0 : -1, kb * 64, scr, lane); continue; }
            r -= I_IN;
            if (r < I_OUT) { const int kb = r / 16, nb = r % 16;
                transpose_item(P.w_out + (size_t)l * DM * DM, DM, DM, (bf16_t*)(ws + WS_WOUT) + (size_t)l * DM * DM, nb * 64, nb * 64, kb * 64, scr, lane); continue; }
            r -= I_OUT;
            if (r < I_GU) { const int kb = r / 88, nb = r % 88, n0 = nb * 64; const int pn = n0 >> 8, half = (n0 >> 7) & 1, jj = n0 & 127;
                transpose_item(P.w_gu + (size_t)l * DM * 2 * FFN, DM, 2 * FFN, (bf16_t*)(ws + WS_WGU) + (size_t)l * 2 * FFN * DM, n0, half * FFN + pn * 128 + jj, kb * 64, scr, lane); continue; }
            r -= I_GU;
            { const int kb = r / 16, nb = r % 16;
                transpose_item(P.w_down + (size_t)l * FFN * DM, FFN, DM, (bf16_t*)(ws + WS_WDN) + (size_t)l * DM * FFN, nb * 64, nb * 64, kb * 64, scr, lane); }
        }
    }
}
__device__ __forceinline__ void phase_prologue(const Params& P, LAS unsigned char* lds) {
    const int tid = opaque_tid();
    unsigned char* ws = P.ws;
    {
        LAS float* sc = (LAS float*)lds;
        LAS float* red = (LAS float*)(lds + 32768);
        for (int i = tid; i < NBATCH * DM; i += NTHREADS) sc[i] = siluf(P.c[i]);
        __syncthreads();
        float* mod = (float*)(ws + WS_MOD);
        for (int u = blockIdx.x; u < DEPTH * 96; u += gridDim.x) {
            const int l = u / 96, j0 = (u % 96) * 64, col = tid & 63, kp = tid >> 6;
            float acc[8];
#pragma unroll
            for (int b = 0; b < 8; ++b) acc[b] = 0.f;
            const float* wp = P.w_ada + (size_t)l * DM * (NMOD * DM) + j0 + col;
            for (int k = kp * 128; k < kp * 128 + 128; ++k) { const float w = wp[(size_t)k * (NMOD * DM)];
#pragma unroll
                for (int b = 0; b < 8; ++b) acc[b] += sc[b * DM + k] * w; }
#pragma unroll
            for (int b = 0; b < 8; ++b) red[(kp * 8 + b) * 64 + col] = acc[b];
            __syncthreads();
            { const int b = tid >> 6; float s = 0.f;
#pragma unroll
              for (int p = 0; p < 8; ++p) s += red[(p * 8 + b) * 64 + col];
              mod[((size_t)l * NBATCH + b) * (NMOD * DM) + j0 + col] = s + P.b_ada[(size_t)l * NMOD * DM + j0 + col]; }
            __syncthreads();
        }
    }
    if (blockIdx.x == 0 && tid < 256) {
        const float l0 = P.lb_logits[tid], l1 = P.lb_logits[256 + tid], m = fmaxf(l0, l1), e0 = __expf(l0 - m), e1 = __expf(l1 - m);
        const float p0 = e0 / (e0 + e1), p1 = e1 / (e0 + e1);
        float* lb = (float*)(ws + WS_LB);
        lb[tid] = fminf(fmaxf(p0 - p0, 0.f), 1.0f - 1e-6f);
        lb[256 + tid] = fminf(fmaxf((p0 + p1) - p0, 0.f), 1.0f - 1e-6f);
    }
}

template <int NY, bool WRITE_X, bool FINAL>
__device__ __forceinline__ void phase_norm(const float* src, const bf16_t* y, const float* gate, const bf16_t* y2, const float* gate2, float* xout, const float* g, const float* shift, const float* scale, bf16_t* dst) {
    constexpr bool HAS_Y = NY > 0;
    const int tid = opaque_tid(), lane = tid & 63, wave = tid >> 6;
    const int gw = blockIdx.x * 8 + wave, NGW = gridDim.x * 8;
    f32x4 gv[4];
#pragma unroll
    for (int j = 0; j < 4; ++j) gv[j] = *(const f32x4*)(g + 4 * lane + 256 * j);
    const int WPB = NGW / NBATCH, b = gw / WPB;
    if (b >= NBATCH) return;
    f32x4 gtv[4], gtv2[4], scv[4], shv[4];
#pragma unroll
    for (int j = 0; j < 4; ++j) {
        if (HAS_Y) gtv[j] = *(const f32x4*)(gate + (size_t)b * (NMOD * DM) + 4 * lane + 256 * j);
        if (NY > 1) gtv2[j] = *(const f32x4*)(gate2 + (size_t)b * (NMOD * DM) + 4 * lane + 256 * j);
        if (!FINAL) { scv[j] = *(const f32x4*)(scale + (size_t)b * (NMOD * DM) + 4 * lane + 256 * j) + 1.0f; shv[j] = *(const f32x4*)(shift + (size_t)b * (NMOD * DM) + 4 * lane + 256 * j); }
    }
    for (int row = b * SEQ + (gw - b * WPB); row < (b + 1) * SEQ; row += WPB) {
        const f32x4* xr = (const f32x4*)(src + (size_t)row * DM) + lane;
        f32x4 v[4]; float s = 0.f;
#pragma unroll
        for (int j = 0; j < 4; ++j) v[j] = __builtin_nontemporal_load(xr + 64 * j);
        if (HAS_Y) {
            const u32x2* yr = (const u32x2*)(y + (size_t)row * DM) + lane;
#pragma unroll
            for (int j = 0; j < 4; ++j) { const u32x2 yw = __builtin_nontemporal_load(yr + 64 * j); const f32x4 gt = gtv[j];
                v[j][0] += gt[0] * bflo(yw.x); v[j][1] += gt[1] * bfhi(yw.x); v[j][2] += gt[2] * bflo(yw.y); v[j][3] += gt[3] * bfhi(yw.y); }
        }
        if (NY > 1) {
            const u32x2* yr2 = (const u32x2*)(y2 + (size_t)row * DM) + lane;
#pragma unroll
            for (int j = 0; j < 4; ++j) { const u32x2 yw = __builtin_nontemporal_load(yr2 + 64 * j); const f32x4 gt = gtv2[j];
                v[j][0] += gt[0] * bflo(yw.x); v[j][1] += gt[1] * bfhi(yw.x); v[j][2] += gt[2] * bflo(yw.y); v[j][3] += gt[3] * bfhi(yw.y); }
        }
#pragma unroll
        for (int j = 0; j < 4; ++j) s += (v[j][0] * v[j][0] + v[j][1] * v[j][1]) + (v[j][2] * v[j][2] + v[j][3] * v[j][3]);
        const float rstd = rsqrtf(wave_sum(s) * (1.0f / DM) + NORM_EPS);
        f32x4* xo = (f32x4*)(xout + (size_t)row * DM) + lane;
        if (FINAL) {
#pragma unroll
            for (int j = 0; j < 4; ++j) __builtin_nontemporal_store(v[j] * rstd * gv[j], xo + 64 * j);
        } else {
            if (WRITE_X) {
#pragma unroll
                for (int j = 0; j < 4; ++j) __builtin_nontemporal_store(v[j], xo + 64 * j);
            }
            unsigned long long* o8 = (unsigned long long*)(dst + (size_t)row * DM) + lane;
#pragma unroll
            for (int j = 0; j < 4; ++j) {
                const f32x4 h = v[j] * rstd * gv[j] * scv[j] + shv[j];
                o8[64 * j] = (unsigned long long)pk2(h[0], h[1]) | ((unsigned long long)pk2(h[2], h[3]) << 32);
            }
        }
    }
}
__device__ __forceinline__ bf16x4 tr4(const LAS bf16_t* img, int pitch, int row0, int col0, int g, int q) {
    return __builtin_amdgcn_ds_read_tr16_b64_v4i16((LAS bf16x4*)(img + (row0 + 4 * g + (q >> 2)) * pitch + col0 + 4 * (q & 3)));
}
__device__ __forceinline__ bf16x8 tr8(const LAS bf16_t* img, int pitch, int row0, int col0, int g, int q) {
    const bf16x4 lo = __builtin_amdgcn_ds_read_tr16_b64_v4i16((LAS bf16x4*)(img + (row0 + 8 * g + (q >> 2)) * pitch + col0 + 4 * (q & 3)));
    const bf16x4 hi = __builtin_amdgcn_ds_read_tr16_b64_v4i16((LAS bf16x4*)(img + (row0 + 8 * g + 4 + (q >> 2)) * pitch + col0 + 4 * (q & 3)));
    return __builtin_shufflevector(lo, hi, 0, 1, 2, 3, 4, 5, 6, 7);
}
struct AttRegs { u32x4 kv[2][4], vv[2][4]; bf16x8 qf[2][2]; };
constexpr int ATT_UNITS = 2304;
__device__ __forceinline__ void att_decode(int u, int& br, int& b, int& h, int& r, int& L, int& p0, int& tok0) {
    const int pi = u >> 6, k = u & 63; b = pi / 6; h = pi % 6; br = k >> 4; const int w = k & 15;
    const int lr = br * 2, nblk = 16 >> lr, rho = w >> (4 - lr), blk = w & (nblk - 1); r = 1 << lr; L = SEQ >> lr; p0 = blk * 256; tok0 = b * SEQ + rho;
}
__device__ __forceinline__ int att_unit(int li, int x) { const int pl = li / 48, k = li - pl * 48; return ((x + 8 * pl) << 6) | k; }
__device__ __forceinline__ void att_load(const Params& P, int u, int tid, AttRegs& R) {
    int br, b, h, r, L, p0, tok0; att_decode(u, br, b, h, r, L, p0, tok0);
    const bf16_t* proj = (const bf16_t*)(P.ws + WS_PROJ);
#pragma unroll
    for (int it = 0; it < 2; ++it) {
        const int item = tid + it * NTHREADS, key = item >> 1, half = item & 1, kj = p0 - 64 + key;
        if (item < 768 && kj >= 0 && kj < L) {
            const bf16_t* src = proj + (size_t)(tok0 + r * kj) * INW + h * 64 + half * 32;
#pragma unroll
            for (int i = 0; i < 4; ++i) { R.kv[it][i] = *(const u32x4*)(src + C_AK + 8 * i); R.vv[it][i] = *(const u32x4*)(src + C_AV + 8 * i); }
        } else {
#pragma unroll
            for (int i = 0; i < 4; ++i) { R.kv[it][i] = (u32x4){0u, 0u, 0u, 0u}; R.vv[it][i] = (u32x4){0u, 0u, 0u, 0u}; }
        }
    }
    const int lane = tid & 63, wave = tid >> 6, q = lane & 15, g = lane >> 4;
#pragma unroll
    for (int qt = 0; qt < 2; ++qt) {
        const size_t tokq = (size_t)(tok0 + r * (p0 + 32 * wave + 16 * qt + q));
#pragma unroll
        for (int kk = 0; kk < 2; ++kk) R.qf[qt][kk] = *(const bf16x8*)(proj + tokq * INW + C_AQ + h * 64 + kk * 32 + 8 * g);
    }
}
__device__ __forceinline__ void att_phase(const Params& P, LAS unsigned char* lds) {
    const int tid = opaque_tid(), lane = tid & 63, wave = __builtin_amdgcn_readfirstlane(tid >> 6), q = lane & 15, g = lane >> 4;
    LAS bf16_t* Ks = (LAS bf16_t*)lds;
    LAS bf16_t* Vs = (LAS bf16_t*)(lds + 55296);
    const int xq = blockIdx.x & 7, nj = ((int)gridDim.x + 7 - xq) >> 3;
    int li = blockIdx.x >> 3; if (li >= 288) return;
    AttRegs R; att_load(P, att_unit(li, xq), tid, R);
    for (; li < 288; li += nj) {
        const int u = att_unit(li, xq);
        int br, b, h, r, L, p0, tok0; att_decode(u, br, b, h, r, L, p0, tok0);
#pragma unroll
        for (int it = 0; it < 2; ++it) {
            const int item = tid + it * NTHREADS, key = item >> 1, half = item & 1;
            if (item < 768) {
#pragma unroll
                for (int i = 0; i < 4; ++i) { *(LAS u32x4*)(Ks + key * 72 + half * 32 + 8 * i) = R.kv[it][i]; *(LAS u32x4*)(Vs + key * 72 + half * 32 + 8 * i) = R.vv[it][i]; }
            }
        }
        bf16x8 qf[2][2]; qf[0][0] = R.qf[0][0]; qf[0][1] = R.qf[0][1]; qf[1][0] = R.qf[1][0]; qf[1][1] = R.qf[1][1];
        __syncthreads();
        if (li + nj < 288) att_load(P, att_unit(li + nj, xq), tid, R);
        const float slope_l2 = exp2f(-8.0f * (float)(h + 1) / 6.0f) * (float)r * 1.44269504f, qk_l2 = 0.125f * 1.44269504f;
        const float fbase = (float)(64 + q - 4 * g);
        const bool edge = (p0 < 64) || (p0 + 320 > L);
#pragma unroll
        for (int qt = 0; qt < 2; ++qt) {
            const int kw = 32 * wave + 16 * qt;
            const int p = p0 + kw + q; const size_t tokq = (size_t)(tok0 + r * p);
            f32x4 st[9]; float mx = -3.0e38f;
#pragma unroll
            for (int t = 0; t < 9; ++t) {
                f32x4 acc = {0.f, 0.f, 0.f, 0.f};
#pragma unroll
                for (int kk = 0; kk < 2; ++kk) { const bf16x8 a = *(const LAS bf16x8*)(Ks + (kw + 16 * t + q) * 72 + kk * 32 + 8 * g); acc = MFMA32(a, qf[qt][kk], acc); }
#pragma unroll
                for (int j = 0; j < 4; ++j) {
                    const float d = fabsf(fbase - (float)(16 * t + j));
                    float s = acc[j] * qk_l2 - slope_l2 * d;
                    if (t == 0 || t == 8) s = (d <= 64.0f) ? s : -1.0e30f;
                    acc[j] = s;
                }
                if (edge) {
#pragma unroll
                    for (int j = 0; j < 4; ++j) { const int kj = p0 - 64 + kw + 16 * t + 4 * g + j; acc[j] = (kj >= 0 && kj < L) ? acc[j] : -1.0e30f; }
                }
#pragma unroll
                for (int j = 0; j < 4; ++j) mx = fmaxf(mx, acc[j]);
                st[t] = acc;
            }
            mx = fmaxf(mx, __shfl_xor(mx, 16)); mx = fmaxf(mx, __shfl_xor(mx, 32));
            float ls = 0.f; bf16x4 pt[9];
#pragma unroll
            for (int t = 0; t < 9; ++t) { f32x4 e;
#pragma unroll
                for (int j = 0; j < 4; ++j) { e[j] = __builtin_amdgcn_exp2f(st[t][j] - mx); ls += e[j]; }
                pt[t] = pk4(e); }
            ls += __shfl_xor(ls, 16); ls += __shfl_xor(ls, 32);
            const float inv = __builtin_amdgcn_rcpf(ls);
            bf16_t* ob = (bf16_t*)(P.ws + WS_OB) + ((size_t)br * NTOK + tokq) * 384 + h * 64;
            const LAS bf16_t* vrd = Vs + (kw + 4 * g + (q >> 2)) * 72 + 4 * (q & 3);
#pragma unroll
            for (int dt = 0; dt < 4; ++dt) {
                f32x4 acc = {0.f, 0.f, 0.f, 0.f};
#pragma unroll
                for (int t = 0; t < 9; ++t) { const bf16x4 a = __builtin_amdgcn_ds_read_tr16_b64_v4i16((LAS bf16x4*)(vrd + 16 * t * 72 + dt * 16)); acc = MFMA16(a, pt[t], acc); }
                acc = acc * inv;
                *(bf16x4*)(ob + dt * 16 + 4 * g) = pk4(acc);
            }
            if (g == 0) ((float*)(P.ws + WS_LSE))[((size_t)br * NTOK + tokq) * 6 + h] = (mx + __log2f(ls)) * 0.69314718f;
        }
        __syncthreads();
    }
}
__device__ __forceinline__ void att_merge(const Params& P) {
    const bf16_t* ob = (const bf16_t*)(P.ws + WS_OB); const float* lse = (const float*)(P.ws + WS_LSE); bf16_t* mixed = (bf16_t*)(P.ws + WS_HBUF);
    for (size_t it = (size_t)blockIdx.x * NTHREADS + opaque_tid(); it < (size_t)NTOK * 48; it += (size_t)gridDim.x * NTHREADS) {
        const size_t tok = it / 48; const int grp = (int)(it % 48), h = grp >> 3;
        const float l0 = lse[tok * 6 + h], l1 = lse[((size_t)NTOK + tok) * 6 + h], l2 = lse[((size_t)2 * NTOK + tok) * 6 + h];
        const float m = fmaxf(l0, fmaxf(l1, l2)), e0 = __expf(l0 - m), e1 = __expf(l1 - m), e2 = __expf(l2 - m), is = __builtin_amdgcn_rcpf(e0 + e1 + e2);
        const float w0 = e0 * is, w1 = e1 * is, w2 = e2 * is;
        const u32x4 a = *(const u32x4*)(ob + tok * 384 + grp * 8), bq = *(const u32x4*)(ob + ((size_t)NTOK + tok) * 384 + grp * 8), cq = *(const u32x4*)(ob + ((size_t)2 * NTOK + tok) * 384 + grp * 8);
        u32x4 o;
#pragma unroll
        for (int i = 0; i < 4; ++i) o[i] = pk2(w0 * bflo(a[i]) + w1 * bflo(bq[i]) + w2 * bflo(cq[i]), w0 * bfhi(a[i]) + w1 * bfhi(bq[i]) + w2 * bfhi(cq[i]));
        *(u32x4*)(mixed + tok * DM + grp * 8) = o;
    }
}

__device__ __forceinline__ float ret_logg(int h) { return log1pf(-exp2f(-5.0f - (float)h)); }
struct RetARegs { u32x4 k0, k1, v0, v1; };
__device__ __forceinline__ void retA_load(const Params& P, int u, int tid, RetARegs& R) {
    const int bh = u >> 5, n = u & 31, b = bh / 6, h = bh % 6, c = tid >> 2, qd = tid & 3;
    const bf16_t* src = (const bf16_t*)(P.ws + WS_PROJ) + (size_t)(b * SEQ + n * 128 + c) * INW + h * 64 + qd * 16;
    R.k0 = *(const u32x4*)(src + C_RK); R.k1 = *(const u32x4*)(src + C_RK + 8); R.v0 = *(const u32x4*)(src + C_RV); R.v1 = *(const u32x4*)(src + C_RV + 8);
}
__device__ __forceinline__ void retA_phase(const Params& P, LAS unsigned char* lds) {
    const int tid = opaque_tid(), lane = tid & 63, wave = __builtin_amdgcn_readfirstlane(tid >> 6), q = lane & 15, g = lane >> 4;
    LAS bf16_t* Kf = (LAS bf16_t*)lds; LAS bf16_t* Kb = (LAS bf16_t*)(lds + 18432); LAS bf16_t* Vs = (LAS bf16_t*)(lds + 36864);
    int u = blockIdx.x; if (u >= 1536) return;
    RetARegs R; retA_load(P, u, tid, R);
    for (; u < 1536; u += gridDim.x) {
        const int bh = u >> 5, n = u & 31, h = bh % 6;
        const float lg = ret_logg(h);
        {
            const int c = tid >> 2, qd = tid & 3;
            const float wf = 0.125f * __expf(lg * (float)(127 - c)), wb = 0.125f * __expf(lg * (float)c);
            u32x4 f0, f1, b0, b1;
#pragma unroll
            for (int e = 0; e < 4; ++e) { f0[e] = pk2(bflo(R.k0[e]) * wf, bfhi(R.k0[e]) * wf); f1[e] = pk2(bflo(R.k1[e]) * wf, bfhi(R.k1[e]) * wf);
                b0[e] = pk2(bflo(R.k0[e]) * wb, bfhi(R.k0[e]) * wb); b1[e] = pk2(bflo(R.k1[e]) * wb, bfhi(R.k1[e]) * wb); }
            *(LAS u32x4*)(Kf + c * 72 + qd * 16) = f0; *(LAS u32x4*)(Kf + c * 72 + qd * 16 + 8) = f1;
            *(LAS u32x4*)(Kb + c * 72 + qd * 16) = b0; *(LAS u32x4*)(Kb + c * 72 + qd * 16 + 8) = b1;
            *(LAS u32x4*)(Vs + c * 72 + qd * 16) = R.v0; *(LAS u32x4*)(Vs + c * 72 + qd * 16 + 8) = R.v1;
        }
        __syncthreads();
        if (u + (int)gridDim.x < 1536) retA_load(P, u + gridDim.x, tid, R);
        const int dir = wave >> 2, dt = wave & 3; const LAS bf16_t* Kt = dir ? Kb : Kf;
        bf16x8 afr[4];
#pragma unroll
        for (int kk = 0; kk < 4; ++kk) afr[kk] = tr8(Kt, 72, kk * 32, dt * 16, g, q);
        bf16_t* dst = (bf16_t*)(P.ws + WS_RST) + ((size_t)(bh * 32 + n) * 2 + dir) * 4096;
#pragma unroll
        for (int et = 0; et < 4; ++et) {
            f32x4 acc = {0.f, 0.f, 0.f, 0.f};
#pragma unroll
            for (int kk = 0; kk < 4; ++kk) { const bf16x8 bfr = tr8(Vs, 72, kk * 32, et * 16, g, q); acc = MFMA32(afr[kk], bfr, acc); }
            *(bf16x4*)(dst + (et * 16 + q) * 64 + dt * 16 + 4 * g) = pk4(acc);
        }
        __syncthreads();
    }
}
__device__ __forceinline__ void ret_scan(const Params& P) {
    bf16_t* st = (bf16_t*)(P.ws + WS_RST);
    for (int it = blockIdx.x * NTHREADS + opaque_tid(); it < 48 * 2 * 512; it += gridDim.x * NTHREADS) {
        const int ch = it & 511, dir = (it >> 9) & 1, bh = it >> 10, h = bh % 6;
        const float cd = __expf(ret_logg(h) * 128.0f);
        float s[8];
#pragma unroll
        for (int e = 0; e < 8; ++e) s[e] = 0.f;
        for (int i0 = 0; i0 < 32; i0 += 8) {
            u32x4 v[8];
#pragma unroll
            for (int i = 0; i < 8; ++i) { const int n = dir ? 31 - (i0 + i) : (i0 + i); v[i] = *(const u32x4*)(st + ((size_t)(bh * 32 + n) * 2 + dir) * 4096 + 8 * ch); }
#pragma unroll
            for (int i = 0; i < 8; ++i) { const int n = dir ? 31 - (i0 + i) : (i0 + i);
                u32x4 o;
#pragma unroll
                for (int e = 0; e < 4; ++e) o[e] = pk2(s[2 * e], s[2 * e + 1]);
                *(u32x4*)(st + ((size_t)(bh * 32 + n) * 2 + dir) * 4096 + 8 * ch) = o;
#pragma unroll
                for (int e = 0; e < 4; ++e) { s[2 * e] = cd * s[2 * e] + bflo(v[i][e]); s[2 * e + 1] = cd * s[2 * e + 1] + bfhi(v[i][e]); } }
        }
    }
}
struct RetBRegs { u32x4 k0, k1, v0, v1, rf, rb, q0, q1; };
__device__ __forceinline__ void retB_load(const Params& P, int u, int tid, RetBRegs& R) {
    const int bh = u >> 5, n = u & 31, b = bh / 6, h = bh % 6, c = tid >> 2, qd = tid & 3;
    const bf16_t* proj = (const bf16_t*)(P.ws + WS_PROJ);
    const bf16_t* src = proj + (size_t)(b * SEQ + n * 128 + c) * INW + h * 64 + qd * 16;
    R.k0 = *(const u32x4*)(src + C_RK); R.k1 = *(const u32x4*)(src + C_RK + 8); R.v0 = *(const u32x4*)(src + C_RV); R.v1 = *(const u32x4*)(src + C_RV + 8);
    const bf16_t* rs = (const bf16_t*)(P.ws + WS_RST) + (size_t)(bh * 32 + n) * 2 * 4096;
    const int e = tid >> 3, d8 = (tid & 7) * 8;
    R.rf = *(const u32x4*)(rs + e * 64 + d8); R.rb = *(const u32x4*)(rs + 4096 + e * 64 + d8);
    const int lane = tid & 63, wave = tid >> 6, q = lane & 15, g = lane >> 4;
    const bf16_t* qp = proj + (size_t)(b * SEQ + n * 128 + 16 * wave + q) * INW + C_RQ + h * 64 + 8 * g;
    R.q0 = *(const u32x4*)qp; R.q1 = *(const u32x4*)(qp + 32);
}
__device__ __forceinline__ void retB_phase(const Params& P, LAS unsigned char* lds, int layer) {
    const int tid = opaque_tid(), lane = tid & 63, wave = __builtin_amdgcn_readfirstlane(tid >> 6), q = lane & 15, g = lane >> 4;
    const bf16_t* proj = (const bf16_t*)(P.ws + WS_PROJ);
    LAS bf16_t* Ks = (LAS bf16_t*)lds;
    LAS bf16_t* Vs = (LAS bf16_t*)(lds + 18432);
    LAS bf16_t* Rf = (LAS bf16_t*)(lds + 36864);
    LAS bf16_t* Rb = (LAS bf16_t*)(lds + 46080);
    int u = blockIdx.x; if (u >= 1536) return;
    RetBRegs R; retB_load(P, u, tid, R);
    for (; u < 1536; u += gridDim.x) {
        const int bh = u >> 5, n = u & 31, b = bh / 6, h = bh % 6;
        const float lg = ret_logg(h);
        {
            const int c = tid >> 2, qd = tid & 3, e = tid >> 3, d8 = (tid & 7) * 8;
            *(LAS u32x4*)(Ks + c * 72 + qd * 16) = R.k0; *(LAS u32x4*)(Ks + c * 72 + qd * 16 + 8) = R.k1;
            *(LAS u32x4*)(Vs + c * 72 + qd * 16) = R.v0; *(LAS u32x4*)(Vs + c * 72 + qd * 16 + 8) = R.v1;
            *(LAS u32x4*)(Rf + e * 72 + d8) = R.rf; *(LAS u32x4*)(Rb + e * 72 + d8) = R.rb;
        }
        const u32x4 qraw[2] = {R.q0, R.q1};
        __syncthreads();
        if (u + (int)gridDim.x < 1536) retB_load(P, u + gridDim.x, tid, R);
        const int i = 16 * wave + q; const size_t tok = (size_t)(b * SEQ + n * 128 + i);
        u32x2 rgv[4]; f32x4 gnv[4];
#pragma unroll
        for (int et = 0; et < 4; ++et) { rgv[et] = *(const u32x2*)(proj + tok * INW + C_RG + h * 64 + et * 16 + 4 * g); gnv[et] = *(const f32x4*)(P.ret_gn + layer * 384 + h * 64 + et * 16 + 4 * g); }
        bf16x8 qf[2], qff[2], qfb[2];
        {
            const float ff = __expf(lg * (float)(i + 1)), fb = __expf(lg * (float)(128 - i));
#pragma unroll
            for (int kk = 0; kk < 2; ++kk) { const u32x4 raw = qraw[kk];
                qf[kk] = __builtin_bit_cast(bf16x8, raw); u32x4 a, c2;
#pragma unroll
                for (int e = 0; e < 4; ++e) { const float lo = bflo(raw[e]), hi = bfhi(raw[e]); a[e] = pk2(lo * ff, hi * ff); c2[e] = pk2(lo * fb, hi * fb); }
                qff[kk] = __builtin_bit_cast(bf16x8, a); qfb[kk] = __builtin_bit_cast(bf16x8, c2); }
        }
        bf16x4 pt[8];
#pragma unroll
        for (int jt = 0; jt < 8; ++jt) {
            f32x4 acc = {0.f, 0.f, 0.f, 0.f};
#pragma unroll
            for (int kk = 0; kk < 2; ++kk) { const bf16x8 a = *(const LAS bf16x8*)(Ks + (16 * jt + q) * 72 + kk * 32 + 8 * g); acc = MFMA32(a, qf[kk], acc); }
#pragma unroll
            for (int jj = 0; jj < 4; ++jj) { int dd = i - (16 * jt + 4 * g + jj); dd = dd < 0 ? -dd : dd; acc[jj] = acc[jj] * 0.125f * __expf(lg * (float)dd); }
            pt[jt] = pk4(acc);
        }
        f32x4 o[4];
#pragma unroll
        for (int et = 0; et < 4; ++et) {
            f32x4 acc = {0.f, 0.f, 0.f, 0.f};
#pragma unroll
            for (int jt = 0; jt < 8; ++jt) { const bf16x4 a = tr4(Vs, 72, 16 * jt, et * 16, g, q); acc = MFMA16(a, pt[jt], acc); }
#pragma unroll
            for (int kk = 0; kk < 2; ++kk) { const bf16x8 a = *(const LAS bf16x8*)(Rf + (et * 16 + q) * 72 + kk * 32 + 8 * g); acc = MFMA32(a, qff[kk], acc);
                const bf16x8 a2 = *(const LAS bf16x8*)(Rb + (et * 16 + q) * 72 + kk * 32 + 8 * g); acc = MFMA32(a2, qfb[kk], acc); }
            o[et] = acc;
        }
        float s = 0.f;
#pragma unroll
        for (int et = 0; et < 4; ++et) s += (o[et][0] + o[et][1]) + (o[et][2] + o[et][3]);
        s += __shfl_xor(s, 16); s += __shfl_xor(s, 32);
        const float mu = s * (1.0f / 64.0f); float vs = 0.f;
#pragma unroll
        for (int et = 0; et < 4; ++et) { o[et] = o[et] - mu; vs += (o[et][0] * o[et][0] + o[et][1] * o[et][1]) + (o[et][2] * o[et][2] + o[et][3] * o[et][3]); }
        vs += __shfl_xor(vs, 16); vs += __shfl_xor(vs, 32);
        const float rstd = rsqrtf(vs * (1.0f / 64.0f) + NORM_EPS);
        bf16_t* mixed = (bf16_t*)(P.ws + WS_HBUF) + tok * DM + 384 + h * 64;
#pragma unroll
        for (int et = 0; et < 4; ++et) {
            const f32x4 gn = gnv[et]; const u32x2 rg = rgv[et];
            f32x4 y; y[0] = o[et][0] * rstd * gn[0] * siluf(bflo(rg.x)); y[1] = o[et][1] * rstd * gn[1] * siluf(bfhi(rg.x));
            y[2] = o[et][2] * rstd * gn[2] * siluf(bflo(rg.y)); y[3] = o[et][3] * rstd * gn[3] * siluf(bfhi(rg.y));
            *(bf16x4*)(mixed + et * 16 + 4 * g) = pk4(y);
        }
        __syncthreads();
    }
}
__device__ __forceinline__ void hgrn_gate(float z, float lbv, float& f, float& kk) {
    z = fminf(fmaxf(z, -30.f), 30.f);
    const float ez = __expf(-z), sg = __builtin_amdgcn_rcpf(1.0f + ez);
    f = lbv + (1.0f - lbv) * sg; kk = (1.0f - lbv) * ez * sg;
}
__device__ __forceinline__ void hgA_unit(const Params& P, LAS unsigned char* lds, int u, int layer) {
    const int tid = opaque_tid(), lane = tid & 63, wave = __builtin_amdgcn_readfirstlane(tid >> 6), q = lane & 15, g = lane >> 4;
    const int bh = u >> 5, n = u & 31, b = bh >> 2, h = bh & 3;
    const bf16_t* proj = (const bf16_t*)(P.ws + WS_PROJ);
    LAS bf16_t* Kr = (LAS bf16_t*)lds;
    LAS bf16_t* Vs = (LAS bf16_t*)(lds + 36864);
    LAS float* segs = (LAS float*)(lds + 55296);
    const size_t tokc = (size_t)(b * SEQ + n * 128);
    {
        const int c = tid >> 2, qd = tid & 3; const bf16_t* src = proj + (tokc + c) * INW + C_HI + h * 64 + qd * 16;
        const u32x4 v0 = *(const u32x4*)src, v1 = *(const u32x4*)(src + 8);
        *(LAS u32x4*)(Vs + c * 72 + qd * 16) = v0; *(LAS u32x4*)(Vs + c * 72 + qd * 16 + 8) = v1;
    }
    const int d = tid & 63, dir = (tid >> 6) & 1, seg = tid >> 7;
    const float lbv = ((const float*)(P.ws + WS_LB))[layer * 256 + h * 64 + d];
    float lf[32], kk[32];
    {
        const bf16_t* zp = proj + (tokc + seg * 32) * INW + (dir ? C_HZB : C_HZF) + h * 64 + d;
        bf16_t zr[32];
#pragma unroll
        for (int i = 0; i < 32; ++i) zr[i] = zp[(size_t)i * INW];
#pragma unroll
        for (int i = 0; i < 32; ++i) hgrn_gate(bf2f(zr[i]), lbv, lf[i], kk[i]);
    }
    float ssum = 1.f;
#pragma unroll
    for (int i = 0; i < 32; ++i) ssum *= lf[i];
    segs[(dir * 4 + seg) * 64 + d] = ssum;
    __syncthreads();
    {
        float before = 1.f, after = 1.f;
#pragma unroll
        for (int s2 = 0; s2 < 4; ++s2) { const float v = segs[(dir * 4 + s2) * 64 + d]; if (s2 < seg) before *= v; if (s2 > seg) after *= v; }
        LAS bf16_t* kt = Kr + dir * (128 * 72) + (seg * 32) * 72 + d;
        if (dir == 0) {
            float run = after;
#pragma unroll
            for (int i = 31; i >= 0; --i) { kt[i * 72] = f2bf(kk[i] * run); run *= lf[i]; }
        } else {
            float run = before;
#pragma unroll
            for (int i = 0; i < 32; ++i) { kt[i * 72] = f2bf(kk[i] * run); run *= lf[i]; }
        }
        if (seg == 0) ((float*)(P.ws + WS_HGA))[((size_t)(bh * 2 + dir) * 32 + n) * 64 + d] = ssum * after;
    }
    __syncthreads();
    {
        const int wdir = wave >> 2, dt = wave & 3; const LAS bf16_t* krs = Kr + wdir * (128 * 72);
        bf16x8 afr[4];
#pragma unroll
        for (int kq = 0; kq < 4; ++kq) afr[kq] = tr8(krs, 72, kq * 32, dt * 16, g, q);
        float* dst = (float*)(P.ws + WS_HGU) + ((size_t)(bh * 2 + wdir) * 32 + n) * 4096;
#pragma unroll
        for (int et = 0; et < 4; ++et) {
            f32x4 acc = {0.f, 0.f, 0.f, 0.f};
#pragma unroll
            for (int kq = 0; kq < 4; ++kq) { const bf16x8 bfr = tr8(Vs, 72, kq * 32, et * 16, g, q); acc = MFMA32(afr[kq], bfr, acc); }
#pragma unroll
            for (int j = 0; j < 4; ++j) dst[(dt * 16 + 4 * g + j) * 64 + et * 16 + q] = acc[j];
        }
    }
    __syncthreads();
}
__device__ __forceinline__ void hg_scan(const Params& P) {
    float* U = (float*)(P.ws + WS_HGU); const float* A = (const float*)(P.ws + WS_HGA);
    const int nthr = gridDim.x * NTHREADS; int it0 = blockIdx.x * NTHREADS + opaque_tid() - 48 * 2 * 512; if (it0 < 0) it0 += nthr;
    for (int it = it0; it < 64 * 64 * 16; it += nthr) {
        const int e4 = it & 15, d = (it >> 4) & 63, bd = it >> 10, dir = bd & 1;
        f32x4 s = {0.f, 0.f, 0.f, 0.f};
        for (int i0 = 0; i0 < 32; i0 += 8) {
            f32x4 v[8]; float a[8];
#pragma unroll
            for (int i = 0; i < 8; ++i) { const int n = dir ? 31 - (i0 + i) : (i0 + i); v[i] = *(const f32x4*)(U + ((size_t)(bd * 32 + n) * 64 + d) * 64 + 4 * e4); a[i] = A[(size_t)(bd * 32 + n) * 64 + d]; }
#pragma unroll
            for (int i = 0; i < 8; ++i) { const int n = dir ? 31 - (i0 + i) : (i0 + i); *(f32x4*)(U + ((size_t)(bd * 32 + n) * 64 + d) * 64 + 4 * e4) = s; s = s * a[i] + v[i]; }
        }
    }
}
__device__ __forceinline__ unsigned pk2h(float lo, float hi) { return pk2(lo, hi); }
__device__ __forceinline__ bf16x4 pk4h(f32x4 v) { return pk4(v); }
__device__ __forceinline__ void hgB_unit(const Params& P, LAS unsigned char* lds, int u, int layer) {
    const int tid = opaque_tid(), lane = tid & 63, wave = __builtin_amdgcn_readfirstlane(tid >> 6), q = lane & 15, g = lane >> 4;
    const int b = u >> 5, n = u & 31, h = wave >> 1, dir = wave & 1, bh = b * 4 + h;
    bf16_t* proj = (bf16_t*)(P.ws + WS_PROJ);
    bf16_t* mixed = (bf16_t*)(P.ws + WS_HBUF);
    LAS unsigned char* wl = lds + wave * 7168;
    LAS bf16_t* Qi = (LAS bf16_t*)wl;
    LAS bf16_t* Ki = (LAS bf16_t*)(wl + 2304);
    LAS bf16_t* Vs = (LAS bf16_t*)(wl + 4608);
    LAS float* Al = (LAS float*)(wl + 6912);
    const size_t tokc = (size_t)(b * SEQ + n * 128);
    const float lbv = ((const float*)(P.ws + WS_LB))[layer * 256 + h * 64 + lane];
    f32x4 S[4][4];
    {
        const float* sp = (const float*)(P.ws + WS_HGU) + ((size_t)(bh * 2 + dir) * 32 + n) * 4096;
#pragma unroll
        for (int dt = 0; dt < 4; ++dt)
#pragma unroll
            for (int et = 0; et < 4; ++et)
#pragma unroll
                for (int j = 0; j < 4; ++j) S[dt][et][j] = sp[(dt * 16 + 4 * g + j) * 64 + et * 16 + q];
    }
    bf16_t* odst = dir ? (proj + C_AQ + h * 64) : (mixed + 768 + h * 64); const size_t opitch = dir ? INW : DM;
    bf16_t qr[16], zz[16]; u32x4 v0, v1;
#define HGB_LOAD(SC) do { const size_t toks_ = tokc + (SC) * 16; const bf16_t* base_ = proj + toks_ * INW + h * 64 + lane; \
        _Pragma("unroll") for (int ii = 0; ii < 16; ++ii) { const int t_ = dir ? 15 - ii : ii; qr[ii] = base_[(size_t)t_ * INW + C_HQ]; zz[ii] = base_[(size_t)t_ * INW + (dir ? C_HZB : C_HZF)]; } \
        const bf16_t* vsrc_ = proj + (toks_ + (lane >> 2)) * INW + C_HI + h * 64 + (lane & 3) * 16; v0 = *(const u32x4*)vsrc_; v1 = *(const u32x4*)(vsrc_ + 8); } while (0)
    HGB_LOAD(dir ? 7 : 0);
    for (int i = 0; i < 8; ++i) {
        const int sc = dir ? 7 - i : i; const size_t toks = tokc + sc * 16;
        {
            *(LAS u32x4*)(Vs + (lane >> 2) * 72 + (lane & 3) * 16) = v0; *(LAS u32x4*)(Vs + (lane >> 2) * 72 + (lane & 3) * 16 + 8) = v1;
            float bp = 1.f;
#pragma unroll
            for (int ii = 0; ii < 16; ++ii) {
                const int t = dir ? 15 - ii : ii;
                float f, kk; hgrn_gate(bf2f(zz[ii]), lbv, f, kk); const float qv = siluf(bf2f(qr[ii]));
                bp *= f;
                Qi[t * 72 + lane] = f2bf(qv * bp); Ki[t * 72 + lane] = f2bf(kk * __builtin_amdgcn_rcpf(fmaxf(bp, 1.0e-30f)));
            }
            Al[lane] = bp;
        }
        if (i + 1 < 8) HGB_LOAD(dir ? 6 - i : i + 1);
        __builtin_amdgcn_fence(__ATOMIC_RELEASE, "wavefront"); __builtin_amdgcn_wave_barrier(); __builtin_amdgcn_fence(__ATOMIC_ACQUIRE, "wavefront");
        f32x4 at = {0.f, 0.f, 0.f, 0.f};
#pragma unroll
        for (int kq = 0; kq < 2; ++kq) { const bf16x8 a8 = *(const LAS bf16x8*)(Ki + q * 72 + kq * 32 + 8 * g), b8 = *(const LAS bf16x8*)(Qi + q * 72 + kq * 32 + 8 * g); at = MFMA32(a8, b8, at); }
#pragma unroll
        for (int j = 0; j < 4; ++j) { const int sl = 4 * g + j; const bool keep = dir ? (sl >= q) : (sl <= q); at[j] = keep ? at[j] : 0.f; }
        const bf16x4 p4 = pk4h(at);
        bf16x4 b4[4], v4[4];
#pragma unroll
        for (int dt = 0; dt < 4; ++dt) b4[dt] = *(const LAS bf16x4*)(Qi + q * 72 + dt * 16 + 4 * g);
#pragma unroll
        for (int et = 0; et < 4; ++et) v4[et] = tr4(Vs, 72, 0, et * 16, g, q);
#pragma unroll
        for (int et = 0; et < 4; ++et) {
            f32x4 o = {0.f, 0.f, 0.f, 0.f};
#pragma unroll
            for (int dt = 0; dt < 4; ++dt) o = MFMA16(pk4h(S[dt][et]), b4[dt], o);
            o = MFMA16(v4[et], p4, o);
            *(bf16x4*)(odst + (toks + q) * opitch + et * 16 + 4 * g) = pk4(o);
        }
#pragma unroll
        for (int dt = 0; dt < 4; ++dt) {
            const bf16x4 kT4 = tr4(Ki, 72, 0, dt * 16, g, q);
            const f32x4 al4 = *(const LAS f32x4*)(Al + dt * 16 + 4 * g);
#pragma unroll
            for (int et = 0; et < 4; ++et) { const f32x4 s2 = MFMA16(kT4, v4[et], S[dt][et]); S[dt][et] = s2 * al4; }
        }
        __builtin_amdgcn_fence(__ATOMIC_RELEASE, "wavefront"); __builtin_amdgcn_wave_barrier(); __builtin_amdgcn_fence(__ATOMIC_ACQUIRE, "wavefront");
    }
    asm volatile("s_waitcnt vmcnt(0)" ::: "memory");
    __syncthreads();
    {
        const int tau = tid >> 2, qd = tid & 3;
        bf16_t* mp = mixed + (tokc + tau) * DM + 768 + qd * 64; const bf16_t* bp2 = proj + (tokc + tau) * INW + C_AQ + qd * 64;
        const bf16_t* gp = proj + (tokc + tau) * INW + C_HG + qd * 64; const float* gn = P.hgrn_gn + layer * 256 + qd * 64;
        float o[64]; float sq = 0.f;
#pragma unroll
        for (int c4 = 0; c4 < 16; ++c4) {
            const unsigned long long fv = __hip_atomic_load((const unsigned long long*)(mp + c4 * 4), __ATOMIC_RELAXED, __HIP_MEMORY_SCOPE_AGENT), bv = __hip_atomic_load((const unsigned long long*)(bp2 + c4 * 4), __ATOMIC_RELAXED, __HIP_MEMORY_SCOPE_AGENT);
            const unsigned f0 = (unsigned)fv, f1 = (unsigned)(fv >> 32), b0 = (unsigned)bv, b1 = (unsigned)(bv >> 32);
            const float x0 = bflo(f0) + bflo(b0), x1 = bfhi(f0) + bfhi(b0), x2 = bflo(f1) + bflo(b1), x3 = bfhi(f1) + bfhi(b1);
            o[c4 * 4 + 0] = x0; o[c4 * 4 + 1] = x1; o[c4 * 4 + 2] = x2; o[c4 * 4 + 3] = x3; sq += (x0 * x0 + x1 * x1) + (x2 * x2 + x3 * x3); }
        sq += __shfl_xor(sq, 1); sq += __shfl_xor(sq, 2);
        const float rstd = rsqrtf(sq * (1.0f / 256.0f) + NORM_EPS);
#pragma unroll
        for (int c8 = 0; c8 < 8; ++c8) {
            const u32x4 gv = *(const u32x4*)(gp + c8 * 8); const f32x4 g0 = *(const f32x4*)(gn + c8 * 8), g1 = *(const f32x4*)(gn + c8 * 8 + 4);
            u32x4 r;
            r.x = pk2h(o[c8 * 8 + 0] * rstd * g0[0] * siluf(bflo(gv.x)), o[c8 * 8 + 1] * rstd * g0[1] * siluf(bfhi(gv.x)));
            r.y = pk2h(o[c8 * 8 + 2] * rstd * g0[2] * siluf(bflo(gv.y)), o[c8 * 8 + 3] * rstd * g0[3] * siluf(bfhi(gv.y)));
            r.z = pk2h(o[c8 * 8 + 4] * rstd * g1[0] * siluf(bflo(gv.z)), o[c8 * 8 + 5] * rstd * g1[1] * siluf(bfhi(gv.z)));
            r.w = pk2h(o[c8 * 8 + 6] * rstd * g1[2] * siluf(bflo(gv.w)), o[c8 * 8 + 7] * rstd * g1[3] * siluf(bfhi(gv.w)));
            *(u32x4*)(mp + c8 * 8) = r;
        }
    }
    __syncthreads();
}
constexpr int N_PHASES = 20;
#ifndef PROBE_MASK
#define PROBE_MASK 0u
#endif
#ifndef PROBE_U
#define PROBE_U 0
#endif
#ifndef STAGGER
#define STAGGER 0
#endif
#ifndef STAGGER_TICKS
#define STAGGER_TICKS 1000u
#endif
#ifndef GEMM_SP2
#define GEMM_SP2 true
#endif
#ifndef GEMM_ALIGN
#define GEMM_ALIGN true
#endif
#ifndef PROBE_SYNC2
#define PROBE_SYNC2 0
#endif
__device__ __forceinline__ void stagger_half(unsigned ticks) {
#if STAGGER
    if ((blockIdx.x >> 3) & 1) { const unsigned long long t0 = __builtin_amdgcn_s_memrealtime(); while (__builtin_amdgcn_s_memrealtime() - t0 < ticks) __builtin_amdgcn_s_sleep(32); }
    __syncthreads();
#endif
}
__device__ __forceinline__ void run_phase(const Params& P, LAS unsigned char* lds, int ph) {
    unsigned char* ws = P.ws;
    if (ph == 0) { phase_prologue(P, lds); return; }
    if (ph == N_PHASES - 1) { const float* ml = (const float*)(ws + WS_MOD) + (size_t)(DEPTH - 1) * NBATCH * NMOD * DM;
        phase_norm<2, false, true>(P.out, (const bf16_t*)(ws + WS_OB), ml + 2 * DM, (const bf16_t*)(ws + WS_HBUF), ml + 5 * DM, P.out, P.g_final, nullptr, nullptr, nullptr); return; }
    const int l = (ph - 1) / 9, s = (ph - 1) % 9;
    const float* mod = (const float*)(ws + WS_MOD) + (size_t)l * NBATCH * NMOD * DM; const float* modp = mod - (size_t)NBATCH * NMOD * DM;
    const float* xprev = (l == 1) ? P.x : P.out;
    bf16_t* hbuf = (bf16_t*)(ws + WS_HBUF); bf16_t* proj = (bf16_t*)(ws + WS_PROJ); bf16_t* ybuf = (bf16_t*)(ws + WS_OB);
#ifdef PH_ONLY
    if (s != PH_ONLY) return;
#endif
    int kD = DM, kF = FFN; asm volatile("" : "+s"(kD), "+s"(kF));
    switch (s) {
    case 0: if (l == 0) { phase_norm<0, false, false>(P.x, nullptr, nullptr, nullptr, nullptr, nullptr, P.g_mix, mod + 0 * DM, mod + 1 * DM, hbuf); phase_weights(P, lds); }
            else phase_norm<2, true, false>(xprev, ybuf, modp + 2 * DM, hbuf, modp + 5 * DM, P.out, P.g_mix + l * DM, mod + 0 * DM, mod + 1 * DM, hbuf);
            break;
    case 1: { pg8::Gemm g{hbuf, (const bf16_t*)(ws + WS_WIN) + (size_t)l * INWP * DM, NTOK, INWP, kD}; pg8::StaticOrder S; S.init(NTOK, INWP, gridDim.x, blockIdx.x);
              EpiProj E{proj, INW, INW}; pg8::gemm_phase<EpiProj, pg8::StaticOrder, GEMM_ALIGN, GEMM_SP2>(lds, g, S, E); } break;
    case 2: { for (int rp = 0; rp < (PROBE_U == 1 ? 2 : 1); ++rp) att_phase(P, lds);
              for (int rp = 0; rp < (PROBE_U == 2 ? 2 : 1); ++rp) retA_phase(P, lds);
              for (int rp = 0; rp < (PROBE_U == 3 ? 2 : 1); ++rp) for (int u = blockIdx.x; u < 1024; u += gridDim.x) hgA_unit(P, lds, u, l); } break;
    case 3: { ret_scan(P); hg_scan(P); } break;
    case 4: { for (int rp = 0; rp < (PROBE_U == 4 ? 2 : 1); ++rp) for (int u = blockIdx.x; u < 256; u += gridDim.x) hgB_unit(P, lds, u, l);
              for (int rp = 0; rp < (PROBE_U == 5 ? 2 : 1); ++rp) retB_phase(P, lds, l); att_merge(P); } break;
    case 5: { pg8::Gemm g{hbuf, (const bf16_t*)(ws + WS_WOUT) + (size_t)l * DM * DM, NTOK, DM, kD}; pg8::StaticOrder S; S.init(NTOK, DM, gridDim.x, blockIdx.x);
              EpiProj E{ybuf, DM, DM}; pg8::gemm_phase<EpiProj, pg8::StaticOrder, GEMM_ALIGN, GEMM_SP2>(lds, g, S, E); } break;
    case 6: phase_norm<1, false, false>(l == 0 ? P.x : P.out, ybuf, mod + 2 * DM, nullptr, nullptr, nullptr, P.g_ffn + l * DM, mod + 3 * DM, mod + 4 * DM, hbuf); break;
    case 7: { pg8::Gemm g{hbuf, (const bf16_t*)(ws + WS_WGU) + (size_t)l * 2 * FFN * DM, NTOK, 2 * FFN, kD}; pg8::StaticOrder S; S.init(NTOK, 2 * FFN, gridDim.x, blockIdx.x);
              EpiSwiglu E{proj}; pg8::gemm_phase<EpiSwiglu, pg8::StaticOrder, GEMM_ALIGN, GEMM_SP2>(lds, g, S, E); } break;
    case 8: { pg8::Gemm g{proj, (const bf16_t*)(ws + WS_WDN) + (size_t)l * DM * FFN, NTOK, DM, kF}; pg8::StaticOrder S; S.init(NTOK, DM, gridDim.x, blockIdx.x);
              EpiProj E{hbuf, DM, DM}; pg8::gemm_phase<EpiProj, pg8::StaticOrder, GEMM_ALIGN, GEMM_SP2>(lds, g, S, E); } break;
    }
}
__global__ void __launch_bounds__(NTHREADS) hybrid_fwd(Params P) {
    extern __shared__ __attribute__((aligned(16))) unsigned char lds_raw[];
    __shared__ uint4 xb_words;
    LAS unsigned char* lds = (LAS unsigned char*)lds_raw;
    if (threadIdx.x == 0) xb_words = make_uint4(0u, 0u, 0u, 0u);
    __syncthreads();
    XcdBarrier bar = xcd_barrier_post((unsigned*)(P.ws + WS_CTL), (volatile LAS unsigned*)&xb_words);
    for (int ph = P.ph_lo; ph < P.ph_hi; ++ph) {
        const int reps = ((PROBE_MASK >> ph) & 1u) ? 2 : 1;
        for (int rep = 0; rep < reps; ++rep) { run_phase(P, lds, ph); if (rep + 1 < reps) __syncthreads(); }
        if (ph + 1 < P.ph_hi) {
            if (P.ph_hi > N_PHASES) cg::this_grid().sync(); else xcd_barrier(bar);
            if (PROBE_SYNC2) xcd_barrier(bar);
        }
    }
}

extern "C" void kernel_launch(void* const* d_in, const int* in_sizes, int n_in, void* d_out, int out_size, void* d_ws, size_t ws_size, hipStream_t stream) {
    static int grid = 0;
    if (grid == 0) {
        if (n_in != 14 || out_size != NTOK * DM || ws_size < WS_END) { fprintf(stderr, "kernel_launch: unexpected shapes (n_in %d out %d ws %zu need %zu)\n", n_in, out_size, ws_size, (size_t)WS_END); grid = -1; return; }
        int dev = 0, cus = 0, per_cu = 0;
        hipGetDevice(&dev); hipDeviceGetAttribute(&cus, hipDeviceAttributeMultiprocessorCount, dev);
        if (hipFuncSetAttribute((const void*)hybrid_fwd, hipFuncAttributeMaxDynamicSharedMemorySize, LDS_BYTES) != hipSuccess) { fprintf(stderr, "kernel_launch: hipFuncSetAttribute failed\n"); grid = -1; return; }
        if (hipOccupancyMaxActiveBlocksPerMultiprocessor(&per_cu, (const void*)hybrid_fwd, NTHREADS, LDS_BYTES) != hipSuccess || per_cu < 1) { fprintf(stderr, "kernel_launch: occupancy query says %d\n", per_cu); grid = -1; return; }
        grid = cus;
    }
    if (grid < 0) return;
    if (hipMemsetAsync((char*)d_ws + WS_CTL, 0, 16384, stream) != hipSuccess) { fprintf(stderr, "kernel_launch: memset failed\n"); return; }
    Params p{};
    p.x = (const float*)d_in[0]; p.c = (const float*)d_in[1]; p.w_ada = (const float*)d_in[2]; p.b_ada = (const float*)d_in[3]; p.g_mix = (const float*)d_in[4];
    p.w_in = (const float*)d_in[5]; p.ret_gn = (const float*)d_in[6]; p.hgrn_gn = (const float*)d_in[7]; p.lb_logits = (const float*)d_in[8]; p.w_out = (const float*)d_in[9];
    p.g_ffn = (const float*)d_in[10]; p.w_gu = (const float*)d_in[11]; p.w_down = (const float*)d_in[12]; p.g_final = (const float*)d_in[13];
    p.out = (float*)d_out; p.ws = (unsigned char*)d_ws;
#if ONE_LAUNCH
    p.ph_lo = 0; p.ph_hi = N_PHASES;
    void* args[] = {&p};
    hipError_t e = hipLaunchCooperativeKernel((const void*)hybrid_fwd, dim3(grid), dim3(NTHREADS), args, LDS_BYTES, stream);
    if (e != hipSuccess) fprintf(stderr, "cooperative launch failed: %s (grid %d)\n", hipGetErrorString(e), grid);
#else
    for (int ph = 0; ph < N_PHASES; ++ph) { p.ph_lo = ph; p.ph_hi = ph + 1; hipLaunchKernelGGL(hybrid_fwd, dim3(grid), dim3(NTHREADS), LDS_BYTES, stream, p); }
#endif
}
```

```cpp
#include <hip/hip_runtime.h>
#include <hip/hip_cooperative_groups.h>
#include <cstdio>
#include <cstdint>
namespace cg = cooperative_groups;
#ifndef ONE_LAUNCH
#define ONE_LAUNCH 1
#endif
__device__ __forceinline__ int opaque_tid() { int t = threadIdx.x; asm volatile("" : "+v"(t)); return t; }
#define LAS __attribute__((address_space(3)))
namespace pg8 {
#define PG8_LAS __attribute__((address_space(3)))
typedef unsigned short bf16_t;
typedef short bf16x8 __attribute__((ext_vector_type(8)));
typedef float f32x4 __attribute__((ext_vector_type(4)));
typedef unsigned u32x4 __attribute__((ext_vector_type(4)));
constexpr int BM = 256, BK = 64, HALF = 128, HTB = HALF * BK * 2  , STAGE_BYTES = 8 * HTB, NXCD = 8, WGM = 8;

__host__ __device__ __forceinline__ int lds_byte(int r, int c) { const int st = (r >> 4) * 2 + (c >> 5), rr = r & 15, cc = c & 31, ob = rr * 64 + cc * 2; return st * 1024 + (ob ^ (((ob >> 9) & 1) << 5)); }
__host__ __device__ __forceinline__ void stage_rc(int b, int& R, int& C) { const int st = b / 1024, sb = b % 1024, swz = sb ^ (((sb >> 9) & 1) << 5); R = (st >> 1) * 16 + swz / 64; C = (st & 1) * 32 + (swz % 64) / 2; }
__host__ __device__ __forceinline__ int perm32(int rho) { const int n = rho >> 4, i = rho & 15; return 8 * (i >> 2) + 4 * n + (i & 3); }

struct Unit { int pm, pn; };
struct Gemm { const bf16_t* A; const bf16_t* Bt; int M, N, K; };

struct StaticOrder {
    int nM, nN, nwg, G, c;
    __host__ __device__ void init(int M, int N, int G_, int c_) { nM = M / BM; nN = N / BM; nwg = nM * nN; G = G_; c = c_; }
    __host__ __device__ bool next(int i, Unit& u) const {
        const long L = (long)i * G + c; if (L >= nwg) return false;
        int wgid = (int)L; { const int q = nwg / NXCD, r = nwg % NXCD, xcd = wgid % NXCD, off = wgid / NXCD; wgid = (xcd < r ? xcd * (q + 1) : r * (q + 1) + (xcd - r) * q) + off; }
        const int nig = WGM * nN, gid = wgid / nig, fm = gid * WGM, gsz = (nM - fm) < WGM ? (nM - fm) : WGM;
        u.pm = fm + ((wgid % nig) % gsz); u.pn = (wgid % nig) / gsz; return true;
    }
    __device__ __forceinline__ void a_ready(const Unit&) const {}
    __device__ __forceinline__ void done(const Unit&) const {}
};
__device__ __forceinline__ unsigned cvt_pk_bf16(float lo, float hi) { unsigned r; asm volatile("v_cvt_pk_bf16_f32 %0, %1, %2" : "=v"(r) : "v"(lo), "v"(hi)); return r; }
typedef float f32x2 __attribute__((ext_vector_type(2)));
template <class Epi, class Sched, bool ALIGN_EPI = false, bool SP2 = false>
__device__ __forceinline__ void gemm_phase(PG8_LAS unsigned char* lds, const Gemm g, const Sched& S, const Epi& E) {
    const int tid = opaque_tid(), wid = __builtin_amdgcn_readfirstlane(tid >> 6), lane = tid & 63, wr = wid >> 2, wc = wid & 3, fr = lane & 15, fq = lane >> 4;
    const int K = g.K, nt = K / BK;
    unsigned voffA[2], voffB[2];
#pragma unroll
    for (int i = 0; i < 2; ++i) { int R, C; stage_rc(tid * 16 + i * 8192, R, C); const int Rb = Epi::PERM ? ((R & ~31) + perm32(R & 31)) : R;
        voffA[i] = (unsigned)(R * K + C) * 2u; voffB[i] = (unsigned)(Rb * K + C) * 2u; }
    const size_t kstep = (size_t)(BK * 2);
    const size_t hstep = (size_t)HALF * K * 2;
    const size_t tstep = 2 * hstep;
    const unsigned ldsw = (unsigned)wid * 1024u;
    const int aoff = lds_byte(wr * 64 + fr, fq * 8), boff = lds_byte(wc * 32 + fr, fq * 8);
#define PG8_SA(b, h) (((b) * 2 + (h)) * HTB)
#define PG8_SB(b, h) ((4 + (b) * 2 + (h)) * HTB)
#define PG8_STAGE(bufoff, gbase, voff) do { _Pragma("unroll") for (int _i = 0; _i < 2; ++_i) \
        __builtin_amdgcn_global_load_lds((const unsigned*)((const char*)(gbase) + (voff)[_i]), (PG8_LAS unsigned*)(lds + (bufoff) + ldsw + _i * 8192), 16, 0, 0); } while (0)
#define PG8_LDA(dst, b, h) do { _Pragma("unroll") for (int m = 0; m < 4; ++m) _Pragma("unroll") for (int k = 0; k < 2; ++k) dst[m][k] = *(const PG8_LAS bf16x8*)(lds + PG8_SA(b, h) + aoff + m * 2048 + k * 1024); } while (0)
#define PG8_LDB(dst, b, h) do { _Pragma("unroll") for (int n = 0; n < 2; ++n) _Pragma("unroll") for (int k = 0; k < 2; ++k) dst[n][k] = *(const PG8_LAS bf16x8*)(lds + PG8_SB(b, h) + boff + n * 2048 + k * 1024); } while (0)
#define PG8_MMA(ai, bj, At, Bt) do { __builtin_amdgcn_s_setprio(1); _Pragma("unroll") for (int m = 0; m < 4; ++m) _Pragma("unroll") for (int n = 0; n < 2; ++n) _Pragma("unroll") for (int k = 0; k < 2; ++k) \
        acc[ai][bj][m][n] = __builtin_amdgcn_mfma_f32_16x16x32_bf16(Bt[n][k], At[m][k], acc[ai][bj][m][n], 0, 0, 0); __builtin_amdgcn_s_setprio(0); } while (0)
#define PG8_WAIT_V(n) asm volatile("s_waitcnt vmcnt(" #n ")" ::: "memory")
#define PG8_WAIT_L(n) asm volatile("s_waitcnt lgkmcnt(" #n ")" ::: "memory")
#define PG8_BAR __builtin_amdgcn_s_barrier()
#define PG8_SCHED __builtin_amdgcn_sched_barrier(0)
    Unit cur, nxt; int ui = 0;
    if (!S.next(0, cur)) return;
    f32x4 acc[2][2][4][2];
#pragma unroll
    for (int a = 0; a < 2; ++a)
#pragma unroll
        for (int b = 0; b < 2; ++b)
#pragma unroll
            for (int m = 0; m < 4; ++m)
#pragma unroll
                for (int n = 0; n < 2; ++n) acc[a][b][m][n] = (f32x4){0.f, 0.f, 0.f, 0.f};
    bf16x8 At[4][2], B0[2][2], B1[2][2];
    const char* cA = (const char*)g.A + (size_t)cur.pm * tstep; const char* cB = (const char*)g.Bt + (size_t)cur.pn * tstep;
    S.a_ready(cur);
    if constexpr (SP2) {
        PG8_STAGE(PG8_SB(0, 0), cB, voffB); PG8_STAGE(PG8_SB(0, 1), cB + hstep, voffB); PG8_STAGE(PG8_SA(0, 0), cA, voffA); PG8_STAGE(PG8_SA(0, 1), cA + hstep, voffA);
        if (wr == 1) PG8_BAR;
        PG8_WAIT_V(2); PG8_BAR;
        PG8_STAGE(PG8_SB(1, 0), cB + kstep, voffB); PG8_STAGE(PG8_SA(1, 0), cA + kstep, voffA); PG8_STAGE(PG8_SB(1, 1), cB + hstep + kstep, voffB);
        PG8_WAIT_V(6); PG8_BAR;
    } else {
        PG8_STAGE(PG8_SB(0, 0), cB, voffB); PG8_STAGE(PG8_SA(0, 0), cA, voffA); PG8_STAGE(PG8_SB(0, 1), cB + hstep, voffB); PG8_STAGE(PG8_SA(0, 1), cA + hstep, voffA);
        if (wr == 1) PG8_BAR;
        PG8_WAIT_V(4); PG8_BAR;
        PG8_STAGE(PG8_SB(1, 0), cB + kstep, voffB); PG8_STAGE(PG8_SA(1, 0), cA + kstep, voffA); PG8_STAGE(PG8_SB(1, 1), cB + hstep + kstep, voffB);
        PG8_WAIT_V(6); PG8_BAR;
    }
    for (;;) {
        const bool has_next = S.next(ui + 1, nxt);
        const char* nA = has_next ? (const char*)g.A + (size_t)nxt.pm * tstep : cA; const char* nB = has_next ? (const char*)g.Bt + (size_t)nxt.pn * tstep : cB;
        for (int t = 0; t < nt; t += 2) {
            const bool last = (t == nt - 2);
            const char* a1 = cA + (size_t)(t + 1) * kstep;
            const char* a2 = last ? nA : cA + (size_t)(t + 2) * kstep; const char* b2 = last ? nB : cB + (size_t)(t + 2) * kstep;
            const char* a3 = a2 + kstep; const char* b3 = b2 + kstep;
            if (last && has_next) S.a_ready(nxt);
            if constexpr (SP2) {
            PG8_LDB(B0, 0, 0); PG8_LDB(B1, 0, 1); PG8_SCHED; PG8_LDA(At, 0, 0); PG8_STAGE(PG8_SA(1, 1), a1 + hstep, voffA);
            PG8_WAIT_V(8); PG8_WAIT_L(0); PG8_BAR; PG8_MMA(0, 0, At, B0); PG8_MMA(0, 1, At, B1); PG8_BAR; PG8_SCHED;
            PG8_LDA(At, 0, 1); PG8_STAGE(PG8_SB(0, 0), b2, voffB); PG8_STAGE(PG8_SB(0, 1), b2 + hstep, voffB); PG8_STAGE(PG8_SA(0, 0), a2, voffA);
            PG8_WAIT_V(8); PG8_WAIT_L(0); PG8_BAR; PG8_MMA(1, 0, At, B0); PG8_MMA(1, 1, At, B1); PG8_BAR; PG8_SCHED;
            PG8_LDB(B0, 1, 0); PG8_LDB(B1, 1, 1); PG8_SCHED; PG8_LDA(At, 1, 0); PG8_STAGE(PG8_SA(0, 1), a2 + hstep, voffA);
            PG8_WAIT_V(8); PG8_WAIT_L(0); PG8_BAR; PG8_MMA(0, 0, At, B0); PG8_MMA(0, 1, At, B1); PG8_BAR; PG8_SCHED;
            PG8_LDA(At, 1, 1); PG8_STAGE(PG8_SB(1, 0), b3, voffB); PG8_STAGE(PG8_SB(1, 1), b3 + hstep, voffB); PG8_STAGE(PG8_SA(1, 0), a3, voffA);
            PG8_WAIT_V(8); PG8_WAIT_L(0); PG8_BAR; PG8_MMA(1, 0, At, B0); PG8_MMA(1, 1, At, B1); PG8_BAR; PG8_SCHED;
            } else {
            PG8_LDB(B0, 0, 0); PG8_SCHED; PG8_LDA(At, 0, 0); PG8_STAGE(PG8_SA(1, 1), a1 + hstep, voffA);
            PG8_WAIT_L(8); PG8_BAR; PG8_WAIT_L(0); PG8_MMA(0, 0, At, B0); PG8_BAR; PG8_SCHED;
            PG8_LDB(B1, 0, 1); PG8_STAGE(PG8_SB(0, 0), b2, voffB);
            PG8_BAR; PG8_WAIT_L(0); PG8_MMA(0, 1, At, B1); PG8_BAR;
            PG8_LDA(At, 0, 1); PG8_STAGE(PG8_SA(0, 0), a2, voffA);
            PG8_BAR; PG8_WAIT_L(0); PG8_MMA(1, 0, At, B0); PG8_BAR; PG8_SCHED;
            PG8_STAGE(PG8_SB(0, 1), b2 + hstep, voffB);
            PG8_WAIT_V(6); PG8_BAR; PG8_MMA(1, 1, At, B1); PG8_BAR;
            PG8_LDB(B0, 1, 0); PG8_SCHED; PG8_LDA(At, 1, 0); PG8_STAGE(PG8_SA(0, 1), a2 + hstep, voffA);
            PG8_WAIT_L(8); PG8_BAR; PG8_WAIT_L(0); PG8_MMA(0, 0, At, B0); PG8_BAR; PG8_SCHED;
            PG8_LDB(B1, 1, 1); PG8_STAGE(PG8_SB(1, 0), b3, voffB);
            PG8_BAR; PG8_WAIT_L(0); PG8_MMA(0, 1, At, B1); PG8_BAR;
            PG8_LDA(At, 1, 1); PG8_STAGE(PG8_SA(1, 0), a3, voffA);
            PG8_BAR; PG8_WAIT_L(0); PG8_MMA(1, 0, At, B0); PG8_BAR; PG8_SCHED;
            PG8_STAGE(PG8_SB(1, 1), b3 + hstep, voffB);
            PG8_WAIT_V(6); PG8_BAR; PG8_MMA(1, 1, At, B1); PG8_BAR;
            }
        }
        if constexpr (ALIGN_EPI) { if (wr == 0) PG8_BAR; }
        if constexpr (!Epi::AFTER_DRAIN) { E(acc, cur, wr, wc, fr, fq); S.done(cur); }
        if (!has_next) break;
#pragma unroll
        for (int a = 0; a < 2; ++a)
#pragma unroll
            for (int b = 0; b < 2; ++b)
#pragma unroll
                for (int m = 0; m < 4; ++m)
#pragma unroll
                    for (int n = 0; n < 2; ++n) acc[a][b][m][n] = (f32x4){0.f, 0.f, 0.f, 0.f};
        cur = nxt; cA = nA; cB = nB; ++ui;
        if constexpr (ALIGN_EPI) { if (wr == 1) PG8_BAR; }
    }
    PG8_WAIT_V(0);
    if constexpr (!ALIGN_EPI) { if (wr == 0) PG8_BAR; }
    PG8_BAR;
    if constexpr (Epi::AFTER_DRAIN) { E.fused(acc, cur, wr, wc, fr, fq, lds, wid, lane); S.done(cur); }
#undef PG8_SA
#undef PG8_SB
#undef PG8_STAGE
#undef PG8_LDA
#undef PG8_LDB
#undef PG8_MMA
#undef PG8_WAIT_V
#undef PG8_WAIT_L
#undef PG8_BAR
#undef PG8_SCHED
}
}

#define XB_TMO      128
#define XB_XCNT(j)  (256  + 64 * (j))
#define XB_XSUB(j)  (1280 + 64 * (j))
#define XB_XGEN(j)  (2304 + 64 * (j))
#define XB_TOP      3328
#define XB_TOPGEN   3392
#define XCD_BAR_WORDS 3456
#define XB_SPIN_CAP (1u << 18)

__device__ __forceinline__ unsigned xb_ld(unsigned* p)              { return __hip_atomic_load(p, __ATOMIC_RELAXED, __HIP_MEMORY_SCOPE_AGENT); }
__device__ __forceinline__ unsigned xb_add(unsigned* p, unsigned v) { return __hip_atomic_fetch_add(p, v, __ATOMIC_RELAXED, __HIP_MEMORY_SCOPE_AGENT); }
__device__ __forceinline__ unsigned xb_xcc_id() { return (unsigned)__builtin_amdgcn_s_getreg((3 << 11) | 20) & 0xFu; }
#define XB_SPIN(cond, bar) do { unsigned _sp = 0; while (cond) { __builtin_amdgcn_s_sleep(1); \
    if ((++_sp & 255u) == 0u) { if (xb_ld(&(bar)[XB_TMO])) break; if (_sp > XB_SPIN_CAP) { atomicAdd(&(bar)[XB_TMO], 1u); break; } } } } while (0)

struct XcdBarrier {
    unsigned* bar; unsigned x;
    volatile LAS unsigned* st;
};

__device__ __forceinline__ XcdBarrier xcd_barrier_post(unsigned* bar, volatile LAS unsigned* st) {
    XcdBarrier b; b.bar = bar; b.x = xb_xcc_id(); b.st = st;
    if (threadIdx.x == 0) (void)xb_add(&bar[XB_XCNT(b.x)], 1u);
    return b;
}
__device__ __forceinline__ void xcd_barrier_complete(unsigned* bar, unsigned x, unsigned& nloc, unsigned& nx) {
    const unsigned G = gridDim.x * gridDim.y * gridDim.z;
    unsigned sum, cnt, mine, sp = 0u;
    for (;;) {
        sum = 0u; cnt = 0u; mine = 0u;
#pragma unroll
        for (unsigned j = 0; j < 16; ++j) { const unsigned c = xb_ld(&bar[XB_XCNT(j)]); sum += c; cnt += (c > 0u) ? 1u : 0u; mine = (j == x) ? c : mine; }
        if (sum == G) break;
        __builtin_amdgcn_s_sleep(1);
        if ((++sp & 255u) == 0u) { if (xb_ld(&bar[XB_TMO])) break; if (sp > XB_SPIN_CAP) { atomicAdd(&bar[XB_TMO], 1u); break; } }
    }
    nloc = mine > 0u ? mine : 1u; nx = cnt > 0u ? cnt : 1u;
}

__device__ __forceinline__ void xcd_barrier(const XcdBarrier& b) {
    asm volatile("s_waitcnt vmcnt(0)" ::: "memory");
    __syncthreads();
    if (threadIdx.x == 0) {
        unsigned* bar = b.bar;
        __builtin_amdgcn_s_waitcnt(0);
        unsigned nloc = b.st[0], nx = b.st[1];
        if (nloc == 0u) { xcd_barrier_complete(bar, b.x, nloc, nx); b.st[0] = nloc; b.st[1] = nx; }
        const unsigned old = xb_add(&bar[XB_XSUB(b.x)], 1u);
        const unsigned gen = old / nloc;
        if (old + 1u == (gen + 1u) * nloc) {
            __builtin_amdgcn_fence(__ATOMIC_RELEASE, "agent");
            asm volatile("s_waitcnt vmcnt(0)" ::: "memory");
            const unsigned og = xb_add(&bar[XB_TOP], 1u);
            const unsigned tg = og / nx;
            if (og + 1u == (tg + 1u) * nx) xb_add(&bar[XB_TOPGEN], 1u);
            else XB_SPIN(xb_ld(&bar[XB_TOPGEN]) == tg, bar);
            __builtin_amdgcn_fence(__ATOMIC_ACQUIRE, "agent");
            xb_add(&bar[XB_XGEN(b.x)], 1u);
            asm volatile("s_waitcnt vmcnt(0)" ::: "memory");
        } else {
            XB_SPIN(xb_ld(&bar[XB_XGEN(b.x)]) == gen, bar);
            __builtin_amdgcn_fence(__ATOMIC_ACQUIRE, "agent");
            asm volatile("s_waitcnt vmcnt(0)" ::: "memory");
        }
    }
    __syncthreads();
}

typedef unsigned short bf16_t;
typedef short bf16x8 __attribute__((ext_vector_type(8)));
typedef short bf16x4 __attribute__((ext_vector_type(4)));
typedef float f32x4 __attribute__((ext_vector_type(4)));
typedef unsigned u32x4 __attribute__((ext_vector_type(4)));
typedef unsigned u32x2 __attribute__((ext_vector_type(2)));
constexpr int DM = 1024, NBATCH = 8, SEQ = 4096, NTOK = NBATCH * SEQ, DEPTH = 2;
constexpr int INW = 3968, INWP = 4096, FFN = 2816, NMOD = 6;
constexpr int C_AQ = 0, C_AK = 384, C_AV = 768, C_RQ = 1152, C_RK = 1536, C_RV = 1920, C_RG = 2304, C_HQ = 2688, C_HZF = 2944, C_HZB = 3200, C_HI = 3456, C_HG = 3712;
constexpr float NORM_EPS = 1e-6f;
constexpr int NTHREADS = 512;
constexpr int LDS_BYTES = 135168;
constexpr size_t WS_CTL = 0, WS_MOD = 16384, WS_LB = WS_MOD + 393216, WS_HGA = WS_LB + 2048, WS_LSE = WS_HGA + 524288, WS_WIN = WS_LSE + 2359296,
    WS_WOUT = WS_WIN + 16777216, WS_WGU = WS_WOUT + 4194304, WS_WDN = WS_WGU + 23068672, WS_HBUF = WS_WDN + 11534336, WS_PROJ = WS_HBUF + 67108864,
    WS_OB = WS_PROJ + 260046848, WS_RST = WS_OB + 75497472, WS_HGU = WS_RST + 25165824, WS_END = WS_HGU + 33554432;

struct Params {
    const float *x, *c, *w_ada, *b_ada, *g_mix, *w_in, *ret_gn, *hgrn_gn, *lb_logits, *w_out, *g_ffn, *w_gu, *w_down, *g_final;
    float* out; unsigned char* ws; int ph_lo, ph_hi;
};

__device__ __forceinline__ float bf2f(bf16_t v) { return __uint_as_float(((unsigned)v) << 16); }
__device__ __forceinline__ float bflo(unsigned w) { return __uint_as_float(w << 16); }
__device__ __forceinline__ float bfhi(unsigned w) { return __uint_as_float(w & 0xffff0000u); }
__device__ __forceinline__ bf16_t f2bf(float f) { return __builtin_bit_cast(bf16_t, (__bf16)f); }
typedef float f32x2c __attribute__((ext_vector_type(2)));
typedef __bf16 bf16v2c __attribute__((ext_vector_type(2)));
__device__ __forceinline__ unsigned pk2(float lo, float hi) { const f32x2c v = {lo, hi}; return __builtin_bit_cast(unsigned, __builtin_convertvector(v, bf16v2c)); }
__device__ __forceinline__ bf16x4 pk4(f32x4 v) { u32x2 w; w.x = pk2(v[0], v[1]); w.y = pk2(v[2], v[3]); return __builtin_bit_cast(bf16x4, w); }
__device__ __forceinline__ float siluf(float v) { return v * __builtin_amdgcn_rcpf(1.0f + __expf(-v)); }
__device__ __forceinline__ float wave_sum(float v) {
#pragma unroll
    for (int o = 1; o < 64; o <<= 1) v += __shfl_xor(v, o);
    return v;
}
#define MFMA32(a, b, c) __builtin_amdgcn_mfma_f32_16x16x32_bf16((a), (b), (c), 0, 0, 0)
#define MFMA16(a, b, c) __builtin_amdgcn_mfma_f32_16x16x16bf16_1k((a), (b), (c), 0, 0, 0)

struct EpiProj {
    static constexpr bool PERM = true, AFTER_DRAIN = false;
    bf16_t* O; int ldc, ncols;
    __device__ __forceinline__ void operator()(const f32x4 (&acc)[2][2][4][2], const pg8::Unit& u, int wr, int wc, int fr, int fq) const {
        const int row0 = u.pm * 256 + wr * 64 + fr, col0 = u.pn * 256 + wc * 32 + 8 * fq;
#pragma unroll
        for (int ai = 0; ai < 2; ++ai)
#pragma unroll
            for (int m = 0; m < 4; ++m) { bf16_t* rowp = O + (size_t)(row0 + ai * 128 + m * 16) * ldc + col0;
#pragma unroll
                for (int bj = 0; bj < 2; ++bj) { if (col0 + bj * 128 < ncols) { const f32x4 v0 = acc[ai][bj][m][0], v1 = acc[ai][bj][m][1];
                    u32x4 w; w.x = pk2(v0[0], v0[1]); w.y = pk2(v0[2], v0[3]); w.z = pk2(v1[0], v1[1]); w.w = pk2(v1[2], v1[3]);
                    *(u32x4*)(rowp + bj * 128) = w; } } }
    }
};
struct EpiRes {
    static constexpr bool PERM = false, AFTER_DRAIN = false;
    const float* base; float* out; const float* gate;
    __device__ __forceinline__ void operator()(const f32x4 (&acc)[2][2][4][2], const pg8::Unit& u, int wr, int wc, int fr, int fq) const {
        const int row0 = u.pm * 256 + wr * 64 + fr, col0 = u.pn * 256 + wc * 32 + 4 * fq;
        const float* gp = gate + (size_t)((u.pm * 256) >> 12) * (NMOD * DM) + col0;
        f32x4 gv[2][2];
#pragma unroll
        for (int bj = 0; bj < 2; ++bj)
#pragma unroll
            for (int n = 0; n < 2; ++n) gv[bj][n] = *(const f32x4*)(gp + bj * 128 + n * 16);
#pragma unroll
        for (int ai = 0; ai < 2; ++ai)
#pragma unroll
            for (int m = 0; m < 4; ++m) { const size_t off = (size_t)(row0 + ai * 128 + m * 16) * DM + col0;
#pragma unroll
                for (int bj = 0; bj < 2; ++bj)
#pragma unroll
                    for (int n = 0; n < 2; ++n) { const f32x4 bs = *(const f32x4*)(base + off + bj * 128 + n * 16);
                        *(f32x4*)(out + off + bj * 128 + n * 16) = bs + gv[bj][n] * acc[ai][bj][m][n]; } }
    }
};
struct EpiSwiglu {
    static constexpr bool PERM = true, AFTER_DRAIN = false;
    bf16_t* O;
    __device__ __forceinline__ void operator()(const f32x4 (&acc)[2][2][4][2], const pg8::Unit& u, int wr, int wc, int fr, int fq) const {
        const int row0 = u.pm * 256 + wr * 64 + fr, col0 = u.pn * 128 + wc * 32 + 8 * fq;
#pragma unroll
        for (int ai = 0; ai < 2; ++ai)
#pragma unroll
            for (int m = 0; m < 4; ++m) { bf16_t* rowp = O + (size_t)(row0 + ai * 128 + m * 16) * FFN + col0;
                float r[8];
#pragma unroll
                for (int n = 0; n < 2; ++n)
#pragma unroll
                    for (int i = 0; i < 4; ++i) { const float g = acc[ai][0][m][n][i], uu = acc[ai][1][m][n][i]; r[n * 4 + i] = siluf(g) * uu; }
                u32x4 w; w.x = pk2(r[0], r[1]); w.y = pk2(r[2], r[3]); w.z = pk2(r[4], r[5]); w.w = pk2(r[6], r[7]);
                *(u32x4*)rowp = w; }
    }
};
__device__ __forceinline__ void transpose_item(const float* W, int K, int N, bf16_t* WT, int dst_row0, int src_col0, int k0, LAS float* scr, int lane) {
    const int c = lane & 7, nr = lane >> 3;
    if (src_col0 < 0) {
#pragma unroll
        for (int j = 0; j < 8; ++j) *(u32x4*)(WT + (size_t)(dst_row0 + nr + 8 * j) * K + k0 + 8 * c) = (u32x4){0u, 0u, 0u, 0u};
        return;
    }
    const int kr = lane >> 4, c4 = lane & 15;
    f32x4 v[16];
#pragma unroll
    for (int i = 0; i < 16; ++i) v[i] = __builtin_nontemporal_load((const f32x4*)(W + (size_t)(k0 + 4 * i + kr) * N + src_col0 + 4 * c4));
#pragma unroll
    for (int i = 0; i < 16; ++i) { LAS float* d = scr + (4 * i + kr) * 65 + 4 * c4; d[0] = v[i][0]; d[1] = v[i][1]; d[2] = v[i][2]; d[3] = v[i][3]; }
    __builtin_amdgcn_fence(__ATOMIC_RELEASE, "wavefront"); __builtin_amdgcn_wave_barrier(); __builtin_amdgcn_fence(__ATOMIC_ACQUIRE, "wavefront");
#pragma unroll
    for (int j = 0; j < 8; ++j) { const int n = nr + 8 * j; const LAS float* sp = scr + (8 * c) * 65 + n;
        u32x4 o; o.x = pk2(sp[0 * 65], sp[1 * 65]); o.y = pk2(sp[2 * 65], sp[3 * 65]); o.z = pk2(sp[4 * 65], sp[5 * 65]); o.w = pk2(sp[6 * 65], sp[7 * 65]);
        *(u32x4*)(WT + (size_t)(dst_row0 + n) * K + k0 + 8 * c) = o; }
    __builtin_amdgcn_fence(__ATOMIC_RELEASE, "wavefront"); __builtin_amdgcn_wave_barrier(); __builtin_amdgcn_fence(__ATOMIC_ACQUIRE, "wavefront");
}

__device__ __forceinline__ void phase_weights(const Params& P, LAS unsigned char* lds) {
    const int tid = opaque_tid(), lane = tid & 63, wave = __builtin_amdgcn_readfirstlane(tid >> 6);
    unsigned char* ws = P.ws;
    {
        LAS float* scr = (LAS float*)(lds + wave * 16640);
        const int gw = blockIdx.x * 8 + wave, NGW = gridDim.x * 8;
        constexpr int I_IN = 16 * 64, I_OUT = 16 * 16, I_GU = 16 * 88, I_DN = 44 * 16, I_L = I_IN + I_OUT + I_GU + I_DN;
        for (int it = gw; it < DEPTH * I_L; it += NGW) {
            const int l = it / I_L; int r = it % I_L;
            if (r < I_IN) { const int kb = r / 64, nb = r % 64, n0 = nb * 64;
                transpose_item(P.w_in + (size_t)l * DM * INW, DM, INW, (bf16_t*)(ws + WS_WIN) + (size_t)l * INWP * DM, n0, n0 < INW ? n0 : -1, kb * 64, scr, lane); continue; }
            r -= I_IN;
            if (r < I_OUT) { const int kb = r / 16, nb = r % 16;
                transpose_item(P.w_out + (size_t)l * DM * DM, DM, DM, (bf16_t*)(ws + WS_WOUT) + (size_t)l * DM * DM, nb * 64, nb * 64, kb * 64, scr, lane); continue; }
            r -= I_OUT;
            if (r < I_GU) { const int kb = r / 88, nb = r % 88, n0 = nb * 64; const int pn = n0 >> 8, half = (n0 >> 7) & 1, jj = n0 & 127;
                transpose_item(P.w_gu + (size_t)l * DM * 2 * FFN, DM, 2 * FFN, (bf16_t*)(ws + WS_WGU) + (size_t)l * 2 * FFN * DM, n0, half * FFN + pn * 128 + jj, kb * 64, scr, lane); continue; }
            r -= I_GU;
            { const int kb = r / 16, nb = r % 16;
                transpose_item(P.w_down + (size_t)l * FFN * DM, FFN, DM, (bf16_t*)(ws + WS_WDN) + (size_t)l * DM * FFN, nb * 64, nb * 64, kb * 64, scr, lane); }
        }
    }
}
__device__ __forceinline__ void phase_prologue(const Params& P, LAS unsigned char* lds) {
    const int tid = opaque_tid();
    unsigned char* ws = P.ws;
    {
        LAS float* sc = (LAS float*)lds;
        LAS float* red = (LAS float*)(lds + 32768);
        for (int i = tid; i < NBATCH * DM; i += NTHREADS) sc[i] = siluf(P.c[i]);
        __syncthreads();
        float* mod = (float*)(ws + WS_MOD);
        for (int u = blockIdx.x; u < DEPTH * 96; u += gridDim.x) {
            const int l = u / 96, j0 = (u % 96) * 64, col = tid & 63, kp = tid >> 6;
            float acc[8];
#pragma unroll
            for (int b = 0; b < 8; ++b) acc[b] = 0.f;
            const float* wp = P.w_ada + (size_t)l * DM * (NMOD * DM) + j0 + col;
            for (int k = kp * 128; k < kp * 128 + 128; ++k) { const float w = __builtin_nontemporal_load(wp + (size_t)k * (NMOD * DM));
#pragma unroll
                for (int b = 0; b < 8; ++b) acc[b] += sc[b * DM + k] * w; }
#pragma unroll
            for (int b = 0; b < 8; ++b) red[(kp * 8 + b) * 64 + col] = acc[b];
            __syncthreads();
            { const int b = tid >> 6; float s = 0.f;
#pragma unroll
              for (int p = 0; p < 8; ++p) s += red[(p * 8 + b) * 64 + col];
              mod[((size_t)l * NBATCH + b) * (NMOD * DM) + j0 + col] = s + P.b_ada[(size_t)l * NMOD * DM + j0 + col]; }
            __syncthreads();
        }
    }
    if (blockIdx.x == 0 && tid < 256) {
        const float l0 = P.lb_logits[tid], l1 = P.lb_logits[256 + tid], m = fmaxf(l0, l1), e0 = __expf(l0 - m), e1 = __expf(l1 - m);
        const float p0 = e0 / (e0 + e1), p1 = e1 / (e0 + e1);
        float* lb = (float*)(ws + WS_LB);
        lb[tid] = fminf(fmaxf(p0 - p0, 0.f), 1.0f - 1e-6f);
        lb[256 + tid] = fminf(fmaxf((p0 + p1) - p0, 0.f), 1.0f - 1e-6f);
    }
}

template <int NY, bool WRITE_X, bool FINAL>
__device__ __forceinline__ void phase_norm(const float* src, const bf16_t* y, const float* gate, const bf16_t* y2, const float* gate2, float* xout, const float* g, const float* shift, const float* scale, bf16_t* dst) {
    constexpr bool HAS_Y = NY > 0;
    const int tid = opaque_tid(), lane = tid & 63, wave = tid >> 6;
    const int gw = blockIdx.x * 8 + wave, NGW = gridDim.x * 8;
    f32x4 gv[4];
#pragma unroll
    for (int j = 0; j < 4; ++j) gv[j] = *(const f32x4*)(g + 4 * lane + 256 * j);
    const int WPB = NGW / NBATCH, b = gw / WPB;
    if (b >= NBATCH) return;
    f32x4 gtv[4], gtv2[4], scv[4], shv[4];
#pragma unroll
    for (int j = 0; j < 4; ++j) {
        if (HAS_Y) gtv[j] = *(const f32x4*)(gate + (size_t)b * (NMOD * DM) + 4 * lane + 256 * j);
        if (NY > 1) gtv2[j] = *(const f32x4*)(gate2 + (size_t)b * (NMOD * DM) + 4 * lane + 256 * j);
        if (!FINAL) { scv[j] = *(const f32x4*)(scale + (size_t)b * (NMOD * DM) + 4 * lane + 256 * j) + 1.0f; shv[j] = *(const f32x4*)(shift + (size_t)b * (NMOD * DM) + 4 * lane + 256 * j); }
    }
    for (int row = b * SEQ + (gw - b * WPB); row < (b + 1) * SEQ; row += WPB) {
        const f32x4* xr = (const f32x4*)(src + (size_t)row * DM) + lane;
        f32x4 v[4]; float s = 0.f;
#pragma unroll
        for (int j = 0; j < 4; ++j) v[j] = __builtin_nontemporal_load(xr + 64 * j);
        if (HAS_Y) {
            const u32x2* yr = (const u32x2*)(y + (size_t)row * DM) + lane;
#pragma unroll
            for (int j = 0; j < 4; ++j) { const u32x2 yw = __builtin_nontemporal_load(yr + 64 * j); const f32x4 gt = gtv[j];
                v[j][0] += gt[0] * bflo(yw.x); v[j][1] += gt[1] * bfhi(yw.x); v[j][2] += gt[2] * bflo(yw.y); v[j][3] += gt[3] * bfhi(yw.y); }
        }
        if (NY > 1) {
            const u32x2* yr2 = (const u32x2*)(y2 + (size_t)row * DM) + lane;
#pragma unroll
            for (int j = 0; j < 4; ++j) { const u32x2 yw = __builtin_nontemporal_load(yr2 + 64 * j); const f32x4 gt = gtv2[j];
                v[j][0] += gt[0] * bflo(yw.x); v[j][1] += gt[1] * bfhi(yw.x); v[j][2] += gt[2] * bflo(yw.y); v[j][3] += gt[3] * bfhi(yw.y); }
        }
#pragma unroll
        for (int j = 0; j < 4; ++j) s += (v[j][0] * v[j][0] + v[j][1] * v[j][1]) + (v[j][2] * v[j][2] + v[j][3] * v[j][3]);
        const float rstd = rsqrtf(wave_sum(s) * (1.0f / DM) + NORM_EPS);
        f32x4* xo = (f32x4*)(xout + (size_t)row * DM) + lane;
        if (FINAL) {
#pragma unroll
            for (int j = 0; j < 4; ++j) __builtin_nontemporal_store(v[j] * rstd * gv[j], xo + 64 * j);
        } else {
            if (WRITE_X) {
#pragma unroll
                for (int j = 0; j < 4; ++j) __builtin_nontemporal_store(v[j], xo + 64 * j);
            }
            unsigned long long* o8 = (unsigned long long*)(dst + (size_t)row * DM) + lane;
#pragma unroll
            for (int j = 0; j < 4; ++j) {
                const f32x4 h = v[j] * rstd * gv[j] * scv[j] + shv[j];
                o8[64 * j] = (unsigned long long)pk2(h[0], h[1]) | ((unsigned long long)pk2(h[2], h[3]) << 32);
            }
        }
    }
}
__device__ __forceinline__ bf16x4 tr4(const LAS bf16_t* img, int pitch, int row0, int col0, int g, int q) {
    return __builtin_amdgcn_ds_read_tr16_b64_v4i16((LAS bf16x4*)(img + (row0 + 4 * g + (q >> 2)) * pitch + col0 + 4 * (q & 3)));
}
__device__ __forceinline__ bf16x8 tr8(const LAS bf16_t* img, int pitch, int row0, int col0, int g, int q) {
    const bf16x4 lo = __builtin_amdgcn_ds_read_tr16_b64_v4i16((LAS bf16x4*)(img + (row0 + 8 * g + (q >> 2)) * pitch + col0 + 4 * (q & 3)));
    const bf16x4 hi = __builtin_amdgcn_ds_read_tr16_b64_v4i16((LAS bf16x4*)(img + (row0 + 8 * g + 4 + (q >> 2)) * pitch + col0 + 4 * (q & 3)));
    return __builtin_shufflevector(lo, hi, 0, 1, 2, 3, 4, 5, 6, 7);
}
struct AttRegs { u32x4 kv[2][4], vv[2][4]; bf16x8 qf[2][2]; };
constexpr int ATT_UNITS = 2304;
__device__ __forceinline__ void att_decode(int u, int& br, int& b, int& h, int& r, int& L, int& p0, int& tok0) {
    const int pi = u >> 6, k = u & 63; b = pi / 6; h = pi % 6; br = k >> 4; const int w = k & 15;
    const int lr = br * 2, nblk = 16 >> lr, rho = w >> (4 - lr), blk = w & (nblk - 1); r = 1 << lr; L = SEQ >> lr; p0 = blk * 256; tok0 = b * SEQ + rho;
}
__device__ __forceinline__ int att_unit(int li, int x) { const int pl = li / 48, k = li - pl * 48; return ((x + 8 * pl) << 6) | k; }
__device__ __forceinline__ void att_load(const Params& P, int u, int tid, AttRegs& R) {
    int br, b, h, r, L, p0, tok0; att_decode(u, br, b, h, r, L, p0, tok0);
    const bf16_t* proj = (const bf16_t*)(P.ws + WS_PROJ);
#pragma unroll
    for (int it = 0; it < 2; ++it) {
        const int item = tid + it * NTHREADS, key = item >> 1, half = item & 1, kj = p0 - 64 + key;
        if (item < 768 && kj >= 0 && kj < L) {
            const bf16_t* src = proj + (size_t)(tok0 + r * kj) * INW + h * 64 + half * 32;
#pragma unroll
            for (int i = 0; i < 4; ++i) { R.kv[it][i] = *(const u32x4*)(src + C_AK + 8 * i); R.vv[it][i] = *(const u32x4*)(src + C_AV + 8 * i); }
        } else {
#pragma unroll
            for (int i = 0; i < 4; ++i) { R.kv[it][i] = (u32x4){0u, 0u, 0u, 0u}; R.vv[it][i] = (u32x4){0u, 0u, 0u, 0u}; }
        }
    }
    const int lane = tid & 63, wave = tid >> 6, q = lane & 15, g = lane >> 4;
#pragma unroll
    for (int qt = 0; qt < 2; ++qt) {
        const size_t tokq = (size_t)(tok0 + r * (p0 + 32 * wave + 16 * qt + q));
#pragma unroll
        for (int kk = 0; kk < 2; ++kk) R.qf[qt][kk] = *(const bf16x8*)(proj + tokq * INW + C_AQ + h * 64 + kk * 32 + 8 * g);
    }
}
__device__ __forceinline__ void att_phase(const Params& P, LAS unsigned char* lds) {
    const int tid = opaque_tid(), lane = tid & 63, wave = __builtin_amdgcn_readfirstlane(tid >> 6), q = lane & 15, g = lane >> 4;
    LAS bf16_t* Ks = (LAS bf16_t*)lds;
    LAS bf16_t* Vs = (LAS bf16_t*)(lds + 55296);
    const int xq = blockIdx.x & 7, nj = ((int)gridDim.x + 7 - xq) >> 3;
    int li = blockIdx.x >> 3; if (li >= 288) return;
    AttRegs R; att_load(P, att_unit(li, xq), tid, R);
    for (; li < 288; li += nj) {
        const int u = att_unit(li, xq);
        int br, b, h, r, L, p0, tok0; att_decode(u, br, b, h, r, L, p0, tok0);
#pragma unroll
        for (int it = 0; it < 2; ++it) {
            const int item = tid + it * NTHREADS, key = item >> 1, half = item & 1;
            if (item < 768) {
#pragma unroll
                for (int i = 0; i < 4; ++i) { *(LAS u32x4*)(Ks + key * 72 + half * 32 + 8 * i) = R.kv[it][i]; *(LAS u32x4*)(Vs + key * 72 + half * 32 + 8 * i) = R.vv[it][i]; }
            }
        }
        bf16x8 qf[2][2]; qf[0][0] = R.qf[0][0]; qf[0][1] = R.qf[0][1]; qf[1][0] = R.qf[1][0]; qf[1][1] = R.qf[1][1];
        __syncthreads();
        if (li + nj < 288) att_load(P, att_unit(li + nj, xq), tid, R);
        const float slope_l2 = exp2f(-8.0f * (float)(h + 1) / 6.0f) * (float)r * 1.44269504f, qk_l2 = 0.125f * 1.44269504f;
        const float fbase = (float)(64 + q - 4 * g);
        const bool edge = (p0 < 64) || (p0 + 320 > L);
#pragma unroll
        for (int qt = 0; qt < 2; ++qt) {
            const int kw = 32 * wave + 16 * qt;
            const int p = p0 + kw + q; const size_t tokq = (size_t)(tok0 + r * p);
            f32x4 st[9]; float mx = -3.0e38f;
#pragma unroll
            for (int t = 0; t < 9; ++t) {
                f32x4 acc = {0.f, 0.f, 0.f, 0.f};
#pragma unroll
                for (int kk = 0; kk < 2; ++kk) { const bf16x8 a = *(const LAS bf16x8*)(Ks + (kw + 16 * t + q) * 72 + kk * 32 + 8 * g); acc = MFMA32(a, qf[qt][kk], acc); }
#pragma unroll
                for (int j = 0; j < 4; ++j) {
                    const float d = fabsf(fbase - (float)(16 * t + j));
                    float s = acc[j] * qk_l2 - slope_l2 * d;
                    if (t == 0 || t == 8) s = (d <= 64.0f) ? s : -1.0e30f;
                    acc[j] = s;
                }
                if (edge) {
#pragma unroll
                    for (int j = 0; j < 4; ++j) { const int kj = p0 - 64 + kw + 16 * t + 4 * g + j; acc[j] = (kj >= 0 && kj < L) ? acc[j] : -1.0e30f; }
                }
#pragma unroll
                for (int j = 0; j < 4; ++j) mx = fmaxf(mx, acc[j]);
                st[t] = acc;
            }
            mx = fmaxf(mx, __shfl_xor(mx, 16)); mx = fmaxf(mx, __shfl_xor(mx, 32));
            float ls = 0.f; bf16x4 pt[9];
#pragma unroll
            for (int t = 0; t < 9; ++t) { f32x4 e;
#pragma unroll
                for (int j = 0; j < 4; ++j) { e[j] = __builtin_amdgcn_exp2f(st[t][j] - mx); ls += e[j]; }
                pt[t] = pk4(e); }
            ls += __shfl_xor(ls, 16); ls += __shfl_xor(ls, 32);
            const float inv = __builtin_amdgcn_rcpf(ls);
            bf16_t* ob = (bf16_t*)(P.ws + WS_OB) + ((size_t)br * NTOK + tokq) * 384 + h * 64;
            const LAS bf16_t* vrd = Vs + (kw + 4 * g + (q >> 2)) * 72 + 4 * (q & 3);
#pragma unroll
            for (int dt = 0; dt < 4; ++dt) {
                f32x4 acc = {0.f, 0.f, 0.f, 0.f};
#pragma unroll
                for (int t = 0; t < 9; ++t) { const bf16x4 a = __builtin_amdgcn_ds_read_tr16_b64_v4i16((LAS bf16x4*)(vrd + 16 * t * 72 + dt * 16)); acc = MFMA16(a, pt[t], acc); }
                acc = acc * inv;
                *(bf16x4*)(ob + dt * 16 + 4 * g) = pk4(acc);
            }
            if (g == 0) ((float*)(P.ws + WS_LSE))[((size_t)br * NTOK + tokq) * 6 + h] = (mx + __log2f(ls)) * 0.69314718f;
        }
        __syncthreads();
    }
}
__device__ __forceinline__ void att_merge(const Params& P) {
    const bf16_t* ob = (const bf16_t*)(P.ws + WS_OB); const float* lse = (const float*)(P.ws + WS_LSE); bf16_t* mixed = (bf16_t*)(P.ws + WS_HBUF);
    for (size_t it = (size_t)blockIdx.x * NTHREADS + opaque_tid(); it < (size_t)NTOK * 48; it += (size_t)gridDim.x * NTHREADS) {
        const size_t tok = it / 48; const int grp = (int)(it % 48), h = grp >> 3;
        const float l0 = lse[tok * 6 + h], l1 = lse[((size_t)NTOK + tok) * 6 + h], l2 = lse[((size_t)2 * NTOK + tok) * 6 + h];
        const float m = fmaxf(l0, fmaxf(l1, l2)), e0 = __expf(l0 - m), e1 = __expf(l1 - m), e2 = __expf(l2 - m), is = __builtin_amdgcn_rcpf(e0 + e1 + e2);
        const float w0 = e0 * is, w1 = e1 * is, w2 = e2 * is;
        const u32x4 a = __builtin_nontemporal_load((const u32x4*)(ob + tok * 384 + grp * 8)), bq = __builtin_nontemporal_load((const u32x4*)(ob + ((size_t)NTOK + tok) * 384 + grp * 8)), cq = __builtin_nontemporal_load((const u32x4*)(ob + ((size_t)2 * NTOK + tok) * 384 + grp * 8));
        u32x4 o;
#pragma unroll
        for (int i = 0; i < 4; ++i) o[i] = pk2(w0 * bflo(a[i]) + w1 * bflo(bq[i]) + w2 * bflo(cq[i]), w0 * bfhi(a[i]) + w1 * bfhi(bq[i]) + w2 * bfhi(cq[i]));
        *(u32x4*)(mixed + tok * DM + grp * 8) = o;
    }
}

__device__ __forceinline__ float ret_logg(int h) { return log1pf(-exp2f(-5.0f - (float)h)); }
struct RetARegs { u32x4 k0, k1, v0, v1; };
__device__ __forceinline__ void retA_load(const Params& P, int u, int tid, RetARegs& R) {
    const int bh = u >> 5, n = u & 31, b = bh / 6, h = bh % 6, c = tid >> 2, qd = tid & 3;
    const bf16_t* src = (const bf16_t*)(P.ws + WS_PROJ) + (size_t)(b * SEQ + n * 128 + c) * INW + h * 64 + qd * 16;
    R.k0 = *(const u32x4*)(src + C_RK); R.k1 = *(const u32x4*)(src + C_RK + 8); R.v0 = *(const u32x4*)(src + C_RV); R.v1 = *(const u32x4*)(src + C_RV + 8);
}
__device__ __forceinline__ void retA_phase(const Params& P, LAS unsigned char* lds) {
    const int tid = opaque_tid(), lane = tid & 63, wave = __builtin_amdgcn_readfirstlane(tid >> 6), q = lane & 15, g = lane >> 4;
    LAS bf16_t* Kf = (LAS bf16_t*)lds; LAS bf16_t* Kb = (LAS bf16_t*)(lds + 18432); LAS bf16_t* Vs = (LAS bf16_t*)(lds + 36864);
    int u = blockIdx.x; if (u >= 1536) return;
    RetARegs R; retA_load(P, u, tid, R);
    for (; u < 1536; u += gridDim.x) {
        const int bh = u >> 5, n = u & 31, h = bh % 6;
        const float lg = ret_logg(h);
        {
            const int c = tid >> 2, qd = tid & 3;
            const float wf = 0.125f * __expf(lg * (float)(127 - c)), wb = 0.125f * __expf(lg * (float)c);
            u32x4 f0, f1, b0, b1;
#pragma unroll
            for (int e = 0; e < 4; ++e) { f0[e] = pk2(bflo(R.k0[e]) * wf, bfhi(R.k0[e]) * wf); f1[e] = pk2(bflo(R.k1[e]) * wf, bfhi(R.k1[e]) * wf);
                b0[e] = pk2(bflo(R.k0[e]) * wb, bfhi(R.k0[e]) * wb); b1[e] = pk2(bflo(R.k1[e]) * wb, bfhi(R.k1[e]) * wb); }
            *(LAS u32x4*)(Kf + c * 72 + qd * 16) = f0; *(LAS u32x4*)(Kf + c * 72 + qd * 16 + 8) = f1;
            *(LAS u32x4*)(Kb + c * 72 + qd * 16) = b0; *(LAS u32x4*)(Kb + c * 72 + qd * 16 + 8) = b1;
            *(LAS u32x4*)(Vs + c * 72 + qd * 16) = R.v0; *(LAS u32x4*)(Vs + c * 72 + qd * 16 + 8) = R.v1;
        }
        __syncthreads();
        if (u + (int)gridDim.x < 1536) retA_load(P, u + gridDim.x, tid, R);
        const int dir = wave >> 2, dt = wave & 3; const LAS bf16_t* Kt = dir ? Kb : Kf;
        bf16x8 afr[4];
#pragma unroll
        for (int kk = 0; kk < 4; ++kk) afr[kk] = tr8(Kt, 72, kk * 32, dt * 16, g, q);
        bf16_t* dst = (bf16_t*)(P.ws + WS_RST) + ((size_t)(bh * 32 + n) * 2 + dir) * 4096;
#pragma unroll
        for (int et = 0; et < 4; ++et) {
            f32x4 acc = {0.f, 0.f, 0.f, 0.f};
#pragma unroll
            for (int kk = 0; kk < 4; ++kk) { const bf16x8 bfr = tr8(Vs, 72, kk * 32, et * 16, g, q); acc = MFMA32(afr[kk], bfr, acc); }
            *(bf16x4*)(dst + (et * 16 + q) * 64 + dt * 16 + 4 * g) = pk4(acc);
        }
        __syncthreads();
    }
}
__device__ __forceinline__ void ret_scan(const Params& P) {
    bf16_t* st = (bf16_t*)(P.ws + WS_RST);
    for (int it = blockIdx.x * NTHREADS + opaque_tid(); it < 48 * 2 * 512; it += gridDim.x * NTHREADS) {
        const int ch = it & 511, dir = (it >> 9) & 1, bh = it >> 10, h = bh % 6;
        const float cd = __expf(ret_logg(h) * 128.0f);
        float s[8];
#pragma unroll
        for (int e = 0; e < 8; ++e) s[e] = 0.f;
        for (int i0 = 0; i0 < 32; i0 += 8) {
            u32x4 v[8];
#pragma unroll
            for (int i = 0; i < 8; ++i) { const int n = dir ? 31 - (i0 + i) : (i0 + i); v[i] = *(const u32x4*)(st + ((size_t)(bh * 32 + n) * 2 + dir) * 4096 + 8 * ch); }
#pragma unroll
            for (int i = 0; i < 8; ++i) { const int n = dir ? 31 - (i0 + i) : (i0 + i);
                u32x4 o;
#pragma unroll
                for (int e = 0; e < 4; ++e) o[e] = pk2(s[2 * e], s[2 * e + 1]);
                *(u32x4*)(st + ((size_t)(bh * 32 + n) * 2 + dir) * 4096 + 8 * ch) = o;
#pragma unroll
                for (int e = 0; e < 4; ++e) { s[2 * e] = cd * s[2 * e] + bflo(v[i][e]); s[2 * e + 1] = cd * s[2 * e + 1] + bfhi(v[i][e]); } }
        }
    }
}
struct RetBRegs { u32x4 k0, k1, v0, v1, rf, rb, q0, q1; };
__device__ __forceinline__ void retB_load(const Params& P, int u, int tid, RetBRegs& R) {
    const int bh = u >> 5, n = u & 31, b = bh / 6, h = bh % 6, c = tid >> 2, qd = tid & 3;
    const bf16_t* proj = (const bf16_t*)(P.ws + WS_PROJ);
    const bf16_t* src = proj + (size_t)(b * SEQ + n * 128 + c) * INW + h * 64 + qd * 16;
    R.k0 = *(const u32x4*)(src + C_RK); R.k1 = *(const u32x4*)(src + C_RK + 8); R.v0 = *(const u32x4*)(src + C_RV); R.v1 = *(const u32x4*)(src + C_RV + 8);
    const bf16_t* rs = (const bf16_t*)(P.ws + WS_RST) + (size_t)(bh * 32 + n) * 2 * 4096;
    const int e = tid >> 3, d8 = (tid & 7) * 8;
    R.rf = *(const u32x4*)(rs + e * 64 + d8); R.rb = *(const u32x4*)(rs + 4096 + e * 64 + d8);
    const int lane = tid & 63, wave = tid >> 6, q = lane & 15, g = lane >> 4;
    const bf16_t* qp = proj + (size_t)(b * SEQ + n * 128 + 16 * wave + q) * INW + C_RQ + h * 64 + 8 * g;
    R.q0 = *(const u32x4*)qp; R.q1 = *(const u32x4*)(qp + 32);
}
__device__ __forceinline__ void retB_phase(const Params& P, LAS unsigned char* lds, int layer) {
    const int tid = opaque_tid(), lane = tid & 63, wave = __builtin_amdgcn_readfirstlane(tid >> 6), q = lane & 15, g = lane >> 4;
    const bf16_t* proj = (const bf16_t*)(P.ws + WS_PROJ);
    LAS bf16_t* Ks = (LAS bf16_t*)lds;
    LAS bf16_t* Vs = (LAS bf16_t*)(lds + 18432);
    LAS bf16_t* Rf = (LAS bf16_t*)(lds + 36864);
    LAS bf16_t* Rb = (LAS bf16_t*)(lds + 46080);
    int u = blockIdx.x; if (u >= 1536) return;
    RetBRegs R; retB_load(P, u, tid, R);
    for (; u < 1536; u += gridDim.x) {
        const int bh = u >> 5, n = u & 31, b = bh / 6, h = bh % 6;
        const float lg = ret_logg(h);
        {
            const int c = tid >> 2, qd = tid & 3, e = tid >> 3, d8 = (tid & 7) * 8;
            *(LAS u32x4*)(Ks + c * 72 + qd * 16) = R.k0; *(LAS u32x4*)(Ks + c * 72 + qd * 16 + 8) = R.k1;
            *(LAS u32x4*)(Vs + c * 72 + qd * 16) = R.v0; *(LAS u32x4*)(Vs + c * 72 + qd * 16 + 8) = R.v1;
            *(LAS u32x4*)(Rf + e * 72 + d8) = R.rf; *(LAS u32x4*)(Rb + e * 72 + d8) = R.rb;
        }
        const u32x4 qraw[2] = {R.q0, R.q1};
        __syncthreads();
        if (u + (int)gridDim.x < 1536) retB_load(P, u + gridDim.x, tid, R);
        const int i = 16 * wave + q; const size_t tok = (size_t)(b * SEQ + n * 128 + i);
        u32x2 rgv[4]; f32x4 gnv[4];
#pragma unroll
        for (int et = 0; et < 4; ++et) { rgv[et] = *(const u32x2*)(proj + tok * INW + C_RG + h * 64 + et * 16 + 4 * g); gnv[et] = *(const f32x4*)(P.ret_gn + layer * 384 + h * 64 + et * 16 + 4 * g); }
        bf16x8 qf[2], qff[2], qfb[2];
        {
            const float ff = __expf(lg * (float)(i + 1)), fb = __expf(lg * (float)(128 - i));
#pragma unroll
            for (int kk = 0; kk < 2; ++kk) { const u32x4 raw = qraw[kk];
                qf[kk] = __builtin_bit_cast(bf16x8, raw); u32x4 a, c2;
#pragma unroll
                for (int e = 0; e < 4; ++e) { const float lo = bflo(raw[e]), hi = bfhi(raw[e]); a[e] = pk2(lo * ff, hi * ff); c2[e] = pk2(lo * fb, hi * fb); }
                qff[kk] = __builtin_bit_cast(bf16x8, a); qfb[kk] = __builtin_bit_cast(bf16x8, c2); }
        }
        bf16x4 pt[8];
#pragma unroll
        for (int jt = 0; jt < 8; ++jt) {
            f32x4 acc = {0.f, 0.f, 0.f, 0.f};
#pragma unroll
            for (int kk = 0; kk < 2; ++kk) { const bf16x8 a = *(const LAS bf16x8*)(Ks + (16 * jt + q) * 72 + kk * 32 + 8 * g); acc = MFMA32(a, qf[kk], acc); }
#pragma unroll
            for (int jj = 0; jj < 4; ++jj) { int dd = i - (16 * jt + 4 * g + jj); dd = dd < 0 ? -dd : dd; acc[jj] = acc[jj] * 0.125f * __expf(lg * (float)dd); }
            pt[jt] = pk4(acc);
        }
        f32x4 o[4];
#pragma unroll
        for (int et = 0; et < 4; ++et) {
            f32x4 acc = {0.f, 0.f, 0.f, 0.f};
#pragma unroll
            for (int jt = 0; jt < 8; ++jt) { const bf16x4 a = tr4(Vs, 72, 16 * jt, et * 16, g, q); acc = MFMA16(a, pt[jt], acc); }
#pragma unroll
            for (int kk = 0; kk < 2; ++kk) { const bf16x8 a = *(const LAS bf16x8*)(Rf + (et * 16 + q) * 72 + kk * 32 + 8 * g); acc = MFMA32(a, qff[kk], acc);
                const bf16x8 a2 = *(const LAS bf16x8*)(Rb + (et * 16 + q) * 72 + kk * 32 + 8 * g); acc = MFMA32(a2, qfb[kk], acc); }
            o[et] = acc;
        }
        float s = 0.f;
#pragma unroll
        for (int et = 0; et < 4; ++et) s += (o[et][0] + o[et][1]) + (o[et][2] + o[et][3]);
        s += __shfl_xor(s, 16); s += __shfl_xor(s, 32);
        const float mu = s * (1.0f / 64.0f); float vs = 0.f;
#pragma unroll
        for (int et = 0; et < 4; ++et) { o[et] = o[et] - mu; vs += (o[et][0] * o[et][0] + o[et][1] * o[et][1]) + (o[et][2] * o[et][2] + o[et][3] * o[et][3]); }
        vs += __shfl_xor(vs, 16); vs += __shfl_xor(vs, 32);
        const float rstd = rsqrtf(vs * (1.0f / 64.0f) + NORM_EPS);
        bf16_t* mixed = (bf16_t*)(P.ws + WS_HBUF) + tok * DM + 384 + h * 64;
#pragma unroll
        for (int et = 0; et < 4; ++et) {
            const f32x4 gn = gnv[et]; const u32x2 rg = rgv[et];
            f32x4 y; y[0] = o[et][0] * rstd * gn[0] * siluf(bflo(rg.x)); y[1] = o[et][1] * rstd * gn[1] * siluf(bfhi(rg.x));
            y[2] = o[et][2] * rstd * gn[2] * siluf(bflo(rg.y)); y[3] = o[et][3] * rstd * gn[3] * siluf(bfhi(rg.y));
            *(bf16x4*)(mixed + et * 16 + 4 * g) = pk4(y);
        }
        __syncthreads();
    }
}
__device__ __forceinline__ void hgrn_gate(float z, float lbv, float& f, float& kk) {
    z = fminf(fmaxf(z, -30.f), 30.f);
    const float ez = __expf(-z), sg = __builtin_amdgcn_rcpf(1.0f + ez);
    f = lbv + (1.0f - lbv) * sg; kk = (1.0f - lbv) * ez * sg;
}
__device__ __forceinline__ void hgA_unit(const Params& P, LAS unsigned char* lds, int u, int layer) {
    const int tid = opaque_tid(), lane = tid & 63, wave = __builtin_amdgcn_readfirstlane(tid >> 6), q = lane & 15, g = lane >> 4;
    const int bh = u >> 5, n = u & 31, b = bh >> 2, h = bh & 3;
    const bf16_t* proj = (const bf16_t*)(P.ws + WS_PROJ);
    LAS bf16_t* Kr = (LAS bf16_t*)lds;
    LAS bf16_t* Vs = (LAS bf16_t*)(lds + 36864);
    LAS float* segs = (LAS float*)(lds + 55296);
    const size_t tokc = (size_t)(b * SEQ + n * 128);
    {
        const int c = tid >> 2, qd = tid & 3; const bf16_t* src = proj + (tokc + c) * INW + C_HI + h * 64 + qd * 16;
        const u32x4 v0 = *(const u32x4*)src, v1 = *(const u32x4*)(src + 8);
        *(LAS u32x4*)(Vs + c * 72 + qd * 16) = v0; *(LAS u32x4*)(Vs + c * 72 + qd * 16 + 8) = v1;
    }
    const int d = tid & 63, dir = (tid >> 6) & 1, seg = tid >> 7;
    const float lbv = ((const float*)(P.ws + WS_LB))[layer * 256 + h * 64 + d];
    float lf[32], kk[32];
    {
        const bf16_t* zp = proj + (tokc + seg * 32) * INW + (dir ? C_HZB : C_HZF) + h * 64 + d;
        bf16_t zr[32];
#pragma unroll
        for (int i = 0; i < 32; ++i) zr[i] = zp[(size_t)i * INW];
#pragma unroll
        for (int i = 0; i < 32; ++i) hgrn_gate(bf2f(zr[i]), lbv, lf[i], kk[i]);
    }
    float ssum = 1.f;
#pragma unroll
    for (int i = 0; i < 32; ++i) ssum *= lf[i];
    segs[(dir * 4 + seg) * 64 + d] = ssum;
    __syncthreads();
    {
        float before = 1.f, after = 1.f;
#pragma unroll
        for (int s2 = 0; s2 < 4; ++s2) { const float v = segs[(dir * 4 + s2) * 64 + d]; if (s2 < seg) before *= v; if (s2 > seg) after *= v; }
        LAS bf16_t* kt = Kr + dir * (128 * 72) + (seg * 32) * 72 + d;
        if (dir == 0) {
            float run = after;
#pragma unroll
            for (int i = 31; i >= 0; --i) { kt[i * 72] = f2bf(kk[i] * run); run *= lf[i]; }
        } else {
            float run = before;
#pragma unroll
            for (int i = 0; i < 32; ++i) { kt[i * 72] = f2bf(kk[i] * run); run *= lf[i]; }
        }
        if (seg == 0) ((float*)(P.ws + WS_HGA))[((size_t)(bh * 2 + dir) * 32 + n) * 64 + d] = ssum * after;
    }
    __syncthreads();
    {
        const int wdir = wave >> 2, dt = wave & 3; const LAS bf16_t* krs = Kr + wdir * (128 * 72);
        bf16x8 afr[4];
#pragma unroll
        for (int kq = 0; kq < 4; ++kq) afr[kq] = tr8(krs, 72, kq * 32, dt * 16, g, q);
        float* dst = (float*)(P.ws + WS_HGU) + ((size_t)(bh * 2 + wdir) * 32 + n) * 4096;
#pragma unroll
        for (int et = 0; et < 4; ++et) {
            f32x4 acc = {0.f, 0.f, 0.f, 0.f};
#pragma unroll
            for (int kq = 0; kq < 4; ++kq) { const bf16x8 bfr = tr8(Vs, 72, kq * 32, et * 16, g, q); acc = MFMA32(afr[kq], bfr, acc); }
#pragma unroll
            for (int j = 0; j < 4; ++j) dst[(dt * 16 + 4 * g + j) * 64 + et * 16 + q] = acc[j];
        }
    }
    __syncthreads();
}
__device__ __forceinline__ void hg_scan(const Params& P) {
    float* U = (float*)(P.ws + WS_HGU); const float* A = (const float*)(P.ws + WS_HGA);
    const int nthr = gridDim.x * NTHREADS; int it0 = blockIdx.x * NTHREADS + opaque_tid() - 48 * 2 * 512; if (it0 < 0) it0 += nthr;
    for (int it = it0; it < 64 * 64 * 16; it += nthr) {
        const int e4 = it & 15, d = (it >> 4) & 63, bd = it >> 10, dir = bd & 1;
        f32x4 s = {0.f, 0.f, 0.f, 0.f};
        for (int i0 = 0; i0 < 32; i0 += 8) {
            f32x4 v[8]; float a[8];
#pragma unroll
            for (int i = 0; i < 8; ++i) { const int n = dir ? 31 - (i0 + i) : (i0 + i); v[i] = *(const f32x4*)(U + ((size_t)(bd * 32 + n) * 64 + d) * 64 + 4 * e4); a[i] = A[(size_t)(bd * 32 + n) * 64 + d]; }
#pragma unroll
            for (int i = 0; i < 8; ++i) { const int n = dir ? 31 - (i0 + i) : (i0 + i); *(f32x4*)(U + ((size_t)(bd * 32 + n) * 64 + d) * 64 + 4 * e4) = s; s = s * a[i] + v[i]; }
        }
    }
}
__device__ __forceinline__ unsigned pk2h(float lo, float hi) { return pk2(lo, hi); }
__device__ __forceinline__ bf16x4 pk4h(f32x4 v) { return pk4(v); }
__device__ __forceinline__ void hgB_unit(const Params& P, LAS unsigned char* lds, int u, int layer) {
    const int tid = opaque_tid(), lane = tid & 63, wave = __builtin_amdgcn_readfirstlane(tid >> 6), q = lane & 15, g = lane >> 4;
    const int b = u >> 5, n = u & 31, h = wave >> 1, dir = wave & 1, bh = b * 4 + h;
    bf16_t* proj = (bf16_t*)(P.ws + WS_PROJ);
    bf16_t* mixed = (bf16_t*)(P.ws + WS_HBUF);
    LAS unsigned char* wl = lds + wave * 7168;
    LAS bf16_t* Qi = (LAS bf16_t*)wl;
    LAS bf16_t* Ki = (LAS bf16_t*)(wl + 2304);
    LAS bf16_t* Vs = (LAS bf16_t*)(wl + 4608);
    LAS float* Al = (LAS float*)(wl + 6912);
    const size_t tokc = (size_t)(b * SEQ + n * 128);
    const float lbv = ((const float*)(P.ws + WS_LB))[layer * 256 + h * 64 + lane];
    f32x4 S[4][4];
    {
        const float* sp = (const float*)(P.ws + WS_HGU) + ((size_t)(bh * 2 + dir) * 32 + n) * 4096;
#pragma unroll
        for (int dt = 0; dt < 4; ++dt)
#pragma unroll
            for (int et = 0; et < 4; ++et)
#pragma unroll
                for (int j = 0; j < 4; ++j) S[dt][et][j] = sp[(dt * 16 + 4 * g + j) * 64 + et * 16 + q];
    }
    bf16_t* odst = dir ? (proj + C_AQ + h * 64) : (mixed + 768 + h * 64); const size_t opitch = dir ? INW : DM;
    bf16_t qr[16], zz[16]; u32x4 v0, v1;
#define HGB_LOAD(SC) do { const size_t toks_ = tokc + (SC) * 16; const bf16_t* base_ = proj + toks_ * INW + h * 64 + lane; \
        _Pragma("unroll") for (int ii = 0; ii < 16; ++ii) { const int t_ = dir ? 15 - ii : ii; qr[ii] = base_[(size_t)t_ * INW + C_HQ]; zz[ii] = base_[(size_t)t_ * INW + (dir ? C_HZB : C_HZF)]; } \
        const bf16_t* vsrc_ = proj + (toks_ + (lane >> 2)) * INW + C_HI + h * 64 + (lane & 3) * 16; v0 = *(const u32x4*)vsrc_; v1 = *(const u32x4*)(vsrc_ + 8); } while (0)
    HGB_LOAD(dir ? 7 : 0);
    for (int i = 0; i < 8; ++i) {
        const int sc = dir ? 7 - i : i; const size_t toks = tokc + sc * 16;
        {
            *(LAS u32x4*)(Vs + (lane >> 2) * 72 + (lane & 3) * 16) = v0; *(LAS u32x4*)(Vs + (lane >> 2) * 72 + (lane & 3) * 16 + 8) = v1;
            float bp = 1.f;
#pragma unroll
            for (int ii = 0; ii < 16; ++ii) {
                const int t = dir ? 15 - ii : ii;
                float f, kk; hgrn_gate(bf2f(zz[ii]), lbv, f, kk); const float qv = siluf(bf2f(qr[ii]));
                bp *= f;
                Qi[t * 72 + lane] = f2bf(qv * bp); Ki[t * 72 + lane] = f2bf(kk * __builtin_amdgcn_rcpf(fmaxf(bp, 1.0e-30f)));
            }
            Al[lane] = bp;
        }
        if (i + 1 < 8) HGB_LOAD(dir ? 6 - i : i + 1);
        __builtin_amdgcn_fence(__ATOMIC_RELEASE, "wavefront"); __builtin_amdgcn_wave_barrier(); __builtin_amdgcn_fence(__ATOMIC_ACQUIRE, "wavefront");
        f32x4 at = {0.f, 0.f, 0.f, 0.f};
#pragma unroll
        for (int kq = 0; kq < 2; ++kq) { const bf16x8 a8 = *(const LAS bf16x8*)(Ki + q * 72 + kq * 32 + 8 * g), b8 = *(const LAS bf16x8*)(Qi + q * 72 + kq * 32 + 8 * g); at = MFMA32(a8, b8, at); }
#pragma unroll
        for (int j = 0; j < 4; ++j) { const int sl = 4 * g + j; const bool keep = dir ? (sl >= q) : (sl <= q); at[j] = keep ? at[j] : 0.f; }
        const bf16x4 p4 = pk4h(at);
        bf16x4 b4[4], v4[4];
#pragma unroll
        for (int dt = 0; dt < 4; ++dt) b4[dt] = *(const LAS bf16x4*)(Qi + q * 72 + dt * 16 + 4 * g);
#pragma unroll
        for (int et = 0; et < 4; ++et) v4[et] = tr4(Vs, 72, 0, et * 16, g, q);
#pragma unroll
        for (int et = 0; et < 4; ++et) {
            f32x4 o = {0.f, 0.f, 0.f, 0.f};
#pragma unroll
            for (int dt = 0; dt < 4; ++dt) o = MFMA16(pk4h(S[dt][et]), b4[dt], o);
            o = MFMA16(v4[et], p4, o);
            *(bf16x4*)(odst + (toks + q) * opitch + et * 16 + 4 * g) = pk4(o);
        }
#pragma unroll
        for (int dt = 0; dt < 4; ++dt) {
            const bf16x4 kT4 = tr4(Ki, 72, 0, dt * 16, g, q);
            const f32x4 al4 = *(const LAS f32x4*)(Al + dt * 16 + 4 * g);
#pragma unroll
            for (int et = 0; et < 4; ++et) { const f32x4 s2 = MFMA16(kT4, v4[et], S[dt][et]); S[dt][et] = s2 * al4; }
        }
        __builtin_amdgcn_fence(__ATOMIC_RELEASE, "wavefront"); __builtin_amdgcn_wave_barrier(); __builtin_amdgcn_fence(__ATOMIC_ACQUIRE, "wavefront");
    }
    asm volatile("s_waitcnt vmcnt(0)" ::: "memory");
    __syncthreads();
    {
        const int tau = tid >> 2, qd = tid & 3;
        bf16_t* mp = mixed + (tokc + tau) * DM + 768 + qd * 64; const bf16_t* bp2 = proj + (tokc + tau) * INW + C_AQ + qd * 64;
        const bf16_t* gp = proj + (tokc + tau) * INW + C_HG + qd * 64; const float* gn = P.hgrn_gn + layer * 256 + qd * 64;
        float o[64]; float sq = 0.f;
#pragma unroll
        for (int c4 = 0; c4 < 16; ++c4) {
            const unsigned long long fv = __hip_atomic_load((const unsigned long long*)(mp + c4 * 4), __ATOMIC_RELAXED, __HIP_MEMORY_SCOPE_AGENT), bv = __hip_atomic_load((const unsigned long long*)(bp2 + c4 * 4), __ATOMIC_RELAXED, __HIP_MEMORY_SCOPE_AGENT);
            const unsigned f0 = (unsigned)fv, f1 = (unsigned)(fv >> 32), b0 = (unsigned)bv, b1 = (unsigned)(bv >> 32);
            const float x0 = bflo(f0) + bflo(b0), x1 = bfhi(f0) + bfhi(b0), x2 = bflo(f1) + bflo(b1), x3 = bfhi(f1) + bfhi(b1);
            o[c4 * 4 + 0] = x0; o[c4 * 4 + 1] = x1; o[c4 * 4 + 2] = x2; o[c4 * 4 + 3] = x3; sq += (x0 * x0 + x1 * x1) + (x2 * x2 + x3 * x3); }
        sq += __shfl_xor(sq, 1); sq += __shfl_xor(sq, 2);
        const float rstd = rsqrtf(sq * (1.0f / 256.0f) + NORM_EPS);
#pragma unroll
        for (int c8 = 0; c8 < 8; ++c8) {
            const u32x4 gv = *(const u32x4*)(gp + c8 * 8); const f32x4 g0 = *(const f32x4*)(gn + c8 * 8), g1 = *(const f32x4*)(gn + c8 * 8 + 4);
            u32x4 r;
            r.x = pk2h(o[c8 * 8 + 0] * rstd * g0[0] * siluf(bflo(gv.x)), o[c8 * 8 + 1] * rstd * g0[1] * siluf(bfhi(gv.x)));
            r.y = pk2h(o[c8 * 8 + 2] * rstd * g0[2] * siluf(bflo(gv.y)), o[c8 * 8 + 3] * rstd * g0[3] * siluf(bfhi(gv.y)));
            r.z = pk2h(o[c8 * 8 + 4] * rstd * g1[0] * siluf(bflo(gv.z)), o[c8 * 8 + 5] * rstd * g1[1] * siluf(bfhi(gv.z)));
            r.w = pk2h(o[c8 * 8 + 6] * rstd * g1[2] * siluf(bflo(gv.w)), o[c8 * 8 + 7] * rstd * g1[3] * siluf(bfhi(gv.w)));
            *(u32x4*)(mp + c8 * 8) = r;
        }
    }
    __syncthreads();
}
constexpr int N_PHASES = 20;
#ifndef PROBE_MASK
#define PROBE_MASK 0u
#endif
#ifndef PROBE_U
#define PROBE_U 0
#endif
#ifndef STAGGER
#define STAGGER 0
#endif
#ifndef STAGGER_TICKS
#define STAGGER_TICKS 1000u
#endif
#ifndef GEMM_SP2
#define GEMM_SP2 true
#endif
#ifndef GEMM_ALIGN
#define GEMM_ALIGN true
#endif
#ifndef PROBE_SYNC2
#define PROBE_SYNC2 0
#endif
__device__ __forceinline__ void stagger_half(unsigned ticks) {
#if STAGGER
    if ((blockIdx.x >> 3) & 1) { const unsigned long long t0 = __builtin_amdgcn_s_memrealtime(); while (__builtin_amdgcn_s_memrealtime() - t0 < ticks) __builtin_amdgcn_s_sleep(32); }
    __syncthreads();
#endif
}
__device__ __forceinline__ void run_phase(const Params& P, LAS unsigned char* lds, int ph) {
    unsigned char* ws = P.ws;
    if (ph == 0) { phase_prologue(P, lds); return; }
    if (ph == N_PHASES - 1) { const float* ml = (const float*)(ws + WS_MOD) + (size_t)(DEPTH - 1) * NBATCH * NMOD * DM;
        phase_norm<2, false, true>(P.out, (const bf16_t*)(ws + WS_OB), ml + 2 * DM, (const bf16_t*)(ws + WS_HBUF), ml + 5 * DM, P.out, P.g_final, nullptr, nullptr, nullptr); return; }
    const int l = (ph - 1) / 9, s = (ph - 1) % 9;
    const float* mod = (const float*)(ws + WS_MOD) + (size_t)l * NBATCH * NMOD * DM; const float* modp = mod - (size_t)NBATCH * NMOD * DM;
    const float* xprev = (l == 1) ? P.x : P.out;
    bf16_t* hbuf = (bf16_t*)(ws + WS_HBUF); bf16_t* proj = (bf16_t*)(ws + WS_PROJ); bf16_t* ybuf = (bf16_t*)(ws + WS_OB);
#ifdef PH_ONLY
    if (s != PH_ONLY) return;
#endif
    int kD = DM, kF = FFN; asm volatile("" : "+s"(kD), "+s"(kF));
    switch (s) {
    case 0: if (l == 0) { phase_norm<0, false, false>(P.x, nullptr, nullptr, nullptr, nullptr, nullptr, P.g_mix, mod + 0 * DM, mod + 1 * DM, hbuf); phase_weights(P, lds); }
            else phase_norm<2, true, false>(xprev, ybuf, modp + 2 * DM, hbuf, modp + 5 * DM, P.out, P.g_mix + l * DM, mod + 0 * DM, mod + 1 * DM, hbuf);
            break;
    case 1: { pg8::Gemm g{hbuf, (const bf16_t*)(ws + WS_WIN) + (size_t)l * INWP * DM, NTOK, INWP, kD}; pg8::StaticOrder S; S.init(NTOK, INWP, gridDim.x, blockIdx.x);
              EpiProj E{proj, INW, INW}; pg8::gemm_phase<EpiProj, pg8::StaticOrder, GEMM_ALIGN, GEMM_SP2>(lds, g, S, E); } break;
    case 2: { for (int rp = 0; rp < (PROBE_U == 1 ? 2 : 1); ++rp) att_phase(P, lds);
              for (int rp = 0; rp < (PROBE_U == 2 ? 2 : 1); ++rp) retA_phase(P, lds);
              for (int rp = 0; rp < (PROBE_U == 3 ? 2 : 1); ++rp) for (int u = blockIdx.x; u < 1024; u += gridDim.x) hgA_unit(P, lds, u, l); } break;
    case 3: { ret_scan(P); hg_scan(P); } break;
    case 4: { for (int rp = 0; rp < (PROBE_U == 4 ? 2 : 1); ++rp) for (int u = blockIdx.x; u < 256; u += gridDim.x) hgB_unit(P, lds, u, l);
              for (int rp = 0; rp < (PROBE_U == 5 ? 2 : 1); ++rp) retB_phase(P, lds, l); att_merge(P); } break;
    case 5: { pg8::Gemm g{hbuf, (const bf16_t*)(ws + WS_WOUT) + (size_t)l * DM * DM, NTOK, DM, kD}; pg8::StaticOrder S; S.init(NTOK, DM, gridDim.x, blockIdx.x);
              EpiProj E{ybuf, DM, DM}; pg8::gemm_phase<EpiProj, pg8::StaticOrder, GEMM_ALIGN, GEMM_SP2>(lds, g, S, E); } break;
    case 6: phase_norm<1, false, false>(l == 0 ? P.x : P.out, ybuf, mod + 2 * DM, nullptr, nullptr, nullptr, P.g_ffn + l * DM, mod + 3 * DM, mod + 4 * DM, hbuf); break;
    case 7: { pg8::Gemm g{hbuf, (const bf16_t*)(ws + WS_WGU) + (size_t)l * 2 * FFN * DM, NTOK, 2 * FFN, kD}; pg8::StaticOrder S; S.init(NTOK, 2 * FFN, gridDim.x, blockIdx.x);
              EpiSwiglu E{proj}; pg8::gemm_phase<EpiSwiglu, pg8::StaticOrder, GEMM_ALIGN, GEMM_SP2>(lds, g, S, E); } break;
    case 8: { pg8::Gemm g{proj, (const bf16_t*)(ws + WS_WDN) + (size_t)l * DM * FFN, NTOK, DM, kF}; pg8::StaticOrder S; S.init(NTOK, DM, gridDim.x, blockIdx.x);
              EpiProj E{hbuf, DM, DM}; pg8::gemm_phase<EpiProj, pg8::StaticOrder, GEMM_ALIGN, GEMM_SP2>(lds, g, S, E); } break;
    }
}
__global__ void __launch_bounds__(NTHREADS) hybrid_fwd(Params P) {
    extern __shared__ __attribute__((aligned(16))) unsigned char lds_raw[];
    __shared__ uint4 xb_words;
    LAS unsigned char* lds = (LAS unsigned char*)lds_raw;
    if (threadIdx.x == 0) xb_words = make_uint4(0u, 0u, 0u, 0u);
    __syncthreads();
    XcdBarrier bar = xcd_barrier_post((unsigned*)(P.ws + WS_CTL), (volatile LAS unsigned*)&xb_words);
    for (int ph = P.ph_lo; ph < P.ph_hi; ++ph) {
        const int reps = ((PROBE_MASK >> ph) & 1u) ? 2 : 1;
        for (int rep = 0; rep < reps; ++rep) { run_phase(P, lds, ph); if (rep + 1 < reps) __syncthreads(); }
        if (ph + 1 < P.ph_hi) {
            if (P.ph_hi > N_PHASES) cg::this_grid().sync(); else xcd_barrier(bar);
            if (PROBE_SYNC2) xcd_barrier(bar);
        }
    }
}

extern "C" void kernel_launch(void* const* d_in, const int* in_sizes, int n_in, void* d_out, int out_size, void* d_ws, size_t ws_size, hipStream_t stream) {
    static int grid = 0;
    if (grid == 0) {
        if (n_in != 14 || out_size != NTOK * DM || ws_size < WS_END) { fprintf(stderr, "kernel_launch: unexpected shapes (n_in %d out %d ws %zu need %zu)\n", n_in, out_size, ws_size, (size_t)WS_END); grid = -1; return; }
        int dev = 0, cus = 0, per_cu = 0;
        hipGetDevice(&dev); hipDeviceGetAttribute(&cus, hipDeviceAttributeMultiprocessorCount, dev);
        if (hipFuncSetAttribute((const void*)hybrid_fwd, hipFuncAttributeMaxDynamicSharedMemorySize, LDS_BYTES) != hipSuccess) { fprintf(stderr, "kernel_launch: hipFuncSetAttribute failed\n"); grid = -1; return; }
        if (hipOccupancyMaxActiveBlocksPerMultiprocessor(&per_cu, (const void*)hybrid_fwd, NTHREADS, LDS_BYTES) != hipSuccess || per_cu < 1) { fprintf(stderr, "kernel_launch: occupancy query says %d\n", per_cu); grid = -1; return; }
        grid = cus;
    }
    if (grid < 0) return;
    if (hipMemsetAsync((char*)d_ws + WS_CTL, 0, 16384, stream) != hipSuccess) { fprintf(stderr, "kernel_launch: memset failed\n"); return; }
    Params p{};
    p.x = (const float*)d_in[0]; p.c = (const float*)d_in[1]; p.w_ada = (const float*)d_in[2]; p.b_ada = (const float*)d_in[3]; p.g_mix = (const float*)d_in[4];
    p.w_in = (const float*)d_in[5]; p.ret_gn = (const float*)d_in[6]; p.hgrn_gn = (const float*)d_in[7]; p.lb_logits = (const float*)d_in[8]; p.w_out = (const float*)d_in[9];
    p.g_ffn = (const float*)d_in[10]; p.w_gu = (const float*)d_in[11]; p.w_down = (const float*)d_in[12]; p.g_final = (const float*)d_in[13];
    p.out = (float*)d_out; p.ws = (unsigned char*)d_ws;
#if ONE_LAUNCH
    p.ph_lo = 0; p.ph_hi = N_PHASES;
    void* args[] = {&p};
    hipError_t e = hipLaunchCooperativeKernel((const void*)hybrid_fwd, dim3(grid), dim3(NTHREADS), args, LDS_BYTES, stream);
    if (e != hipSuccess) fprintf(stderr, "cooperative launch failed: %s (grid %d)\n", hipGetErrorString(e), grid);
#else
    for (int ph = 0; ph < N_PHASES; ++ph) { p.ph_lo = ph; p.ph_hi = ph + 1; hipLaunchKernelGGL(hybrid_fwd, dim3(grid), dim3(NTHREADS), LDS_BYTES, stream, p); }
#endif
}
```

```cpp
#include <hip/hip_runtime.h>
#include <hip/hip_cooperative_groups.h>
#include <cstdio>
#include <cstdint>
namespace cg = cooperative_groups;
#ifndef ONE_LAUNCH
#define ONE_LAUNCH 1
#endif
__device__ __forceinline__ int opaque_tid() { int t = threadIdx.x; asm volatile("" : "+v"(t)); return t; }
#define LAS __attribute__((address_space(3)))
namespace pg8 {
#define PG8_LAS __attribute__((address_space(3)))
typedef unsigned short bf16_t;
typedef short bf16x8 __attribute__((ext_vector_type(8)));
typedef float f32x4 __attribute__((ext_vector_type(4)));
typedef unsigned u32x4 __attribute__((ext_vector_type(4)));
constexpr int BM = 256, BK = 64, HALF = 128, HTB = HALF * BK * 2  , STAGE_BYTES = 8 * HTB, NXCD = 8, WGM = 8;

__host__ __device__ __forceinline__ int lds_byte(int r, int c) { const int st = (r >> 4) * 2 + (c >> 5), rr = r & 15, cc = c & 31, ob = rr * 64 + cc * 2; return st * 1024 + (ob ^ (((ob >> 9) & 1) << 5)); }
__host__ __device__ __forceinline__ void stage_rc(int b, int& R, int& C) { const int st = b / 1024, sb = b % 1024, swz = sb ^ (((sb >> 9) & 1) << 5); R = (st >> 1) * 16 + swz / 64; C = (st & 1) * 32 + (swz % 64) / 2; }
__host__ __device__ __forceinline__ int perm32(int rho) { const int n = rho >> 4, i = rho & 15; return 8 * (i >> 2) + 4 * n + (i & 3); }

struct Unit { int pm, pn; };
struct Gemm { const bf16_t* A; const bf16_t* Bt; int M, N, K; };

struct StaticOrder {
    int nM, nN, nwg, G, c;
    __host__ __device__ void init(int M, int N, int G_, int c_) { nM = M / BM; nN = N / BM; nwg = nM * nN; G = G_; c = c_; }
    __host__ __device__ bool next(int i, Unit& u) const {
        const long L = (long)i * G + c; if (L >= nwg) return false;
        int wgid = (int)L; { const int q = nwg / NXCD, r = nwg % NXCD, xcd = wgid % NXCD, off = wgid / NXCD; wgid = (xcd < r ? xcd * (q + 1) : r * (q + 1) + (xcd - r) * q) + off; }
        const int nig = WGM * nN, gid = wgid / nig, fm = gid * WGM, gsz = (nM - fm) < WGM ? (nM - fm) : WGM;
        u.pm = fm + ((wgid % nig) % gsz); u.pn = (wgid % nig) / gsz; return true;
    }
    __device__ __forceinline__ void a_ready(const Unit&) const {}
    __device__ __forceinline__ void done(const Unit&) const {}
};
__device__ __forceinline__ unsigned cvt_pk_bf16(float lo, float hi) { unsigned r; asm volatile("v_cvt_pk_bf16_f32 %0, %1, %2" : "=v"(r) : "v"(lo), "v"(hi)); return r; }
typedef float f32x2 __attribute__((ext_vector_type(2)));
template <class Epi, class Sched, bool ALIGN_EPI = false, bool SP2 = false>
__device__ __forceinline__ void gemm_phase(PG8_LAS unsigned char* lds, const Gemm g, const Sched& S, const Epi& E) {
    const int tid = opaque_tid(), wid = __builtin_amdgcn_readfirstlane(tid >> 6), lane = tid & 63, wr = wid >> 2, wc = wid & 3, fr = lane & 15, fq = lane >> 4;
    const int K = g.K, nt = K / BK;
    unsigned voffA[2], voffB[2];
#pragma unroll
    for (int i = 0; i < 2; ++i) { int R, C; stage_rc(tid * 16 + i * 8192, R, C); const int Rb = Epi::PERM ? ((R & ~31) + perm32(R & 31)) : R;
        voffA[i] = (unsigned)(R * K + C) * 2u; voffB[i] = (unsigned)(Rb * K + C) * 2u; }
    const size_t kstep = (size_t)(BK * 2);
    const size_t hstep = (size_t)HALF * K * 2;
    const size_t tstep = 2 * hstep;
    const unsigned ldsw = (unsigned)wid * 1024u;
    const int aoff = lds_byte(wr * 64 + fr, fq * 8), boff = lds_byte(wc * 32 + fr, fq * 8);
#define PG8_SA(b, h) (((b) * 2 + (h)) * HTB)
#define PG8_SB(b, h) ((4 + (b) * 2 + (h)) * HTB)
#define PG8_STAGE(bufoff, gbase, voff) do { _Pragma("unroll") for (int _i = 0; _i < 2; ++_i) \
        __builtin_amdgcn_global_load_lds((const unsigned*)((const char*)(gbase) + (voff)[_i]), (PG8_LAS unsigned*)(lds + (bufoff) + ldsw + _i * 8192), 16, 0, 0); } while (0)
#define PG8_LDA(dst, b, h) do { _Pragma("unroll") for (int m = 0; m < 4; ++m) _Pragma("unroll") for (int k = 0; k < 2; ++k) dst[m][k] = *(const PG8_LAS bf16x8*)(lds + PG8_SA(b, h) + aoff + m * 2048 + k * 1024); } while (0)
#define PG8_LDB(dst, b, h) do { _Pragma("unroll") for (int n = 0; n < 2; ++n) _Pragma("unroll") for (int k = 0; k < 2; ++k) dst[n][k] = *(const PG8_LAS bf16x8*)(lds + PG8_SB(b, h) + boff + n * 2048 + k * 1024); } while (0)
#define PG8_MMA(ai, bj, At, Bt) do { __builtin_amdgcn_s_setprio(1); _Pragma("unroll") for (int m = 0; m < 4; ++m) _Pragma("unroll") for (int n = 0; n < 2; ++n) _Pragma("unroll") for (int k = 0; k < 2; ++k) \
        acc[ai][bj][m][n] = __builtin_amdgcn_mfma_f32_16x16x32_bf16(Bt[n][k], At[m][k], acc[ai][bj][m][n], 0, 0, 0); __builtin_amdgcn_s_setprio(0); } while (0)
#define PG8_WAIT_V(n) asm volatile("s_waitcnt vmcnt(" #n ")" ::: "memory")
#define PG8_WAIT_L(n) asm volatile("s_waitcnt lgkmcnt(" #n ")" ::: "memory")
#define PG8_BAR __builtin_amdgcn_s_barrier()
#define PG8_SCHED __builtin_amdgcn_sched_barrier(0)
    Unit cur, nxt; int ui = 0;
    if (!S.next(0, cur)) return;
    f32x4 acc[2][2][4][2];
#pragma unroll
    for (int a = 0; a < 2; ++a)
#pragma unroll
        for (int b = 0; b < 2; ++b)
#pragma unroll
            for (int m = 0; m < 4; ++m)
#pragma unroll
                for (int n = 0; n < 2; ++n) acc[a][b][m][n] = (f32x4){0.f, 0.f, 0.f, 0.f};
    bf16x8 At[4][2], B0[2][2], B1[2][2];
    const char* cA = (const char*)g.A + (size_t)cur.pm * tstep; const char* cB = (const char*)g.Bt + (size_t)cur.pn * tstep;
    S.a_ready(cur);
    if constexpr (SP2) {
        PG8_STAGE(PG8_SB(0, 0), cB, voffB); PG8_STAGE(PG8_SB(0, 1), cB + hstep, voffB); PG8_STAGE(PG8_SA(0, 0), cA, voffA); PG8_STAGE(PG8_SA(0, 1), cA + hstep, voffA);
        if (wr == 1) PG8_BAR;
        PG8_WAIT_V(2); PG8_BAR;
        PG8_STAGE(PG8_SB(1, 0), cB + kstep, voffB); PG8_STAGE(PG8_SA(1, 0), cA + kstep, voffA); PG8_STAGE(PG8_SB(1, 1), cB + hstep + kstep, voffB);
        PG8_WAIT_V(6); PG8_BAR;
    } else {
        PG8_STAGE(PG8_SB(0, 0), cB, voffB); PG8_STAGE(PG8_SA(0, 0), cA, voffA); PG8_STAGE(PG8_SB(0, 1), cB + hstep, voffB); PG8_STAGE(PG8_SA(0, 1), cA + hstep, voffA);
        if (wr == 1) PG8_BAR;
        PG8_WAIT_V(4); PG8_BAR;
        PG8_STAGE(PG8_SB(1, 0), cB + kstep, voffB); PG8_STAGE(PG8_SA(1, 0), cA + kstep, voffA); PG8_STAGE(PG8_SB(1, 1), cB + hstep + kstep, voffB);
        PG8_WAIT_V(6); PG8_BAR;
    }
    for (;;) {
        const bool has_next = S.next(ui + 1, nxt);
        const char* nA = has_next ? (const char*)g.A + (size_t)nxt.pm * tstep : cA; const char* nB = has_next ? (const char*)g.Bt + (size_t)nxt.pn * tstep : cB;
        for (int t = 0; t < nt; t += 2) {
            const bool last = (t == nt - 2);
            const char* a1 = cA + (size_t)(t + 1) * kstep;
            const char* a2 = last ? nA : cA + (size_t)(t + 2) * kstep; const char* b2 = last ? nB : cB + (size_t)(t + 2) * kstep;
            const char* a3 = a2 + kstep; const char* b3 = b2 + kstep;
            if (last && has_next) S.a_ready(nxt);
            if constexpr (SP2) {
            PG8_LDB(B0, 0, 0); PG8_LDB(B1, 0, 1); PG8_SCHED; PG8_LDA(At, 0, 0); PG8_STAGE(PG8_SA(1, 1), a1 + hstep, voffA);
            PG8_WAIT_V(8); PG8_WAIT_L(0); PG8_BAR; PG8_MMA(0, 0, At, B0); PG8_MMA(0, 1, At, B1); PG8_BAR; PG8_SCHED;
            PG8_LDA(At, 0, 1); PG8_STAGE(PG8_SB(0, 0), b2, voffB); PG8_STAGE(PG8_SB(0, 1), b2 + hstep, voffB); PG8_STAGE(PG8_SA(0, 0), a2, voffA);
            PG8_WAIT_V(8); PG8_WAIT_L(0); PG8_BAR; PG8_MMA(1, 0, At, B0); PG8_MMA(1, 1, At, B1); PG8_BAR; PG8_SCHED;
            PG8_LDB(B0, 1, 0); PG8_LDB(B1, 1, 1); PG8_SCHED; PG8_LDA(At, 1, 0); PG8_STAGE(PG8_SA(0, 1), a2 + hstep, voffA);
            PG8_WAIT_V(8); PG8_WAIT_L(0); PG8_BAR; PG8_MMA(0, 0, At, B0); PG8_MMA(0, 1, At, B1); PG8_BAR; PG8_SCHED;
            PG8_LDA(At, 1, 1); PG8_STAGE(PG8_SB(1, 0), b3, voffB); PG8_STAGE(PG8_SB(1, 1), b3 + hstep, voffB); PG8_STAGE(PG8_SA(1, 0), a3, voffA);
            PG8_WAIT_V(8); PG8_WAIT_L(0); PG8_BAR; PG8_MMA(1, 0, At, B0); PG8_MMA(1, 1, At, B1); PG8_BAR; PG8_SCHED;
            } else {
            PG8_LDB(B0, 0, 0); PG8_SCHED; PG8_LDA(At, 0, 0); PG8_STAGE(PG8_SA(1, 1), a1 + hstep, voffA);
            PG8_WAIT_L(8); PG8_BAR; PG8_WAIT_L(0); PG8_MMA(0, 0, At, B0); PG8_BAR; PG8_SCHED;
            PG8_LDB(B1, 0, 1); PG8_STAGE(PG8_SB(0, 0), b2, voffB);
            PG8_BAR; PG8_WAIT_L(0); PG8_MMA(0, 1, At, B1); PG8_BAR;
            PG8_LDA(At, 0, 1); PG8_STAGE(PG8_SA(0, 0), a2, voffA);
            PG8_BAR; PG8_WAIT_L(0); PG8_MMA(1, 0, At, B0); PG8_BAR; PG8_SCHED;
            PG8_STAGE(PG8_SB(0, 1), b2 + hstep, voffB);
            PG8_WAIT_V(6); PG8_BAR; PG8_MMA(1, 1, At, B1); PG8_BAR;
            PG8_LDB(B0, 1, 0); PG8_SCHED; PG8_LDA(At, 1, 0); PG8_STAGE(PG8_SA(0, 1), a2 + hstep, voffA);
            PG8_WAIT_L(8); PG8_BAR; PG8_WAIT_L(0); PG8_MMA(0, 0, At, B0); PG8_BAR; PG8_SCHED;
            PG8_LDB(B1, 1, 1); PG8_STAGE(PG8_SB(1, 0), b3, voffB);
            PG8_BAR; PG8_WAIT_L(0); PG8_MMA(0, 1, At, B1); PG8_BAR;
            PG8_LDA(At, 1, 1); PG8_STAGE(PG8_SA(1, 0), a3, voffA);
            PG8_BAR; PG8_WAIT_L(0); PG8_MMA(1, 0, At, B0); PG8_BAR; PG8_SCHED;
            PG8_STAGE(PG8_SB(1, 1), b3 + hstep, voffB);
            PG8_WAIT_V(6); PG8_BAR; PG8_MMA(1, 1, At, B1); PG8_BAR;
            }
        }
        if constexpr (ALIGN_EPI) { if (wr == 0) PG8_BAR; }
        if constexpr (!Epi::AFTER_DRAIN) { E(acc, cur, wr, wc, fr, fq); S.done(cur); }
        if (!has_next) break;
#pragma unroll
        for (int a = 0; a < 2; ++a)
#pragma unroll
            for (int b = 0; b < 2; ++b)
#pragma unroll
                for (int m = 0; m < 4; ++m)
#pragma unroll
                    for (int n = 0; n < 2; ++n) acc[a][b][m][n] = (f32x4){0.f, 0.f, 0.f, 0.f};
        cur = nxt; cA = nA; cB = nB; ++ui;
        if constexpr (ALIGN_EPI) { if (wr == 1) PG8_BAR; }
    }
    PG8_WAIT_V(0);
    if constexpr (!ALIGN_EPI) { if (wr == 0) PG8_BAR; }
    PG8_BAR;
    if constexpr (Epi::AFTER_DRAIN) { E.fused(acc, cur, wr, wc, fr, fq, lds, wid, lane); S.done(cur); }
#undef PG8_SA
#undef PG8_SB
#undef PG8_STAGE
#undef PG8_LDA
#undef PG8_LDB
#undef PG8_MMA
#undef PG8_WAIT_V
#undef PG8_WAIT_L
#undef PG8_BAR
#undef PG8_SCHED
}
}

#define XB_TMO      128
#define XB_XCNT(j)  (256  + 64 * (j))
#define XB_XSUB(j)  (1280 + 64 * (j))
#define XB_XGEN(j)  (2304 + 64 * (j))
#define XB_TOP      3328
#define XB_TOPGEN   3392
#define XCD_BAR_WORDS 3456
#define XB_SPIN_CAP (1u << 18)

__device__ __forceinline__ unsigned xb_ld(unsigned* p)              { return __hip_atomic_load(p, __ATOMIC_RELAXED, __HIP_MEMORY_SCOPE_AGENT); }
__device__ __forceinline__ unsigned xb_add(unsigned* p, unsigned v) { return __hip_atomic_fetch_add(p, v, __ATOMIC_RELAXED, __HIP_MEMORY_SCOPE_AGENT); }
__device__ __forceinline__ unsigned xb_xcc_id() { return (unsigned)__builtin_amdgcn_s_getreg((3 << 11) | 20) & 0xFu; }
#define XB_SPIN(cond, bar) do { unsigned _sp = 0; while (cond) { __builtin_amdgcn_s_sleep(1); \
    if ((++_sp & 255u) == 0u) { if (xb_ld(&(bar)[XB_TMO])) break; if (_sp > XB_SPIN_CAP) { atomicAdd(&(bar)[XB_TMO], 1u); break; } } } } while (0)

struct XcdBarrier {
    unsigned* bar; unsigned x;
    volatile LAS unsigned* st;
};

__device__ __forceinline__ XcdBarrier xcd_barrier_post(unsigned* bar, volatile LAS unsigned* st) {
    XcdBarrier b; b.bar = bar; b.x = xb_xcc_id(); b.st = st;
    if (threadIdx.x == 0) (void)xb_add(&bar[XB_XCNT(b.x)], 1u);
    return b;
}
__device__ __forceinline__ void xcd_barrier_complete(unsigned* bar, unsigned x, unsigned& nloc, unsigned& nx) {
    const unsigned G = gridDim.x * gridDim.y * gridDim.z;
    unsigned sum, cnt, mine, sp = 0u;
    for (;;) {
        sum = 0u; cnt = 0u; mine = 0u;
#pragma unroll
        for (unsigned j = 0; j < 16; ++j) { const unsigned c = xb_ld(&bar[XB_XCNT(j)]); sum += c; cnt += (c > 0u) ? 1u : 0u; mine = (j == x) ? c : mine; }
        if (sum == G) break;
        __builtin_amdgcn_s_sleep(1);
        if ((++sp & 255u) == 0u) { if (xb_ld(&bar[XB_TMO])) break; if (sp > XB_SPIN_CAP) { atomicAdd(&bar[XB_TMO], 1u); break; } }
    }
    nloc = mine > 0u ? mine : 1u; nx = cnt > 0u ? cnt : 1u;
}

__device__ __forceinline__ void xcd_barrier(const XcdBarrier& b) {
    asm volatile("s_waitcnt vmcnt(0)" ::: "memory");
    __syncthreads();
    if (threadIdx.x == 0) {
        unsigned* bar = b.bar;
        __builtin_amdgcn_s_waitcnt(0);
        unsigned nloc = b.st[0], nx = b.st[1];
        if (nloc == 0u) { xcd_barrier_complete(bar, b.x, nloc, nx); b.st[0] = nloc; b.st[1] = nx; }
        const unsigned old = xb_add(&bar[XB_XSUB(b.x)], 1u);
        const unsigned gen = old / nloc;
        if (old + 1u == (gen + 1u) * nloc) {
            __builtin_amdgcn_fence(__ATOMIC_RELEASE, "agent");
            asm volatile("s_waitcnt vmcnt(0)" ::: "memory");
            const unsigned og = xb_add(&bar[XB_TOP], 1u);
            const unsigned tg = og / nx;
            if (og + 1u == (tg + 1u) * nx) xb_add(&bar[XB_TOPGEN], 1u);
            else XB_SPIN(xb_ld(&bar[XB_TOPGEN]) == tg, bar);
            __builtin_amdgcn_fence(__ATOMIC_ACQUIRE, "agent");
            xb_add(&bar[XB_XGEN(b.x)], 1u);
            asm volatile("s_waitcnt vmcnt(0)" ::: "memory");
        } else {
            XB_SPIN(xb_ld(&bar[XB_XGEN(b.x)]) == gen, bar);
            __builtin_amdgcn_fence(__ATOMIC_ACQUIRE, "agent");
            asm volatile("s_waitcnt vmcnt(0)" ::: "memory");
        }
    }
    __syncthreads();
}

typedef unsigned short bf16_t;
typedef short bf16x8 __attribute__((ext_vector_type(8)));
typedef short bf16x4 __attribute__((ext_vector_type(4)));
typedef float f32x4 __attribute__((ext_vector_type(4)));
typedef unsigned u32x4 __attribute__((ext_vector_type(4)));
typedef unsigned u32x2 __attribute__((ext_vector_type(2)));
constexpr int DM = 1024, NBATCH = 8, SEQ = 4096, NTOK = NBATCH * SEQ, DEPTH = 2;
constexpr int INW = 3968, INWP = 4096, FFN = 2816, NMOD = 6;
constexpr int C_AQ = 0, C_AK = 384, C_AV = 768, C_RQ = 1152, C_RK = 1536, C_RV = 1920, C_RG = 2304, C_HQ = 2688, C_HZF = 2944, C_HZB = 3200, C_HI = 3456, C_HG = 3712;
constexpr float NORM_EPS = 1e-6f;
constexpr int NTHREADS = 512;
constexpr int LDS_BYTES = 135168;
constexpr size_t WS_CTL = 0, WS_MOD = 16384, WS_LB = WS_MOD + 393216, WS_HGA = WS_LB + 2048, WS_LSE = WS_HGA + 524288, WS_WIN = WS_LSE + 2359296,
    WS_WOUT = WS_WIN + 16777216, WS_WGU = WS_WOUT + 4194304, WS_WDN = WS_WGU + 23068672, WS_HBUF = WS_WDN + 11534336, WS_PROJ = WS_HBUF + 67108864,
    WS_OB = WS_PROJ + 260046848, WS_RST = WS_OB + 75497472, WS_HGU = WS_RST + 25165824, WS_END = WS_HGU + 33554432;

struct Params {
    const float *x, *c, *w_ada, *b_ada, *g_mix, *w_in, *ret_gn, *hgrn_gn, *lb_logits, *w_out, *g_ffn, *w_gu, *w_down, *g_final;
    float* out; unsigned char* ws; int ph_lo, ph_hi;
};

__device__ __forceinline__ float bf2f(bf16_t v) { return __uint_as_float(((unsigned)v) << 16); }
__device__ __forceinline__ float bflo(unsigned w) { return __uint_as_float(w << 16); }
__device__ __forceinline__ float bfhi(unsigned w) { return __uint_as_float(w & 0xffff0000u); }
__device__ __forceinline__ bf16_t f2bf(float f) { return __builtin_bit_cast(bf16_t, (__bf16)f); }
typedef float f32x2c __attribute__((ext_vector_type(2)));
typedef __bf16 bf16v2c __attribute__((ext_vector_type(2)));
__device__ __forceinline__ unsigned pk2(float lo, float hi) { const f32x2c v = {lo, hi}; return __builtin_bit_cast(unsigned, __builtin_convertvector(v, bf16v2c)); }
__device__ __forceinline__ bf16x4 pk4(f32x4 v) { u32x2 w; w.x = pk2(v[0], v[1]); w.y = pk2(v[2], v[3]); return __builtin_bit_cast(bf16x4, w); }
__device__ __forceinline__ float siluf(float v) { return v * __builtin_amdgcn_rcpf(1.0f + __expf(-v)); }
__device__ __forceinline__ float wave_sum(float v) {
#pragma unroll
    for (int o = 1; o < 64; o <<= 1) v += __shfl_xor(v, o);
    return v;
}
#define MFMA32(a, b, c) __builtin_amdgcn_mfma_f32_16x16x32_bf16((a), (b), (c), 0, 0, 0)
#define MFMA16(a, b, c) __builtin_amdgcn_mfma_f32_16x16x16bf16_1k((a), (b), (c), 0, 0, 0)

struct EpiProj {
    static constexpr bool PERM = true, AFTER_DRAIN = false;
    bf16_t* O; int ldc, ncols;
    __device__ __forceinline__ void operator()(const f32x4 (&acc)[2][2][4][2], const pg8::Unit& u, int wr, int wc, int fr, int fq) const {
        const int row0 = u.pm * 256 + wr * 64 + fr, col0 = u.pn * 256 + wc * 32 + 8 * fq;
#pragma unroll
        for (int ai = 0; ai < 2; ++ai)
#pragma unroll
            for (int m = 0; m < 4; ++m) { bf16_t* rowp = O + (size_t)(row0 + ai * 128 + m * 16) * ldc + col0;
#pragma unroll
                for (int bj = 0; bj < 2; ++bj) { if (col0 + bj * 128 < ncols) { const f32x4 v0 = acc[ai][bj][m][0], v1 = acc[ai][bj][m][1];
                    u32x4 w; w.x = pk2(v0[0], v0[1]); w.y = pk2(v0[2], v0[3]); w.z = pk2(v1[0], v1[1]); w.w = pk2(v1[2], v1[3]);
                    *(u32x4*)(rowp + bj * 128) = w; } } }
    }
};
struct EpiRes {
    static constexpr bool PERM = false, AFTER_DRAIN = false;
    const float* base; float* out; const float* gate;
    __device__ __forceinline__ void operator()(const f32x4 (&acc)[2][2][4][2], const pg8::Unit& u, int wr, int wc, int fr, int fq) const {
        const int row0 = u.pm * 256 + wr * 64 + fr, col0 = u.pn * 256 + wc * 32 + 4 * fq;
        const float* gp = gate + (size_t)((u.pm * 256) >> 12) * (NMOD * DM) + col0;
        f32x4 gv[2][2];
#pragma unroll
        for (int bj = 0; bj < 2; ++bj)
#pragma unroll
            for (int n = 0; n < 2; ++n) gv[bj][n] = *(const f32x4*)(gp + bj * 128 + n * 16);
#pragma unroll
        for (int ai = 0; ai < 2; ++ai)
#pragma unroll
            for (int m = 0; m < 4; ++m) { const size_t off = (size_t)(row0 + ai * 128 + m * 16) * DM + col0;
#pragma unroll
                for (int bj = 0; bj < 2; ++bj)
#pragma unroll
                    for (int n = 0; n < 2; ++n) { const f32x4 bs = *(const f32x4*)(base + off + bj * 128 + n * 16);
                        *(f32x4*)(out + off + bj * 128 + n * 16) = bs + gv[bj][n] * acc[ai][bj][m][n]; } }
    }
};
struct EpiSwiglu {
    static constexpr bool PERM = true, AFTER_DRAIN = false;
    bf16_t* O;
    __device__ __forceinline__ void operator()(const f32x4 (&acc)[2][2][4][2], const pg8::Unit& u, int wr, int wc, int fr, int fq) const {
        const int row0 = u.pm * 256 + wr * 64 + fr, col0 = u.pn * 128 + wc * 32 + 8 * fq;
#pragma unroll
        for (int ai = 0; ai < 2; ++ai)
#pragma unroll
            for (int m = 0; m < 4; ++m) { bf16_t* rowp = O + (size_t)(row0 + ai * 128 + m * 16) * FFN + col0;
                float r[8];
#pragma unroll
                for (int n = 0; n < 2; ++n)
#pragma unroll
                    for (int i = 0; i < 4; ++i) { const float g = acc[ai][0][m][n][i], uu = acc[ai][1][m][n][i]; r[n * 4 + i] = siluf(g) * uu; }
                u32x4 w; w.x = pk2(r[0], r[1]); w.y = pk2(r[2], r[3]); w.z = pk2(r[4], r[5]); w.w = pk2(r[6], r[7]);
                *(u32x4*)rowp = w; }
    }
};
__device__ __forceinline__ void transpose_item(const float* W, int K, int N, bf16_t* WT, int dst_row0, int src_col0, int k0, LAS float* scr, int lane) {
    const int c = lane & 7, nr = lane >> 3;
    if (src_col0 < 0) {
#pragma unroll
        for (int j = 0; j < 8; ++j) *(u32x4*)(WT + (size_t)(dst_row0 + nr + 8 * j) * K + k0 + 8 * c) = (u32x4){0u, 0u, 0u, 0u};
        return;
    }
    const int kr = lane >> 4, c4 = lane & 15;
    f32x4 v[16];
#pragma unroll
    for (int i = 0; i < 16; ++i) v[i] = __builtin_nontemporal_load((const f32x4*)(W + (size_t)(k0 + 4 * i + kr) * N + src_col0 + 4 * c4));
#pragma unroll
    for (int i = 0; i < 16; ++i) { LAS float* d = scr + (4 * i + kr) * 65 + 4 * c4; d[0] = v[i][0]; d[1] = v[i][1]; d[2] = v[i][2]; d[3] = v[i][3]; }
    __builtin_amdgcn_fence(__ATOMIC_RELEASE, "wavefront"); __builtin_amdgcn_wave_barrier(); __builtin_amdgcn_fence(__ATOMIC_ACQUIRE, "wavefront");
#pragma unroll
    for (int j = 0; j < 8; ++j) { const int n = nr + 8 * j; const LAS float* sp = scr + (8 * c) * 65 + n;
        u32x4 o; o.x = pk2(sp[0 * 65], sp[1 * 65]); o.y = pk2(sp[2 * 65], sp[3 * 65]); o.z = pk2(sp[4 * 65], sp[5 * 65]); o.w = pk2(sp[6 * 65], sp[7 * 65]);
        *(u32x4*)(WT + (size_t)(dst_row0 + n) * K + k0 + 8 * c) = o; }
    __builtin_amdgcn_fence(__ATOMIC_RELEASE, "wavefront"); __builtin_amdgcn_wave_barrier(); __builtin_amdgcn_fence(__ATOMIC_ACQUIRE, "wavefront");
}

__device__ __forceinline__ void phase_weights(const Params& P, LAS unsigned char* lds) {
    const int tid = opaque_tid(), lane = tid & 63, wave = __builtin_amdgcn_readfirstlane(tid >> 6);
    unsigned char* ws = P.ws;
    {
        LAS float* scr = (LAS float*)(lds + wave * 16640);
        const int gw = blockIdx.x * 8 + wave, NGW = gridDim.x * 8;
        constexpr int I_IN = 16 * 64, I_OUT = 16 * 16, I_GU = 16 * 88, I_DN = 44 * 16, I_L = I_IN + I_OUT + I_GU + I_DN;
        for (int it = gw; it < DEPTH * I_L; it += NGW) {
            const int l = it / I_L; int r = it % I_L;
            if (r < I_IN) { const int kb = r / 64, nb = r % 64, n0 = nb * 64;
                transpose_item(P.w_in + (size_t)l * DM * INW, DM, INW, (bf16_t*)(ws + WS_WIN) + (size_t)l * INWP * DM, n0, n0 < INW ? n0 : -1, kb * 64, scr, lane); continue; }
            r -= I_IN;
            if (r < I_OUT) { const int kb = r / 16, nb = r % 16;
                transpose_item(P.w_out + (size_t)l * DM * DM, DM, DM, (bf16_t*)(ws + WS_WOUT) + (size_t)l * DM * DM, nb * 64, nb * 64, kb * 64, scr, lane); continue; }
            r -= I_OUT;
            if (r < I_GU) { const int kb = r / 88, nb = r % 88, n0 = nb * 64; const int pn = n0 >> 8, half = (n0 >> 7) & 1, jj = n0 & 127;
                transpose_item(P.w_gu + (size_t)l * DM * 2 * FFN, DM, 2 * FFN, (bf16_t*)(ws + WS_WGU) + (size_t)l * 2 * FFN * DM, n0, half * FFN + pn * 128 + jj, kb * 64, scr, lane); continue; }
            r -= I_GU;
            { const int kb = r / 16, nb = r % 16;
                transpose_item(P.w_down + (size_t)l * FFN * DM, FFN, DM, (bf16_t*)(ws + WS_WDN) + (size_t)l * DM * FFN, nb * 64, nb * 64, kb * 64, scr, lane); }
        }
    }
}
__device__ __forceinline__ void phase_prologue(const Params& P, LAS unsigned char* lds) {
    const int tid = opaque_tid();
    unsigned char* ws = P.ws;
    {
        LAS float* sc = (LAS float*)lds;
        LAS float* red = (LAS float*)(lds + 32768);
        for (int i = tid; i < NBATCH * DM; i += NTHREADS) sc[i] = siluf(P.c[i]);
        __syncthreads();
        float* mod = (float*)(ws + WS_MOD);
        for (int u = blockIdx.x; u < DEPTH * 96; u += gridDim.x) {
            const int l = u / 96, j0 = (u % 96) * 64, col = tid & 63, kp = tid >> 6;
            float acc[8];
#pragma unroll
            for (int b = 0; b < 8; ++b) acc[b] = 0.f;
            const float* wp = P.w_ada + (size_t)l * DM * (NMOD * DM) + j0 + col;
            for (int k = kp * 128; k < kp * 128 + 128; ++k) { const float w = __builtin_nontemporal_load(wp + (size_t)k * (NMOD * DM));
#pragma unroll
                for (int b = 0; b < 8; ++b) acc[b] += sc[b * DM + k] * w; }
#pragma unroll
            for (int b = 0; b < 8; ++b) red[(kp * 8 + b) * 64 + col] = acc[b];
            __syncthreads();
            { const int b = tid >> 6; float s = 0.f;
#pragma unroll
              for (int p = 0; p < 8; ++p) s += red[(p * 8 + b) * 64 + col];
              mod[((size_t)l * NBATCH + b) * (NMOD * DM) + j0 + col] = s + P.b_ada[(size_t)l * NMOD * DM + j0 + col]; }
            __syncthreads();
        }
    }
    if (blockIdx.x == 0 && tid < 256) {
        const float l0 = P.lb_logits[tid], l1 = P.lb_logits[256 + tid], m = fmaxf(l0, l1), e0 = __expf(l0 - m), e1 = __expf(l1 - m);
        const float p0 = e0 / (e0 + e1), p1 = e1 / (e0 + e1);
        float* lb = (float*)(ws + WS_LB);
        lb[tid] = fminf(fmaxf(p0 - p0, 0.f), 1.0f - 1e-6f);
        lb[256 + tid] = fminf(fmaxf((p0 + p1) - p0, 0.f), 1.0f - 1e-6f);
    }
}

template <int NY, bool WRITE_X, bool FINAL>
__device__ __forceinline__ void phase_norm(const float* src, const bf16_t* y, const float* gate, const bf16_t* y2, const float* gate2, float* xout, const float* g, const float* shift, const float* scale, bf16_t* dst) {
    constexpr bool HAS_Y = NY > 0;
    const int tid = opaque_tid(), lane = tid & 63, wave = tid >> 6;
    const int gw = blockIdx.x * 8 + wave, NGW = gridDim.x * 8;
    f32x4 gv[4];
#pragma unroll
    for (int j = 0; j < 4; ++j) gv[j] = *(const f32x4*)(g + 4 * lane + 256 * j);
    const int WPB = NGW / NBATCH, b = gw / WPB;
    if (b >= NBATCH) return;
    f32x4 gtv[4], gtv2[4], scv[4], shv[4];
#pragma unroll
    for (int j = 0; j < 4; ++j) {
        if (HAS_Y) gtv[j] = *(const f32x4*)(gate + (size_t)b * (NMOD * DM) + 4 * lane + 256 * j);
        if (NY > 1) gtv2[j] = *(const f32x4*)(gate2 + (size_t)b * (NMOD * DM) + 4 * lane + 256 * j);
        if (!FINAL) { scv[j] = *(const f32x4*)(scale + (size_t)b * (NMOD * DM) + 4 * lane + 256 * j) + 1.0f; shv[j] = *(const f32x4*)(shift + (size_t)b * (NMOD * DM) + 4 * lane + 256 * j); }
    }
    for (int row = b * SEQ + (gw - b * WPB); row < (b + 1) * SEQ; row += WPB) {
        const f32x4* xr = (const f32x4*)(src + (size_t)row * DM) + lane;
        f32x4 v[4]; float s = 0.f;
#pragma unroll
        for (int j = 0; j < 4; ++j) v[j] = __builtin_nontemporal_load(xr + 64 * j);
        if (HAS_Y) {
            const u32x2* yr = (const u32x2*)(y + (size_t)row * DM) + lane;
#pragma unroll
            for (int j = 0; j < 4; ++j) { const u32x2 yw = __builtin_nontemporal_load(yr + 64 * j); const f32x4 gt = gtv[j];
                v[j][0] += gt[0] * bflo(yw.x); v[j][1] += gt[1] * bfhi(yw.x); v[j][2] += gt[2] * bflo(yw.y); v[j][3] += gt[3] * bfhi(yw.y); }
        }
        if (NY > 1) {
            const u32x2* yr2 = (const u32x2*)(y2 + (size_t)row * DM) + lane;
#pragma unroll
            for (int j = 0; j < 4; ++j) { const u32x2 yw = __builtin_nontemporal_load(yr2 + 64 * j); const f32x4 gt = gtv2[j];
                v[j][0] += gt[0] * bflo(yw.x); v[j][1] += gt[1] * bfhi(yw.x); v[j][2] += gt[2] * bflo(yw.y); v[j][3] += gt[3] * bfhi(yw.y); }
        }
#pragma unroll
        for (int j = 0; j < 4; ++j) s += (v[j][0] * v[j][0] + v[j][1] * v[j][1]) + (v[j][2] * v[j][2] + v[j][3] * v[j][3]);
        const float rstd = rsqrtf(wave_sum(s) * (1.0f / DM) + NORM_EPS);
        f32x4* xo = (f32x4*)(xout + (size_t)row * DM) + lane;
        if (FINAL) {
#pragma unroll
            for (int j = 0; j < 4; ++j) __builtin_nontemporal_store(v[j] * rstd * gv[j], xo + 64 * j);
        } else {
            if (WRITE_X) {
#pragma unroll
                for (int j = 0; j < 4; ++j) __builtin_nontemporal_store(v[j], xo + 64 * j);
            }
            unsigned long long* o8 = (unsigned long long*)(dst + (size_t)row * DM) + lane;
#pragma unroll
            for (int j = 0; j < 4; ++j) {
                const f32x4 h = v[j] * rstd * gv[j] * scv[j] + shv[j];
                o8[64 * j] = (unsigned long long)pk2(h[0], h[1]) | ((unsigned long long)pk2(h[2], h[3]) << 32);
            }
        }
    }
}
__device__ __forceinline__ bf16x4 tr4(const LAS bf16_t* img, int pitch, int row0, int col0, int g, int q) {
    return __builtin_amdgcn_ds_read_tr16_b64_v4i16((LAS bf16x4*)(img + (row0 + 4 * g + (q >> 2)) * pitch + col0 + 4 * (q & 3)));
}
__device__ __forceinline__ bf16x8 tr8(const LAS bf16_t* img, int pitch, int row0, int col0, int g, int q) {
    const bf16x4 lo = __builtin_amdgcn_ds_read_tr16_b64_v4i16((LAS bf16x4*)(img + (row0 + 8 * g + (q >> 2)) * pitch + col0 + 4 * (q & 3)));
    const bf16x4 hi = __builtin_amdgcn_ds_read_tr16_b64_v4i16((LAS bf16x4*)(img + (row0 + 8 * g + 4 + (q >> 2)) * pitch + col0 + 4 * (q & 3)));
    return __builtin_shufflevector(lo, hi, 0, 1, 2, 3, 4, 5, 6, 7);
}
struct AttRegs { u32x4 kv[3][2], vv[3][2]; bf16x8 qf[2][2]; };
constexpr int ATT_UNITS = 2304;
__device__ __forceinline__ void att_decode(int u, int& br, int& b, int& h, int& r, int& L, int& p0, int& tok0) {
    const int pi = u >> 6, k = u & 63; b = pi / 6; h = pi % 6; br = k >> 4; const int w = k & 15;
    const int lr = br * 2, nblk = 16 >> lr, rho = w >> (4 - lr), blk = w & (nblk - 1); r = 1 << lr; L = SEQ >> lr; p0 = blk * 256; tok0 = b * SEQ + rho;
}
__device__ __forceinline__ int att_unit(int li, int x) { const int pl = li / 48, k = li - pl * 48; return ((x + 8 * pl) << 6) | k; }
__device__ __forceinline__ void att_load_kv(const Params& P, int u, int tid, AttRegs& R) {
    int br, b, h, r, L, p0, tok0; att_decode(u, br, b, h, r, L, p0, tok0);
    const bf16_t* proj = (const bf16_t*)(P.ws + WS_PROJ);
#pragma unroll
    for (int it = 0; it < 3; ++it) {
        const int item = tid + it * NTHREADS, key = item >> 2, qd = item & 3, kj = p0 - 64 + key;
        if (kj >= 0 && kj < L) {
            const bf16_t* src = proj + (size_t)(tok0 + r * kj) * INW + h * 64 + qd * 16;
#pragma unroll
            for (int i = 0; i < 2; ++i) { R.kv[it][i] = *(const u32x4*)(src + C_AK + 8 * i); R.vv[it][i] = *(const u32x4*)(src + C_AV + 8 * i); }
        } else {
#pragma unroll
            for (int i = 0; i < 2; ++i) { R.kv[it][i] = (u32x4){0u, 0u, 0u, 0u}; R.vv[it][i] = (u32x4){0u, 0u, 0u, 0u}; }
        }
    }
}
__device__ __forceinline__ void att_load_q(const Params& P, int u, int tid, AttRegs& R) {
    int br, b, h, r, L, p0, tok0; att_decode(u, br, b, h, r, L, p0, tok0);
    const bf16_t* proj = (const bf16_t*)(P.ws + WS_PROJ);
    const int lane = tid & 63, wave = tid >> 6, q = lane & 15, g = lane >> 4;
#pragma unroll
    for (int qt = 0; qt < 2; ++qt) {
        const size_t tokq = (size_t)(tok0 + r * (p0 + 32 * wave + 16 * qt + q));
#pragma unroll
        for (int kk = 0; kk < 2; ++kk) R.qf[qt][kk] = *(const bf16x8*)(proj + tokq * INW + C_AQ + h * 64 + kk * 32 + 8 * g);
    }
}
__device__ __forceinline__ void att_phase(const Params& P, LAS unsigned char* lds) {
    const int tid = opaque_tid(), lane = tid & 63, wave = __builtin_amdgcn_readfirstlane(tid >> 6), q = lane & 15, g = lane >> 4;
    LAS bf16_t* Ks = (LAS bf16_t*)lds;
    LAS bf16_t* Vs = (LAS bf16_t*)(lds + 55296);
    const int xq = blockIdx.x & 7, nj = ((int)gridDim.x + 7 - xq) >> 3;
    int li = blockIdx.x >> 3; if (li >= 288) return;
    AttRegs R; att_load_kv(P, att_unit(li, xq), tid, R); att_load_q(P, att_unit(li, xq), tid, R);
    for (; li < 288; li += nj) {
        const int u = att_unit(li, xq);
        int br, b, h, r, L, p0, tok0; att_decode(u, br, b, h, r, L, p0, tok0);
#pragma unroll
        for (int it = 0; it < 3; ++it) {
            const int item = tid + it * NTHREADS, key = item >> 2, qd = item & 3;
#pragma unroll
            for (int i = 0; i < 2; ++i) { *(LAS u32x4*)(Ks + key * 72 + qd * 16 + 8 * i) = R.kv[it][i]; *(LAS u32x4*)(Vs + key * 72 + qd * 16 + 8 * i) = R.vv[it][i]; }
        }
        __syncthreads();
        if (li + nj < 288) att_load_kv(P, att_unit(li + nj, xq), tid, R);
        const float slope_l2 = exp2f(-8.0f * (float)(h + 1) / 6.0f) * (float)r * 1.44269504f, qk_l2 = 0.125f * 1.44269504f;
        const float fbase = (float)(64 + q - 4 * g);
        const bool edge = (p0 < 64) || (p0 + 320 > L);
#pragma unroll
        for (int qt = 0; qt < 2; ++qt) {
            const int kw = 32 * wave + 16 * qt;
            const int p = p0 + kw + q; const size_t tokq = (size_t)(tok0 + r * p);
            f32x4 st[9]; float mx = -3.0e38f;
#pragma unroll
            for (int t = 0; t < 9; ++t) {
                f32x4 acc = {0.f, 0.f, 0.f, 0.f};
#pragma unroll
                for (int kk = 0; kk < 2; ++kk) { const bf16x8 a = *(const LAS bf16x8*)(Ks + (kw + 16 * t + q) * 72 + kk * 32 + 8 * g); acc = MFMA32(a, R.qf[qt][kk], acc); }
#pragma unroll
                for (int j = 0; j < 4; ++j) {
                    const float d = fabsf(fbase - (float)(16 * t + j));
                    float s = acc[j] * qk_l2 - slope_l2 * d;
                    if (t == 0 || t == 8) s = (d <= 64.0f) ? s : -1.0e30f;
                    acc[j] = s;
                }
                if (edge) {
#pragma unroll
                    for (int j = 0; j < 4; ++j) { const int kj = p0 - 64 + kw + 16 * t + 4 * g + j; acc[j] = (kj >= 0 && kj < L) ? acc[j] : -1.0e30f; }
                }
#pragma unroll
                for (int j = 0; j < 4; ++j) mx = fmaxf(mx, acc[j]);
                st[t] = acc;
            }
            if (qt == 1 && li + nj < 288) att_load_q(P, att_unit(li + nj, xq), tid, R);
            mx = fmaxf(mx, __shfl_xor(mx, 16)); mx = fmaxf(mx, __shfl_xor(mx, 32));
            float ls = 0.f; bf16x4 pt[9];
#pragma unroll
            for (int t = 0; t < 9; ++t) { f32x4 e;
#pragma unroll
                for (int j = 0; j < 4; ++j) { e[j] = __builtin_amdgcn_exp2f(st[t][j] - mx); ls += e[j]; }
                pt[t] = pk4(e); }
            ls += __shfl_xor(ls, 16); ls += __shfl_xor(ls, 32);
            const float inv = __builtin_amdgcn_rcpf(ls);
            bf16_t* ob = (bf16_t*)(P.ws + WS_OB) + ((size_t)br * NTOK + tokq) * 384 + h * 64;
            const LAS bf16_t* vrd = Vs + (kw + 4 * g + (q >> 2)) * 72 + 4 * (q & 3);
#pragma unroll
            for (int dt = 0; dt < 4; ++dt) {
                f32x4 acc = {0.f, 0.f, 0.f, 0.f};
#pragma unroll
                for (int t = 0; t < 9; ++t) { const bf16x4 a = __builtin_amdgcn_ds_read_tr16_b64_v4i16((LAS bf16x4*)(vrd + 16 * t * 72 + dt * 16)); acc = MFMA16(a, pt[t], acc); }
                acc = acc * inv;
                *(bf16x4*)(ob + dt * 16 + 4 * g) = pk4(acc);
            }
            if (g == 0) ((float*)(P.ws + WS_LSE))[((size_t)br * NTOK + tokq) * 6 + h] = (mx + __log2f(ls)) * 0.69314718f;
        }
        __syncthreads();
    }
}
__device__ __forceinline__ void att_merge(const Params& P) {
    const bf16_t* ob = (const bf16_t*)(P.ws + WS_OB); const float* lse = (const float*)(P.ws + WS_LSE); bf16_t* mixed = (bf16_t*)(P.ws + WS_HBUF);
    for (size_t it = (size_t)blockIdx.x * NTHREADS + opaque_tid(); it < (size_t)NTOK * 48; it += (size_t)gridDim.x * NTHREADS) {
        const size_t tok = it / 48; const int grp = (int)(it % 48), h = grp >> 3;
        const float l0 = lse[tok * 6 + h], l1 = lse[((size_t)NTOK + tok) * 6 + h], l2 = lse[((size_t)2 * NTOK + tok) * 6 + h];
        const float m = fmaxf(l0, fmaxf(l1, l2)), e0 = __expf(l0 - m), e1 = __expf(l1 - m), e2 = __expf(l2 - m), is = __builtin_amdgcn_rcpf(e0 + e1 + e2);
        const float w0 = e0 * is, w1 = e1 * is, w2 = e2 * is;
        const u32x4 a = __builtin_nontemporal_load((const u32x4*)(ob + tok * 384 + grp * 8)), bq = __builtin_nontemporal_load((const u32x4*)(ob + ((size_t)NTOK + tok) * 384 + grp * 8)), cq = __builtin_nontemporal_load((const u32x4*)(ob + ((size_t)2 * NTOK + tok) * 384 + grp * 8));
        u32x4 o;
#pragma unroll
        for (int i = 0; i < 4; ++i) o[i] = pk2(w0 * bflo(a[i]) + w1 * bflo(bq[i]) + w2 * bflo(cq[i]), w0 * bfhi(a[i]) + w1 * bfhi(bq[i]) + w2 * bfhi(cq[i]));
        *(u32x4*)(mixed + tok * DM + grp * 8) = o;
    }
}

__device__ __forceinline__ float ret_logg(int h) { return log1pf(-exp2f(-5.0f - (float)h)); }
struct RetARegs { u32x4 k0, k1, v0, v1; };
__device__ __forceinline__ void retA_load(const Params& P, int u, int tid, RetARegs& R) {
    const int bh = u >> 5, n = u & 31, b = bh / 6, h = bh % 6, c = tid >> 2, qd = tid & 3;
    const bf16_t* src = (const bf16_t*)(P.ws + WS_PROJ) + (size_t)(b * SEQ + n * 128 + c) * INW + h * 64 + qd * 16;
    R.k0 = *(const u32x4*)(src + C_RK); R.k1 = *(const u32x4*)(src + C_RK + 8); R.v0 = *(const u32x4*)(src + C_RV); R.v1 = *(const u32x4*)(src + C_RV + 8);
}
__device__ __forceinline__ void retA_phase(const Params& P, LAS unsigned char* lds) {
    const int tid = opaque_tid(), lane = tid & 63, wave = __builtin_amdgcn_readfirstlane(tid >> 6), q = lane & 15, g = lane >> 4;
    LAS bf16_t* Kf = (LAS bf16_t*)lds; LAS bf16_t* Kb = (LAS bf16_t*)(lds + 18432); LAS bf16_t* Vs = (LAS bf16_t*)(lds + 36864);
    int u = blockIdx.x; if (u >= 1536) return;
    RetARegs R; retA_load(P, u, tid, R);
    for (; u < 1536; u += gridDim.x) {
        const int bh = u >> 5, n = u & 31, h = bh % 6;
        const float lg = ret_logg(h);
        {
            const int c = tid >> 2, qd = tid & 3;
            const float wf = 0.125f * __expf(lg * (float)(127 - c)), wb = 0.125f * __expf(lg * (float)c);
            u32x4 f0, f1, b0, b1;
#pragma unroll
            for (int e = 0; e < 4; ++e) { f0[e] = pk2(bflo(R.k0[e]) * wf, bfhi(R.k0[e]) * wf); f1[e] = pk2(bflo(R.k1[e]) * wf, bfhi(R.k1[e]) * wf);
                b0[e] = pk2(bflo(R.k0[e]) * wb, bfhi(R.k0[e]) * wb); b1[e] = pk2(bflo(R.k1[e]) * wb, bfhi(R.k1[e]) * wb); }
            *(LAS u32x4*)(Kf + c * 72 + qd * 16) = f0; *(LAS u32x4*)(Kf + c * 72 + qd * 16 + 8) = f1;
            *(LAS u32x4*)(Kb + c * 72 + qd * 16) = b0; *(LAS u32x4*)(Kb + c * 72 + qd * 16 + 8) = b1;
            *(LAS u32x4*)(Vs + c * 72 + qd * 16) = R.v0; *(LAS u32x4*)(Vs + c * 72 + qd * 16 + 8) = R.v1;
        }
        __syncthreads();
        if (u + (int)gridDim.x < 1536) retA_load(P, u + gridDim.x, tid, R);
        const int dir = wave >> 2, dt = wave & 3; const LAS bf16_t* Kt = dir ? Kb : Kf;
        bf16x8 afr[4];
#pragma unroll
        for (int kk = 0; kk < 4; ++kk) afr[kk] = tr8(Kt, 72, kk * 32, dt * 16, g, q);
        bf16_t* dst = (bf16_t*)(P.ws + WS_RST) + ((size_t)(bh * 32 + n) * 2 + dir) * 4096;
#pragma unroll
        for (int et = 0; et < 4; ++et) {
            f32x4 acc = {0.f, 0.f, 0.f, 0.f};
#pragma unroll
            for (int kk = 0; kk < 4; ++kk) { const bf16x8 bfr = tr8(Vs, 72, kk * 32, et * 16, g, q); acc = MFMA32(afr[kk], bfr, acc); }
            *(bf16x4*)(dst + (et * 16 + q) * 64 + dt * 16 + 4 * g) = pk4(acc);
        }
        __syncthreads();
    }
}
__device__ __forceinline__ void ret_scan(const Params& P) {
    bf16_t* st = (bf16_t*)(P.ws + WS_RST);
    for (int it = blockIdx.x * NTHREADS + opaque_tid(); it < 48 * 2 * 512; it += gridDim.x * NTHREADS) {
        const int ch = it & 511, dir = (it >> 9) & 1, bh = it >> 10, h = bh % 6;
        const float cd = __expf(ret_logg(h) * 128.0f);
        float s[8];
#pragma unroll
        for (int e = 0; e < 8; ++e) s[e] = 0.f;
        for (int i0 = 0; i0 < 32; i0 += 8) {
            u32x4 v[8];
#pragma unroll
            for (int i = 0; i < 8; ++i) { const int n = dir ? 31 - (i0 + i) : (i0 + i); v[i] = *(const u32x4*)(st + ((size_t)(bh * 32 + n) * 2 + dir) * 4096 + 8 * ch); }
#pragma unroll
            for (int i = 0; i < 8; ++i) { const int n = dir ? 31 - (i0 + i) : (i0 + i);
                u32x4 o;
#pragma unroll
                for (int e = 0; e < 4; ++e) o[e] = pk2(s[2 * e], s[2 * e + 1]);
                *(u32x4*)(st + ((size_t)(bh * 32 + n) * 2 + dir) * 4096 + 8 * ch) = o;
#pragma unroll
                for (int e = 0; e < 4; ++e) { s[2 * e] = cd * s[2 * e] + bflo(v[i][e]); s[2 * e + 1] = cd * s[2 * e + 1] + bfhi(v[i][e]); } }
        }
    }
}
struct RetBRegs { u32x4 k0, k1, v0, v1, rf, rb, q0, q1; };
__device__ __forceinline__ void retB_load(const Params& P, int u, int tid, RetBRegs& R) {
    const int bh = u >> 5, n = u & 31, b = bh / 6, h = bh % 6, c = tid >> 2, qd = tid & 3;
    const bf16_t* proj = (const bf16_t*)(P.ws + WS_PROJ);
    const bf16_t* src = proj + (size_t)(b * SEQ + n * 128 + c) * INW + h * 64 + qd * 16;
    R.k0 = *(const u32x4*)(src + C_RK); R.k1 = *(const u32x4*)(src + C_RK + 8); R.v0 = *(const u32x4*)(src + C_RV); R.v1 = *(const u32x4*)(src + C_RV + 8);
    const bf16_t* rs = (const bf16_t*)(P.ws + WS_RST) + (size_t)(bh * 32 + n) * 2 * 4096;
    const int e = tid >> 3, d8 = (tid & 7) * 8;
    R.rf = *(const u32x4*)(rs + e * 64 + d8); R.rb = *(const u32x4*)(rs + 4096 + e * 64 + d8);
    const int lane = tid & 63, wave = tid >> 6, q = lane & 15, g = lane >> 4;
    const bf16_t* qp = proj + (size_t)(b * SEQ + n * 128 + 16 * wave + q) * INW + C_RQ + h * 64 + 8 * g;
    R.q0 = *(const u32x4*)qp; R.q1 = *(const u32x4*)(qp + 32);
}
__device__ __forceinline__ void retB_phase(const Params& P, LAS unsigned char* lds, int layer) {
    const int tid = opaque_tid(), lane = tid & 63, wave = __builtin_amdgcn_readfirstlane(tid >> 6), q = lane & 15, g = lane >> 4;
    const bf16_t* proj = (const bf16_t*)(P.ws + WS_PROJ);
    LAS bf16_t* Ks = (LAS bf16_t*)lds;
    LAS bf16_t* Vs = (LAS bf16_t*)(lds + 18432);
    LAS bf16_t* Rf = (LAS bf16_t*)(lds + 36864);
    LAS bf16_t* Rb = (LAS bf16_t*)(lds + 46080);
    int u = blockIdx.x; if (u >= 1536) return;
    RetBRegs R; retB_load(P, u, tid, R);
    for (; u < 1536; u += gridDim.x) {
        const int bh = u >> 5, n = u & 31, b = bh / 6, h = bh % 6;
        const float lg = ret_logg(h);
        {
            const int c = tid >> 2, qd = tid & 3, e = tid >> 3, d8 = (tid & 7) * 8;
            *(LAS u32x4*)(Ks + c * 72 + qd * 16) = R.k0; *(LAS u32x4*)(Ks + c * 72 + qd * 16 + 8) = R.k1;
            *(LAS u32x4*)(Vs + c * 72 + qd * 16) = R.v0; *(LAS u32x4*)(Vs + c * 72 + qd * 16 + 8) = R.v1;
            *(LAS u32x4*)(Rf + e * 72 + d8) = R.rf; *(LAS u32x4*)(Rb + e * 72 + d8) = R.rb;
        }
        const u32x4 qraw[2] = {R.q0, R.q1};
        __syncthreads();
        if (u + (int)gridDim.x < 1536) retB_load(P, u + gridDim.x, tid, R);
        const int i = 16 * wave + q; const size_t tok = (size_t)(b * SEQ + n * 128 + i);
        u32x2 rgv[4]; f32x4 gnv[4];
#pragma unroll
        for (int et = 0; et < 4; ++et) { rgv[et] = *(const u32x2*)(proj + tok * INW + C_RG + h * 64 + et * 16 + 4 * g); gnv[et] = *(const f32x4*)(P.ret_gn + layer * 384 + h * 64 + et * 16 + 4 * g); }
        bf16x8 qf[2], qff[2], qfb[2];
        {
            const float ff = __expf(lg * (float)(i + 1)), fb = __expf(lg * (float)(128 - i));
#pragma unroll
            for (int kk = 0; kk < 2; ++kk) { const u32x4 raw = qraw[kk];
                qf[kk] = __builtin_bit_cast(bf16x8, raw); u32x4 a, c2;
#pragma unroll
                for (int e = 0; e < 4; ++e) { const float lo = bflo(raw[e]), hi = bfhi(raw[e]); a[e] = pk2(lo * ff, hi * ff); c2[e] = pk2(lo * fb, hi * fb); }
                qff[kk] = __builtin_bit_cast(bf16x8, a); qfb[kk] = __builtin_bit_cast(bf16x8, c2); }
        }
        bf16x4 pt[8];
#pragma unroll
        for (int jt = 0; jt < 8; ++jt) {
            f32x4 acc = {0.f, 0.f, 0.f, 0.f};
#pragma unroll
            for (int kk = 0; kk < 2; ++kk) { const bf16x8 a = *(const LAS bf16x8*)(Ks + (16 * jt + q) * 72 + kk * 32 + 8 * g); acc = MFMA32(a, qf[kk], acc); }
#pragma unroll
            for (int jj = 0; jj < 4; ++jj) { int dd = i - (16 * jt + 4 * g + jj); dd = dd < 0 ? -dd : dd; acc[jj] = acc[jj] * 0.125f * __expf(lg * (float)dd); }
            pt[jt] = pk4(acc);
        }
        f32x4 o[4];
#pragma unroll
        for (int et = 0; et < 4; ++et) {
            f32x4 acc = {0.f, 0.f, 0.f, 0.f};
#pragma unroll
            for (int jt = 0; jt < 8; ++jt) { const bf16x4 a = tr4(Vs, 72, 16 * jt, et * 16, g, q); acc = MFMA16(a, pt[jt], acc); }
#pragma unroll
            for (int kk = 0; kk < 2; ++kk) { const bf16x8 a = *(const LAS bf16x8*)(Rf + (et * 16 + q) * 72 + kk * 32 + 8 * g); acc = MFMA32(a, qff[kk], acc);
                const bf16x8 a2 = *(const LAS bf16x8*)(Rb + (et * 16 + q) * 72 + kk * 32 + 8 * g); acc = MFMA32(a2, qfb[kk], acc); }
            o[et] = acc;
        }
        float s = 0.f;
#pragma unroll
        for (int et = 0; et < 4; ++et) s += (o[et][0] + o[et][1]) + (o[et][2] + o[et][3]);
        s += __shfl_xor(s, 16); s += __shfl_xor(s, 32);
        const float mu = s * (1.0f / 64.0f); float vs = 0.f;
#pragma unroll
        for (int et = 0; et < 4; ++et) { o[et] = o[et] - mu; vs += (o[et][0] * o[et][0] + o[et][1] * o[et][1]) + (o[et][2] * o[et][2] + o[et][3] * o[et][3]); }
        vs += __shfl_xor(vs, 16); vs += __shfl_xor(vs, 32);
        const float rstd = rsqrtf(vs * (1.0f / 64.0f) + NORM_EPS);
        bf16_t* mixed = (bf16_t*)(P.ws + WS_HBUF) + tok * DM + 384 + h * 64;
#pragma unroll
        for (int et = 0; et < 4; ++et) {
            const f32x4 gn = gnv[et]; const u32x2 rg = rgv[et];
            f32x4 y; y[0] = o[et][0] * rstd * gn[0] * siluf(bflo(rg.x)); y[1] = o[et][1] * rstd * gn[1] * siluf(bfhi(rg.x));
            y[2] = o[et][2] * rstd * gn[2] * siluf(bflo(rg.y)); y[3] = o[et][3] * rstd * gn[3] * siluf(bfhi(rg.y));
            *(bf16x4*)(mixed + et * 16 + 4 * g) = pk4(y);
        }
        __syncthreads();
    }
}
__device__ __forceinline__ void hgrn_gate(float z, float lbv, float& f, float& kk) {
    z = fminf(fmaxf(z, -30.f), 30.f);
    const float ez = __expf(-z), sg = __builtin_amdgcn_rcpf(1.0f + ez);
    f = lbv + (1.0f - lbv) * sg; kk = (1.0f - lbv) * ez * sg;
}
__device__ __forceinline__ void hgA_unit(const Params& P, LAS unsigned char* lds, int u, int layer) {
    const int tid = opaque_tid(), lane = tid & 63, wave = __builtin_amdgcn_readfirstlane(tid >> 6), q = lane & 15, g = lane >> 4;
    const int bh = u >> 5, n = u & 31, b = bh >> 2, h = bh & 3;
    const bf16_t* proj = (const bf16_t*)(P.ws + WS_PROJ);
    LAS bf16_t* Kr = (LAS bf16_t*)lds;
    LAS bf16_t* Vs = (LAS bf16_t*)(lds + 36864);
    LAS float* segs = (LAS float*)(lds + 55296);
    const size_t tokc = (size_t)(b * SEQ + n * 128);
    {
        const int c = tid >> 2, qd = tid & 3; const bf16_t* src = proj + (tokc + c) * INW + C_HI + h * 64 + qd * 16;
        const u32x4 v0 = *(const u32x4*)src, v1 = *(const u32x4*)(src + 8);
        *(LAS u32x4*)(Vs + c * 72 + qd * 16) = v0; *(LAS u32x4*)(Vs + c * 72 + qd * 16 + 8) = v1;
    }
    const int d = tid & 63, dir = (tid >> 6) & 1, seg = tid >> 7;
    const float lbv = ((const float*)(P.ws + WS_LB))[layer * 256 + h * 64 + d];
    float lf[32], kk[32];
    {
        const bf16_t* zp = proj + (tokc + seg * 32) * INW + (dir ? C_HZB : C_HZF) + h * 64 + d;
        bf16_t zr[32];
#pragma unroll
        for (int i = 0; i < 32; ++i) zr[i] = zp[(size_t)i * INW];
#pragma unroll
        for (int i = 0; i < 32; ++i) hgrn_gate(bf2f(zr[i]), lbv, lf[i], kk[i]);
    }
    float ssum = 1.f;
#pragma unroll
    for (int i = 0; i < 32; ++i) ssum *= lf[i];
    segs[(dir * 4 + seg) * 64 + d] = ssum;
    __syncthreads();
    {
        float before = 1.f, after = 1.f;
#pragma unroll
        for (int s2 = 0; s2 < 4; ++s2) { const float v = segs[(dir * 4 + s2) * 64 + d]; if (s2 < seg) before *= v; if (s2 > seg) after *= v; }
        LAS bf16_t* kt = Kr + dir * (128 * 72) + (seg * 32) * 72 + d;
        if (dir == 0) {
            float run = after;
#pragma unroll
            for (int i = 31; i >= 0; --i) { kt[i * 72] = f2bf(kk[i] * run); run *= lf[i]; }
        } else {
            float run = before;
#pragma unroll
            for (int i = 0; i < 32; ++i) { kt[i * 72] = f2bf(kk[i] * run); run *= lf[i]; }
        }
        if (seg == 0) ((float*)(P.ws + WS_HGA))[((size_t)(bh * 2 + dir) * 32 + n) * 64 + d] = ssum * after;
    }
    __syncthreads();
    {
        const int wdir = wave >> 2, dt = wave & 3; const LAS bf16_t* krs = Kr + wdir * (128 * 72);
        bf16x8 afr[4];
#pragma unroll
        for (int kq = 0; kq < 4; ++kq) afr[kq] = tr8(krs, 72, kq * 32, dt * 16, g, q);
        float* dst = (float*)(P.ws + WS_HGU) + ((size_t)(bh * 2 + wdir) * 32 + n) * 4096;
#pragma unroll
        for (int et = 0; et < 4; ++et) {
            f32x4 acc = {0.f, 0.f, 0.f, 0.f};
#pragma unroll
            for (int kq = 0; kq < 4; ++kq) { const bf16x8 bfr = tr8(Vs, 72, kq * 32, et * 16, g, q); acc = MFMA32(afr[kq], bfr, acc); }
#pragma unroll
            for (int j = 0; j < 4; ++j) dst[(dt * 16 + 4 * g + j) * 64 + et * 16 + q] = acc[j];
        }
    }
    __syncthreads();
}
__device__ __forceinline__ void hg_scan(const Params& P) {
    float* U = (float*)(P.ws + WS_HGU); const float* A = (const float*)(P.ws + WS_HGA);
    const int nthr = gridDim.x * NTHREADS; int it0 = blockIdx.x * NTHREADS + opaque_tid() - 48 * 2 * 512; if (it0 < 0) it0 += nthr;
    for (int it = it0; it < 64 * 64 * 16; it += nthr) {
        const int e4 = it & 15, d = (it >> 4) & 63, bd = it >> 10, dir = bd & 1;
        f32x4 s = {0.f, 0.f, 0.f, 0.f};
        for (int i0 = 0; i0 < 32; i0 += 8) {
            f32x4 v[8]; float a[8];
#pragma unroll
            for (int i = 0; i < 8; ++i) { const int n = dir ? 31 - (i0 + i) : (i0 + i); v[i] = *(const f32x4*)(U + ((size_t)(bd * 32 + n) * 64 + d) * 64 + 4 * e4); a[i] = A[(size_t)(bd * 32 + n) * 64 + d]; }
#pragma unroll
            for (int i = 0; i < 8; ++i) { const int n = dir ? 31 - (i0 + i) : (i0 + i); *(f32x4*)(U + ((size_t)(bd * 32 + n) * 64 + d) * 64 + 4 * e4) = s; s = s * a[i] + v[i]; }
        }
    }
}
__device__ __forceinline__ unsigned pk2h(float lo, float hi) { return pk2(lo, hi); }
__device__ __forceinline__ bf16x4 pk4h(f32x4 v) { return pk4(v); }
struct MergeItem { u32x4 a, b, c; float l0, l1, l2; };
__device__ __forceinline__ void merge_load(const Params& P, size_t tok, int grp, MergeItem& M) {
    const bf16_t* ob = (const bf16_t*)(P.ws + WS_OB); const float* lse = (const float*)(P.ws + WS_LSE); const int h = grp >> 3;
    M.l0 = lse[tok * 6 + h]; M.l1 = lse[((size_t)NTOK + tok) * 6 + h]; M.l2 = lse[((size_t)2 * NTOK + tok) * 6 + h];
    M.a = __builtin_nontemporal_load((const u32x4*)(ob + tok * 384 + grp * 8)); M.b = __builtin_nontemporal_load((const u32x4*)(ob + ((size_t)NTOK + tok) * 384 + grp * 8)); M.c = __builtin_nontemporal_load((const u32x4*)(ob + ((size_t)2 * NTOK + tok) * 384 + grp * 8));
}
__device__ __forceinline__ void merge_finish(const Params& P, size_t tok, int grp, const MergeItem& M) {
    const float m = fmaxf(M.l0, fmaxf(M.l1, M.l2)), e0 = __expf(M.l0 - m), e1 = __expf(M.l1 - m), e2 = __expf(M.l2 - m), is = __builtin_amdgcn_rcpf(e0 + e1 + e2);
    const float w0 = e0 * is, w1 = e1 * is, w2 = e2 * is;
    u32x4 o;
#pragma unroll
    for (int i = 0; i < 4; ++i) o[i] = pk2(w0 * bflo(M.a[i]) + w1 * bflo(M.b[i]) + w2 * bflo(M.c[i]), w0 * bfhi(M.a[i]) + w1 * bfhi(M.b[i]) + w2 * bfhi(M.c[i]));
    *(u32x4*)((bf16_t*)(P.ws + WS_HBUF) + tok * DM + grp * 8) = o;
}
__device__ __forceinline__ void hgB_unit(const Params& P, LAS unsigned char* lds, int u, int layer) {
    const int tid = opaque_tid(), lane = tid & 63, wave = __builtin_amdgcn_readfirstlane(tid >> 6), q = lane & 15, g = lane >> 4;
    const int b = u >> 5, n = u & 31, h = wave >> 1, dir = wave & 1, bh = b * 4 + h;
    bf16_t* proj = (bf16_t*)(P.ws + WS_PROJ);
    bf16_t* mixed = (bf16_t*)(P.ws + WS_HBUF);
    LAS unsigned char* wl = lds + wave * 7168;
    LAS bf16_t* Qi = (LAS bf16_t*)wl;
    LAS bf16_t* Ki = (LAS bf16_t*)(wl + 2304);
    LAS bf16_t* Vs = (LAS bf16_t*)(wl + 4608);
    LAS float* Al = (LAS float*)(wl + 6912);
    const size_t tokc = (size_t)(b * SEQ + n * 128);
    const float lbv = ((const float*)(P.ws + WS_LB))[layer * 256 + h * 64 + lane];
    f32x4 S[4][4];
    {
        const float* sp = (const float*)(P.ws + WS_HGU) + ((size_t)(bh * 2 + dir) * 32 + n) * 4096;
#pragma unroll
        for (int dt = 0; dt < 4; ++dt)
#pragma unroll
            for (int et = 0; et < 4; ++et)
#pragma unroll
                for (int j = 0; j < 4; ++j) S[dt][et][j] = sp[(dt * 16 + 4 * g + j) * 64 + et * 16 + q];
    }
    bf16_t* odst = dir ? (proj + C_AQ + h * 64) : (mixed + 768 + h * 64); const size_t opitch = dir ? INW : DM;
    bf16_t qr[16], zz[16]; u32x4 v0, v1;
#define HGB_LOAD(SC) do { const size_t toks_ = tokc + (SC) * 16; const bf16_t* base_ = proj + toks_ * INW + h * 64 + lane; \
        _Pragma("unroll") for (int ii = 0; ii < 16; ++ii) { const int t_ = dir ? 15 - ii : ii; qr[ii] = base_[(size_t)t_ * INW + C_HQ]; zz[ii] = base_[(size_t)t_ * INW + (dir ? C_HZB : C_HZF)]; } \
        const bf16_t* vsrc_ = proj + (toks_ + (lane >> 2)) * INW + C_HI + h * 64 + (lane & 3) * 16; v0 = *(const u32x4*)vsrc_; v1 = *(const u32x4*)(vsrc_ + 8); } while (0)
    HGB_LOAD(dir ? 7 : 0);
    for (int i = 0; i < 8; ++i) {
        const int sc = dir ? 7 - i : i; const size_t toks = tokc + sc * 16;
        {
            *(LAS u32x4*)(Vs + (lane >> 2) * 72 + (lane & 3) * 16) = v0; *(LAS u32x4*)(Vs + (lane >> 2) * 72 + (lane & 3) * 16 + 8) = v1;
            float bp = 1.f;
#pragma unroll
            for (int ii = 0; ii < 16; ++ii) {
                const int t = dir ? 15 - ii : ii;
                float f, kk; hgrn_gate(bf2f(zz[ii]), lbv, f, kk); const float qv = siluf(bf2f(qr[ii]));
                bp *= f;
                Qi[t * 72 + lane] = f2bf(qv * bp); Ki[t * 72 + lane] = f2bf(kk * __builtin_amdgcn_rcpf(fmaxf(bp, 1.0e-30f)));
            }
            Al[lane] = bp;
        }
        if (i + 1 < 8) HGB_LOAD(dir ? 6 - i : i + 1);
        MergeItem M0, M1; const int id0 = tid + NTHREADS * i, id1 = tid + NTHREADS * (8 + i);
        merge_load(P, tokc + id0 / 48, id0 % 48, M0); if (i < 4) merge_load(P, tokc + id1 / 48, id1 % 48, M1);
        __builtin_amdgcn_fence(__ATOMIC_RELEASE, "wavefront"); __builtin_amdgcn_wave_barrier(); __builtin_amdgcn_fence(__ATOMIC_ACQUIRE, "wavefront");
        f32x4 at = {0.f, 0.f, 0.f, 0.f};
#pragma unroll
        for (int kq = 0; kq < 2; ++kq) { const bf16x8 a8 = *(const LAS bf16x8*)(Ki + q * 72 + kq * 32 + 8 * g), b8 = *(const LAS bf16x8*)(Qi + q * 72 + kq * 32 + 8 * g); at = MFMA32(a8, b8, at); }
#pragma unroll
        for (int j = 0; j < 4; ++j) { const int sl = 4 * g + j; const bool keep = dir ? (sl >= q) : (sl <= q); at[j] = keep ? at[j] : 0.f; }
        const bf16x4 p4 = pk4h(at);
        bf16x4 b4[4], v4[4];
#pragma unroll
        for (int dt = 0; dt < 4; ++dt) b4[dt] = *(const LAS bf16x4*)(Qi + q * 72 + dt * 16 + 4 * g);
#pragma unroll
        for (int et = 0; et < 4; ++et) v4[et] = tr4(Vs, 72, 0, et * 16, g, q);
#pragma unroll
        for (int et = 0; et < 4; ++et) {
            f32x4 o = {0.f, 0.f, 0.f, 0.f};
#pragma unroll
            for (int dt = 0; dt < 4; ++dt) o = MFMA16(pk4h(S[dt][et]), b4[dt], o);
            o = MFMA16(v4[et], p4, o);
            *(bf16x4*)(odst + (toks + q) * opitch + et * 16 + 4 * g) = pk4(o);
        }
#pragma unroll
        for (int dt = 0; dt < 4; ++dt) {
            const bf16x4 kT4 = tr4(Ki, 72, 0, dt * 16, g, q);
            const f32x4 al4 = *(const LAS f32x4*)(Al + dt * 16 + 4 * g);
#pragma unroll
            for (int et = 0; et < 4; ++et) { const f32x4 s2 = MFMA16(kT4, v4[et], S[dt][et]); S[dt][et] = s2 * al4; }
        }
        merge_finish(P, tokc + id0 / 48, id0 % 48, M0); if (i < 4) merge_finish(P, tokc + id1 / 48, id1 % 48, M1);
        __builtin_amdgcn_fence(__ATOMIC_RELEASE, "wavefront"); __builtin_amdgcn_wave_barrier(); __builtin_amdgcn_fence(__ATOMIC_ACQUIRE, "wavefront");
    }
    asm volatile("s_waitcnt vmcnt(0)" ::: "memory");
    __syncthreads();
    {
        const int tau = tid >> 2, qd = tid & 3;
        bf16_t* mp = mixed + (tokc + tau) * DM + 768 + qd * 64; const bf16_t* bp2 = proj + (tokc + tau) * INW + C_AQ + qd * 64;
        const bf16_t* gp = proj + (tokc + tau) * INW + C_HG + qd * 64; const float* gn = P.hgrn_gn + layer * 256 + qd * 64;
        float o[64]; float sq = 0.f;
#pragma unroll
        for (int c4 = 0; c4 < 16; ++c4) {
            const unsigned long long fv = __hip_atomic_load((const unsigned long long*)(mp + c4 * 4), __ATOMIC_RELAXED, __HIP_MEMORY_SCOPE_AGENT), bv = __hip_atomic_load((const unsigned long long*)(bp2 + c4 * 4), __ATOMIC_RELAXED, __HIP_MEMORY_SCOPE_AGENT);
            const unsigned f0 = (unsigned)fv, f1 = (unsigned)(fv >> 32), b0 = (unsigned)bv, b1 = (unsigned)(bv >> 32);
            const float x0 = bflo(f0) + bflo(b0), x1 = bfhi(f0) + bfhi(b0), x2 = bflo(f1) + bflo(b1), x3 = bfhi(f1) + bfhi(b1);
            o[c4 * 4 + 0] = x0; o[c4 * 4 + 1] = x1; o[c4 * 4 + 2] = x2; o[c4 * 4 + 3] = x3; sq += (x0 * x0 + x1 * x1) + (x2 * x2 + x3 * x3); }
        sq += __shfl_xor(sq, 1); sq += __shfl_xor(sq, 2);
        const float rstd = rsqrtf(sq * (1.0f / 256.0f) + NORM_EPS);
#pragma unroll
        for (int c8 = 0; c8 < 8; ++c8) {
            const u32x4 gv = *(const u32x4*)(gp + c8 * 8); const f32x4 g0 = *(const f32x4*)(gn + c8 * 8), g1 = *(const f32x4*)(gn + c8 * 8 + 4);
            u32x4 r;
            r.x = pk2h(o[c8 * 8 + 0] * rstd * g0[0] * siluf(bflo(gv.x)), o[c8 * 8 + 1] * rstd * g0[1] * siluf(bfhi(gv.x)));
            r.y = pk2h(o[c8 * 8 + 2] * rstd * g0[2] * siluf(bflo(gv.y)), o[c8 * 8 + 3] * rstd * g0[3] * siluf(bfhi(gv.y)));
            r.z = pk2h(o[c8 * 8 + 4] * rstd * g1[0] * siluf(bflo(gv.z)), o[c8 * 8 + 5] * rstd * g1[1] * siluf(bfhi(gv.z)));
            r.w = pk2h(o[c8 * 8 + 6] * rstd * g1[2] * siluf(bflo(gv.w)), o[c8 * 8 + 7] * rstd * g1[3] * siluf(bfhi(gv.w)));
            *(u32x4*)(mp + c8 * 8) = r;
        }
    }
    __syncthreads();
}
constexpr int N_PHASES = 20;
#ifndef PROBE_MASK
#define PROBE_MASK 0u
#endif
#ifndef PROBE_U
#define PROBE_U 0
#endif
#ifndef STAGGER
#define STAGGER 0
#endif
#ifndef STAGGER_TICKS
#define STAGGER_TICKS 1000u
#endif
#ifndef GEMM_SP2
#define GEMM_SP2 true
#endif
#ifndef GEMM_ALIGN
#define GEMM_ALIGN true
#endif
#ifndef PROBE_SYNC2
#define PROBE_SYNC2 0
#endif
__device__ __forceinline__ void stagger_half(unsigned ticks) {
#if STAGGER
    if ((blockIdx.x >> 3) & 1) { const unsigned long long t0 = __builtin_amdgcn_s_memrealtime(); while (__builtin_amdgcn_s_memrealtime() - t0 < ticks) __builtin_amdgcn_s_sleep(32); }
    __syncthreads();
#endif
}
__device__ __forceinline__ void run_phase(const Params& P, LAS unsigned char* lds, int ph) {
    unsigned char* ws = P.ws;
    if (ph == 0) { phase_prologue(P, lds); return; }
    if (ph == N_PHASES - 1) { const float* ml = (const float*)(ws + WS_MOD) + (size_t)(DEPTH - 1) * NBATCH * NMOD * DM;
        phase_norm<2, false, true>(P.out, (const bf16_t*)(ws + WS_OB), ml + 2 * DM, (const bf16_t*)(ws + WS_HBUF), ml + 5 * DM, P.out, P.g_final, nullptr, nullptr, nullptr); return; }
    const int l = (ph - 1) / 9, s = (ph - 1) % 9;
    const float* mod = (const float*)(ws + WS_MOD) + (size_t)l * NBATCH * NMOD * DM; const float* modp = mod - (size_t)NBATCH * NMOD * DM;
    const float* xprev = (l == 1) ? P.x : P.out;
    bf16_t* hbuf = (bf16_t*)(ws + WS_HBUF); bf16_t* proj = (bf16_t*)(ws + WS_PROJ); bf16_t* ybuf = (bf16_t*)(ws + WS_OB);
#ifdef PH_ONLY
    if (s != PH_ONLY) return;
#endif
    int kD = DM, kF = FFN; asm volatile("" : "+s"(kD), "+s"(kF));
    switch (s) {
    case 0: if (l == 0) { phase_norm<0, false, false>(P.x, nullptr, nullptr, nullptr, nullptr, nullptr, P.g_mix, mod + 0 * DM, mod + 1 * DM, hbuf); phase_weights(P, lds); }
            else phase_norm<2, true, false>(xprev, ybuf, modp + 2 * DM, hbuf, modp + 5 * DM, P.out, P.g_mix + l * DM, mod + 0 * DM, mod + 1 * DM, hbuf);
            break;
    case 1: { pg8::Gemm g{hbuf, (const bf16_t*)(ws + WS_WIN) + (size_t)l * INWP * DM, NTOK, INWP, kD}; pg8::StaticOrder S; S.init(NTOK, INWP, gridDim.x, blockIdx.x);
              EpiProj E{proj, INW, INW}; pg8::gemm_phase<EpiProj, pg8::StaticOrder, GEMM_ALIGN, GEMM_SP2>(lds, g, S, E); } break;
    case 2: { for (int rp = 0; rp < (PROBE_U == 1 ? 2 : 1); ++rp) att_phase(P, lds);
              for (int rp = 0; rp < (PROBE_U == 2 ? 2 : 1); ++rp) retA_phase(P, lds);
              for (int rp = 0; rp < (PROBE_U == 3 ? 2 : 1); ++rp) for (int u = blockIdx.x; u < 1024; u += gridDim.x) hgA_unit(P, lds, u, l); } break;
    case 3: { ret_scan(P); hg_scan(P); } break;
    case 4: { for (int rp = 0; rp < (PROBE_U == 4 ? 2 : 1); ++rp) for (int u = blockIdx.x; u < 256; u += gridDim.x) hgB_unit(P, lds, u, l);
              for (int rp = 0; rp < (PROBE_U == 5 ? 2 : 1); ++rp) retB_phase(P, lds, l); } break;
    case 5: { pg8::Gemm g{hbuf, (const bf16_t*)(ws + WS_WOUT) + (size_t)l * DM * DM, NTOK, DM, kD}; pg8::StaticOrder S; S.init(NTOK, DM, gridDim.x, blockIdx.x);
              EpiProj E{ybuf, DM, DM}; pg8::gemm_phase<EpiProj, pg8::StaticOrder, GEMM_ALIGN, GEMM_SP2>(lds, g, S, E); } break;
    case 6: phase_norm<1, false, false>(l == 0 ? P.x : P.out, ybuf, mod + 2 * DM, nullptr, nullptr, nullptr, P.g_ffn + l * DM, mod + 3 * DM, mod + 4 * DM, hbuf); break;
    case 7: { pg8::Gemm g{hbuf, (const bf16_t*)(ws + WS_WGU) + (size_t)l * 2 * FFN * DM, NTOK, 2 * FFN, kD}; pg8::StaticOrder S; S.init(NTOK, 2 * FFN, gridDim.x, blockIdx.x);
              EpiSwiglu E{proj}; pg8::gemm_phase<EpiSwiglu, pg8::StaticOrder, GEMM_ALIGN, GEMM_SP2>(lds, g, S, E); } break;
    case 8: { pg8::Gemm g{proj, (const bf16_t*)(ws + WS_WDN) + (size_t)l * DM * FFN, NTOK, DM, kF}; pg8::StaticOrder S; S.init(NTOK, DM, gridDim.x, blockIdx.x);
              EpiProj E{hbuf, DM, DM}; pg8::gemm_phase<EpiProj, pg8::StaticOrder, GEMM_ALIGN, GEMM_SP2>(lds, g, S, E); } break;
    }
}
__global__ void __launch_bounds__(NTHREADS) hybrid_fwd(Params P) {
    extern __shared__ __attribute__((aligned(16))) unsigned char lds_raw[];
    __shared__ uint4 xb_words;
    LAS unsigned char* lds = (LAS unsigned char*)lds_raw;
    if (threadIdx.x == 0) xb_words = make_uint4(0u, 0u, 0u, 0u);
    __syncthreads();
    XcdBarrier bar = xcd_barrier_post((unsigned*)(P.ws + WS_CTL), (volatile LAS unsigned*)&xb_words);
    for (int ph = P.ph_lo; ph < P.ph_hi; ++ph) {
        const int reps = ((PROBE_MASK >> ph) & 1u) ? 2 : 1;
        for (int rep = 0; rep < reps; ++rep) { run_phase(P, lds, ph); if (rep + 1 < reps) __syncthreads(); }
        if (ph + 1 < P.ph_hi) {
            if (P.ph_hi > N_PHASES) cg::this_grid().sync(); else xcd_barrier(bar);
            if (PROBE_SYNC2) xcd_barrier(bar);
        }
    }
}

extern "C" void kernel_launch(void* const* d_in, const int* in_sizes, int n_in, void* d_out, int out_size, void* d_ws, size_t ws_size, hipStream_t stream) {
    static int grid = 0;
    if (grid == 0) {
        if (n_in != 14 || out_size != NTOK * DM || ws_size < WS_END) { fprintf(stderr, "kernel_launch: unexpected shapes (n_in %d out %d ws %zu need %zu)\n", n_in, out_size, ws_size, (size_t)WS_END); grid = -1; return; }
        int dev = 0, cus = 0, per_cu = 0;
        hipGetDevice(&dev); hipDeviceGetAttribute(&cus, hipDeviceAttributeMultiprocessorCount, dev);
        if (hipFuncSetAttribute((const void*)hybrid_fwd, hipFuncAttributeMaxDynamicSharedMemorySize, LDS_BYTES) != hipSuccess) { fprintf(stderr, "kernel_launch: hipFuncSetAttribute failed\n"); grid = -1; return; }
        if (hipOccupancyMaxActiveBlocksPerMultiprocessor(&per_cu, (const void*)hybrid_fwd, NTHREADS, LDS_BYTES) != hipSuccess || per_cu < 1) { fprintf(stderr, "kernel_launch: occupancy query says %d\n", per_cu); grid = -1; return; }
        grid = cus;
    }
    if (grid < 0) return;
    if (hipMemsetAsync((char*)d_ws + WS_CTL, 0, 16384, stream) != hipSuccess) { fprintf(stderr, "kernel_launch: memset failed\n"); return; }
    Params p{};
    p.x = (const float*)d_in[0]; p.c = (const float*)d_in[1]; p.w_ada = (const float*)d_in[2]; p.b_ada = (const float*)d_in[3]; p.g_mix = (const float*)d_in[4];
    p.w_in = (const float*)d_in[5]; p.ret_gn = (const float*)d_in[6]; p.hgrn_gn = (const float*)d_in[7]; p.lb_logits = (const float*)d_in[8]; p.w_out = (const float*)d_in[9];
    p.g_ffn = (const float*)d_in[10]; p.w_gu = (const float*)d_in[11]; p.w_down = (const float*)d_in[12]; p.g_final = (const float*)d_in[13];
    p.out = (float*)d_out; p.ws = (unsigned char*)d_ws;
#if ONE_LAUNCH
    p.ph_lo = 0; p.ph_hi = N_PHASES;
    void* args[] = {&p};
    hipError_t e = hipLaunchCooperativeKernel((const void*)hybrid_fwd, dim3(grid), dim3(NTHREADS), args, LDS_BYTES, stream);
    if (e != hipSuccess) fprintf(stderr, "cooperative launch failed: %s (grid %d)\n", hipGetErrorString(e), grid);
#else
    for (int ph = 0; ph < N_PHASES; ++ph) { p.ph_lo = ph; p.ph_hi = ph + 1; hipLaunchKernelGGL(hybrid_fwd, dim3(grid), dim3(NTHREADS), LDS_BYTES, stream, p); }
#endif
}
```

```cpp
#include <hip/hip_runtime.h>
#include <hip/hip_cooperative_groups.h>
#include <cstdio>
#include <cstdint>
namespace cg = cooperative_groups;
#ifndef ONE_LAUNCH
#define ONE_LAUNCH 1
#endif
__device__ __forceinline__ int opaque_tid() { int t = threadIdx.x; asm volatile("" : "+v"(t)); return t; }
#define LAS __attribute__((address_space(3)))
namespace pg8 {
#define PG8_LAS __attribute__((address_space(3)))
typedef unsigned short bf16_t;
typedef short bf16x8 __attribute__((ext_vector_type(8)));
typedef float f32x4 __attribute__((ext_vector_type(4)));
typedef unsigned u32x4 __attribute__((ext_vector_type(4)));
constexpr int BM = 256, BK = 64, HALF = 128, HTB = HALF * BK * 2  , STAGE_BYTES = 8 * HTB, NXCD = 8, WGM = 8;

__host__ __device__ __forceinline__ int lds_byte(int r, int c) { const int st = (r >> 4) * 2 + (c >> 5), rr = r & 15, cc = c & 31, ob = rr * 64 + cc * 2; return st * 1024 + (ob ^ (((ob >> 9) & 1) << 5)); }
__host__ __device__ __forceinline__ void stage_rc(int b, int& R, int& C) { const int st = b / 1024, sb = b % 1024, swz = sb ^ (((sb >> 9) & 1) << 5); R = (st >> 1) * 16 + swz / 64; C = (st & 1) * 32 + (swz % 64) / 2; }
__host__ __device__ __forceinline__ int perm32(int rho) { const int n = rho >> 4, i = rho & 15; return 8 * (i >> 2) + 4 * n + (i & 3); }

struct Unit { int pm, pn; };
struct Gemm { const bf16_t* A; const bf16_t* Bt; int M, N, K; };

struct StaticOrder {
    int nM, nN, nwg, G, c;
    __host__ __device__ void init(int M, int N, int G_, int c_) { nM = M / BM; nN = N / BM; nwg = nM * nN; G = G_; c = c_; }
    __host__ __device__ bool next(int i, Unit& u) const {
        const long L = (long)i * G + c; if (L >= nwg) return false;
        int wgid = (int)L; { const int q = nwg / NXCD, r = nwg % NXCD, xcd = wgid % NXCD, off = wgid / NXCD; wgid = (xcd < r ? xcd * (q + 1) : r * (q + 1) + (xcd - r) * q) + off; }
        const int nig = WGM * nN, gid = wgid / nig, fm = gid * WGM, gsz = (nM - fm) < WGM ? (nM - fm) : WGM;
        u.pm = fm + ((wgid % nig) % gsz); u.pn = (wgid % nig) / gsz; return true;
    }
    __device__ __forceinline__ void a_ready(const Unit&) const {}
    __device__ __forceinline__ void done(const Unit&) const {}
};
__device__ __forceinline__ unsigned cvt_pk_bf16(float lo, float hi) { unsigned r; asm volatile("v_cvt_pk_bf16_f32 %0, %1, %2" : "=v"(r) : "v"(lo), "v"(hi)); return r; }
typedef float f32x2 __attribute__((ext_vector_type(2)));
template <class Epi, class Sched, bool ALIGN_EPI = false, bool SP2 = false>
__device__ __forceinline__ void gemm_phase(PG8_LAS unsigned char* lds, const Gemm g, const Sched& S, const Epi& E) {
    const int tid = opaque_tid(), wid = __builtin_amdgcn_readfirstlane(tid >> 6), lane = tid & 63, wr = wid >> 2, wc = wid & 3, fr = lane & 15, fq = lane >> 4;
    const int K = g.K, nt = K / BK;
    unsigned voffA[2], voffB[2];
#pragma unroll
    for (int i = 0; i < 2; ++i) { int R, C; stage_rc(tid * 16 + i * 8192, R, C); const int Rb = Epi::PERM ? ((R & ~31) + perm32(R & 31)) : R;
        voffA[i] = (unsigned)(R * K + C) * 2u; voffB[i] = (unsigned)(Rb * K + C) * 2u; }
    const size_t kstep = (size_t)(BK * 2);
    const size_t hstep = (size_t)HALF * K * 2;
    const size_t tstep = 2 * hstep;
    const unsigned ldsw = (unsigned)wid * 1024u;
    const int aoff = lds_byte(wr * 64 + fr, fq * 8), boff = lds_byte(wc * 32 + fr, fq * 8);
#define PG8_SA(b, h) (((b) * 2 + (h)) * HTB)
#define PG8_SB(b, h) ((4 + (b) * 2 + (h)) * HTB)
#define PG8_STAGE(bufoff, gbase, voff) do { _Pragma("unroll") for (int _i = 0; _i < 2; ++_i) \
        __builtin_amdgcn_global_load_lds((const unsigned*)((const char*)(gbase) + (voff)[_i]), (PG8_LAS unsigned*)(lds + (bufoff) + ldsw + _i * 8192), 16, 0, 0); } while (0)
#define PG8_LDA(dst, b, h) do { _Pragma("unroll") for (int m = 0; m < 4; ++m) _Pragma("unroll") for (int k = 0; k < 2; ++k) dst[m][k] = *(const PG8_LAS bf16x8*)(lds + PG8_SA(b, h) + aoff + m * 2048 + k * 1024); } while (0)
#define PG8_LDB(dst, b, h) do { _Pragma("unroll") for (int n = 0; n < 2; ++n) _Pragma("unroll") for (int k = 0; k < 2; ++k) dst[n][k] = *(const PG8_LAS bf16x8*)(lds + PG8_SB(b, h) + boff + n * 2048 + k * 1024); } while (0)
#define PG8_MMA(ai, bj, At, Bt) do { __builtin_amdgcn_s_setprio(1); _Pragma("unroll") for (int m = 0; m < 4; ++m) _Pragma("unroll") for (int n = 0; n < 2; ++n) _Pragma("unroll") for (int k = 0; k < 2; ++k) \
        acc[ai][bj][m][n] = __builtin_amdgcn_mfma_f32_16x16x32_bf16(Bt[n][k], At[m][k], acc[ai][bj][m][n], 0, 0, 0); __builtin_amdgcn_s_setprio(0); } while (0)
#define PG8_WAIT_V(n) asm volatile("s_waitcnt vmcnt(" #n ")" ::: "memory")
#define PG8_WAIT_L(n) asm volatile("s_waitcnt lgkmcnt(" #n ")" ::: "memory")
#define PG8_BAR __builtin_amdgcn_s_barrier()
#define PG8_SCHED __builtin_amdgcn_sched_barrier(0)
    Unit cur, nxt; int ui = 0;
    if (!S.next(0, cur)) return;
    f32x4 acc[2][2][4][2];
#pragma unroll
    for (int a = 0; a < 2; ++a)
#pragma unroll
        for (int b = 0; b < 2; ++b)
#pragma unroll
            for (int m = 0; m < 4; ++m)
#pragma unroll
                for (int n = 0; n < 2; ++n) acc[a][b][m][n] = (f32x4){0.f, 0.f, 0.f, 0.f};
    bf16x8 At[4][2], B0[2][2], B1[2][2];
    const char* cA = (const char*)g.A + (size_t)cur.pm * tstep; const char* cB = (const char*)g.Bt + (size_t)cur.pn * tstep;
    S.a_ready(cur);
    if constexpr (SP2) {
        PG8_STAGE(PG8_SB(0, 0), cB, voffB); PG8_STAGE(PG8_SB(0, 1), cB + hstep, voffB); PG8_STAGE(PG8_SA(0, 0), cA, voffA); PG8_STAGE(PG8_SA(0, 1), cA + hstep, voffA);
        if (wr == 1) PG8_BAR;
        PG8_WAIT_V(2); PG8_BAR;
        PG8_STAGE(PG8_SB(1, 0), cB + kstep, voffB); PG8_STAGE(PG8_SA(1, 0), cA + kstep, voffA); PG8_STAGE(PG8_SB(1, 1), cB + hstep + kstep, voffB);
        PG8_WAIT_V(6); PG8_BAR;
    } else {
        PG8_STAGE(PG8_SB(0, 0), cB, voffB); PG8_STAGE(PG8_SA(0, 0), cA, voffA); PG8_STAGE(PG8_SB(0, 1), cB + hstep, voffB); PG8_STAGE(PG8_SA(0, 1), cA + hstep, voffA);
        if (wr == 1) PG8_BAR;
        PG8_WAIT_V(4); PG8_BAR;
        PG8_STAGE(PG8_SB(1, 0), cB + kstep, voffB); PG8_STAGE(PG8_SA(1, 0), cA + kstep, voffA); PG8_STAGE(PG8_SB(1, 1), cB + hstep + kstep, voffB);
        PG8_WAIT_V(6); PG8_BAR;
    }
    for (;;) {
        const bool has_next = S.next(ui + 1, nxt);
        const char* nA = has_next ? (const char*)g.A + (size_t)nxt.pm * tstep : cA; const char* nB = has_next ? (const char*)g.Bt + (size_t)nxt.pn * tstep : cB;
        for (int t = 0; t < nt; t += 2) {
            const bool last = (t == nt - 2);
            const char* a1 = cA + (size_t)(t + 1) * kstep;
            const char* a2 = last ? nA : cA + (size_t)(t + 2) * kstep; const char* b2 = last ? nB : cB + (size_t)(t + 2) * kstep;
            const char* a3 = a2 + kstep; const char* b3 = b2 + kstep;
            if (last && has_next) S.a_ready(nxt);
            if constexpr (SP2) {
            PG8_LDB(B0, 0, 0); PG8_LDB(B1, 0, 1); PG8_SCHED; PG8_LDA(At, 0, 0); PG8_STAGE(PG8_SA(1, 1), a1 + hstep, voffA);
            PG8_WAIT_V(8); PG8_WAIT_L(0); PG8_BAR; PG8_MMA(0, 0, At, B0); PG8_MMA(0, 1, At, B1); PG8_BAR; PG8_SCHED;
            PG8_LDA(At, 0, 1); PG8_STAGE(PG8_SB(0, 0), b2, voffB); PG8_STAGE(PG8_SB(0, 1), b2 + hstep, voffB); PG8_STAGE(PG8_SA(0, 0), a2, voffA);
            PG8_WAIT_V(8); PG8_WAIT_L(0); PG8_BAR; PG8_MMA(1, 0, At, B0); PG8_MMA(1, 1, At, B1); PG8_BAR; PG8_SCHED;
            PG8_LDB(B0, 1, 0); PG8_LDB(B1, 1, 1); PG8_SCHED; PG8_LDA(At, 1, 0); PG8_STAGE(PG8_SA(0, 1), a2 + hstep, voffA);
            PG8_WAIT_V(8); PG8_WAIT_L(0); PG8_BAR; PG8_MMA(0, 0, At, B0); PG8_MMA(0, 1, At, B1); PG8_BAR; PG8_SCHED;
            PG8_LDA(At, 1, 1); PG8_STAGE(PG8_SB(1, 0), b3, voffB); PG8_STAGE(PG8_SB(1, 1), b3 + hstep, voffB); PG8_STAGE(PG8_SA(1, 0), a3, voffA);
            PG8_WAIT_V(8); PG8_WAIT_L(0); PG8_BAR; PG8_MMA(1, 0, At, B0); PG8_MMA(1, 1, At, B1); PG8_BAR; PG8_SCHED;
            } else {
            PG8_LDB(B0, 0, 0); PG8_SCHED; PG8_LDA(At, 0, 0); PG8_STAGE(PG8_SA(1, 1), a1 + hstep, voffA);
            PG8_WAIT_L(8); PG8_BAR; PG8_WAIT_L(0); PG8_MMA(0, 0, At, B0); PG8_BAR; PG8_SCHED;
            PG8_LDB(B1, 0, 1); PG8_STAGE(PG8_SB(0, 0), b2, voffB);
            PG8_BAR; PG8_WAIT_L(0); PG8_MMA(0, 1, At, B1); PG8_BAR;
            PG8_LDA(At, 0, 1); PG8_STAGE(PG8_SA(0, 0), a2, voffA);
            PG8_BAR; PG8_WAIT_L(0); PG8_MMA(1, 0, At, B0); PG8_BAR; PG8_SCHED;
            PG8_STAGE(PG8_SB(0, 1), b2 + hstep, voffB);
            PG8_WAIT_V(6); PG8_BAR; PG8_MMA(1, 1, At, B1); PG8_BAR;
            PG8_LDB(B0, 1, 0); PG8_SCHED; PG8_LDA(At, 1, 0); PG8_STAGE(PG8_SA(0, 1), a2 + hstep, voffA);
            PG8_WAIT_L(8); PG8_BAR; PG8_WAIT_L(0); PG8_MMA(0, 0, At, B0); PG8_BAR; PG8_SCHED;
            PG8_LDB(B1, 1, 1); PG8_STAGE(PG8_SB(1, 0), b3, voffB);
            PG8_BAR; PG8_WAIT_L(0); PG8_MMA(0, 1, At, B1); PG8_BAR;
            PG8_LDA(At, 1, 1); PG8_STAGE(PG8_SA(1, 0), a3, voffA);
            PG8_BAR; PG8_WAIT_L(0); PG8_MMA(1, 0, At, B0); PG8_BAR; PG8_SCHED;
            PG8_STAGE(PG8_SB(1, 1), b3 + hstep, voffB);
            PG8_WAIT_V(6); PG8_BAR; PG8_MMA(1, 1, At, B1); PG8_BAR;
            }
        }
        if constexpr (ALIGN_EPI) { if (wr == 0) PG8_BAR; }
        if constexpr (!Epi::AFTER_DRAIN) { E(acc, cur, wr, wc, fr, fq); S.done(cur); }
        if (!has_next) break;
#pragma unroll
        for (int a = 0; a < 2; ++a)
#pragma unroll
            for (int b = 0; b < 2; ++b)
#pragma unroll
                for (int m = 0; m < 4; ++m)
#pragma unroll
                    for (int n = 0; n < 2; ++n) acc[a][b][m][n] = (f32x4){0.f, 0.f, 0.f, 0.f};
        cur = nxt; cA = nA; cB = nB; ++ui;
        if constexpr (ALIGN_EPI) { if (wr == 1) PG8_BAR; }
    }
    PG8_WAIT_V(0);
    if constexpr (!ALIGN_EPI) { if (wr == 0) PG8_BAR; }
    PG8_BAR;
    if constexpr (Epi::AFTER_DRAIN) { E.fused(acc, cur, wr, wc, fr, fq, lds, wid, lane); S.done(cur); }
#undef PG8_SA
#undef PG8_SB
#undef PG8_STAGE
#undef PG8_LDA
#undef PG8_LDB
#undef PG8_MMA
#undef PG8_WAIT_V
#undef PG8_WAIT_L
#undef PG8_BAR
#undef PG8_SCHED
}
}

#define XB_TMO      128
#define XB_XCNT(j)  (256  + 64 * (j))
#define XB_XSUB(j)  (1280 + 64 * (j))
#define XB_XGEN(j)  (2304 + 64 * (j))
#define XB_TOP      3328
#define XB_TOPGEN   3392
#define XCD_BAR_WORDS 3456
#define XB_SPIN_CAP (1u << 18)

__device__ __forceinline__ unsigned xb_ld(unsigned* p)              { return __hip_atomic_load(p, __ATOMIC_RELAXED, __HIP_MEMORY_SCOPE_AGENT); }
__device__ __forceinline__ unsigned xb_add(unsigned* p, unsigned v) { return __hip_atomic_fetch_add(p, v, __ATOMIC_RELAXED, __HIP_MEMORY_SCOPE_AGENT); }
__device__ __forceinline__ unsigned xb_xcc_id() { return (unsigned)__builtin_amdgcn_s_getreg((3 << 11) | 20) & 0xFu; }
#define XB_SPIN(cond, bar) do { unsigned _sp = 0; while (cond) { __builtin_amdgcn_s_sleep(1); \
    if ((++_sp & 255u) == 0u) { if (xb_ld(&(bar)[XB_TMO])) break; if (_sp > XB_SPIN_CAP) { atomicAdd(&(bar)[XB_TMO], 1u); break; } } } } while (0)

struct XcdBarrier {
    unsigned* bar; unsigned x;
    volatile LAS unsigned* st;
};

__device__ __forceinline__ XcdBarrier xcd_barrier_post(unsigned* bar, volatile LAS unsigned* st) {
    XcdBarrier b; b.bar = bar; b.x = xb_xcc_id(); b.st = st;
    if (threadIdx.x == 0) (void)xb_add(&bar[XB_XCNT(b.x)], 1u);
    return b;
}
__device__ __forceinline__ void xcd_barrier_complete(unsigned* bar, unsigned x, unsigned& nloc, unsigned& nx) {
    const unsigned G = gridDim.x * gridDim.y * gridDim.z;
    unsigned sum, cnt, mine, sp = 0u;
    for (;;) {
        sum = 0u; cnt = 0u; mine = 0u;
#pragma unroll
        for (unsigned j = 0; j < 16; ++j) { const unsigned c = xb_ld(&bar[XB_XCNT(j)]); sum += c; cnt += (c > 0u) ? 1u : 0u; mine = (j == x) ? c : mine; }
        if (sum == G) break;
        __builtin_amdgcn_s_sleep(1);
        if ((++sp & 255u) == 0u) { if (xb_ld(&bar[XB_TMO])) break; if (sp > XB_SPIN_CAP) { atomicAdd(&bar[XB_TMO], 1u); break; } }
    }
    nloc = mine > 0u ? mine : 1u; nx = cnt > 0u ? cnt : 1u;
}

__device__ __forceinline__ void xcd_barrier(const XcdBarrier& b) {
    asm volatile("s_waitcnt vmcnt(0)" ::: "memory");
    __syncthreads();
    if (threadIdx.x == 0) {
        unsigned* bar = b.bar;
        __builtin_amdgcn_s_waitcnt(0);
        unsigned nloc = b.st[0], nx = b.st[1];
        if (nloc == 0u) { xcd_barrier_complete(bar, b.x, nloc, nx); b.st[0] = nloc; b.st[1] = nx; }
        const unsigned old = xb_add(&bar[XB_XSUB(b.x)], 1u);
        const unsigned gen = old / nloc;
        if (old + 1u == (gen + 1u) * nloc) {
            __builtin_amdgcn_fence(__ATOMIC_RELEASE, "agent");
            asm volatile("s_waitcnt vmcnt(0)" ::: "memory");
            const unsigned og = xb_add(&bar[XB_TOP], 1u);
            const unsigned tg = og / nx;
            if (og + 1u == (tg + 1u) * nx) xb_add(&bar[XB_TOPGEN], 1u);
            else XB_SPIN(xb_ld(&bar[XB_TOPGEN]) == tg, bar);
            __builtin_amdgcn_fence(__ATOMIC_ACQUIRE, "agent");
            xb_add(&bar[XB_XGEN(b.x)], 1u);
            asm volatile("s_waitcnt vmcnt(0)" ::: "memory");
        } else {
            XB_SPIN(xb_ld(&bar[XB_XGEN(b.x)]) == gen, bar);
            __builtin_amdgcn_fence(__ATOMIC_ACQUIRE, "agent");
            asm volatile("s_waitcnt vmcnt(0)" ::: "memory");
        }
    }
    __syncthreads();
}

typedef unsigned short bf16_t;
typedef short bf16x8 __attribute__((ext_vector_type(8)));
typedef short bf16x4 __attribute__((ext_vector_type(4)));
typedef float f32x4 __attribute__((ext_vector_type(4)));
typedef unsigned u32x4 __attribute__((ext_vector_type(4)));
typedef unsigned u32x2 __attribute__((ext_vector_type(2)));
constexpr int DM = 1024, NBATCH = 8, SEQ = 4096, NTOK = NBATCH * SEQ, DEPTH = 2;
constexpr int INW = 3968, INWP = 4096, FFN = 2816, NMOD = 6;
constexpr int C_AQ = 0, C_AK = 384, C_AV = 768, C_RQ = 1152, C_RK = 1536, C_RV = 1920, C_RG = 2304, C_HQ = 2688, C_HZF = 2944, C_HZB = 3200, C_HI = 3456, C_HG = 3712;
constexpr float NORM_EPS = 1e-6f;
constexpr int NTHREADS = 512;
constexpr int LDS_BYTES = 135168;
constexpr size_t WS_CTL = 0, WS_MOD = 16384, WS_LB = WS_MOD + 393216, WS_HGA = WS_LB + 2048, WS_LSE = WS_HGA + 524288, WS_WIN = WS_LSE + 2359296,
    WS_WOUT = WS_WIN + 16777216, WS_WGU = WS_WOUT + 4194304, WS_WDN = WS_WGU + 23068672, WS_HBUF = WS_WDN + 11534336, WS_PROJ = WS_HBUF + 67108864,
    WS_OB = WS_PROJ + 260046848, WS_RST = WS_OB + 75497472, WS_HGU = WS_RST + 25165824, WS_END = WS_HGU + 33554432;

struct Params {
    const float *x, *c, *w_ada, *b_ada, *g_mix, *w_in, *ret_gn, *hgrn_gn, *lb_logits, *w_out, *g_ffn, *w_gu, *w_down, *g_final;
    float* out; unsigned char* ws; int ph_lo, ph_hi;
};

__device__ __forceinline__ float bf2f(bf16_t v) { return __uint_as_float(((unsigned)v) << 16); }
__device__ __forceinline__ float bflo(unsigned w) { return __uint_as_float(w << 16); }
__device__ __forceinline__ float bfhi(unsigned w) { return __uint_as_float(w & 0xffff0000u); }
__device__ __forceinline__ bf16_t f2bf(float f) { return __builtin_bit_cast(bf16_t, (__bf16)f); }
typedef float f32x2c __attribute__((ext_vector_type(2)));
typedef __bf16 bf16v2c __attribute__((ext_vector_type(2)));
__device__ __forceinline__ unsigned pk2(float lo, float hi) { const f32x2c v = {lo, hi}; return __builtin_bit_cast(unsigned, __builtin_convertvector(v, bf16v2c)); }
__device__ __forceinline__ bf16x4 pk4(f32x4 v) { u32x2 w; w.x = pk2(v[0], v[1]); w.y = pk2(v[2], v[3]); return __builtin_bit_cast(bf16x4, w); }
__device__ __forceinline__ float siluf(float v) { return v * __builtin_amdgcn_rcpf(1.0f + __expf(-v)); }
__device__ __forceinline__ float wave_sum(float v) {
#pragma unroll
    for (int o = 1; o < 64; o <<= 1) v += __shfl_xor(v, o);
    return v;
}
#define MFMA32(a, b, c) __builtin_amdgcn_mfma_f32_16x16x32_bf16((a), (b), (c), 0, 0, 0)
#define MFMA16(a, b, c) __builtin_amdgcn_mfma_f32_16x16x16bf16_1k((a), (b), (c), 0, 0, 0)

struct EpiProj {
    static constexpr bool PERM = true, AFTER_DRAIN = false;
    bf16_t* O; int ldc, ncols;
    __device__ __forceinline__ void operator()(const f32x4 (&acc)[2][2][4][2], const pg8::Unit& u, int wr, int wc, int fr, int fq) const {
        const int row0 = u.pm * 256 + wr * 64 + fr, col0 = u.pn * 256 + wc * 32 + 8 * fq;
#pragma unroll
        for (int ai = 0; ai < 2; ++ai)
#pragma unroll
            for (int m = 0; m < 4; ++m) { bf16_t* rowp = O + (size_t)(row0 + ai * 128 + m * 16) * ldc + col0;
#pragma unroll
                for (int bj = 0; bj < 2; ++bj) { if (col0 + bj * 128 < ncols) { const f32x4 v0 = acc[ai][bj][m][0], v1 = acc[ai][bj][m][1];
                    u32x4 w; w.x = pk2(v0[0], v0[1]); w.y = pk2(v0[2], v0[3]); w.z = pk2(v1[0], v1[1]); w.w = pk2(v1[2], v1[3]);
                    *(u32x4*)(rowp + bj * 128) = w; } } }
    }
};
struct EpiRes {
    static constexpr bool PERM = false, AFTER_DRAIN = false;
    const float* base; float* out; const float* gate;
    __device__ __forceinline__ void operator()(const f32x4 (&acc)[2][2][4][2], const pg8::Unit& u, int wr, int wc, int fr, int fq) const {
        const int row0 = u.pm * 256 + wr * 64 + fr, col0 = u.pn * 256 + wc * 32 + 4 * fq;
        const float* gp = gate + (size_t)((u.pm * 256) >> 12) * (NMOD * DM) + col0;
        f32x4 gv[2][2];
#pragma unroll
        for (int bj = 0; bj < 2; ++bj)
#pragma unroll
            for (int n = 0; n < 2; ++n) gv[bj][n] = *(const f32x4*)(gp + bj * 128 + n * 16);
#pragma unroll
        for (int ai = 0; ai < 2; ++ai)
#pragma unroll
            for (int m = 0; m < 4; ++m) { const size_t off = (size_t)(row0 + ai * 128 + m * 16) * DM + col0;
#pragma unroll
                for (int bj = 0; bj < 2; ++bj)
#pragma unroll
                    for (int n = 0; n < 2; ++n) { const f32x4 bs = *(const f32x4*)(base + off + bj * 128 + n * 16);
                        *(f32x4*)(out + off + bj * 128 + n * 16) = bs + gv[bj][n] * acc[ai][bj][m][n]; } }
    }
};
struct EpiSwiglu {
    static constexpr bool PERM = true, AFTER_DRAIN = false;
    bf16_t* O;
    __device__ __forceinline__ void operator()(const f32x4 (&acc)[2][2][4][2], const pg8::Unit& u, int wr, int wc, int fr, int fq) const {
        const int row0 = u.pm * 256 + wr * 64 + fr, col0 = u.pn * 128 + wc * 32 + 8 * fq;
#pragma unroll
        for (int ai = 0; ai < 2; ++ai)
#pragma unroll
            for (int m = 0; m < 4; ++m) { bf16_t* rowp = O + (size_t)(row0 + ai * 128 + m * 16) * FFN + col0;
                float r[8];
#pragma unroll
                for (int n = 0; n < 2; ++n)
#pragma unroll
                    for (int i = 0; i < 4; ++i) { const float g = acc[ai][0][m][n][i], uu = acc[ai][1][m][n][i]; r[n * 4 + i] = siluf(g) * uu; }
                u32x4 w; w.x = pk2(r[0], r[1]); w.y = pk2(r[2], r[3]); w.z = pk2(r[4], r[5]); w.w = pk2(r[6], r[7]);
                *(u32x4*)rowp = w; }
    }
};
__device__ __forceinline__ void transpose_item(const float* W, int K, int N, bf16_t* WT, int dst_row0, int src_col0, int k0, LAS float* scr, int lane) {
    const int c = lane & 7, nr = lane >> 3;
    if (src_col0 < 0) {
#pragma unroll
        for (int j = 0; j < 8; ++j) *(u32x4*)(WT + (size_t)(dst_row0 + nr + 8 * j) * K + k0 + 8 * c) = (u32x4){0u, 0u, 0u, 0u};
        return;
    }
    const int kr = lane >> 4, c4 = lane & 15;
    f32x4 v[16];
#pragma unroll
    for (int i = 0; i < 16; ++i) v[i] = __builtin_nontemporal_load((const f32x4*)(W + (size_t)(k0 + 4 * i + kr) * N + src_col0 + 4 * c4));
#pragma unroll
    for (int i = 0; i < 16; ++i) { LAS float* d = scr + (4 * i + kr) * 65 + 4 * c4; d[0] = v[i][0]; d[1] = v[i][1]; d[2] = v[i][2]; d[3] = v[i][3]; }
    __builtin_amdgcn_fence(__ATOMIC_RELEASE, "wavefront"); __builtin_amdgcn_wave_barrier(); __builtin_amdgcn_fence(__ATOMIC_ACQUIRE, "wavefront");
#pragma unroll
    for (int j = 0; j < 8; ++j) { const int n = nr + 8 * j; const LAS float* sp = scr + (8 * c) * 65 + n;
        u32x4 o; o.x = pk2(sp[0 * 65], sp[1 * 65]); o.y = pk2(sp[2 * 65], sp[3 * 65]); o.z = pk2(sp[4 * 65], sp[5 * 65]); o.w = pk2(sp[6 * 65], sp[7 * 65]);
        *(u32x4*)(WT + (size_t)(dst_row0 + n) * K + k0 + 8 * c) = o; }
    __builtin_amdgcn_fence(__ATOMIC_RELEASE, "wavefront"); __builtin_amdgcn_wave_barrier(); __builtin_amdgcn_fence(__ATOMIC_ACQUIRE, "wavefront");
}

__device__ __forceinline__ void phase_weights(const Params& P, LAS unsigned char* lds, int l_lo, int l_hi) {
    const int tid = opaque_tid(), lane = tid & 63, wave = __builtin_amdgcn_readfirstlane(tid >> 6);
    unsigned char* ws = P.ws;
    {
        LAS float* scr = (LAS float*)(lds + wave * 16640);
        const int gw = blockIdx.x * 8 + wave, NGW = gridDim.x * 8;
        constexpr int I_IN = 16 * 64, I_OUT = 16 * 16, I_GU = 16 * 88, I_DN = 44 * 16, I_L = I_IN + I_OUT + I_GU + I_DN;
        for (int it = l_lo * I_L + gw; it < l_hi * I_L; it += NGW) {
            const int l = it / I_L; int r = it % I_L;
            if (r < I_IN) { const int kb = r / 64, nb = r % 64, n0 = nb * 64;
                transpose_item(P.w_in + (size_t)l * DM * INW, DM, INW, (bf16_t*)(ws + WS_WIN) + (size_t)l * INWP * DM, n0, n0 < INW ? n0 : -1, kb * 64, scr, lane); continue; }
            r -= I_IN;
            if (r < I_OUT) { const int kb = r / 16, nb = r % 16;
                transpose_item(P.w_out + (size_t)l * DM * DM, DM, DM, (bf16_t*)(ws + WS_WOUT) + (size_t)l * DM * DM, nb * 64, nb * 64, kb * 64, scr, lane); continue; }
            r -= I_OUT;
            if (r < I_GU) { const int kb = r / 88, nb = r % 88, n0 = nb * 64; const int pn = n0 >> 8, half = (n0 >> 7) & 1, jj = n0 & 127;
                transpose_item(P.w_gu + (size_t)l * DM * 2 * FFN, DM, 2 * FFN, (bf16_t*)(ws + WS_WGU) + (size_t)l * 2 * FFN * DM, n0, half * FFN + pn * 128 + jj, kb * 64, scr, lane); continue; }
            r -= I_GU;
            { const int kb = r / 16, nb = r % 16;
                transpose_item(P.w_down + (size_t)l * FFN * DM, FFN, DM, (bf16_t*)(ws + WS_WDN) + (size_t)l * DM * FFN, nb * 64, nb * 64, kb * 64, scr, lane); }
        }
    }
}
__device__ __forceinline__ void phase_prologue(const Params& P, LAS unsigned char* lds) {
    const int tid = opaque_tid();
    unsigned char* ws = P.ws;
    {
        LAS float* sc = (LAS float*)lds;
        LAS float* red = (LAS float*)(lds + 32768);
        for (int i = tid; i < NBATCH * DM; i += NTHREADS) sc[i] = siluf(P.c[i]);
        __syncthreads();
        float* mod = (float*)(ws + WS_MOD);
        for (int u = blockIdx.x; u < DEPTH * 96; u += gridDim.x) {
            const int l = u / 96, j0 = (u % 96) * 64, col = tid & 63, kp = tid >> 6;
            float acc[8];
#pragma unroll
            for (int b = 0; b < 8; ++b) acc[b] = 0.f;
            const float* wp = P.w_ada + (size_t)l * DM * (NMOD * DM) + j0 + col;
            for (int k = kp * 128; k < kp * 128 + 128; ++k) { const float w = __builtin_nontemporal_load(wp + (size_t)k * (NMOD * DM));
#pragma unroll
                for (int b = 0; b < 8; ++b) acc[b] += sc[b * DM + k] * w; }
#pragma unroll
            for (int b = 0; b < 8; ++b) red[(kp * 8 + b) * 64 + col] = acc[b];
            __syncthreads();
            { const int b = tid >> 6; float s = 0.f;
#pragma unroll
              for (int p = 0; p < 8; ++p) s += red[(p * 8 + b) * 64 + col];
              mod[((size_t)l * NBATCH + b) * (NMOD * DM) + j0 + col] = s + P.b_ada[(size_t)l * NMOD * DM + j0 + col]; }
            __syncthreads();
        }
    }
    if (blockIdx.x == 0 && tid < 256) {
        const float l0 = P.lb_logits[tid], l1 = P.lb_logits[256 + tid], m = fmaxf(l0, l1), e0 = __expf(l0 - m), e1 = __expf(l1 - m);
        const float p0 = e0 / (e0 + e1), p1 = e1 / (e0 + e1);
        float* lb = (float*)(ws + WS_LB);
        lb[tid] = fminf(fmaxf(p0 - p0, 0.f), 1.0f - 1e-6f);
        lb[256 + tid] = fminf(fmaxf((p0 + p1) - p0, 0.f), 1.0f - 1e-6f);
    }
}

template <int NY, bool WRITE_X, bool FINAL>
__device__ __forceinline__ void phase_norm(const float* src, const bf16_t* y, const float* gate, const bf16_t* y2, const float* gate2, float* xout, const float* g, const float* shift, const float* scale, bf16_t* dst) {
    constexpr bool HAS_Y = NY > 0;
    const int tid = opaque_tid(), lane = tid & 63, wave = tid >> 6;
    const int gw = blockIdx.x * 8 + wave, NGW = gridDim.x * 8;
    f32x4 gv[4];
#pragma unroll
    for (int j = 0; j < 4; ++j) gv[j] = *(const f32x4*)(g + 4 * lane + 256 * j);
    const int WPB = NGW / NBATCH, b = gw / WPB;
    if (b >= NBATCH) return;
    f32x4 gtv[4], gtv2[4], scv[4], shv[4];
#pragma unroll
    for (int j = 0; j < 4; ++j) {
        if (HAS_Y) gtv[j] = *(const f32x4*)(gate + (size_t)b * (NMOD * DM) + 4 * lane + 256 * j);
        if (NY > 1) gtv2[j] = *(const f32x4*)(gate2 + (size_t)b * (NMOD * DM) + 4 * lane + 256 * j);
        if (!FINAL) { scv[j] = *(const f32x4*)(scale + (size_t)b * (NMOD * DM) + 4 * lane + 256 * j) + 1.0f; shv[j] = *(const f32x4*)(shift + (size_t)b * (NMOD * DM) + 4 * lane + 256 * j); }
    }
    for (int row = b * SEQ + (gw - b * WPB); row < (b + 1) * SEQ; row += WPB) {
        const f32x4* xr = (const f32x4*)(src + (size_t)row * DM) + lane;
        f32x4 v[4]; float s = 0.f;
#pragma unroll
        for (int j = 0; j < 4; ++j) v[j] = __builtin_nontemporal_load(xr + 64 * j);
        if (HAS_Y) {
            const u32x2* yr = (const u32x2*)(y + (size_t)row * DM) + lane;
#pragma unroll
            for (int j = 0; j < 4; ++j) { const u32x2 yw = __builtin_nontemporal_load(yr + 64 * j); const f32x4 gt = gtv[j];
                v[j][0] += gt[0] * bflo(yw.x); v[j][1] += gt[1] * bfhi(yw.x); v[j][2] += gt[2] * bflo(yw.y); v[j][3] += gt[3] * bfhi(yw.y); }
        }
        if (NY > 1) {
            const u32x2* yr2 = (const u32x2*)(y2 + (size_t)row * DM) + lane;
#pragma unroll
            for (int j = 0; j < 4; ++j) { const u32x2 yw = __builtin_nontemporal_load(yr2 + 64 * j); const f32x4 gt = gtv2[j];
                v[j][0] += gt[0] * bflo(yw.x); v[j][1] += gt[1] * bfhi(yw.x); v[j][2] += gt[2] * bflo(yw.y); v[j][3] += gt[3] * bfhi(yw.y); }
        }
#pragma unroll
        for (int j = 0; j < 4; ++j) s += (v[j][0] * v[j][0] + v[j][1] * v[j][1]) + (v[j][2] * v[j][2] + v[j][3] * v[j][3]);
        const float rstd = rsqrtf(wave_sum(s) * (1.0f / DM) + NORM_EPS);
        f32x4* xo = (f32x4*)(xout + (size_t)row * DM) + lane;
        if (FINAL) {
#pragma unroll
            for (int j = 0; j < 4; ++j) __builtin_nontemporal_store(v[j] * rstd * gv[j], xo + 64 * j);
        } else {
            if (WRITE_X) {
#pragma unroll
                for (int j = 0; j < 4; ++j) __builtin_nontemporal_store(v[j], xo + 64 * j);
            }
            unsigned long long* o8 = (unsigned long long*)(dst + (size_t)row * DM) + lane;
#pragma unroll
            for (int j = 0; j < 4; ++j) {
                const f32x4 h = v[j] * rstd * gv[j] * scv[j] + shv[j];
                o8[64 * j] = (unsigned long long)pk2(h[0], h[1]) | ((unsigned long long)pk2(h[2], h[3]) << 32);
            }
        }
    }
}
__device__ __forceinline__ bf16x4 tr4(const LAS bf16_t* img, int pitch, int row0, int col0, int g, int q) {
    return __builtin_amdgcn_ds_read_tr16_b64_v4i16((LAS bf16x4*)(img + (row0 + 4 * g + (q >> 2)) * pitch + col0 + 4 * (q & 3)));
}
__device__ __forceinline__ bf16x8 tr8(const LAS bf16_t* img, int pitch, int row0, int col0, int g, int q) {
    const bf16x4 lo = __builtin_amdgcn_ds_read_tr16_b64_v4i16((LAS bf16x4*)(img + (row0 + 8 * g + (q >> 2)) * pitch + col0 + 4 * (q & 3)));
    const bf16x4 hi = __builtin_amdgcn_ds_read_tr16_b64_v4i16((LAS bf16x4*)(img + (row0 + 8 * g + 4 + (q >> 2)) * pitch + col0 + 4 * (q & 3)));
    return __builtin_shufflevector(lo, hi, 0, 1, 2, 3, 4, 5, 6, 7);
}
struct AttRegs { u32x4 kv[3][2], vv[3][2]; bf16x8 qf[2][2]; };
constexpr int ATT_UNITS = 2304;
__device__ __forceinline__ void att_decode(int u, int& br, int& b, int& h, int& r, int& L, int& p0, int& tok0) {
    const int pi = u >> 6, k = u & 63; b = pi / 6; h = pi % 6; br = k >> 4; const int w = k & 15;
    const int lr = br * 2, nblk = 16 >> lr, rho = w >> (4 - lr), blk = w & (nblk - 1); r = 1 << lr; L = SEQ >> lr; p0 = blk * 256; tok0 = b * SEQ + rho;
}
__device__ __forceinline__ int att_unit(int li, int x) { const int pl = li / 48, k = li - pl * 48; return ((x + 8 * pl) << 6) | k; }
__device__ __forceinline__ void att_load_kv(const Params& P, int u, int tid, AttRegs& R) {
    int br, b, h, r, L, p0, tok0; att_decode(u, br, b, h, r, L, p0, tok0);
    const bf16_t* proj = (const bf16_t*)(P.ws + WS_PROJ);
#pragma unroll
    for (int it = 0; it < 3; ++it) {
        const int item = tid + it * NTHREADS, key = item >> 2, qd = item & 3, kj = p0 - 64 + key;
        if (kj >= 0 && kj < L) {
            const bf16_t* src = proj + (size_t)(tok0 + r * kj) * INW + h * 64 + qd * 16;
#pragma unroll
            for (int i = 0; i < 2; ++i) { R.kv[it][i] = *(const u32x4*)(src + C_AK + 8 * i); R.vv[it][i] = *(const u32x4*)(src + C_AV + 8 * i); }
        } else {
#pragma unroll
            for (int i = 0; i < 2; ++i) { R.kv[it][i] = (u32x4){0u, 0u, 0u, 0u}; R.vv[it][i] = (u32x4){0u, 0u, 0u, 0u}; }
        }
    }
}
__device__ __forceinline__ void att_load_q(const Params& P, int u, int tid, AttRegs& R) {
    int br, b, h, r, L, p0, tok0; att_decode(u, br, b, h, r, L, p0, tok0);
    const bf16_t* proj = (const bf16_t*)(P.ws + WS_PROJ);
    const int lane = tid & 63, wave = tid >> 6, q = lane & 15, g = lane >> 4;
#pragma unroll
    for (int qt = 0; qt < 2; ++qt) {
        const size_t tokq = (size_t)(tok0 + r * (p0 + 32 * wave + 16 * qt + q));
#pragma unroll
        for (int kk = 0; kk < 2; ++kk) R.qf[qt][kk] = *(const bf16x8*)(proj + tokq * INW + C_AQ + h * 64 + kk * 32 + 8 * g);
    }
}
__device__ __forceinline__ void att_phase(const Params& P, LAS unsigned char* lds) {
    const int tid = opaque_tid(), lane = tid & 63, wave = __builtin_amdgcn_readfirstlane(tid >> 6), q = lane & 15, g = lane >> 4;
    LAS bf16_t* Ks = (LAS bf16_t*)lds;
    LAS bf16_t* Vs = (LAS bf16_t*)(lds + 55296);
    const int xq = blockIdx.x & 7, nj = ((int)gridDim.x + 7 - xq) >> 3;
    int li = blockIdx.x >> 3; if (li >= 288) return;
    AttRegs R; att_load_kv(P, att_unit(li, xq), tid, R); att_load_q(P, att_unit(li, xq), tid, R);
    for (; li < 288; li += nj) {
        const int u = att_unit(li, xq);
        int br, b, h, r, L, p0, tok0; att_decode(u, br, b, h, r, L, p0, tok0);
#pragma unroll
        for (int it = 0; it < 3; ++it) {
            const int item = tid + it * NTHREADS, key = item >> 2, qd = item & 3;
#pragma unroll
            for (int i = 0; i < 2; ++i) { *(LAS u32x4*)(Ks + key * 72 + qd * 16 + 8 * i) = R.kv[it][i]; *(LAS u32x4*)(Vs + key * 72 + qd * 16 + 8 * i) = R.vv[it][i]; }
        }
        __syncthreads();
        if (li + nj < 288) att_load_kv(P, att_unit(li + nj, xq), tid, R);
        const float slope_l2 = exp2f(-8.0f * (float)(h + 1) / 6.0f) * (float)r * 1.44269504f, qk_l2 = 0.125f * 1.44269504f;
        const float fbase = (float)(64 + q - 4 * g);
        const bool edge = (p0 < 64) || (p0 + 320 > L);
#pragma unroll
        for (int qt = 0; qt < 2; ++qt) {
            const int kw = 32 * wave + 16 * qt;
            const int p = p0 + kw + q; const size_t tokq = (size_t)(tok0 + r * p);
            f32x4 st[9]; float mx = -3.0e38f;
#pragma unroll
            for (int t = 0; t < 9; ++t) {
                f32x4 acc = {0.f, 0.f, 0.f, 0.f};
#pragma unroll
                for (int kk = 0; kk < 2; ++kk) { const bf16x8 a = *(const LAS bf16x8*)(Ks + (kw + 16 * t + q) * 72 + kk * 32 + 8 * g); acc = MFMA32(a, R.qf[qt][kk], acc); }
#pragma unroll
                for (int j = 0; j < 4; ++j) {
                    const float d = fabsf(fbase - (float)(16 * t + j));
                    float s = acc[j] * qk_l2 - slope_l2 * d;
                    if (t == 0 || t == 8) s = (d <= 64.0f) ? s : -1.0e30f;
                    acc[j] = s;
                }
                if (edge) {
#pragma unroll
                    for (int j = 0; j < 4; ++j) { const int kj = p0 - 64 + kw + 16 * t + 4 * g + j; acc[j] = (kj >= 0 && kj < L) ? acc[j] : -1.0e30f; }
                }
#pragma unroll
                for (int j = 0; j < 4; ++j) mx = fmaxf(mx, acc[j]);
                st[t] = acc;
            }
            if (qt == 1 && li + nj < 288) att_load_q(P, att_unit(li + nj, xq), tid, R);
            mx = fmaxf(mx, __shfl_xor(mx, 16)); mx = fmaxf(mx, __shfl_xor(mx, 32));
            float ls = 0.f; bf16x4 pt[9];
#pragma unroll
            for (int t = 0; t < 9; ++t) { f32x4 e;
#pragma unroll
                for (int j = 0; j < 4; ++j) { e[j] = __builtin_amdgcn_exp2f(st[t][j] - mx); ls += e[j]; }
                pt[t] = pk4(e); }
            ls += __shfl_xor(ls, 16); ls += __shfl_xor(ls, 32);
            const float inv = __builtin_amdgcn_rcpf(ls);
            bf16_t* ob = (bf16_t*)(P.ws + WS_OB) + ((size_t)br * NTOK + tokq) * 384 + h * 64;
            const LAS bf16_t* vrd = Vs + (kw + 4 * g + (q >> 2)) * 72 + 4 * (q & 3);
#pragma unroll
            for (int dt = 0; dt < 4; ++dt) {
                f32x4 acc = {0.f, 0.f, 0.f, 0.f};
#pragma unroll
                for (int t = 0; t < 9; ++t) { const bf16x4 a = __builtin_amdgcn_ds_read_tr16_b64_v4i16((LAS bf16x4*)(vrd + 16 * t * 72 + dt * 16)); acc = MFMA16(a, pt[t], acc); }
                acc = acc * inv;
                *(bf16x4*)(ob + dt * 16 + 4 * g) = pk4(acc);
            }
            if (g == 0) ((float*)(P.ws + WS_LSE))[((size_t)br * NTOK + tokq) * 6 + h] = (mx + __log2f(ls)) * 0.69314718f;
        }
        __syncthreads();
    }
}
__device__ __forceinline__ void att_merge(const Params& P) {
    const bf16_t* ob = (const bf16_t*)(P.ws + WS_OB); const float* lse = (const float*)(P.ws + WS_LSE); bf16_t* mixed = (bf16_t*)(P.ws + WS_HBUF);
    for (size_t it = (size_t)blockIdx.x * NTHREADS + opaque_tid(); it < (size_t)NTOK * 48; it += (size_t)gridDim.x * NTHREADS) {
        const size_t tok = it / 48; const int grp = (int)(it % 48), h = grp >> 3;
        const float l0 = lse[tok * 6 + h], l1 = lse[((size_t)NTOK + tok) * 6 + h], l2 = lse[((size_t)2 * NTOK + tok) * 6 + h];
        const float m = fmaxf(l0, fmaxf(l1, l2)), e0 = __expf(l0 - m), e1 = __expf(l1 - m), e2 = __expf(l2 - m), is = __builtin_amdgcn_rcpf(e0 + e1 + e2);
        const float w0 = e0 * is, w1 = e1 * is, w2 = e2 * is;
        const u32x4 a = __builtin_nontemporal_load((const u32x4*)(ob + tok * 384 + grp * 8)), bq = __builtin_nontemporal_load((const u32x4*)(ob + ((size_t)NTOK + tok) * 384 + grp * 8)), cq = __builtin_nontemporal_load((const u32x4*)(ob + ((size_t)2 * NTOK + tok) * 384 + grp * 8));
        u32x4 o;
#pragma unroll
        for (int i = 0; i < 4; ++i) o[i] = pk2(w0 * bflo(a[i]) + w1 * bflo(bq[i]) + w2 * bflo(cq[i]), w0 * bfhi(a[i]) + w1 * bfhi(bq[i]) + w2 * bfhi(cq[i]));
        *(u32x4*)(mixed + tok * DM + grp * 8) = o;
    }
}

__device__ __forceinline__ float ret_logg(int h) { return log1pf(-exp2f(-5.0f - (float)h)); }
struct RetARegs { u32x4 k0, k1, v0, v1; };
__device__ __forceinline__ void retA_load(const Params& P, int u, int tid, RetARegs& R) {
    const int bh = u >> 5, n = u & 31, b = bh / 6, h = bh % 6, c = tid >> 2, qd = tid & 3;
    const bf16_t* src = (const bf16_t*)(P.ws + WS_PROJ) + (size_t)(b * SEQ + n * 128 + c) * INW + h * 64 + qd * 16;
    R.k0 = *(const u32x4*)(src + C_RK); R.k1 = *(const u32x4*)(src + C_RK + 8); R.v0 = *(const u32x4*)(src + C_RV); R.v1 = *(const u32x4*)(src + C_RV + 8);
}
__device__ __forceinline__ void retA_phase(const Params& P, LAS unsigned char* lds) {
    const int tid = opaque_tid(), lane = tid & 63, wave = __builtin_amdgcn_readfirstlane(tid >> 6), q = lane & 15, g = lane >> 4;
    LAS bf16_t* Kf = (LAS bf16_t*)lds; LAS bf16_t* Kb = (LAS bf16_t*)(lds + 18432); LAS bf16_t* Vs = (LAS bf16_t*)(lds + 36864);
    int u = blockIdx.x; if (u >= 1536) return;
    RetARegs R; retA_load(P, u, tid, R);
    for (; u < 1536; u += gridDim.x) {
        const int bh = u >> 5, n = u & 31, h = bh % 6;
        const float lg = ret_logg(h);
        {
            const int c = tid >> 2, qd = tid & 3;
            const float wf = 0.125f * __expf(lg * (float)(127 - c)), wb = 0.125f * __expf(lg * (float)c);
            u32x4 f0, f1, b0, b1;
#pragma unroll
            for (int e = 0; e < 4; ++e) { f0[e] = pk2(bflo(R.k0[e]) * wf, bfhi(R.k0[e]) * wf); f1[e] = pk2(bflo(R.k1[e]) * wf, bfhi(R.k1[e]) * wf);
                b0[e] = pk2(bflo(R.k0[e]) * wb, bfhi(R.k0[e]) * wb); b1[e] = pk2(bflo(R.k1[e]) * wb, bfhi(R.k1[e]) * wb); }
            *(LAS u32x4*)(Kf + c * 72 + qd * 16) = f0; *(LAS u32x4*)(Kf + c * 72 + qd * 16 + 8) = f1;
            *(LAS u32x4*)(Kb + c * 72 + qd * 16) = b0; *(LAS u32x4*)(Kb + c * 72 + qd * 16 + 8) = b1;
            *(LAS u32x4*)(Vs + c * 72 + qd * 16) = R.v0; *(LAS u32x4*)(Vs + c * 72 + qd * 16 + 8) = R.v1;
        }
        __syncthreads();
        if (u + (int)gridDim.x < 1536) retA_load(P, u + gridDim.x, tid, R);
        const int dir = wave >> 2, dt = wave & 3; const LAS bf16_t* Kt = dir ? Kb : Kf;
        bf16x8 afr[4];
#pragma unroll
        for (int kk = 0; kk < 4; ++kk) afr[kk] = tr8(Kt, 72, kk * 32, dt * 16, g, q);
        bf16_t* dst = (bf16_t*)(P.ws + WS_RST) + ((size_t)(bh * 32 + n) * 2 + dir) * 4096;
#pragma unroll
        for (int et = 0; et < 4; ++et) {
            f32x4 acc = {0.f, 0.f, 0.f, 0.f};
#pragma unroll
            for (int kk = 0; kk < 4; ++kk) { const bf16x8 bfr = tr8(Vs, 72, kk * 32, et * 16, g, q); acc = MFMA32(afr[kk], bfr, acc); }
            *(bf16x4*)(dst + (et * 16 + q) * 64 + dt * 16 + 4 * g) = pk4(acc);
        }
        __syncthreads();
    }
}
__device__ __forceinline__ void ret_scan(const Params& P) {
    bf16_t* st = (bf16_t*)(P.ws + WS_RST);
    for (int it = blockIdx.x * NTHREADS + opaque_tid(); it < 48 * 2 * 512; it += gridDim.x * NTHREADS) {
        const int ch = it & 511, dir = (it >> 9) & 1, bh = it >> 10, h = bh % 6;
        const float cd = __expf(ret_logg(h) * 128.0f);
        float s[8];
#pragma unroll
        for (int e = 0; e < 8; ++e) s[e] = 0.f;
        for (int i0 = 0; i0 < 32; i0 += 8) {
            u32x4 v[8];
#pragma unroll
            for (int i = 0; i < 8; ++i) { const int n = dir ? 31 - (i0 + i) : (i0 + i); v[i] = *(const u32x4*)(st + ((size_t)(bh * 32 + n) * 2 + dir) * 4096 + 8 * ch); }
#pragma unroll
            for (int i = 0; i < 8; ++i) { const int n = dir ? 31 - (i0 + i) : (i0 + i);
                u32x4 o;
#pragma unroll
                for (int e = 0; e < 4; ++e) o[e] = pk2(s[2 * e], s[2 * e + 1]);
                *(u32x4*)(st + ((size_t)(bh * 32 + n) * 2 + dir) * 4096 + 8 * ch) = o;
#pragma unroll
                for (int e = 0; e < 4; ++e) { s[2 * e] = cd * s[2 * e] + bflo(v[i][e]); s[2 * e + 1] = cd * s[2 * e + 1] + bfhi(v[i][e]); } }
        }
    }
}
struct RetBRegs { u32x4 k0, k1, v0, v1, rf, rb, q0, q1; };
__device__ __forceinline__ void retB_load(const Params& P, int u, int tid, RetBRegs& R) {
    const int bh = u >> 5, n = u & 31, b = bh / 6, h = bh % 6, c = tid >> 2, qd = tid & 3;
    const bf16_t* proj = (const bf16_t*)(P.ws + WS_PROJ);
    const bf16_t* src = proj + (size_t)(b * SEQ + n * 128 + c) * INW + h * 64 + qd * 16;
    R.k0 = *(const u32x4*)(src + C_RK); R.k1 = *(const u32x4*)(src + C_RK + 8); R.v0 = *(const u32x4*)(src + C_RV); R.v1 = *(const u32x4*)(src + C_RV + 8);
    const bf16_t* rs = (const bf16_t*)(P.ws + WS_RST) + (size_t)(bh * 32 + n) * 2 * 4096;
    const int e = tid >> 3, d8 = (tid & 7) * 8;
    R.rf = *(const u32x4*)(rs + e * 64 + d8); R.rb = *(const u32x4*)(rs + 4096 + e * 64 + d8);
    const int lane = tid & 63, wave = tid >> 6, q = lane & 15, g = lane >> 4;
    const bf16_t* qp = proj + (size_t)(b * SEQ + n * 128 + 16 * wave + q) * INW + C_RQ + h * 64 + 8 * g;
    R.q0 = *(const u32x4*)qp; R.q1 = *(const u32x4*)(qp + 32);
}
__device__ __forceinline__ void retB_phase(const Params& P, LAS unsigned char* lds, int layer) {
    const int tid = opaque_tid(), lane = tid & 63, wave = __builtin_amdgcn_readfirstlane(tid >> 6), q = lane & 15, g = lane >> 4;
    const bf16_t* proj = (const bf16_t*)(P.ws + WS_PROJ);
    LAS bf16_t* Ks = (LAS bf16_t*)lds;
    LAS bf16_t* Vs = (LAS bf16_t*)(lds + 18432);
    LAS bf16_t* Rf = (LAS bf16_t*)(lds + 36864);
    LAS bf16_t* Rb = (LAS bf16_t*)(lds + 46080);
    int u = blockIdx.x; if (u >= 1536) return;
    RetBRegs R; retB_load(P, u, tid, R);
    for (; u < 1536; u += gridDim.x) {
        const int bh = u >> 5, n = u & 31, b = bh / 6, h = bh % 6;
        const float lg = ret_logg(h);
        {
            const int c = tid >> 2, qd = tid & 3, e = tid >> 3, d8 = (tid & 7) * 8;
            *(LAS u32x4*)(Ks + c * 72 + qd * 16) = R.k0; *(LAS u32x4*)(Ks + c * 72 + qd * 16 + 8) = R.k1;
            *(LAS u32x4*)(Vs + c * 72 + qd * 16) = R.v0; *(LAS u32x4*)(Vs + c * 72 + qd * 16 + 8) = R.v1;
            *(LAS u32x4*)(Rf + e * 72 + d8) = R.rf; *(LAS u32x4*)(Rb + e * 72 + d8) = R.rb;
        }
        const u32x4 qraw[2] = {R.q0, R.q1};
        __syncthreads();
        if (u + (int)gridDim.x < 1536) retB_load(P, u + gridDim.x, tid, R);
        const int i = 16 * wave + q; const size_t tok = (size_t)(b * SEQ + n * 128 + i);
        u32x2 rgv[4]; f32x4 gnv[4];
#pragma unroll
        for (int et = 0; et < 4; ++et) { rgv[et] = *(const u32x2*)(proj + tok * INW + C_RG + h * 64 + et * 16 + 4 * g); gnv[et] = *(const f32x4*)(P.ret_gn + layer * 384 + h * 64 + et * 16 + 4 * g); }
        bf16x8 qf[2], qff[2], qfb[2];
        {
            const float ff = __expf(lg * (float)(i + 1)), fb = __expf(lg * (float)(128 - i));
#pragma unroll
            for (int kk = 0; kk < 2; ++kk) { const u32x4 raw = qraw[kk];
                qf[kk] = __builtin_bit_cast(bf16x8, raw); u32x4 a, c2;
#pragma unroll
                for (int e = 0; e < 4; ++e) { const float lo = bflo(raw[e]), hi = bfhi(raw[e]); a[e] = pk2(lo * ff, hi * ff); c2[e] = pk2(lo * fb, hi * fb); }
                qff[kk] = __builtin_bit_cast(bf16x8, a); qfb[kk] = __builtin_bit_cast(bf16x8, c2); }
        }
        bf16x4 pt[8];
#pragma unroll
        for (int jt = 0; jt < 8; ++jt) {
            f32x4 acc = {0.f, 0.f, 0.f, 0.f};
#pragma unroll
            for (int kk = 0; kk < 2; ++kk) { const bf16x8 a = *(const LAS bf16x8*)(Ks + (16 * jt + q) * 72 + kk * 32 + 8 * g); acc = MFMA32(a, qf[kk], acc); }
#pragma unroll
            for (int jj = 0; jj < 4; ++jj) { int dd = i - (16 * jt + 4 * g + jj); dd = dd < 0 ? -dd : dd; acc[jj] = acc[jj] * 0.125f * __expf(lg * (float)dd); }
            pt[jt] = pk4(acc);
        }
        f32x4 o[4];
#pragma unroll
        for (int et = 0; et < 4; ++et) {
            f32x4 acc = {0.f, 0.f, 0.f, 0.f};
#pragma unroll
            for (int jt = 0; jt < 8; ++jt) { const bf16x4 a = tr4(Vs, 72, 16 * jt, et * 16, g, q); acc = MFMA16(a, pt[jt], acc); }
#pragma unroll
            for (int kk = 0; kk < 2; ++kk) { const bf16x8 a = *(const LAS bf16x8*)(Rf + (et * 16 + q) * 72 + kk * 32 + 8 * g); acc = MFMA32(a, qff[kk], acc);
                const bf16x8 a2 = *(const LAS bf16x8*)(Rb + (et * 16 + q) * 72 + kk * 32 + 8 * g); acc = MFMA32(a2, qfb[kk], acc); }
            o[et] = acc;
        }
        float s = 0.f;
#pragma unroll
        for (int et = 0; et < 4; ++et) s += (o[et][0] + o[et][1]) + (o[et][2] + o[et][3]);
        s += __shfl_xor(s, 16); s += __shfl_xor(s, 32);
        const float mu = s * (1.0f / 64.0f); float vs = 0.f;
#pragma unroll
        for (int et = 0; et < 4; ++et) { o[et] = o[et] - mu; vs += (o[et][0] * o[et][0] + o[et][1] * o[et][1]) + (o[et][2] * o[et][2] + o[et][3] * o[et][3]); }
        vs += __shfl_xor(vs, 16); vs += __shfl_xor(vs, 32);
        const float rstd = rsqrtf(vs * (1.0f / 64.0f) + NORM_EPS);
        bf16_t* mixed = (bf16_t*)(P.ws + WS_HBUF) + tok * DM + 384 + h * 64;
#pragma unroll
        for (int et = 0; et < 4; ++et) {
            const f32x4 gn = gnv[et]; const u32x2 rg = rgv[et];
            f32x4 y; y[0] = o[et][0] * rstd * gn[0] * siluf(bflo(rg.x)); y[1] = o[et][1] * rstd * gn[1] * siluf(bfhi(rg.x));
            y[2] = o[et][2] * rstd * gn[2] * siluf(bflo(rg.y)); y[3] = o[et][3] * rstd * gn[3] * siluf(bfhi(rg.y));
            *(bf16x4*)(mixed + et * 16 + 4 * g) = pk4(y);
        }
        __syncthreads();
    }
}
__device__ __forceinline__ void hgrn_gate(float z, float lbv, float& f, float& kk) {
    z = fminf(fmaxf(z, -30.f), 30.f);
    const float ez = __expf(-z), sg = __builtin_amdgcn_rcpf(1.0f + ez);
    f = lbv + (1.0f - lbv) * sg; kk = (1.0f - lbv) * ez * sg;
}
__device__ __forceinline__ void hgA_unit(const Params& P, LAS unsigned char* lds, int u, int layer) {
    const int tid = opaque_tid(), lane = tid & 63, wave = __builtin_amdgcn_readfirstlane(tid >> 6), q = lane & 15, g = lane >> 4;
    const int bh = u >> 5, n = u & 31, b = bh >> 2, h = bh & 3;
    const bf16_t* proj = (const bf16_t*)(P.ws + WS_PROJ);
    LAS bf16_t* Kr = (LAS bf16_t*)lds;
    LAS bf16_t* Vs = (LAS bf16_t*)(lds + 36864);
    LAS float* segs = (LAS float*)(lds + 55296);
    const size_t tokc = (size_t)(b * SEQ + n * 128);
    {
        const int c = tid >> 2, qd = tid & 3; const bf16_t* src = proj + (tokc + c) * INW + C_HI + h * 64 + qd * 16;
        const u32x4 v0 = *(const u32x4*)src, v1 = *(const u32x4*)(src + 8);
        *(LAS u32x4*)(Vs + c * 72 + qd * 16) = v0; *(LAS u32x4*)(Vs + c * 72 + qd * 16 + 8) = v1;
    }
    const int d = tid & 63, dir = (tid >> 6) & 1, seg = tid >> 7;
    const float lbv = ((const float*)(P.ws + WS_LB))[layer * 256 + h * 64 + d];
    float lf[32], kk[32];
    {
        const bf16_t* zp = proj + (tokc + seg * 32) * INW + (dir ? C_HZB : C_HZF) + h * 64 + d;
        bf16_t zr[32];
#pragma unroll
        for (int i = 0; i < 32; ++i) zr[i] = zp[(size_t)i * INW];
#pragma unroll
        for (int i = 0; i < 32; ++i) hgrn_gate(bf2f(zr[i]), lbv, lf[i], kk[i]);
    }
    float ssum = 1.f;
#pragma unroll
    for (int i = 0; i < 32; ++i) ssum *= lf[i];
    segs[(dir * 4 + seg) * 64 + d] = ssum;
    __syncthreads();
    {
        float before = 1.f, after = 1.f;
#pragma unroll
        for (int s2 = 0; s2 < 4; ++s2) { const float v = segs[(dir * 4 + s2) * 64 + d]; if (s2 < seg) before *= v; if (s2 > seg) after *= v; }
        LAS bf16_t* kt = Kr + dir * (128 * 72) + (seg * 32) * 72 + d;
        if (dir == 0) {
            float run = after;
#pragma unroll
            for (int i = 31; i >= 0; --i) { kt[i * 72] = f2bf(kk[i] * run); run *= lf[i]; }
        } else {
            float run = before;
#pragma unroll
            for (int i = 0; i < 32; ++i) { kt[i * 72] = f2bf(kk[i] * run); run *= lf[i]; }
        }
        if (seg == 0) ((float*)(P.ws + WS_HGA))[((size_t)(bh * 2 + dir) * 32 + n) * 64 + d] = ssum * after;
    }
    __syncthreads();
    {
        const int wdir = wave >> 2, dt = wave & 3; const LAS bf16_t* krs = Kr + wdir * (128 * 72);
        bf16x8 afr[4];
#pragma unroll
        for (int kq = 0; kq < 4; ++kq) afr[kq] = tr8(krs, 72, kq * 32, dt * 16, g, q);
        float* dst = (float*)(P.ws + WS_HGU) + ((size_t)(bh * 2 + wdir) * 32 + n) * 4096;
#pragma unroll
        for (int et = 0; et < 4; ++et) {
            f32x4 acc = {0.f, 0.f, 0.f, 0.f};
#pragma unroll
            for (int kq = 0; kq < 4; ++kq) { const bf16x8 bfr = tr8(Vs, 72, kq * 32, et * 16, g, q); acc = MFMA32(afr[kq], bfr, acc); }
#pragma unroll
            for (int j = 0; j < 4; ++j) dst[(dt * 16 + 4 * g + j) * 64 + et * 16 + q] = acc[j];
        }
    }
    __syncthreads();
}
__device__ __forceinline__ void hg_scan(const Params& P) {
    float* U = (float*)(P.ws + WS_HGU); const float* A = (const float*)(P.ws + WS_HGA);
    const int nthr = gridDim.x * NTHREADS; int it0 = blockIdx.x * NTHREADS + opaque_tid() - 48 * 2 * 512; if (it0 < 0) it0 += nthr;
    for (int it = it0; it < 64 * 64 * 16; it += nthr) {
        const int e4 = it & 15, d = (it >> 4) & 63, bd = it >> 10, dir = bd & 1;
        f32x4 s = {0.f, 0.f, 0.f, 0.f};
        for (int i0 = 0; i0 < 32; i0 += 8) {
            f32x4 v[8]; float a[8];
#pragma unroll
            for (int i = 0; i < 8; ++i) { const int n = dir ? 31 - (i0 + i) : (i0 + i); v[i] = *(const f32x4*)(U + ((size_t)(bd * 32 + n) * 64 + d) * 64 + 4 * e4); a[i] = A[(size_t)(bd * 32 + n) * 64 + d]; }
#pragma unroll
            for (int i = 0; i < 8; ++i) { const int n = dir ? 31 - (i0 + i) : (i0 + i); *(f32x4*)(U + ((size_t)(bd * 32 + n) * 64 + d) * 64 + 4 * e4) = s; s = s * a[i] + v[i]; }
        }
    }
}
__device__ __forceinline__ unsigned pk2h(float lo, float hi) { return pk2(lo, hi); }
__device__ __forceinline__ bf16x4 pk4h(f32x4 v) { return pk4(v); }
struct MergeItem { u32x4 a, b, c; float l0, l1, l2; };
__device__ __forceinline__ void merge_load(const Params& P, size_t tok, int grp, MergeItem& M) {
    const bf16_t* ob = (const bf16_t*)(P.ws + WS_OB); const float* lse = (const float*)(P.ws + WS_LSE); const int h = grp >> 3;
    M.l0 = lse[tok * 6 + h]; M.l1 = lse[((size_t)NTOK + tok) * 6 + h]; M.l2 = lse[((size_t)2 * NTOK + tok) * 6 + h];
    M.a = __builtin_nontemporal_load((const u32x4*)(ob + tok * 384 + grp * 8)); M.b = __builtin_nontemporal_load((const u32x4*)(ob + ((size_t)NTOK + tok) * 384 + grp * 8)); M.c = __builtin_nontemporal_load((const u32x4*)(ob + ((size_t)2 * NTOK + tok) * 384 + grp * 8));
}
__device__ __forceinline__ void merge_finish(const Params& P, size_t tok, int grp, const MergeItem& M) {
    const float m = fmaxf(M.l0, fmaxf(M.l1, M.l2)), e0 = __expf(M.l0 - m), e1 = __expf(M.l1 - m), e2 = __expf(M.l2 - m), is = __builtin_amdgcn_rcpf(e0 + e1 + e2);
    const float w0 = e0 * is, w1 = e1 * is, w2 = e2 * is;
    u32x4 o;
#pragma unroll
    for (int i = 0; i < 4; ++i) o[i] = pk2(w0 * bflo(M.a[i]) + w1 * bflo(M.b[i]) + w2 * bflo(M.c[i]), w0 * bfhi(M.a[i]) + w1 * bfhi(M.b[i]) + w2 * bfhi(M.c[i]));
    *(u32x4*)((bf16_t*)(P.ws + WS_HBUF) + tok * DM + grp * 8) = o;
}
__device__ __forceinline__ void hgB_unit(const Params& P, LAS unsigned char* lds, int u, int layer) {
    const int tid = opaque_tid(), lane = tid & 63, wave = __builtin_amdgcn_readfirstlane(tid >> 6), q = lane & 15, g = lane >> 4;
    const int b = u >> 5, n = u & 31, h = wave >> 1, dir = wave & 1, bh = b * 4 + h;
    bf16_t* proj = (bf16_t*)(P.ws + WS_PROJ);
    bf16_t* mixed = (bf16_t*)(P.ws + WS_HBUF);
    LAS unsigned char* wl = lds + wave * 7168;
    LAS bf16_t* Qi = (LAS bf16_t*)wl;
    LAS bf16_t* Ki = (LAS bf16_t*)(wl + 2304);
    LAS bf16_t* Vs = (LAS bf16_t*)(wl + 4608);
    LAS float* Al = (LAS float*)(wl + 6912);
    const size_t tokc = (size_t)(b * SEQ + n * 128);
    const float lbv = ((const float*)(P.ws + WS_LB))[layer * 256 + h * 64 + lane];
    f32x4 S[4][4];
    {
        const float* sp = (const float*)(P.ws + WS_HGU) + ((size_t)(bh * 2 + dir) * 32 + n) * 4096;
#pragma unroll
        for (int dt = 0; dt < 4; ++dt)
#pragma unroll
            for (int et = 0; et < 4; ++et)
#pragma unroll
                for (int j = 0; j < 4; ++j) S[dt][et][j] = sp[(dt * 16 + 4 * g + j) * 64 + et * 16 + q];
    }
    bf16_t* odst = dir ? (proj + C_AQ + h * 64) : (mixed + 768 + h * 64); const size_t opitch = dir ? INW : DM;
    bf16_t qr[16], zz[16]; u32x4 v0, v1;
#define HGB_LOAD(SC) do { const size_t toks_ = tokc + (SC) * 16; const bf16_t* base_ = proj + toks_ * INW + h * 64 + lane; \
        _Pragma("unroll") for (int ii = 0; ii < 16; ++ii) { const int t_ = dir ? 15 - ii : ii; qr[ii] = base_[(size_t)t_ * INW + C_HQ]; zz[ii] = base_[(size_t)t_ * INW + (dir ? C_HZB : C_HZF)]; } \
        const bf16_t* vsrc_ = proj + (toks_ + (lane >> 2)) * INW + C_HI + h * 64 + (lane & 3) * 16; v0 = *(const u32x4*)vsrc_; v1 = *(const u32x4*)(vsrc_ + 8); } while (0)
    HGB_LOAD(dir ? 7 : 0);
    for (int i = 0; i < 8; ++i) {
        const int sc = dir ? 7 - i : i; const size_t toks = tokc + sc * 16;
        {
            *(LAS u32x4*)(Vs + (lane >> 2) * 72 + (lane & 3) * 16) = v0; *(LAS u32x4*)(Vs + (lane >> 2) * 72 + (lane & 3) * 16 + 8) = v1;
            float bp = 1.f;
#pragma unroll
            for (int ii = 0; ii < 16; ++ii) {
                const int t = dir ? 15 - ii : ii;
                float f, kk; hgrn_gate(bf2f(zz[ii]), lbv, f, kk); const float qv = siluf(bf2f(qr[ii]));
                bp *= f;
                Qi[t * 72 + lane] = f2bf(qv * bp); Ki[t * 72 + lane] = f2bf(kk * __builtin_amdgcn_rcpf(fmaxf(bp, 1.0e-30f)));
            }
            Al[lane] = bp;
        }
        if (i + 1 < 8) HGB_LOAD(dir ? 6 - i : i + 1);
        MergeItem M0, M1; const int id0 = tid + NTHREADS * i, id1 = tid + NTHREADS * (8 + i);
        merge_load(P, tokc + id0 / 48, id0 % 48, M0); if (i < 4) merge_load(P, tokc + id1 / 48, id1 % 48, M1);
        __builtin_amdgcn_fence(__ATOMIC_RELEASE, "wavefront"); __builtin_amdgcn_wave_barrier(); __builtin_amdgcn_fence(__ATOMIC_ACQUIRE, "wavefront");
        f32x4 at = {0.f, 0.f, 0.f, 0.f};
#pragma unroll
        for (int kq = 0; kq < 2; ++kq) { const bf16x8 a8 = *(const LAS bf16x8*)(Ki + q * 72 + kq * 32 + 8 * g), b8 = *(const LAS bf16x8*)(Qi + q * 72 + kq * 32 + 8 * g); at = MFMA32(a8, b8, at); }
#pragma unroll
        for (int j = 0; j < 4; ++j) { const int sl = 4 * g + j; const bool keep = dir ? (sl >= q) : (sl <= q); at[j] = keep ? at[j] : 0.f; }
        const bf16x4 p4 = pk4h(at);
        bf16x4 b4[4], v4[4];
#pragma unroll
        for (int dt = 0; dt < 4; ++dt) b4[dt] = *(const LAS bf16x4*)(Qi + q * 72 + dt * 16 + 4 * g);
#pragma unroll
        for (int et = 0; et < 4; ++et) v4[et] = tr4(Vs, 72, 0, et * 16, g, q);
#pragma unroll
        for (int et = 0; et < 4; ++et) {
            f32x4 o = {0.f, 0.f, 0.f, 0.f};
#pragma unroll
            for (int dt = 0; dt < 4; ++dt) o = MFMA16(pk4h(S[dt][et]), b4[dt], o);
            o = MFMA16(v4[et], p4, o);
            *(bf16x4*)(odst + (toks + q) * opitch + et * 16 + 4 * g) = pk4(o);
        }
#pragma unroll
        for (int dt = 0; dt < 4; ++dt) {
            const bf16x4 kT4 = tr4(Ki, 72, 0, dt * 16, g, q);
            const f32x4 al4 = *(const LAS f32x4*)(Al + dt * 16 + 4 * g);
#pragma unroll
            for (int et = 0; et < 4; ++et) { const f32x4 s2 = MFMA16(kT4, v4[et], S[dt][et]); S[dt][et] = s2 * al4; }
        }
        merge_finish(P, tokc + id0 / 48, id0 % 48, M0); if (i < 4) merge_finish(P, tokc + id1 / 48, id1 % 48, M1);
        __builtin_amdgcn_fence(__ATOMIC_RELEASE, "wavefront"); __builtin_amdgcn_wave_barrier(); __builtin_amdgcn_fence(__ATOMIC_ACQUIRE, "wavefront");
    }
    asm volatile("s_waitcnt vmcnt(0)" ::: "memory");
    __syncthreads();
    {
        const int tau = tid >> 2, qd = tid & 3;
        bf16_t* mp = mixed + (tokc + tau) * DM + 768 + qd * 64; const bf16_t* bp2 = proj + (tokc + tau) * INW + C_AQ + qd * 64;
        const bf16_t* gp = proj + (tokc + tau) * INW + C_HG + qd * 64; const float* gn = P.hgrn_gn + layer * 256 + qd * 64;
        float o[64]; float sq = 0.f;
#pragma unroll
        for (int c4 = 0; c4 < 16; ++c4) {
            const unsigned long long fv = __hip_atomic_load((const unsigned long long*)(mp + c4 * 4), __ATOMIC_RELAXED, __HIP_MEMORY_SCOPE_AGENT), bv = __hip_atomic_load((const unsigned long long*)(bp2 + c4 * 4), __ATOMIC_RELAXED, __HIP_MEMORY_SCOPE_AGENT);
            const unsigned f0 = (unsigned)fv, f1 = (unsigned)(fv >> 32), b0 = (unsigned)bv, b1 = (unsigned)(bv >> 32);
            const float x0 = bflo(f0) + bflo(b0), x1 = bfhi(f0) + bfhi(b0), x2 = bflo(f1) + bflo(b1), x3 = bfhi(f1) + bfhi(b1);
            o[c4 * 4 + 0] = x0; o[c4 * 4 + 1] = x1; o[c4 * 4 + 2] = x2; o[c4 * 4 + 3] = x3; sq += (x0 * x0 + x1 * x1) + (x2 * x2 + x3 * x3); }
        sq += __shfl_xor(sq, 1); sq += __shfl_xor(sq, 2);
        const float rstd = rsqrtf(sq * (1.0f / 256.0f) + NORM_EPS);
#pragma unroll
        for (int c8 = 0; c8 < 8; ++c8) {
            const u32x4 gv = *(const u32x4*)(gp + c8 * 8); const f32x4 g0 = *(const f32x4*)(gn + c8 * 8), g1 = *(const f32x4*)(gn + c8 * 8 + 4);
            u32x4 r;
            r.x = pk2h(o[c8 * 8 + 0] * rstd * g0[0] * siluf(bflo(gv.x)), o[c8 * 8 + 1] * rstd * g0[1] * siluf(bfhi(gv.x)));
            r.y = pk2h(o[c8 * 8 + 2] * rstd * g0[2] * siluf(bflo(gv.y)), o[c8 * 8 + 3] * rstd * g0[3] * siluf(bfhi(gv.y)));
            r.z = pk2h(o[c8 * 8 + 4] * rstd * g1[0] * siluf(bflo(gv.z)), o[c8 * 8 + 5] * rstd * g1[1] * siluf(bfhi(gv.z)));
            r.w = pk2h(o[c8 * 8 + 6] * rstd * g1[2] * siluf(bflo(gv.w)), o[c8 * 8 + 7] * rstd * g1[3] * siluf(bfhi(gv.w)));
            *(u32x4*)(mp + c8 * 8) = r;
        }
    }
    __syncthreads();
}
constexpr int N_PHASES = 20;
#ifndef PROBE_MASK
#define PROBE_MASK 0u
#endif
#ifndef PROBE_U
#define PROBE_U 0
#endif
#ifndef STAGGER
#define STAGGER 0
#endif
#ifndef STAGGER_TICKS
#define STAGGER_TICKS 1000u
#endif
#ifndef GEMM_SP2
#define GEMM_SP2 true
#endif
#ifndef GEMM_ALIGN
#define GEMM_ALIGN true
#endif
#ifndef PROBE_SYNC2
#define PROBE_SYNC2 0
#endif
__device__ __forceinline__ void stagger_half(unsigned ticks) {
#if STAGGER
    if ((blockIdx.x >> 3) & 1) { const unsigned long long t0 = __builtin_amdgcn_s_memrealtime(); while (__builtin_amdgcn_s_memrealtime() - t0 < ticks) __builtin_amdgcn_s_sleep(32); }
    __syncthreads();
#endif
}
__device__ __forceinline__ void run_phase(const Params& P, LAS unsigned char* lds, int ph) {
    unsigned char* ws = P.ws;
    if (ph == 0) { phase_prologue(P, lds); return; }
    if (ph == N_PHASES - 1) { const float* ml = (const float*)(ws + WS_MOD) + (size_t)(DEPTH - 1) * NBATCH * NMOD * DM;
        phase_norm<2, false, true>(P.out, (const bf16_t*)(ws + WS_OB), ml + 2 * DM, (const bf16_t*)(ws + WS_HBUF), ml + 5 * DM, P.out, P.g_final, nullptr, nullptr, nullptr); return; }
    const int l = (ph - 1) / 9, s = (ph - 1) % 9;
    const float* mod = (const float*)(ws + WS_MOD) + (size_t)l * NBATCH * NMOD * DM; const float* modp = mod - (size_t)NBATCH * NMOD * DM;
    const float* xprev = (l == 1) ? P.x : P.out;
    bf16_t* hbuf = (bf16_t*)(ws + WS_HBUF); bf16_t* proj = (bf16_t*)(ws + WS_PROJ); bf16_t* ybuf = (bf16_t*)(ws + WS_OB);
#ifdef PH_ONLY
    if (s != PH_ONLY) return;
#endif
    int kD = DM, kF = FFN; asm volatile("" : "+s"(kD), "+s"(kF));
    switch (s) {
    case 0: if (l == 0) { phase_norm<0, false, false>(P.x, nullptr, nullptr, nullptr, nullptr, nullptr, P.g_mix, mod + 0 * DM, mod + 1 * DM, hbuf); phase_weights(P, lds, 0, 1); }
            else phase_norm<2, true, false>(xprev, ybuf, modp + 2 * DM, hbuf, modp + 5 * DM, P.out, P.g_mix + l * DM, mod + 0 * DM, mod + 1 * DM, hbuf);
            break;
    case 1: { pg8::Gemm g{hbuf, (const bf16_t*)(ws + WS_WIN) + (size_t)l * INWP * DM, NTOK, INWP, kD}; pg8::StaticOrder S; S.init(NTOK, INWP, gridDim.x, blockIdx.x);
              EpiProj E{proj, INW, INW}; pg8::gemm_phase<EpiProj, pg8::StaticOrder, GEMM_ALIGN, GEMM_SP2>(lds, g, S, E); } break;
    case 2: { for (int rp = 0; rp < (PROBE_U == 1 ? 2 : 1); ++rp) att_phase(P, lds);
              for (int rp = 0; rp < (PROBE_U == 2 ? 2 : 1); ++rp) retA_phase(P, lds);
              for (int rp = 0; rp < (PROBE_U == 3 ? 2 : 1); ++rp) for (int u = blockIdx.x; u < 1024; u += gridDim.x) hgA_unit(P, lds, u, l); } break;
    case 3: { ret_scan(P); hg_scan(P); if (l + 1 < DEPTH) phase_weights(P, lds, l + 1, l + 2); } break;
    case 4: { for (int rp = 0; rp < (PROBE_U == 4 ? 2 : 1); ++rp) for (int u = blockIdx.x; u < 256; u += gridDim.x) hgB_unit(P, lds, u, l);
              for (int rp = 0; rp < (PROBE_U == 5 ? 2 : 1); ++rp) retB_phase(P, lds, l); } break;
    case 5: { pg8::Gemm g{hbuf, (const bf16_t*)(ws + WS_WOUT) + (size_t)l * DM * DM, NTOK, DM, kD}; pg8::StaticOrder S; S.init(NTOK, DM, gridDim.x, blockIdx.x);
              EpiProj E{ybuf, DM, DM}; pg8::gemm_phase<EpiProj, pg8::StaticOrder, GEMM_ALIGN, GEMM_SP2>(lds, g, S, E); } break;
    case 6: phase_norm<1, false, false>(l == 0 ? P.x : P.out, ybuf, mod + 2 * DM, nullptr, nullptr, nullptr, P.g_ffn + l * DM, mod + 3 * DM, mod + 4 * DM, hbuf); break;
    case 7: { pg8::Gemm g{hbuf, (const bf16_t*)(ws + WS_WGU) + (size_t)l * 2 * FFN * DM, NTOK, 2 * FFN, kD}; pg8::StaticOrder S; S.init(NTOK, 2 * FFN, gridDim.x, blockIdx.x);
              EpiSwiglu E{proj}; pg8::gemm_phase<EpiSwiglu, pg8::StaticOrder, GEMM_ALIGN, GEMM_SP2>(lds, g, S, E); } break;
    case 8: { pg8::Gemm g{proj, (const bf16_t*)(ws + WS_WDN) + (size_t)l * DM * FFN, NTOK, DM, kF}; pg8::StaticOrder S; S.init(NTOK, DM, gridDim.x, blockIdx.x);
              EpiProj E{hbuf, DM, DM}; pg8::gemm_phase<EpiProj, pg8::StaticOrder, GEMM_ALIGN, GEMM_SP2>(lds, g, S, E); } break;
    }
}
__global__ void __launch_bounds__(NTHREADS) hybrid_fwd(Params P) {
    extern __shared__ __attribute__((aligned(16))) unsigned char lds_raw[];
    __shared__ uint4 xb_words;
    LAS unsigned char* lds = (LAS unsigned char*)lds_raw;
    if (threadIdx.x == 0) xb_words = make_uint4(0u, 0u, 0u, 0u);
    __syncthreads();
    XcdBarrier bar = xcd_barrier_post((unsigned*)(P.ws + WS_CTL), (volatile LAS unsigned*)&xb_words);
    for (int ph = P.ph_lo; ph < P.ph_hi; ++ph) {
        const int reps = ((PROBE_MASK >> ph) & 1u) ? 2 : 1;
        for (int rep = 0; rep < reps; ++rep) { run_phase(P, lds, ph); if (rep + 1 < reps) __syncthreads(); }
        if (ph + 1 < P.ph_hi) {
            if (P.ph_hi > N_PHASES) cg::this_grid().sync(); else xcd_barrier(bar);
            if (PROBE_SYNC2) xcd_barrier(bar);
        }
    }
}

extern "C" void kernel_launch(void* const* d_in, const int* in_sizes, int n_in, void* d_out, int out_size, void* d_ws, size_t ws_size, hipStream_t stream) {
    static int grid = 0;
    if (grid == 0) {
        if (n_in != 14 || out_size != NTOK * DM || ws_size < WS_END) { fprintf(stderr, "kernel_launch: unexpected shapes (n_in %d out %d ws %zu need %zu)\n", n_in, out_size, ws_size, (size_t)WS_END); grid = -1; return; }
        int dev = 0, cus = 0, per_cu = 0;
        hipGetDevice(&dev); hipDeviceGetAttribute(&cus, hipDeviceAttributeMultiprocessorCount, dev);
        if (hipFuncSetAttribute((const void*)hybrid_fwd, hipFuncAttributeMaxDynamicSharedMemorySize, LDS_BYTES) != hipSuccess) { fprintf(stderr, "kernel_launch: hipFuncSetAttribute failed\n"); grid = -1; return; }
        if (hipOccupancyMaxActiveBlocksPerMultiprocessor(&per_cu, (const void*)hybrid_fwd, NTHREADS, LDS_BYTES) != hipSuccess || per_cu < 1) { fprintf(stderr, "kernel_launch: occupancy query says %d\n", per_cu); grid = -1; return; }
        grid = cus;
    }
    if (grid < 0) return;
    if (hipMemsetAsync((char*)d_ws + WS_CTL, 0, 16384, stream) != hipSuccess) { fprintf(stderr, "kernel_launch: memset failed\n"); return; }
    Params p{};
    p.x = (const float*)d_in[0]; p.c = (const float*)d_in[1]; p.w_ada = (const float*)d_in[2]; p.b_ada = (const float*)d_in[3]; p.g_mix = (const float*)d_in[4];
    p.w_in = (const float*)d_in[5]; p.ret_gn = (const float*)d_in[6]; p.hgrn_gn = (const float*)d_in[7]; p.lb_logits = (const float*)d_in[8]; p.w_out = (const float*)d_in[9];
    p.g_ffn = (const float*)d_in[10]; p.w_gu = (const float*)d_in[11]; p.w_down = (const float*)d_in[12]; p.g_final = (const float*)d_in[13];
    p.out = (float*)d_out; p.ws = (unsigned char*)d_ws;
#if ONE_LAUNCH
    p.ph_lo = 0; p.ph_hi = N_PHASES;
    void* args[] = {&p};
    hipError_t e = hipLaunchCooperativeKernel((const void*)hybrid_fwd, dim3(grid), dim3(NTHREADS), args, LDS_BYTES, stream);
    if (e != hipSuccess) fprintf(stderr, "cooperative launch failed: %s (grid %d)\n", hipGetErrorString(e), grid);
#else
    for (int ph = 0; ph < N_PHASES; ++ph) { p.ph_lo = ph; p.ph_hi = ph + 1; hipLaunchKernelGGL(hybrid_fwd, dim3(grid), dim3(NTHREADS), LDS_BYTES, stream, p); }
#endif
}
```
